# Optimizing an MI355X kernel written in HIP

```python
import math
import jax, jax.numpy as jnp
from jax import lax
import numpy as np

D_MODEL = 2048
BATCH = 2
SEQ = 4096
DEPTH = 1

CHUNK = 64
Q_BLOCK = 2 * CHUNK
HEAD_DIM = 128
SB_HEADS = 8
FOX_HEADS = 8
SB_WIDTH = SB_HEADS * HEAD_DIM
FOX_WIDTH = FOX_HEADS * HEAD_DIM
IN_SPLITS = [SB_WIDTH, SB_WIDTH, SB_WIDTH,
             FOX_WIDTH, FOX_WIDTH, FOX_WIDTH,
             FOX_HEADS,
             D_MODEL, D_MODEL]
IN_WIDTH = sum(IN_SPLITS)
PEER_HEADS = 8
N_KEYS = 128
N_EXPERTS = N_KEYS * N_KEYS
PEER_TOPK = 16
D_KEY = 256
HALF_KEY = D_KEY // 2
PEER_BLOCK = 128
EPS = 1e-6
NEG_INF = -1e30

kernel_name = "hybrid_sb_fox_peer_block"


def rms_norm(x, gain):
    x32 = x.astype(jnp.float32)
    y = x32 * lax.rsqrt(jnp.mean(x32 * x32, axis=-1, keepdims=True) + EPS)
    return (y * gain.astype(jnp.float32)).astype(x.dtype)


def to_heads(t, n_heads):
    b, s, _ = t.shape
    return t.reshape(b, s, n_heads, HEAD_DIM).transpose(0, 2, 1, 3)


def from_heads(t):
    b, h, s, d = t.shape
    return t.transpose(0, 2, 1, 3).reshape(b, s, h * d)


def stick_breaking_attention(q, k, v):
    s_len = q.shape[2]
    scale = 1.0 / math.sqrt(HEAD_DIM)
    outs = []
    for blk in range(s_len // Q_BLOCK):
        t0, t1 = blk * Q_BLOCK, (blk + 1) * Q_BLOCK
        qb = q[:, :, t0:t1].astype(jnp.float32)
        kb = k[:, :, :t1].astype(jnp.float32)
        vb = v[:, :, :t1].astype(jnp.float32)
        z = jnp.einsum('bhqd,bhkd->bhqk', qb, kb) * scale
        t_idx = jnp.arange(t0, t1)[:, None]
        s_idx = jnp.arange(t1)[None, :]
        strict = s_idx < t_idx
        log_1m_beta = jnp.where(strict, jax.nn.log_sigmoid(-z), 0.0)
        suffix = lax.cumsum(log_1m_beta, axis=3, reverse=True) - log_1m_beta
        weights = jnp.where(strict, jnp.exp(jax.nn.log_sigmoid(z) + suffix), 0.0)
        outs.append(jnp.einsum('bhqk,bhkd->bhqd', weights, vb))
    return jnp.concatenate(outs, axis=2).astype(q.dtype)


def forgetting_attention(q, k, v, log_f):
    s_len = q.shape[2]
    scale = 1.0 / math.sqrt(HEAD_DIM)
    cum_f = jnp.cumsum(log_f.astype(jnp.float32), axis=-1)
    outs = []
    for blk in range(s_len // Q_BLOCK):
        t0, t1 = blk * Q_BLOCK, (blk + 1) * Q_BLOCK
        qb = q[:, :, t0:t1].astype(jnp.float32)
        kb = k[:, :, :t1].astype(jnp.float32)
        vb = v[:, :, :t1].astype(jnp.float32)
        logits = jnp.einsum('bhqd,bhkd->bhqk', qb, kb) * scale
        logits = logits + cum_f[:, :, t0:t1, None] - cum_f[:, :, None, :t1]
        causal = jnp.arange(t1)[None, :] <= jnp.arange(t0, t1)[:, None]
        probs = jax.nn.softmax(jnp.where(causal, logits, NEG_INF), axis=-1)
        outs.append(jnp.einsum('bhqk,bhkd->bhqd', probs, vb))
    return jnp.concatenate(outs, axis=2).astype(q.dtype)


def hybrid_mixer(h, w_in, b_forget, w_branch_a, w_branch_b, w_out):
    proj = h @ w_in
    cuts = list(np.cumsum(IN_SPLITS)[:-1])
    q_a, k_a, v_a, q_b, k_b, v_b, f_logit, g_a, g_b = jnp.split(proj, cuts, axis=-1)
    o_a = stick_breaking_attention(to_heads(q_a, SB_HEADS), to_heads(k_a, SB_HEADS),
                                   to_heads(v_a, SB_HEADS))
    log_f = jax.nn.log_sigmoid(f_logit.astype(jnp.float32) + b_forget.astype(jnp.float32))
    log_f = log_f.transpose(0, 2, 1)
    o_b = forgetting_attention(to_heads(q_b, FOX_HEADS), to_heads(k_b, FOX_HEADS),
                               to_heads(v_b, FOX_HEADS), log_f)
    merged = (jax.nn.sigmoid(g_a) * (from_heads(o_a) @ w_branch_a)
              + jax.nn.sigmoid(g_b) * (from_heads(o_b) @ w_branch_b))
    return merged @ w_out


def peer_ffn(h, w_query, sub_keys, expert_u, expert_v):
    b, s, d = h.shape
    n_tok = b * s
    ht = h.reshape(n_tok, d)
    q = (ht @ w_query).astype(jnp.float32).reshape(n_tok, PEER_HEADS, 2, HALF_KEY)
    scores = jnp.einsum('thpc,hpnc->thpn', q, sub_keys.astype(jnp.float32))
    s1, i1 = lax.top_k(scores[:, :, 0], PEER_TOPK)
    s2, i2 = lax.top_k(scores[:, :, 1], PEER_TOPK)
    cand_score = (s1[..., :, None] + s2[..., None, :]).reshape(n_tok, PEER_HEADS, PEER_TOPK * PEER_TOPK)
    cand_id = (i1[..., :, None] * N_KEYS + i2[..., None, :]).reshape(n_tok, PEER_HEADS, PEER_TOPK * PEER_TOPK)
    top_score, pos = lax.top_k(cand_score, PEER_TOPK)
    expert_ids = jnp.take_along_axis(cand_id, pos, axis=-1)
    gates = jax.nn.softmax(top_score, axis=-1)

    n_blk = n_tok // PEER_BLOCK

    def expert_block(args):
        xb, idb, gb = args
        u_sel = expert_u[idb]
        act = jax.nn.gelu(jnp.einsum('thkd,td->thk', u_sel, xb).astype(jnp.float32))
        w = (gb * act).astype(xb.dtype)
        v_sel = expert_v[idb]
        return jnp.einsum('thk,thkd->td', w, v_sel)

    out = lax.map(expert_block, (ht.reshape(n_blk, PEER_BLOCK, d),
                                 expert_ids.reshape(n_blk, PEER_BLOCK, PEER_HEADS, PEER_TOPK),
                                 gates.reshape(n_blk, PEER_BLOCK, PEER_HEADS, PEER_TOPK)))
    return out.reshape(b, s, d)


def setup_inputs(seed: int = 0) -> dict:
    key = jax.random.key(seed)
    ks = jax.random.split(key, 14)
    f32 = jnp.float32
    x = jax.random.normal(ks[0], (BATCH, SEQ, D_MODEL), f32)
    norm_mix_gain = 1.0 + 0.02 * jax.random.normal(ks[1], (DEPTH, D_MODEL), f32)
    w_in = jax.random.normal(ks[2], (DEPTH, D_MODEL, IN_WIDTH), f32) * D_MODEL ** -0.5
    b_forget = jax.random.uniform(ks[3], (DEPTH, FOX_HEADS), f32, minval=1.0, maxval=4.0)
    w_branch_a = jax.random.normal(ks[4], (DEPTH, SB_WIDTH, D_MODEL), f32) * SB_WIDTH ** -0.5
    w_branch_b = jax.random.normal(ks[5], (DEPTH, FOX_WIDTH, D_MODEL), f32) * FOX_WIDTH ** -0.5
    w_out = jax.random.normal(ks[6], (DEPTH, D_MODEL, D_MODEL), f32) * D_MODEL ** -0.5
    norm_ffn_gain = 1.0 + 0.02 * jax.random.normal(ks[7], (DEPTH, D_MODEL), f32)
    w_query = jax.random.normal(ks[8], (DEPTH, D_MODEL, PEER_HEADS * D_KEY), f32) * D_MODEL ** -0.5
    sub_keys = jax.random.normal(ks[9], (DEPTH, PEER_HEADS, 2, N_KEYS, HALF_KEY), f32) * HALF_KEY ** -0.5
    expert_u = jax.random.normal(ks[10], (DEPTH, N_EXPERTS, D_MODEL), f32) * D_MODEL ** -0.5
    expert_v = jax.random.normal(ks[11], (DEPTH, N_EXPERTS, D_MODEL), f32) * PEER_HEADS ** -0.5
    norm_final_gain = 1.0 + 0.02 * jax.random.normal(ks[12], (D_MODEL,), f32)
    return {"x": x, "norm_mix_gain": norm_mix_gain, "w_in": w_in, "b_forget": b_forget,
            "w_branch_a": w_branch_a, "w_branch_b": w_branch_b, "w_out": w_out,
            "norm_ffn_gain": norm_ffn_gain, "w_query": w_query, "sub_keys": sub_keys,
            "expert_u": expert_u, "expert_v": expert_v, "norm_final_gain": norm_final_gain}


def reference(x, norm_mix_gain, w_in, b_forget, w_branch_a, w_branch_b, w_out,
              norm_ffn_gain, w_query, sub_keys, expert_u, expert_v, norm_final_gain):
    for layer in range(DEPTH):
        h = rms_norm(x, norm_mix_gain[layer])
        x = x + hybrid_mixer(h, w_in[layer], b_forget[layer], w_branch_a[layer],
                             w_branch_b[layer], w_out[layer])
        h = rms_norm(x, norm_ffn_gain[layer])
        x = x + peer_ffn(h, w_query[layer], sub_keys[layer], expert_u[layer], expert_v[layer])
    return rms_norm(x, norm_final_gain)
```

```cpp
#include <hip/hip_runtime.h>
#include <hip/hip_cooperative_groups.h>
#include <cstdio>
#include <cstdint>
namespace cg = cooperative_groups;

#define LAS __attribute__((address_space(3)))
typedef unsigned short bf16_t;
typedef short bf16x8 __attribute__((ext_vector_type(8)));
typedef short s16x4 __attribute__((ext_vector_type(4)));
typedef float f32x2 __attribute__((ext_vector_type(2)));
typedef float f32x4 __attribute__((ext_vector_type(4)));
typedef float f32x16 __attribute__((ext_vector_type(16)));
typedef unsigned u32x2 __attribute__((ext_vector_type(2)));
typedef unsigned u32x4 __attribute__((ext_vector_type(4)));
typedef __bf16 bf16v2 __attribute__((ext_vector_type(2)));

#ifndef DBG
#define DBG 11
#endif
#ifndef MK_N_LAUNCHES
#define MK_N_LAUNCHES 1
#endif

constexpr int T_TOK = 8192, DM = 2048, SEQ = 4096, HD = 128;
constexpr int NWAVES = 8, NTHR = 512;
constexpr int LDS_BYTES = 147456;
constexpr float LOG2E = 1.4426950408889634f;
constexpr float EPS = 1e-6f;
constexpr int N_PHASES = 8;

constexpr size_t MiB = 1u << 20;
constexpr size_t WS_CTL = 0;
constexpr size_t WS_LOGF = 1 * MiB;
constexpr size_t WS_SKB = 1 * MiB + 512 * 1024;
constexpr size_t WS_IDS = 2 * MiB;
constexpr size_t WS_GATES = 6 * MiB;
constexpr size_t WS_WAT = 10 * MiB, WS_WBT = 14 * MiB, WS_WOUT = 18 * MiB, WS_WQ = 26 * MiB, WS_WIN = 34 * MiB;
constexpr size_t WS_H = 74 * MiB;
constexpr size_t WS_QKV = 106 * MiB;
constexpr size_t WS_TMP = 106 * MiB, WS_MERGED = 170 * MiB, WS_Q2 = 106 * MiB;
constexpr size_t WS_SG = 202 * MiB;
constexpr size_t WS_X1B = 202 * MiB;
constexpr size_t WS_X1 = 266 * MiB;
constexpr size_t WS_EU = 330 * MiB, WS_EV = 394 * MiB;
constexpr size_t WS_END = 458 * MiB;

struct Params {
    const float* x; const float* g_mix; const float* w_in; const float* b_forget; const float* w_a; const float* w_b; const float* w_out;
    const float* g_ffn; const float* w_query; const float* sub_keys; const float* e_u; const float* e_v; const float* g_final;
    float* out; unsigned char* ws; int ph_lo, ph_hi;
};

__device__ __forceinline__ unsigned pk2(float a, float b) { f32x2 v = {a, b}; return __builtin_bit_cast(unsigned, __builtin_convertvector(v, bf16v2)); }
__device__ __forceinline__ float bf_lo(unsigned u) { return __builtin_bit_cast(float, u << 16); }
__device__ __forceinline__ float bf_hi(unsigned u) { return __builtin_bit_cast(float, u & 0xffff0000u); }
__device__ __forceinline__ float fexp2(float x) { return __builtin_amdgcn_exp2f(x); }
__device__ __forceinline__ float flog2(float x) { return __builtin_amdgcn_logf(x); }
__device__ __forceinline__ float frcp(float x) { return __builtin_amdgcn_rcpf(x); }
__device__ __forceinline__ float wave_sum(float v) {
#pragma unroll
    for (int o = 1; o < 64; o <<= 1) v += __shfl_xor(v, o);
    return v;
}
#define LDS_WAIT() asm volatile("s_waitcnt lgkmcnt(0)" ::: "memory")

namespace pg8 {
constexpr int BM = 256, BK = 64, HALF = 128, HTB = HALF * BK * 2, STAGE_BYTES = 8 * HTB, NXCD = 8, WGM = 8;
__host__ __device__ __forceinline__ int lds_byte(int r, int c) { const int st = (r >> 4) * 2 + (c >> 5), rr = r & 15, cc = c & 31, ob = rr * 64 + cc * 2; return st * 1024 + (ob ^ (((ob >> 9) & 1) << 5)); }
__host__ __device__ __forceinline__ void stage_rc(int b, int& R, int& C) { const int st = b / 1024, sb = b % 1024, swz = sb ^ (((sb >> 9) & 1) << 5); R = (st >> 1) * 16 + swz / 64; C = (st & 1) * 32 + (swz % 64) / 2; }
__host__ __device__ __forceinline__ int perm32(int rho) { const int n = rho >> 4, i = rho & 15; return 8 * (i >> 2) + 4 * n + (i & 3); }
struct Unit { int pm, pn; };
struct Gemm { const bf16_t* A; const bf16_t* Bt; int M, N, K, lda, ldb; };
struct StaticOrder {
    int nM, nN, nwg, G, c;
    __device__ void init(int M, int N, int G_, int c_) { nM = M / BM; nN = N / BM; nwg = nM * nN; G = G_; c = c_; }
    __device__ bool next(int i, Unit& u) const {
        const long L = (long)i * G + c; if (L >= nwg) return false;
        int wgid = (int)L; { const int q = nwg / NXCD, r = nwg % NXCD, xcd = wgid % NXCD, off = wgid / NXCD; wgid = (xcd < r ? xcd * (q + 1) : r * (q + 1) + (xcd - r) * q) + off; }
        const int nig = WGM * nN, gid = wgid / nig, fm = gid * WGM, gsz = (nM - fm) < WGM ? (nM - fm) : WGM;
        u.pm = fm + ((wgid % nig) % gsz); u.pn = (wgid % nig) / gsz; return true;
    }
};
template <class Epi>
__device__ __forceinline__ void gemm_phase(LAS unsigned char* lds, const Gemm g, const StaticOrder& S, const Epi& E) {
    const int tid = threadIdx.x, wid = __builtin_amdgcn_readfirstlane(tid >> 6), lane = tid & 63, wr = wid >> 2, wc = wid & 3, fr = lane & 15, fq = lane >> 4;
    const int K = g.K, nt = K / BK;
    unsigned voffA[2], voffB[2];
#pragma unroll
    for (int i = 0; i < 2; ++i) { int R, C; stage_rc(tid * 16 + i * 8192, R, C); const int Rb = (R & ~31) + perm32(R & 31);
        voffA[i] = (unsigned)(R * g.lda + C) * 2u; voffB[i] = (unsigned)(Rb * g.ldb + C) * 2u; }
    const size_t kstep = (size_t)(BK * 2);
    const size_t hstepA = (size_t)HALF * g.lda * 2, hstepB = (size_t)HALF * g.ldb * 2;
    const size_t tstepA = 2 * hstepA, tstepB = 2 * hstepB;
    const unsigned ldsw = (unsigned)wid * 1024u;
    const int aoff = lds_byte(wr * 64 + fr, fq * 8), boff = lds_byte(wc * 32 + fr, fq * 8);
#define PG8_SA(b, h) (((b) * 2 + (h)) * HTB)
#define PG8_SB(b, h) ((4 + (b) * 2 + (h)) * HTB)
#define PG8_STAGE(bufoff, gbase, voff) do { _Pragma("unroll") for (int _i = 0; _i < 2; ++_i) \
        __builtin_amdgcn_global_load_lds((const unsigned*)((const char*)(gbase) + (voff)[_i]), (LAS unsigned*)(lds + (bufoff) + ldsw + _i * 8192), 16, 0, 0); } while (0)
#define PG8_LDA(dst, b, h) do { _Pragma("unroll") for (int m = 0; m < 4; ++m) _Pragma("unroll") for (int k = 0; k < 2; ++k) dst[m][k] = *(const LAS bf16x8*)(lds + PG8_SA(b, h) + aoff + m * 2048 + k * 1024); } while (0)
#define PG8_LDB(dst, b, h) do { _Pragma("unroll") for (int n = 0; n < 2; ++n) _Pragma("unroll") for (int k = 0; k < 2; ++k) dst[n][k] = *(const LAS bf16x8*)(lds + PG8_SB(b, h) + boff + n * 2048 + k * 1024); } while (0)
#define PG8_MMA(ai, bj, At, Bt) do { __builtin_amdgcn_s_setprio(1); _Pragma("unroll") for (int m = 0; m < 4; ++m) _Pragma("unroll") for (int n = 0; n < 2; ++n) _Pragma("unroll") for (int k = 0; k < 2; ++k) \
        acc[ai][bj][m][n] = __builtin_amdgcn_mfma_f32_16x16x32_bf16(Bt[n][k], At[m][k], acc[ai][bj][m][n], 0, 0, 0); __builtin_amdgcn_s_setprio(0); } while (0)
#define PG8_WAIT_V(n) asm volatile("s_waitcnt vmcnt(" #n ")" ::: "memory")
#define PG8_WAIT_L(n) asm volatile("s_waitcnt lgkmcnt(" #n ")" ::: "memory")
#define PG8_BAR __builtin_amdgcn_s_barrier()
#define PG8_SCHED __builtin_amdgcn_sched_barrier(0)
    Unit cur, nxt; int ui = 0;
    if (!S.next(0, cur)) return;
    f32x4 acc[2][2][4][2];
#pragma unroll
    for (int a = 0; a < 2; ++a)
#pragma unroll
        for (int b = 0; b < 2; ++b)
#pragma unroll
            for (int m = 0; m < 4; ++m)
#pragma unroll
                for (int n = 0; n < 2; ++n) acc[a][b][m][n] = (f32x4){0.f, 0.f, 0.f, 0.f};
    bf16x8 At[4][2], B0[2][2], B1[2][2];
    const char* cA = (const char*)g.A + (size_t)cur.pm * tstepA; const char* cB = (const char*)g.Bt + (size_t)cur.pn * tstepB;
    PG8_STAGE(PG8_SB(0, 0), cB, voffB); PG8_STAGE(PG8_SA(0, 0), cA, voffA); PG8_STAGE(PG8_SB(0, 1), cB + hstepB, voffB); PG8_STAGE(PG8_SA(0, 1), cA + hstepA, voffA);
    if (wr == 1) PG8_BAR;
    PG8_WAIT_V(4); PG8_BAR;
    PG8_STAGE(PG8_SB(1, 0), cB + kstep, voffB); PG8_STAGE(PG8_SA(1, 0), cA + kstep, voffA); PG8_STAGE(PG8_SB(1, 1), cB + hstepB + kstep, voffB);
    PG8_WAIT_V(6); PG8_BAR;
    for (;;) {
        const bool has_next = S.next(ui + 1, nxt);
        const char* nA = has_next ? (const char*)g.A + (size_t)nxt.pm * tstepA : cA; const char* nB = has_next ? (const char*)g.Bt + (size_t)nxt.pn * tstepB : cB;
        for (int t = 0; t < nt; t += 2) {
            const bool last = (t == nt - 2);
            const char* a1 = cA + (size_t)(t + 1) * kstep;
            const char* a2 = last ? nA : cA + (size_t)(t + 2) * kstep; const char* b2 = last ? nB : cB + (size_t)(t + 2) * kstep;
            const char* a3 = a2 + kstep; const char* b3 = b2 + kstep;
            PG8_LDB(B0, 0, 0); PG8_SCHED; PG8_LDA(At, 0, 0); PG8_STAGE(PG8_SA(1, 1), a1 + hstepA, voffA);
            PG8_WAIT_L(8); PG8_BAR; PG8_WAIT_L(0); PG8_MMA(0, 0, At, B0); PG8_BAR; PG8_SCHED;
            PG8_LDB(B1, 0, 1); PG8_STAGE(PG8_SB(0, 0), b2, voffB);
            PG8_BAR; PG8_WAIT_L(0); PG8_MMA(0, 1, At, B1); PG8_BAR;
            PG8_LDA(At, 0, 1); PG8_STAGE(PG8_SA(0, 0), a2, voffA);
            PG8_BAR; PG8_WAIT_L(0); PG8_MMA(1, 0, At, B0); PG8_BAR; PG8_SCHED;
            PG8_STAGE(PG8_SB(0, 1), b2 + hstepB, voffB);
            PG8_WAIT_V(6); PG8_BAR; PG8_MMA(1, 1, At, B1); PG8_BAR;
            PG8_LDB(B0, 1, 0); PG8_SCHED; PG8_LDA(At, 1, 0); PG8_STAGE(PG8_SA(0, 1), a2 + hstepA, voffA);
            PG8_WAIT_L(8); PG8_BAR; PG8_WAIT_L(0); PG8_MMA(0, 0, At, B0); PG8_BAR; PG8_SCHED;
            PG8_LDB(B1, 1, 1); PG8_STAGE(PG8_SB(1, 0), b3, voffB);
            PG8_BAR; PG8_WAIT_L(0); PG8_MMA(0, 1, At, B1); PG8_BAR;
            PG8_LDA(At, 1, 1); PG8_STAGE(PG8_SA(1, 0), a3, voffA);
            PG8_BAR; PG8_WAIT_L(0); PG8_MMA(1, 0, At, B0); PG8_BAR; PG8_SCHED;
            PG8_STAGE(PG8_SB(1, 1), b3 + hstepB, voffB);
            PG8_WAIT_V(6); PG8_BAR; PG8_MMA(1, 1, At, B1); PG8_BAR;
        }
        E(acc, cur, wr, wc, fr, fq);
        if (!has_next) break;
#pragma unroll
        for (int a = 0; a < 2; ++a)
#pragma unroll
            for (int b = 0; b < 2; ++b)
#pragma unroll
                for (int m = 0; m < 4; ++m)
#pragma unroll
                    for (int n = 0; n < 2; ++n) acc[a][b][m][n] = (f32x4){0.f, 0.f, 0.f, 0.f};
        cur = nxt; cA = nA; cB = nB; ++ui;
    }
    PG8_WAIT_V(0);
    if (wr == 0) PG8_BAR;
    PG8_BAR;
#undef PG8_SA
#undef PG8_SB
#undef PG8_STAGE
#undef PG8_LDA
#undef PG8_LDB
#undef PG8_MMA
#undef PG8_WAIT_V
#undef PG8_WAIT_L
#undef PG8_BAR
#undef PG8_SCHED
}

struct EpiProj {
    bf16_t* qkv; bf16_t* sg; float qscale;
    __device__ __forceinline__ void operator()(const f32x4 (&acc)[2][2][4][2], const Unit& u, int wr, int wc, int fr, int fq) const {
        const int row0 = u.pm * BM + wr * 64 + fr;
        if (u.pn < 24) {
            const int t = u.pn >> 2; bf16_t* base = qkv + (size_t)t * ((size_t)T_TOK * 1024) + (u.pn & 3) * 256 + wc * 32 + 8 * fq;
            const float sc = (t == 0 || t == 3) ? qscale : 1.f;
#pragma unroll
            for (int ai = 0; ai < 2; ++ai)
#pragma unroll
                for (int m = 0; m < 4; ++m) { bf16_t* rowp = base + (size_t)(row0 + ai * HALF + m * 16) * 1024;
#pragma unroll
                    for (int bj = 0; bj < 2; ++bj) { const f32x4 v0 = acc[ai][bj][m][0] * sc, v1 = acc[ai][bj][m][1] * sc;
                        u32x4 w; w.x = pk2(v0[0], v0[1]); w.y = pk2(v0[2], v0[3]); w.z = pk2(v1[0], v1[1]); w.w = pk2(v1[2], v1[3]);
                        *(u32x4*)(rowp + bj * HALF) = w; } }
        } else {
            bf16_t* base = sg + (u.pn - 24) * 256 + wc * 32 + 8 * fq;
#pragma unroll
            for (int ai = 0; ai < 2; ++ai)
#pragma unroll
                for (int m = 0; m < 4; ++m) { bf16_t* rowp = base + (size_t)(row0 + ai * HALF + m * 16) * 4096;
#pragma unroll
                    for (int bj = 0; bj < 2; ++bj) { float s[8];
#pragma unroll
                        for (int e = 0; e < 4; ++e) { s[e] = frcp(1.f + fexp2(-LOG2E * acc[ai][bj][m][0][e])); s[4 + e] = frcp(1.f + fexp2(-LOG2E * acc[ai][bj][m][1][e])); }
                        u32x4 w; w.x = pk2(s[0], s[1]); w.y = pk2(s[2], s[3]); w.z = pk2(s[4], s[5]); w.w = pk2(s[6], s[7]);
                        *(u32x4*)(rowp + bj * HALF) = w; } }
        }
    }
};
template <int SECOND> struct EpiGate {
    const bf16_t* sg;
    float* tmp; bf16_t* merged;
    __device__ __forceinline__ void operator()(const f32x4 (&acc)[2][2][4][2], const Unit& u, int wr, int wc, int fr, int fq) const {
        const int row0 = u.pm * BM + wr * 64 + fr, col0 = u.pn * BM + wc * 32 + 8 * fq;
#pragma unroll
        for (int ai = 0; ai < 2; ++ai)
#pragma unroll
            for (int m = 0; m < 4; ++m) { const size_t row = (size_t)(row0 + ai * HALF + m * 16);
#pragma unroll
                for (int bj = 0; bj < 2; ++bj) { const int col = col0 + bj * HALF;
                    const u32x4 gv = *(const u32x4*)(sg + row * 4096 + col);
                    const f32x4 g0 = {bf_lo(gv.x), bf_hi(gv.x), bf_lo(gv.y), bf_hi(gv.y)}, g1 = {bf_lo(gv.z), bf_hi(gv.z), bf_lo(gv.w), bf_hi(gv.w)};
                    f32x4 v0 = acc[ai][bj][m][0] * g0, v1 = acc[ai][bj][m][1] * g1;
                    float* tp = tmp + row * DM + col;
                    if (SECOND == 0) { *(f32x4*)tp = v0; *(f32x4*)(tp + 4) = v1; }
                    else { v0 += *(const f32x4*)tp; v1 += *(const f32x4*)(tp + 4);
                        u32x4 w; w.x = pk2(v0[0], v0[1]); w.y = pk2(v0[2], v0[3]); w.z = pk2(v1[0], v1[1]); w.w = pk2(v1[2], v1[3]);
                        *(u32x4*)(merged + row * DM + col) = w; } } }
    }
};
struct EpiResid {
    const float* x; float* x1; bf16_t* x1b; float* rowss;
    __device__ __forceinline__ void operator()(const f32x4 (&acc)[2][2][4][2], const Unit& u, int wr, int wc, int fr, int fq) const {
        const int row0 = u.pm * BM + wr * 64 + fr, col0 = u.pn * BM + wc * 32 + 8 * fq;
#pragma unroll
        for (int ai = 0; ai < 2; ++ai)
#pragma unroll
            for (int m = 0; m < 4; ++m) { const size_t row = (size_t)(row0 + ai * HALF + m * 16); float ss = 0.f;
#pragma unroll
                for (int bj = 0; bj < 2; ++bj) { const size_t o = row * DM + col0 + bj * HALF;
                    const f32x4 v0 = (DBG == 2 ? 0.f : 1.f) * acc[ai][bj][m][0] + *(const f32x4*)(x + o), v1 = (DBG == 2 ? 0.f : 1.f) * acc[ai][bj][m][1] + *(const f32x4*)(x + o + 4);
                    *(f32x4*)(x1 + o) = v0; *(f32x4*)(x1 + o + 4) = v1;
                    u32x4 w; w.x = pk2(v0[0], v0[1]); w.y = pk2(v0[2], v0[3]); w.z = pk2(v1[0], v1[1]); w.w = pk2(v1[2], v1[3]);
                    *(u32x4*)(x1b + o) = w;
                    ss += (v0[0] * v0[0] + v0[1] * v0[1]) + (v0[2] * v0[2] + v0[3] * v0[3]) + (v1[0] * v1[0] + v1[1] * v1[1]) + (v1[2] * v1[2] + v1[3] * v1[3]); }
                ss += __shfl_xor(ss, 16); ss += __shfl_xor(ss, 32);
                if (fq == 0) atomicAdd(rowss + row, ss); }
    }
};
struct EpiPlainBf16 {
    bf16_t* o;
    __device__ __forceinline__ void operator()(const f32x4 (&acc)[2][2][4][2], const Unit& u, int wr, int wc, int fr, int fq) const {
        const int row0 = u.pm * BM + wr * 64 + fr, col0 = u.pn * BM + wc * 32 + 8 * fq;
#pragma unroll
        for (int ai = 0; ai < 2; ++ai)
#pragma unroll
            for (int m = 0; m < 4; ++m) { const size_t row = (size_t)(row0 + ai * HALF + m * 16);
#pragma unroll
                for (int bj = 0; bj < 2; ++bj) { const f32x4 v0 = acc[ai][bj][m][0], v1 = acc[ai][bj][m][1];
                    u32x4 w; w.x = pk2(v0[0], v0[1]); w.y = pk2(v0[2], v0[3]); w.z = pk2(v1[0], v1[1]); w.w = pk2(v1[2], v1[3]);
                    *(u32x4*)(o + row * DM + col0 + bj * HALF) = w; } }
    }
};
}

__device__ __forceinline__ void transpose_item(const float* W, int ldw, int src_n0, bf16_t* WT, int K, int dst_n0, int k0, LAS float* scr, int lane, const float* kscale) {
#pragma unroll 8
    for (int i = 0; i < 32; ++i) { const int kk = 2 * i + (lane >> 5); float v = W[(size_t)(k0 + kk) * ldw + src_n0 + (lane & 31)]; if (kscale) v *= kscale[k0 + kk]; scr[kk * 33 + (lane & 31)] = v; }
    LDS_WAIT();
    const int c = lane & 7;
#pragma unroll
    for (int j = 0; j < 4; ++j) { const int n = (lane >> 3) + 8 * j; const LAS float* s = scr + (8 * c) * 33 + n;
        u32x4 o; o.x = pk2(s[0 * 33], s[1 * 33]); o.y = pk2(s[2 * 33], s[3 * 33]); o.z = pk2(s[4 * 33], s[5 * 33]); o.w = pk2(s[6 * 33], s[7 * 33]);
        *(u32x4*)(WT + (size_t)(dst_n0 + n) * K + k0 + 8 * c) = o; }
    LDS_WAIT();
}

__device__ __forceinline__ void p0_prologue(const Params& P, LAS unsigned char* lds, int vcu, int G) {
    const int tid = threadIdx.x, lane = tid & 63, wave = __builtin_amdgcn_readfirstlane(tid >> 6);
    const int gw = vcu * NWAVES + wave, NGW = G * NWAVES;
    unsigned char* ws = P.ws;
    {
        LAS float* scr = (LAS float*)(lds + wave * 16384);
        constexpr int I_IN = 32 * 320, I_A = 16 * 64, I_O = 32 * 64;
        constexpr int NITEMS = I_IN + 2 * I_A + 2 * I_O;
        for (int it = gw; it < NITEMS; it += NGW) {
            int r = it;
            if (r < I_IN) { const int kb = r / 320, nb = r % 320, dn = nb * 32; transpose_item(P.w_in, 10248, dn < 6144 ? dn : dn + 8, (bf16_t*)(ws + WS_WIN), 2048, dn, kb * 64, scr, lane, nullptr); continue; } r -= I_IN;
            if (r < I_A) { const int kb = r / 64, nb = r % 64; transpose_item(P.w_a, 2048, nb * 32, (bf16_t*)(ws + WS_WAT), 1024, nb * 32, kb * 64, scr, lane, nullptr); continue; } r -= I_A;
            if (r < I_A) { const int kb = r / 64, nb = r % 64; transpose_item(P.w_b, 2048, nb * 32, (bf16_t*)(ws + WS_WBT), 1024, nb * 32, kb * 64, scr, lane, nullptr); continue; } r -= I_A;
            if (r < I_O) { const int kb = r / 64, nb = r % 64; transpose_item(P.w_out, 2048, nb * 32, (bf16_t*)(ws + WS_WOUT), 2048, nb * 32, kb * 64, scr, lane, nullptr); continue; } r -= I_O;
            { const int kb = r / 64, nb = r % 64; transpose_item(P.w_query, 2048, nb * 32, (bf16_t*)(ws + WS_WQ), 2048, nb * 32, kb * 64, scr, lane, P.g_ffn); }
        }
    }
    __syncthreads();
    {
        LAS float* wf = (LAS float*)lds;
        for (int idx = tid; idx < 2048 * 8; idx += NTHR) { const int k = idx >> 3, c = idx & 7; wf[c * 2048 + k] = P.w_in[(size_t)k * 10248 + 6144 + c]; }
        __syncthreads();
        bf16_t* H = (bf16_t*)(ws + WS_H); float* LOGF = (float*)(ws + WS_LOGF);
        for (int r = gw; r < T_TOK; r += NGW) {
            const f32x4* xr = (const f32x4*)(P.x + (size_t)r * DM) + lane;
            float ss = 0.f;
#pragma unroll
            for (int j = 0; j < 8; ++j) { const f32x4 v = xr[64 * j]; ss += (v[0] * v[0] + v[1] * v[1]) + (v[2] * v[2] + v[3] * v[3]); }
            const float rstd = 1.0f / sqrtf(wave_sum(ss) * (1.f / DM) + EPS);
            float fl[8];
#pragma unroll
            for (int c = 0; c < 8; ++c) fl[c] = 0.f;
            u32x2* hp = (u32x2*)(H + (size_t)r * DM) + lane;
#pragma unroll 1
            for (int j = 0; j < 8; ++j) { const f32x4 gn = *((const f32x4*)P.g_mix + lane + 64 * j); const f32x4 hv = xr[64 * j] * rstd * gn;
                u32x2 o; o.x = pk2(hv[0], hv[1]); o.y = pk2(hv[2], hv[3]); hp[64 * j] = o;
#pragma unroll
                for (int c = 0; c < 8; ++c) { const f32x4 wv = *((const LAS f32x4*)(wf + c * 2048) + lane + 64 * j); fl[c] += (hv[0] * wv[0] + hv[1] * wv[1]) + (hv[2] * wv[2] + hv[3] * wv[3]); } }
#pragma unroll
            for (int c = 0; c < 8; ++c) fl[c] = wave_sum(fl[c]);
            if (lane == 0) {
#pragma unroll
                for (int c = 0; c < 8; ++c) { const float y = fl[c] + P.b_forget[c]; LOGF[(size_t)r * 8 + c] = fminf(y, 0.f) - log1pf(expf(-fabsf(y))); }
            }
        }
    }
    {
        const size_t gid = (size_t)vcu * NTHR + tid, gstride = (size_t)G * NTHR;
        constexpr size_t NCH = (size_t)16384 * 2048 / 8;
        for (size_t i = gid; i < 2 * NCH; i += gstride) { const bool second = i >= NCH; const size_t off = (second ? i - NCH : i) * 8;
            const float* src = (second ? P.e_v : P.e_u) + off; bf16_t* dst = (bf16_t*)(ws + (second ? WS_EV : WS_EU)) + off;
            const f32x4 a = __builtin_nontemporal_load((const f32x4*)src), b = __builtin_nontemporal_load((const f32x4*)src + 1);
            u32x4 o; o.x = pk2(a[0], a[1]); o.y = pk2(a[2], a[3]); o.z = pk2(b[0], b[1]); o.w = pk2(b[2], b[3]); *(u32x4*)dst = o; }
        for (size_t i = gid; i < 262144 / 8; i += gstride) { const float* src = P.sub_keys + i * 8; const f32x4 a = *(const f32x4*)src, b = *((const f32x4*)src + 1);
            u32x4 o; o.x = pk2(a[0], a[1]); o.y = pk2(a[2], a[3]); o.z = pk2(b[0], b[1]); o.w = pk2(b[2], b[3]); *(u32x4*)((bf16_t*)(ws + WS_SKB) + i * 8) = o; }
    }
}

namespace att {
constexpr int KST = 272, VST = 320;
constexpr int KBUF = 64 * KST, VBUF = 64 * VST;
constexpr int OFF_K = 0, OFF_V = 2 * KBUF, OFF_F = OFF_V + 2 * VBUF, OFF_SC = OFF_F + 4096 * 4;
static_assert(OFF_SC + 64 <= 131072, "attention LDS");

__device__ __forceinline__ void build_cumf(LAS unsigned char* lds, const float* LOGF, int b, int h, int n, int tid, int lane, int wid) {
    LAS float* F2 = (LAS float*)(lds + OFF_F); LAS float* sc = (LAS float*)(lds + OFF_SC);
    const int s0 = tid * 8; float v[8];
#pragma unroll
    for (int i = 0; i < 8; ++i) v[i] = (s0 < n) ? LOGF[((size_t)b * SEQ + s0 + i) * 8 + h] * LOG2E : 0.f;
#pragma unroll
    for (int i = 1; i < 8; ++i) v[i] += v[i - 1];
    float tot = v[7], inc = tot;
#pragma unroll
    for (int o = 1; o < 64; o <<= 1) { const float t = __shfl_up(inc, o); if (lane >= o) inc += t; }
    if (lane == 63) sc[wid] = inc;
    __syncthreads();
    float base = inc - tot;
#pragma unroll
    for (int w = 0; w < 8; ++w) if (w < wid) base += sc[w];
    if (s0 < n) {
#pragma unroll
        for (int i = 0; i < 8; ++i) F2[s0 + i] = v[i] + base;
    }
    __syncthreads();
}

template <int MIXER>
__device__ __forceinline__ void attn_unit(LAS unsigned char* lds, const bf16_t* Q, const bf16_t* Kg, const bf16_t* Vg, bf16_t* O, int b, int h, int qb, int tid, int lane, int wid) {
    const int c = lane & 31, hh = lane >> 5;
    const int t0 = qb * 256 + wid * 32, tq = t0 + c;
    const size_t rowbase = (size_t)b * SEQ;
    size_t qoff = (rowbase + tq) * 1024 + h * HD + 8 * hh;
    f32x16 oacc[4];
#pragma unroll
    for (int d = 0; d < 4; ++d)
#pragma unroll
        for (int r = 0; r < 16; ++r) oacc[d][r] = 0.f;
    float carry = 0.f, mrun = -1e30f, lsum = 0.f; const float nhf = hh ? 0.f : 1.f;
    const LAS float* F2 = (const LAS float*)(lds + OFF_F);
    const float Ft = (MIXER == 1) ? F2[tq] : 0.f;
    const int ktmax = 4 * qb + 3;
    const int srow = tid >> 4, scc = tid & 15;
    u32x4 kr[2], vr[2];
#define ATT_LOAD(kt) do { _Pragma("unroll") for (int j = 0; j < 2; ++j) { const size_t g_ = (rowbase + 64 * (kt) + srow + 32 * j) * 1024 + h * HD + scc * 8; \
        kr[j] = *(const u32x4*)(Kg + g_); vr[j] = *(const u32x4*)(Vg + g_); } } while (0)
#define ATT_WRITE(buf) do { _Pragma("unroll") for (int j = 0; j < 2; ++j) { \
        *(LAS u32x4*)(lds + OFF_K + (buf) * KBUF + (srow + 32 * j) * KST + scc * 16) = kr[j]; \
        *(LAS u32x4*)(lds + OFF_V + (buf) * VBUF + (srow + 32 * j) * VST + scc * 16) = vr[j]; } } while (0)
    ATT_LOAD(ktmax); ATT_WRITE(0); __syncthreads();
    int buf = 0;
    for (int kt = ktmax; kt >= 0; --kt) {
        if (kt > 0) ATT_LOAD(kt - 1);
        if (64 * kt <= t0 + 31) {
            const LAS unsigned char* Kl = lds + OFF_K + buf * KBUF; const LAS unsigned char* Vl = lds + OFF_V + buf * VBUF;
            f32x16 sacc[2];
            asm volatile("" : "+v"(qoff));
            bf16x8 qf[8];
#pragma unroll
            for (int s = 0; s < 8; ++s) qf[s] = *(const bf16x8*)(Q + qoff + 16 * s);
#pragma unroll
            for (int sub = 0; sub < 2; ++sub) {
#pragma unroll
                for (int r = 0; r < 16; ++r) sacc[sub][r] = 0.f;
#pragma unroll
                for (int s = 0; s < 8; ++s) { const bf16x8 kf = *(const LAS bf16x8*)(Kl + (32 * sub + c) * KST + (16 * s + 8 * hh) * 2);
                    sacc[sub] = __builtin_amdgcn_mfma_f32_32x32x16_bf16(kf, qf[s], sacc[sub], 0, 0, 0); }
            }
            const bool need_mask = (64 * kt + 63 >= t0);
            if (MIXER == 0) {
#pragma unroll
                for (int sub = 1; sub >= 0; --sub) {
                    float lb[16];
#pragma unroll
                    for (int r = 0; r < 16; ++r) { const float z = sacc[sub][r]; float l = -flog2(1.f + fexp2(z));
                        if (need_mask) { const int sidx = 64 * kt + 32 * sub + (r & 3) + 8 * (r >> 2) + 4 * hh; l = (sidx < tq) ? l : 0.f; }
                        lb[r] = l; }
                    float Glo[4], Ghi[4];
#pragma unroll
                    for (int g = 0; g < 4; ++g) { lb[4 * g + 2] += lb[4 * g + 3]; lb[4 * g + 1] += lb[4 * g + 2]; lb[4 * g] += lb[4 * g + 1];
                        const unsigned gu = __builtin_bit_cast(unsigned, lb[4 * g]); const auto rr = __builtin_amdgcn_permlane32_swap(gu, gu, false, false);
                        Glo[g] = __builtin_bit_cast(float, (unsigned)rr[0]); Ghi[g] = __builtin_bit_cast(float, (unsigned)rr[1]); }
                    float E[8];
                    E[7] = carry; E[6] = E[7] + Ghi[3]; E[5] = E[6] + Glo[3]; E[4] = E[5] + Ghi[2]; E[3] = E[4] + Glo[2]; E[2] = E[3] + Ghi[1]; E[1] = E[2] + Glo[1]; E[0] = E[1] + Ghi[0];
                    carry = E[0] + Glo[0];
#pragma unroll
                    for (int g = 0; g < 4; ++g) { const float Eo = __builtin_fmaf(nhf, Ghi[g], E[2 * g + 1]);
#pragma unroll
                        for (int i = 0; i < 4; ++i) { const int r = 4 * g + i; float w = fexp2(sacc[sub][r] + lb[r] + Eo);
                            if (need_mask) { const int sidx = 64 * kt + 32 * sub + (r & 3) + 8 * (r >> 2) + 4 * hh; w = (sidx < tq) ? w : 0.f; }
                            sacc[sub][r] = w; } }
                }
            } else {
                float mx = -1e30f;
#pragma unroll
                for (int sub = 0; sub < 2; ++sub)
#pragma unroll
                    for (int g = 0; g < 4; ++g) { const f32x4 fs = *(const LAS f32x4*)(F2 + 64 * kt + 32 * sub + 8 * g + 4 * hh);
#pragma unroll
                        for (int i = 0; i < 4; ++i) { const int r = 4 * g + i; float xv = sacc[sub][r] + (Ft - fs[i]);
                            if (need_mask) { const int sidx = 64 * kt + 32 * sub + 8 * g + 4 * hh + i; xv = (sidx <= tq) ? xv : -1e30f; }
                            sacc[sub][r] = xv; mx = fmaxf(mx, xv); } }
                { const unsigned mu = __builtin_bit_cast(unsigned, mx); const auto rr = __builtin_amdgcn_permlane32_swap(mu, mu, false, false);
                  mx = fmaxf(__builtin_bit_cast(float, (unsigned)rr[0]), __builtin_bit_cast(float, (unsigned)rr[1])); }
                const float mnew = fmaxf(mrun, mx);
                const float alpha = fexp2(mrun - mnew);
                float ps = 0.f;
#pragma unroll
                for (int sub = 0; sub < 2; ++sub)
#pragma unroll
                    for (int r = 0; r < 16; ++r) { const float p = fexp2(sacc[sub][r] - mnew); sacc[sub][r] = p; ps += p; }
                lsum = lsum * alpha + ps;
                if (__any(mnew > mrun)) {
#pragma unroll
                    for (int d = 0; d < 4; ++d)
#pragma unroll
                        for (int r = 0; r < 16; ++r) oacc[d][r] *= alpha;
                }
                mrun = mnew;
            }
#pragma unroll
            for (int ks = 0; ks < 4; ++ks) { const int sub = ks >> 1, rb = 8 * (ks & 1);
                u32x4 pw; pw.x = pk2(sacc[sub][rb + 0], sacc[sub][rb + 1]); pw.y = pk2(sacc[sub][rb + 2], sacc[sub][rb + 3]); pw.z = pk2(sacc[sub][rb + 4], sacc[sub][rb + 5]); pw.w = pk2(sacc[sub][rb + 6], sacc[sub][rb + 7]);
                const bf16x8 pf = __builtin_bit_cast(bf16x8, pw);
                const LAS unsigned char* vb = Vl + (16 * ks + 4 * hh + ((lane & 15) >> 2)) * VST + (16 * ((lane >> 4) & 1) + 4 * (lane & 3)) * 2;
#pragma unroll
                for (int d = 0; d < 4; ++d) {
                    const s16x4 a0 = __builtin_amdgcn_ds_read_tr16_b64_v4i16((LAS s16x4*)(vb + d * 64));
                    const s16x4 a1 = __builtin_amdgcn_ds_read_tr16_b64_v4i16((LAS s16x4*)(vb + d * 64 + 8 * VST));
                    const bf16x8 af = {a0[0], a0[1], a0[2], a0[3], a1[0], a1[1], a1[2], a1[3]};
                    oacc[d] = __builtin_amdgcn_mfma_f32_32x32x16_bf16(af, pf, oacc[d], 0, 0, 0); }
            }
        }
        if (kt > 0) ATT_WRITE(buf ^ 1);
        __syncthreads();
        buf ^= 1;
    }
#undef ATT_LOAD
#undef ATT_WRITE
    float inv = 1.f;
    if (MIXER == 1) { const unsigned lu = __builtin_bit_cast(unsigned, lsum); const auto rr = __builtin_amdgcn_permlane32_swap(lu, lu, false, false);
        inv = 1.f / (__builtin_bit_cast(float, (unsigned)rr[0]) + __builtin_bit_cast(float, (unsigned)rr[1])); }
    bf16_t* op = O + (rowbase + tq) * 2048 + 4 * hh;
#pragma unroll
    for (int d = 0; d < 4; ++d)
#pragma unroll
        for (int g = 0; g < 4; ++g) { u32x2 w; w.x = pk2(oacc[d][4 * g] * inv, oacc[d][4 * g + 1] * inv); w.y = pk2(oacc[d][4 * g + 2] * inv, oacc[d][4 * g + 3] * inv);
            *(u32x2*)(op + 32 * d + 8 * g) = w; }
}

__device__ __forceinline__ void attn_phase(const Params& P, LAS unsigned char* lds, int vcu, int G) {
    const int tid = threadIdx.x, lane = tid & 63, wid = __builtin_amdgcn_readfirstlane(tid >> 6);
    unsigned char* ws = P.ws;
    const bf16_t* QKV = (const bf16_t*)(ws + WS_QKV); const size_t TS = (size_t)T_TOK * 1024;
    bf16_t* OAB = (bf16_t*)(ws + WS_H); const float* LOGF = (const float*)(ws + WS_LOGF);
    for (int item = vcu; item < 256; item += G) {
        const int mixer = item >> 7, rem = item & 127, bh = rem >> 3, pair = rem & 7, b = bh >> 3, h = bh & 7;
        if (mixer == 0) {
            attn_unit<0>(lds, QKV, QKV + TS, QKV + 2 * TS, OAB + h * HD, b, h, 15 - pair, tid, lane, wid);
            attn_unit<0>(lds, QKV, QKV + TS, QKV + 2 * TS, OAB + h * HD, b, h, pair, tid, lane, wid);
        } else {
            build_cumf(lds, LOGF, b, h, 256 * (16 - pair), tid, lane, wid);
            attn_unit<1>(lds, QKV + 3 * TS, QKV + 4 * TS, QKV + 5 * TS, OAB + 1024 + h * HD, b, h, 15 - pair, tid, lane, wid);
            attn_unit<1>(lds, QKV + 3 * TS, QKV + 4 * TS, QKV + 5 * TS, OAB + 1024 + h * HD, b, h, pair, tid, lane, wid);
        }
        __syncthreads();
    }
}
}

namespace peer {
__device__ __forceinline__ unsigned sortable(float f) { const unsigned u = __builtin_bit_cast(unsigned, f); return (u & 0x80000000u) ? ~u : (u | 0x80000000u); }
__device__ __forceinline__ float unsortable(unsigned k) { const unsigned u = (k & 0x80000000u) ? (k & 0x7fffffffu) : ~k; return __builtin_bit_cast(float, u); }
template <int N> __device__ __forceinline__ unsigned umax_all(const unsigned (&k)[N]) {
    unsigned m = k[0];
#pragma unroll
    for (int q = 1; q < N; ++q) m = m > k[q] ? m : k[q];
    return m;
}

__device__ __forceinline__ void topk_phase(const Params& P, LAS unsigned char* lds, int vcu, int G) {
    const int tid = threadIdx.x, lane = tid & 63, wave = __builtin_amdgcn_readfirstlane(tid >> 6);
    const int c = lane & 31, hh = lane >> 5;
    const int gw = vcu * NWAVES + wave, NGW = G * NWAVES;
    unsigned char* ws = P.ws;
    const bf16_t* Q2 = (const bf16_t*)(ws + WS_Q2); const bf16_t* SKB = (const bf16_t*)(ws + WS_SKB);
    const float* ROWSS = (const float*)(ws + WS_CTL); int* IDS = (int*)(ws + WS_IDS); float* GATES = (float*)(ws + WS_GATES);
    LAS unsigned char* scr = lds + wave * 4096;
    for (int task = gw; task < 2048; task += NGW) {
        const int tg = task >> 3, hd = task & 7, tok = tg * 32 + c;
#pragma unroll 1
        for (int p = 0; p < 2; ++p) {
            bf16x8 qf[8];
            { const bf16_t* qp = Q2 + (size_t)tok * DM + hd * 256 + p * 128 + 8 * hh;
#pragma unroll
              for (int s = 0; s < 8; ++s) qf[s] = *(const bf16x8*)(qp + 16 * s); }
            unsigned keys[64];
#pragma unroll
            for (int sub = 0; sub < 4; ++sub) {
                f32x16 acc;
#pragma unroll
                for (int r = 0; r < 16; ++r) acc[r] = 0.f;
                const bf16_t* kp = SKB + ((size_t)(hd * 2 + p) * 128 + 32 * sub + c) * 128 + 8 * hh;
#pragma unroll
                for (int s = 0; s < 8; ++s) { const bf16x8 kf = *(const bf16x8*)(kp + 16 * s); acc = __builtin_amdgcn_mfma_f32_32x32x16_bf16(kf, qf[s], acc, 0, 0, 0); }
#pragma unroll
                for (int r = 0; r < 16; ++r) { const int nlo = 127 - (32 * sub + (r & 3) + 8 * (r >> 2)); keys[sub * 16 + r] = (sortable(acc[r]) & ~127u) | (unsigned)(nlo - 4 * hh); }
            }
            unsigned top[16];
#pragma unroll
            for (int i = 0; i < 16; ++i) {
                unsigned m = umax_all<64>(keys);
                const auto rr = __builtin_amdgcn_permlane32_swap(m, m, false, false);
                m = (unsigned)rr[0] > (unsigned)rr[1] ? (unsigned)rr[0] : (unsigned)rr[1];
                top[i] = m;
#pragma unroll
                for (int q = 0; q < 64; ++q) keys[q] = (keys[q] == m) ? 0u : keys[q];
            }
            if (hh == 0) {
#pragma unroll
                for (int w = 0; w < 4; ++w) *(LAS u32x4*)(scr + (c * 2 + p) * 64 + w * 16) = (u32x4){top[4 * w], top[4 * w + 1], top[4 * w + 2], top[4 * w + 3]};
            }
        }
        LDS_WAIT();
        float s1[16], s2[16];
#pragma unroll
        for (int w = 0; w < 4; ++w) { const u32x4 a = *(const LAS u32x4*)(scr + (c * 2) * 64 + w * 16), b2 = *(const LAS u32x4*)(scr + (c * 2 + 1) * 64 + w * 16);
#pragma unroll
            for (int e = 0; e < 4; ++e) { s1[4 * w + e] = unsortable((a[e] & ~127u) | 64u); s2[4 * w + e] = unsortable((b2[e] & ~127u) | 64u); } }
        unsigned ck[50];
        { int n = 0;
#pragma unroll
          for (int i = 0; i < 16; ++i)
#pragma unroll
              for (int j = 0; j < 16; ++j) if ((i + 1) * (j + 1) <= 16) { ck[n] = (sortable(s1[i] + s2[j]) & ~255u) | (unsigned)(255 - (i * 16 + j)); ++n; } }
        unsigned t2[16];
#pragma unroll
        for (int k = 0; k < 16; ++k) { const unsigned m = umax_all<50>(ck); t2[k] = m;
#pragma unroll
            for (int q = 0; q < 50; ++q) ck[q] = (ck[q] == m) ? 0u : ck[q]; }
        int ids[16]; float sc[16];
#pragma unroll
        for (int k = 0; k < 16; ++k) { const unsigned pos = 255u - (t2[k] & 255u);
            const unsigned k1 = *(const LAS unsigned*)(scr + (c * 2) * 64 + (pos >> 4) * 4), k2 = *(const LAS unsigned*)(scr + (c * 2 + 1) * 64 + (pos & 15u) * 4);
            ids[k] = (int)((127u - (k1 & 127u)) * 128u + (127u - (k2 & 127u))); sc[k] = unsortable((t2[k] & ~255u) | 128u); }
        LDS_WAIT();
        const float rs = 1.0f / sqrtf(ROWSS[tok] * (1.f / DM) + EPS);
        float ev[16], Z = 0.f;
#pragma unroll
        for (int k = 0; k < 16; ++k) { ev[k] = fexp2((sc[k] - sc[0]) * rs * LOG2E); Z += ev[k]; }
        const float iz = 1.f / Z;
        int* ip = IDS + (size_t)tok * 128 + hd * 16; float* gp = GATES + (size_t)tok * 128 + hd * 16;
        if (hh == 0) {
#pragma unroll
            for (int k = 0; k < 8; ++k) { ip[k] = ids[k]; gp[k] = ev[k] * iz; }
        } else {
#pragma unroll
            for (int k = 8; k < 16; ++k) { ip[k] = ids[k]; gp[k] = ev[k] * iz; }
        }
    }
}


__device__ __forceinline__ void topk_naive(const Params& P, LAS unsigned char* lds, int vcu, int G) {
    const int tid = threadIdx.x, lane = tid & 63, wave = __builtin_amdgcn_readfirstlane(tid >> 6);
    const int gw = vcu * NWAVES + wave, NGW = G * NWAVES;
    unsigned char* ws = P.ws;
    const bf16_t* Q2 = (const bf16_t*)(ws + WS_Q2);
    const float* ROWSS = (const float*)(ws + WS_CTL); int* IDS = (int*)(ws + WS_IDS); float* GATES = (float*)(ws + WS_GATES);
    LAS float* sv = (LAS float*)(lds + wave * 1024);
    LAS int* si = (LAS int*)(lds + wave * 1024 + 256);
    for (int task = gw; task < T_TOK * 8; task += NGW) {
        const int tok = task >> 3, hd = task & 7;
        for (int p = 0; p < 2; ++p) {
            float v0 = 0.f, v1 = 0.f;
            for (int cc = 0; cc < 128; ++cc) { const float q = bf_lo((unsigned)Q2[(size_t)tok * DM + hd * 256 + p * 128 + cc]);
                v0 += q * P.sub_keys[((size_t)(hd * 2 + p) * 128 + lane) * 128 + cc]; v1 += q * P.sub_keys[((size_t)(hd * 2 + p) * 128 + lane + 64) * 128 + cc]; }
            for (int i = 0; i < 16; ++i) {
                float bv = v0 >= v1 ? v0 : v1; int bi = v0 >= v1 ? lane : lane + 64;
                for (int o = 1; o < 64; o <<= 1) { const float ov = __shfl_xor(bv, o); const int oi = __shfl_xor(bi, o); if (ov > bv || (ov == bv && oi < bi)) { bv = ov; bi = oi; } }
                if (lane == 0) { sv[p * 16 + i] = bv; si[p * 16 + i] = bi; }
                if (bi == lane) v0 = -3e38f; if (bi == lane + 64) v1 = -3e38f;
            }
        }
        LDS_WAIT();
        float cv[4]; for (int q = 0; q < 4; ++q) { const int pos = lane * 4 + q; cv[q] = sv[pos >> 4] + sv[16 + (pos & 15)]; }
        float sel_v = 0.f; int sel_id = 0; float mx = 0.f;
        for (int k = 0; k < 16; ++k) {
            float bv = cv[0]; int bi = lane * 4;
            for (int q = 1; q < 4; ++q) if (cv[q] > bv) { bv = cv[q]; bi = lane * 4 + q; }
            for (int o = 1; o < 64; o <<= 1) { const float ov = __shfl_xor(bv, o); const int oi = __shfl_xor(bi, o); if (ov > bv || (ov == bv && oi < bi)) { bv = ov; bi = oi; } }
            if (k == 0) mx = bv;
            if (lane == k) { sel_v = bv; sel_id = si[bi >> 4] * 128 + si[16 + (bi & 15)]; }
            for (int q = 0; q < 4; ++q) if (bi == lane * 4 + q) cv[q] = -3e38f;
        }
        const float rs = 1.0f / sqrtf(ROWSS[tok] * (1.f / DM) + EPS);
        float ev = (lane < 16) ? expf((sel_v - mx) * rs) : 0.f;
        const float Z = wave_sum(ev);
        if (lane < 16) { IDS[(size_t)tok * 128 + hd * 16 + lane] = sel_id; GATES[(size_t)tok * 128 + hd * 16 + lane] = ev / Z; }
        LDS_WAIT();
    }
}

__device__ __forceinline__ float dot8(u32x4 a, u32x4 b, float acc) {
    acc = __builtin_amdgcn_fdot2_f32_bf16(__builtin_bit_cast(bf16v2, a.x), __builtin_bit_cast(bf16v2, b.x), acc, false);
    acc = __builtin_amdgcn_fdot2_f32_bf16(__builtin_bit_cast(bf16v2, a.y), __builtin_bit_cast(bf16v2, b.y), acc, false);
    acc = __builtin_amdgcn_fdot2_f32_bf16(__builtin_bit_cast(bf16v2, a.z), __builtin_bit_cast(bf16v2, b.z), acc, false);
    acc = __builtin_amdgcn_fdot2_f32_bf16(__builtin_bit_cast(bf16v2, a.w), __builtin_bit_cast(bf16v2, b.w), acc, false);
    return acc;
}
__device__ __forceinline__ float gelu_tanh(float a) { const float t = 1.5957691216f * (a + 0.044715f * a * a * a); return a * frcp(1.f + fexp2(-LOG2E * t)); }

__device__ __forceinline__ void gather_phase(const Params& P, int vcu, int G) {
    const int tid = threadIdx.x, lane = tid & 63, wave = __builtin_amdgcn_readfirstlane(tid >> 6);
    const int gw = vcu * NWAVES + wave, NGW = G * NWAVES;
    unsigned char* ws = P.ws;
    const float* X1 = (const float*)(ws + WS_X1); const float* ROWSS = (const float*)(ws + WS_CTL);
    const int* IDS = (const int*)(ws + WS_IDS); const float* GATES = (const float*)(ws + WS_GATES);
    const bf16_t* EU = (const bf16_t*)(ws + WS_EU); const bf16_t* EV = (const bf16_t*)(ws + WS_EV);
    for (int tok = gw; tok < T_TOK; tok += NGW) {
        f32x4 xv[4][2]; u32x4 hp[4];
        const float rs = 1.0f / sqrtf(ROWSS[tok] * (1.f / DM) + EPS);
#pragma unroll
        for (int j = 0; j < 4; ++j) { const size_t o = (size_t)tok * DM + 8 * lane + 512 * j; xv[j][0] = *(const f32x4*)(X1 + o); xv[j][1] = *(const f32x4*)(X1 + o + 4);
            const f32x4 g0 = *(const f32x4*)(P.g_ffn + 8 * lane + 512 * j), g1 = *(const f32x4*)(P.g_ffn + 8 * lane + 512 * j + 4);
            const f32x4 h0 = xv[j][0] * rs * g0, h1 = xv[j][1] * rs * g1;
            hp[j].x = pk2(h0[0], h0[1]); hp[j].y = pk2(h0[2], h0[3]); hp[j].z = pk2(h1[0], h1[1]); hp[j].w = pk2(h1[2], h1[3]); }
        const int ida = IDS[(size_t)tok * 128 + lane], idb = IDS[(size_t)tok * 128 + 64 + lane];
        float wreg[16];
        const bool b5 = (lane >> 5) & 1, b4 = (lane >> 4) & 1, b3 = (lane >> 3) & 1;
#pragma unroll
        for (int bt = 0; bt < 16; ++bt) {
            float part[8];
#pragma unroll
            for (int hb = 0; hb < 2; ++hb) {
                u32x4 ud[4][4];
#pragma unroll
                for (int q = 0; q < 4; ++q) { const int k = bt * 8 + hb * 4 + q; const int e = __builtin_amdgcn_readlane(k < 64 ? ida : idb, k & 63);
                    const bf16_t* ur = EU + (size_t)e * DM + 8 * lane;
#pragma unroll
                    for (int j = 0; j < 4; ++j) ud[q][j] = *(const u32x4*)(ur + 512 * j); }
#pragma unroll
                for (int q = 0; q < 4; ++q) { float a = 0.f;
#pragma unroll
                    for (int j = 0; j < 4; ++j) a = dot8(ud[q][j], hp[j], a);
                    part[hb * 4 + q] = a; }
            }
            float p1[4], p2[2];
#pragma unroll
            for (int q = 0; q < 4; ++q) { const float send = b5 ? part[q] : part[q + 4], keep = b5 ? part[q + 4] : part[q]; p1[q] = keep + __shfl_xor(send, 32); }
#pragma unroll
            for (int q = 0; q < 2; ++q) { const float send = b4 ? p1[q] : p1[q + 2], keep = b4 ? p1[q + 2] : p1[q]; p2[q] = keep + __shfl_xor(send, 16); }
            float p3; { const float send = b3 ? p2[0] : p2[1], keep = b3 ? p2[1] : p2[0]; p3 = keep + __shfl_xor(send, 8); }
            p3 += __shfl_xor(p3, 4); p3 += __shfl_xor(p3, 2); p3 += __shfl_xor(p3, 1);
            const float gate = GATES[(size_t)tok * 128 + bt * 8 + (lane >> 3)];
            wreg[bt] = gate * gelu_tanh(p3);
        }
        f32x4 acc[4][2];
#pragma unroll
        for (int j = 0; j < 4; ++j) { acc[j][0] = (f32x4){0.f, 0.f, 0.f, 0.f}; acc[j][1] = (f32x4){0.f, 0.f, 0.f, 0.f}; }
#pragma unroll
        for (int bt = 0; bt < 16; ++bt) {
#pragma unroll
            for (int hb = 0; hb < 2; ++hb) {
                u32x4 vd[4][4];
#pragma unroll
                for (int q = 0; q < 4; ++q) { const int k = bt * 8 + hb * 4 + q; const int e = __builtin_amdgcn_readlane(k < 64 ? ida : idb, k & 63);
                    const bf16_t* vr = EV + (size_t)e * DM + 8 * lane;
#pragma unroll
                    for (int j = 0; j < 4; ++j) vd[q][j] = *(const u32x4*)(vr + 512 * j); }
#pragma unroll
                for (int q = 0; q < 4; ++q) { const float w = __builtin_bit_cast(float, __builtin_amdgcn_readlane(__builtin_bit_cast(int, wreg[bt]), 8 * (hb * 4 + q)));
#pragma unroll
                    for (int j = 0; j < 4; ++j) { const u32x4 v = vd[q][j];
                        acc[j][0] += w * (f32x4){bf_lo(v.x), bf_hi(v.x), bf_lo(v.y), bf_hi(v.y)};
                        acc[j][1] += w * (f32x4){bf_lo(v.z), bf_hi(v.z), bf_lo(v.w), bf_hi(v.w)}; } }
            }
        }
        float ss = 0.f;
#pragma unroll
        for (int j = 0; j < 4; ++j)
#pragma unroll
            for (int e = 0; e < 2; ++e) { const f32x4 v = (DBG == 1 || DBG == 2) ? xv[j][e] : xv[j][e] + acc[j][e]; xv[j][e] = v; ss += (v[0] * v[0] + v[1] * v[1]) + (v[2] * v[2] + v[3] * v[3]); }
        const float rs2 = 1.0f / sqrtf(wave_sum(ss) * (1.f / DM) + EPS);
#pragma unroll
        for (int j = 0; j < 4; ++j) { const size_t o = (size_t)tok * DM + 8 * lane + 512 * j;
            const f32x4 g0 = *(const f32x4*)(P.g_final + 8 * lane + 512 * j), g1 = *(const f32x4*)(P.g_final + 8 * lane + 512 * j + 4);
            *(f32x4*)(P.out + o) = xv[j][0] * rs2 * g0; *(f32x4*)(P.out + o + 4) = xv[j][1] * rs2 * g1; }
    }
}

__device__ __forceinline__ void gather_naive(const Params& P, int vcu, int G) {
    const int tid = threadIdx.x, lane = tid & 63, wave = __builtin_amdgcn_readfirstlane(tid >> 6);
    const int gw = vcu * NWAVES + wave, NGW = G * NWAVES;
    unsigned char* ws = P.ws;
    const float* X1 = (const float*)(ws + WS_X1); const float* ROWSS = (const float*)(ws + WS_CTL);
    const int* IDS = (const int*)(ws + WS_IDS); const float* GATES = (const float*)(ws + WS_GATES);
    for (int tok = gw; tok < T_TOK; tok += NGW) {
        float xv[32], h2[32], acc[32];
        const float rs = 1.0f / sqrtf(ROWSS[tok] * (1.f / DM) + EPS);
#pragma unroll
        for (int i = 0; i < 32; ++i) { xv[i] = X1[(size_t)tok * DM + lane + 64 * i]; h2[i] = xv[i] * rs * P.g_ffn[lane + 64 * i]; acc[i] = 0.f; }
#pragma unroll 1
        for (int k = 0; k < 128; ++k) {
            const int e = IDS[(size_t)tok * 128 + k]; float a = 0.f;
#pragma unroll
            for (int i = 0; i < 32; ++i) a += h2[i] * P.e_u[(size_t)e * DM + lane + 64 * i];
            a = wave_sum(a);
            const float w = GATES[(size_t)tok * 128 + k] * gelu_tanh(a);
#pragma unroll
            for (int i = 0; i < 32; ++i) acc[i] += w * P.e_v[(size_t)e * DM + lane + 64 * i];
        }
        float ss = 0.f;
#pragma unroll
        for (int i = 0; i < 32; ++i) { xv[i] += acc[i]; ss += xv[i] * xv[i]; }
        const float rs2 = 1.0f / sqrtf(wave_sum(ss) * (1.f / DM) + EPS);
#pragma unroll
        for (int i = 0; i < 32; ++i) P.out[(size_t)tok * DM + lane + 64 * i] = xv[i] * rs2 * P.g_final[lane + 64 * i];
    }
}
}

__global__ void __launch_bounds__(NTHR, 2) mega_fwd(Params P) {
    extern __shared__ __attribute__((aligned(16))) unsigned char lds_raw[];
    LAS unsigned char* lds = (LAS unsigned char*)lds_raw;
    cg::grid_group grid = cg::this_grid();
    const int G = gridDim.x, bx = blockIdx.x;
    const int vcu = (G % 8 == 0) ? (bx % 8) * (G / 8) + bx / 8 : bx;
    unsigned char* ws = P.ws;
#ifndef ONLY_PHASE
#define ONLY_PHASE -1
#endif
#define IN(k) ((ONLY_PHASE < 0 || ONLY_PHASE == (k)) && P.ph_lo <= (k) && (k) < P.ph_hi)
#define SEAM(k) do { if (IN(k) && IN((k) + 1)) grid.sync(); } while (0)
    if (IN(0)) p0_prologue(P, lds, vcu, G);
    SEAM(0);
    if (IN(1)) {
        pg8::Gemm g{(const bf16_t*)(ws + WS_H), (const bf16_t*)(ws + WS_WIN), T_TOK, 10240, 2048, 2048, 2048};
        pg8::StaticOrder S; S.init(T_TOK, 10240, G, bx);
        pg8::EpiProj E{(bf16_t*)(ws + WS_QKV), (bf16_t*)(ws + WS_SG), LOG2E * 0.08838834764831845f};
        pg8::gemm_phase(lds, g, S, E);
    }
    SEAM(1);
    if (IN(2)) att::attn_phase(P, lds, vcu, G);
    SEAM(2);
    if (IN(3)) {
        pg8::StaticOrder S; S.init(T_TOK, DM, G, bx);
        { pg8::Gemm g{(const bf16_t*)(ws + WS_H), (const bf16_t*)(ws + WS_WAT), T_TOK, DM, 1024, 2048, 1024};
          pg8::EpiGate<0> E{(const bf16_t*)(ws + WS_SG), (float*)(ws + WS_TMP), (bf16_t*)(ws + WS_MERGED)};
          pg8::gemm_phase(lds, g, S, E); }
        { pg8::Gemm g{(const bf16_t*)(ws + WS_H) + 1024, (const bf16_t*)(ws + WS_WBT), T_TOK, DM, 1024, 2048, 1024};
          pg8::EpiGate<1> E{(const bf16_t*)(ws + WS_SG) + 2048, (float*)(ws + WS_TMP), (bf16_t*)(ws + WS_MERGED)};
          pg8::gemm_phase(lds, g, S, E); }
    }
    SEAM(3);
    if (IN(4)) {
        pg8::Gemm g{(const bf16_t*)(ws + WS_MERGED), (const bf16_t*)(ws + WS_WOUT), T_TOK, DM, 2048, 2048, 2048};
        pg8::StaticOrder S; S.init(T_TOK, DM, G, bx);
        pg8::EpiResid E{P.x, (float*)(ws + WS_X1), (bf16_t*)(ws + WS_X1B), (float*)(ws + WS_CTL)};
        pg8::gemm_phase(lds, g, S, E);
    }
    SEAM(4);
    if (IN(5)) {
        pg8::Gemm g{(const bf16_t*)(ws + WS_X1B), (const bf16_t*)(ws + WS_WQ), T_TOK, DM, 2048, 2048, 2048};
        pg8::StaticOrder S; S.init(T_TOK, DM, G, bx);
        pg8::EpiPlainBf16 E{(bf16_t*)(ws + WS_Q2)};
        pg8::gemm_phase(lds, g, S, E);
    }
    SEAM(5);
    if (IN(6)) { if (DBG == 10) peer::topk_naive(P, lds, vcu, G); else peer::topk_phase(P, lds, vcu, G); }
    SEAM(6);
    if (IN(7)) { if (DBG == 11) peer::gather_naive(P, vcu, G); else peer::gather_phase(P, vcu, G); }
#undef IN
#undef SEAM
}

extern "C" void kernel_launch(void* const* d_in, const int* in_sizes, int n_in, void* d_out, int out_size, void* d_ws, size_t ws_size, hipStream_t stream) {
    static int grid = 0;
    if (grid == 0) {
        if (n_in != 13 || out_size != T_TOK * DM || ws_size < WS_END) { fprintf(stderr, "kernel_launch: unexpected shapes (n_in %d out %d ws %zu)\n", n_in, out_size, ws_size); grid = -1; return; }
        int dev = 0, cus = 0, per_cu = 0;
        if (hipGetDevice(&dev) != hipSuccess || hipDeviceGetAttribute(&cus, hipDeviceAttributeMultiprocessorCount, dev) != hipSuccess) { grid = -1; return; }
        if (hipFuncSetAttribute((const void*)mega_fwd, hipFuncAttributeMaxDynamicSharedMemorySize, LDS_BYTES) != hipSuccess) { fprintf(stderr, "kernel_launch: hipFuncSetAttribute failed\n"); grid = -1; return; }
        if (hipOccupancyMaxActiveBlocksPerMultiprocessor(&per_cu, (const void*)mega_fwd, NTHR, LDS_BYTES) != hipSuccess || per_cu < 1) { fprintf(stderr, "kernel_launch: occupancy query says %d\n", per_cu); grid = -1; return; }
        grid = cus;
    }
    if (grid < 0) return;
    (void)hipMemsetAsync((char*)d_ws + WS_CTL, 0, 1 * MiB, stream);
    Params p{};
    p.x = (const float*)d_in[0]; p.g_mix = (const float*)d_in[1]; p.w_in = (const float*)d_in[2]; p.b_forget = (const float*)d_in[3];
    p.w_a = (const float*)d_in[4]; p.w_b = (const float*)d_in[5]; p.w_out = (const float*)d_in[6]; p.g_ffn = (const float*)d_in[7];
    p.w_query = (const float*)d_in[8]; p.sub_keys = (const float*)d_in[9]; p.e_u = (const float*)d_in[10]; p.e_v = (const float*)d_in[11]; p.g_final = (const float*)d_in[12];
    p.out = (float*)d_out; p.ws = (unsigned char*)d_ws;
#if MK_N_LAUNCHES == 1
    p.ph_lo = 0; p.ph_hi = N_PHASES;
    void* args[] = {&p};
    hipError_t e = hipLaunchCooperativeKernel((const void*)mega_fwd, dim3(grid), dim3(NTHR), args, LDS_BYTES, stream);
    if (e != hipSuccess) fprintf(stderr, "kernel_launch: cooperative launch failed: %s (grid %d)\n", hipGetErrorString(e), grid);
#else
    for (int ph = 0; ph < N_PHASES; ++ph) { p.ph_lo = ph; p.ph_hi = ph + 1; hipLaunchKernelGGL(mega_fwd, dim3(grid), dim3(NTHR), LDS_BYTES, stream, p); }
#endif
}
```

```cpp
#include <hip/hip_runtime.h>
#include <hip/hip_cooperative_groups.h>
#include <cstdio>
#include <cstdint>
namespace cg = cooperative_groups;

#define LAS __attribute__((address_space(3)))
typedef unsigned short bf16_t;
typedef short bf16x8 __attribute__((ext_vector_type(8)));
typedef short s16x4 __attribute__((ext_vector_type(4)));
typedef float f32x2 __attribute__((ext_vector_type(2)));
typedef float f32x4 __attribute__((ext_vector_type(4)));
typedef float f32x16 __attribute__((ext_vector_type(16)));
typedef unsigned u32x2 __attribute__((ext_vector_type(2)));
typedef unsigned u32x4 __attribute__((ext_vector_type(4)));
typedef __bf16 bf16v2 __attribute__((ext_vector_type(2)));

#ifndef DBG
#define DBG 0
#endif
#ifndef MK_N_LAUNCHES
#define MK_N_LAUNCHES 1
#endif

constexpr int T_TOK = 8192, DM = 2048, SEQ = 4096, HD = 128;
constexpr int NWAVES = 8, NTHR = 512;
constexpr int LDS_BYTES = 147456;
constexpr float LOG2E = 1.4426950408889634f;
constexpr float EPS = 1e-6f;
constexpr int N_PHASES = 8;

constexpr size_t MiB = 1u << 20;
constexpr size_t WS_CTL = 0;
constexpr size_t WS_LOGF = 1 * MiB;
constexpr size_t WS_SKB = 1 * MiB + 512 * 1024;
constexpr size_t WS_IDS = 2 * MiB;
constexpr size_t WS_GATES = 6 * MiB;
constexpr size_t WS_WAT = 10 * MiB, WS_WBT = 14 * MiB, WS_WOUT = 18 * MiB, WS_WQ = 26 * MiB, WS_WIN = 34 * MiB;
constexpr size_t WS_H = 74 * MiB;
constexpr size_t WS_QKV = 106 * MiB;
constexpr size_t WS_TMP = 106 * MiB, WS_MERGED = 170 * MiB, WS_Q2 = 106 * MiB;
constexpr size_t WS_SG = 202 * MiB;
constexpr size_t WS_X1B = 202 * MiB;
constexpr size_t WS_X1 = 266 * MiB;
constexpr size_t WS_EU = 330 * MiB, WS_EV = 394 * MiB;
constexpr size_t WS_END = 458 * MiB;

struct Params {
    const float* x; const float* g_mix; const float* w_in; const float* b_forget; const float* w_a; const float* w_b; const float* w_out;
    const float* g_ffn; const float* w_query; const float* sub_keys; const float* e_u; const float* e_v; const float* g_final;
    float* out; unsigned char* ws; int ph_lo, ph_hi;
};

__device__ __forceinline__ unsigned pk2(float a, float b) { f32x2 v = {a, b}; return __builtin_bit_cast(unsigned, __builtin_convertvector(v, bf16v2)); }
__device__ __forceinline__ float bf_lo(unsigned u) { return __builtin_bit_cast(float, u << 16); }
__device__ __forceinline__ float bf_hi(unsigned u) { return __builtin_bit_cast(float, u & 0xffff0000u); }
__device__ __forceinline__ float fexp2(float x) { return __builtin_amdgcn_exp2f(x); }
__device__ __forceinline__ float flog2(float x) { return __builtin_amdgcn_logf(x); }
__device__ __forceinline__ float frcp(float x) { return __builtin_amdgcn_rcpf(x); }
__device__ __forceinline__ float wave_sum(float v) {
#pragma unroll
    for (int o = 1; o < 64; o <<= 1) v += __shfl_xor(v, o);
    return v;
}
#define LDS_WAIT() asm volatile("s_waitcnt lgkmcnt(0)" ::: "memory")

namespace pg8 {
constexpr int BM = 256, BK = 64, HALF = 128, HTB = HALF * BK * 2, STAGE_BYTES = 8 * HTB, NXCD = 8, WGM = 8;
__host__ __device__ __forceinline__ int lds_byte(int r, int c) { const int st = (r >> 4) * 2 + (c >> 5), rr = r & 15, cc = c & 31, ob = rr * 64 + cc * 2; return st * 1024 + (ob ^ (((ob >> 9) & 1) << 5)); }
__host__ __device__ __forceinline__ void stage_rc(int b, int& R, int& C) { const int st = b / 1024, sb = b % 1024, swz = sb ^ (((sb >> 9) & 1) << 5); R = (st >> 1) * 16 + swz / 64; C = (st & 1) * 32 + (swz % 64) / 2; }
__host__ __device__ __forceinline__ int perm32(int rho) { const int n = rho >> 4, i = rho & 15; return 8 * (i >> 2) + 4 * n + (i & 3); }
struct Unit { int pm, pn; };
struct Gemm { const bf16_t* A; const bf16_t* Bt; int M, N, K, lda, ldb; };
struct StaticOrder {
    int nM, nN, nwg, G, c;
    __device__ void init(int M, int N, int G_, int c_) { nM = M / BM; nN = N / BM; nwg = nM * nN; G = G_; c = c_; }
    __device__ bool next(int i, Unit& u) const {
        const long L = (long)i * G + c; if (L >= nwg) return false;
        int wgid = (int)L; { const int q = nwg / NXCD, r = nwg % NXCD, xcd = wgid % NXCD, off = wgid / NXCD; wgid = (xcd < r ? xcd * (q + 1) : r * (q + 1) + (xcd - r) * q) + off; }
        const int nig = WGM * nN, gid = wgid / nig, fm = gid * WGM, gsz = (nM - fm) < WGM ? (nM - fm) : WGM;
        u.pm = fm + ((wgid % nig) % gsz); u.pn = (wgid % nig) / gsz; return true;
    }
};
template <class Epi>
__device__ __forceinline__ void gemm_phase(LAS unsigned char* lds, const Gemm g, const StaticOrder& S, const Epi& E) {
    const int tid = threadIdx.x, wid = __builtin_amdgcn_readfirstlane(tid >> 6), lane = tid & 63, wr = wid >> 2, wc = wid & 3, fr = lane & 15, fq = lane >> 4;
    const int K = g.K, nt = K / BK;
    unsigned voffA[2], voffB[2];
#pragma unroll
    for (int i = 0; i < 2; ++i) { int R, C; stage_rc(tid * 16 + i * 8192, R, C); const int Rb = (R & ~31) + perm32(R & 31);
        voffA[i] = (unsigned)(R * g.lda + C) * 2u; voffB[i] = (unsigned)(Rb * g.ldb + C) * 2u; }
    const size_t kstep = (size_t)(BK * 2);
    const size_t hstepA = (size_t)HALF * g.lda * 2, hstepB = (size_t)HALF * g.ldb * 2;
    const size_t tstepA = 2 * hstepA, tstepB = 2 * hstepB;
    const unsigned ldsw = (unsigned)wid * 1024u;
    const int aoff = lds_byte(wr * 64 + fr, fq * 8), boff = lds_byte(wc * 32 + fr, fq * 8);
#define PG8_SA(b, h) (((b) * 2 + (h)) * HTB)
#define PG8_SB(b, h) ((4 + (b) * 2 + (h)) * HTB)
#define PG8_STAGE(bufoff, gbase, voff) do { _Pragma("unroll") for (int _i = 0; _i < 2; ++_i) \
        __builtin_amdgcn_global_load_lds((const unsigned*)((const char*)(gbase) + (voff)[_i]), (LAS unsigned*)(lds + (bufoff) + ldsw + _i * 8192), 16, 0, 0); } while (0)
#define PG8_LDA(dst, b, h) do { _Pragma("unroll") for (int m = 0; m < 4; ++m) _Pragma("unroll") for (int k = 0; k < 2; ++k) dst[m][k] = *(const LAS bf16x8*)(lds + PG8_SA(b, h) + aoff + m * 2048 + k * 1024); } while (0)
#define PG8_LDB(dst, b, h) do { _Pragma("unroll") for (int n = 0; n < 2; ++n) _Pragma("unroll") for (int k = 0; k < 2; ++k) dst[n][k] = *(const LAS bf16x8*)(lds + PG8_SB(b, h) + boff + n * 2048 + k * 1024); } while (0)
#define PG8_MMA(ai, bj, At, Bt) do { __builtin_amdgcn_s_setprio(1); _Pragma("unroll") for (int m = 0; m < 4; ++m) _Pragma("unroll") for (int n = 0; n < 2; ++n) _Pragma("unroll") for (int k = 0; k < 2; ++k) \
        acc[ai][bj][m][n] = __builtin_amdgcn_mfma_f32_16x16x32_bf16(Bt[n][k], At[m][k], acc[ai][bj][m][n], 0, 0, 0); __builtin_amdgcn_s_setprio(0); } while (0)
#define PG8_WAIT_V(n) asm volatile("s_waitcnt vmcnt(" #n ")" ::: "memory")
#define PG8_WAIT_L(n) asm volatile("s_waitcnt lgkmcnt(" #n ")" ::: "memory")
#define PG8_BAR __builtin_amdgcn_s_barrier()
#define PG8_SCHED __builtin_amdgcn_sched_barrier(0)
    Unit cur, nxt; int ui = 0;
    if (!S.next(0, cur)) return;
    f32x4 acc[2][2][4][2];
#pragma unroll
    for (int a = 0; a < 2; ++a)
#pragma unroll
        for (int b = 0; b < 2; ++b)
#pragma unroll
            for (int m = 0; m < 4; ++m)
#pragma unroll
                for (int n = 0; n < 2; ++n) acc[a][b][m][n] = (f32x4){0.f, 0.f, 0.f, 0.f};
    bf16x8 At[4][2], B0[2][2], B1[2][2];
    const char* cA = (const char*)g.A + (size_t)cur.pm * tstepA; const char* cB = (const char*)g.Bt + (size_t)cur.pn * tstepB;
    PG8_STAGE(PG8_SB(0, 0), cB, voffB); PG8_STAGE(PG8_SA(0, 0), cA, voffA); PG8_STAGE(PG8_SB(0, 1), cB + hstepB, voffB); PG8_STAGE(PG8_SA(0, 1), cA + hstepA, voffA);
    if (wr == 1) PG8_BAR;
    PG8_WAIT_V(4); PG8_BAR;
    PG8_STAGE(PG8_SB(1, 0), cB + kstep, voffB); PG8_STAGE(PG8_SA(1, 0), cA + kstep, voffA); PG8_STAGE(PG8_SB(1, 1), cB + hstepB + kstep, voffB);
    PG8_WAIT_V(6); PG8_BAR;
    for (;;) {
        const bool has_next = S.next(ui + 1, nxt);
        const char* nA = has_next ? (const char*)g.A + (size_t)nxt.pm * tstepA : cA; const char* nB = has_next ? (const char*)g.Bt + (size_t)nxt.pn * tstepB : cB;
        for (int t = 0; t < nt; t += 2) {
            const bool last = (t == nt - 2);
            const char* a1 = cA + (size_t)(t + 1) * kstep;
            const char* a2 = last ? nA : cA + (size_t)(t + 2) * kstep; const char* b2 = last ? nB : cB + (size_t)(t + 2) * kstep;
            const char* a3 = a2 + kstep; const char* b3 = b2 + kstep;
            PG8_LDB(B0, 0, 0); PG8_SCHED; PG8_LDA(At, 0, 0); PG8_STAGE(PG8_SA(1, 1), a1 + hstepA, voffA);
            PG8_WAIT_L(8); PG8_BAR; PG8_WAIT_L(0); PG8_MMA(0, 0, At, B0); PG8_BAR; PG8_SCHED;
            PG8_LDB(B1, 0, 1); PG8_STAGE(PG8_SB(0, 0), b2, voffB);
            PG8_BAR; PG8_WAIT_L(0); PG8_MMA(0, 1, At, B1); PG8_BAR;
            PG8_LDA(At, 0, 1); PG8_STAGE(PG8_SA(0, 0), a2, voffA);
            PG8_BAR; PG8_WAIT_L(0); PG8_MMA(1, 0, At, B0); PG8_BAR; PG8_SCHED;
            PG8_STAGE(PG8_SB(0, 1), b2 + hstepB, voffB);
            PG8_WAIT_V(6); PG8_BAR; PG8_MMA(1, 1, At, B1); PG8_BAR;
            PG8_LDB(B0, 1, 0); PG8_SCHED; PG8_LDA(At, 1, 0); PG8_STAGE(PG8_SA(0, 1), a2 + hstepA, voffA);
            PG8_WAIT_L(8); PG8_BAR; PG8_WAIT_L(0); PG8_MMA(0, 0, At, B0); PG8_BAR; PG8_SCHED;
            PG8_LDB(B1, 1, 1); PG8_STAGE(PG8_SB(1, 0), b3, voffB);
            PG8_BAR; PG8_WAIT_L(0); PG8_MMA(0, 1, At, B1); PG8_BAR;
            PG8_LDA(At, 1, 1); PG8_STAGE(PG8_SA(1, 0), a3, voffA);
            PG8_BAR; PG8_WAIT_L(0); PG8_MMA(1, 0, At, B0); PG8_BAR; PG8_SCHED;
            PG8_STAGE(PG8_SB(1, 1), b3 + hstepB, voffB);
            PG8_WAIT_V(6); PG8_BAR; PG8_MMA(1, 1, At, B1); PG8_BAR;
        }
        E(acc, cur, wr, wc, fr, fq);
        if (!has_next) break;
#pragma unroll
        for (int a = 0; a < 2; ++a)
#pragma unroll
            for (int b = 0; b < 2; ++b)
#pragma unroll
                for (int m = 0; m < 4; ++m)
#pragma unroll
                    for (int n = 0; n < 2; ++n) acc[a][b][m][n] = (f32x4){0.f, 0.f, 0.f, 0.f};
        cur = nxt; cA = nA; cB = nB; ++ui;
    }
    PG8_WAIT_V(0);
    if (wr == 0) PG8_BAR;
    PG8_BAR;
#undef PG8_SA
#undef PG8_SB
#undef PG8_STAGE
#undef PG8_LDA
#undef PG8_LDB
#undef PG8_MMA
#undef PG8_WAIT_V
#undef PG8_WAIT_L
#undef PG8_BAR
#undef PG8_SCHED
}

struct EpiProj {
    bf16_t* qkv; bf16_t* sg; float qscale;
    __device__ __forceinline__ void operator()(const f32x4 (&acc)[2][2][4][2], const Unit& u, int wr, int wc, int fr, int fq) const {
        const int row0 = u.pm * BM + wr * 64 + fr;
        if (u.pn < 24) {
            const int t = u.pn >> 2; bf16_t* base = qkv + (size_t)t * ((size_t)T_TOK * 1024) + (u.pn & 3) * 256 + wc * 32 + 8 * fq;
            const float sc = (t == 0 || t == 3) ? qscale : 1.f;
#pragma unroll
            for (int ai = 0; ai < 2; ++ai)
#pragma unroll
                for (int m = 0; m < 4; ++m) { bf16_t* rowp = base + (size_t)(row0 + ai * HALF + m * 16) * 1024;
#pragma unroll
                    for (int bj = 0; bj < 2; ++bj) { const f32x4 v0 = acc[ai][bj][m][0] * sc, v1 = acc[ai][bj][m][1] * sc;
                        u32x4 w; w.x = pk2(v0[0], v0[1]); w.y = pk2(v0[2], v0[3]); w.z = pk2(v1[0], v1[1]); w.w = pk2(v1[2], v1[3]);
                        *(u32x4*)(rowp + bj * HALF) = w; } }
        } else {
            bf16_t* base = sg + (u.pn - 24) * 256 + wc * 32 + 8 * fq;
#pragma unroll
            for (int ai = 0; ai < 2; ++ai)
#pragma unroll
                for (int m = 0; m < 4; ++m) { bf16_t* rowp = base + (size_t)(row0 + ai * HALF + m * 16) * 4096;
#pragma unroll
                    for (int bj = 0; bj < 2; ++bj) { float s[8];
#pragma unroll
                        for (int e = 0; e < 4; ++e) { s[e] = frcp(1.f + fexp2(-LOG2E * acc[ai][bj][m][0][e])); s[4 + e] = frcp(1.f + fexp2(-LOG2E * acc[ai][bj][m][1][e])); }
                        u32x4 w; w.x = pk2(s[0], s[1]); w.y = pk2(s[2], s[3]); w.z = pk2(s[4], s[5]); w.w = pk2(s[6], s[7]);
                        *(u32x4*)(rowp + bj * HALF) = w; } }
        }
    }
};
template <int SECOND> struct EpiGate {
    const bf16_t* sg;
    float* tmp; bf16_t* merged;
    __device__ __forceinline__ void operator()(const f32x4 (&acc)[2][2][4][2], const Unit& u, int wr, int wc, int fr, int fq) const {
        const int row0 = u.pm * BM + wr * 64 + fr, col0 = u.pn * BM + wc * 32 + 8 * fq;
#pragma unroll
        for (int ai = 0; ai < 2; ++ai)
#pragma unroll
            for (int m = 0; m < 4; ++m) { const size_t row = (size_t)(row0 + ai * HALF + m * 16);
#pragma unroll
                for (int bj = 0; bj < 2; ++bj) { const int col = col0 + bj * HALF;
                    const u32x4 gv = *(const u32x4*)(sg + row * 4096 + col);
                    const f32x4 g0 = {bf_lo(gv.x), bf_hi(gv.x), bf_lo(gv.y), bf_hi(gv.y)}, g1 = {bf_lo(gv.z), bf_hi(gv.z), bf_lo(gv.w), bf_hi(gv.w)};
                    f32x4 v0 = acc[ai][bj][m][0] * g0, v1 = acc[ai][bj][m][1] * g1;
                    float* tp = tmp + row * DM + col;
                    if (SECOND == 0) { *(f32x4*)tp = v0; *(f32x4*)(tp + 4) = v1; }
                    else { v0 += *(const f32x4*)tp; v1 += *(const f32x4*)(tp + 4);
                        u32x4 w; w.x = pk2(v0[0], v0[1]); w.y = pk2(v0[2], v0[3]); w.z = pk2(v1[0], v1[1]); w.w = pk2(v1[2], v1[3]);
                        *(u32x4*)(merged + row * DM + col) = w; } } }
    }
};
struct EpiResid {
    const float* x; float* x1; bf16_t* x1b; float* rowss;
    __device__ __forceinline__ void operator()(const f32x4 (&acc)[2][2][4][2], const Unit& u, int wr, int wc, int fr, int fq) const {
        const int row0 = u.pm * BM + wr * 64 + fr, col0 = u.pn * BM + wc * 32 + 8 * fq;
#pragma unroll
        for (int ai = 0; ai < 2; ++ai)
#pragma unroll
            for (int m = 0; m < 4; ++m) { const size_t row = (size_t)(row0 + ai * HALF + m * 16); float ss = 0.f;
#pragma unroll
                for (int bj = 0; bj < 2; ++bj) { const size_t o = row * DM + col0 + bj * HALF;
                    const f32x4 v0 = (DBG == 2 ? 0.f : 1.f) * acc[ai][bj][m][0] + *(const f32x4*)(x + o), v1 = (DBG == 2 ? 0.f : 1.f) * acc[ai][bj][m][1] + *(const f32x4*)(x + o + 4);
                    *(f32x4*)(x1 + o) = v0; *(f32x4*)(x1 + o + 4) = v1;
                    u32x4 w; w.x = pk2(v0[0], v0[1]); w.y = pk2(v0[2], v0[3]); w.z = pk2(v1[0], v1[1]); w.w = pk2(v1[2], v1[3]);
                    *(u32x4*)(x1b + o) = w;
                    ss += (v0[0] * v0[0] + v0[1] * v0[1]) + (v0[2] * v0[2] + v0[3] * v0[3]) + (v1[0] * v1[0] + v1[1] * v1[1]) + (v1[2] * v1[2] + v1[3] * v1[3]); }
                ss += __shfl_xor(ss, 16); ss += __shfl_xor(ss, 32);
                if (fq == 0) atomicAdd(rowss + row, ss); }
    }
};
struct EpiPlainBf16 {
    bf16_t* o;
    __device__ __forceinline__ void operator()(const f32x4 (&acc)[2][2][4][2], const Unit& u, int wr, int wc, int fr, int fq) const {
        const int row0 = u.pm * BM + wr * 64 + fr, col0 = u.pn * BM + wc * 32 + 8 * fq;
#pragma unroll
        for (int ai = 0; ai < 2; ++ai)
#pragma unroll
            for (int m = 0; m < 4; ++m) { const size_t row = (size_t)(row0 + ai * HALF + m * 16);
#pragma unroll
                for (int bj = 0; bj < 2; ++bj) { const f32x4 v0 = acc[ai][bj][m][0], v1 = acc[ai][bj][m][1];
                    u32x4 w; w.x = pk2(v0[0], v0[1]); w.y = pk2(v0[2], v0[3]); w.z = pk2(v1[0], v1[1]); w.w = pk2(v1[2], v1[3]);
                    *(u32x4*)(o + row * DM + col0 + bj * HALF) = w; } }
    }
};
}

__device__ __forceinline__ void transpose_item(const float* W, int ldw, int src_n0, bf16_t* WT, int K, int dst_n0, int k0, LAS float* scr, int lane, const float* kscale) {
#pragma unroll 8
    for (int i = 0; i < 32; ++i) { const int kk = 2 * i + (lane >> 5); float v = W[(size_t)(k0 + kk) * ldw + src_n0 + (lane & 31)]; if (kscale) v *= kscale[k0 + kk]; scr[kk * 33 + (lane & 31)] = v; }
    LDS_WAIT();
    const int c = lane & 7;
#pragma unroll
    for (int j = 0; j < 4; ++j) { const int n = (lane >> 3) + 8 * j; const LAS float* s = scr + (8 * c) * 33 + n;
        u32x4 o; o.x = pk2(s[0 * 33], s[1 * 33]); o.y = pk2(s[2 * 33], s[3 * 33]); o.z = pk2(s[4 * 33], s[5 * 33]); o.w = pk2(s[6 * 33], s[7 * 33]);
        *(u32x4*)(WT + (size_t)(dst_n0 + n) * K + k0 + 8 * c) = o; }
    LDS_WAIT();
}

__device__ __forceinline__ void p0_prologue(const Params& P, LAS unsigned char* lds, int vcu, int G) {
    const int tid = threadIdx.x, lane = tid & 63, wave = __builtin_amdgcn_readfirstlane(tid >> 6);
    const int gw = vcu * NWAVES + wave, NGW = G * NWAVES;
    unsigned char* ws = P.ws;
    {
        LAS float* scr = (LAS float*)(lds + wave * 16384);
        constexpr int I_IN = 32 * 320, I_A = 16 * 64, I_O = 32 * 64;
        constexpr int NITEMS = I_IN + 2 * I_A + 2 * I_O;
        for (int it = gw; it < NITEMS; it += NGW) {
            int r = it;
            if (r < I_IN) { const int kb = r / 320, nb = r % 320, dn = nb * 32; transpose_item(P.w_in, 10248, dn < 6144 ? dn : dn + 8, (bf16_t*)(ws + WS_WIN), 2048, dn, kb * 64, scr, lane, nullptr); continue; } r -= I_IN;
            if (r < I_A) { const int kb = r / 64, nb = r % 64; transpose_item(P.w_a, 2048, nb * 32, (bf16_t*)(ws + WS_WAT), 1024, nb * 32, kb * 64, scr, lane, nullptr); continue; } r -= I_A;
            if (r < I_A) { const int kb = r / 64, nb = r % 64; transpose_item(P.w_b, 2048, nb * 32, (bf16_t*)(ws + WS_WBT), 1024, nb * 32, kb * 64, scr, lane, nullptr); continue; } r -= I_A;
            if (r < I_O) { const int kb = r / 64, nb = r % 64; transpose_item(P.w_out, 2048, nb * 32, (bf16_t*)(ws + WS_WOUT), 2048, nb * 32, kb * 64, scr, lane, nullptr); continue; } r -= I_O;
            { const int kb = r / 64, nb = r % 64; transpose_item(P.w_query, 2048, nb * 32, (bf16_t*)(ws + WS_WQ), 2048, nb * 32, kb * 64, scr, lane, P.g_ffn); }
        }
    }
    __syncthreads();
    {
        LAS float* wf = (LAS float*)lds;
        for (int idx = tid; idx < 2048 * 8; idx += NTHR) { const int k = idx >> 3, c = idx & 7; wf[c * 2048 + k] = P.w_in[(size_t)k * 10248 + 6144 + c]; }
        __syncthreads();
        bf16_t* H = (bf16_t*)(ws + WS_H); float* LOGF = (float*)(ws + WS_LOGF);
        for (int r = gw; r < T_TOK; r += NGW) {
            const f32x4* xr = (const f32x4*)(P.x + (size_t)r * DM) + lane;
            float ss = 0.f;
#pragma unroll
            for (int j = 0; j < 8; ++j) { const f32x4 v = xr[64 * j]; ss += (v[0] * v[0] + v[1] * v[1]) + (v[2] * v[2] + v[3] * v[3]); }
            const float rstd = 1.0f / sqrtf(wave_sum(ss) * (1.f / DM) + EPS);
            float fl[8];
#pragma unroll
            for (int c = 0; c < 8; ++c) fl[c] = 0.f;
            u32x2* hp = (u32x2*)(H + (size_t)r * DM) + lane;
#pragma unroll 1
            for (int j = 0; j < 8; ++j) { const f32x4 gn = *((const f32x4*)P.g_mix + lane + 64 * j); const f32x4 hv = xr[64 * j] * rstd * gn;
                u32x2 o; o.x = pk2(hv[0], hv[1]); o.y = pk2(hv[2], hv[3]); hp[64 * j] = o;
#pragma unroll
                for (int c = 0; c < 8; ++c) { const f32x4 wv = *((const LAS f32x4*)(wf + c * 2048) + lane + 64 * j); fl[c] += (hv[0] * wv[0] + hv[1] * wv[1]) + (hv[2] * wv[2] + hv[3] * wv[3]); } }
#pragma unroll
            for (int c = 0; c < 8; ++c) fl[c] = wave_sum(fl[c]);
            if (lane == 0) {
#pragma unroll
                for (int c = 0; c < 8; ++c) { const float y = fl[c] + P.b_forget[c]; LOGF[(size_t)r * 8 + c] = fminf(y, 0.f) - log1pf(expf(-fabsf(y))); }
            }
        }
    }
    {
        const size_t gid = (size_t)vcu * NTHR + tid, gstride = (size_t)G * NTHR;
        constexpr size_t NCH = (size_t)16384 * 2048 / 8;
        for (size_t i = gid; i < 2 * NCH; i += gstride) { const bool second = i >= NCH; const size_t off = (second ? i - NCH : i) * 8;
            const float* src = (second ? P.e_v : P.e_u) + off; bf16_t* dst = (bf16_t*)(ws + (second ? WS_EV : WS_EU)) + off;
            const f32x4 a = __builtin_nontemporal_load((const f32x4*)src), b = __builtin_nontemporal_load((const f32x4*)src + 1);
            u32x4 o; o.x = pk2(a[0], a[1]); o.y = pk2(a[2], a[3]); o.z = pk2(b[0], b[1]); o.w = pk2(b[2], b[3]); *(u32x4*)dst = o; }
        for (size_t i = gid; i < 262144 / 8; i += gstride) { const float* src = P.sub_keys + i * 8; const f32x4 a = *(const f32x4*)src, b = *((const f32x4*)src + 1);
            u32x4 o; o.x = pk2(a[0], a[1]); o.y = pk2(a[2], a[3]); o.z = pk2(b[0], b[1]); o.w = pk2(b[2], b[3]); *(u32x4*)((bf16_t*)(ws + WS_SKB) + i * 8) = o; }
    }
}

namespace att {
constexpr int KST = 272, VST = 320;
constexpr int KBUF = 64 * KST, VBUF = 64 * VST;
constexpr int OFF_K = 0, OFF_V = 2 * KBUF, OFF_F = OFF_V + 2 * VBUF, OFF_SC = OFF_F + 4096 * 4;
static_assert(OFF_SC + 64 <= 131072, "attention LDS");

__device__ __forceinline__ void build_cumf(LAS unsigned char* lds, const float* LOGF, int b, int h, int n, int tid, int lane, int wid) {
    LAS float* F2 = (LAS float*)(lds + OFF_F); LAS float* sc = (LAS float*)(lds + OFF_SC);
    const int s0 = tid * 8; float v[8];
#pragma unroll
    for (int i = 0; i < 8; ++i) v[i] = (s0 < n) ? LOGF[((size_t)b * SEQ + s0 + i) * 8 + h] * LOG2E : 0.f;
#pragma unroll
    for (int i = 1; i < 8; ++i) v[i] += v[i - 1];
    float tot = v[7], inc = tot;
#pragma unroll
    for (int o = 1; o < 64; o <<= 1) { const float t = __shfl_up(inc, o); if (lane >= o) inc += t; }
    if (lane == 63) sc[wid] = inc;
    __syncthreads();
    float base = inc - tot;
#pragma unroll
    for (int w = 0; w < 8; ++w) if (w < wid) base += sc[w];
    if (s0 < n) {
#pragma unroll
        for (int i = 0; i < 8; ++i) F2[s0 + i] = v[i] + base;
    }
    __syncthreads();
}

template <int MIXER>
__device__ __forceinline__ void attn_unit(LAS unsigned char* lds, const bf16_t* Q, const bf16_t* Kg, const bf16_t* Vg, bf16_t* O, int b, int h, int qb, int tid, int lane, int wid) {
    const int c = lane & 31, hh = lane >> 5;
    const int t0 = qb * 256 + wid * 32, tq = t0 + c;
    const size_t rowbase = (size_t)b * SEQ;
    size_t qoff = (rowbase + tq) * 1024 + h * HD + 8 * hh;
    f32x16 oacc[4];
#pragma unroll
    for (int d = 0; d < 4; ++d)
#pragma unroll
        for (int r = 0; r < 16; ++r) oacc[d][r] = 0.f;
    float carry = 0.f, mrun = -1e30f, lsum = 0.f; const float nhf = hh ? 0.f : 1.f;
    const LAS float* F2 = (const LAS float*)(lds + OFF_F);
    const float Ft = (MIXER == 1) ? F2[tq] : 0.f;
    const int ktmax = 4 * qb + 3;
    const int srow = tid >> 4, scc = tid & 15;
    u32x4 kr[2], vr[2];
#define ATT_LOAD(kt) do { _Pragma("unroll") for (int j = 0; j < 2; ++j) { const size_t g_ = (rowbase + 64 * (kt) + srow + 32 * j) * 1024 + h * HD + scc * 8; \
        kr[j] = *(const u32x4*)(Kg + g_); vr[j] = *(const u32x4*)(Vg + g_); } } while (0)
#define ATT_WRITE(buf) do { _Pragma("unroll") for (int j = 0; j < 2; ++j) { \
        *(LAS u32x4*)(lds + OFF_K + (buf) * KBUF + (srow + 32 * j) * KST + scc * 16) = kr[j]; \
        *(LAS u32x4*)(lds + OFF_V + (buf) * VBUF + (srow + 32 * j) * VST + scc * 16) = vr[j]; } } while (0)
    ATT_LOAD(ktmax); ATT_WRITE(0); __syncthreads();
    int buf = 0;
    for (int kt = ktmax; kt >= 0; --kt) {
        if (kt > 0) ATT_LOAD(kt - 1);
        if (64 * kt <= t0 + 31) {
            const LAS unsigned char* Kl = lds + OFF_K + buf * KBUF; const LAS unsigned char* Vl = lds + OFF_V + buf * VBUF;
            f32x16 sacc[2];
            asm volatile("" : "+v"(qoff));
            bf16x8 qf[8];
#pragma unroll
            for (int s = 0; s < 8; ++s) qf[s] = *(const bf16x8*)(Q + qoff + 16 * s);
#pragma unroll
            for (int sub = 0; sub < 2; ++sub) {
#pragma unroll
                for (int r = 0; r < 16; ++r) sacc[sub][r] = 0.f;
#pragma unroll
                for (int s = 0; s < 8; ++s) { const bf16x8 kf = *(const LAS bf16x8*)(Kl + (32 * sub + c) * KST + (16 * s + 8 * hh) * 2);
                    sacc[sub] = __builtin_amdgcn_mfma_f32_32x32x16_bf16(kf, qf[s], sacc[sub], 0, 0, 0); }
            }
            const bool need_mask = (64 * kt + 63 >= t0);
            if (MIXER == 0) {
#pragma unroll
                for (int sub = 1; sub >= 0; --sub) {
                    float lb[16];
#pragma unroll
                    for (int r = 0; r < 16; ++r) { const float z = sacc[sub][r]; float l = -flog2(1.f + fexp2(z));
                        if (need_mask) { const int sidx = 64 * kt + 32 * sub + (r & 3) + 8 * (r >> 2) + 4 * hh; l = (sidx < tq) ? l : 0.f; }
                        lb[r] = l; }
                    float Glo[4], Ghi[4];
#pragma unroll
                    for (int g = 0; g < 4; ++g) { lb[4 * g + 2] += lb[4 * g + 3]; lb[4 * g + 1] += lb[4 * g + 2]; lb[4 * g] += lb[4 * g + 1];
                        const unsigned gu = __builtin_bit_cast(unsigned, lb[4 * g]); const auto rr = __builtin_amdgcn_permlane32_swap(gu, gu, false, false);
                        Glo[g] = __builtin_bit_cast(float, (unsigned)rr[0]); Ghi[g] = __builtin_bit_cast(float, (unsigned)rr[1]); }
                    float E[8];
                    E[7] = carry; E[6] = E[7] + Ghi[3]; E[5] = E[6] + Glo[3]; E[4] = E[5] + Ghi[2]; E[3] = E[4] + Glo[2]; E[2] = E[3] + Ghi[1]; E[1] = E[2] + Glo[1]; E[0] = E[1] + Ghi[0];
                    carry = E[0] + Glo[0];
#pragma unroll
                    for (int g = 0; g < 4; ++g) { const float Eo = __builtin_fmaf(nhf, Ghi[g], E[2 * g + 1]);
#pragma unroll
                        for (int i = 0; i < 4; ++i) { const int r = 4 * g + i; float w = fexp2(sacc[sub][r] + lb[r] + Eo);
                            if (need_mask) { const int sidx = 64 * kt + 32 * sub + (r & 3) + 8 * (r >> 2) + 4 * hh; w = (sidx < tq) ? w : 0.f; }
                            sacc[sub][r] = w; } }
                }
            } else {
                float mx = -1e30f;
#pragma unroll
                for (int sub = 0; sub < 2; ++sub)
#pragma unroll
                    for (int g = 0; g < 4; ++g) { const f32x4 fs = *(const LAS f32x4*)(F2 + 64 * kt + 32 * sub + 8 * g + 4 * hh);
#pragma unroll
                        for (int i = 0; i < 4; ++i) { const int r = 4 * g + i; float xv = sacc[sub][r] + (Ft - fs[i]);
                            if (need_mask) { const int sidx = 64 * kt + 32 * sub + 8 * g + 4 * hh + i; xv = (sidx <= tq) ? xv : -1e30f; }
                            sacc[sub][r] = xv; mx = fmaxf(mx, xv); } }
                { const unsigned mu = __builtin_bit_cast(unsigned, mx); const auto rr = __builtin_amdgcn_permlane32_swap(mu, mu, false, false);
                  mx = fmaxf(__builtin_bit_cast(float, (unsigned)rr[0]), __builtin_bit_cast(float, (unsigned)rr[1])); }
                const float mnew = fmaxf(mrun, mx);
                const float alpha = fexp2(mrun - mnew);
                float ps = 0.f;
#pragma unroll
                for (int sub = 0; sub < 2; ++sub)
#pragma unroll
                    for (int r = 0; r < 16; ++r) { const float p = fexp2(sacc[sub][r] - mnew); sacc[sub][r] = p; ps += p; }
                lsum = lsum * alpha + ps;
                if (__any(mnew > mrun)) {
#pragma unroll
                    for (int d = 0; d < 4; ++d)
#pragma unroll
                        for (int r = 0; r < 16; ++r) oacc[d][r] *= alpha;
                }
                mrun = mnew;
            }
#pragma unroll
            for (int ks = 0; ks < 4; ++ks) { const int sub = ks >> 1, rb = 8 * (ks & 1);
                u32x4 pw; pw.x = pk2(sacc[sub][rb + 0], sacc[sub][rb + 1]); pw.y = pk2(sacc[sub][rb + 2], sacc[sub][rb + 3]); pw.z = pk2(sacc[sub][rb + 4], sacc[sub][rb + 5]); pw.w = pk2(sacc[sub][rb + 6], sacc[sub][rb + 7]);
                const bf16x8 pf = __builtin_bit_cast(bf16x8, pw);
                const LAS unsigned char* vb = Vl + (16 * ks + 4 * hh + ((lane & 15) >> 2)) * VST + (16 * ((lane >> 4) & 1) + 4 * (lane & 3)) * 2;
#pragma unroll
                for (int d = 0; d < 4; ++d) {
                    const s16x4 a0 = __builtin_amdgcn_ds_read_tr16_b64_v4i16((LAS s16x4*)(vb + d * 64));
                    const s16x4 a1 = __builtin_amdgcn_ds_read_tr16_b64_v4i16((LAS s16x4*)(vb + d * 64 + 8 * VST));
                    const bf16x8 af = {a0[0], a0[1], a0[2], a0[3], a1[0], a1[1], a1[2], a1[3]};
                    oacc[d] = __builtin_amdgcn_mfma_f32_32x32x16_bf16(af, pf, oacc[d], 0, 0, 0); }
            }
        }
        if (kt > 0) ATT_WRITE(buf ^ 1);
        __syncthreads();
        buf ^= 1;
    }
#undef ATT_LOAD
#undef ATT_WRITE
    float inv = 1.f;
    if (MIXER == 1) { const unsigned lu = __builtin_bit_cast(unsigned, lsum); const auto rr = __builtin_amdgcn_permlane32_swap(lu, lu, false, false);
        inv = 1.f / (__builtin_bit_cast(float, (unsigned)rr[0]) + __builtin_bit_cast(float, (unsigned)rr[1])); }
    bf16_t* op = O + (rowbase + tq) * 2048 + 4 * hh;
#pragma unroll
    for (int d = 0; d < 4; ++d)
#pragma unroll
        for (int g = 0; g < 4; ++g) { u32x2 w; w.x = pk2(oacc[d][4 * g] * inv, oacc[d][4 * g + 1] * inv); w.y = pk2(oacc[d][4 * g + 2] * inv, oacc[d][4 * g + 3] * inv);
            *(u32x2*)(op + 32 * d + 8 * g) = w; }
}

__device__ __forceinline__ void attn_phase(const Params& P, LAS unsigned char* lds, int vcu, int G) {
    const int tid = threadIdx.x, lane = tid & 63, wid = __builtin_amdgcn_readfirstlane(tid >> 6);
    unsigned char* ws = P.ws;
    const bf16_t* QKV = (const bf16_t*)(ws + WS_QKV); const size_t TS = (size_t)T_TOK * 1024;
    bf16_t* OAB = (bf16_t*)(ws + WS_H); const float* LOGF = (const float*)(ws + WS_LOGF);
    for (int item = vcu; item < 256; item += G) {
        const int mixer = item >> 7, rem = item & 127, bh = rem >> 3, pair = rem & 7, b = bh >> 3, h = bh & 7;
        if (mixer == 0) {
            attn_unit<0>(lds, QKV, QKV + TS, QKV + 2 * TS, OAB + h * HD, b, h, 15 - pair, tid, lane, wid);
            attn_unit<0>(lds, QKV, QKV + TS, QKV + 2 * TS, OAB + h * HD, b, h, pair, tid, lane, wid);
        } else {
            build_cumf(lds, LOGF, b, h, 256 * (16 - pair), tid, lane, wid);
            attn_unit<1>(lds, QKV + 3 * TS, QKV + 4 * TS, QKV + 5 * TS, OAB + 1024 + h * HD, b, h, 15 - pair, tid, lane, wid);
            attn_unit<1>(lds, QKV + 3 * TS, QKV + 4 * TS, QKV + 5 * TS, OAB + 1024 + h * HD, b, h, pair, tid, lane, wid);
        }
        __syncthreads();
    }
}
}

namespace peer {
__device__ __forceinline__ unsigned sortable(float f) { const unsigned u = __builtin_bit_cast(unsigned, f); return (u & 0x80000000u) ? ~u : (u | 0x80000000u); }
__device__ __forceinline__ float unsortable(unsigned k) { const unsigned u = (k & 0x80000000u) ? (k & 0x7fffffffu) : ~k; return __builtin_bit_cast(float, u); }
template <int N> __device__ __forceinline__ unsigned umax_all(const unsigned (&k)[N]) {
    unsigned m = k[0];
#pragma unroll
    for (int q = 1; q < N; ++q) m = m > k[q] ? m : k[q];
    return m;
}

__device__ __forceinline__ void topk_phase(const Params& P, LAS unsigned char* lds, int vcu, int G) {
    const int tid = threadIdx.x, lane = tid & 63, wave = __builtin_amdgcn_readfirstlane(tid >> 6);
    const int c = lane & 31, hh = lane >> 5;
    const int gw = vcu * NWAVES + wave, NGW = G * NWAVES;
    unsigned char* ws = P.ws;
    const bf16_t* Q2 = (const bf16_t*)(ws + WS_Q2); const bf16_t* SKB = (const bf16_t*)(ws + WS_SKB);
    const float* ROWSS = (const float*)(ws + WS_CTL); int* IDS = (int*)(ws + WS_IDS); float* GATES = (float*)(ws + WS_GATES);
    LAS unsigned char* scr = lds + wave * 4096;
    for (int task = gw; task < 2048; task += NGW) {
        const int tg = task >> 3, hd = task & 7, tok = tg * 32 + c;
#pragma unroll 1
        for (int p = 0; p < 2; ++p) {
            bf16x8 qf[8];
            { const bf16_t* qp = Q2 + (size_t)tok * DM + hd * 256 + p * 128 + 8 * hh;
#pragma unroll
              for (int s = 0; s < 8; ++s) qf[s] = *(const bf16x8*)(qp + 16 * s); }
            unsigned keys[64];
#pragma unroll
            for (int sub = 0; sub < 4; ++sub) {
                f32x16 acc;
#pragma unroll
                for (int r = 0; r < 16; ++r) acc[r] = 0.f;
                const bf16_t* kp = SKB + ((size_t)(hd * 2 + p) * 128 + 32 * sub + c) * 128 + 8 * hh;
#pragma unroll
                for (int s = 0; s < 8; ++s) { const bf16x8 kf = *(const bf16x8*)(kp + 16 * s); acc = __builtin_amdgcn_mfma_f32_32x32x16_bf16(kf, qf[s], acc, 0, 0, 0); }
#pragma unroll
                for (int r = 0; r < 16; ++r) { const int nlo = 127 - (32 * sub + (r & 3) + 8 * (r >> 2)); keys[sub * 16 + r] = (sortable(acc[r]) & ~127u) | (unsigned)(nlo - 4 * hh); }
            }
            unsigned top[16];
#pragma unroll
            for (int i = 0; i < 16; ++i) {
                unsigned m = umax_all<64>(keys);
                const auto rr = __builtin_amdgcn_permlane32_swap(m, m, false, false);
                m = (unsigned)rr[0] > (unsigned)rr[1] ? (unsigned)rr[0] : (unsigned)rr[1];
                top[i] = m;
#pragma unroll
                for (int q = 0; q < 64; ++q) keys[q] = (keys[q] == m) ? 0u : keys[q];
            }
            if (hh == 0) {
#pragma unroll
                for (int w = 0; w < 4; ++w) *(LAS u32x4*)(scr + (c * 2 + p) * 64 + w * 16) = (u32x4){top[4 * w], top[4 * w + 1], top[4 * w + 2], top[4 * w + 3]};
            }
        }
        LDS_WAIT();
        float s1[16], s2[16];
#pragma unroll
        for (int w = 0; w < 4; ++w) { const u32x4 a = *(const LAS u32x4*)(scr + (c * 2) * 64 + w * 16), b2 = *(const LAS u32x4*)(scr + (c * 2 + 1) * 64 + w * 16);
#pragma unroll
            for (int e = 0; e < 4; ++e) { s1[4 * w + e] = unsortable((a[e] & ~127u) | 64u); s2[4 * w + e] = unsortable((b2[e] & ~127u) | 64u); } }
        unsigned ck[50];
        { int n = 0;
#pragma unroll
          for (int i = 0; i < 16; ++i)
#pragma unroll
              for (int j = 0; j < 16; ++j) if ((i + 1) * (j + 1) <= 16) { ck[n] = (sortable(s1[i] + s2[j]) & ~255u) | (unsigned)(255 - (i * 16 + j)); ++n; } }
        unsigned t2[16];
#pragma unroll
        for (int k = 0; k < 16; ++k) { const unsigned m = umax_all<50>(ck); t2[k] = m;
#pragma unroll
            for (int q = 0; q < 50; ++q) ck[q] = (ck[q] == m) ? 0u : ck[q]; }
        int ids[16]; float sc[16];
#pragma unroll
        for (int k = 0; k < 16; ++k) { const unsigned pos = 255u - (t2[k] & 255u);
            const unsigned k1 = *(const LAS unsigned*)(scr + (c * 2) * 64 + (pos >> 4) * 4), k2 = *(const LAS unsigned*)(scr + (c * 2 + 1) * 64 + (pos & 15u) * 4);
            ids[k] = (int)((127u - (k1 & 127u)) * 128u + (127u - (k2 & 127u))); sc[k] = unsortable((t2[k] & ~255u) | 128u); }
        LDS_WAIT();
        const float rs = 1.0f / sqrtf(ROWSS[tok] * (1.f / DM) + EPS);
        float ev[16], Z = 0.f;
#pragma unroll
        for (int k = 0; k < 16; ++k) { ev[k] = fexp2((sc[k] - sc[0]) * rs * LOG2E); Z += ev[k]; }
        const float iz = 1.f / Z;
        int* ip = IDS + (size_t)tok * 128 + hd * 16; float* gp = GATES + (size_t)tok * 128 + hd * 16;
        if (hh == 0) {
#pragma unroll
            for (int k = 0; k < 8; ++k) { ip[k] = ids[k]; gp[k] = ev[k] * iz; }
        } else {
#pragma unroll
            for (int k = 8; k < 16; ++k) { ip[k] = ids[k]; gp[k] = ev[k] * iz; }
        }
    }
}


__device__ __forceinline__ void topk_naive(const Params& P, LAS unsigned char* lds, int vcu, int G) {
    const int tid = threadIdx.x, lane = tid & 63, wave = __builtin_amdgcn_readfirstlane(tid >> 6);
    const int gw = vcu * NWAVES + wave, NGW = G * NWAVES;
    unsigned char* ws = P.ws;
    const bf16_t* Q2 = (const bf16_t*)(ws + WS_Q2);
    const float* ROWSS = (const float*)(ws + WS_CTL); int* IDS = (int*)(ws + WS_IDS); float* GATES = (float*)(ws + WS_GATES);
    LAS float* sv = (LAS float*)(lds + wave * 1024);
    LAS int* si = (LAS int*)(lds + wave * 1024 + 256);
    for (int task = gw; task < T_TOK * 8; task += NGW) {
        const int tok = task >> 3, hd = task & 7;
        for (int p = 0; p < 2; ++p) {
            float v0 = 0.f, v1 = 0.f;
            for (int cc = 0; cc < 128; ++cc) { const float q = bf_lo((unsigned)Q2[(size_t)tok * DM + hd * 256 + p * 128 + cc]);
                v0 += q * P.sub_keys[((size_t)(hd * 2 + p) * 128 + lane) * 128 + cc]; v1 += q * P.sub_keys[((size_t)(hd * 2 + p) * 128 + lane + 64) * 128 + cc]; }
            for (int i = 0; i < 16; ++i) {
                float bv = v0 >= v1 ? v0 : v1; int bi = v0 >= v1 ? lane : lane + 64;
                for (int o = 1; o < 64; o <<= 1) { const float ov = __shfl_xor(bv, o); const int oi = __shfl_xor(bi, o); if (ov > bv || (ov == bv && oi < bi)) { bv = ov; bi = oi; } }
                if (lane == 0) { sv[p * 16 + i] = bv; si[p * 16 + i] = bi; }
                if (bi == lane) v0 = -3e38f; if (bi == lane + 64) v1 = -3e38f;
            }
        }
        LDS_WAIT();
        float cv[4]; for (int q = 0; q < 4; ++q) { const int pos = lane * 4 + q; cv[q] = sv[pos >> 4] + sv[16 + (pos & 15)]; }
        float sel_v = 0.f; int sel_id = 0; float mx = 0.f;
        for (int k = 0; k < 16; ++k) {
            float bv = cv[0]; int bi = lane * 4;
            for (int q = 1; q < 4; ++q) if (cv[q] > bv) { bv = cv[q]; bi = lane * 4 + q; }
            for (int o = 1; o < 64; o <<= 1) { const float ov = __shfl_xor(bv, o); const int oi = __shfl_xor(bi, o); if (ov > bv || (ov == bv && oi < bi)) { bv = ov; bi = oi; } }
            if (k == 0) mx = bv;
            if (lane == k) { sel_v = bv; sel_id = si[bi >> 4] * 128 + si[16 + (bi & 15)]; }
            for (int q = 0; q < 4; ++q) if (bi == lane * 4 + q) cv[q] = -3e38f;
        }
        const float rs = 1.0f / sqrtf(ROWSS[tok] * (1.f / DM) + EPS);
        float ev = (lane < 16) ? expf((sel_v - mx) * rs) : 0.f;
        const float Z = wave_sum(ev);
        if (lane < 16) { IDS[(size_t)tok * 128 + hd * 16 + lane] = sel_id; GATES[(size_t)tok * 128 + hd * 16 + lane] = ev / Z; }
        LDS_WAIT();
    }
}

__device__ __forceinline__ float dot8(u32x4 a, u32x4 b, float acc) {
    const unsigned a0 = a[0], a1 = a[1], a2 = a[2], a3 = a[3], b0 = b[0], b1 = b[1], b2 = b[2], b3 = b[3];
    acc = __builtin_amdgcn_fdot2_f32_bf16(__builtin_bit_cast(bf16v2, a0), __builtin_bit_cast(bf16v2, b0), acc, false);
    acc = __builtin_amdgcn_fdot2_f32_bf16(__builtin_bit_cast(bf16v2, a1), __builtin_bit_cast(bf16v2, b1), acc, false);
    acc = __builtin_amdgcn_fdot2_f32_bf16(__builtin_bit_cast(bf16v2, a2), __builtin_bit_cast(bf16v2, b2), acc, false);
    acc = __builtin_amdgcn_fdot2_f32_bf16(__builtin_bit_cast(bf16v2, a3), __builtin_bit_cast(bf16v2, b3), acc, false);
    return acc;
}
__device__ __forceinline__ float gelu_tanh(float a) { const float t = 1.5957691216f * (a + 0.044715f * a * a * a); return a * frcp(1.f + fexp2(-LOG2E * t)); }

__device__ __forceinline__ void gather_phase(const Params& P, int vcu, int G) {
    const int tid = threadIdx.x, lane = tid & 63, wave = __builtin_amdgcn_readfirstlane(tid >> 6);
    const int gw = vcu * NWAVES + wave, NGW = G * NWAVES;
    unsigned char* ws = P.ws;
    const float* X1 = (const float*)(ws + WS_X1); const float* ROWSS = (const float*)(ws + WS_CTL);
    const int* IDS = (const int*)(ws + WS_IDS); const float* GATES = (const float*)(ws + WS_GATES);
    const bf16_t* EU = (const bf16_t*)(ws + WS_EU); const bf16_t* EV = (const bf16_t*)(ws + WS_EV);
    for (int tok = gw; tok < T_TOK; tok += NGW) {
        f32x4 xv[4][2]; u32x4 hp[4];
        const float rs = 1.0f / sqrtf(ROWSS[tok] * (1.f / DM) + EPS);
#pragma unroll
        for (int j = 0; j < 4; ++j) { const size_t o = (size_t)tok * DM + 8 * lane + 512 * j; xv[j][0] = *(const f32x4*)(X1 + o); xv[j][1] = *(const f32x4*)(X1 + o + 4);
            const f32x4 g0 = *(const f32x4*)(P.g_ffn + 8 * lane + 512 * j), g1 = *(const f32x4*)(P.g_ffn + 8 * lane + 512 * j + 4);
            const f32x4 h0 = xv[j][0] * rs * g0, h1 = xv[j][1] * rs * g1;
            hp[j].x = pk2(h0[0], h0[1]); hp[j].y = pk2(h0[2], h0[3]); hp[j].z = pk2(h1[0], h1[1]); hp[j].w = pk2(h1[2], h1[3]); }
        const int ida = IDS[(size_t)tok * 128 + lane], idb = IDS[(size_t)tok * 128 + 64 + lane];
        float wreg[16];
        const bool b5 = (lane >> 5) & 1, b4 = (lane >> 4) & 1, b3 = (lane >> 3) & 1;
#pragma unroll
        for (int bt = 0; bt < 16; ++bt) {
            float part[8];
#pragma unroll
            for (int hb = 0; hb < 2; ++hb) {
                u32x4 ud[4][4];
#pragma unroll
                for (int q = 0; q < 4; ++q) { const int k = bt * 8 + hb * 4 + q; const int e = __builtin_amdgcn_readlane(k < 64 ? ida : idb, k & 63);
                    const bf16_t* ur = EU + (size_t)e * DM + 8 * lane;
#pragma unroll
                    for (int j = 0; j < 4; ++j) { if (DBG == 13) { const float* fp = P.e_u + (size_t)e * DM + 8 * lane + 512 * j; const f32x4 a0 = *(const f32x4*)fp, a1 = *(const f32x4*)(fp + 4);
                            ud[q][j] = (u32x4){pk2(a0[0], a0[1]), pk2(a0[2], a0[3]), pk2(a1[0], a1[1]), pk2(a1[2], a1[3])}; } else ud[q][j] = *(const u32x4*)(ur + 512 * j); } }
#pragma unroll
                for (int q = 0; q < 4; ++q) { float a = 0.f;
#pragma unroll
                    for (int j = 0; j < 4; ++j) a = dot8(ud[q][j], hp[j], a);
                    part[hb * 4 + q] = a; }
            }
            float p1[4], p2[2];
#pragma unroll
            for (int q = 0; q < 4; ++q) { const float send = b5 ? part[q] : part[q + 4], keep = b5 ? part[q + 4] : part[q]; p1[q] = keep + __shfl_xor(send, 32); }
#pragma unroll
            for (int q = 0; q < 2; ++q) { const float send = b4 ? p1[q] : p1[q + 2], keep = b4 ? p1[q + 2] : p1[q]; p2[q] = keep + __shfl_xor(send, 16); }
            float p3; { const float send = b3 ? p2[0] : p2[1], keep = b3 ? p2[1] : p2[0]; p3 = keep + __shfl_xor(send, 8); }
            p3 += __shfl_xor(p3, 4); p3 += __shfl_xor(p3, 2); p3 += __shfl_xor(p3, 1);
            const float gate = GATES[(size_t)tok * 128 + bt * 8 + (lane >> 3)];
            wreg[bt] = gate * gelu_tanh(p3);
        }
        f32x4 acc[4][2];
#pragma unroll
        for (int j = 0; j < 4; ++j) { acc[j][0] = (f32x4){0.f, 0.f, 0.f, 0.f}; acc[j][1] = (f32x4){0.f, 0.f, 0.f, 0.f}; }
#pragma unroll
        for (int bt = 0; bt < 16; ++bt) {
#pragma unroll
            for (int hb = 0; hb < 2; ++hb) {
                u32x4 vd[4][4];
#pragma unroll
                for (int q = 0; q < 4; ++q) { const int k = bt * 8 + hb * 4 + q; const int e = __builtin_amdgcn_readlane(k < 64 ? ida : idb, k & 63);
                    const bf16_t* vr = EV + (size_t)e * DM + 8 * lane;
#pragma unroll
                    for (int j = 0; j < 4; ++j) { if (DBG == 13) { const float* fp = P.e_v + (size_t)e * DM + 8 * lane + 512 * j; const f32x4 a0 = *(const f32x4*)fp, a1 = *(const f32x4*)(fp + 4);
                            vd[q][j] = (u32x4){pk2(a0[0], a0[1]), pk2(a0[2], a0[3]), pk2(a1[0], a1[1]), pk2(a1[2], a1[3])}; } else vd[q][j] = *(const u32x4*)(vr + 512 * j); } }
#pragma unroll
                for (int q = 0; q < 4; ++q) { const float w = __builtin_bit_cast(float, __builtin_amdgcn_readlane(__builtin_bit_cast(int, wreg[bt]), 8 * (hb * 4 + q)));
#pragma unroll
                    for (int j = 0; j < 4; ++j) { const u32x4 v = vd[q][j];
                        acc[j][0] += w * (f32x4){bf_lo(v.x), bf_hi(v.x), bf_lo(v.y), bf_hi(v.y)};
                        acc[j][1] += w * (f32x4){bf_lo(v.z), bf_hi(v.z), bf_lo(v.w), bf_hi(v.w)}; } }
            }
        }
        float ss = 0.f;
#pragma unroll
        for (int j = 0; j < 4; ++j)
#pragma unroll
            for (int e = 0; e < 2; ++e) { const f32x4 v = (DBG == 1 || DBG == 2) ? xv[j][e] : xv[j][e] + acc[j][e]; xv[j][e] = v; ss += (v[0] * v[0] + v[1] * v[1]) + (v[2] * v[2] + v[3] * v[3]); }
        const float rs2 = 1.0f / sqrtf(wave_sum(ss) * (1.f / DM) + EPS);
#pragma unroll
        for (int j = 0; j < 4; ++j) { const size_t o = (size_t)tok * DM + 8 * lane + 512 * j;
            const f32x4 g0 = *(const f32x4*)(P.g_final + 8 * lane + 512 * j), g1 = *(const f32x4*)(P.g_final + 8 * lane + 512 * j + 4);
            *(f32x4*)(P.out + o) = xv[j][0] * rs2 * g0; *(f32x4*)(P.out + o + 4) = xv[j][1] * rs2 * g1; }
    }
}

__device__ __forceinline__ void gather_naive(const Params& P, int vcu, int G) {
    const int tid = threadIdx.x, lane = tid & 63, wave = __builtin_amdgcn_readfirstlane(tid >> 6);
    const int gw = vcu * NWAVES + wave, NGW = G * NWAVES;
    unsigned char* ws = P.ws;
    const float* X1 = (const float*)(ws + WS_X1); const float* ROWSS = (const float*)(ws + WS_CTL);
    const int* IDS = (const int*)(ws + WS_IDS); const float* GATES = (const float*)(ws + WS_GATES);
    for (int tok = gw; tok < T_TOK; tok += NGW) {
        float h2[32], acc[32];
        const float rs = 1.0f / sqrtf(ROWSS[tok] * (1.f / DM) + EPS);
#pragma unroll
        for (int i = 0; i < 32; ++i) { h2[i] = X1[(size_t)tok * DM + lane + 64 * i] * rs * P.g_ffn[lane + 64 * i]; acc[i] = 0.f; }
#pragma unroll 1
        for (int k = 0; k < 128; ++k) {
            const int e = IDS[(size_t)tok * 128 + k]; float a = 0.f;
            if (DBG == 12) { const bf16_t* up = (const bf16_t*)(ws + WS_EU) + (size_t)e * DM + lane;
#pragma unroll
                for (int i = 0; i < 32; ++i) a += h2[i] * bf_lo((unsigned)up[64 * i]);
            } else { const float* up = P.e_u + (size_t)e * DM + lane;
#pragma unroll
                for (int i = 0; i < 32; ++i) a += h2[i] * up[64 * i]; }
            a = wave_sum(a);
            const float w = GATES[(size_t)tok * 128 + k] * gelu_tanh(a);
            if (DBG == 12) { const bf16_t* vp = (const bf16_t*)(ws + WS_EV) + (size_t)e * DM + lane;
#pragma unroll
                for (int i = 0; i < 32; ++i) acc[i] += w * bf_lo((unsigned)vp[64 * i]);
            } else { const float* vp = P.e_v + (size_t)e * DM + lane;
#pragma unroll
                for (int i = 0; i < 32; ++i) acc[i] += w * vp[64 * i]; }
        }
        float ss = 0.f;
#pragma unroll
        for (int i = 0; i < 32; ++i) { acc[i] += X1[(size_t)tok * DM + lane + 64 * i]; ss += acc[i] * acc[i]; }
        const float rs2 = 1.0f / sqrtf(wave_sum(ss) * (1.f / DM) + EPS);
#pragma unroll
        for (int i = 0; i < 32; ++i) P.out[(size_t)tok * DM + lane + 64 * i] = acc[i] * rs2 * P.g_final[lane + 64 * i];
    }
}
}

__global__ void __launch_bounds__(NTHR, 2) mega_fwd(Params P) {
    extern __shared__ __attribute__((aligned(16))) unsigned char lds_raw[];
    LAS unsigned char* lds = (LAS unsigned char*)lds_raw;
    cg::grid_group grid = cg::this_grid();
    const int G = gridDim.x, bx = blockIdx.x;
    const int vcu = (G % 8 == 0) ? (bx % 8) * (G / 8) + bx / 8 : bx;
    unsigned char* ws = P.ws;
#ifndef ONLY_PHASE
#define ONLY_PHASE -1
#endif
#define IN(k) ((ONLY_PHASE < 0 || ONLY_PHASE == (k)) && P.ph_lo <= (k) && (k) < P.ph_hi)
#define SEAM(k) do { if (IN(k) && IN((k) + 1)) grid.sync(); } while (0)
    if (IN(0)) p0_prologue(P, lds, vcu, G);
    SEAM(0);
    if (IN(1)) {
        pg8::Gemm g{(const bf16_t*)(ws + WS_H), (const bf16_t*)(ws + WS_WIN), T_TOK, 10240, 2048, 2048, 2048};
        pg8::StaticOrder S; S.init(T_TOK, 10240, G, bx);
        pg8::EpiProj E{(bf16_t*)(ws + WS_QKV), (bf16_t*)(ws + WS_SG), LOG2E * 0.08838834764831845f};
        pg8::gemm_phase(lds, g, S, E);
    }
    SEAM(1);
    if (IN(2)) att::attn_phase(P, lds, vcu, G);
    SEAM(2);
    if (IN(3)) {
        pg8::StaticOrder S; S.init(T_TOK, DM, G, bx);
        { pg8::Gemm g{(const bf16_t*)(ws + WS_H), (const bf16_t*)(ws + WS_WAT), T_TOK, DM, 1024, 2048, 1024};
          pg8::EpiGate<0> E{(const bf16_t*)(ws + WS_SG), (float*)(ws + WS_TMP), (bf16_t*)(ws + WS_MERGED)};
          pg8::gemm_phase(lds, g, S, E); }
        { pg8::Gemm g{(const bf16_t*)(ws + WS_H) + 1024, (const bf16_t*)(ws + WS_WBT), T_TOK, DM, 1024, 2048, 1024};
          pg8::EpiGate<1> E{(const bf16_t*)(ws + WS_SG) + 2048, (float*)(ws + WS_TMP), (bf16_t*)(ws + WS_MERGED)};
          pg8::gemm_phase(lds, g, S, E); }
    }
    SEAM(3);
    if (IN(4)) {
        pg8::Gemm g{(const bf16_t*)(ws + WS_MERGED), (const bf16_t*)(ws + WS_WOUT), T_TOK, DM, 2048, 2048, 2048};
        pg8::StaticOrder S; S.init(T_TOK, DM, G, bx);
        pg8::EpiResid E{P.x, (float*)(ws + WS_X1), (bf16_t*)(ws + WS_X1B), (float*)(ws + WS_CTL)};
        pg8::gemm_phase(lds, g, S, E);
    }
    SEAM(4);
    if (IN(5)) {
        pg8::Gemm g{(const bf16_t*)(ws + WS_X1B), (const bf16_t*)(ws + WS_WQ), T_TOK, DM, 2048, 2048, 2048};
        pg8::StaticOrder S; S.init(T_TOK, DM, G, bx);
        pg8::EpiPlainBf16 E{(bf16_t*)(ws + WS_Q2)};
        pg8::gemm_phase(lds, g, S, E);
    }
    SEAM(5);
    if (IN(6)) { if (DBG == 10) peer::topk_naive(P, lds, vcu, G); else peer::topk_phase(P, lds, vcu, G); }
    SEAM(6);
    if (IN(7)) { if (DBG == 11 || DBG == 12) peer::gather_naive(P, vcu, G); else peer::gather_phase(P, vcu, G); }
#undef IN
#undef SEAM
}

extern "C" void kernel_launch(void* const* d_in, const int* in_sizes, int n_in, void* d_out, int out_size, void* d_ws, size_t ws_size, hipStream_t stream) {
    static int grid = 0;
    if (grid == 0) {
        if (n_in != 13 || out_size != T_TOK * DM || ws_size < WS_END) { fprintf(stderr, "kernel_launch: unexpected shapes (n_in %d out %d ws %zu)\n", n_in, out_size, ws_size); grid = -1; return; }
        int dev = 0, cus = 0, per_cu = 0;
        if (hipGetDevice(&dev) != hipSuccess || hipDeviceGetAttribute(&cus, hipDeviceAttributeMultiprocessorCount, dev) != hipSuccess) { grid = -1; return; }
        if (hipFuncSetAttribute((const void*)mega_fwd, hipFuncAttributeMaxDynamicSharedMemorySize, LDS_BYTES) != hipSuccess) { fprintf(stderr, "kernel_launch: hipFuncSetAttribute failed\n"); grid = -1; return; }
        if (hipOccupancyMaxActiveBlocksPerMultiprocessor(&per_cu, (const void*)mega_fwd, NTHR, LDS_BYTES) != hipSuccess || per_cu < 1) { fprintf(stderr, "kernel_launch: occupancy query says %d\n", per_cu); grid = -1; return; }
        grid = cus;
    }
    if (grid < 0) return;
    (void)hipMemsetAsync((char*)d_ws + WS_CTL, 0, 1 * MiB, stream);
    Params p{};
    p.x = (const float*)d_in[0]; p.g_mix = (const float*)d_in[1]; p.w_in = (const float*)d_in[2]; p.b_forget = (const float*)d_in[3];
    p.w_a = (const float*)d_in[4]; p.w_b = (const float*)d_in[5]; p.w_out = (const float*)d_in[6]; p.g_ffn = (const float*)d_in[7];
    p.w_query = (const float*)d_in[8]; p.sub_keys = (const float*)d_in[9]; p.e_u = (const float*)d_in[10]; p.e_v = (const float*)d_in[11]; p.g_final = (const float*)d_in[12];
    p.out = (float*)d_out; p.ws = (unsigned char*)d_ws;
#if MK_N_LAUNCHES == 1
    p.ph_lo = 0; p.ph_hi = N_PHASES;
    void* args[] = {&p};
    hipError_t e = hipLaunchCooperativeKernel((const void*)mega_fwd, dim3(grid), dim3(NTHR), args, LDS_BYTES, stream);
    if (e != hipSuccess) fprintf(stderr, "kernel_launch: cooperative launch failed: %s (grid %d)\n", hipGetErrorString(e), grid);
#else
    for (int ph = 0; ph < N_PHASES; ++ph) { p.ph_lo = ph; p.ph_hi = ph + 1; hipLaunchKernelGGL(mega_fwd, dim3(grid), dim3(NTHR), LDS_BYTES, stream, p); }
#endif
}
```

```cpp
#include <hip/hip_runtime.h>
#include <hip/hip_cooperative_groups.h>
#include <cstdio>
#include <cstdint>
namespace cg = cooperative_groups;

#define LAS __attribute__((address_space(3)))
typedef unsigned short bf16_t;
typedef short bf16x8 __attribute__((ext_vector_type(8)));
typedef short s16x4 __attribute__((ext_vector_type(4)));
typedef float f32x2 __attribute__((ext_vector_type(2)));
typedef float f32x4 __attribute__((ext_vector_type(4)));
typedef float f32x16 __attribute__((ext_vector_type(16)));
typedef unsigned u32x2 __attribute__((ext_vector_type(2)));
typedef unsigned u32x4 __attribute__((ext_vector_type(4)));
typedef __bf16 bf16v2 __attribute__((ext_vector_type(2)));

#ifndef DBG
#define DBG 0
#endif
#ifndef REPK
#define REPK -1
#endif
#ifndef MK_N_LAUNCHES
#define MK_N_LAUNCHES 1
#endif

constexpr int T_TOK = 8192, DM = 2048, SEQ = 4096, HD = 128;
constexpr int NWAVES = 8, NTHR = 512;
constexpr int LDS_BYTES = 147456;
constexpr float LOG2E = 1.4426950408889634f;
constexpr float EPS = 1e-6f;
constexpr int N_PHASES = 8;

constexpr size_t MiB = 1u << 20;
constexpr size_t WS_CTL = 0;
constexpr size_t WS_LOGF = 1 * MiB;
constexpr size_t WS_SKB = 1 * MiB + 512 * 1024;
constexpr size_t WS_IDS = 2 * MiB;
constexpr size_t WS_GATES = 6 * MiB;
constexpr size_t WS_WAT = 10 * MiB, WS_WBT = 14 * MiB, WS_WOUT = 18 * MiB, WS_WQ = 26 * MiB, WS_WIN = 34 * MiB;
constexpr size_t WS_H = 74 * MiB;
constexpr size_t WS_QKV = 106 * MiB;
constexpr size_t WS_TMP = 106 * MiB, WS_MERGED = 170 * MiB, WS_Q2 = 106 * MiB;
constexpr size_t WS_SG = 202 * MiB;
constexpr size_t WS_X1B = 202 * MiB;
constexpr size_t WS_X1 = 266 * MiB;
constexpr size_t WS_EU = 330 * MiB, WS_EV = 362 * MiB;
constexpr size_t WS_SU = 394 * MiB, WS_SV = 394 * MiB + 65536;
constexpr size_t WS_END = 395 * MiB;

struct Params {
    const float* x; const float* g_mix; const float* w_in; const float* b_forget; const float* w_a; const float* w_b; const float* w_out;
    const float* g_ffn; const float* w_query; const float* sub_keys; const float* e_u; const float* e_v; const float* g_final;
    float* out; unsigned char* ws; int ph_lo, ph_hi;
};

__device__ __forceinline__ unsigned pk2(float a, float b) { f32x2 v = {a, b}; return __builtin_bit_cast(unsigned, __builtin_convertvector(v, bf16v2)); }
__device__ __forceinline__ float bf_lo(unsigned u) { return __builtin_bit_cast(float, u << 16); }
__device__ __forceinline__ float bf_hi(unsigned u) { return __builtin_bit_cast(float, u & 0xffff0000u); }
__device__ __forceinline__ float fexp2(float x) { return __builtin_amdgcn_exp2f(x); }
__device__ __forceinline__ float flog2(float x) { return __builtin_amdgcn_logf(x); }
__device__ __forceinline__ float frcp(float x) { return __builtin_amdgcn_rcpf(x); }
__device__ __forceinline__ float wave_sum(float v) {
#pragma unroll
    for (int o = 1; o < 64; o <<= 1) v += __shfl_xor(v, o);
    return v;
}
#define LDS_WAIT() asm volatile("s_waitcnt lgkmcnt(0)" ::: "memory")

namespace pg8 {
constexpr int BM = 256, BK = 64, HALF = 128, HTB = HALF * BK * 2, STAGE_BYTES = 8 * HTB, NXCD = 8, WGM = 8;
__host__ __device__ __forceinline__ int lds_byte(int r, int c) { const int st = (r >> 4) * 2 + (c >> 5), rr = r & 15, cc = c & 31, ob = rr * 64 + cc * 2; return st * 1024 + (ob ^ (((ob >> 9) & 1) << 5)); }
__host__ __device__ __forceinline__ void stage_rc(int b, int& R, int& C) { const int st = b / 1024, sb = b % 1024, swz = sb ^ (((sb >> 9) & 1) << 5); R = (st >> 1) * 16 + swz / 64; C = (st & 1) * 32 + (swz % 64) / 2; }
__host__ __device__ __forceinline__ int perm32(int rho) { const int n = rho >> 4, i = rho & 15; return 8 * (i >> 2) + 4 * n + (i & 3); }
struct Unit { int pm, pn; };
struct Gemm { const bf16_t* A; const bf16_t* Bt; int M, N, K, lda, ldb; };
struct StaticOrder {
    int nM, nN, nwg, G, c;
    __device__ void init(int M, int N, int G_, int c_) { nM = M / BM; nN = N / BM; nwg = nM * nN; G = G_; c = c_; }
    __device__ bool next(int i, Unit& u) const {
        const long L = (long)i * G + c; if (L >= nwg) return false;
        int wgid = (int)L; { const int q = nwg / NXCD, r = nwg % NXCD, xcd = wgid % NXCD, off = wgid / NXCD; wgid = (xcd < r ? xcd * (q + 1) : r * (q + 1) + (xcd - r) * q) + off; }
        const int nig = WGM * nN, gid = wgid / nig, fm = gid * WGM, gsz = (nM - fm) < WGM ? (nM - fm) : WGM;
        u.pm = fm + ((wgid % nig) % gsz); u.pn = (wgid % nig) / gsz; return true;
    }
};
template <class Epi>
__device__ __forceinline__ void gemm_phase(LAS unsigned char* lds, const Gemm g, const StaticOrder& S, const Epi& E) {
    const int tid = threadIdx.x, wid = __builtin_amdgcn_readfirstlane(tid >> 6), lane = tid & 63, wr = wid >> 2, wc = wid & 3, fr = lane & 15, fq = lane >> 4;
    const int K = g.K, nt = K / BK;
    unsigned voffA[2], voffB[2];
#pragma unroll
    for (int i = 0; i < 2; ++i) { int R, C; stage_rc(tid * 16 + i * 8192, R, C); const int Rb = (R & ~31) + perm32(R & 31);
        voffA[i] = (unsigned)(R * g.lda + C) * 2u; voffB[i] = (unsigned)(Rb * g.ldb + C) * 2u; }
    const size_t kstep = (size_t)(BK * 2);
    const size_t hstepA = (size_t)HALF * g.lda * 2, hstepB = (size_t)HALF * g.ldb * 2;
    const size_t tstepA = 2 * hstepA, tstepB = 2 * hstepB;
    const unsigned ldsw = (unsigned)wid * 1024u;
    const int aoff = lds_byte(wr * 64 + fr, fq * 8), boff = lds_byte(wc * 32 + fr, fq * 8);
#define PG8_SA(b, h) (((b) * 2 + (h)) * HTB)
#define PG8_SB(b, h) ((4 + (b) * 2 + (h)) * HTB)
#define PG8_STAGE(bufoff, gbase, voff) do { _Pragma("unroll") for (int _i = 0; _i < 2; ++_i) \
        __builtin_amdgcn_global_load_lds((const unsigned*)((const char*)(gbase) + (voff)[_i]), (LAS unsigned*)(lds + (bufoff) + ldsw + _i * 8192), 16, 0, 0); } while (0)
#define PG8_LDA(dst, b, h) do { _Pragma("unroll") for (int m = 0; m < 4; ++m) _Pragma("unroll") for (int k = 0; k < 2; ++k) dst[m][k] = *(const LAS bf16x8*)(lds + PG8_SA(b, h) + aoff + m * 2048 + k * 1024); } while (0)
#define PG8_LDB(dst, b, h) do { _Pragma("unroll") for (int n = 0; n < 2; ++n) _Pragma("unroll") for (int k = 0; k < 2; ++k) dst[n][k] = *(const LAS bf16x8*)(lds + PG8_SB(b, h) + boff + n * 2048 + k * 1024); } while (0)
#define PG8_MMA(ai, bj, At, Bt) do { __builtin_amdgcn_s_setprio(1); _Pragma("unroll") for (int m = 0; m < 4; ++m) _Pragma("unroll") for (int n = 0; n < 2; ++n) _Pragma("unroll") for (int k = 0; k < 2; ++k) \
        acc[ai][bj][m][n] = __builtin_amdgcn_mfma_f32_16x16x32_bf16(Bt[n][k], At[m][k], acc[ai][bj][m][n], 0, 0, 0); __builtin_amdgcn_s_setprio(0); } while (0)
#define PG8_WAIT_V(n) asm volatile("s_waitcnt vmcnt(" #n ")" ::: "memory")
#define PG8_WAIT_L(n) asm volatile("s_waitcnt lgkmcnt(" #n ")" ::: "memory")
#define PG8_BAR __builtin_amdgcn_s_barrier()
#define PG8_SCHED __builtin_amdgcn_sched_barrier(0)
    Unit cur, nxt; int ui = 0;
    if (!S.next(0, cur)) return;
    f32x4 acc[2][2][4][2];
#pragma unroll
    for (int a = 0; a < 2; ++a)
#pragma unroll
        for (int b = 0; b < 2; ++b)
#pragma unroll
            for (int m = 0; m < 4; ++m)
#pragma unroll
                for (int n = 0; n < 2; ++n) acc[a][b][m][n] = (f32x4){0.f, 0.f, 0.f, 0.f};
    bf16x8 At[4][2], B0[2][2], B1[2][2];
    const char* cA = (const char*)g.A + (size_t)cur.pm * tstepA; const char* cB = (const char*)g.Bt + (size_t)cur.pn * tstepB;
    PG8_STAGE(PG8_SB(0, 0), cB, voffB); PG8_STAGE(PG8_SA(0, 0), cA, voffA); PG8_STAGE(PG8_SB(0, 1), cB + hstepB, voffB); PG8_STAGE(PG8_SA(0, 1), cA + hstepA, voffA);
    if (wr == 1) PG8_BAR;
    PG8_WAIT_V(4); PG8_BAR;
    PG8_STAGE(PG8_SB(1, 0), cB + kstep, voffB); PG8_STAGE(PG8_SA(1, 0), cA + kstep, voffA); PG8_STAGE(PG8_SB(1, 1), cB + hstepB + kstep, voffB);
    PG8_WAIT_V(6); PG8_BAR;
    for (;;) {
        const bool has_next = S.next(ui + 1, nxt);
        const char* nA = has_next ? (const char*)g.A + (size_t)nxt.pm * tstepA : cA; const char* nB = has_next ? (const char*)g.Bt + (size_t)nxt.pn * tstepB : cB;
        for (int t = 0; t < nt; t += 2) {
            const bool last = (t == nt - 2);
            const char* a1 = cA + (size_t)(t + 1) * kstep;
            const char* a2 = last ? nA : cA + (size_t)(t + 2) * kstep; const char* b2 = last ? nB : cB + (size_t)(t + 2) * kstep;
            const char* a3 = a2 + kstep; const char* b3 = b2 + kstep;
            PG8_LDB(B0, 0, 0); PG8_SCHED; PG8_LDA(At, 0, 0); PG8_STAGE(PG8_SA(1, 1), a1 + hstepA, voffA);
            PG8_WAIT_L(8); PG8_BAR; PG8_WAIT_L(0); PG8_MMA(0, 0, At, B0); PG8_BAR; PG8_SCHED;
            PG8_LDB(B1, 0, 1); PG8_STAGE(PG8_SB(0, 0), b2, voffB);
            PG8_BAR; PG8_WAIT_L(0); PG8_MMA(0, 1, At, B1); PG8_BAR;
            PG8_LDA(At, 0, 1); PG8_STAGE(PG8_SA(0, 0), a2, voffA);
            PG8_BAR; PG8_WAIT_L(0); PG8_MMA(1, 0, At, B0); PG8_BAR; PG8_SCHED;
            PG8_STAGE(PG8_SB(0, 1), b2 + hstepB, voffB);
            PG8_WAIT_V(6); PG8_BAR; PG8_MMA(1, 1, At, B1); PG8_BAR;
            PG8_LDB(B0, 1, 0); PG8_SCHED; PG8_LDA(At, 1, 0); PG8_STAGE(PG8_SA(0, 1), a2 + hstepA, voffA);
            PG8_WAIT_L(8); PG8_BAR; PG8_WAIT_L(0); PG8_MMA(0, 0, At, B0); PG8_BAR; PG8_SCHED;
            PG8_LDB(B1, 1, 1); PG8_STAGE(PG8_SB(1, 0), b3, voffB);
            PG8_BAR; PG8_WAIT_L(0); PG8_MMA(0, 1, At, B1); PG8_BAR;
            PG8_LDA(At, 1, 1); PG8_STAGE(PG8_SA(1, 0), a3, voffA);
            PG8_BAR; PG8_WAIT_L(0); PG8_MMA(1, 0, At, B0); PG8_BAR; PG8_SCHED;
            PG8_STAGE(PG8_SB(1, 1), b3 + hstepB, voffB);
            PG8_WAIT_V(6); PG8_BAR; PG8_MMA(1, 1, At, B1); PG8_BAR;
        }
        E(acc, cur, wr, wc, fr, fq);
        if (!has_next) break;
#pragma unroll
        for (int a = 0; a < 2; ++a)
#pragma unroll
            for (int b = 0; b < 2; ++b)
#pragma unroll
                for (int m = 0; m < 4; ++m)
#pragma unroll
                    for (int n = 0; n < 2; ++n) acc[a][b][m][n] = (f32x4){0.f, 0.f, 0.f, 0.f};
        cur = nxt; cA = nA; cB = nB; ++ui;
    }
    PG8_WAIT_V(0);
    if (wr == 0) PG8_BAR;
    PG8_BAR;
#undef PG8_SA
#undef PG8_SB
#undef PG8_STAGE
#undef PG8_LDA
#undef PG8_LDB
#undef PG8_MMA
#undef PG8_WAIT_V
#undef PG8_WAIT_L
#undef PG8_BAR
#undef PG8_SCHED
}

struct EpiProj {
    bf16_t* qkv; bf16_t* sg; float qscale;
    __device__ __forceinline__ void operator()(const f32x4 (&acc)[2][2][4][2], const Unit& u, int wr, int wc, int fr, int fq) const {
        const int row0 = u.pm * BM + wr * 64 + fr;
        if (u.pn < 24) {
            const int t = u.pn >> 2; bf16_t* base = qkv + (size_t)t * ((size_t)T_TOK * 1024) + (u.pn & 3) * 256 + wc * 32 + 8 * fq;
            const float sc = (t == 0 || t == 3) ? qscale : 1.f;
#pragma unroll
            for (int ai = 0; ai < 2; ++ai)
#pragma unroll
                for (int m = 0; m < 4; ++m) { bf16_t* rowp = base + (size_t)(row0 + ai * HALF + m * 16) * 1024;
#pragma unroll
                    for (int bj = 0; bj < 2; ++bj) { const f32x4 v0 = acc[ai][bj][m][0] * sc, v1 = acc[ai][bj][m][1] * sc;
                        u32x4 w; w.x = pk2(v0[0], v0[1]); w.y = pk2(v0[2], v0[3]); w.z = pk2(v1[0], v1[1]); w.w = pk2(v1[2], v1[3]);
                        *(u32x4*)(rowp + bj * HALF) = w; } }
        } else {
            bf16_t* base = sg + (u.pn - 24) * 256 + wc * 32 + 8 * fq;
#pragma unroll
            for (int ai = 0; ai < 2; ++ai)
#pragma unroll
                for (int m = 0; m < 4; ++m) { bf16_t* rowp = base + (size_t)(row0 + ai * HALF + m * 16) * 4096;
#pragma unroll
                    for (int bj = 0; bj < 2; ++bj) { float s[8];
#pragma unroll
                        for (int e = 0; e < 4; ++e) { s[e] = frcp(1.f + fexp2(-LOG2E * acc[ai][bj][m][0][e])); s[4 + e] = frcp(1.f + fexp2(-LOG2E * acc[ai][bj][m][1][e])); }
                        u32x4 w; w.x = pk2(s[0], s[1]); w.y = pk2(s[2], s[3]); w.z = pk2(s[4], s[5]); w.w = pk2(s[6], s[7]);
                        *(u32x4*)(rowp + bj * HALF) = w; } }
        }
    }
};
template <int SECOND> struct EpiGate {
    const bf16_t* sg;
    float* tmp; bf16_t* merged;
    __device__ __forceinline__ void operator()(const f32x4 (&acc)[2][2][4][2], const Unit& u, int wr, int wc, int fr, int fq) const {
        const int row0 = u.pm * BM + wr * 64 + fr, col0 = u.pn * BM + wc * 32 + 8 * fq;
#pragma unroll
        for (int ai = 0; ai < 2; ++ai)
#pragma unroll
            for (int m = 0; m < 4; ++m) { const size_t row = (size_t)(row0 + ai * HALF + m * 16);
#pragma unroll
                for (int bj = 0; bj < 2; ++bj) { const int col = col0 + bj * HALF;
                    const u32x4 gv = *(const u32x4*)(sg + row * 4096 + col);
                    const f32x4 g0 = {bf_lo(gv.x), bf_hi(gv.x), bf_lo(gv.y), bf_hi(gv.y)}, g1 = {bf_lo(gv.z), bf_hi(gv.z), bf_lo(gv.w), bf_hi(gv.w)};
                    f32x4 v0 = acc[ai][bj][m][0] * g0, v1 = acc[ai][bj][m][1] * g1;
                    float* tp = tmp + row * DM + col;
                    if (SECOND == 0) { *(f32x4*)tp = v0; *(f32x4*)(tp + 4) = v1; }
                    else { v0 += *(const f32x4*)tp; v1 += *(const f32x4*)(tp + 4);
                        u32x4 w; w.x = pk2(v0[0], v0[1]); w.y = pk2(v0[2], v0[3]); w.z = pk2(v1[0], v1[1]); w.w = pk2(v1[2], v1[3]);
                        *(u32x4*)(merged + row * DM + col) = w; } } }
    }
};
struct EpiResid {
    const float* x; float* x1; bf16_t* x1b; float* rowss;
    __device__ __forceinline__ void operator()(const f32x4 (&acc)[2][2][4][2], const Unit& u, int wr, int wc, int fr, int fq) const {
        const int row0 = u.pm * BM + wr * 64 + fr, col0 = u.pn * BM + wc * 32 + 8 * fq;
#pragma unroll
        for (int ai = 0; ai < 2; ++ai)
#pragma unroll
            for (int m = 0; m < 4; ++m) { const size_t row = (size_t)(row0 + ai * HALF + m * 16); float ss = 0.f;
#pragma unroll
                for (int bj = 0; bj < 2; ++bj) { const size_t o = row * DM + col0 + bj * HALF;
                    const f32x4 v0 = (DBG == 2 ? 0.f : 1.f) * acc[ai][bj][m][0] + *(const f32x4*)(x + o), v1 = (DBG == 2 ? 0.f : 1.f) * acc[ai][bj][m][1] + *(const f32x4*)(x + o + 4);
                    *(f32x4*)(x1 + o) = v0; *(f32x4*)(x1 + o + 4) = v1;
                    u32x4 w; w.x = pk2(v0[0], v0[1]); w.y = pk2(v0[2], v0[3]); w.z = pk2(v1[0], v1[1]); w.w = pk2(v1[2], v1[3]);
                    *(u32x4*)(x1b + o) = w;
                    ss += (v0[0] * v0[0] + v0[1] * v0[1]) + (v0[2] * v0[2] + v0[3] * v0[3]) + (v1[0] * v1[0] + v1[1] * v1[1]) + (v1[2] * v1[2] + v1[3] * v1[3]); }
                ss += __shfl_xor(ss, 16); ss += __shfl_xor(ss, 32);
                if (fq == 0) atomicAdd(rowss + row, ss); }
    }
};
struct EpiPlainBf16 {
    bf16_t* o;
    __device__ __forceinline__ void operator()(const f32x4 (&acc)[2][2][4][2], const Unit& u, int wr, int wc, int fr, int fq) const {
        const int row0 = u.pm * BM + wr * 64 + fr, col0 = u.pn * BM + wc * 32 + 8 * fq;
#pragma unroll
        for (int ai = 0; ai < 2; ++ai)
#pragma unroll
            for (int m = 0; m < 4; ++m) { const size_t row = (size_t)(row0 + ai * HALF + m * 16);
#pragma unroll
                for (int bj = 0; bj < 2; ++bj) { const f32x4 v0 = acc[ai][bj][m][0], v1 = acc[ai][bj][m][1];
                    u32x4 w; w.x = pk2(v0[0], v0[1]); w.y = pk2(v0[2], v0[3]); w.z = pk2(v1[0], v1[1]); w.w = pk2(v1[2], v1[3]);
                    *(u32x4*)(o + row * DM + col0 + bj * HALF) = w; } }
    }
};
}

__device__ __forceinline__ void transpose_item(const float* W, int ldw, int src_n0, bf16_t* WT, int K, int dst_n0, int k0, LAS float* scr, int lane, const float* kscale) {
#pragma unroll 8
    for (int i = 0; i < 32; ++i) { const int kk = 2 * i + (lane >> 5); float v = W[(size_t)(k0 + kk) * ldw + src_n0 + (lane & 31)]; if (kscale) v *= kscale[k0 + kk]; scr[kk * 33 + (lane & 31)] = v; }
    LDS_WAIT();
    const int c = lane & 7;
#pragma unroll
    for (int j = 0; j < 4; ++j) { const int n = (lane >> 3) + 8 * j; const LAS float* s = scr + (8 * c) * 33 + n;
        u32x4 o; o.x = pk2(s[0 * 33], s[1 * 33]); o.y = pk2(s[2 * 33], s[3 * 33]); o.z = pk2(s[4 * 33], s[5 * 33]); o.w = pk2(s[6 * 33], s[7 * 33]);
        *(u32x4*)(WT + (size_t)(dst_n0 + n) * K + k0 + 8 * c) = o; }
    LDS_WAIT();
}

__device__ __forceinline__ void p0_prologue(const Params& P, LAS unsigned char* lds, int vcu, int G) {
    const int tid = threadIdx.x, lane = tid & 63, wave = __builtin_amdgcn_readfirstlane(tid >> 6);
    const int gw = vcu * NWAVES + wave, NGW = G * NWAVES;
    unsigned char* ws = P.ws;
    {
        LAS float* scr = (LAS float*)(lds + wave * 16384);
        constexpr int I_IN = 32 * 320, I_A = 16 * 64, I_O = 32 * 64;
        constexpr int NITEMS = I_IN + 2 * I_A + 2 * I_O;
        for (int it = gw; it < NITEMS; it += NGW) {
            int r = it;
            if (r < I_IN) { const int kb = r / 320, nb = r % 320, dn = nb * 32; transpose_item(P.w_in, 10248, dn < 6144 ? dn : dn + 8, (bf16_t*)(ws + WS_WIN), 2048, dn, kb * 64, scr, lane, nullptr); continue; } r -= I_IN;
            if (r < I_A) { const int kb = r / 64, nb = r % 64; transpose_item(P.w_a, 2048, nb * 32, (bf16_t*)(ws + WS_WAT), 1024, nb * 32, kb * 64, scr, lane, nullptr); continue; } r -= I_A;
            if (r < I_A) { const int kb = r / 64, nb = r % 64; transpose_item(P.w_b, 2048, nb * 32, (bf16_t*)(ws + WS_WBT), 1024, nb * 32, kb * 64, scr, lane, nullptr); continue; } r -= I_A;
            if (r < I_O) { const int kb = r / 64, nb = r % 64; transpose_item(P.w_out, 2048, nb * 32, (bf16_t*)(ws + WS_WOUT), 2048, nb * 32, kb * 64, scr, lane, nullptr); continue; } r -= I_O;
            { const int kb = r / 64, nb = r % 64; transpose_item(P.w_query, 2048, nb * 32, (bf16_t*)(ws + WS_WQ), 2048, nb * 32, kb * 64, scr, lane, P.g_ffn); }
        }
    }
    __syncthreads();
    {
        LAS float* wf = (LAS float*)lds;
        for (int idx = tid; idx < 2048 * 8; idx += NTHR) { const int k = idx >> 3, c = idx & 7; wf[c * 2048 + k] = P.w_in[(size_t)k * 10248 + 6144 + c]; }
        __syncthreads();
        bf16_t* H = (bf16_t*)(ws + WS_H); float* LOGF = (float*)(ws + WS_LOGF);
        for (int r = gw; r < T_TOK; r += NGW) {
            const f32x4* xr = (const f32x4*)(P.x + (size_t)r * DM) + lane;
            float ss = 0.f;
#pragma unroll
            for (int j = 0; j < 8; ++j) { const f32x4 v = xr[64 * j]; ss += (v[0] * v[0] + v[1] * v[1]) + (v[2] * v[2] + v[3] * v[3]); }
            const float rstd = 1.0f / sqrtf(wave_sum(ss) * (1.f / DM) + EPS);
            float fl[8];
#pragma unroll
            for (int c = 0; c < 8; ++c) fl[c] = 0.f;
            u32x2* hp = (u32x2*)(H + (size_t)r * DM) + lane;
#pragma unroll 1
            for (int j = 0; j < 8; ++j) { const f32x4 gn = *((const f32x4*)P.g_mix + lane + 64 * j); const f32x4 hv = xr[64 * j] * rstd * gn;
                u32x2 o; o.x = pk2(hv[0], hv[1]); o.y = pk2(hv[2], hv[3]); hp[64 * j] = o;
#pragma unroll
                for (int c = 0; c < 8; ++c) { const f32x4 wv = *((const LAS f32x4*)(wf + c * 2048) + lane + 64 * j); fl[c] += (hv[0] * wv[0] + hv[1] * wv[1]) + (hv[2] * wv[2] + hv[3] * wv[3]); } }
#pragma unroll
            for (int c = 0; c < 8; ++c) fl[c] = wave_sum(fl[c]);
            if (lane == 0) {
#pragma unroll
                for (int c = 0; c < 8; ++c) { const float y = fl[c] + P.b_forget[c]; LOGF[(size_t)r * 8 + c] = fminf(y, 0.f) - log1pf(expf(-fabsf(y))); }
            }
        }
    }
    {
        float* SU = (float*)(ws + WS_SU); float* SV = (float*)(ws + WS_SV);
        for (int r = gw; r < 2 * 16384; r += NGW) {
            const bool second = r >= 16384; const int row = second ? r - 16384 : r;
            const f32x4* src = (const f32x4*)((second ? P.e_v : P.e_u) + (size_t)row * DM) + lane;
            f32x4 v[8]; float mx = 0.f;
#pragma unroll
            for (int j = 0; j < 8; ++j) { v[j] = __builtin_nontemporal_load(src + 64 * j); mx = fmaxf(mx, fmaxf(fmaxf(fabsf(v[j][0]), fabsf(v[j][1])), fmaxf(fabsf(v[j][2]), fabsf(v[j][3])))); }
#pragma unroll
            for (int o = 1; o < 64; o <<= 1) mx = fmaxf(mx, __shfl_xor(mx, o));
            mx = fmaxf(mx, 1e-30f);
            const float inv = 127.f / mx; const int bias = second ? 128 : 0;
            unsigned* dst = (unsigned*)(ws + (second ? WS_EV : WS_EU) + (size_t)row * DM) + lane;
#pragma unroll
            for (int j = 0; j < 8; ++j) { unsigned w = 0;
#pragma unroll
                for (int e = 0; e < 4; ++e) { const int q = (int)__builtin_rintf(v[j][e] * inv) + bias; w |= ((unsigned)q & 255u) << (8 * e); }
                dst[64 * j] = w; }
            if (lane == 0) (second ? SV : SU)[row] = mx * (1.f / 127.f);
        }
        const size_t gid = (size_t)vcu * NTHR + tid, gstride = (size_t)G * NTHR;
        for (size_t i = gid; i < 262144 / 8; i += gstride) { const float* src = P.sub_keys + i * 8; const f32x4 a = *(const f32x4*)src, b = *((const f32x4*)src + 1);
            u32x4 o; o.x = pk2(a[0], a[1]); o.y = pk2(a[2], a[3]); o.z = pk2(b[0], b[1]); o.w = pk2(b[2], b[3]); *(u32x4*)((bf16_t*)(ws + WS_SKB) + i * 8) = o; }
    }
}

namespace att {
constexpr int KST = 272, VST = 320;
constexpr int KBUF = 64 * KST, VBUF = 64 * VST;
constexpr int OFF_K = 0, OFF_V = 2 * KBUF, OFF_F = OFF_V + 2 * VBUF, OFF_SC = OFF_F + 4096 * 4;
static_assert(OFF_SC + 64 <= 131072, "attention LDS");

__device__ __forceinline__ void build_cumf(LAS unsigned char* lds, const float* LOGF, int b, int h, int n, int tid, int lane, int wid) {
    LAS float* F2 = (LAS float*)(lds + OFF_F); LAS float* sc = (LAS float*)(lds + OFF_SC);
    const int s0 = tid * 8; float v[8];
#pragma unroll
    for (int i = 0; i < 8; ++i) v[i] = (s0 < n) ? LOGF[((size_t)b * SEQ + s0 + i) * 8 + h] * LOG2E : 0.f;
#pragma unroll
    for (int i = 1; i < 8; ++i) v[i] += v[i - 1];
    float tot = v[7], inc = tot;
#pragma unroll
    for (int o = 1; o < 64; o <<= 1) { const float t = __shfl_up(inc, o); if (lane >= o) inc += t; }
    if (lane == 63) sc[wid] = inc;
    __syncthreads();
    float base = inc - tot;
#pragma unroll
    for (int w = 0; w < 8; ++w) if (w < wid) base += sc[w];
    if (s0 < n) {
#pragma unroll
        for (int i = 0; i < 8; ++i) F2[s0 + i] = v[i] + base;
    }
    __syncthreads();
}

template <int MIXER>
__device__ __forceinline__ void attn_unit(LAS unsigned char* lds, const bf16_t* Q, const bf16_t* Kg, const bf16_t* Vg, bf16_t* O, int b, int h, int qb, int tid, int lane, int wid) {
    const int c = lane & 31, hh = lane >> 5;
    const int t0 = qb * 256 + wid * 32, tq = t0 + c;
    const size_t rowbase = (size_t)b * SEQ;
    size_t qoff = (rowbase + tq) * 1024 + h * HD + 8 * hh;
    f32x16 oacc[4];
#pragma unroll
    for (int d = 0; d < 4; ++d)
#pragma unroll
        for (int r = 0; r < 16; ++r) oacc[d][r] = 0.f;
    float carry = 0.f, mrun = -1e30f, lsum = 0.f; const float nhf = hh ? 0.f : 1.f;
    const LAS float* F2 = (const LAS float*)(lds + OFF_F);
    const float Ft = (MIXER == 1) ? F2[tq] : 0.f;
    const int ktmax = 4 * qb + 3;
    const int srow = tid >> 4, scc = tid & 15;
    u32x4 kr[2], vr[2];
#define ATT_LOAD(kt) do { _Pragma("unroll") for (int j = 0; j < 2; ++j) { const size_t g_ = (rowbase + 64 * (kt) + srow + 32 * j) * 1024 + h * HD + scc * 8; \
        kr[j] = *(const u32x4*)(Kg + g_); vr[j] = *(const u32x4*)(Vg + g_); } } while (0)
#define ATT_WRITE(buf) do { _Pragma("unroll") for (int j = 0; j < 2; ++j) { \
        *(LAS u32x4*)(lds + OFF_K + (buf) * KBUF + (srow + 32 * j) * KST + scc * 16) = kr[j]; \
        *(LAS u32x4*)(lds + OFF_V + (buf) * VBUF + (srow + 32 * j) * VST + scc * 16) = vr[j]; } } while (0)
    ATT_LOAD(ktmax); ATT_WRITE(0); __syncthreads();
    int buf = 0;
    for (int kt = ktmax; kt >= 0; --kt) {
        if (kt > 0) ATT_LOAD(kt - 1);
        if (64 * kt <= t0 + 31) {
            const LAS unsigned char* Kl = lds + OFF_K + buf * KBUF; const LAS unsigned char* Vl = lds + OFF_V + buf * VBUF;
            f32x16 sacc[2];
            asm volatile("" : "+v"(qoff));
            bf16x8 qf[8];
#pragma unroll
            for (int s = 0; s < 8; ++s) qf[s] = *(const bf16x8*)(Q + qoff + 16 * s);
#pragma unroll
            for (int sub = 0; sub < 2; ++sub) {
#pragma unroll
                for (int r = 0; r < 16; ++r) sacc[sub][r] = 0.f;
#pragma unroll
                for (int s = 0; s < 8; ++s) { const bf16x8 kf = *(const LAS bf16x8*)(Kl + (32 * sub + c) * KST + (16 * s + 8 * hh) * 2);
                    sacc[sub] = __builtin_amdgcn_mfma_f32_32x32x16_bf16(kf, qf[s], sacc[sub], 0, 0, 0); }
            }
            const bool need_mask = (64 * kt + 63 >= t0);
            if (MIXER == 0) {
#pragma unroll
                for (int sub = 1; sub >= 0; --sub) {
                    float lb[16];
#pragma unroll
                    for (int r = 0; r < 16; ++r) { const float z = sacc[sub][r]; float l = -flog2(1.f + fexp2(z));
                        if (need_mask) { const int sidx = 64 * kt + 32 * sub + (r & 3) + 8 * (r >> 2) + 4 * hh; l = (sidx < tq) ? l : 0.f; }
                        lb[r] = l; }
                    float Glo[4], Ghi[4];
#pragma unroll
                    for (int g = 0; g < 4; ++g) { lb[4 * g + 2] += lb[4 * g + 3]; lb[4 * g + 1] += lb[4 * g + 2]; lb[4 * g] += lb[4 * g + 1];
                        const unsigned gu = __builtin_bit_cast(unsigned, lb[4 * g]); const auto rr = __builtin_amdgcn_permlane32_swap(gu, gu, false, false);
                        Glo[g] = __builtin_bit_cast(float, (unsigned)rr[0]); Ghi[g] = __builtin_bit_cast(float, (unsigned)rr[1]); }
                    float E[8];
                    E[7] = carry; E[6] = E[7] + Ghi[3]; E[5] = E[6] + Glo[3]; E[4] = E[5] + Ghi[2]; E[3] = E[4] + Glo[2]; E[2] = E[3] + Ghi[1]; E[1] = E[2] + Glo[1]; E[0] = E[1] + Ghi[0];
                    carry = E[0] + Glo[0];
#pragma unroll
                    for (int g = 0; g < 4; ++g) { const float Eo = __builtin_fmaf(nhf, Ghi[g], E[2 * g + 1]);
#pragma unroll
                        for (int i = 0; i < 4; ++i) { const int r = 4 * g + i; float w = fexp2(sacc[sub][r] + lb[r] + Eo);
                            if (need_mask) { const int sidx = 64 * kt + 32 * sub + (r & 3) + 8 * (r >> 2) + 4 * hh; w = (sidx < tq) ? w : 0.f; }
                            sacc[sub][r] = w; } }
                }
            } else {
                float mx = -1e30f;
#pragma unroll
                for (int sub = 0; sub < 2; ++sub)
#pragma unroll
                    for (int g = 0; g < 4; ++g) { const f32x4 fs = *(const LAS f32x4*)(F2 + 64 * kt + 32 * sub + 8 * g + 4 * hh);
#pragma unroll
                        for (int i = 0; i < 4; ++i) { const int r = 4 * g + i; float xv = sacc[sub][r] + (Ft - fs[i]);
                            if (need_mask) { const int sidx = 64 * kt + 32 * sub + 8 * g + 4 * hh + i; xv = (sidx <= tq) ? xv : -1e30f; }
                            sacc[sub][r] = xv; mx = fmaxf(mx, xv); } }
                { const unsigned mu = __builtin_bit_cast(unsigned, mx); const auto rr = __builtin_amdgcn_permlane32_swap(mu, mu, false, false);
                  mx = fmaxf(__builtin_bit_cast(float, (unsigned)rr[0]), __builtin_bit_cast(float, (unsigned)rr[1])); }
                const float mnew = fmaxf(mrun, mx);
                const float alpha = fexp2(mrun - mnew);
                float ps = 0.f;
#pragma unroll
                for (int sub = 0; sub < 2; ++sub)
#pragma unroll
                    for (int r = 0; r < 16; ++r) { const float p = fexp2(sacc[sub][r] - mnew); sacc[sub][r] = p; ps += p; }
                lsum = lsum * alpha + ps;
                if (__any(mnew > mrun)) {
#pragma unroll
                    for (int d = 0; d < 4; ++d)
#pragma unroll
                        for (int r = 0; r < 16; ++r) oacc[d][r] *= alpha;
                }
                mrun = mnew;
            }
#pragma unroll
            for (int ks = 0; ks < 4; ++ks) { const int sub = ks >> 1, rb = 8 * (ks & 1);
                u32x4 pw; pw.x = pk2(sacc[sub][rb + 0], sacc[sub][rb + 1]); pw.y = pk2(sacc[sub][rb + 2], sacc[sub][rb + 3]); pw.z = pk2(sacc[sub][rb + 4], sacc[sub][rb + 5]); pw.w = pk2(sacc[sub][rb + 6], sacc[sub][rb + 7]);
                const bf16x8 pf = __builtin_bit_cast(bf16x8, pw);
                const LAS unsigned char* vb = Vl + (16 * ks + 4 * hh + ((lane & 15) >> 2)) * VST + (16 * ((lane >> 4) & 1) + 4 * (lane & 3)) * 2;
#pragma unroll
                for (int d = 0; d < 4; ++d) {
                    const s16x4 a0 = __builtin_amdgcn_ds_read_tr16_b64_v4i16((LAS s16x4*)(vb + d * 64));
                    const s16x4 a1 = __builtin_amdgcn_ds_read_tr16_b64_v4i16((LAS s16x4*)(vb + d * 64 + 8 * VST));
                    const bf16x8 af = {a0[0], a0[1], a0[2], a0[3], a1[0], a1[1], a1[2], a1[3]};
                    oacc[d] = __builtin_amdgcn_mfma_f32_32x32x16_bf16(af, pf, oacc[d], 0, 0, 0); }
            }
        }
        if (kt > 0) ATT_WRITE(buf ^ 1);
        __syncthreads();
        buf ^= 1;
    }
#undef ATT_LOAD
#undef ATT_WRITE
    float inv = 1.f;
    if (MIXER == 1) { const unsigned lu = __builtin_bit_cast(unsigned, lsum); const auto rr = __builtin_amdgcn_permlane32_swap(lu, lu, false, false);
        inv = 1.f / (__builtin_bit_cast(float, (unsigned)rr[0]) + __builtin_bit_cast(float, (unsigned)rr[1])); }
    bf16_t* op = O + (rowbase + tq) * 2048 + 4 * hh;
#pragma unroll
    for (int d = 0; d < 4; ++d)
#pragma unroll
        for (int g = 0; g < 4; ++g) { u32x2 w; w.x = pk2(oacc[d][4 * g] * inv, oacc[d][4 * g + 1] * inv); w.y = pk2(oacc[d][4 * g + 2] * inv, oacc[d][4 * g + 3] * inv);
            *(u32x2*)(op + 32 * d + 8 * g) = w; }
}

__device__ __forceinline__ void attn_phase(const Params& P, LAS unsigned char* lds, int vcu, int G) {
    const int tid = threadIdx.x, lane = tid & 63, wid = __builtin_amdgcn_readfirstlane(tid >> 6);
    unsigned char* ws = P.ws;
    const bf16_t* QKV = (const bf16_t*)(ws + WS_QKV); const size_t TS = (size_t)T_TOK * 1024;
    bf16_t* OAB = (bf16_t*)(ws + WS_H); const float* LOGF = (const float*)(ws + WS_LOGF);
    for (int item = vcu; item < 256; item += G) {
        const int mixer = item >> 7, rem = item & 127, bh = rem >> 3, pair = rem & 7, b = bh >> 3, h = bh & 7;
        if (mixer == 0) {
            attn_unit<0>(lds, QKV, QKV + TS, QKV + 2 * TS, OAB + h * HD, b, h, 15 - pair, tid, lane, wid);
            attn_unit<0>(lds, QKV, QKV + TS, QKV + 2 * TS, OAB + h * HD, b, h, pair, tid, lane, wid);
        } else {
            build_cumf(lds, LOGF, b, h, 256 * (16 - pair), tid, lane, wid);
            attn_unit<1>(lds, QKV + 3 * TS, QKV + 4 * TS, QKV + 5 * TS, OAB + 1024 + h * HD, b, h, 15 - pair, tid, lane, wid);
            attn_unit<1>(lds, QKV + 3 * TS, QKV + 4 * TS, QKV + 5 * TS, OAB + 1024 + h * HD, b, h, pair, tid, lane, wid);
        }
        __syncthreads();
    }
}
}

namespace peer {
__device__ __forceinline__ unsigned sortable(float f) { const unsigned u = __builtin_bit_cast(unsigned, f); return (u & 0x80000000u) ? ~u : (u | 0x80000000u); }
__device__ __forceinline__ float unsortable(unsigned k) { const unsigned u = (k & 0x80000000u) ? (k & 0x7fffffffu) : ~k; return __builtin_bit_cast(float, u); }
template <int N> __device__ __forceinline__ unsigned umax_all(const unsigned (&k)[N]) {
    unsigned m = k[0];
#pragma unroll
    for (int q = 1; q < N; ++q) m = m > k[q] ? m : k[q];
    return m;
}

__device__ __forceinline__ void topk_phase(const Params& P, LAS unsigned char* lds, int vcu, int G) {
    const int tid = threadIdx.x, lane = tid & 63, wave = __builtin_amdgcn_readfirstlane(tid >> 6);
    const int c = lane & 31, hh = lane >> 5;
    const int gw = vcu * NWAVES + wave, NGW = G * NWAVES;
    unsigned char* ws = P.ws;
    const bf16_t* Q2 = (const bf16_t*)(ws + WS_Q2); const bf16_t* SKB = (const bf16_t*)(ws + WS_SKB);
    const float* ROWSS = (const float*)(ws + WS_CTL); int* IDS = (int*)(ws + WS_IDS); float* GATES = (float*)(ws + WS_GATES);
    LAS unsigned char* scr = lds + wave * 4096;
    for (int task = gw; task < 2048; task += NGW) {
        const int tg = task >> 3, hd = task & 7, tok = tg * 32 + c;
#pragma unroll 1
        for (int p = 0; p < 2; ++p) {
            bf16x8 qf[8];
            { const bf16_t* qp = Q2 + (size_t)tok * DM + hd * 256 + p * 128 + 8 * hh;
#pragma unroll
              for (int s = 0; s < 8; ++s) qf[s] = *(const bf16x8*)(qp + 16 * s); }
            unsigned keys[64];
#pragma unroll
            for (int sub = 0; sub < 4; ++sub) {
                f32x16 acc;
#pragma unroll
                for (int r = 0; r < 16; ++r) acc[r] = 0.f;
                const bf16_t* kp = SKB + ((size_t)(hd * 2 + p) * 128 + 32 * sub + c) * 128 + 8 * hh;
#pragma unroll
                for (int s = 0; s < 8; ++s) { const bf16x8 kf = *(const bf16x8*)(kp + 16 * s); acc = __builtin_amdgcn_mfma_f32_32x32x16_bf16(kf, qf[s], acc, 0, 0, 0); }
#pragma unroll
                for (int r = 0; r < 16; ++r) { const int nlo = 127 - (32 * sub + (r & 3) + 8 * (r >> 2)); keys[sub * 16 + r] = (sortable(acc[r]) & ~127u) | (unsigned)(nlo - 4 * hh); }
            }
            unsigned top[16];
#pragma unroll
            for (int i = 0; i < 16; ++i) {
                unsigned m = umax_all<64>(keys);
                const auto rr = __builtin_amdgcn_permlane32_swap(m, m, false, false);
                m = (unsigned)rr[0] > (unsigned)rr[1] ? (unsigned)rr[0] : (unsigned)rr[1];
                top[i] = m;
#pragma unroll
                for (int q = 0; q < 64; ++q) keys[q] = (keys[q] == m) ? 0u : keys[q];
            }
            if (hh == 0) {
#pragma unroll
                for (int w = 0; w < 4; ++w) *(LAS u32x4*)(scr + (c * 2 + p) * 64 + w * 16) = (u32x4){top[4 * w], top[4 * w + 1], top[4 * w + 2], top[4 * w + 3]};
            }
        }
        LDS_WAIT();
        float s1[16], s2[16];
#pragma unroll
        for (int w = 0; w < 4; ++w) { const u32x4 a = *(const LAS u32x4*)(scr + (c * 2) * 64 + w * 16), b2 = *(const LAS u32x4*)(scr + (c * 2 + 1) * 64 + w * 16);
#pragma unroll
            for (int e = 0; e < 4; ++e) { s1[4 * w + e] = unsortable((a[e] & ~127u) | 64u); s2[4 * w + e] = unsortable((b2[e] & ~127u) | 64u); } }
        unsigned ck[50];
        { int n = 0;
#pragma unroll
          for (int i = 0; i < 16; ++i)
#pragma unroll
              for (int j = 0; j < 16; ++j) if ((i + 1) * (j + 1) <= 16) { ck[n] = (sortable(s1[i] + s2[j]) & ~255u) | (unsigned)(255 - (i * 16 + j)); ++n; } }
        unsigned t2[16];
#pragma unroll
        for (int k = 0; k < 16; ++k) { const unsigned m = umax_all<50>(ck); t2[k] = m;
#pragma unroll
            for (int q = 0; q < 50; ++q) ck[q] = (ck[q] == m) ? 0u : ck[q]; }
        int ids[16]; float sc[16];
#pragma unroll
        for (int k = 0; k < 16; ++k) { const unsigned pos = 255u - (t2[k] & 255u);
            const unsigned k1 = *(const LAS unsigned*)(scr + (c * 2) * 64 + (pos >> 4) * 4), k2 = *(const LAS unsigned*)(scr + (c * 2 + 1) * 64 + (pos & 15u) * 4);
            ids[k] = (int)((127u - (k1 & 127u)) * 128u + (127u - (k2 & 127u))); sc[k] = unsortable((t2[k] & ~255u) | 128u); }
        LDS_WAIT();
        const float rs = 1.0f / sqrtf(ROWSS[tok] * (1.f / DM) + EPS);
        float ev[16], Z = 0.f;
#pragma unroll
        for (int k = 0; k < 16; ++k) { ev[k] = fexp2((sc[k] - sc[0]) * rs * LOG2E); Z += ev[k]; }
        const float iz = 1.f / Z;
        int* ip = IDS + (size_t)tok * 128 + hd * 16; float* gp = GATES + (size_t)tok * 128 + hd * 16;
        if (hh == 0) {
#pragma unroll
            for (int k = 0; k < 8; ++k) { ip[k] = ids[k]; gp[k] = ev[k] * iz; }
        } else {
#pragma unroll
            for (int k = 8; k < 16; ++k) { ip[k] = ids[k]; gp[k] = ev[k] * iz; }
        }
    }
}


__device__ __forceinline__ void topk_naive(const Params& P, LAS unsigned char* lds, int vcu, int G) {
    const int tid = threadIdx.x, lane = tid & 63, wave = __builtin_amdgcn_readfirstlane(tid >> 6);
    const int gw = vcu * NWAVES + wave, NGW = G * NWAVES;
    unsigned char* ws = P.ws;
    const bf16_t* Q2 = (const bf16_t*)(ws + WS_Q2);
    const float* ROWSS = (const float*)(ws + WS_CTL); int* IDS = (int*)(ws + WS_IDS); float* GATES = (float*)(ws + WS_GATES);
    LAS float* sv = (LAS float*)(lds + wave * 1024);
    LAS int* si = (LAS int*)(lds + wave * 1024 + 256);
    for (int task = gw; task < T_TOK * 8; task += NGW) {
        const int tok = task >> 3, hd = task & 7;
        for (int p = 0; p < 2; ++p) {
            float v0 = 0.f, v1 = 0.f;
            for (int cc = 0; cc < 128; ++cc) { const float q = bf_lo((unsigned)Q2[(size_t)tok * DM + hd * 256 + p * 128 + cc]);
                v0 += q * P.sub_keys[((size_t)(hd * 2 + p) * 128 + lane) * 128 + cc]; v1 += q * P.sub_keys[((size_t)(hd * 2 + p) * 128 + lane + 64) * 128 + cc]; }
            for (int i = 0; i < 16; ++i) {
                float bv = v0 >= v1 ? v0 : v1; int bi = v0 >= v1 ? lane : lane + 64;
                for (int o = 1; o < 64; o <<= 1) { const float ov = __shfl_xor(bv, o); const int oi = __shfl_xor(bi, o); if (ov > bv || (ov == bv && oi < bi)) { bv = ov; bi = oi; } }
                if (lane == 0) { sv[p * 16 + i] = bv; si[p * 16 + i] = bi; }
                if (bi == lane) v0 = -3e38f; if (bi == lane + 64) v1 = -3e38f;
            }
        }
        LDS_WAIT();
        float cv[4]; for (int q = 0; q < 4; ++q) { const int pos = lane * 4 + q; cv[q] = sv[pos >> 4] + sv[16 + (pos & 15)]; }
        float sel_v = 0.f; int sel_id = 0; float mx = 0.f;
        for (int k = 0; k < 16; ++k) {
            float bv = cv[0]; int bi = lane * 4;
            for (int q = 1; q < 4; ++q) if (cv[q] > bv) { bv = cv[q]; bi = lane * 4 + q; }
            for (int o = 1; o < 64; o <<= 1) { const float ov = __shfl_xor(bv, o); const int oi = __shfl_xor(bi, o); if (ov > bv || (ov == bv && oi < bi)) { bv = ov; bi = oi; } }
            if (k == 0) mx = bv;
            if (lane == k) { sel_v = bv; sel_id = si[bi >> 4] * 128 + si[16 + (bi & 15)]; }
            for (int q = 0; q < 4; ++q) if (bi == lane * 4 + q) cv[q] = -3e38f;
        }
        const float rs = 1.0f / sqrtf(ROWSS[tok] * (1.f / DM) + EPS);
        float ev = (lane < 16) ? expf((sel_v - mx) * rs) : 0.f;
        const float Z = wave_sum(ev);
        if (lane < 16) { IDS[(size_t)tok * 128 + hd * 16 + lane] = sel_id; GATES[(size_t)tok * 128 + hd * 16 + lane] = ev / Z; }
        LDS_WAIT();
    }
}

__device__ __forceinline__ float dot8(u32x4 a, u32x4 b, float acc) {
    const unsigned a0 = a[0], a1 = a[1], a2 = a[2], a3 = a[3], b0 = b[0], b1 = b[1], b2 = b[2], b3 = b[3];
    acc = __builtin_amdgcn_fdot2_f32_bf16(__builtin_bit_cast(bf16v2, a0), __builtin_bit_cast(bf16v2, b0), acc, false);
    acc = __builtin_amdgcn_fdot2_f32_bf16(__builtin_bit_cast(bf16v2, a1), __builtin_bit_cast(bf16v2, b1), acc, false);
    acc = __builtin_amdgcn_fdot2_f32_bf16(__builtin_bit_cast(bf16v2, a2), __builtin_bit_cast(bf16v2, b2), acc, false);
    acc = __builtin_amdgcn_fdot2_f32_bf16(__builtin_bit_cast(bf16v2, a3), __builtin_bit_cast(bf16v2, b3), acc, false);
    return acc;
}
__device__ __forceinline__ float gelu_tanh(float a) { const float t = 1.5957691216f * (a + 0.044715f * a * a * a); return a * frcp(1.f + fexp2(-LOG2E * t)); }

__device__ __forceinline__ void gather_phase(const Params& P, int vcu, int G) {
    const int tid = threadIdx.x, lane = tid & 63, wave = __builtin_amdgcn_readfirstlane(tid >> 6);
    const int gw = vcu * NWAVES + wave, NGW = G * NWAVES;
    unsigned char* ws = P.ws;
    const float* X1 = (const float*)(ws + WS_X1); const float* ROWSS = (const float*)(ws + WS_CTL);
    const int* IDS = (const int*)(ws + WS_IDS); const float* GATES = (const float*)(ws + WS_GATES);
    const unsigned char* EU = ws + WS_EU; const unsigned char* EV = ws + WS_EV;
    const float* SU = (const float*)(ws + WS_SU); const float* SV = (const float*)(ws + WS_SV);
    const bool b5 = (lane >> 5) & 1, b4 = (lane >> 4) & 1, b3 = (lane >> 3) & 1;
    for (int tok = gw; tok < T_TOK; tok += NGW) {
        f32x4 xv[2][4]; u32x4 hq[2];
        const float rs = 1.0f / sqrtf(ROWSS[tok] * (1.f / DM) + EPS);
        float hmx = 0.f;
#pragma unroll
        for (int j = 0; j < 2; ++j)
#pragma unroll
            for (int c4 = 0; c4 < 4; ++c4) { const size_t o = (size_t)tok * DM + 16 * lane + 1024 * j + 4 * c4; xv[j][c4] = *(const f32x4*)(X1 + o); }
        f32x4 hv[2][4];
#pragma unroll
        for (int j = 0; j < 2; ++j)
#pragma unroll
            for (int c4 = 0; c4 < 4; ++c4) { const f32x4 g = *(const f32x4*)(P.g_ffn + 16 * lane + 1024 * j + 4 * c4); hv[j][c4] = xv[j][c4] * rs * g;
                hmx = fmaxf(hmx, fmaxf(fmaxf(fabsf(hv[j][c4][0]), fabsf(hv[j][c4][1])), fmaxf(fabsf(hv[j][c4][2]), fabsf(hv[j][c4][3])))); }
#pragma unroll
        for (int o = 1; o < 64; o <<= 1) hmx = fmaxf(hmx, __shfl_xor(hmx, o));
        hmx = fmaxf(hmx, 1e-30f);
        const float hinv = 127.f / hmx, hscale = hmx * (1.f / 127.f);
#pragma unroll
        for (int j = 0; j < 2; ++j)
#pragma unroll
            for (int c4 = 0; c4 < 4; ++c4) { unsigned w = 0;
#pragma unroll
                for (int e = 0; e < 4; ++e) w |= ((unsigned)(int)__builtin_rintf(hv[j][c4][e] * hinv) & 255u) << (8 * e);
                hq[j][c4] = w; }
        const int ida = IDS[(size_t)tok * 128 + lane], idb = IDS[(size_t)tok * 128 + 64 + lane];
        const float sua = SU[ida], sub = SU[idb], sva = SV[ida], svb = SV[idb];
        float wreg[16];
#pragma unroll
        for (int bt = 0; bt < 16; ++bt) {
            int part[8]; u32x4 ud[8][2];
#pragma unroll
            for (int q = 0; q < 8; ++q) { const int k = bt * 8 + q; const int e = __builtin_amdgcn_readlane(k < 64 ? ida : idb, k & 63);
                const unsigned char* ur = EU + (size_t)e * DM + 16 * lane;
                ud[q][0] = *(const u32x4*)ur; ud[q][1] = *(const u32x4*)(ur + 1024); }
#pragma unroll
            for (int q = 0; q < 8; ++q) { int a = 0;
#pragma unroll
                for (int j = 0; j < 2; ++j)
#pragma unroll
                    for (int c4 = 0; c4 < 4; ++c4) a = __builtin_amdgcn_sdot4((int)ud[q][j][c4], (int)hq[j][c4], a, false);
                part[q] = a; }
            int p1[4], p2[2];
#pragma unroll
            for (int q = 0; q < 4; ++q) { const int send = b5 ? part[q] : part[q + 4], keep = b5 ? part[q + 4] : part[q]; p1[q] = keep + __shfl_xor(send, 32); }
#pragma unroll
            for (int q = 0; q < 2; ++q) { const int send = b4 ? p1[q] : p1[q + 2], keep = b4 ? p1[q + 2] : p1[q]; p2[q] = keep + __shfl_xor(send, 16); }
            int p3; { const int send = b3 ? p2[0] : p2[1], keep = b3 ? p2[1] : p2[0]; p3 = keep + __shfl_xor(send, 8); }
            p3 += __shfl_xor(p3, 4); p3 += __shfl_xor(p3, 2); p3 += __shfl_xor(p3, 1);
            const int ksel = bt * 8 + (lane >> 3);
            const float su_k = __shfl(bt < 8 ? sua : sub, ksel & 63), sv_k = __shfl(bt < 8 ? sva : svb, ksel & 63);
            const float gate = GATES[(size_t)tok * 128 + ksel];
            const float act = (float)p3 * (su_k * hscale);
            wreg[bt] = gate * gelu_tanh(act) * sv_k;
        }
        f32x4 acc[2][4]; float wsum = 0.f;
#pragma unroll
        for (int j = 0; j < 2; ++j)
#pragma unroll
            for (int c4 = 0; c4 < 4; ++c4) acc[j][c4] = (f32x4){0.f, 0.f, 0.f, 0.f};
#pragma unroll
        for (int bt = 0; bt < 16; ++bt) {
            u32x4 vd[8][2];
#pragma unroll
            for (int q = 0; q < 8; ++q) { const int k = bt * 8 + q; const int e = __builtin_amdgcn_readlane(k < 64 ? ida : idb, k & 63);
                const unsigned char* vr = EV + (size_t)e * DM + 16 * lane;
                vd[q][0] = *(const u32x4*)vr; vd[q][1] = *(const u32x4*)(vr + 1024); }
#pragma unroll
            for (int q = 0; q < 8; ++q) { const float w = __builtin_bit_cast(float, __builtin_amdgcn_readlane(__builtin_bit_cast(int, wreg[bt]), 8 * q));
                wsum += w;
#pragma unroll
                for (int j = 0; j < 2; ++j)
#pragma unroll
                    for (int c4 = 0; c4 < 4; ++c4) { const unsigned u = vd[q][j][c4];
                        acc[j][c4] += w * (f32x4){(float)(u & 255u), (float)((u >> 8) & 255u), (float)((u >> 16) & 255u), (float)(u >> 24)}; } }
        }
        float ss = 0.f; const float corr = 128.f * wsum;
#pragma unroll
        for (int j = 0; j < 2; ++j)
#pragma unroll
            for (int c4 = 0; c4 < 4; ++c4) { const f32x4 v = (DBG == 1 || DBG == 2) ? xv[j][c4] : xv[j][c4] + (acc[j][c4] - corr); xv[j][c4] = v; ss += (v[0] * v[0] + v[1] * v[1]) + (v[2] * v[2] + v[3] * v[3]); }
        const float rs2 = 1.0f / sqrtf(wave_sum(ss) * (1.f / DM) + EPS);
#pragma unroll
        for (int j = 0; j < 2; ++j)
#pragma unroll
            for (int c4 = 0; c4 < 4; ++c4) { const size_t o = (size_t)tok * DM + 16 * lane + 1024 * j + 4 * c4;
                const f32x4 g = *(const f32x4*)(P.g_final + 16 * lane + 1024 * j + 4 * c4);
                *(f32x4*)(P.out + o) = xv[j][c4] * rs2 * g; }
    }
}

__device__ __forceinline__ void gather_naive(const Params& P, int vcu, int G) {
    const int tid = threadIdx.x, lane = tid & 63, wave = __builtin_amdgcn_readfirstlane(tid >> 6);
    const int gw = vcu * NWAVES + wave, NGW = G * NWAVES;
    unsigned char* ws = P.ws;
    const float* X1 = (const float*)(ws + WS_X1); const float* ROWSS = (const float*)(ws + WS_CTL);
    const int* IDS = (const int*)(ws + WS_IDS); const float* GATES = (const float*)(ws + WS_GATES);
    for (int tok = gw; tok < T_TOK; tok += NGW) {
        float h2[32], acc[32];
        const float rs = 1.0f / sqrtf(ROWSS[tok] * (1.f / DM) + EPS);
#pragma unroll
        for (int i = 0; i < 32; ++i) { h2[i] = X1[(size_t)tok * DM + lane + 64 * i] * rs * P.g_ffn[lane + 64 * i]; acc[i] = 0.f; }
#pragma unroll 1
        for (int k = 0; k < 128; ++k) {
            const int e = IDS[(size_t)tok * 128 + k]; float a = 0.f;
            if (false) { const bf16_t* up = (const bf16_t*)(ws + WS_EU) + (size_t)e * DM + lane;
#pragma unroll
                for (int i = 0; i < 32; ++i) a += h2[i] * bf_lo((unsigned)up[64 * i]);
            } else { const float* up = P.e_u + (size_t)e * DM + lane;
#pragma unroll
                for (int i = 0; i < 32; ++i) a += h2[i] * up[64 * i]; }
            a = wave_sum(a);
            const float w = GATES[(size_t)tok * 128 + k] * gelu_tanh(a);
            if (false) { const bf16_t* vp = (const bf16_t*)(ws + WS_EV) + (size_t)e * DM + lane;
#pragma unroll
                for (int i = 0; i < 32; ++i) acc[i] += w * bf_lo((unsigned)vp[64 * i]);
            } else { const float* vp = P.e_v + (size_t)e * DM + lane;
#pragma unroll
                for (int i = 0; i < 32; ++i) acc[i] += w * vp[64 * i]; }
        }
        float ss = 0.f;
#pragma unroll
        for (int i = 0; i < 32; ++i) { acc[i] += X1[(size_t)tok * DM + lane + 64 * i]; ss += acc[i] * acc[i]; }
        const float rs2 = 1.0f / sqrtf(wave_sum(ss) * (1.f / DM) + EPS);
#pragma unroll
        for (int i = 0; i < 32; ++i) P.out[(size_t)tok * DM + lane + 64 * i] = acc[i] * rs2 * P.g_final[lane + 64 * i];
    }
}
}


#define XB_TMO      128
#define XB_XCNT(j)  (256  + 64 * (j))
#define XB_XSUB(j)  (1280 + 64 * (j))
#define XB_XGEN(j)  (2304 + 64 * (j))
#define XB_TOP      3328
#define XB_TOPGEN   3392
#define XCD_BAR_WORDS 3456
#define XB_SPIN_CAP (1u << 18)
__device__ __forceinline__ unsigned xb_ld(unsigned* p)              { return __hip_atomic_load(p, __ATOMIC_RELAXED, __HIP_MEMORY_SCOPE_AGENT); }
__device__ __forceinline__ unsigned xb_add(unsigned* p, unsigned v) { return __hip_atomic_fetch_add(p, v, __ATOMIC_RELAXED, __HIP_MEMORY_SCOPE_AGENT); }
__device__ __forceinline__ unsigned xb_xcc_id() { return (unsigned)__builtin_amdgcn_s_getreg((3 << 11) | 20) & 0xFu; }
#define XB_SPIN(cond, bar) do { unsigned _sp = 0; while (cond) { __builtin_amdgcn_s_sleep(1); \
    if ((++_sp & 255u) == 0u) { if (xb_ld(&(bar)[XB_TMO])) break; if (_sp > XB_SPIN_CAP) { atomicAdd(&(bar)[XB_TMO], 1u); break; } } } } while (0)
struct XcdBarrier { unsigned* bar; unsigned x; volatile LAS unsigned* st; };
__device__ __forceinline__ XcdBarrier xcd_barrier_post(unsigned* bar, volatile LAS unsigned* st) {
    XcdBarrier b; b.bar = bar; b.x = xb_xcc_id(); b.st = st;
    if (threadIdx.x == 0) (void)xb_add(&bar[XB_XCNT(b.x)], 1u);
    return b;
}
__device__ __forceinline__ void xcd_barrier_complete(unsigned* bar, unsigned x, unsigned& nloc, unsigned& nx) {
    const unsigned G = gridDim.x * gridDim.y * gridDim.z;
    unsigned sum, cnt, mine, sp = 0u;
    for (;;) {
        sum = 0u; cnt = 0u; mine = 0u;
#pragma unroll
        for (unsigned j = 0; j < 16; ++j) { const unsigned c = xb_ld(&bar[XB_XCNT(j)]); sum += c; cnt += (c > 0u) ? 1u : 0u; mine = (j == x) ? c : mine; }
        if (sum == G) break;
        __builtin_amdgcn_s_sleep(1);
        if ((++sp & 255u) == 0u) { if (xb_ld(&bar[XB_TMO])) break; if (sp > XB_SPIN_CAP) { atomicAdd(&bar[XB_TMO], 1u); break; } }
    }
    nloc = mine > 0u ? mine : 1u; nx = cnt > 0u ? cnt : 1u;
}
__device__ __forceinline__ void xcd_barrier(const XcdBarrier& b) {
    asm volatile("s_waitcnt vmcnt(0)" ::: "memory");
    __syncthreads();
    if (threadIdx.x == 0) {
        unsigned* bar = b.bar;
        __builtin_amdgcn_s_waitcnt(0);
        unsigned nloc = b.st[0], nx = b.st[1];
        if (nloc == 0u) { xcd_barrier_complete(bar, b.x, nloc, nx); b.st[0] = nloc; b.st[1] = nx; }
        const unsigned old = xb_add(&bar[XB_XSUB(b.x)], 1u);
        const unsigned gen = old / nloc;
        if (old + 1u == (gen + 1u) * nloc) {
            __builtin_amdgcn_fence(__ATOMIC_RELEASE, "agent");
            asm volatile("s_waitcnt vmcnt(0)" ::: "memory");
            const unsigned og = xb_add(&bar[XB_TOP], 1u);
            const unsigned tg = og / nx;
            if (og + 1u == (tg + 1u) * nx) xb_add(&bar[XB_TOPGEN], 1u);
            else XB_SPIN(xb_ld(&bar[XB_TOPGEN]) == tg, bar);
            __builtin_amdgcn_fence(__ATOMIC_ACQUIRE, "agent");
            xb_add(&bar[XB_XGEN(b.x)], 1u);
            asm volatile("s_waitcnt vmcnt(0)" ::: "memory");
        } else {
            XB_SPIN(xb_ld(&bar[XB_XGEN(b.x)]) == gen, bar);
            __builtin_amdgcn_fence(__ATOMIC_ACQUIRE, "agent");
            asm volatile("s_waitcnt vmcnt(0)" ::: "memory");
        }
    }
    __syncthreads();
}

__global__ void __launch_bounds__(NTHR, 2) mega_fwd(Params P) {
    extern __shared__ __attribute__((aligned(16))) unsigned char lds_raw[];
    LAS unsigned char* lds = (LAS unsigned char*)lds_raw;
    cg::grid_group grid = cg::this_grid();
    const int G = gridDim.x, bx = blockIdx.x;
    const int vcu = (G % 8 == 0) ? (bx % 8) * (G / 8) + bx / 8 : bx;
    unsigned char* ws = P.ws;
#ifndef ONLY_PHASE
#define ONLY_PHASE -1
#endif
#define IN(k) ((ONLY_PHASE < 0 || ONLY_PHASE == (k)) && P.ph_lo <= (k) && (k) < P.ph_hi)
    volatile LAS unsigned* bst = (volatile LAS unsigned*)(lds + 131072);
    if (threadIdx.x < 16) bst[threadIdx.x] = 0u;
    __syncthreads();
    const XcdBarrier xbar = xcd_barrier_post((unsigned*)(ws + WS_CTL + 131072), bst);
#define SEAM(k) do { if (IN(k) && IN((k) + 1)) { if ((k) == 0) grid.sync(); else xcd_barrier(xbar); } } while (0)
    for (int rep_ = 0; rep_ < (REPK == 0 ? 2 : 1); ++rep_) if (IN(0)) p0_prologue(P, lds, vcu, G);
    SEAM(0);
    for (int rep_ = 0; rep_ < (REPK == 1 ? 2 : 1); ++rep_) if (IN(1)) {
        pg8::Gemm g{(const bf16_t*)(ws + WS_H), (const bf16_t*)(ws + WS_WIN), T_TOK, 10240, 2048, 2048, 2048};
        pg8::StaticOrder S; S.init(T_TOK, 10240, G, bx);
        pg8::EpiProj E{(bf16_t*)(ws + WS_QKV), (bf16_t*)(ws + WS_SG), LOG2E * 0.08838834764831845f};
        pg8::gemm_phase(lds, g, S, E);
    }
    SEAM(1);
    for (int rep_ = 0; rep_ < (REPK == 2 ? 2 : 1); ++rep_) if (IN(2)) att::attn_phase(P, lds, vcu, G);
    SEAM(2);
    for (int rep_ = 0; rep_ < (REPK == 3 ? 2 : 1); ++rep_) if (IN(3)) {
        pg8::StaticOrder S; S.init(T_TOK, DM, G, bx);
        { pg8::Gemm g{(const bf16_t*)(ws + WS_H), (const bf16_t*)(ws + WS_WAT), T_TOK, DM, 1024, 2048, 1024};
          pg8::EpiGate<0> E{(const bf16_t*)(ws + WS_SG), (float*)(ws + WS_TMP), (bf16_t*)(ws + WS_MERGED)};
          pg8::gemm_phase(lds, g, S, E); }
        { pg8::Gemm g{(const bf16_t*)(ws + WS_H) + 1024, (const bf16_t*)(ws + WS_WBT), T_TOK, DM, 1024, 2048, 1024};
          pg8::EpiGate<1> E{(const bf16_t*)(ws + WS_SG) + 2048, (float*)(ws + WS_TMP), (bf16_t*)(ws + WS_MERGED)};
          pg8::gemm_phase(lds, g, S, E); }
    }
    SEAM(3);
    for (int rep_ = 0; rep_ < (REPK == 4 ? 2 : 1); ++rep_) if (IN(4)) {
        pg8::Gemm g{(const bf16_t*)(ws + WS_MERGED), (const bf16_t*)(ws + WS_WOUT), T_TOK, DM, 2048, 2048, 2048};
        pg8::StaticOrder S; S.init(T_TOK, DM, G, bx);
        pg8::EpiResid E{P.x, (float*)(ws + WS_X1), (bf16_t*)(ws + WS_X1B), (float*)(ws + WS_CTL)};
        pg8::gemm_phase(lds, g, S, E);
    }
    SEAM(4);
    for (int rep_ = 0; rep_ < (REPK == 5 ? 2 : 1); ++rep_) if (IN(5)) {
        pg8::Gemm g{(const bf16_t*)(ws + WS_X1B), (const bf16_t*)(ws + WS_WQ), T_TOK, DM, 2048, 2048, 2048};
        pg8::StaticOrder S; S.init(T_TOK, DM, G, bx);
        pg8::EpiPlainBf16 E{(bf16_t*)(ws + WS_Q2)};
        pg8::gemm_phase(lds, g, S, E);
    }
    SEAM(5);
    for (int rep_ = 0; rep_ < (REPK == 6 ? 2 : 1); ++rep_) if (IN(6)) { if (DBG == 10) peer::topk_naive(P, lds, vcu, G); else peer::topk_phase(P, lds, vcu, G); }
    SEAM(6);
    for (int rep_ = 0; rep_ < (REPK == 7 ? 2 : 1); ++rep_) if (IN(7)) { if (DBG == 11 || DBG == 12) peer::gather_naive(P, vcu, G); else peer::gather_phase(P, vcu, G); }
#undef IN
#undef SEAM
}

extern "C" void kernel_launch(void* const* d_in, const int* in_sizes, int n_in, void* d_out, int out_size, void* d_ws, size_t ws_size, hipStream_t stream) {
    static int grid = 0;
    if (grid == 0) {
        if (n_in != 13 || out_size != T_TOK * DM || ws_size < WS_END) { fprintf(stderr, "kernel_launch: unexpected shapes (n_in %d out %d ws %zu)\n", n_in, out_size, ws_size); grid = -1; return; }
        int dev = 0, cus = 0, per_cu = 0;
        if (hipGetDevice(&dev) != hipSuccess || hipDeviceGetAttribute(&cus, hipDeviceAttributeMultiprocessorCount, dev) != hipSuccess) { grid = -1; return; }
        if (hipFuncSetAttribute((const void*)mega_fwd, hipFuncAttributeMaxDynamicSharedMemorySize, LDS_BYTES) != hipSuccess) { fprintf(stderr, "kernel_launch: hipFuncSetAttribute failed\n"); grid = -1; return; }
        if (hipOccupancyMaxActiveBlocksPerMultiprocessor(&per_cu, (const void*)mega_fwd, NTHR, LDS_BYTES) != hipSuccess || per_cu < 1) { fprintf(stderr, "kernel_launch: occupancy query says %d\n", per_cu); grid = -1; return; }
        grid = cus;
    }
    if (grid < 0) return;
    (void)hipMemsetAsync((char*)d_ws + WS_CTL, 0, 1 * MiB, stream);
    Params p{};
    p.x = (const float*)d_in[0]; p.g_mix = (const float*)d_in[1]; p.w_in = (const float*)d_in[2]; p.b_forget = (const float*)d_in[3];
    p.w_a = (const float*)d_in[4]; p.w_b = (const float*)d_in[5]; p.w_out = (const float*)d_in[6]; p.g_ffn = (const float*)d_in[7];
    p.w_query = (const float*)d_in[8]; p.sub_keys = (const float*)d_in[9]; p.e_u = (const float*)d_in[10]; p.e_v = (const float*)d_in[11]; p.g_final = (const float*)d_in[12];
    p.out = (float*)d_out; p.ws = (unsigned char*)d_ws;
#if MK_N_LAUNCHES == 1
    p.ph_lo = 0; p.ph_hi = N_PHASES;
    void* args[] = {&p};
    hipError_t e = hipLaunchCooperativeKernel((const void*)mega_fwd, dim3(grid), dim3(NTHR), args, LDS_BYTES, stream);
    if (e != hipSuccess) fprintf(stderr, "kernel_launch: cooperative launch failed: %s (grid %d)\n", hipGetErrorString(e), grid);
#else
    for (int ph = 0; ph < N_PHASES; ++ph) { p.ph_lo = ph; p.ph_hi = ph + 1; hipLaunchKernelGGL(mega_fwd, dim3(grid), dim3(NTHR), LDS_BYTES, stream, p); }
#endif
}
```

```cpp
#include <hip/hip_runtime.h>
#include <hip/hip_cooperative_groups.h>
#include <cstdio>
#include <cstdint>
namespace cg = cooperative_groups;

#define LAS __attribute__((address_space(3)))
typedef unsigned short bf16_t;
typedef short bf16x8 __attribute__((ext_vector_type(8)));
typedef short s16x4 __attribute__((ext_vector_type(4)));
typedef float f32x2 __attribute__((ext_vector_type(2)));
typedef float f32x4 __attribute__((ext_vector_type(4)));
typedef float f32x16 __attribute__((ext_vector_type(16)));
typedef unsigned u32x2 __attribute__((ext_vector_type(2)));
typedef unsigned u32x4 __attribute__((ext_vector_type(4)));
typedef __bf16 bf16v2 __attribute__((ext_vector_type(2)));

#ifndef DBG
#define DBG 0
#endif
#ifndef REPK
#define REPK -1
#endif
#ifndef MK_N_LAUNCHES
#define MK_N_LAUNCHES 1
#endif

constexpr int T_TOK = 8192, DM = 2048, SEQ = 4096, HD = 128;
constexpr int NWAVES = 8, NTHR = 512;
constexpr int LDS_BYTES = 147456;
constexpr float LOG2E = 1.4426950408889634f;
constexpr float EPS = 1e-6f;
constexpr int N_PHASES = 8;

constexpr size_t MiB = 1u << 20;
constexpr size_t WS_CTL = 0;
constexpr size_t WS_LOGF = 1 * MiB;
constexpr size_t WS_SKB = 1 * MiB + 512 * 1024;
constexpr size_t WS_IDS = 2 * MiB;
constexpr size_t WS_GATES = 6 * MiB;
constexpr size_t WS_WAT = 10 * MiB, WS_WBT = 14 * MiB, WS_WOUT = 18 * MiB, WS_WQ = 26 * MiB, WS_WIN = 34 * MiB;
constexpr size_t WS_H = 74 * MiB;
constexpr size_t WS_QKV = 106 * MiB;
constexpr size_t WS_TMP = 106 * MiB, WS_MERGED = 170 * MiB, WS_Q2 = 106 * MiB;
constexpr size_t WS_SG = 202 * MiB;
constexpr size_t WS_X1B = 202 * MiB;
constexpr size_t WS_X1 = 266 * MiB;
constexpr size_t WS_EU = 330 * MiB, WS_EV = 362 * MiB;
constexpr size_t WS_SU = 394 * MiB, WS_SV = 394 * MiB + 65536;
constexpr size_t WS_END = 395 * MiB;

struct Params {
    const float* x; const float* g_mix; const float* w_in; const float* b_forget; const float* w_a; const float* w_b; const float* w_out;
    const float* g_ffn; const float* w_query; const float* sub_keys; const float* e_u; const float* e_v; const float* g_final;
    float* out; unsigned char* ws; int ph_lo, ph_hi;
};

__device__ __forceinline__ unsigned pk2(float a, float b) { f32x2 v = {a, b}; return __builtin_bit_cast(unsigned, __builtin_convertvector(v, bf16v2)); }
__device__ __forceinline__ float bf_lo(unsigned u) { return __builtin_bit_cast(float, u << 16); }
__device__ __forceinline__ float bf_hi(unsigned u) { return __builtin_bit_cast(float, u & 0xffff0000u); }
__device__ __forceinline__ float fexp2(float x) { return __builtin_amdgcn_exp2f(x); }
__device__ __forceinline__ float flog2(float x) { return __builtin_amdgcn_logf(x); }
__device__ __forceinline__ float frcp(float x) { return __builtin_amdgcn_rcpf(x); }
__device__ __forceinline__ float wave_sum(float v) {
#pragma unroll
    for (int o = 1; o < 64; o <<= 1) v += __shfl_xor(v, o);
    return v;
}
#define LDS_WAIT() asm volatile("s_waitcnt lgkmcnt(0)" ::: "memory")

namespace pg8 {
constexpr int BM = 256, BK = 64, HALF = 128, HTB = HALF * BK * 2, STAGE_BYTES = 8 * HTB, NXCD = 8, WGM = 8;
__host__ __device__ __forceinline__ int lds_byte(int r, int c) { const int st = (r >> 4) * 2 + (c >> 5), rr = r & 15, cc = c & 31, ob = rr * 64 + cc * 2; return st * 1024 + (ob ^ (((ob >> 9) & 1) << 5)); }
__host__ __device__ __forceinline__ void stage_rc(int b, int& R, int& C) { const int st = b / 1024, sb = b % 1024, swz = sb ^ (((sb >> 9) & 1) << 5); R = (st >> 1) * 16 + swz / 64; C = (st & 1) * 32 + (swz % 64) / 2; }
__host__ __device__ __forceinline__ int perm32(int rho) { const int n = rho >> 4, i = rho & 15; return 8 * (i >> 2) + 4 * n + (i & 3); }
struct Unit { int pm, pn; };
struct Gemm { const bf16_t* A; const bf16_t* Bt; int M, N, K, lda, ldb; };
struct StaticOrder {
    int nM, nN, nwg, G, c;
    __device__ void init(int M, int N, int G_, int c_) { nM = M / BM; nN = N / BM; nwg = nM * nN; G = G_; c = c_; }
    __device__ bool next(int i, Unit& u) const {
        const long L = (long)i * G + c; if (L >= nwg) return false;
        int wgid = (int)L; { const int q = nwg / NXCD, r = nwg % NXCD, xcd = wgid % NXCD, off = wgid / NXCD; wgid = (xcd < r ? xcd * (q + 1) : r * (q + 1) + (xcd - r) * q) + off; }
        const int nig = WGM * nN, gid = wgid / nig, fm = gid * WGM, gsz = (nM - fm) < WGM ? (nM - fm) : WGM;
        u.pm = fm + ((wgid % nig) % gsz); u.pn = (wgid % nig) / gsz; return true;
    }
};
template <class Epi>
__device__ __forceinline__ void gemm_phase(LAS unsigned char* lds, const Gemm g, const StaticOrder& S, const Epi& E) {
    const int tid = threadIdx.x, wid = __builtin_amdgcn_readfirstlane(tid >> 6), lane = tid & 63, wr = wid >> 2, wc = wid & 3, fr = lane & 15, fq = lane >> 4;
    const int K = g.K, nt = K / BK;
    unsigned voffA[2], voffB[2];
#pragma unroll
    for (int i = 0; i < 2; ++i) { int R, C; stage_rc(tid * 16 + i * 8192, R, C); const int Rb = (R & ~31) + perm32(R & 31);
        voffA[i] = (unsigned)(R * g.lda + C) * 2u; voffB[i] = (unsigned)(Rb * g.ldb + C) * 2u; }
    const size_t kstep = (size_t)(BK * 2);
    const size_t hstepA = (size_t)HALF * g.lda * 2, hstepB = (size_t)HALF * g.ldb * 2;
    const size_t tstepA = 2 * hstepA, tstepB = 2 * hstepB;
    const unsigned ldsw = (unsigned)wid * 1024u;
    const int aoff = lds_byte(wr * 64 + fr, fq * 8), boff = lds_byte(wc * 32 + fr, fq * 8);
#define PG8_SA(b, h) (((b) * 2 + (h)) * HTB)
#define PG8_SB(b, h) ((4 + (b) * 2 + (h)) * HTB)
#define PG8_STAGE(bufoff, gbase, voff) do { _Pragma("unroll") for (int _i = 0; _i < 2; ++_i) \
        __builtin_amdgcn_global_load_lds((const unsigned*)((const char*)(gbase) + (voff)[_i]), (LAS unsigned*)(lds + (bufoff) + ldsw + _i * 8192), 16, 0, 0); } while (0)
#define PG8_LDA(dst, b, h) do { _Pragma("unroll") for (int m = 0; m < 4; ++m) _Pragma("unroll") for (int k = 0; k < 2; ++k) dst[m][k] = *(const LAS bf16x8*)(lds + PG8_SA(b, h) + aoff + m * 2048 + k * 1024); } while (0)
#define PG8_LDB(dst, b, h) do { _Pragma("unroll") for (int n = 0; n < 2; ++n) _Pragma("unroll") for (int k = 0; k < 2; ++k) dst[n][k] = *(const LAS bf16x8*)(lds + PG8_SB(b, h) + boff + n * 2048 + k * 1024); } while (0)
#define PG8_MMA(ai, bj, At, Bt) do { __builtin_amdgcn_s_setprio(1); _Pragma("unroll") for (int m = 0; m < 4; ++m) _Pragma("unroll") for (int n = 0; n < 2; ++n) _Pragma("unroll") for (int k = 0; k < 2; ++k) \
        acc[ai][bj][m][n] = __builtin_amdgcn_mfma_f32_16x16x32_bf16(Bt[n][k], At[m][k], acc[ai][bj][m][n], 0, 0, 0); __builtin_amdgcn_s_setprio(0); } while (0)
#define PG8_WAIT_V(n) asm volatile("s_waitcnt vmcnt(" #n ")" ::: "memory")
#define PG8_WAIT_L(n) asm volatile("s_waitcnt lgkmcnt(" #n ")" ::: "memory")
#define PG8_BAR __builtin_amdgcn_s_barrier()
#define PG8_SCHED __builtin_amdgcn_sched_barrier(0)
    Unit cur, nxt; int ui = 0;
    if (!S.next(0, cur)) return;
    f32x4 acc[2][2][4][2];
#pragma unroll
    for (int a = 0; a < 2; ++a)
#pragma unroll
        for (int b = 0; b < 2; ++b)
#pragma unroll
            for (int m = 0; m < 4; ++m)
#pragma unroll
                for (int n = 0; n < 2; ++n) acc[a][b][m][n] = (f32x4){0.f, 0.f, 0.f, 0.f};
    bf16x8 At[4][2], B0[2][2], B1[2][2];
    const char* cA = (const char*)g.A + (size_t)cur.pm * tstepA; const char* cB = (const char*)g.Bt + (size_t)cur.pn * tstepB;
    PG8_STAGE(PG8_SB(0, 0), cB, voffB); PG8_STAGE(PG8_SA(0, 0), cA, voffA); PG8_STAGE(PG8_SB(0, 1), cB + hstepB, voffB); PG8_STAGE(PG8_SA(0, 1), cA + hstepA, voffA);
    if (wr == 1) PG8_BAR;
    PG8_WAIT_V(4); PG8_BAR;
    PG8_STAGE(PG8_SB(1, 0), cB + kstep, voffB); PG8_STAGE(PG8_SA(1, 0), cA + kstep, voffA); PG8_STAGE(PG8_SB(1, 1), cB + hstepB + kstep, voffB);
    PG8_WAIT_V(6); PG8_BAR;
    for (;;) {
        const bool has_next = S.next(ui + 1, nxt);
        const char* nA = has_next ? (const char*)g.A + (size_t)nxt.pm * tstepA : cA; const char* nB = has_next ? (const char*)g.Bt + (size_t)nxt.pn * tstepB : cB;
        for (int t = 0; t < nt; t += 2) {
            const bool last = (t == nt - 2);
            const char* a1 = cA + (size_t)(t + 1) * kstep;
            const char* a2 = last ? nA : cA + (size_t)(t + 2) * kstep; const char* b2 = last ? nB : cB + (size_t)(t + 2) * kstep;
            const char* a3 = a2 + kstep; const char* b3 = b2 + kstep;
            PG8_LDB(B0, 0, 0); PG8_SCHED; PG8_LDA(At, 0, 0); PG8_STAGE(PG8_SA(1, 1), a1 + hstepA, voffA);
            PG8_WAIT_L(8); PG8_BAR; PG8_WAIT_L(0); PG8_MMA(0, 0, At, B0); PG8_BAR; PG8_SCHED;
            PG8_LDB(B1, 0, 1); PG8_STAGE(PG8_SB(0, 0), b2, voffB);
            PG8_BAR; PG8_WAIT_L(0); PG8_MMA(0, 1, At, B1); PG8_BAR;
            PG8_LDA(At, 0, 1); PG8_STAGE(PG8_SA(0, 0), a2, voffA);
            PG8_BAR; PG8_WAIT_L(0); PG8_MMA(1, 0, At, B0); PG8_BAR; PG8_SCHED;
            PG8_STAGE(PG8_SB(0, 1), b2 + hstepB, voffB);
            PG8_WAIT_V(6); PG8_BAR; PG8_MMA(1, 1, At, B1); PG8_BAR;
            PG8_LDB(B0, 1, 0); PG8_SCHED; PG8_LDA(At, 1, 0); PG8_STAGE(PG8_SA(0, 1), a2 + hstepA, voffA);
            PG8_WAIT_L(8); PG8_BAR; PG8_WAIT_L(0); PG8_MMA(0, 0, At, B0); PG8_BAR; PG8_SCHED;
            PG8_LDB(B1, 1, 1); PG8_STAGE(PG8_SB(1, 0), b3, voffB);
            PG8_BAR; PG8_WAIT_L(0); PG8_MMA(0, 1, At, B1); PG8_BAR;
            PG8_LDA(At, 1, 1); PG8_STAGE(PG8_SA(1, 0), a3, voffA);
            PG8_BAR; PG8_WAIT_L(0); PG8_MMA(1, 0, At, B0); PG8_BAR; PG8_SCHED;
            PG8_STAGE(PG8_SB(1, 1), b3 + hstepB, voffB);
            PG8_WAIT_V(6); PG8_BAR; PG8_MMA(1, 1, At, B1); PG8_BAR;
        }
        E(acc, cur, wr, wc, fr, fq);
        if (!has_next) break;
#pragma unroll
        for (int a = 0; a < 2; ++a)
#pragma unroll
            for (int b = 0; b < 2; ++b)
#pragma unroll
                for (int m = 0; m < 4; ++m)
#pragma unroll
                    for (int n = 0; n < 2; ++n) acc[a][b][m][n] = (f32x4){0.f, 0.f, 0.f, 0.f};
        cur = nxt; cA = nA; cB = nB; ++ui;
    }
    PG8_WAIT_V(0);
    if (wr == 0) PG8_BAR;
    PG8_BAR;
#undef PG8_SA
#undef PG8_SB
#undef PG8_STAGE
#undef PG8_LDA
#undef PG8_LDB
#undef PG8_MMA
#undef PG8_WAIT_V
#undef PG8_WAIT_L
#undef PG8_BAR
#undef PG8_SCHED
}

struct EpiProj {
    bf16_t* qkv; bf16_t* sg; float qscale; unsigned* kmaxw;
    __device__ __forceinline__ void operator()(const f32x4 (&acc)[2][2][4][2], const Unit& u, int wr, int wc, int fr, int fq) const {
        const int row0 = u.pm * BM + wr * 64 + fr;
        if (u.pn < 24) {
            const int t = u.pn >> 2; bf16_t* base = qkv + (size_t)t * ((size_t)T_TOK * 1024) + (u.pn & 3) * 256 + wc * 32 + 8 * fq;
            const float sc = (t == 0 || t == 3) ? qscale : 1.f;
            if (t == 4) {
#pragma unroll
                for (int bj = 0; bj < 2; ++bj) { float mxv = 0.f;
#pragma unroll
                    for (int ai = 0; ai < 2; ++ai)
#pragma unroll
                        for (int m = 0; m < 4; ++m) { const f32x4 v0 = acc[ai][bj][m][0], v1 = acc[ai][bj][m][1];
                            float ssq = (v0[0] * v0[0] + v0[1] * v0[1]) + (v0[2] * v0[2] + v0[3] * v0[3]) + (v1[0] * v1[0] + v1[1] * v1[1]) + (v1[2] * v1[2] + v1[3] * v1[3]);
                            ssq += __shfl_xor(ssq, 16); ssq += __shfl_xor(ssq, 32); mxv = fmaxf(mxv, ssq); }
#pragma unroll
                    for (int o = 1; o < 16; o <<= 1) mxv = fmaxf(mxv, __shfl_xor(mxv, o));
                    if ((fr | fq) == 0) atomicMax(kmaxw + ((u.pm >> 4) * 8 + (u.pn & 3) * 2 + bj) * 4 + wc, __builtin_bit_cast(unsigned, mxv)); }
            }
#pragma unroll
            for (int ai = 0; ai < 2; ++ai)
#pragma unroll
                for (int m = 0; m < 4; ++m) { bf16_t* rowp = base + (size_t)(row0 + ai * HALF + m * 16) * 1024;
#pragma unroll
                    for (int bj = 0; bj < 2; ++bj) { const f32x4 v0 = acc[ai][bj][m][0] * sc, v1 = acc[ai][bj][m][1] * sc;
                        u32x4 w; w.x = pk2(v0[0], v0[1]); w.y = pk2(v0[2], v0[3]); w.z = pk2(v1[0], v1[1]); w.w = pk2(v1[2], v1[3]);
                        *(u32x4*)(rowp + bj * HALF) = w; } }
        } else {
            bf16_t* base = sg + (u.pn - 24) * 256 + wc * 32 + 8 * fq;
#pragma unroll
            for (int ai = 0; ai < 2; ++ai)
#pragma unroll
                for (int m = 0; m < 4; ++m) { bf16_t* rowp = base + (size_t)(row0 + ai * HALF + m * 16) * 4096;
#pragma unroll
                    for (int bj = 0; bj < 2; ++bj) { float s[8];
#pragma unroll
                        for (int e = 0; e < 4; ++e) { s[e] = frcp(1.f + fexp2(-LOG2E * acc[ai][bj][m][0][e])); s[4 + e] = frcp(1.f + fexp2(-LOG2E * acc[ai][bj][m][1][e])); }
                        u32x4 w; w.x = pk2(s[0], s[1]); w.y = pk2(s[2], s[3]); w.z = pk2(s[4], s[5]); w.w = pk2(s[6], s[7]);
                        *(u32x4*)(rowp + bj * HALF) = w; } }
        }
    }
};
template <int SECOND> struct EpiGate {
    const bf16_t* sg;
    float* tmp; bf16_t* merged;
    __device__ __forceinline__ void operator()(const f32x4 (&acc)[2][2][4][2], const Unit& u, int wr, int wc, int fr, int fq) const {
        const int row0 = u.pm * BM + wr * 64 + fr, col0 = u.pn * BM + wc * 32 + 8 * fq;
#pragma unroll
        for (int ai = 0; ai < 2; ++ai)
#pragma unroll
            for (int m = 0; m < 4; ++m) { const size_t row = (size_t)(row0 + ai * HALF + m * 16);
#pragma unroll
                for (int bj = 0; bj < 2; ++bj) { const int col = col0 + bj * HALF;
                    const u32x4 gv = *(const u32x4*)(sg + row * 4096 + col);
                    const f32x4 g0 = {bf_lo(gv.x), bf_hi(gv.x), bf_lo(gv.y), bf_hi(gv.y)}, g1 = {bf_lo(gv.z), bf_hi(gv.z), bf_lo(gv.w), bf_hi(gv.w)};
                    f32x4 v0 = acc[ai][bj][m][0] * g0, v1 = acc[ai][bj][m][1] * g1;
                    float* tp = tmp + row * DM + col;
                    if (SECOND == 0) { *(f32x4*)tp = v0; *(f32x4*)(tp + 4) = v1; }
                    else { v0 += *(const f32x4*)tp; v1 += *(const f32x4*)(tp + 4);
                        u32x4 w; w.x = pk2(v0[0], v0[1]); w.y = pk2(v0[2], v0[3]); w.z = pk2(v1[0], v1[1]); w.w = pk2(v1[2], v1[3]);
                        *(u32x4*)(merged + row * DM + col) = w; } } }
    }
};
struct EpiResid {
    const float* x; float* x1; bf16_t* x1b; float* rowss;
    __device__ __forceinline__ void operator()(const f32x4 (&acc)[2][2][4][2], const Unit& u, int wr, int wc, int fr, int fq) const {
        const int row0 = u.pm * BM + wr * 64 + fr, col0 = u.pn * BM + wc * 32 + 8 * fq;
#pragma unroll
        for (int ai = 0; ai < 2; ++ai)
#pragma unroll
            for (int m = 0; m < 4; ++m) { const size_t row = (size_t)(row0 + ai * HALF + m * 16); float ss = 0.f;
#pragma unroll
                for (int bj = 0; bj < 2; ++bj) { const size_t o = row * DM + col0 + bj * HALF;
                    const f32x4 v0 = (DBG == 2 ? 0.f : 1.f) * acc[ai][bj][m][0] + *(const f32x4*)(x + o), v1 = (DBG == 2 ? 0.f : 1.f) * acc[ai][bj][m][1] + *(const f32x4*)(x + o + 4);
                    *(f32x4*)(x1 + o) = v0; *(f32x4*)(x1 + o + 4) = v1;
                    u32x4 w; w.x = pk2(v0[0], v0[1]); w.y = pk2(v0[2], v0[3]); w.z = pk2(v1[0], v1[1]); w.w = pk2(v1[2], v1[3]);
                    *(u32x4*)(x1b + o) = w;
                    ss += (v0[0] * v0[0] + v0[1] * v0[1]) + (v0[2] * v0[2] + v0[3] * v0[3]) + (v1[0] * v1[0] + v1[1] * v1[1]) + (v1[2] * v1[2] + v1[3] * v1[3]); }
                ss += __shfl_xor(ss, 16); ss += __shfl_xor(ss, 32);
                if (fq == 0) atomicAdd(rowss + row, ss); }
    }
};
struct EpiPlainBf16 {
    bf16_t* o;
    __device__ __forceinline__ void operator()(const f32x4 (&acc)[2][2][4][2], const Unit& u, int wr, int wc, int fr, int fq) const {
        const int row0 = u.pm * BM + wr * 64 + fr, col0 = u.pn * BM + wc * 32 + 8 * fq;
#pragma unroll
        for (int ai = 0; ai < 2; ++ai)
#pragma unroll
            for (int m = 0; m < 4; ++m) { const size_t row = (size_t)(row0 + ai * HALF + m * 16);
#pragma unroll
                for (int bj = 0; bj < 2; ++bj) { const f32x4 v0 = acc[ai][bj][m][0], v1 = acc[ai][bj][m][1];
                    u32x4 w; w.x = pk2(v0[0], v0[1]); w.y = pk2(v0[2], v0[3]); w.z = pk2(v1[0], v1[1]); w.w = pk2(v1[2], v1[3]);
                    *(u32x4*)(o + row * DM + col0 + bj * HALF) = w; } }
    }
};
}

__device__ __forceinline__ void transpose_item(const float* W, int ldw, int src_n0, bf16_t* WT, int K, int dst_n0, int k0, LAS float* scr, int lane, const float* kscale) {
#pragma unroll 8
    for (int i = 0; i < 32; ++i) { const int kk = 2 * i + (lane >> 5); float v = W[(size_t)(k0 + kk) * ldw + src_n0 + (lane & 31)]; if (kscale) v *= kscale[k0 + kk]; scr[kk * 33 + (lane & 31)] = v; }
    LDS_WAIT();
    const int c = lane & 7;
#pragma unroll
    for (int j = 0; j < 4; ++j) { const int n = (lane >> 3) + 8 * j; const LAS float* s = scr + (8 * c) * 33 + n;
        u32x4 o; o.x = pk2(s[0 * 33], s[1 * 33]); o.y = pk2(s[2 * 33], s[3 * 33]); o.z = pk2(s[4 * 33], s[5 * 33]); o.w = pk2(s[6 * 33], s[7 * 33]);
        *(u32x4*)(WT + (size_t)(dst_n0 + n) * K + k0 + 8 * c) = o; }
    LDS_WAIT();
}

__device__ __forceinline__ void p0_prologue(const Params& P, LAS unsigned char* lds, int vcu, int G) {
    const int tid = threadIdx.x, lane = tid & 63, wave = __builtin_amdgcn_readfirstlane(tid >> 6);
    const int gw = vcu * NWAVES + wave, NGW = G * NWAVES;
    unsigned char* ws = P.ws;
    {
        LAS float* scr = (LAS float*)(lds + wave * 16384);
        constexpr int I_IN = 32 * 320;
        for (int it = gw; it < I_IN; it += NGW) { const int kb = it / 320, nb = it % 320, dn = nb * 32;
            transpose_item(P.w_in, 10248, dn < 6144 ? dn : dn + 8, (bf16_t*)(ws + WS_WIN), 2048, dn, kb * 64, scr, lane, nullptr); }
    }
    __syncthreads();
    {
        LAS float* wf = (LAS float*)lds;
        for (int idx = tid; idx < 2048 * 8; idx += NTHR) { const int k = idx >> 3, c = idx & 7; wf[c * 2048 + k] = P.w_in[(size_t)k * 10248 + 6144 + c]; }
        __syncthreads();
        bf16_t* H = (bf16_t*)(ws + WS_H); float* LOGF = (float*)(ws + WS_LOGF);
        for (int r = gw; r < T_TOK; r += NGW) {
            const f32x4* xr = (const f32x4*)(P.x + (size_t)r * DM) + lane;
            float ss = 0.f;
#pragma unroll
            for (int j = 0; j < 8; ++j) { const f32x4 v = xr[64 * j]; ss += (v[0] * v[0] + v[1] * v[1]) + (v[2] * v[2] + v[3] * v[3]); }
            const float rstd = 1.0f / sqrtf(wave_sum(ss) * (1.f / DM) + EPS);
            float fl[8];
#pragma unroll
            for (int c = 0; c < 8; ++c) fl[c] = 0.f;
            u32x2* hp = (u32x2*)(H + (size_t)r * DM) + lane;
#pragma unroll 1
            for (int j = 0; j < 8; ++j) { const f32x4 gn = *((const f32x4*)P.g_mix + lane + 64 * j); const f32x4 hv = xr[64 * j] * rstd * gn;
                u32x2 o; o.x = pk2(hv[0], hv[1]); o.y = pk2(hv[2], hv[3]); hp[64 * j] = o;
#pragma unroll
                for (int c = 0; c < 8; ++c) { const f32x4 wv = *((const LAS f32x4*)(wf + c * 2048) + lane + 64 * j); fl[c] += (hv[0] * wv[0] + hv[1] * wv[1]) + (hv[2] * wv[2] + hv[3] * wv[3]); } }
#pragma unroll
            for (int c = 0; c < 8; ++c) fl[c] = wave_sum(fl[c]);
            if (lane == 0) {
#pragma unroll
                for (int c = 0; c < 8; ++c) { const float y = fl[c] + P.b_forget[c]; LOGF[(size_t)r * 8 + c] = fminf(y, 0.f) - log1pf(expf(-fabsf(y))); }
            }
        }
    }
    {
        const size_t gid = (size_t)vcu * NTHR + tid, gstride = (size_t)G * NTHR;
        for (size_t i = gid; i < 262144 / 8; i += gstride) { const float* src = P.sub_keys + i * 8; const f32x4 a = *(const f32x4*)src, b = *((const f32x4*)src + 1);
            u32x4 o; o.x = pk2(a[0], a[1]); o.y = pk2(a[2], a[3]); o.z = pk2(b[0], b[1]); o.w = pk2(b[2], b[3]); *(u32x4*)((bf16_t*)(ws + WS_SKB) + i * 8) = o; }
    }
}
__device__ __forceinline__ void late_transposes(const Params& P, LAS unsigned char* lds, int vcu, int G) {
    const int tid = threadIdx.x, lane = tid & 63, wave = __builtin_amdgcn_readfirstlane(tid >> 6);
    const int gw = vcu * NWAVES + wave, NGW = G * NWAVES;
    unsigned char* ws = P.ws;
    LAS float* scr = (LAS float*)(lds + wave * 16384);
    constexpr int I_A = 16 * 64, I_O = 32 * 64, NITEMS = 2 * I_A + 2 * I_O;
    for (int it = gw; it < NITEMS; it += NGW) {
        int r = it;
        if (r < I_A) { const int kb = r / 64, nb = r % 64; transpose_item(P.w_a, 2048, nb * 32, (bf16_t*)(ws + WS_WAT), 1024, nb * 32, kb * 64, scr, lane, nullptr); continue; } r -= I_A;
        if (r < I_A) { const int kb = r / 64, nb = r % 64; transpose_item(P.w_b, 2048, nb * 32, (bf16_t*)(ws + WS_WBT), 1024, nb * 32, kb * 64, scr, lane, nullptr); continue; } r -= I_A;
        if (r < I_O) { const int kb = r / 64, nb = r % 64; transpose_item(P.w_out, 2048, nb * 32, (bf16_t*)(ws + WS_WOUT), 2048, nb * 32, kb * 64, scr, lane, nullptr); continue; } r -= I_O;
        { const int kb = r / 64, nb = r % 64; transpose_item(P.w_query, 2048, nb * 32, (bf16_t*)(ws + WS_WQ), 2048, nb * 32, kb * 64, scr, lane, P.g_ffn); }
    }
}
__device__ __forceinline__ void quantise_experts(const Params& P, int vcu, int G) {
    const int tid = threadIdx.x, lane = tid & 63, wave = __builtin_amdgcn_readfirstlane(tid >> 6);
    const int gw = vcu * NWAVES + wave, NGW = G * NWAVES;
    unsigned char* ws = P.ws;
    float* SU = (float*)(ws + WS_SU); float* SV = (float*)(ws + WS_SV);
    for (int r = gw; r < 2 * 16384; r += NGW) {
        const bool second = r >= 16384; const int row = second ? r - 16384 : r;
        const f32x4* src = (const f32x4*)((second ? P.e_v : P.e_u) + (size_t)row * DM) + lane;
        f32x4 v[8]; float mx = 0.f;
#pragma unroll
        for (int j = 0; j < 8; ++j) { v[j] = __builtin_nontemporal_load(src + 64 * j); mx = fmaxf(mx, fmaxf(fmaxf(fabsf(v[j][0]), fabsf(v[j][1])), fmaxf(fabsf(v[j][2]), fabsf(v[j][3])))); }
#pragma unroll
        for (int o = 1; o < 64; o <<= 1) mx = fmaxf(mx, __shfl_xor(mx, o));
        mx = fmaxf(mx, 1e-30f);
        const float inv = 127.f / mx; const int bias = second ? 128 : 0;
        unsigned* dst = (unsigned*)(ws + (second ? WS_EV : WS_EU) + (size_t)row * DM) + lane;
#pragma unroll
        for (int j = 0; j < 8; ++j) { unsigned w = 0;
#pragma unroll
            for (int e = 0; e < 4; ++e) { const int q = (int)__builtin_rintf(v[j][e] * inv) + bias; w |= ((unsigned)q & 255u) << (8 * e); }
            dst[64 * j] = w; }
        if (lane == 0) (second ? SV : SU)[row] = mx * (1.f / 127.f);
    }
}

namespace att {
constexpr int KST = 272, VST = 320;
constexpr int KBUF = 64 * KST, VBUF = 64 * VST;
constexpr int OFF_K = 0, OFF_V = 2 * KBUF, OFF_F = OFF_V + 2 * VBUF, OFF_SC = OFF_F + 4096 * 4;
constexpr int OFF_FLG = OFF_SC + 64, OFF_UNIT = OFF_FLG + 64;
static_assert(OFF_UNIT + 16 <= 131072, "attention LDS");
constexpr float THR_SB = 40.f, THR_FOX = 30.f;

__device__ __forceinline__ void build_cumf(LAS unsigned char* lds, const float* LOGF, int b, int h, int n, int tid, int lane, int wid) {
    LAS float* F2 = (LAS float*)(lds + OFF_F); LAS float* sc = (LAS float*)(lds + OFF_SC);
    const int s0 = tid * 8; float v[8];
#pragma unroll
    for (int i = 0; i < 8; ++i) v[i] = (s0 < n) ? LOGF[((size_t)b * SEQ + s0 + i) * 8 + h] * LOG2E : 0.f;
#pragma unroll
    for (int i = 1; i < 8; ++i) v[i] += v[i - 1];
    float tot = v[7], inc = tot;
#pragma unroll
    for (int o = 1; o < 64; o <<= 1) { const float t = __shfl_up(inc, o); if (lane >= o) inc += t; }
    if (lane == 63) sc[wid] = inc;
    __syncthreads();
    float base = inc - tot;
#pragma unroll
    for (int w = 0; w < 8; ++w) if (w < wid) base += sc[w];
    if (s0 < n) {
#pragma unroll
        for (int i = 0; i < 8; ++i) F2[s0 + i] = v[i] + base;
    }
    __syncthreads();
}

template <int MIXER>
__device__ __forceinline__ void attn_unit(LAS unsigned char* lds, const bf16_t* Q, const bf16_t* Kg, const bf16_t* Vg, bf16_t* O, int b, int h, int qb, float kmax, int tid, int lane, int wid) {
    const int c = lane & 31, hh = lane >> 5;
    const int t0 = qb * 256 + wid * 32, tq = t0 + c;
    const size_t rowbase = (size_t)b * SEQ;
    size_t qoff = (rowbase + tq) * 1024 + h * HD + 8 * hh;
    f32x16 oacc[4];
#pragma unroll
    for (int d = 0; d < 4; ++d)
#pragma unroll
        for (int r = 0; r < 16; ++r) oacc[d][r] = 0.f;
    float carry = 0.f, mrun = -1e30f, lsum = 0.f; const float nhf = hh ? 0.f : 1.f;
    const LAS float* F2 = (const LAS float*)(lds + OFF_F);
    const float Ft = (MIXER == 1) ? F2[tq] : 0.f;
    float qk_bound = 0.f;
    if (MIXER == 1) { float qs = 0.f;
#pragma unroll
        for (int s2 = 0; s2 < 8; ++s2) { const u32x4 qv = *(const u32x4*)(Q + qoff + 16 * s2);
#pragma unroll
            for (int e = 0; e < 4; ++e) { const float a = bf_lo(qv[e]), b2 = bf_hi(qv[e]); qs += a * a + b2 * b2; } }
        qs += __shfl_xor(qs, 32);
        qk_bound = sqrtf(qs) * kmax; }
    bool wave_done = false;
    volatile LAS unsigned* flg = (volatile LAS unsigned*)(lds + OFF_FLG);
    const int ktmax = 4 * qb + 3;
    const int srow = tid >> 4, scc = tid & 15;
    u32x4 kr[2], vr[2];
#define ATT_LOAD(kt) do { _Pragma("unroll") for (int j = 0; j < 2; ++j) { const size_t g_ = (rowbase + 64 * (kt) + srow + 32 * j) * 1024 + h * HD + scc * 8; \
        kr[j] = *(const u32x4*)(Kg + g_); vr[j] = *(const u32x4*)(Vg + g_); } } while (0)
#define ATT_WRITE(buf) do { _Pragma("unroll") for (int j = 0; j < 2; ++j) { \
        *(LAS u32x4*)(lds + OFF_K + (buf) * KBUF + (srow + 32 * j) * KST + scc * 16) = kr[j]; \
        *(LAS u32x4*)(lds + OFF_V + (buf) * VBUF + (srow + 32 * j) * VST + scc * 16) = vr[j]; } } while (0)
    ATT_LOAD(ktmax); ATT_WRITE(0); __syncthreads();
    int buf = 0;
    for (int kt = ktmax; kt >= 0; --kt) {
        if (kt > 0) ATT_LOAD(kt - 1);
        const bool started = (64 * kt <= t0 + 31);
        if (started && !wave_done) {
            const LAS unsigned char* Kl = lds + OFF_K + buf * KBUF; const LAS unsigned char* Vl = lds + OFF_V + buf * VBUF;
            f32x16 sacc[2];
            asm volatile("" : "+v"(qoff));
            bf16x8 qf[8];
#pragma unroll
            for (int s = 0; s < 8; ++s) qf[s] = *(const bf16x8*)(Q + qoff + 16 * s);
#pragma unroll
            for (int sub = 0; sub < 2; ++sub) {
#pragma unroll
                for (int r = 0; r < 16; ++r) sacc[sub][r] = 0.f;
#pragma unroll
                for (int s = 0; s < 8; ++s) { const bf16x8 kf = *(const LAS bf16x8*)(Kl + (32 * sub + c) * KST + (16 * s + 8 * hh) * 2);
                    sacc[sub] = __builtin_amdgcn_mfma_f32_32x32x16_bf16(kf, qf[s], sacc[sub], 0, 0, 0); }
            }
            const bool need_mask = (64 * kt + 63 >= t0);
            if (MIXER == 0) {
#pragma unroll
                for (int sub = 1; sub >= 0; --sub) {
                    float lb[16];
#pragma unroll
                    for (int r = 0; r < 16; ++r) { const float z = sacc[sub][r]; float l = -flog2(1.f + fexp2(z));
                        if (need_mask) { const int sidx = 64 * kt + 32 * sub + (r & 3) + 8 * (r >> 2) + 4 * hh; l = (sidx < tq) ? l : 0.f; }
                        lb[r] = l; }
                    float Glo[4], Ghi[4];
#pragma unroll
                    for (int g = 0; g < 4; ++g) { lb[4 * g + 2] += lb[4 * g + 3]; lb[4 * g + 1] += lb[4 * g + 2]; lb[4 * g] += lb[4 * g + 1];
                        const unsigned gu = __builtin_bit_cast(unsigned, lb[4 * g]); const auto rr = __builtin_amdgcn_permlane32_swap(gu, gu, false, false);
                        Glo[g] = __builtin_bit_cast(float, (unsigned)rr[0]); Ghi[g] = __builtin_bit_cast(float, (unsigned)rr[1]); }
                    float E[8];
                    E[7] = carry; E[6] = E[7] + Ghi[3]; E[5] = E[6] + Glo[3]; E[4] = E[5] + Ghi[2]; E[3] = E[4] + Glo[2]; E[2] = E[3] + Ghi[1]; E[1] = E[2] + Glo[1]; E[0] = E[1] + Ghi[0];
                    carry = E[0] + Glo[0];
#pragma unroll
                    for (int g = 0; g < 4; ++g) { const float Eo = __builtin_fmaf(nhf, Ghi[g], E[2 * g + 1]);
#pragma unroll
                        for (int i = 0; i < 4; ++i) { const int r = 4 * g + i; float w = fexp2(sacc[sub][r] + lb[r] + Eo);
                            if (need_mask) { const int sidx = 64 * kt + 32 * sub + (r & 3) + 8 * (r >> 2) + 4 * hh; w = (sidx < tq) ? w : 0.f; }
                            sacc[sub][r] = w; } }
                }
            } else {
                float mx = -1e30f;
#pragma unroll
                for (int sub = 0; sub < 2; ++sub)
#pragma unroll
                    for (int g = 0; g < 4; ++g) { const f32x4 fs = *(const LAS f32x4*)(F2 + 64 * kt + 32 * sub + 8 * g + 4 * hh);
#pragma unroll
                        for (int i = 0; i < 4; ++i) { const int r = 4 * g + i; float xv = sacc[sub][r] + (Ft - fs[i]);
                            if (need_mask) { const int sidx = 64 * kt + 32 * sub + 8 * g + 4 * hh + i; xv = (sidx <= tq) ? xv : -1e30f; }
                            sacc[sub][r] = xv; mx = fmaxf(mx, xv); } }
                { const unsigned mu = __builtin_bit_cast(unsigned, mx); const auto rr = __builtin_amdgcn_permlane32_swap(mu, mu, false, false);
                  mx = fmaxf(__builtin_bit_cast(float, (unsigned)rr[0]), __builtin_bit_cast(float, (unsigned)rr[1])); }
                const float mnew = fmaxf(mrun, mx);
                const float alpha = fexp2(mrun - mnew);
                float ps = 0.f;
#pragma unroll
                for (int sub = 0; sub < 2; ++sub)
#pragma unroll
                    for (int r = 0; r < 16; ++r) { const float p = fexp2(sacc[sub][r] - mnew); sacc[sub][r] = p; ps += p; }
                lsum = lsum * alpha + ps;
                if (__any(mnew > mrun)) {
#pragma unroll
                    for (int d = 0; d < 4; ++d)
#pragma unroll
                        for (int r = 0; r < 16; ++r) oacc[d][r] *= alpha;
                }
                mrun = mnew;
            }
#pragma unroll
            for (int ks = 0; ks < 4; ++ks) { const int sub = ks >> 1, rb = 8 * (ks & 1);
                u32x4 pw; pw.x = pk2(sacc[sub][rb + 0], sacc[sub][rb + 1]); pw.y = pk2(sacc[sub][rb + 2], sacc[sub][rb + 3]); pw.z = pk2(sacc[sub][rb + 4], sacc[sub][rb + 5]); pw.w = pk2(sacc[sub][rb + 6], sacc[sub][rb + 7]);
                const bf16x8 pf = __builtin_bit_cast(bf16x8, pw);
                const LAS unsigned char* vb = Vl + (16 * ks + 4 * hh + ((lane & 15) >> 2)) * VST + (16 * ((lane >> 4) & 1) + 4 * (lane & 3)) * 2;
#pragma unroll
                for (int d = 0; d < 4; ++d) {
                    const s16x4 a0 = __builtin_amdgcn_ds_read_tr16_b64_v4i16((LAS s16x4*)(vb + d * 64));
                    const s16x4 a1 = __builtin_amdgcn_ds_read_tr16_b64_v4i16((LAS s16x4*)(vb + d * 64 + 8 * VST));
                    const bf16x8 af = {a0[0], a0[1], a0[2], a0[3], a1[0], a1[1], a1[2], a1[3]};
                    oacc[d] = __builtin_amdgcn_mfma_f32_32x32x16_bf16(af, pf, oacc[d], 0, 0, 0); }
            }
        }
        if (kt > 0) ATT_WRITE(buf ^ 1);
        if (kt > 0 && started && !wave_done) {
            if (MIXER == 0) wave_done = __all(carry < -THR_SB);
            else wave_done = __all(qk_bound + (Ft - F2[64 * kt - 1]) - mrun < -THR_FOX);
        }
        if (lane == 0) flg[(kt & 1) * 8 + wid] = wave_done ? 1u : 0u;
        __syncthreads();
        buf ^= 1;
        { unsigned alld = 1u;
#pragma unroll
          for (int w = 0; w < 8; ++w) alld &= flg[(kt & 1) * 8 + w];
          if (alld) break; }
    }
#undef ATT_LOAD
#undef ATT_WRITE
    float inv = 1.f;
    if (MIXER == 1) { const unsigned lu = __builtin_bit_cast(unsigned, lsum); const auto rr = __builtin_amdgcn_permlane32_swap(lu, lu, false, false);
        inv = 1.f / (__builtin_bit_cast(float, (unsigned)rr[0]) + __builtin_bit_cast(float, (unsigned)rr[1])); }
    bf16_t* op = O + (rowbase + tq) * 2048 + 4 * hh;
#pragma unroll
    for (int d = 0; d < 4; ++d)
#pragma unroll
        for (int g = 0; g < 4; ++g) { u32x2 w; w.x = pk2(oacc[d][4 * g] * inv, oacc[d][4 * g + 1] * inv); w.y = pk2(oacc[d][4 * g + 2] * inv, oacc[d][4 * g + 3] * inv);
            *(u32x2*)(op + 32 * d + 8 * g) = w; }
}

__device__ __forceinline__ void attn_phase(const Params& P, LAS unsigned char* lds, int vcu, int G) {
    const int tid = threadIdx.x, lane = tid & 63, wid = __builtin_amdgcn_readfirstlane(tid >> 6);
    unsigned char* ws = P.ws;
    const bf16_t* QKV = (const bf16_t*)(ws + WS_QKV); const size_t TS = (size_t)T_TOK * 1024;
    bf16_t* OAB = (bf16_t*)(ws + WS_H); const float* LOGF = (const float*)(ws + WS_LOGF);
    unsigned* qctr = (unsigned*)(ws + WS_CTL + 196608);
    const unsigned* KMAXW = (const unsigned*)(ws + WS_CTL + 200704);
    volatile LAS unsigned* uw = (volatile LAS unsigned*)(lds + OFF_UNIT);
    for (;;) {
        if (tid == 0) uw[0] = atomicAdd(qctr, 1u);
        __syncthreads();
        const unsigned u = uw[0];
        __syncthreads();
        if (u >= 512u) break;
        const int mixer = (u < 256u) ? 1 : 0, v = (int)(u & 255u), qb = 15 - (v >> 4), bh = v & 15, b = bh >> 3, h = bh & 7;
        if (mixer == 0) {
            attn_unit<0>(lds, QKV, QKV + TS, QKV + 2 * TS, OAB + h * HD, b, h, qb, 0.f, tid, lane, wid);
        } else {
            float k2 = 0.f;
#pragma unroll
            for (int w = 0; w < 4; ++w) k2 += __builtin_bit_cast(float, __hip_atomic_load(KMAXW + bh * 4 + w, __ATOMIC_RELAXED, __HIP_MEMORY_SCOPE_AGENT));
            const float kmax = sqrtf(k2) * 1.01f;
            build_cumf(lds, LOGF, b, h, 256 * (qb + 1), tid, lane, wid);
            attn_unit<1>(lds, QKV + 3 * TS, QKV + 4 * TS, QKV + 5 * TS, OAB + 1024 + h * HD, b, h, qb, kmax, tid, lane, wid);
        }
        __syncthreads();
    }
}
}

namespace peer {
__device__ __forceinline__ unsigned sortable(float f) { const unsigned u = __builtin_bit_cast(unsigned, f); return (u & 0x80000000u) ? ~u : (u | 0x80000000u); }
__device__ __forceinline__ float unsortable(unsigned k) { const unsigned u = (k & 0x80000000u) ? (k & 0x7fffffffu) : ~k; return __builtin_bit_cast(float, u); }
template <int N> __device__ __forceinline__ unsigned umax_all(const unsigned (&k)[N]) {
    unsigned m = k[0];
#pragma unroll
    for (int q = 1; q < N; ++q) m = m > k[q] ? m : k[q];
    return m;
}

__device__ __forceinline__ void topk_phase(const Params& P, LAS unsigned char* lds, int vcu, int G) {
    const int tid = threadIdx.x, lane = tid & 63, wave = __builtin_amdgcn_readfirstlane(tid >> 6);
    const int c = lane & 31, hh = lane >> 5;
    const int gw = vcu * NWAVES + wave, NGW = G * NWAVES;
    unsigned char* ws = P.ws;
    const bf16_t* Q2 = (const bf16_t*)(ws + WS_Q2); const bf16_t* SKB = (const bf16_t*)(ws + WS_SKB);
    const float* ROWSS = (const float*)(ws + WS_CTL); int* IDS = (int*)(ws + WS_IDS); float* GATES = (float*)(ws + WS_GATES);
    LAS unsigned char* scr = lds + wave * 4096;
    for (int task = gw; task < 2048; task += NGW) {
        const int tg = task >> 3, hd = task & 7, tok = tg * 32 + c;
#pragma unroll 1
        for (int p = 0; p < 2; ++p) {
            bf16x8 qf[8];
            { const bf16_t* qp = Q2 + (size_t)tok * DM + hd * 256 + p * 128 + 8 * hh;
#pragma unroll
              for (int s = 0; s < 8; ++s) qf[s] = *(const bf16x8*)(qp + 16 * s); }
            unsigned keys[64];
#pragma unroll
            for (int sub = 0; sub < 4; ++sub) {
                f32x16 acc;
#pragma unroll
                for (int r = 0; r < 16; ++r) acc[r] = 0.f;
                const bf16_t* kp = SKB + ((size_t)(hd * 2 + p) * 128 + 32 * sub + c) * 128 + 8 * hh;
#pragma unroll
                for (int s = 0; s < 8; ++s) { const bf16x8 kf = *(const bf16x8*)(kp + 16 * s); acc = __builtin_amdgcn_mfma_f32_32x32x16_bf16(kf, qf[s], acc, 0, 0, 0); }
#pragma unroll
                for (int r = 0; r < 16; ++r) { const int nlo = 127 - (32 * sub + (r & 3) + 8 * (r >> 2)); keys[sub * 16 + r] = (sortable(acc[r]) & ~127u) | (unsigned)(nlo - 4 * hh); }
            }
            unsigned top[16];
#pragma unroll
            for (int i = 0; i < 16; ++i) {
                unsigned m = umax_all<64>(keys);
                const auto rr = __builtin_amdgcn_permlane32_swap(m, m, false, false);
                m = (unsigned)rr[0] > (unsigned)rr[1] ? (unsigned)rr[0] : (unsigned)rr[1];
                top[i] = m;
#pragma unroll
                for (int q = 0; q < 64; ++q) keys[q] = (keys[q] == m) ? 0u : keys[q];
            }
            if (hh == 0) {
#pragma unroll
                for (int w = 0; w < 4; ++w) *(LAS u32x4*)(scr + (c * 2 + p) * 64 + w * 16) = (u32x4){top[4 * w], top[4 * w + 1], top[4 * w + 2], top[4 * w + 3]};
            }
        }
        LDS_WAIT();
        float s1[16], s2[16];
#pragma unroll
        for (int w = 0; w < 4; ++w) { const u32x4 a = *(const LAS u32x4*)(scr + (c * 2) * 64 + w * 16), b2 = *(const LAS u32x4*)(scr + (c * 2 + 1) * 64 + w * 16);
#pragma unroll
            for (int e = 0; e < 4; ++e) { s1[4 * w + e] = unsortable((a[e] & ~127u) | 64u); s2[4 * w + e] = unsortable((b2[e] & ~127u) | 64u); } }
        unsigned ck[50];
        { int n = 0;
#pragma unroll
          for (int i = 0; i < 16; ++i)
#pragma unroll
              for (int j = 0; j < 16; ++j) if ((i + 1) * (j + 1) <= 16) { ck[n] = (sortable(s1[i] + s2[j]) & ~255u) | (unsigned)(255 - (i * 16 + j)); ++n; } }
        unsigned t2[16];
#pragma unroll
        for (int k = 0; k < 16; ++k) { const unsigned m = umax_all<50>(ck); t2[k] = m;
#pragma unroll
            for (int q = 0; q < 50; ++q) ck[q] = (ck[q] == m) ? 0u : ck[q]; }
        int ids[16]; float sc[16];
#pragma unroll
        for (int k = 0; k < 16; ++k) { const unsigned pos = 255u - (t2[k] & 255u);
            const unsigned k1 = *(const LAS unsigned*)(scr + (c * 2) * 64 + (pos >> 4) * 4), k2 = *(const LAS unsigned*)(scr + (c * 2 + 1) * 64 + (pos & 15u) * 4);
            ids[k] = (int)((127u - (k1 & 127u)) * 128u + (127u - (k2 & 127u))); sc[k] = unsortable((t2[k] & ~255u) | 128u); }
        LDS_WAIT();
        const float rs = 1.0f / sqrtf(ROWSS[tok] * (1.f / DM) + EPS);
        float ev[16], Z = 0.f;
#pragma unroll
        for (int k = 0; k < 16; ++k) { ev[k] = fexp2((sc[k] - sc[0]) * rs * LOG2E); Z += ev[k]; }
        const float iz = 1.f / Z;
        int* ip = IDS + (size_t)tok * 128 + hd * 16; float* gp = GATES + (size_t)tok * 128 + hd * 16;
        if (hh == 0) {
#pragma unroll
            for (int k = 0; k < 8; ++k) { ip[k] = ids[k]; gp[k] = ev[k] * iz; }
        } else {
#pragma unroll
            for (int k = 8; k < 16; ++k) { ip[k] = ids[k]; gp[k] = ev[k] * iz; }
        }
    }
}


__device__ __forceinline__ void topk_naive(const Params& P, LAS unsigned char* lds, int vcu, int G) {
    const int tid = threadIdx.x, lane = tid & 63, wave = __builtin_amdgcn_readfirstlane(tid >> 6);
    const int gw = vcu * NWAVES + wave, NGW = G * NWAVES;
    unsigned char* ws = P.ws;
    const bf16_t* Q2 = (const bf16_t*)(ws + WS_Q2);
    const float* ROWSS = (const float*)(ws + WS_CTL); int* IDS = (int*)(ws + WS_IDS); float* GATES = (float*)(ws + WS_GATES);
    LAS float* sv = (LAS float*)(lds + wave * 1024);
    LAS int* si = (LAS int*)(lds + wave * 1024 + 256);
    for (int task = gw; task < T_TOK * 8; task += NGW) {
        const int tok = task >> 3, hd = task & 7;
        for (int p = 0; p < 2; ++p) {
            float v0 = 0.f, v1 = 0.f;
            for (int cc = 0; cc < 128; ++cc) { const float q = bf_lo((unsigned)Q2[(size_t)tok * DM + hd * 256 + p * 128 + cc]);
                v0 += q * P.sub_keys[((size_t)(hd * 2 + p) * 128 + lane) * 128 + cc]; v1 += q * P.sub_keys[((size_t)(hd * 2 + p) * 128 + lane + 64) * 128 + cc]; }
            for (int i = 0; i < 16; ++i) {
                float bv = v0 >= v1 ? v0 : v1; int bi = v0 >= v1 ? lane : lane + 64;
                for (int o = 1; o < 64; o <<= 1) { const float ov = __shfl_xor(bv, o); const int oi = __shfl_xor(bi, o); if (ov > bv || (ov == bv && oi < bi)) { bv = ov; bi = oi; } }
                if (lane == 0) { sv[p * 16 + i] = bv; si[p * 16 + i] = bi; }
                if (bi == lane) v0 = -3e38f; if (bi == lane + 64) v1 = -3e38f;
            }
        }
        LDS_WAIT();
        float cv[4]; for (int q = 0; q < 4; ++q) { const int pos = lane * 4 + q; cv[q] = sv[pos >> 4] + sv[16 + (pos & 15)]; }
        float sel_v = 0.f; int sel_id = 0; float mx = 0.f;
        for (int k = 0; k < 16; ++k) {
            float bv = cv[0]; int bi = lane * 4;
            for (int q = 1; q < 4; ++q) if (cv[q] > bv) { bv = cv[q]; bi = lane * 4 + q; }
            for (int o = 1; o < 64; o <<= 1) { const float ov = __shfl_xor(bv, o); const int oi = __shfl_xor(bi, o); if (ov > bv || (ov == bv && oi < bi)) { bv = ov; bi = oi; } }
            if (k == 0) mx = bv;
            if (lane == k) { sel_v = bv; sel_id = si[bi >> 4] * 128 + si[16 + (bi & 15)]; }
            for (int q = 0; q < 4; ++q) if (bi == lane * 4 + q) cv[q] = -3e38f;
        }
        const float rs = 1.0f / sqrtf(ROWSS[tok] * (1.f / DM) + EPS);
        float ev = (lane < 16) ? expf((sel_v - mx) * rs) : 0.f;
        const float Z = wave_sum(ev);
        if (lane < 16) { IDS[(size_t)tok * 128 + hd * 16 + lane] = sel_id; GATES[(size_t)tok * 128 + hd * 16 + lane] = ev / Z; }
        LDS_WAIT();
    }
}

__device__ __forceinline__ float dot8(u32x4 a, u32x4 b, float acc) {
    const unsigned a0 = a[0], a1 = a[1], a2 = a[2], a3 = a[3], b0 = b[0], b1 = b[1], b2 = b[2], b3 = b[3];
    acc = __builtin_amdgcn_fdot2_f32_bf16(__builtin_bit_cast(bf16v2, a0), __builtin_bit_cast(bf16v2, b0), acc, false);
    acc = __builtin_amdgcn_fdot2_f32_bf16(__builtin_bit_cast(bf16v2, a1), __builtin_bit_cast(bf16v2, b1), acc, false);
    acc = __builtin_amdgcn_fdot2_f32_bf16(__builtin_bit_cast(bf16v2, a2), __builtin_bit_cast(bf16v2, b2), acc, false);
    acc = __builtin_amdgcn_fdot2_f32_bf16(__builtin_bit_cast(bf16v2, a3), __builtin_bit_cast(bf16v2, b3), acc, false);
    return acc;
}
__device__ __forceinline__ float gelu_tanh(float a) { const float t = 1.5957691216f * (a + 0.044715f * a * a * a); return a * frcp(1.f + fexp2(-LOG2E * t)); }

__device__ __forceinline__ void gather_phase(const Params& P, int vcu, int G) {
    const int tid = threadIdx.x, lane = tid & 63, wave = __builtin_amdgcn_readfirstlane(tid >> 6);
    const int gw = vcu * NWAVES + wave, NGW = G * NWAVES;
    unsigned char* ws = P.ws;
    const float* X1 = (const float*)(ws + WS_X1); const float* ROWSS = (const float*)(ws + WS_CTL);
    const int* IDS = (const int*)(ws + WS_IDS); const float* GATES = (const float*)(ws + WS_GATES);
    const unsigned char* EU = ws + WS_EU; const unsigned char* EV = ws + WS_EV;
    const float* SU = (const float*)(ws + WS_SU); const float* SV = (const float*)(ws + WS_SV);
    const bool b5 = (lane >> 5) & 1, b4 = (lane >> 4) & 1, b3 = (lane >> 3) & 1;
    for (int tok = gw; tok < T_TOK; tok += NGW) {
        f32x4 xv[2][4]; u32x4 hq[2];
        const float rs = 1.0f / sqrtf(ROWSS[tok] * (1.f / DM) + EPS);
        float hmx = 0.f;
#pragma unroll
        for (int j = 0; j < 2; ++j)
#pragma unroll
            for (int c4 = 0; c4 < 4; ++c4) { const size_t o = (size_t)tok * DM + 16 * lane + 1024 * j + 4 * c4; xv[j][c4] = *(const f32x4*)(X1 + o); }
        f32x4 hv[2][4];
#pragma unroll
        for (int j = 0; j < 2; ++j)
#pragma unroll
            for (int c4 = 0; c4 < 4; ++c4) { const f32x4 g = *(const f32x4*)(P.g_ffn + 16 * lane + 1024 * j + 4 * c4); hv[j][c4] = xv[j][c4] * rs * g;
                hmx = fmaxf(hmx, fmaxf(fmaxf(fabsf(hv[j][c4][0]), fabsf(hv[j][c4][1])), fmaxf(fabsf(hv[j][c4][2]), fabsf(hv[j][c4][3])))); }
#pragma unroll
        for (int o = 1; o < 64; o <<= 1) hmx = fmaxf(hmx, __shfl_xor(hmx, o));
        hmx = fmaxf(hmx, 1e-30f);
        const float hinv = 127.f / hmx, hscale = hmx * (1.f / 127.f);
#pragma unroll
        for (int j = 0; j < 2; ++j)
#pragma unroll
            for (int c4 = 0; c4 < 4; ++c4) { unsigned w = 0;
#pragma unroll
                for (int e = 0; e < 4; ++e) w |= ((unsigned)(int)__builtin_rintf(hv[j][c4][e] * hinv) & 255u) << (8 * e);
                hq[j][c4] = w; }
        const int ida = IDS[(size_t)tok * 128 + lane], idb = IDS[(size_t)tok * 128 + 64 + lane];
        const float sua = SU[ida], sub = SU[idb], sva = SV[ida], svb = SV[idb];
        float wreg[16];
#pragma unroll
        for (int bt = 0; bt < 16; ++bt) {
            int part[8]; u32x4 ud[8][2];
#pragma unroll
            for (int q = 0; q < 8; ++q) { const int k = bt * 8 + q; const int e = __builtin_amdgcn_readlane(k < 64 ? ida : idb, k & 63);
                const unsigned char* ur = EU + (size_t)e * DM + 16 * lane;
                ud[q][0] = *(const u32x4*)ur; ud[q][1] = *(const u32x4*)(ur + 1024); }
#pragma unroll
            for (int q = 0; q < 8; ++q) { int a = 0;
#pragma unroll
                for (int j = 0; j < 2; ++j)
#pragma unroll
                    for (int c4 = 0; c4 < 4; ++c4) a = __builtin_amdgcn_sdot4((int)ud[q][j][c4], (int)hq[j][c4], a, false);
                part[q] = a; }
            int p1[4], p2[2];
#pragma unroll
            for (int q = 0; q < 4; ++q) { const int send = b5 ? part[q] : part[q + 4], keep = b5 ? part[q + 4] : part[q]; p1[q] = keep + __shfl_xor(send, 32); }
#pragma unroll
            for (int q = 0; q < 2; ++q) { const int send = b4 ? p1[q] : p1[q + 2], keep = b4 ? p1[q + 2] : p1[q]; p2[q] = keep + __shfl_xor(send, 16); }
            int p3; { const int send = b3 ? p2[0] : p2[1], keep = b3 ? p2[1] : p2[0]; p3 = keep + __shfl_xor(send, 8); }
            p3 += __shfl_xor(p3, 4); p3 += __shfl_xor(p3, 2); p3 += __shfl_xor(p3, 1);
            const int ksel = bt * 8 + (lane >> 3);
            const float su_k = __shfl(bt < 8 ? sua : sub, ksel & 63), sv_k = __shfl(bt < 8 ? sva : svb, ksel & 63);
            const float gate = GATES[(size_t)tok * 128 + ksel];
            const float act = (float)p3 * (su_k * hscale);
            wreg[bt] = gate * gelu_tanh(act) * sv_k;
        }
        f32x4 acc[2][4]; float wsum = 0.f;
#pragma unroll
        for (int j = 0; j < 2; ++j)
#pragma unroll
            for (int c4 = 0; c4 < 4; ++c4) acc[j][c4] = (f32x4){0.f, 0.f, 0.f, 0.f};
#pragma unroll
        for (int bt = 0; bt < 16; ++bt) {
            u32x4 vd[8][2];
#pragma unroll
            for (int q = 0; q < 8; ++q) { const int k = bt * 8 + q; const int e = __builtin_amdgcn_readlane(k < 64 ? ida : idb, k & 63);
                const unsigned char* vr = EV + (size_t)e * DM + 16 * lane;
                vd[q][0] = *(const u32x4*)vr; vd[q][1] = *(const u32x4*)(vr + 1024); }
#pragma unroll
            for (int q = 0; q < 8; ++q) { const float w = __builtin_bit_cast(float, __builtin_amdgcn_readlane(__builtin_bit_cast(int, wreg[bt]), 8 * q));
                wsum += w;
#pragma unroll
                for (int j = 0; j < 2; ++j)
#pragma unroll
                    for (int c4 = 0; c4 < 4; ++c4) { const unsigned u = vd[q][j][c4];
                        acc[j][c4] += w * (f32x4){(float)(u & 255u), (float)((u >> 8) & 255u), (float)((u >> 16) & 255u), (float)(u >> 24)}; } }
        }
        float ss = 0.f; const float corr = 128.f * wsum;
#pragma unroll
        for (int j = 0; j < 2; ++j)
#pragma unroll
            for (int c4 = 0; c4 < 4; ++c4) { const f32x4 v = (DBG == 1 || DBG == 2) ? xv[j][c4] : xv[j][c4] + (acc[j][c4] - corr); xv[j][c4] = v; ss += (v[0] * v[0] + v[1] * v[1]) + (v[2] * v[2] + v[3] * v[3]); }
        const float rs2 = 1.0f / sqrtf(wave_sum(ss) * (1.f / DM) + EPS);
#pragma unroll
        for (int j = 0; j < 2; ++j)
#pragma unroll
            for (int c4 = 0; c4 < 4; ++c4) { const size_t o = (size_t)tok * DM + 16 * lane + 1024 * j + 4 * c4;
                const f32x4 g = *(const f32x4*)(P.g_final + 16 * lane + 1024 * j + 4 * c4);
                *(f32x4*)(P.out + o) = xv[j][c4] * rs2 * g; }
    }
}

__device__ __forceinline__ void gather_naive(const Params& P, int vcu, int G) {
    const int tid = threadIdx.x, lane = tid & 63, wave = __builtin_amdgcn_readfirstlane(tid >> 6);
    const int gw = vcu * NWAVES + wave, NGW = G * NWAVES;
    unsigned char* ws = P.ws;
    const float* X1 = (const float*)(ws + WS_X1); const float* ROWSS = (const float*)(ws + WS_CTL);
    const int* IDS = (const int*)(ws + WS_IDS); const float* GATES = (const float*)(ws + WS_GATES);
    for (int tok = gw; tok < T_TOK; tok += NGW) {
        float h2[32], acc[32];
        const float rs = 1.0f / sqrtf(ROWSS[tok] * (1.f / DM) + EPS);
#pragma unroll
        for (int i = 0; i < 32; ++i) { h2[i] = X1[(size_t)tok * DM + lane + 64 * i] * rs * P.g_ffn[lane + 64 * i]; acc[i] = 0.f; }
#pragma unroll 1
        for (int k = 0; k < 128; ++k) {
            const int e = IDS[(size_t)tok * 128 + k]; float a = 0.f;
            if (false) { const bf16_t* up = (const bf16_t*)(ws + WS_EU) + (size_t)e * DM + lane;
#pragma unroll
                for (int i = 0; i < 32; ++i) a += h2[i] * bf_lo((unsigned)up[64 * i]);
            } else { const float* up = P.e_u + (size_t)e * DM + lane;
#pragma unroll
                for (int i = 0; i < 32; ++i) a += h2[i] * up[64 * i]; }
            a = wave_sum(a);
            const float w = GATES[(size_t)tok * 128 + k] * gelu_tanh(a);
            if (false) { const bf16_t* vp = (const bf16_t*)(ws + WS_EV) + (size_t)e * DM + lane;
#pragma unroll
                for (int i = 0; i < 32; ++i) acc[i] += w * bf_lo((unsigned)vp[64 * i]);
            } else { const float* vp = P.e_v + (size_t)e * DM + lane;
#pragma unroll
                for (int i = 0; i < 32; ++i) acc[i] += w * vp[64 * i]; }
        }
        float ss = 0.f;
#pragma unroll
        for (int i = 0; i < 32; ++i) { acc[i] += X1[(size_t)tok * DM + lane + 64 * i]; ss += acc[i] * acc[i]; }
        const float rs2 = 1.0f / sqrtf(wave_sum(ss) * (1.f / DM) + EPS);
#pragma unroll
        for (int i = 0; i < 32; ++i) P.out[(size_t)tok * DM + lane + 64 * i] = acc[i] * rs2 * P.g_final[lane + 64 * i];
    }
}
}


#define XB_TMO      128
#define XB_XCNT(j)  (256  + 64 * (j))
#define XB_XSUB(j)  (1280 + 64 * (j))
#define XB_XGEN(j)  (2304 + 64 * (j))
#define XB_TOP      3328
#define XB_TOPGEN   3392
#define XCD_BAR_WORDS 3456
#define XB_SPIN_CAP (1u << 18)
__device__ __forceinline__ unsigned xb_ld(unsigned* p)              { return __hip_atomic_load(p, __ATOMIC_RELAXED, __HIP_MEMORY_SCOPE_AGENT); }
__device__ __forceinline__ unsigned xb_add(unsigned* p, unsigned v) { return __hip_atomic_fetch_add(p, v, __ATOMIC_RELAXED, __HIP_MEMORY_SCOPE_AGENT); }
__device__ __forceinline__ unsigned xb_xcc_id() { return (unsigned)__builtin_amdgcn_s_getreg((3 << 11) | 20) & 0xFu; }
#define XB_SPIN(cond, bar) do { unsigned _sp = 0; while (cond) { __builtin_amdgcn_s_sleep(1); \
    if ((++_sp & 255u) == 0u) { if (xb_ld(&(bar)[XB_TMO])) break; if (_sp > XB_SPIN_CAP) { atomicAdd(&(bar)[XB_TMO], 1u); break; } } } } while (0)
struct XcdBarrier { unsigned* bar; unsigned x; volatile LAS unsigned* st; };
__device__ __forceinline__ XcdBarrier xcd_barrier_post(unsigned* bar, volatile LAS unsigned* st) {
    XcdBarrier b; b.bar = bar; b.x = xb_xcc_id(); b.st = st;
    if (threadIdx.x == 0) (void)xb_add(&bar[XB_XCNT(b.x)], 1u);
    return b;
}
__device__ __forceinline__ void xcd_barrier_complete(unsigned* bar, unsigned x, unsigned& nloc, unsigned& nx) {
    const unsigned G = gridDim.x * gridDim.y * gridDim.z;
    unsigned sum, cnt, mine, sp = 0u;
    for (;;) {
        sum = 0u; cnt = 0u; mine = 0u;
#pragma unroll
        for (unsigned j = 0; j < 16; ++j) { const unsigned c = xb_ld(&bar[XB_XCNT(j)]); sum += c; cnt += (c > 0u) ? 1u : 0u; mine = (j == x) ? c : mine; }
        if (sum == G) break;
        __builtin_amdgcn_s_sleep(1);
        if ((++sp & 255u) == 0u) { if (xb_ld(&bar[XB_TMO])) break; if (sp > XB_SPIN_CAP) { atomicAdd(&bar[XB_TMO], 1u); break; } }
    }
    nloc = mine > 0u ? mine : 1u; nx = cnt > 0u ? cnt : 1u;
}
__device__ __forceinline__ void xcd_barrier(const XcdBarrier& b) {
    asm volatile("s_waitcnt vmcnt(0)" ::: "memory");
    __syncthreads();
    if (threadIdx.x == 0) {
        unsigned* bar = b.bar;
        __builtin_amdgcn_s_waitcnt(0);
        unsigned nloc = b.st[0], nx = b.st[1];
        if (nloc == 0u) { xcd_barrier_complete(bar, b.x, nloc, nx); b.st[0] = nloc; b.st[1] = nx; }
        const unsigned old = xb_add(&bar[XB_XSUB(b.x)], 1u);
        const unsigned gen = old / nloc;
        if (old + 1u == (gen + 1u) * nloc) {
            __builtin_amdgcn_fence(__ATOMIC_RELEASE, "agent");
            asm volatile("s_waitcnt vmcnt(0)" ::: "memory");
            const unsigned og = xb_add(&bar[XB_TOP], 1u);
            const unsigned tg = og / nx;
            if (og + 1u == (tg + 1u) * nx) xb_add(&bar[XB_TOPGEN], 1u);
            else XB_SPIN(xb_ld(&bar[XB_TOPGEN]) == tg, bar);
            __builtin_amdgcn_fence(__ATOMIC_ACQUIRE, "agent");
            xb_add(&bar[XB_XGEN(b.x)], 1u);
            asm volatile("s_waitcnt vmcnt(0)" ::: "memory");
        } else {
            XB_SPIN(xb_ld(&bar[XB_XGEN(b.x)]) == gen, bar);
            __builtin_amdgcn_fence(__ATOMIC_ACQUIRE, "agent");
            asm volatile("s_waitcnt vmcnt(0)" ::: "memory");
        }
    }
    __syncthreads();
}

__global__ void __launch_bounds__(NTHR, 2) mega_fwd(Params P) {
    extern __shared__ __attribute__((aligned(16))) unsigned char lds_raw[];
    LAS unsigned char* lds = (LAS unsigned char*)lds_raw;
    cg::grid_group grid = cg::this_grid();
    const int G = gridDim.x, bx = blockIdx.x;
    const int vcu = (G % 8 == 0) ? (bx % 8) * (G / 8) + bx / 8 : bx;
    unsigned char* ws = P.ws;
#ifndef ONLY_PHASE
#define ONLY_PHASE -1
#endif
#define IN(k) ((ONLY_PHASE < 0 || ONLY_PHASE == (k)) && P.ph_lo <= (k) && (k) < P.ph_hi)
    volatile LAS unsigned* bst = (volatile LAS unsigned*)(lds + 131072);
    if (threadIdx.x < 16) bst[threadIdx.x] = 0u;
    __syncthreads();
    const XcdBarrier xbar = xcd_barrier_post((unsigned*)(ws + WS_CTL + 131072), bst);
    if (P.ph_lo < 0) grid.sync();
#define SEAM(k) do { if (IN(k) && IN((k) + 1)) xcd_barrier(xbar); } while (0)
    for (int rep_ = 0; rep_ < (REPK == 0 ? 2 : 1); ++rep_) if (IN(0)) p0_prologue(P, lds, vcu, G);
    SEAM(0);
    for (int rep_ = 0; rep_ < (REPK == 1 ? 2 : 1); ++rep_) if (IN(1)) {
        pg8::Gemm g{(const bf16_t*)(ws + WS_H), (const bf16_t*)(ws + WS_WIN), T_TOK, 10240, 2048, 2048, 2048};
        pg8::StaticOrder S; S.init(T_TOK, 10240, G, bx);
        pg8::EpiProj E{(bf16_t*)(ws + WS_QKV), (bf16_t*)(ws + WS_SG), LOG2E * 0.08838834764831845f, (unsigned*)(ws + WS_CTL + 200704)};
        pg8::gemm_phase(lds, g, S, E);
    }
    SEAM(1);
    if (IN(2)) { att::attn_phase(P, lds, vcu, G); __syncthreads(); late_transposes(P, lds, vcu, G); }
    SEAM(2);
    for (int rep_ = 0; rep_ < (REPK == 3 ? 2 : 1); ++rep_) if (IN(3)) {
        pg8::StaticOrder S; S.init(T_TOK, DM, G, bx);
        { pg8::Gemm g{(const bf16_t*)(ws + WS_H), (const bf16_t*)(ws + WS_WAT), T_TOK, DM, 1024, 2048, 1024};
          pg8::EpiGate<0> E{(const bf16_t*)(ws + WS_SG), (float*)(ws + WS_TMP), (bf16_t*)(ws + WS_MERGED)};
          pg8::gemm_phase(lds, g, S, E); }
        { pg8::Gemm g{(const bf16_t*)(ws + WS_H) + 1024, (const bf16_t*)(ws + WS_WBT), T_TOK, DM, 1024, 2048, 1024};
          pg8::EpiGate<1> E{(const bf16_t*)(ws + WS_SG) + 2048, (float*)(ws + WS_TMP), (bf16_t*)(ws + WS_MERGED)};
          pg8::gemm_phase(lds, g, S, E); }
    }
    SEAM(3);
    for (int rep_ = 0; rep_ < (REPK == 4 ? 2 : 1); ++rep_) if (IN(4)) {
        pg8::Gemm g{(const bf16_t*)(ws + WS_MERGED), (const bf16_t*)(ws + WS_WOUT), T_TOK, DM, 2048, 2048, 2048};
        pg8::StaticOrder S; S.init(T_TOK, DM, G, bx);
        pg8::EpiResid E{P.x, (float*)(ws + WS_X1), (bf16_t*)(ws + WS_X1B), (float*)(ws + WS_CTL)};
        pg8::gemm_phase(lds, g, S, E);
    }
    SEAM(4);
    for (int rep_ = 0; rep_ < (REPK == 5 ? 2 : 1); ++rep_) if (IN(5)) {
        pg8::Gemm g{(const bf16_t*)(ws + WS_X1B), (const bf16_t*)(ws + WS_WQ), T_TOK, DM, 2048, 2048, 2048};
        pg8::StaticOrder S; S.init(T_TOK, DM, G, bx);
        pg8::EpiPlainBf16 E{(bf16_t*)(ws + WS_Q2)};
        pg8::gemm_phase(lds, g, S, E);
    }
    SEAM(5);
    if (IN(6)) {
        const bool conv_first = __builtin_amdgcn_readfirstlane(threadIdx.x >> 6) >= 4;
        if (conv_first) quantise_experts(P, vcu, G);
        peer::topk_phase(P, lds, vcu, G);
        if (!conv_first) quantise_experts(P, vcu, G);
    }
    SEAM(6);
    for (int rep_ = 0; rep_ < (REPK == 7 ? 2 : 1); ++rep_) if (IN(7)) { if (DBG == 11 || DBG == 12) peer::gather_naive(P, vcu, G); else peer::gather_phase(P, vcu, G); }
#undef IN
#undef SEAM
}

extern "C" void kernel_launch(void* const* d_in, const int* in_sizes, int n_in, void* d_out, int out_size, void* d_ws, size_t ws_size, hipStream_t stream) {
    static int grid = 0;
    if (grid == 0) {
        if (n_in != 13 || out_size != T_TOK * DM || ws_size < WS_END) { fprintf(stderr, "kernel_launch: unexpected shapes (n_in %d out %d ws %zu)\n", n_in, out_size, ws_size); grid = -1; return; }
        int dev = 0, cus = 0, per_cu = 0;
        if (hipGetDevice(&dev) != hipSuccess || hipDeviceGetAttribute(&cus, hipDeviceAttributeMultiprocessorCount, dev) != hipSuccess) { grid = -1; return; }
        if (hipFuncSetAttribute((const void*)mega_fwd, hipFuncAttributeMaxDynamicSharedMemorySize, LDS_BYTES) != hipSuccess) { fprintf(stderr, "kernel_launch: hipFuncSetAttribute failed\n"); grid = -1; return; }
        if (hipOccupancyMaxActiveBlocksPerMultiprocessor(&per_cu, (const void*)mega_fwd, NTHR, LDS_BYTES) != hipSuccess || per_cu < 1) { fprintf(stderr, "kernel_launch: occupancy query says %d\n", per_cu); grid = -1; return; }
        grid = cus;
    }
    if (grid < 0) return;
    (void)hipMemsetAsync((char*)d_ws + WS_CTL, 0, 1 * MiB, stream);
    Params p{};
    p.x = (const float*)d_in[0]; p.g_mix = (const float*)d_in[1]; p.w_in = (const float*)d_in[2]; p.b_forget = (const float*)d_in[3];
    p.w_a = (const float*)d_in[4]; p.w_b = (const float*)d_in[5]; p.w_out = (const float*)d_in[6]; p.g_ffn = (const float*)d_in[7];
    p.w_query = (const float*)d_in[8]; p.sub_keys = (const float*)d_in[9]; p.e_u = (const float*)d_in[10]; p.e_v = (const float*)d_in[11]; p.g_final = (const float*)d_in[12];
    p.out = (float*)d_out; p.ws = (unsigned char*)d_ws;
#if MK_N_LAUNCHES == 1
    p.ph_lo = 0; p.ph_hi = N_PHASES;
    void* args[] = {&p};
    hipError_t e = hipLaunchCooperativeKernel((const void*)mega_fwd, dim3(grid), dim3(NTHR), args, LDS_BYTES, stream);
    if (e != hipSuccess) fprintf(stderr, "kernel_launch: cooperative launch failed: %s (grid %d)\n", hipGetErrorString(e), grid);
#else
    for (int ph = 0; ph < N_PHASES; ++ph) { p.ph_lo = ph; p.ph_hi = ph + 1; hipLaunchKernelGGL(mega_fwd, dim3(grid), dim3(NTHR), LDS_BYTES, stream, p); }
#endif
}
```

```cpp
#include <hip/hip_runtime.h>
#include <hip/hip_cooperative_groups.h>
#include <cstdio>
#include <cstdint>
namespace cg = cooperative_groups;

#define LAS __attribute__((address_space(3)))
typedef unsigned short bf16_t;
typedef short bf16x8 __attribute__((ext_vector_type(8)));
typedef short s16x4 __attribute__((ext_vector_type(4)));
typedef float f32x2 __attribute__((ext_vector_type(2)));
typedef float f32x4 __attribute__((ext_vector_type(4)));
typedef float f32x16 __attribute__((ext_vector_type(16)));
typedef unsigned u32x2 __attribute__((ext_vector_type(2)));
typedef unsigned u32x4 __attribute__((ext_vector_type(4)));
typedef __bf16 bf16v2 __attribute__((ext_vector_type(2)));

#ifndef DBG
#define DBG 0
#endif
#ifndef REPK
#define REPK -1
#endif
#ifndef MK_N_LAUNCHES
#define MK_N_LAUNCHES 1
#endif

constexpr int T_TOK = 8192, DM = 2048, SEQ = 4096, HD = 128;
constexpr int NWAVES = 8, NTHR = 512;
constexpr int LDS_BYTES = 147456;
constexpr float LOG2E = 1.4426950408889634f;
constexpr float EPS = 1e-6f;
constexpr int N_PHASES = 8;

constexpr size_t MiB = 1u << 20;
constexpr size_t WS_CTL = 0;
constexpr size_t WS_LOGF = 1 * MiB;
constexpr size_t WS_SKB = 1 * MiB + 512 * 1024;
constexpr size_t WS_IDS = 2 * MiB;
constexpr size_t WS_GATES = 6 * MiB;
constexpr size_t WS_WAT = 10 * MiB, WS_WBT = 14 * MiB, WS_WOUT = 18 * MiB, WS_WQ = 26 * MiB, WS_WIN = 34 * MiB;
constexpr size_t WS_H = 74 * MiB;
constexpr size_t WS_QKV = 106 * MiB;
constexpr size_t WS_TMP = 106 * MiB, WS_MERGED = 170 * MiB, WS_Q2 = 106 * MiB;
constexpr size_t WS_SG = 202 * MiB;
constexpr size_t WS_X1B = 202 * MiB;
constexpr size_t WS_X1 = 266 * MiB;
constexpr size_t WS_EU = 330 * MiB, WS_EV = 362 * MiB;
constexpr size_t WS_SU = 394 * MiB, WS_SV = 394 * MiB + 65536;
constexpr size_t WS_END = 395 * MiB;

struct Params {
    const float* x; const float* g_mix; const float* w_in; const float* b_forget; const float* w_a; const float* w_b; const float* w_out;
    const float* g_ffn; const float* w_query; const float* sub_keys; const float* e_u; const float* e_v; const float* g_final;
    float* out; unsigned char* ws; int ph_lo, ph_hi;
};

__device__ __forceinline__ unsigned pk2(float a, float b) { f32x2 v = {a, b}; return __builtin_bit_cast(unsigned, __builtin_convertvector(v, bf16v2)); }
__device__ __forceinline__ float bf_lo(unsigned u) { return __builtin_bit_cast(float, u << 16); }
__device__ __forceinline__ float bf_hi(unsigned u) { return __builtin_bit_cast(float, u & 0xffff0000u); }
__device__ __forceinline__ float fexp2(float x) { return __builtin_amdgcn_exp2f(x); }
__device__ __forceinline__ float flog2(float x) { return __builtin_amdgcn_logf(x); }
__device__ __forceinline__ float frcp(float x) { return __builtin_amdgcn_rcpf(x); }
__device__ __forceinline__ float wave_sum(float v) {
#pragma unroll
    for (int o = 1; o < 64; o <<= 1) v += __shfl_xor(v, o);
    return v;
}
#define LDS_WAIT() asm volatile("s_waitcnt lgkmcnt(0)" ::: "memory")

namespace pg8 {
constexpr int BM = 256, BK = 64, HALF = 128, HTB = HALF * BK * 2, STAGE_BYTES = 8 * HTB, NXCD = 8, WGM = 8;
__host__ __device__ __forceinline__ int lds_byte(int r, int c) { const int st = (r >> 4) * 2 + (c >> 5), rr = r & 15, cc = c & 31, ob = rr * 64 + cc * 2; return st * 1024 + (ob ^ (((ob >> 9) & 1) << 5)); }
__host__ __device__ __forceinline__ void stage_rc(int b, int& R, int& C) { const int st = b / 1024, sb = b % 1024, swz = sb ^ (((sb >> 9) & 1) << 5); R = (st >> 1) * 16 + swz / 64; C = (st & 1) * 32 + (swz % 64) / 2; }
__host__ __device__ __forceinline__ int perm32(int rho) { const int n = rho >> 4, i = rho & 15; return 8 * (i >> 2) + 4 * n + (i & 3); }
struct Unit { int pm, pn; };
struct Gemm { const bf16_t* A; const bf16_t* Bt; int M, N, K, lda, ldb; };
struct StaticOrder {
    int nM, nN, nwg, G, c;
    __device__ void init(int M, int N, int G_, int c_) { nM = M / BM; nN = N / BM; nwg = nM * nN; G = G_; c = c_; }
    __device__ bool next(int i, Unit& u) const {
        const long L = (long)i * G + c; if (L >= nwg) return false;
        int wgid = (int)L; { const int q = nwg / NXCD, r = nwg % NXCD, xcd = wgid % NXCD, off = wgid / NXCD; wgid = (xcd < r ? xcd * (q + 1) : r * (q + 1) + (xcd - r) * q) + off; }
        const int nig = WGM * nN, gid = wgid / nig, fm = gid * WGM, gsz = (nM - fm) < WGM ? (nM - fm) : WGM;
        u.pm = fm + ((wgid % nig) % gsz); u.pn = (wgid % nig) / gsz; return true;
    }
};
template <class Epi>
__device__ __forceinline__ void gemm_phase(LAS unsigned char* lds, const Gemm g, const StaticOrder& S, const Epi& E) {
    const int tid = threadIdx.x, wid = __builtin_amdgcn_readfirstlane(tid >> 6), lane = tid & 63, wr = wid >> 2, wc = wid & 3, fr = lane & 15, fq = lane >> 4;
    const int K = g.K, nt = K / BK;
    unsigned voffA[2], voffB[2];
#pragma unroll
    for (int i = 0; i < 2; ++i) { int R, C; stage_rc(tid * 16 + i * 8192, R, C); const int Rb = (R & ~31) + perm32(R & 31);
        voffA[i] = (unsigned)(R * g.lda + C) * 2u; voffB[i] = (unsigned)(Rb * g.ldb + C) * 2u; }
    const size_t kstep = (size_t)(BK * 2);
    const size_t hstepA = (size_t)HALF * g.lda * 2, hstepB = (size_t)HALF * g.ldb * 2;
    const size_t tstepA = 2 * hstepA, tstepB = 2 * hstepB;
    const unsigned ldsw = (unsigned)wid * 1024u;
    const int aoff = lds_byte(wr * 64 + fr, fq * 8), boff = lds_byte(wc * 32 + fr, fq * 8);
#define PG8_SA(b, h) (((b) * 2 + (h)) * HTB)
#define PG8_SB(b, h) ((4 + (b) * 2 + (h)) * HTB)
#define PG8_STAGE(bufoff, gbase, voff) do { _Pragma("unroll") for (int _i = 0; _i < 2; ++_i) \
        __builtin_amdgcn_global_load_lds((const unsigned*)((const char*)(gbase) + (voff)[_i]), (LAS unsigned*)(lds + (bufoff) + ldsw + _i * 8192), 16, 0, 0); } while (0)
#define PG8_LDA(dst, b, h) do { _Pragma("unroll") for (int m = 0; m < 4; ++m) _Pragma("unroll") for (int k = 0; k < 2; ++k) dst[m][k] = *(const LAS bf16x8*)(lds + PG8_SA(b, h) + aoff + m * 2048 + k * 1024); } while (0)
#define PG8_LDB(dst, b, h) do { _Pragma("unroll") for (int n = 0; n < 2; ++n) _Pragma("unroll") for (int k = 0; k < 2; ++k) dst[n][k] = *(const LAS bf16x8*)(lds + PG8_SB(b, h) + boff + n * 2048 + k * 1024); } while (0)
#define PG8_MMA(ai, bj, At, Bt) do { __builtin_amdgcn_s_setprio(1); _Pragma("unroll") for (int m = 0; m < 4; ++m) _Pragma("unroll") for (int n = 0; n < 2; ++n) _Pragma("unroll") for (int k = 0; k < 2; ++k) \
        acc[ai][bj][m][n] = __builtin_amdgcn_mfma_f32_16x16x32_bf16(Bt[n][k], At[m][k], acc[ai][bj][m][n], 0, 0, 0); __builtin_amdgcn_s_setprio(0); } while (0)
#define PG8_WAIT_V(n) asm volatile("s_waitcnt vmcnt(" #n ")" ::: "memory")
#define PG8_WAIT_L(n) asm volatile("s_waitcnt lgkmcnt(" #n ")" ::: "memory")
#define PG8_BAR __builtin_amdgcn_s_barrier()
#define PG8_SCHED __builtin_amdgcn_sched_barrier(0)
    Unit cur, nxt; int ui = 0;
    if (!S.next(0, cur)) return;
    f32x4 acc[2][2][4][2];
#pragma unroll
    for (int a = 0; a < 2; ++a)
#pragma unroll
        for (int b = 0; b < 2; ++b)
#pragma unroll
            for (int m = 0; m < 4; ++m)
#pragma unroll
                for (int n = 0; n < 2; ++n) acc[a][b][m][n] = (f32x4){0.f, 0.f, 0.f, 0.f};
    bf16x8 At[4][2], B0[2][2], B1[2][2];
    const char* cA = (const char*)g.A + (size_t)cur.pm * tstepA; const char* cB = (const char*)g.Bt + (size_t)cur.pn * tstepB;
    PG8_STAGE(PG8_SB(0, 0), cB, voffB); PG8_STAGE(PG8_SA(0, 0), cA, voffA); PG8_STAGE(PG8_SB(0, 1), cB + hstepB, voffB); PG8_STAGE(PG8_SA(0, 1), cA + hstepA, voffA);
    if (wr == 1) PG8_BAR;
    PG8_WAIT_V(4); PG8_BAR;
    PG8_STAGE(PG8_SB(1, 0), cB + kstep, voffB); PG8_STAGE(PG8_SA(1, 0), cA + kstep, voffA); PG8_STAGE(PG8_SB(1, 1), cB + hstepB + kstep, voffB);
    PG8_WAIT_V(6); PG8_BAR;
    for (;;) {
        const bool has_next = S.next(ui + 1, nxt);
        const char* nA = has_next ? (const char*)g.A + (size_t)nxt.pm * tstepA : cA; const char* nB = has_next ? (const char*)g.Bt + (size_t)nxt.pn * tstepB : cB;
        for (int t = 0; t < nt; t += 2) {
            const bool last = (t == nt - 2);
            const char* a1 = cA + (size_t)(t + 1) * kstep;
            const char* a2 = last ? nA : cA + (size_t)(t + 2) * kstep; const char* b2 = last ? nB : cB + (size_t)(t + 2) * kstep;
            const char* a3 = a2 + kstep; const char* b3 = b2 + kstep;
            PG8_LDB(B0, 0, 0); PG8_SCHED; PG8_LDA(At, 0, 0); PG8_STAGE(PG8_SA(1, 1), a1 + hstepA, voffA);
            PG8_WAIT_L(8); PG8_BAR; PG8_WAIT_L(0); PG8_MMA(0, 0, At, B0); PG8_BAR; PG8_SCHED;
            PG8_LDB(B1, 0, 1); PG8_STAGE(PG8_SB(0, 0), b2, voffB);
            PG8_BAR; PG8_WAIT_L(0); PG8_MMA(0, 1, At, B1); PG8_BAR;
            PG8_LDA(At, 0, 1); PG8_STAGE(PG8_SA(0, 0), a2, voffA);
            PG8_BAR; PG8_WAIT_L(0); PG8_MMA(1, 0, At, B0); PG8_BAR; PG8_SCHED;
            PG8_STAGE(PG8_SB(0, 1), b2 + hstepB, voffB);
            PG8_WAIT_V(6); PG8_BAR; PG8_MMA(1, 1, At, B1); PG8_BAR;
            PG8_LDB(B0, 1, 0); PG8_SCHED; PG8_LDA(At, 1, 0); PG8_STAGE(PG8_SA(0, 1), a2 + hstepA, voffA);
            PG8_WAIT_L(8); PG8_BAR; PG8_WAIT_L(0); PG8_MMA(0, 0, At, B0); PG8_BAR; PG8_SCHED;
            PG8_LDB(B1, 1, 1); PG8_STAGE(PG8_SB(1, 0), b3, voffB);
            PG8_BAR; PG8_WAIT_L(0); PG8_MMA(0, 1, At, B1); PG8_BAR;
            PG8_LDA(At, 1, 1); PG8_STAGE(PG8_SA(1, 0), a3, voffA);
            PG8_BAR; PG8_WAIT_L(0); PG8_MMA(1, 0, At, B0); PG8_BAR; PG8_SCHED;
            PG8_STAGE(PG8_SB(1, 1), b3 + hstepB, voffB);
            PG8_WAIT_V(6); PG8_BAR; PG8_MMA(1, 1, At, B1); PG8_BAR;
        }
        E(acc, cur, wr, wc, fr, fq);
        if (!has_next) break;
#pragma unroll
        for (int a = 0; a < 2; ++a)
#pragma unroll
            for (int b = 0; b < 2; ++b)
#pragma unroll
                for (int m = 0; m < 4; ++m)
#pragma unroll
                    for (int n = 0; n < 2; ++n) acc[a][b][m][n] = (f32x4){0.f, 0.f, 0.f, 0.f};
        cur = nxt; cA = nA; cB = nB; ++ui;
    }
    PG8_WAIT_V(0);
    if (wr == 0) PG8_BAR;
    PG8_BAR;
#undef PG8_SA
#undef PG8_SB
#undef PG8_STAGE
#undef PG8_LDA
#undef PG8_LDB
#undef PG8_MMA
#undef PG8_WAIT_V
#undef PG8_WAIT_L
#undef PG8_BAR
#undef PG8_SCHED
}

struct EpiProj {
    bf16_t* qkv; bf16_t* sg; float qscale; unsigned* kmaxw;
    __device__ __forceinline__ void operator()(const f32x4 (&acc)[2][2][4][2], const Unit& u, int wr, int wc, int fr, int fq) const {
        const int row0 = u.pm * BM + wr * 64 + fr;
        if (u.pn < 24) {
            const int t = u.pn >> 2; bf16_t* base = qkv + (size_t)t * ((size_t)T_TOK * 1024) + (u.pn & 3) * 256 + wc * 32 + 8 * fq;
            const float sc = (t == 0 || t == 3) ? qscale : 1.f;
            if (t == 4) {
#pragma unroll
                for (int bj = 0; bj < 2; ++bj) { float mxv = 0.f;
#pragma unroll
                    for (int ai = 0; ai < 2; ++ai)
#pragma unroll
                        for (int m = 0; m < 4; ++m) { const f32x4 v0 = acc[ai][bj][m][0], v1 = acc[ai][bj][m][1];
                            float ssq = (v0[0] * v0[0] + v0[1] * v0[1]) + (v0[2] * v0[2] + v0[3] * v0[3]) + (v1[0] * v1[0] + v1[1] * v1[1]) + (v1[2] * v1[2] + v1[3] * v1[3]);
                            ssq += __shfl_xor(ssq, 16); ssq += __shfl_xor(ssq, 32); mxv = fmaxf(mxv, ssq); }
#pragma unroll
                    for (int o = 1; o < 16; o <<= 1) mxv = fmaxf(mxv, __shfl_xor(mxv, o));
                    if ((fr | fq) == 0) atomicMax(kmaxw + ((u.pm >> 4) * 8 + (u.pn & 3) * 2 + bj) * 4 + wc, __builtin_bit_cast(unsigned, mxv)); }
            }
#pragma unroll
            for (int ai = 0; ai < 2; ++ai)
#pragma unroll
                for (int m = 0; m < 4; ++m) { bf16_t* rowp = base + (size_t)(row0 + ai * HALF + m * 16) * 1024;
#pragma unroll
                    for (int bj = 0; bj < 2; ++bj) { const f32x4 v0 = acc[ai][bj][m][0] * sc, v1 = acc[ai][bj][m][1] * sc;
                        u32x4 w; w.x = pk2(v0[0], v0[1]); w.y = pk2(v0[2], v0[3]); w.z = pk2(v1[0], v1[1]); w.w = pk2(v1[2], v1[3]);
                        *(u32x4*)(rowp + bj * HALF) = w; } }
        } else {
            bf16_t* base = sg + (u.pn - 24) * 256 + wc * 32 + 8 * fq;
#pragma unroll
            for (int ai = 0; ai < 2; ++ai)
#pragma unroll
                for (int m = 0; m < 4; ++m) { bf16_t* rowp = base + (size_t)(row0 + ai * HALF + m * 16) * 4096;
#pragma unroll
                    for (int bj = 0; bj < 2; ++bj) { float s[8];
#pragma unroll
                        for (int e = 0; e < 4; ++e) { s[e] = frcp(1.f + fexp2(-LOG2E * acc[ai][bj][m][0][e])); s[4 + e] = frcp(1.f + fexp2(-LOG2E * acc[ai][bj][m][1][e])); }
                        u32x4 w; w.x = pk2(s[0], s[1]); w.y = pk2(s[2], s[3]); w.z = pk2(s[4], s[5]); w.w = pk2(s[6], s[7]);
                        *(u32x4*)(rowp + bj * HALF) = w; } }
        }
    }
};
template <int SECOND> struct EpiGate {
    const bf16_t* sg;
    float* tmp; bf16_t* merged;
    __device__ __forceinline__ void operator()(const f32x4 (&acc)[2][2][4][2], const Unit& u, int wr, int wc, int fr, int fq) const {
        const int row0 = u.pm * BM + wr * 64 + fr, col0 = u.pn * BM + wc * 32 + 8 * fq;
#pragma unroll
        for (int ai = 0; ai < 2; ++ai)
#pragma unroll
            for (int m = 0; m < 4; ++m) { const size_t row = (size_t)(row0 + ai * HALF + m * 16);
#pragma unroll
                for (int bj = 0; bj < 2; ++bj) { const int col = col0 + bj * HALF;
                    const u32x4 gv = *(const u32x4*)(sg + row * 4096 + col);
                    const f32x4 g0 = {bf_lo(gv.x), bf_hi(gv.x), bf_lo(gv.y), bf_hi(gv.y)}, g1 = {bf_lo(gv.z), bf_hi(gv.z), bf_lo(gv.w), bf_hi(gv.w)};
                    f32x4 v0 = acc[ai][bj][m][0] * g0, v1 = acc[ai][bj][m][1] * g1;
                    float* tp = tmp + row * DM + col;
                    if (SECOND == 0) { *(f32x4*)tp = v0; *(f32x4*)(tp + 4) = v1; }
                    else { v0 += *(const f32x4*)tp; v1 += *(const f32x4*)(tp + 4);
                        u32x4 w; w.x = pk2(v0[0], v0[1]); w.y = pk2(v0[2], v0[3]); w.z = pk2(v1[0], v1[1]); w.w = pk2(v1[2], v1[3]);
                        *(u32x4*)(merged + row * DM + col) = w; } } }
    }
};
struct EpiResid {
    const float* x; float* x1; bf16_t* x1b; float* rowss;
    __device__ __forceinline__ void operator()(const f32x4 (&acc)[2][2][4][2], const Unit& u, int wr, int wc, int fr, int fq) const {
        const int row0 = u.pm * BM + wr * 64 + fr, col0 = u.pn * BM + wc * 32 + 8 * fq;
#pragma unroll
        for (int ai = 0; ai < 2; ++ai)
#pragma unroll
            for (int m = 0; m < 4; ++m) { const size_t row = (size_t)(row0 + ai * HALF + m * 16); float ss = 0.f;
#pragma unroll
                for (int bj = 0; bj < 2; ++bj) { const size_t o = row * DM + col0 + bj * HALF;
                    const f32x4 v0 = (DBG == 2 ? 0.f : 1.f) * acc[ai][bj][m][0] + *(const f32x4*)(x + o), v1 = (DBG == 2 ? 0.f : 1.f) * acc[ai][bj][m][1] + *(const f32x4*)(x + o + 4);
                    *(f32x4*)(x1 + o) = v0; *(f32x4*)(x1 + o + 4) = v1;
                    u32x4 w; w.x = pk2(v0[0], v0[1]); w.y = pk2(v0[2], v0[3]); w.z = pk2(v1[0], v1[1]); w.w = pk2(v1[2], v1[3]);
                    *(u32x4*)(x1b + o) = w;
                    ss += (v0[0] * v0[0] + v0[1] * v0[1]) + (v0[2] * v0[2] + v0[3] * v0[3]) + (v1[0] * v1[0] + v1[1] * v1[1]) + (v1[2] * v1[2] + v1[3] * v1[3]); }
                ss += __shfl_xor(ss, 16); ss += __shfl_xor(ss, 32);
                if (fq == 0) atomicAdd(rowss + row, ss); }
    }
};
struct EpiPlainBf16 {
    bf16_t* o;
    __device__ __forceinline__ void operator()(const f32x4 (&acc)[2][2][4][2], const Unit& u, int wr, int wc, int fr, int fq) const {
        const int row0 = u.pm * BM + wr * 64 + fr, col0 = u.pn * BM + wc * 32 + 8 * fq;
#pragma unroll
        for (int ai = 0; ai < 2; ++ai)
#pragma unroll
            for (int m = 0; m < 4; ++m) { const size_t row = (size_t)(row0 + ai * HALF + m * 16);
#pragma unroll
                for (int bj = 0; bj < 2; ++bj) { const f32x4 v0 = acc[ai][bj][m][0], v1 = acc[ai][bj][m][1];
                    u32x4 w; w.x = pk2(v0[0], v0[1]); w.y = pk2(v0[2], v0[3]); w.z = pk2(v1[0], v1[1]); w.w = pk2(v1[2], v1[3]);
                    *(u32x4*)(o + row * DM + col0 + bj * HALF) = w; } }
    }
};
}

__device__ __forceinline__ void transpose_item(const float* W, int ldw, int src_n0, bf16_t* WT, int K, int dst_n0, int k0, LAS float* scr, int lane, const float* kscale) {
#pragma unroll 8
    for (int i = 0; i < 32; ++i) { const int kk = 2 * i + (lane >> 5); float v = W[(size_t)(k0 + kk) * ldw + src_n0 + (lane & 31)]; if (kscale) v *= kscale[k0 + kk]; scr[kk * 33 + (lane & 31)] = v; }
    LDS_WAIT();
    const int c = lane & 7;
#pragma unroll
    for (int j = 0; j < 4; ++j) { const int n = (lane >> 3) + 8 * j; const LAS float* s = scr + (8 * c) * 33 + n;
        u32x4 o; o.x = pk2(s[0 * 33], s[1 * 33]); o.y = pk2(s[2 * 33], s[3 * 33]); o.z = pk2(s[4 * 33], s[5 * 33]); o.w = pk2(s[6 * 33], s[7 * 33]);
        *(u32x4*)(WT + (size_t)(dst_n0 + n) * K + k0 + 8 * c) = o; }
    LDS_WAIT();
}

__device__ __forceinline__ void p0_prologue(const Params& P, LAS unsigned char* lds, int vcu, int G) {
    const int tid = threadIdx.x, lane = tid & 63, wave = __builtin_amdgcn_readfirstlane(tid >> 6);
    const int gw = vcu * NWAVES + wave, NGW = G * NWAVES;
    unsigned char* ws = P.ws;
    {
        LAS float* scr = (LAS float*)(lds + wave * 16384);
        constexpr int I_IN = 32 * 320;
        for (int it = gw; it < I_IN; it += NGW) { const int kb = it / 320, nb = it % 320, dn = nb * 32;
            transpose_item(P.w_in, 10248, dn < 6144 ? dn : dn + 8, (bf16_t*)(ws + WS_WIN), 2048, dn, kb * 64, scr, lane, nullptr); }
    }
    __syncthreads();
    {
        LAS float* wf = (LAS float*)lds;
        for (int idx = tid; idx < 2048 * 8; idx += NTHR) { const int k = idx >> 3, c = idx & 7; wf[c * 2048 + k] = P.w_in[(size_t)k * 10248 + 6144 + c]; }
        __syncthreads();
        bf16_t* H = (bf16_t*)(ws + WS_H); float* LOGF = (float*)(ws + WS_LOGF);
        for (int r = gw; r < T_TOK; r += NGW) {
            const f32x4* xr = (const f32x4*)(P.x + (size_t)r * DM) + lane;
            float ss = 0.f;
#pragma unroll
            for (int j = 0; j < 8; ++j) { const f32x4 v = xr[64 * j]; ss += (v[0] * v[0] + v[1] * v[1]) + (v[2] * v[2] + v[3] * v[3]); }
            const float rstd = 1.0f / sqrtf(wave_sum(ss) * (1.f / DM) + EPS);
            float fl[8];
#pragma unroll
            for (int c = 0; c < 8; ++c) fl[c] = 0.f;
            u32x2* hp = (u32x2*)(H + (size_t)r * DM) + lane;
#pragma unroll 1
            for (int j = 0; j < 8; ++j) { const f32x4 gn = *((const f32x4*)P.g_mix + lane + 64 * j); const f32x4 hv = xr[64 * j] * rstd * gn;
                u32x2 o; o.x = pk2(hv[0], hv[1]); o.y = pk2(hv[2], hv[3]); hp[64 * j] = o;
#pragma unroll
                for (int c = 0; c < 8; ++c) { const f32x4 wv = *((const LAS f32x4*)(wf + c * 2048) + lane + 64 * j); fl[c] += (hv[0] * wv[0] + hv[1] * wv[1]) + (hv[2] * wv[2] + hv[3] * wv[3]); } }
#pragma unroll
            for (int c = 0; c < 8; ++c) fl[c] = wave_sum(fl[c]);
            if (lane == 0) {
#pragma unroll
                for (int c = 0; c < 8; ++c) { const float y = fl[c] + P.b_forget[c]; LOGF[(size_t)r * 8 + c] = fminf(y, 0.f) - log1pf(expf(-fabsf(y))); }
            }
        }
    }
    {
        const size_t gid = (size_t)vcu * NTHR + tid, gstride = (size_t)G * NTHR;
        for (size_t i = gid; i < 262144 / 8; i += gstride) { const float* src = P.sub_keys + i * 8; const f32x4 a = *(const f32x4*)src, b = *((const f32x4*)src + 1);
            u32x4 o; o.x = pk2(a[0], a[1]); o.y = pk2(a[2], a[3]); o.z = pk2(b[0], b[1]); o.w = pk2(b[2], b[3]); *(u32x4*)((bf16_t*)(ws + WS_SKB) + i * 8) = o; }
    }
}
__device__ __forceinline__ void late_transposes(const Params& P, LAS unsigned char* lds, int vcu, int G) {
    const int tid = threadIdx.x, lane = tid & 63, wave = __builtin_amdgcn_readfirstlane(tid >> 6);
    const int gw = vcu * NWAVES + wave, NGW = G * NWAVES;
    unsigned char* ws = P.ws;
    LAS float* scr = (LAS float*)(lds + wave * 16384);
    constexpr int I_A = 16 * 64, I_O = 32 * 64, NITEMS = 2 * I_A + 2 * I_O;
    for (int it = gw; it < NITEMS; it += NGW) {
        int r = it;
        if (r < I_A) { const int kb = r / 64, nb = r % 64; transpose_item(P.w_a, 2048, nb * 32, (bf16_t*)(ws + WS_WAT), 1024, nb * 32, kb * 64, scr, lane, nullptr); continue; } r -= I_A;
        if (r < I_A) { const int kb = r / 64, nb = r % 64; transpose_item(P.w_b, 2048, nb * 32, (bf16_t*)(ws + WS_WBT), 1024, nb * 32, kb * 64, scr, lane, nullptr); continue; } r -= I_A;
        if (r < I_O) { const int kb = r / 64, nb = r % 64; transpose_item(P.w_out, 2048, nb * 32, (bf16_t*)(ws + WS_WOUT), 2048, nb * 32, kb * 64, scr, lane, nullptr); continue; } r -= I_O;
        { const int kb = r / 64, nb = r % 64; transpose_item(P.w_query, 2048, nb * 32, (bf16_t*)(ws + WS_WQ), 2048, nb * 32, kb * 64, scr, lane, P.g_ffn); }
    }
}
__device__ __forceinline__ void quantise_experts(const Params& P, int vcu, int G) {
    const int tid = threadIdx.x, lane = tid & 63, wave = __builtin_amdgcn_readfirstlane(tid >> 6);
    const int gw = vcu * NWAVES + wave, NGW = G * NWAVES;
    unsigned char* ws = P.ws;
    float* SU = (float*)(ws + WS_SU); float* SV = (float*)(ws + WS_SV);
    for (int r = gw; r < 2 * 16384; r += NGW) {
        const bool second = r >= 16384; const int row = second ? r - 16384 : r;
        const f32x4* src = (const f32x4*)((second ? P.e_v : P.e_u) + (size_t)row * DM) + lane;
        f32x4 v[8]; float mx = 0.f;
#pragma unroll
        for (int j = 0; j < 8; ++j) { v[j] = __builtin_nontemporal_load(src + 64 * j); mx = fmaxf(mx, fmaxf(fmaxf(fabsf(v[j][0]), fabsf(v[j][1])), fmaxf(fabsf(v[j][2]), fabsf(v[j][3])))); }
#pragma unroll
        for (int o = 1; o < 64; o <<= 1) mx = fmaxf(mx, __shfl_xor(mx, o));
        mx = fmaxf(mx, 1e-30f);
        const float inv = 127.f / mx; const int bias = second ? 128 : 0;
        unsigned* dst = (unsigned*)(ws + (second ? WS_EV : WS_EU) + (size_t)row * DM) + lane;
#pragma unroll
        for (int j = 0; j < 8; ++j) { unsigned w = 0;
#pragma unroll
            for (int e = 0; e < 4; ++e) { const int q = (int)__builtin_rintf(v[j][e] * inv) + bias; w |= ((unsigned)q & 255u) << (8 * e); }
            dst[64 * j] = w; }
        if (lane == 0) (second ? SV : SU)[row] = mx * (1.f / 127.f);
    }
}

namespace att {
constexpr int KST = 272, VST = 320;
constexpr int KBUF = 64 * KST, VBUF = 64 * VST;
constexpr int OFF_K = 0, OFF_V = 2 * KBUF, OFF_F = OFF_V + 2 * VBUF, OFF_SC = OFF_F + 4096 * 4;
constexpr int OFF_FLG = OFF_SC + 64, OFF_UNIT = OFF_FLG + 64;
static_assert(OFF_UNIT + 16 <= 131072, "attention LDS");
constexpr float THR_SB = 40.f, THR_FOX = 30.f;

__device__ __forceinline__ void build_cumf(LAS unsigned char* lds, const float* LOGF, int b, int h, int n, int tid, int lane, int wid) {
    LAS float* F2 = (LAS float*)(lds + OFF_F); LAS float* sc = (LAS float*)(lds + OFF_SC);
    const int s0 = tid * 8; float v[8];
#pragma unroll
    for (int i = 0; i < 8; ++i) v[i] = (s0 < n) ? LOGF[((size_t)b * SEQ + s0 + i) * 8 + h] * LOG2E : 0.f;
#pragma unroll
    for (int i = 1; i < 8; ++i) v[i] += v[i - 1];
    float tot = v[7], inc = tot;
#pragma unroll
    for (int o = 1; o < 64; o <<= 1) { const float t = __shfl_up(inc, o); if (lane >= o) inc += t; }
    if (lane == 63) sc[wid] = inc;
    __syncthreads();
    float base = inc - tot;
#pragma unroll
    for (int w = 0; w < 8; ++w) if (w < wid) base += sc[w];
    if (s0 < n) {
#pragma unroll
        for (int i = 0; i < 8; ++i) F2[s0 + i] = v[i] + base;
    }
    __syncthreads();
}

template <int MIXER>
__device__ __forceinline__ void attn_unit(LAS unsigned char* lds, const bf16_t* Q, const bf16_t* Kg, const bf16_t* Vg, bf16_t* O, int b, int h, int qb, float kmax, int tid, int lane, int wid) {
    const int c = lane & 31, hh = lane >> 5;
    const int t0 = qb * 256 + wid * 32, tq = t0 + c;
    const size_t rowbase = (size_t)b * SEQ;
    size_t qoff = (rowbase + tq) * 1024 + h * HD + 8 * hh;
    f32x16 oacc[4];
#pragma unroll
    for (int d = 0; d < 4; ++d)
#pragma unroll
        for (int r = 0; r < 16; ++r) oacc[d][r] = 0.f;
    float carry = 0.f, mrun = -1e30f, lsum = 0.f; const float nhf = hh ? 0.f : 1.f;
    const LAS float* F2 = (const LAS float*)(lds + OFF_F);
    const float Ft = (MIXER == 1) ? F2[tq] : 0.f;
    float qk_bound = 0.f;
    if (MIXER == 1) { float qs = 0.f;
#pragma unroll
        for (int s2 = 0; s2 < 8; ++s2) { const u32x4 qv = *(const u32x4*)(Q + qoff + 16 * s2);
#pragma unroll
            for (int e = 0; e < 4; ++e) { const float a = bf_lo(qv[e]), b2 = bf_hi(qv[e]); qs += a * a + b2 * b2; } }
        qs += __shfl_xor(qs, 32);
        qk_bound = sqrtf(qs) * kmax; }
    bool wave_done = false;
    volatile LAS unsigned* flg = (volatile LAS unsigned*)(lds + OFF_FLG);
    const int ktmax = 4 * qb + 3;
    const int srow = tid >> 4, scc = tid & 15;
    u32x4 kr[2], vr[2];
#define ATT_LOAD(kt) do { _Pragma("unroll") for (int j = 0; j < 2; ++j) { const size_t g_ = (rowbase + 64 * (kt) + srow + 32 * j) * 1024 + h * HD + scc * 8; \
        kr[j] = *(const u32x4*)(Kg + g_); vr[j] = *(const u32x4*)(Vg + g_); } } while (0)
#define ATT_WRITE(buf) do { _Pragma("unroll") for (int j = 0; j < 2; ++j) { \
        *(LAS u32x4*)(lds + OFF_K + (buf) * KBUF + (srow + 32 * j) * KST + scc * 16) = kr[j]; \
        *(LAS u32x4*)(lds + OFF_V + (buf) * VBUF + (srow + 32 * j) * VST + scc * 16) = vr[j]; } } while (0)
    ATT_LOAD(ktmax); ATT_WRITE(0); __syncthreads();
    int buf = 0;
    for (int kt = ktmax; kt >= 0; --kt) {
        if (kt > 0) ATT_LOAD(kt - 1);
        const bool started = (64 * kt <= t0 + 31);
        if (started && !wave_done) {
            const LAS unsigned char* Kl = lds + OFF_K + buf * KBUF; const LAS unsigned char* Vl = lds + OFF_V + buf * VBUF;
            f32x16 sacc[2];
            asm volatile("" : "+v"(qoff));
            bf16x8 qf[8];
#pragma unroll
            for (int s = 0; s < 8; ++s) qf[s] = *(const bf16x8*)(Q + qoff + 16 * s);
#pragma unroll
            for (int sub = 0; sub < 2; ++sub) {
#pragma unroll
                for (int r = 0; r < 16; ++r) sacc[sub][r] = 0.f;
#pragma unroll
                for (int s = 0; s < 8; ++s) { const bf16x8 kf = *(const LAS bf16x8*)(Kl + (32 * sub + c) * KST + (16 * s + 8 * hh) * 2);
                    sacc[sub] = __builtin_amdgcn_mfma_f32_32x32x16_bf16(kf, qf[s], sacc[sub], 0, 0, 0); }
            }
            const bool need_mask = (64 * kt + 63 >= t0);
            if (MIXER == 0) {
#pragma unroll
                for (int sub = 1; sub >= 0; --sub) {
                    float lb[16];
#pragma unroll
                    for (int r = 0; r < 16; ++r) { const float z = sacc[sub][r]; float l = -flog2(1.f + fexp2(z));
                        if (need_mask) { const int sidx = 64 * kt + 32 * sub + (r & 3) + 8 * (r >> 2) + 4 * hh; l = (sidx < tq) ? l : 0.f; }
                        lb[r] = l; }
                    float Glo[4], Ghi[4];
#pragma unroll
                    for (int g = 0; g < 4; ++g) { lb[4 * g + 2] += lb[4 * g + 3]; lb[4 * g + 1] += lb[4 * g + 2]; lb[4 * g] += lb[4 * g + 1];
                        const unsigned gu = __builtin_bit_cast(unsigned, lb[4 * g]); const auto rr = __builtin_amdgcn_permlane32_swap(gu, gu, false, false);
                        Glo[g] = __builtin_bit_cast(float, (unsigned)rr[0]); Ghi[g] = __builtin_bit_cast(float, (unsigned)rr[1]); }
                    float E[8];
                    E[7] = carry; E[6] = E[7] + Ghi[3]; E[5] = E[6] + Glo[3]; E[4] = E[5] + Ghi[2]; E[3] = E[4] + Glo[2]; E[2] = E[3] + Ghi[1]; E[1] = E[2] + Glo[1]; E[0] = E[1] + Ghi[0];
                    carry = E[0] + Glo[0];
#pragma unroll
                    for (int g = 0; g < 4; ++g) { const float Eo = __builtin_fmaf(nhf, Ghi[g], E[2 * g + 1]);
#pragma unroll
                        for (int i = 0; i < 4; ++i) { const int r = 4 * g + i; float w = fexp2(sacc[sub][r] + lb[r] + Eo);
                            if (need_mask) { const int sidx = 64 * kt + 32 * sub + (r & 3) + 8 * (r >> 2) + 4 * hh; w = (sidx < tq) ? w : 0.f; }
                            sacc[sub][r] = w; } }
                }
            } else {
                float mx = -1e30f;
#pragma unroll
                for (int sub = 0; sub < 2; ++sub)
#pragma unroll
                    for (int g = 0; g < 4; ++g) { const f32x4 fs = *(const LAS f32x4*)(F2 + 64 * kt + 32 * sub + 8 * g + 4 * hh);
#pragma unroll
                        for (int i = 0; i < 4; ++i) { const int r = 4 * g + i; float xv = sacc[sub][r] + (Ft - fs[i]);
                            if (need_mask) { const int sidx = 64 * kt + 32 * sub + 8 * g + 4 * hh + i; xv = (sidx <= tq) ? xv : -1e30f; }
                            sacc[sub][r] = xv; mx = fmaxf(mx, xv); } }
                { const unsigned mu = __builtin_bit_cast(unsigned, mx); const auto rr = __builtin_amdgcn_permlane32_swap(mu, mu, false, false);
                  mx = fmaxf(__builtin_bit_cast(float, (unsigned)rr[0]), __builtin_bit_cast(float, (unsigned)rr[1])); }
                const float mnew = fmaxf(mrun, mx);
                const float alpha = fexp2(mrun - mnew);
                float ps = 0.f;
#pragma unroll
                for (int sub = 0; sub < 2; ++sub)
#pragma unroll
                    for (int r = 0; r < 16; ++r) { const float p = fexp2(sacc[sub][r] - mnew); sacc[sub][r] = p; ps += p; }
                lsum = lsum * alpha + ps;
                if (__any(mnew > mrun)) {
#pragma unroll
                    for (int d = 0; d < 4; ++d)
#pragma unroll
                        for (int r = 0; r < 16; ++r) oacc[d][r] *= alpha;
                }
                mrun = mnew;
            }
#pragma unroll
            for (int ks = 0; ks < 4; ++ks) { const int sub = ks >> 1, rb = 8 * (ks & 1);
                u32x4 pw; pw.x = pk2(sacc[sub][rb + 0], sacc[sub][rb + 1]); pw.y = pk2(sacc[sub][rb + 2], sacc[sub][rb + 3]); pw.z = pk2(sacc[sub][rb + 4], sacc[sub][rb + 5]); pw.w = pk2(sacc[sub][rb + 6], sacc[sub][rb + 7]);
                const bf16x8 pf = __builtin_bit_cast(bf16x8, pw);
                const LAS unsigned char* vb = Vl + (16 * ks + 4 * hh + ((lane & 15) >> 2)) * VST + (16 * ((lane >> 4) & 1) + 4 * (lane & 3)) * 2;
#pragma unroll
                for (int d = 0; d < 4; ++d) {
                    const s16x4 a0 = __builtin_amdgcn_ds_read_tr16_b64_v4i16((LAS s16x4*)(vb + d * 64));
                    const s16x4 a1 = __builtin_amdgcn_ds_read_tr16_b64_v4i16((LAS s16x4*)(vb + d * 64 + 8 * VST));
                    const bf16x8 af = {a0[0], a0[1], a0[2], a0[3], a1[0], a1[1], a1[2], a1[3]};
                    oacc[d] = __builtin_amdgcn_mfma_f32_32x32x16_bf16(af, pf, oacc[d], 0, 0, 0); }
            }
        }
        if (kt > 0) ATT_WRITE(buf ^ 1);
        if (kt > 0 && started && !wave_done) {
            if (MIXER == 0) wave_done = __all(carry < -THR_SB);
            else wave_done = __all(qk_bound + (Ft - F2[64 * kt - 1]) - mrun < -THR_FOX);
        }
        if (lane == 0) flg[(kt & 1) * 8 + wid] = wave_done ? 1u : 0u;
        __syncthreads();
        buf ^= 1;
        { unsigned alld = 1u;
#pragma unroll
          for (int w = 0; w < 8; ++w) alld &= flg[(kt & 1) * 8 + w];
          if (alld) break; }
    }
#undef ATT_LOAD
#undef ATT_WRITE
    float inv = 1.f;
    if (MIXER == 1) { const unsigned lu = __builtin_bit_cast(unsigned, lsum); const auto rr = __builtin_amdgcn_permlane32_swap(lu, lu, false, false);
        inv = 1.f / (__builtin_bit_cast(float, (unsigned)rr[0]) + __builtin_bit_cast(float, (unsigned)rr[1])); }
    bf16_t* op = O + (rowbase + tq) * 2048 + 4 * hh;
#pragma unroll
    for (int d = 0; d < 4; ++d)
#pragma unroll
        for (int g = 0; g < 4; ++g) { u32x2 w; w.x = pk2(oacc[d][4 * g] * inv, oacc[d][4 * g + 1] * inv); w.y = pk2(oacc[d][4 * g + 2] * inv, oacc[d][4 * g + 3] * inv);
            *(u32x2*)(op + 32 * d + 8 * g) = w; }
}

__device__ __forceinline__ void attn_phase(const Params& P, LAS unsigned char* lds, int vcu, int G) {
    const int tid = threadIdx.x, lane = tid & 63, wid = __builtin_amdgcn_readfirstlane(tid >> 6);
    unsigned char* ws = P.ws;
    const bf16_t* QKV = (const bf16_t*)(ws + WS_QKV); const size_t TS = (size_t)T_TOK * 1024;
    bf16_t* OAB = (bf16_t*)(ws + WS_H); const float* LOGF = (const float*)(ws + WS_LOGF);
    unsigned* qctr = (unsigned*)(ws + WS_CTL + 196608);
    const unsigned* KMAXW = (const unsigned*)(ws + WS_CTL + 200704);
    volatile LAS unsigned* uw = (volatile LAS unsigned*)(lds + OFF_UNIT);
    for (;;) {
        if (tid == 0) uw[0] = atomicAdd(qctr, 1u);
        __syncthreads();
        const unsigned u = uw[0];
        __syncthreads();
        if (u >= 512u) break;
        const int mixer = (u < 256u) ? 1 : 0, v = (int)(u & 255u), qb = 15 - (v >> 4), bh = v & 15, b = bh >> 3, h = bh & 7;
        if (mixer == 0) {
            attn_unit<0>(lds, QKV, QKV + TS, QKV + 2 * TS, OAB + h * HD, b, h, qb, 0.f, tid, lane, wid);
        } else {
            float k2 = 0.f;
#pragma unroll
            for (int w = 0; w < 4; ++w) k2 += __builtin_bit_cast(float, __hip_atomic_load(KMAXW + bh * 4 + w, __ATOMIC_RELAXED, __HIP_MEMORY_SCOPE_AGENT));
            const float kmax = sqrtf(k2) * 1.01f;
            build_cumf(lds, LOGF, b, h, 256 * (qb + 1), tid, lane, wid);
            attn_unit<1>(lds, QKV + 3 * TS, QKV + 4 * TS, QKV + 5 * TS, OAB + 1024 + h * HD, b, h, qb, kmax, tid, lane, wid);
        }
        __syncthreads();
    }
}
}

namespace peer {
__device__ __forceinline__ unsigned sortable(float f) { const unsigned u = __builtin_bit_cast(unsigned, f); return (u & 0x80000000u) ? ~u : (u | 0x80000000u); }
__device__ __forceinline__ float unsortable(unsigned k) { const unsigned u = (k & 0x80000000u) ? (k & 0x7fffffffu) : ~k; return __builtin_bit_cast(float, u); }
template <int N> __device__ __forceinline__ unsigned umax_all(const unsigned (&k)[N]) {
    unsigned m = k[0];
#pragma unroll
    for (int q = 1; q < N; ++q) m = m > k[q] ? m : k[q];
    return m;
}

__device__ __forceinline__ void topk_phase(const Params& P, LAS unsigned char* lds, int vcu, int G) {
    const int tid = threadIdx.x, lane = tid & 63, wave = __builtin_amdgcn_readfirstlane(tid >> 6);
    const int c = lane & 31, hh = lane >> 5;
    const int gw = vcu * NWAVES + wave, NGW = G * NWAVES;
    unsigned char* ws = P.ws;
    const bf16_t* Q2 = (const bf16_t*)(ws + WS_Q2); const bf16_t* SKB = (const bf16_t*)(ws + WS_SKB);
    const float* ROWSS = (const float*)(ws + WS_CTL); int* IDS = (int*)(ws + WS_IDS); float* GATES = (float*)(ws + WS_GATES);
    LAS unsigned char* scr = lds + wave * 4096;
    for (int task = gw; task < 2048; task += NGW) {
        const int tg = task >> 3, hd = task & 7, tok = tg * 32 + c;
#pragma unroll 1
        for (int p = 0; p < 2; ++p) {
            bf16x8 qf[8];
            { const bf16_t* qp = Q2 + (size_t)tok * DM + hd * 256 + p * 128 + 8 * hh;
#pragma unroll
              for (int s = 0; s < 8; ++s) qf[s] = *(const bf16x8*)(qp + 16 * s); }
            unsigned keys[64];
#pragma unroll
            for (int sub = 0; sub < 4; ++sub) {
                f32x16 acc;
#pragma unroll
                for (int r = 0; r < 16; ++r) acc[r] = 0.f;
                const bf16_t* kp = SKB + ((size_t)(hd * 2 + p) * 128 + 32 * sub + c) * 128 + 8 * hh;
#pragma unroll
                for (int s = 0; s < 8; ++s) { const bf16x8 kf = *(const bf16x8*)(kp + 16 * s); acc = __builtin_amdgcn_mfma_f32_32x32x16_bf16(kf, qf[s], acc, 0, 0, 0); }
#pragma unroll
                for (int r = 0; r < 16; ++r) { const int nlo = 127 - (32 * sub + (r & 3) + 8 * (r >> 2)); keys[sub * 16 + r] = (sortable(acc[r]) & ~127u) | (unsigned)(nlo - 4 * hh); }
            }
            unsigned top[16];
#pragma unroll
            for (int i = 0; i < 16; ++i) {
                unsigned m = umax_all<64>(keys);
                const auto rr = __builtin_amdgcn_permlane32_swap(m, m, false, false);
                m = (unsigned)rr[0] > (unsigned)rr[1] ? (unsigned)rr[0] : (unsigned)rr[1];
                top[i] = m;
#pragma unroll
                for (int q = 0; q < 64; ++q) keys[q] = (keys[q] == m) ? 0u : keys[q];
            }
            if (hh == 0) {
#pragma unroll
                for (int w = 0; w < 4; ++w) *(LAS u32x4*)(scr + (c * 2 + p) * 64 + w * 16) = (u32x4){top[4 * w], top[4 * w + 1], top[4 * w + 2], top[4 * w + 3]};
            }
        }
        LDS_WAIT();
        float s1[16], s2[16];
#pragma unroll
        for (int w = 0; w < 4; ++w) { const u32x4 a = *(const LAS u32x4*)(scr + (c * 2) * 64 + w * 16), b2 = *(const LAS u32x4*)(scr + (c * 2 + 1) * 64 + w * 16);
#pragma unroll
            for (int e = 0; e < 4; ++e) { s1[4 * w + e] = unsortable((a[e] & ~127u) | 64u); s2[4 * w + e] = unsortable((b2[e] & ~127u) | 64u); } }
        unsigned ck[50];
        { int n = 0;
#pragma unroll
          for (int i = 0; i < 16; ++i)
#pragma unroll
              for (int j = 0; j < 16; ++j) if ((i + 1) * (j + 1) <= 16) { ck[n] = (sortable(s1[i] + s2[j]) & ~255u) | (unsigned)(255 - (i * 16 + j)); ++n; } }
        unsigned t2[16];
#pragma unroll
        for (int k = 0; k < 16; ++k) { const unsigned m = umax_all<50>(ck); t2[k] = m;
#pragma unroll
            for (int q = 0; q < 50; ++q) ck[q] = (ck[q] == m) ? 0u : ck[q]; }
        int ids[16]; float sc[16];
#pragma unroll
        for (int k = 0; k < 16; ++k) { const unsigned pos = 255u - (t2[k] & 255u);
            const unsigned k1 = *(const LAS unsigned*)(scr + (c * 2) * 64 + (pos >> 4) * 4), k2 = *(const LAS unsigned*)(scr + (c * 2 + 1) * 64 + (pos & 15u) * 4);
            ids[k] = (int)((127u - (k1 & 127u)) * 128u + (127u - (k2 & 127u))); sc[k] = unsortable((t2[k] & ~255u) | 128u); }
        LDS_WAIT();
        const float rs = 1.0f / sqrtf(ROWSS[tok] * (1.f / DM) + EPS);
        float ev[16], Z = 0.f;
#pragma unroll
        for (int k = 0; k < 16; ++k) { ev[k] = fexp2((sc[k] - sc[0]) * rs * LOG2E); Z += ev[k]; }
        const float iz = 1.f / Z;
        int* ip = IDS + (size_t)tok * 128 + hd * 16; float* gp = GATES + (size_t)tok * 128 + hd * 16;
        if (hh == 0) {
#pragma unroll
            for (int k = 0; k < 8; ++k) { ip[k] = ids[k]; gp[k] = ev[k] * iz; }
        } else {
#pragma unroll
            for (int k = 8; k < 16; ++k) { ip[k] = ids[k]; gp[k] = ev[k] * iz; }
        }
    }
}


__device__ __forceinline__ void topk_naive(const Params& P, LAS unsigned char* lds, int vcu, int G) {
    const int tid = threadIdx.x, lane = tid & 63, wave = __builtin_amdgcn_readfirstlane(tid >> 6);
    const int gw = vcu * NWAVES + wave, NGW = G * NWAVES;
    unsigned char* ws = P.ws;
    const bf16_t* Q2 = (const bf16_t*)(ws + WS_Q2);
    const float* ROWSS = (const float*)(ws + WS_CTL); int* IDS = (int*)(ws + WS_IDS); float* GATES = (float*)(ws + WS_GATES);
    LAS float* sv = (LAS float*)(lds + wave * 1024);
    LAS int* si = (LAS int*)(lds + wave * 1024 + 256);
    for (int task = gw; task < T_TOK * 8; task += NGW) {
        const int tok = task >> 3, hd = task & 7;
        for (int p = 0; p < 2; ++p) {
            float v0 = 0.f, v1 = 0.f;
            for (int cc = 0; cc < 128; ++cc) { const float q = bf_lo((unsigned)Q2[(size_t)tok * DM + hd * 256 + p * 128 + cc]);
                v0 += q * P.sub_keys[((size_t)(hd * 2 + p) * 128 + lane) * 128 + cc]; v1 += q * P.sub_keys[((size_t)(hd * 2 + p) * 128 + lane + 64) * 128 + cc]; }
            for (int i = 0; i < 16; ++i) {
                float bv = v0 >= v1 ? v0 : v1; int bi = v0 >= v1 ? lane : lane + 64;
                for (int o = 1; o < 64; o <<= 1) { const float ov = __shfl_xor(bv, o); const int oi = __shfl_xor(bi, o); if (ov > bv || (ov == bv && oi < bi)) { bv = ov; bi = oi; } }
                if (lane == 0) { sv[p * 16 + i] = bv; si[p * 16 + i] = bi; }
                if (bi == lane) v0 = -3e38f; if (bi == lane + 64) v1 = -3e38f;
            }
        }
        LDS_WAIT();
        float cv[4]; for (int q = 0; q < 4; ++q) { const int pos = lane * 4 + q; cv[q] = sv[pos >> 4] + sv[16 + (pos & 15)]; }
        float sel_v = 0.f; int sel_id = 0; float mx = 0.f;
        for (int k = 0; k < 16; ++k) {
            float bv = cv[0]; int bi = lane * 4;
            for (int q = 1; q < 4; ++q) if (cv[q] > bv) { bv = cv[q]; bi = lane * 4 + q; }
            for (int o = 1; o < 64; o <<= 1) { const float ov = __shfl_xor(bv, o); const int oi = __shfl_xor(bi, o); if (ov > bv || (ov == bv && oi < bi)) { bv = ov; bi = oi; } }
            if (k == 0) mx = bv;
            if (lane == k) { sel_v = bv; sel_id = si[bi >> 4] * 128 + si[16 + (bi & 15)]; }
            for (int q = 0; q < 4; ++q) if (bi == lane * 4 + q) cv[q] = -3e38f;
        }
        const float rs = 1.0f / sqrtf(ROWSS[tok] * (1.f / DM) + EPS);
        float ev = (lane < 16) ? expf((sel_v - mx) * rs) : 0.f;
        const float Z = wave_sum(ev);
        if (lane < 16) { IDS[(size_t)tok * 128 + hd * 16 + lane] = sel_id; GATES[(size_t)tok * 128 + hd * 16 + lane] = ev / Z; }
        LDS_WAIT();
    }
}

__device__ __forceinline__ float dot8(u32x4 a, u32x4 b, float acc) {
    const unsigned a0 = a[0], a1 = a[1], a2 = a[2], a3 = a[3], b0 = b[0], b1 = b[1], b2 = b[2], b3 = b[3];
    acc = __builtin_amdgcn_fdot2_f32_bf16(__builtin_bit_cast(bf16v2, a0), __builtin_bit_cast(bf16v2, b0), acc, false);
    acc = __builtin_amdgcn_fdot2_f32_bf16(__builtin_bit_cast(bf16v2, a1), __builtin_bit_cast(bf16v2, b1), acc, false);
    acc = __builtin_amdgcn_fdot2_f32_bf16(__builtin_bit_cast(bf16v2, a2), __builtin_bit_cast(bf16v2, b2), acc, false);
    acc = __builtin_amdgcn_fdot2_f32_bf16(__builtin_bit_cast(bf16v2, a3), __builtin_bit_cast(bf16v2, b3), acc, false);
    return acc;
}
__device__ __forceinline__ float gelu_tanh(float a) { const float t = 1.5957691216f * (a + 0.044715f * a * a * a); return a * frcp(1.f + fexp2(-LOG2E * t)); }

__device__ __forceinline__ void gather_phase(const Params& P, int vcu, int G) {
    const int tid = threadIdx.x, lane = tid & 63, wave = __builtin_amdgcn_readfirstlane(tid >> 6);
    const int gw = vcu * NWAVES + wave, NGW = G * NWAVES;
    unsigned char* ws = P.ws;
    const float* X1 = (const float*)(ws + WS_X1); const float* ROWSS = (const float*)(ws + WS_CTL);
    const int* IDS = (const int*)(ws + WS_IDS); const float* GATES = (const float*)(ws + WS_GATES);
    const unsigned char* EU = ws + WS_EU; const unsigned char* EV = ws + WS_EV;
    const float* SU = (const float*)(ws + WS_SU); const float* SV = (const float*)(ws + WS_SV);
    const bool b5 = (lane >> 5) & 1, b4 = (lane >> 4) & 1, b3 = (lane >> 3) & 1;
    for (int tok = gw; tok < T_TOK; tok += NGW) {
        f32x4 xv[2][4]; u32x4 hq[2];
        const float rs = 1.0f / sqrtf(ROWSS[tok] * (1.f / DM) + EPS);
        float hmx = 0.f;
#pragma unroll
        for (int j = 0; j < 2; ++j)
#pragma unroll
            for (int c4 = 0; c4 < 4; ++c4) { const size_t o = (size_t)tok * DM + 16 * lane + 1024 * j + 4 * c4; xv[j][c4] = *(const f32x4*)(X1 + o); }
        f32x4 hv[2][4];
#pragma unroll
        for (int j = 0; j < 2; ++j)
#pragma unroll
            for (int c4 = 0; c4 < 4; ++c4) { const f32x4 g = *(const f32x4*)(P.g_ffn + 16 * lane + 1024 * j + 4 * c4); hv[j][c4] = xv[j][c4] * rs * g;
                hmx = fmaxf(hmx, fmaxf(fmaxf(fabsf(hv[j][c4][0]), fabsf(hv[j][c4][1])), fmaxf(fabsf(hv[j][c4][2]), fabsf(hv[j][c4][3])))); }
#pragma unroll
        for (int o = 1; o < 64; o <<= 1) hmx = fmaxf(hmx, __shfl_xor(hmx, o));
        hmx = fmaxf(hmx, 1e-30f);
        const float hinv = 127.f / hmx, hscale = hmx * (1.f / 127.f);
#pragma unroll
        for (int j = 0; j < 2; ++j)
#pragma unroll
            for (int c4 = 0; c4 < 4; ++c4) { unsigned w = 0;
#pragma unroll
                for (int e = 0; e < 4; ++e) w |= ((unsigned)(int)__builtin_rintf(hv[j][c4][e] * hinv) & 255u) << (8 * e);
                hq[j][c4] = w; }
        const int ida = IDS[(size_t)tok * 128 + lane], idb = IDS[(size_t)tok * 128 + 64 + lane];
        const float sua = SU[ida], sub = SU[idb], sva = SV[ida], svb = SV[idb];
        float wreg[16];
#pragma unroll
        for (int bt = 0; bt < 16; ++bt) {
            int part[8]; u32x4 ud[8][2];
#pragma unroll
            for (int q = 0; q < 8; ++q) { const int k = bt * 8 + q; const int e = __builtin_amdgcn_readlane(k < 64 ? ida : idb, k & 63);
                const unsigned char* ur = EU + (size_t)e * DM + 16 * lane;
                ud[q][0] = *(const u32x4*)ur; ud[q][1] = *(const u32x4*)(ur + 1024); }
#pragma unroll
            for (int q = 0; q < 8; ++q) { int a = 0;
#pragma unroll
                for (int j = 0; j < 2; ++j)
#pragma unroll
                    for (int c4 = 0; c4 < 4; ++c4) a = __builtin_amdgcn_sdot4((int)ud[q][j][c4], (int)hq[j][c4], a, false);
                part[q] = a; }
            int p1[4], p2[2];
#pragma unroll
            for (int q = 0; q < 4; ++q) { const int send = b5 ? part[q] : part[q + 4], keep = b5 ? part[q + 4] : part[q]; p1[q] = keep + __shfl_xor(send, 32); }
#pragma unroll
            for (int q = 0; q < 2; ++q) { const int send = b4 ? p1[q] : p1[q + 2], keep = b4 ? p1[q + 2] : p1[q]; p2[q] = keep + __shfl_xor(send, 16); }
            int p3; { const int send = b3 ? p2[0] : p2[1], keep = b3 ? p2[1] : p2[0]; p3 = keep + __shfl_xor(send, 8); }
            p3 += __shfl_xor(p3, 4); p3 += __shfl_xor(p3, 2); p3 += __shfl_xor(p3, 1);
            const int ksel = bt * 8 + (lane >> 3);
            const float su_k = __shfl(bt < 8 ? sua : sub, ksel & 63), sv_k = __shfl(bt < 8 ? sva : svb, ksel & 63);
            const float gate = GATES[(size_t)tok * 128 + ksel];
            const float act = (float)p3 * (su_k * hscale);
            wreg[bt] = gate * gelu_tanh(act) * sv_k;
        }
        f32x4 acc[2][4]; float wsum = 0.f;
#pragma unroll
        for (int j = 0; j < 2; ++j)
#pragma unroll
            for (int c4 = 0; c4 < 4; ++c4) acc[j][c4] = (f32x4){0.f, 0.f, 0.f, 0.f};
#pragma unroll
        for (int bt = 0; bt < 16; ++bt) {
            u32x4 vd[8][2];
#pragma unroll
            for (int q = 0; q < 8; ++q) { const int k = bt * 8 + q; const int e = __builtin_amdgcn_readlane(k < 64 ? ida : idb, k & 63);
                const unsigned char* vr = EV + (size_t)e * DM + 16 * lane;
                vd[q][0] = *(const u32x4*)vr; vd[q][1] = *(const u32x4*)(vr + 1024); }
#pragma unroll
            for (int q = 0; q < 8; ++q) { const float w = __builtin_bit_cast(float, __builtin_amdgcn_readlane(__builtin_bit_cast(int, wreg[bt]), 8 * q));
                wsum += w;
#pragma unroll
                for (int j = 0; j < 2; ++j)
#pragma unroll
                    for (int c4 = 0; c4 < 4; ++c4) { const unsigned u = vd[q][j][c4];
                        acc[j][c4] += w * (f32x4){(float)(u & 255u), (float)((u >> 8) & 255u), (float)((u >> 16) & 255u), (float)(u >> 24)}; } }
        }
        float ss = 0.f; const float corr = 128.f * wsum;
#pragma unroll
        for (int j = 0; j < 2; ++j)
#pragma unroll
            for (int c4 = 0; c4 < 4; ++c4) { const f32x4 v = (DBG == 1 || DBG == 2) ? xv[j][c4] : xv[j][c4] + (acc[j][c4] - corr); xv[j][c4] = v; ss += (v[0] * v[0] + v[1] * v[1]) + (v[2] * v[2] + v[3] * v[3]); }
        const float rs2 = 1.0f / sqrtf(wave_sum(ss) * (1.f / DM) + EPS);
#pragma unroll
        for (int j = 0; j < 2; ++j)
#pragma unroll
            for (int c4 = 0; c4 < 4; ++c4) { const size_t o = (size_t)tok * DM + 16 * lane + 1024 * j + 4 * c4;
                const f32x4 g = *(const f32x4*)(P.g_final + 16 * lane + 1024 * j + 4 * c4);
                *(f32x4*)(P.out + o) = xv[j][c4] * rs2 * g; }
    }
}


__device__ __forceinline__ int dot16(u32x4 a, u32x4 b, int acc) {
    acc = __builtin_amdgcn_sdot4((int)a[0], (int)b[0], acc, false); acc = __builtin_amdgcn_sdot4((int)a[1], (int)b[1], acc, false);
    acc = __builtin_amdgcn_sdot4((int)a[2], (int)b[2], acc, false); acc = __builtin_amdgcn_sdot4((int)a[3], (int)b[3], acc, false);
    return acc;
}
__device__ __forceinline__ void gather_sweep(const Params& P, LAS unsigned char* lds, int vcu, int G) {
    const int tid = threadIdx.x, lane = tid & 63, wave = __builtin_amdgcn_readfirstlane(tid >> 6);
    const int gw = vcu * NWAVES + wave, NGW = G * NWAVES;
    const int g = lane >> 3, i = lane & 7;
    unsigned char* ws = P.ws;
    const float* X1 = (const float*)(ws + WS_X1); const float* ROWSS = (const float*)(ws + WS_CTL);
    const int* IDS = (const int*)(ws + WS_IDS); const float* GATES = (const float*)(ws + WS_GATES);
    const unsigned char* EU = ws + WS_EU; const unsigned char* EV = ws + WS_EV;
    const float* SU = (const float*)(ws + WS_SU); const float* SV = (const float*)(ws + WS_SV);
    LAS unsigned char* wl = lds + wave * 16384;
    const bool b2 = (lane >> 2) & 1, b1 = (lane >> 1) & 1, b0 = lane & 1, B2 = (lane >> 5) & 1, B1 = (lane >> 4) & 1, B0 = (lane >> 3) & 1;
    for (int tg = gw; tg < T_TOK / 4; tg += NGW) {
        const int tok0 = tg * 4;
        float hs[4];
#pragma unroll
        for (int j = 0; j < 4; ++j) { const int tok = tok0 + j;
            const float rs = 1.0f / sqrtf(ROWSS[tok] * (1.f / DM) + EPS);
            f32x4 hv[8]; float hmx = 0.f;
#pragma unroll
            for (int q = 0; q < 8; ++q) { const f32x4 xv = *((const f32x4*)(X1 + (size_t)tok * DM) + lane + 64 * q); const f32x4 gn = *((const f32x4*)P.g_ffn + lane + 64 * q);
                hv[q] = xv * rs * gn; hmx = fmaxf(hmx, fmaxf(fmaxf(fabsf(hv[q][0]), fabsf(hv[q][1])), fmaxf(fabsf(hv[q][2]), fabsf(hv[q][3])))); }
#pragma unroll
            for (int o = 1; o < 64; o <<= 1) hmx = fmaxf(hmx, __shfl_xor(hmx, o));
            hmx = fmaxf(hmx, 1e-30f); const float hinv = 127.f / hmx; hs[j] = hmx * (1.f / 127.f);
#pragma unroll
            for (int q = 0; q < 8; ++q) { unsigned w = 0;
#pragma unroll
                for (int e = 0; e < 4; ++e) w |= ((unsigned)(int)__builtin_rintf(hv[q][e] * hinv) & 255u) << (8 * e);
                *(LAS unsigned*)(wl + j * 2048 + 4 * (lane + 64 * q)) = w; }
#pragma unroll
            for (int hf = 0; hf < 2; ++hf) { const int k = lane + 64 * hf; const int id = IDS[(size_t)tok * 128 + k];
                *(LAS unsigned*)(wl + 8192 + (j * 128 + k) * 4) = (unsigned)id * 2048u;
                *(LAS float*)(wl + 10240 + (j * 128 + k) * 4) = GATES[(size_t)tok * 128 + k] * SV[id];
                *(LAS float*)(wl + 12288 + (j * 128 + k) * 4) = SU[id]; }
        }
        LDS_WAIT();
        int accu[4][16];
#pragma unroll
        for (int j = 0; j < 4; ++j)
#pragma unroll
            for (int m = 0; m < 16; ++m) accu[j][m] = 0;
#pragma unroll 1
        for (int sl = 0; sl < 16; ++sl) {
            const unsigned char* ub = EU + 128 * sl + 16 * i;
#pragma unroll
            for (int j = 0; j < 4; ++j) {
                const u32x4 hqc = *(const LAS u32x4*)(wl + j * 2048 + 128 * sl + 16 * i);
                u32x4 d[16];
#pragma unroll
                for (int m = 0; m < 16; ++m) { const unsigned off = *(const LAS unsigned*)(wl + 8192 + (j * 128 + 8 * m + g) * 4); d[m] = *(const u32x4*)(ub + off); }
#pragma unroll
                for (int m = 0; m < 16; ++m) accu[j][m] = dot16(d[m], hqc, accu[j][m]);
                __builtin_amdgcn_sched_barrier(0);
            }
        }
        float corr[4];
#pragma unroll
        for (int j = 0; j < 4; ++j) {
            int r1[8], r2[4], r3[2];
#pragma unroll
            for (int m = 0; m < 8; ++m) { const int send = b2 ? accu[j][m] : accu[j][m + 8], keep = b2 ? accu[j][m + 8] : accu[j][m]; r1[m] = keep + __shfl_xor(send, 4); }
#pragma unroll
            for (int m = 0; m < 4; ++m) { const int send = b1 ? r1[m] : r1[m + 4], keep = b1 ? r1[m + 4] : r1[m]; r2[m] = keep + __shfl_xor(send, 2); }
#pragma unroll
            for (int m = 0; m < 2; ++m) { const int send = b0 ? r2[m] : r2[m + 2], keep = b0 ? r2[m + 2] : r2[m]; r3[m] = keep + __shfl_xor(send, 1); }
            float wsum = 0.f;
#pragma unroll
            for (int m = 0; m < 2; ++m) { const int k = 16 * i + 8 * m + g;
                const float act = (float)r3[m] * (hs[j] * *(const LAS float*)(wl + 12288 + (j * 128 + k) * 4));
                const float w = *(const LAS float*)(wl + 10240 + (j * 128 + k) * 4) * gelu_tanh(act);
                *(LAS float*)(wl + 10240 + (j * 128 + k) * 4) = w; wsum += w; }
            corr[j] = 128.f * wave_sum(wsum);
        }
        LDS_WAIT();
        float ssq[4] = {0.f, 0.f, 0.f, 0.f};
#pragma unroll 1
        for (int sl = 0; sl < 16; ++sl) {
            const unsigned char* vb = EV + 128 * sl + 16 * i;
#pragma unroll
            for (int j = 0; j < 4; ++j) {
                u32x4 d[16]; float wv[16];
#pragma unroll
                for (int m = 0; m < 16; ++m) { const unsigned off = *(const LAS unsigned*)(wl + 8192 + (j * 128 + 8 * m + g) * 4); wv[m] = *(const LAS float*)(wl + 10240 + (j * 128 + 8 * m + g) * 4); d[m] = *(const u32x4*)(vb + off); }
                float ca[16];
#pragma unroll
                for (int b = 0; b < 16; ++b) ca[b] = 0.f;
#pragma unroll
                for (int m = 0; m < 16; ++m)
#pragma unroll
                    for (int c4 = 0; c4 < 4; ++c4) { const unsigned u = d[m][c4];
                        ca[4 * c4 + 0] += wv[m] * (float)(u & 255u); ca[4 * c4 + 1] += wv[m] * (float)((u >> 8) & 255u);
                        ca[4 * c4 + 2] += wv[m] * (float)((u >> 16) & 255u); ca[4 * c4 + 3] += wv[m] * (float)(u >> 24); }
                float c1[8], c2[4], c3[2];
#pragma unroll
                for (int b = 0; b < 8; ++b) { const float send = B2 ? ca[b] : ca[b + 8], keep = B2 ? ca[b + 8] : ca[b]; c1[b] = keep + __shfl_xor(send, 32); }
#pragma unroll
                for (int b = 0; b < 4; ++b) { const float send = B1 ? c1[b] : c1[b + 4], keep = B1 ? c1[b + 4] : c1[b]; c2[b] = keep + __shfl_xor(send, 16); }
#pragma unroll
                for (int b = 0; b < 2; ++b) { const float send = B0 ? c2[b] : c2[b + 2], keep = B0 ? c2[b + 2] : c2[b]; c3[b] = keep + __shfl_xor(send, 8); }
                const size_t o = (size_t)(tok0 + j) * DM + 128 * sl + 16 * i + 2 * g;
                const f32x2 xv = *(const f32x2*)(X1 + o);
                const f32x2 x2 = {xv[0] + (c3[0] - corr[j]), xv[1] + (c3[1] - corr[j])};
                ssq[j] += x2[0] * x2[0] + x2[1] * x2[1];
                *(f32x2*)(P.out + o) = x2;
                __builtin_amdgcn_sched_barrier(0);
            }
        }
#pragma unroll
        for (int j = 0; j < 4; ++j) { const float rs2 = 1.0f / sqrtf(wave_sum(ssq[j]) * (1.f / DM) + EPS);
            f32x4* orow = (f32x4*)(P.out + (size_t)(tok0 + j) * DM) + lane;
#pragma unroll
            for (int q = 0; q < 8; ++q) { const f32x4 gn = *((const f32x4*)P.g_final + lane + 64 * q); orow[64 * q] = orow[64 * q] * rs2 * gn; } }
        LDS_WAIT();
    }
}

__device__ __forceinline__ void gather_naive(const Params& P, int vcu, int G) {
    const int tid = threadIdx.x, lane = tid & 63, wave = __builtin_amdgcn_readfirstlane(tid >> 6);
    const int gw = vcu * NWAVES + wave, NGW = G * NWAVES;
    unsigned char* ws = P.ws;
    const float* X1 = (const float*)(ws + WS_X1); const float* ROWSS = (const float*)(ws + WS_CTL);
    const int* IDS = (const int*)(ws + WS_IDS); const float* GATES = (const float*)(ws + WS_GATES);
    for (int tok = gw; tok < T_TOK; tok += NGW) {
        float h2[32], acc[32];
        const float rs = 1.0f / sqrtf(ROWSS[tok] * (1.f / DM) + EPS);
#pragma unroll
        for (int i = 0; i < 32; ++i) { h2[i] = X1[(size_t)tok * DM + lane + 64 * i] * rs * P.g_ffn[lane + 64 * i]; acc[i] = 0.f; }
#pragma unroll 1
        for (int k = 0; k < 128; ++k) {
            const int e = IDS[(size_t)tok * 128 + k]; float a = 0.f;
            if (false) { const bf16_t* up = (const bf16_t*)(ws + WS_EU) + (size_t)e * DM + lane;
#pragma unroll
                for (int i = 0; i < 32; ++i) a += h2[i] * bf_lo((unsigned)up[64 * i]);
            } else { const float* up = P.e_u + (size_t)e * DM + lane;
#pragma unroll
                for (int i = 0; i < 32; ++i) a += h2[i] * up[64 * i]; }
            a = wave_sum(a);
            const float w = GATES[(size_t)tok * 128 + k] * gelu_tanh(a);
            if (false) { const bf16_t* vp = (const bf16_t*)(ws + WS_EV) + (size_t)e * DM + lane;
#pragma unroll
                for (int i = 0; i < 32; ++i) acc[i] += w * bf_lo((unsigned)vp[64 * i]);
            } else { const float* vp = P.e_v + (size_t)e * DM + lane;
#pragma unroll
                for (int i = 0; i < 32; ++i) acc[i] += w * vp[64 * i]; }
        }
        float ss = 0.f;
#pragma unroll
        for (int i = 0; i < 32; ++i) { acc[i] += X1[(size_t)tok * DM + lane + 64 * i]; ss += acc[i] * acc[i]; }
        const float rs2 = 1.0f / sqrtf(wave_sum(ss) * (1.f / DM) + EPS);
#pragma unroll
        for (int i = 0; i < 32; ++i) P.out[(size_t)tok * DM + lane + 64 * i] = acc[i] * rs2 * P.g_final[lane + 64 * i];
    }
}
}


#define XB_TMO      128
#define XB_XCNT(j)  (256  + 64 * (j))
#define XB_XSUB(j)  (1280 + 64 * (j))
#define XB_XGEN(j)  (2304 + 64 * (j))
#define XB_TOP      3328
#define XB_TOPGEN   3392
#define XCD_BAR_WORDS 3456
#define XB_SPIN_CAP (1u << 18)
__device__ __forceinline__ unsigned xb_ld(unsigned* p)              { return __hip_atomic_load(p, __ATOMIC_RELAXED, __HIP_MEMORY_SCOPE_AGENT); }
__device__ __forceinline__ unsigned xb_add(unsigned* p, unsigned v) { return __hip_atomic_fetch_add(p, v, __ATOMIC_RELAXED, __HIP_MEMORY_SCOPE_AGENT); }
__device__ __forceinline__ unsigned xb_xcc_id() { return (unsigned)__builtin_amdgcn_s_getreg((3 << 11) | 20) & 0xFu; }
#define XB_SPIN(cond, bar) do { unsigned _sp = 0; while (cond) { __builtin_amdgcn_s_sleep(1); \
    if ((++_sp & 255u) == 0u) { if (xb_ld(&(bar)[XB_TMO])) break; if (_sp > XB_SPIN_CAP) { atomicAdd(&(bar)[XB_TMO], 1u); break; } } } } while (0)
struct XcdBarrier { unsigned* bar; unsigned x; volatile LAS unsigned* st; };
__device__ __forceinline__ XcdBarrier xcd_barrier_post(unsigned* bar, volatile LAS unsigned* st) {
    XcdBarrier b; b.bar = bar; b.x = xb_xcc_id(); b.st = st;
    if (threadIdx.x == 0) (void)xb_add(&bar[XB_XCNT(b.x)], 1u);
    return b;
}
__device__ __forceinline__ void xcd_barrier_complete(unsigned* bar, unsigned x, unsigned& nloc, unsigned& nx) {
    const unsigned G = gridDim.x * gridDim.y * gridDim.z;
    unsigned sum, cnt, mine, sp = 0u;
    for (;;) {
        sum = 0u; cnt = 0u; mine = 0u;
#pragma unroll
        for (unsigned j = 0; j < 16; ++j) { const unsigned c = xb_ld(&bar[XB_XCNT(j)]); sum += c; cnt += (c > 0u) ? 1u : 0u; mine = (j == x) ? c : mine; }
        if (sum == G) break;
        __builtin_amdgcn_s_sleep(1);
        if ((++sp & 255u) == 0u) { if (xb_ld(&bar[XB_TMO])) break; if (sp > XB_SPIN_CAP) { atomicAdd(&bar[XB_TMO], 1u); break; } }
    }
    nloc = mine > 0u ? mine : 1u; nx = cnt > 0u ? cnt : 1u;
}
__device__ __forceinline__ void xcd_barrier(const XcdBarrier& b) {
    asm volatile("s_waitcnt vmcnt(0)" ::: "memory");
    __syncthreads();
    if (threadIdx.x == 0) {
        unsigned* bar = b.bar;
        __builtin_amdgcn_s_waitcnt(0);
        unsigned nloc = b.st[0], nx = b.st[1];
        if (nloc == 0u) { xcd_barrier_complete(bar, b.x, nloc, nx); b.st[0] = nloc; b.st[1] = nx; }
        const unsigned old = xb_add(&bar[XB_XSUB(b.x)], 1u);
        const unsigned gen = old / nloc;
        if (old + 1u == (gen + 1u) * nloc) {
            __builtin_amdgcn_fence(__ATOMIC_RELEASE, "agent");
            asm volatile("s_waitcnt vmcnt(0)" ::: "memory");
            const unsigned og = xb_add(&bar[XB_TOP], 1u);
            const unsigned tg = og / nx;
            if (og + 1u == (tg + 1u) * nx) xb_add(&bar[XB_TOPGEN], 1u);
            else XB_SPIN(xb_ld(&bar[XB_TOPGEN]) == tg, bar);
            __builtin_amdgcn_fence(__ATOMIC_ACQUIRE, "agent");
            xb_add(&bar[XB_XGEN(b.x)], 1u);
            asm volatile("s_waitcnt vmcnt(0)" ::: "memory");
        } else {
            XB_SPIN(xb_ld(&bar[XB_XGEN(b.x)]) == gen, bar);
            __builtin_amdgcn_fence(__ATOMIC_ACQUIRE, "agent");
            asm volatile("s_waitcnt vmcnt(0)" ::: "memory");
        }
    }
    __syncthreads();
}

__global__ void __launch_bounds__(NTHR, 2) mega_fwd(Params P) {
    extern __shared__ __attribute__((aligned(16))) unsigned char lds_raw[];
    LAS unsigned char* lds = (LAS unsigned char*)lds_raw;
    cg::grid_group grid = cg::this_grid();
    const int G = gridDim.x, bx = blockIdx.x;
    const int vcu = (G % 8 == 0) ? (bx % 8) * (G / 8) + bx / 8 : bx;
    unsigned char* ws = P.ws;
#ifndef ONLY_PHASE
#define ONLY_PHASE -1
#endif
#define IN(k) ((ONLY_PHASE < 0 || ONLY_PHASE == (k)) && P.ph_lo <= (k) && (k) < P.ph_hi)
    volatile LAS unsigned* bst = (volatile LAS unsigned*)(lds + 131072);
    if (threadIdx.x < 16) bst[threadIdx.x] = 0u;
    __syncthreads();
    const XcdBarrier xbar = xcd_barrier_post((unsigned*)(ws + WS_CTL + 131072), bst);
    if (P.ph_lo < 0) grid.sync();
#define SEAM(k) do { if (IN(k) && IN((k) + 1)) xcd_barrier(xbar); } while (0)
    for (int rep_ = 0; rep_ < (REPK == 0 ? 2 : 1); ++rep_) if (IN(0)) p0_prologue(P, lds, vcu, G);
    SEAM(0);
    for (int rep_ = 0; rep_ < (REPK == 1 ? 2 : 1); ++rep_) if (IN(1)) {
        pg8::Gemm g{(const bf16_t*)(ws + WS_H), (const bf16_t*)(ws + WS_WIN), T_TOK, 10240, 2048, 2048, 2048};
        pg8::StaticOrder S; S.init(T_TOK, 10240, G, bx);
        pg8::EpiProj E{(bf16_t*)(ws + WS_QKV), (bf16_t*)(ws + WS_SG), LOG2E * 0.08838834764831845f, (unsigned*)(ws + WS_CTL + 200704)};
        pg8::gemm_phase(lds, g, S, E);
    }
    SEAM(1);
    if (IN(2)) { att::attn_phase(P, lds, vcu, G); __syncthreads(); late_transposes(P, lds, vcu, G); }
    SEAM(2);
    for (int rep_ = 0; rep_ < (REPK == 3 ? 2 : 1); ++rep_) if (IN(3)) {
        pg8::StaticOrder S; S.init(T_TOK, DM, G, bx);
        { pg8::Gemm g{(const bf16_t*)(ws + WS_H), (const bf16_t*)(ws + WS_WAT), T_TOK, DM, 1024, 2048, 1024};
          pg8::EpiGate<0> E{(const bf16_t*)(ws + WS_SG), (float*)(ws + WS_TMP), (bf16_t*)(ws + WS_MERGED)};
          pg8::gemm_phase(lds, g, S, E); }
        { pg8::Gemm g{(const bf16_t*)(ws + WS_H) + 1024, (const bf16_t*)(ws + WS_WBT), T_TOK, DM, 1024, 2048, 1024};
          pg8::EpiGate<1> E{(const bf16_t*)(ws + WS_SG) + 2048, (float*)(ws + WS_TMP), (bf16_t*)(ws + WS_MERGED)};
          pg8::gemm_phase(lds, g, S, E); }
    }
    SEAM(3);
    for (int rep_ = 0; rep_ < (REPK == 4 ? 2 : 1); ++rep_) if (IN(4)) {
        pg8::Gemm g{(const bf16_t*)(ws + WS_MERGED), (const bf16_t*)(ws + WS_WOUT), T_TOK, DM, 2048, 2048, 2048};
        pg8::StaticOrder S; S.init(T_TOK, DM, G, bx);
        pg8::EpiResid E{P.x, (float*)(ws + WS_X1), (bf16_t*)(ws + WS_X1B), (float*)(ws + WS_CTL)};
        pg8::gemm_phase(lds, g, S, E);
    }
    SEAM(4);
    for (int rep_ = 0; rep_ < (REPK == 5 ? 2 : 1); ++rep_) if (IN(5)) {
        pg8::Gemm g{(const bf16_t*)(ws + WS_X1B), (const bf16_t*)(ws + WS_WQ), T_TOK, DM, 2048, 2048, 2048};
        pg8::StaticOrder S; S.init(T_TOK, DM, G, bx);
        pg8::EpiPlainBf16 E{(bf16_t*)(ws + WS_Q2)};
        pg8::gemm_phase(lds, g, S, E);
    }
    SEAM(5);
    if (IN(6)) {
        const bool conv_first = __builtin_amdgcn_readfirstlane(threadIdx.x >> 6) >= 4;
        if (conv_first) quantise_experts(P, vcu, G);
        peer::topk_phase(P, lds, vcu, G);
        if (!conv_first) quantise_experts(P, vcu, G);
    }
    SEAM(6);
    for (int rep_ = 0; rep_ < (REPK == 7 ? 2 : 1); ++rep_) if (IN(7)) { if (DBG == 11) peer::gather_naive(P, vcu, G); else if (DBG == 14) peer::gather_phase(P, vcu, G); else peer::gather_sweep(P, lds, vcu, G); }
#undef IN
#undef SEAM
}

extern "C" void kernel_launch(void* const* d_in, const int* in_sizes, int n_in, void* d_out, int out_size, void* d_ws, size_t ws_size, hipStream_t stream) {
    static int grid = 0;
    if (grid == 0) {
        if (n_in != 13 || out_size != T_TOK * DM || ws_size < WS_END) { fprintf(stderr, "kernel_launch: unexpected shapes (n_in %d out %d ws %zu)\n", n_in, out_size, ws_size); grid = -1; return; }
        int dev = 0, cus = 0, per_cu = 0;
        if (hipGetDevice(&dev) != hipSuccess || hipDeviceGetAttribute(&cus, hipDeviceAttributeMultiprocessorCount, dev) != hipSuccess) { grid = -1; return; }
        if (hipFuncSetAttribute((const void*)mega_fwd, hipFuncAttributeMaxDynamicSharedMemorySize, LDS_BYTES) != hipSuccess) { fprintf(stderr, "kernel_launch: hipFuncSetAttribute failed\n"); grid = -1; return; }
        if (hipOccupancyMaxActiveBlocksPerMultiprocessor(&per_cu, (const void*)mega_fwd, NTHR, LDS_BYTES) != hipSuccess || per_cu < 1) { fprintf(stderr, "kernel_launch: occupancy query says %d\n", per_cu); grid = -1; return; }
        grid = cus;
    }
    if (grid < 0) return;
    (void)hipMemsetAsync((char*)d_ws + WS_CTL, 0, 1 * MiB, stream);
    Params p{};
    p.x = (const float*)d_in[0]; p.g_mix = (const float*)d_in[1]; p.w_in = (const float*)d_in[2]; p.b_forget = (const float*)d_in[3];
    p.w_a = (const float*)d_in[4]; p.w_b = (const float*)d_in[5]; p.w_out = (const float*)d_in[6]; p.g_ffn = (const float*)d_in[7];
    p.w_query = (const float*)d_in[8]; p.sub_keys = (const float*)d_in[9]; p.e_u = (const float*)d_in[10]; p.e_v = (const float*)d_in[11]; p.g_final = (const float*)d_in[12];
    p.out = (float*)d_out; p.ws = (unsigned char*)d_ws;
#if MK_N_LAUNCHES == 1
    p.ph_lo = 0; p.ph_hi = N_PHASES;
    void* args[] = {&p};
    hipError_t e = hipLaunchCooperativeKernel((const void*)mega_fwd, dim3(grid), dim3(NTHR), args, LDS_BYTES, stream);
    if (e != hipSuccess) fprintf(stderr, "kernel_launch: cooperative launch failed: %s (grid %d)\n", hipGetErrorString(e), grid);
#else
    for (int ph = 0; ph < N_PHASES; ++ph) { p.ph_lo = ph; p.ph_hi = ph + 1; hipLaunchKernelGGL(mega_fwd, dim3(grid), dim3(NTHR), LDS_BYTES, stream, p); }
#endif
}
```

```cpp
#include <hip/hip_runtime.h>
#include <hip/hip_cooperative_groups.h>
#include <cstdio>
#include <cstdint>
namespace cg = cooperative_groups;

#define LAS __attribute__((address_space(3)))
typedef unsigned short bf16_t;
typedef short bf16x8 __attribute__((ext_vector_type(8)));
typedef short s16x4 __attribute__((ext_vector_type(4)));
typedef float f32x2 __attribute__((ext_vector_type(2)));
typedef float f32x4 __attribute__((ext_vector_type(4)));
typedef float f32x16 __attribute__((ext_vector_type(16)));
typedef unsigned u32x2 __attribute__((ext_vector_type(2)));
typedef unsigned u32x4 __attribute__((ext_vector_type(4)));
typedef __bf16 bf16v2 __attribute__((ext_vector_type(2)));
typedef int i32x4 __attribute__((ext_vector_type(4)));

#ifndef DBG
#define DBG 0
#endif
#ifndef REPK
#define REPK -1
#endif
#ifndef MK_N_LAUNCHES
#define MK_N_LAUNCHES 1
#endif

constexpr int T_TOK = 8192, DM = 2048, SEQ = 4096, HD = 128;
constexpr int NWAVES = 8, NTHR = 512;
constexpr int LDS_BYTES = 147456;
constexpr float LOG2E = 1.4426950408889634f;
constexpr float EPS = 1e-6f;
constexpr int N_PHASES = 8;

constexpr size_t MiB = 1u << 20;
constexpr size_t WS_CTL = 0;
constexpr size_t WS_LOGF = 1 * MiB;
constexpr size_t WS_SKB = 1 * MiB + 512 * 1024;
constexpr size_t WS_HSC = 1 * MiB + 256 * 1024;
constexpr size_t WS_WSC = 1 * MiB + 320 * 1024;
constexpr size_t CTL_CMAX = 262144;
constexpr size_t WS_IDS = 2 * MiB;
constexpr size_t WS_GATES = 6 * MiB;
constexpr size_t WS_WAT = 10 * MiB, WS_WBT = 14 * MiB, WS_WOUT = 18 * MiB, WS_WQ = 26 * MiB, WS_WIN = 34 * MiB;
constexpr size_t WS_H = 74 * MiB;
constexpr size_t WS_QKV = 106 * MiB;
constexpr size_t WS_TMP = 106 * MiB, WS_MERGED = 170 * MiB, WS_Q2 = 106 * MiB;
constexpr size_t WS_SG = 202 * MiB;
constexpr size_t WS_X1B = 202 * MiB;
constexpr size_t WS_X1 = 266 * MiB;
constexpr size_t WS_EU = 330 * MiB, WS_EV = 362 * MiB;
constexpr size_t WS_SU = 394 * MiB, WS_SV = 394 * MiB + 65536;
constexpr size_t WS_END = 395 * MiB;

struct Params {
    const float* x; const float* g_mix; const float* w_in; const float* b_forget; const float* w_a; const float* w_b; const float* w_out;
    const float* g_ffn; const float* w_query; const float* sub_keys; const float* e_u; const float* e_v; const float* g_final;
    float* out; unsigned char* ws; int ph_lo, ph_hi;
};

__device__ __forceinline__ unsigned pk2(float a, float b) { f32x2 v = {a, b}; return __builtin_bit_cast(unsigned, __builtin_convertvector(v, bf16v2)); }
__device__ __forceinline__ float bf_lo(unsigned u) { return __builtin_bit_cast(float, u << 16); }
__device__ __forceinline__ float bf_hi(unsigned u) { return __builtin_bit_cast(float, u & 0xffff0000u); }
__device__ __forceinline__ float fexp2(float x) { return __builtin_amdgcn_exp2f(x); }
__device__ __forceinline__ float flog2(float x) { return __builtin_amdgcn_logf(x); }
__device__ __forceinline__ float frcp(float x) { return __builtin_amdgcn_rcpf(x); }
__device__ __forceinline__ float wave_sum(float v) {
#pragma unroll
    for (int o = 1; o < 64; o <<= 1) v += __shfl_xor(v, o);
    return v;
}
#define LDS_WAIT() asm volatile("s_waitcnt lgkmcnt(0)" ::: "memory")

namespace pg8 {
constexpr int BM = 256, BK = 64, HALF = 128, HTB = HALF * BK * 2, STAGE_BYTES = 8 * HTB, NXCD = 8, WGM = 8;
__host__ __device__ __forceinline__ int lds_byte(int r, int c) { const int st = (r >> 4) * 2 + (c >> 5), rr = r & 15, cc = c & 31, ob = rr * 64 + cc * 2; return st * 1024 + (ob ^ (((ob >> 9) & 1) << 5)); }
__host__ __device__ __forceinline__ void stage_rc(int b, int& R, int& C) { const int st = b / 1024, sb = b % 1024, swz = sb ^ (((sb >> 9) & 1) << 5); R = (st >> 1) * 16 + swz / 64; C = (st & 1) * 32 + (swz % 64) / 2; }
__host__ __device__ __forceinline__ int perm32(int rho) { const int n = rho >> 4, i = rho & 15; return 8 * (i >> 2) + 4 * n + (i & 3); }
struct Unit { int pm, pn; };
struct Gemm { const void* A; const void* Bt; int M, N, K, pa, pb; };
struct StaticOrder {
    int nM, nN, nwg, G, c;
    __device__ void init(int M, int N, int G_, int c_) { nM = M / BM; nN = N / BM; nwg = nM * nN; G = G_; c = c_; }
    __device__ bool next(int i, Unit& u) const {
        const long L = (long)i * G + c; if (L >= nwg) return false;
        int wgid = (int)L; { const int q = nwg / NXCD, r = nwg % NXCD, xcd = wgid % NXCD, off = wgid / NXCD; wgid = (xcd < r ? xcd * (q + 1) : r * (q + 1) + (xcd - r) * q) + off; }
        const int nig = WGM * nN, gid = wgid / nig, fm = gid * WGM, gsz = (nM - fm) < WGM ? (nM - fm) : WGM;
        u.pm = fm + ((wgid % nig) % gsz); u.pn = (wgid % nig) / gsz; return true;
    }
};
template <class Epi, bool I8 = false>
__device__ __forceinline__ void gemm_phase(LAS unsigned char* lds, const Gemm g, const StaticOrder& S, const Epi& E) {
    const int tid = threadIdx.x, wid = __builtin_amdgcn_readfirstlane(tid >> 6), lane = tid & 63, wr = wid >> 2, wc = wid & 3, fr = lane & 15, fq = lane >> 4;
    const int K = g.K, nt = I8 ? K / (2 * BK) : K / BK;
    unsigned voffA[2], voffB[2];
#pragma unroll
    for (int i = 0; i < 2; ++i) { int R, C; stage_rc(tid * 16 + i * 8192, R, C); const int Rb = (R & ~31) + perm32(R & 31);
        voffA[i] = (unsigned)(R * g.pa + C * 2); voffB[i] = (unsigned)(Rb * g.pb + C * 2); }
    const size_t kstep = (size_t)(BK * 2);
    const size_t hstepA = (size_t)HALF * g.pa, hstepB = (size_t)HALF * g.pb;
    const size_t tstepA = 2 * hstepA, tstepB = 2 * hstepB;
    const unsigned ldsw = (unsigned)wid * 1024u;
    const int aoff = lds_byte(wr * 64 + fr, fq * 8), boff = lds_byte(wc * 32 + fr, fq * 8);
#define PG8_SA(b, h) (((b) * 2 + (h)) * HTB)
#define PG8_SB(b, h) ((4 + (b) * 2 + (h)) * HTB)
#define PG8_STAGE(bufoff, gbase, voff) do { _Pragma("unroll") for (int _i = 0; _i < 2; ++_i) \
        __builtin_amdgcn_global_load_lds((const unsigned*)((const char*)(gbase) + (voff)[_i]), (LAS unsigned*)(lds + (bufoff) + ldsw + _i * 8192), 16, 0, 0); } while (0)
#define PG8_LDA(dst, b, h) do { _Pragma("unroll") for (int m = 0; m < 4; ++m) _Pragma("unroll") for (int k = 0; k < 2; ++k) dst[m][k] = *(const LAS bf16x8*)(lds + PG8_SA(b, h) + aoff + m * 2048 + k * 1024); } while (0)
#define PG8_LDB(dst, b, h) do { _Pragma("unroll") for (int n = 0; n < 2; ++n) _Pragma("unroll") for (int k = 0; k < 2; ++k) dst[n][k] = *(const LAS bf16x8*)(lds + PG8_SB(b, h) + boff + n * 2048 + k * 1024); } while (0)
#define PG8_MMA(ai, bj, At, Bt) do { __builtin_amdgcn_s_setprio(1); _Pragma("unroll") for (int m = 0; m < 4; ++m) _Pragma("unroll") for (int n = 0; n < 2; ++n) _Pragma("unroll") for (int k = 0; k < 2; ++k) \
        { if (I8) acc[ai][bj][m][n] = __builtin_bit_cast(f32x4, __builtin_amdgcn_mfma_i32_16x16x64_i8(__builtin_bit_cast(i32x4, Bt[n][k]), __builtin_bit_cast(i32x4, At[m][k]), __builtin_bit_cast(i32x4, acc[ai][bj][m][n]), 0, 0, 0)); \
          else acc[ai][bj][m][n] = __builtin_amdgcn_mfma_f32_16x16x32_bf16(Bt[n][k], At[m][k], acc[ai][bj][m][n], 0, 0, 0); } __builtin_amdgcn_s_setprio(0); } while (0)
#define PG8_WAIT_V(n) asm volatile("s_waitcnt vmcnt(" #n ")" ::: "memory")
#define PG8_WAIT_L(n) asm volatile("s_waitcnt lgkmcnt(" #n ")" ::: "memory")
#define PG8_BAR __builtin_amdgcn_s_barrier()
#define PG8_SCHED __builtin_amdgcn_sched_barrier(0)
    Unit cur, nxt; int ui = 0;
    if (!S.next(0, cur)) return;
    f32x4 acc[2][2][4][2];
#pragma unroll
    for (int a = 0; a < 2; ++a)
#pragma unroll
        for (int b = 0; b < 2; ++b)
#pragma unroll
            for (int m = 0; m < 4; ++m)
#pragma unroll
                for (int n = 0; n < 2; ++n) acc[a][b][m][n] = (f32x4){0.f, 0.f, 0.f, 0.f};
    bf16x8 At[4][2], B0[2][2], B1[2][2];
    const char* cA = (const char*)g.A + (size_t)cur.pm * tstepA; const char* cB = (const char*)g.Bt + (size_t)cur.pn * tstepB;
    PG8_STAGE(PG8_SB(0, 0), cB, voffB); PG8_STAGE(PG8_SA(0, 0), cA, voffA); PG8_STAGE(PG8_SB(0, 1), cB + hstepB, voffB); PG8_STAGE(PG8_SA(0, 1), cA + hstepA, voffA);
    if (wr == 1) PG8_BAR;
    PG8_WAIT_V(4); PG8_BAR;
    PG8_STAGE(PG8_SB(1, 0), cB + kstep, voffB); PG8_STAGE(PG8_SA(1, 0), cA + kstep, voffA); PG8_STAGE(PG8_SB(1, 1), cB + hstepB + kstep, voffB);
    PG8_WAIT_V(6); PG8_BAR;
    for (;;) {
        const bool has_next = S.next(ui + 1, nxt);
        const char* nA = has_next ? (const char*)g.A + (size_t)nxt.pm * tstepA : cA; const char* nB = has_next ? (const char*)g.Bt + (size_t)nxt.pn * tstepB : cB;
        for (int t = 0; t < nt; t += 2) {
            const bool last = (t == nt - 2);
            const char* a1 = cA + (size_t)(t + 1) * kstep;
            const char* a2 = last ? nA : cA + (size_t)(t + 2) * kstep; const char* b2 = last ? nB : cB + (size_t)(t + 2) * kstep;
            const char* a3 = a2 + kstep; const char* b3 = b2 + kstep;
            PG8_LDB(B0, 0, 0); PG8_SCHED; PG8_LDA(At, 0, 0); PG8_STAGE(PG8_SA(1, 1), a1 + hstepA, voffA);
            PG8_WAIT_L(8); PG8_BAR; PG8_WAIT_L(0); PG8_MMA(0, 0, At, B0); PG8_BAR; PG8_SCHED;
            PG8_LDB(B1, 0, 1); PG8_STAGE(PG8_SB(0, 0), b2, voffB);
            PG8_BAR; PG8_WAIT_L(0); PG8_MMA(0, 1, At, B1); PG8_BAR;
            PG8_LDA(At, 0, 1); PG8_STAGE(PG8_SA(0, 0), a2, voffA);
            PG8_BAR; PG8_WAIT_L(0); PG8_MMA(1, 0, At, B0); PG8_BAR; PG8_SCHED;
            PG8_STAGE(PG8_SB(0, 1), b2 + hstepB, voffB);
            PG8_WAIT_V(6); PG8_BAR; PG8_MMA(1, 1, At, B1); PG8_BAR;
            PG8_LDB(B0, 1, 0); PG8_SCHED; PG8_LDA(At, 1, 0); PG8_STAGE(PG8_SA(0, 1), a2 + hstepA, voffA);
            PG8_WAIT_L(8); PG8_BAR; PG8_WAIT_L(0); PG8_MMA(0, 0, At, B0); PG8_BAR; PG8_SCHED;
            PG8_LDB(B1, 1, 1); PG8_STAGE(PG8_SB(1, 0), b3, voffB);
            PG8_BAR; PG8_WAIT_L(0); PG8_MMA(0, 1, At, B1); PG8_BAR;
            PG8_LDA(At, 1, 1); PG8_STAGE(PG8_SA(1, 0), a3, voffA);
            PG8_BAR; PG8_WAIT_L(0); PG8_MMA(1, 0, At, B0); PG8_BAR; PG8_SCHED;
            PG8_STAGE(PG8_SB(1, 1), b3 + hstepB, voffB);
            PG8_WAIT_V(6); PG8_BAR; PG8_MMA(1, 1, At, B1); PG8_BAR;
        }
        E(acc, cur, wr, wc, fr, fq);
        if (!has_next) break;
#pragma unroll
        for (int a = 0; a < 2; ++a)
#pragma unroll
            for (int b = 0; b < 2; ++b)
#pragma unroll
                for (int m = 0; m < 4; ++m)
#pragma unroll
                    for (int n = 0; n < 2; ++n) acc[a][b][m][n] = (f32x4){0.f, 0.f, 0.f, 0.f};
        cur = nxt; cA = nA; cB = nB; ++ui;
    }
    PG8_WAIT_V(0);
    if (wr == 0) PG8_BAR;
    PG8_BAR;
#undef PG8_SA
#undef PG8_SB
#undef PG8_STAGE
#undef PG8_LDA
#undef PG8_LDB
#undef PG8_MMA
#undef PG8_WAIT_V
#undef PG8_WAIT_L
#undef PG8_BAR
#undef PG8_SCHED
}

struct EpiProj {
    bf16_t* qkv; bf16_t* sg; float qscale; unsigned* kmaxw; const float* hsc; const float* wsc;
    __device__ __forceinline__ void operator()(const f32x4 (&acci)[2][2][4][2], const Unit& u, int wr, int wc, int fr, int fq) const {
        const int row0 = u.pm * BM + wr * 64 + fr;
        f32x4 acc[2][2][4][2];
        { f32x4 cs[2][2];
#pragma unroll
          for (int bj = 0; bj < 2; ++bj)
#pragma unroll
              for (int n = 0; n < 2; ++n) cs[bj][n] = *(const f32x4*)(wsc + u.pn * BM + bj * HALF + wc * 32 + 8 * fq + 4 * n);
#pragma unroll
          for (int ai = 0; ai < 2; ++ai)
#pragma unroll
              for (int m = 0; m < 4; ++m) { const float rsc = hsc[row0 + ai * HALF + m * 16];
#pragma unroll
                  for (int bj = 0; bj < 2; ++bj)
#pragma unroll
                      for (int n = 0; n < 2; ++n) { const i32x4 iv = __builtin_bit_cast(i32x4, acci[ai][bj][m][n]);
                          acc[ai][bj][m][n] = (f32x4){(float)iv[0], (float)iv[1], (float)iv[2], (float)iv[3]} * rsc * cs[bj][n]; } } }
        if (u.pn < 24) {
            const int t = u.pn >> 2; bf16_t* base = qkv + (size_t)t * ((size_t)T_TOK * 1024) + (u.pn & 3) * 256 + wc * 32 + 8 * fq;
            const float sc = (t == 0 || t == 3) ? qscale : 1.f;
            if (t == 4) {
#pragma unroll
                for (int bj = 0; bj < 2; ++bj) { float mxv = 0.f;
#pragma unroll
                    for (int ai = 0; ai < 2; ++ai)
#pragma unroll
                        for (int m = 0; m < 4; ++m) { const f32x4 v0 = acc[ai][bj][m][0], v1 = acc[ai][bj][m][1];
                            float ssq = (v0[0] * v0[0] + v0[1] * v0[1]) + (v0[2] * v0[2] + v0[3] * v0[3]) + (v1[0] * v1[0] + v1[1] * v1[1]) + (v1[2] * v1[2] + v1[3] * v1[3]);
                            ssq += __shfl_xor(ssq, 16); ssq += __shfl_xor(ssq, 32); mxv = fmaxf(mxv, ssq); }
#pragma unroll
                    for (int o = 1; o < 16; o <<= 1) mxv = fmaxf(mxv, __shfl_xor(mxv, o));
                    if ((fr | fq) == 0) atomicMax(kmaxw + ((u.pm >> 4) * 8 + (u.pn & 3) * 2 + bj) * 4 + wc, __builtin_bit_cast(unsigned, mxv)); }
            }
#pragma unroll
            for (int ai = 0; ai < 2; ++ai)
#pragma unroll
                for (int m = 0; m < 4; ++m) { bf16_t* rowp = base + (size_t)(row0 + ai * HALF + m * 16) * 1024;
#pragma unroll
                    for (int bj = 0; bj < 2; ++bj) { const f32x4 v0 = acc[ai][bj][m][0] * sc, v1 = acc[ai][bj][m][1] * sc;
                        u32x4 w; w.x = pk2(v0[0], v0[1]); w.y = pk2(v0[2], v0[3]); w.z = pk2(v1[0], v1[1]); w.w = pk2(v1[2], v1[3]);
                        *(u32x4*)(rowp + bj * HALF) = w; } }
        } else {
            bf16_t* base = sg + (u.pn - 24) * 256 + wc * 32 + 8 * fq;
#pragma unroll
            for (int ai = 0; ai < 2; ++ai)
#pragma unroll
                for (int m = 0; m < 4; ++m) { bf16_t* rowp = base + (size_t)(row0 + ai * HALF + m * 16) * 4096;
#pragma unroll
                    for (int bj = 0; bj < 2; ++bj) { float s[8];
#pragma unroll
                        for (int e = 0; e < 4; ++e) { s[e] = frcp(1.f + fexp2(-LOG2E * acc[ai][bj][m][0][e])); s[4 + e] = frcp(1.f + fexp2(-LOG2E * acc[ai][bj][m][1][e])); }
                        u32x4 w; w.x = pk2(s[0], s[1]); w.y = pk2(s[2], s[3]); w.z = pk2(s[4], s[5]); w.w = pk2(s[6], s[7]);
                        *(u32x4*)(rowp + bj * HALF) = w; } }
        }
    }
};
template <int SECOND> struct EpiGate {
    const bf16_t* sg;
    float* tmp; bf16_t* merged;
    __device__ __forceinline__ void operator()(const f32x4 (&acc)[2][2][4][2], const Unit& u, int wr, int wc, int fr, int fq) const {
        const int row0 = u.pm * BM + wr * 64 + fr, col0 = u.pn * BM + wc * 32 + 8 * fq;
#pragma unroll
        for (int ai = 0; ai < 2; ++ai)
#pragma unroll
            for (int m = 0; m < 4; ++m) { const size_t row = (size_t)(row0 + ai * HALF + m * 16);
#pragma unroll
                for (int bj = 0; bj < 2; ++bj) { const int col = col0 + bj * HALF;
                    const u32x4 gv = *(const u32x4*)(sg + row * 4096 + col);
                    const f32x4 g0 = {bf_lo(gv.x), bf_hi(gv.x), bf_lo(gv.y), bf_hi(gv.y)}, g1 = {bf_lo(gv.z), bf_hi(gv.z), bf_lo(gv.w), bf_hi(gv.w)};
                    f32x4 v0 = acc[ai][bj][m][0] * g0, v1 = acc[ai][bj][m][1] * g1;
                    float* tp = tmp + row * DM + col;
                    if (SECOND == 0) { *(f32x4*)tp = v0; *(f32x4*)(tp + 4) = v1; }
                    else { v0 += *(const f32x4*)tp; v1 += *(const f32x4*)(tp + 4);
                        u32x4 w; w.x = pk2(v0[0], v0[1]); w.y = pk2(v0[2], v0[3]); w.z = pk2(v1[0], v1[1]); w.w = pk2(v1[2], v1[3]);
                        *(u32x4*)(merged + row * DM + col) = w; } } }
    }
};
struct EpiResid {
    const float* x; float* x1; bf16_t* x1b; float* rowss;
    __device__ __forceinline__ void operator()(const f32x4 (&acc)[2][2][4][2], const Unit& u, int wr, int wc, int fr, int fq) const {
        const int row0 = u.pm * BM + wr * 64 + fr, col0 = u.pn * BM + wc * 32 + 8 * fq;
#pragma unroll
        for (int ai = 0; ai < 2; ++ai)
#pragma unroll
            for (int m = 0; m < 4; ++m) { const size_t row = (size_t)(row0 + ai * HALF + m * 16); float ss = 0.f;
#pragma unroll
                for (int bj = 0; bj < 2; ++bj) { const size_t o = row * DM + col0 + bj * HALF;
                    const f32x4 v0 = (DBG == 2 ? 0.f : 1.f) * acc[ai][bj][m][0] + *(const f32x4*)(x + o), v1 = (DBG == 2 ? 0.f : 1.f) * acc[ai][bj][m][1] + *(const f32x4*)(x + o + 4);
                    *(f32x4*)(x1 + o) = v0; *(f32x4*)(x1 + o + 4) = v1;
                    u32x4 w; w.x = pk2(v0[0], v0[1]); w.y = pk2(v0[2], v0[3]); w.z = pk2(v1[0], v1[1]); w.w = pk2(v1[2], v1[3]);
                    *(u32x4*)(x1b + o) = w;
                    ss += (v0[0] * v0[0] + v0[1] * v0[1]) + (v0[2] * v0[2] + v0[3] * v0[3]) + (v1[0] * v1[0] + v1[1] * v1[1]) + (v1[2] * v1[2] + v1[3] * v1[3]); }
                ss += __shfl_xor(ss, 16); ss += __shfl_xor(ss, 32);
                if (fq == 0) atomicAdd(rowss + row, ss); }
    }
};
struct EpiPlainBf16 {
    bf16_t* o;
    __device__ __forceinline__ void operator()(const f32x4 (&acc)[2][2][4][2], const Unit& u, int wr, int wc, int fr, int fq) const {
        const int row0 = u.pm * BM + wr * 64 + fr, col0 = u.pn * BM + wc * 32 + 8 * fq;
#pragma unroll
        for (int ai = 0; ai < 2; ++ai)
#pragma unroll
            for (int m = 0; m < 4; ++m) { const size_t row = (size_t)(row0 + ai * HALF + m * 16);
#pragma unroll
                for (int bj = 0; bj < 2; ++bj) { const f32x4 v0 = acc[ai][bj][m][0], v1 = acc[ai][bj][m][1];
                    u32x4 w; w.x = pk2(v0[0], v0[1]); w.y = pk2(v0[2], v0[3]); w.z = pk2(v1[0], v1[1]); w.w = pk2(v1[2], v1[3]);
                    *(u32x4*)(o + row * DM + col0 + bj * HALF) = w; } }
    }
};
}

__device__ __forceinline__ void transpose_item(const float* W, int ldw, int src_n0, bf16_t* WT, int K, int dst_n0, int k0, LAS float* scr, int lane, const float* kscale) {
#pragma unroll 8
    for (int i = 0; i < 32; ++i) { const int kk = 2 * i + (lane >> 5); float v = W[(size_t)(k0 + kk) * ldw + src_n0 + (lane & 31)]; if (kscale) v *= kscale[k0 + kk]; scr[kk * 33 + (lane & 31)] = v; }
    LDS_WAIT();
    const int c = lane & 7;
#pragma unroll
    for (int j = 0; j < 4; ++j) { const int n = (lane >> 3) + 8 * j; const LAS float* s = scr + (8 * c) * 33 + n;
        u32x4 o; o.x = pk2(s[0 * 33], s[1 * 33]); o.y = pk2(s[2 * 33], s[3 * 33]); o.z = pk2(s[4 * 33], s[5 * 33]); o.w = pk2(s[6 * 33], s[7 * 33]);
        *(u32x4*)(WT + (size_t)(dst_n0 + n) * K + k0 + 8 * c) = o; }
    LDS_WAIT();
}

__device__ __forceinline__ void p0a(const Params& P, LAS unsigned char* lds, int vcu, int G) {
    const int tid = threadIdx.x, lane = tid & 63, wave = __builtin_amdgcn_readfirstlane(tid >> 6);
    const int gw = vcu * NWAVES + wave, NGW = G * NWAVES;
    unsigned char* ws = P.ws;
    {
        unsigned* CMAX = (unsigned*)(ws + WS_CTL + CTL_CMAX);
        constexpr int NCB = (10248 + 255) / 256;
        for (int it = gw; it < 32 * NCB; it += NGW) { const int kb = it / NCB, cb = it % NCB, sc = cb * 256 + 4 * lane;
            if (sc < 10248) { f32x4 mx = {0.f, 0.f, 0.f, 0.f};
#pragma unroll 8
                for (int r = 0; r < 64; ++r) { const f32x4 v = *(const f32x4*)(P.w_in + (size_t)(kb * 64 + r) * 10248 + sc); mx[0] = fmaxf(mx[0], fabsf(v[0])); mx[1] = fmaxf(mx[1], fabsf(v[1])); mx[2] = fmaxf(mx[2], fabsf(v[2])); mx[3] = fmaxf(mx[3], fabsf(v[3])); }
#pragma unroll
                for (int e = 0; e < 4; ++e) { const int c = sc + e; const float mv = mx[e]; const unsigned mb = __float_as_uint(mv);
                    if (c < 6144) atomicMax(CMAX + c, mb); else if (c >= 6152) atomicMax(CMAX + c - 8, mb); } } }
    }
    {
        LAS float* wf = (LAS float*)lds;
        for (int idx = tid; idx < 2048 * 8; idx += NTHR) { const int k = idx >> 3, c = idx & 7; wf[c * 2048 + k] = P.w_in[(size_t)k * 10248 + 6144 + c]; }
        __syncthreads();
        unsigned char* HQ8 = ws + WS_H; float* HSC = (float*)(ws + WS_HSC); float* LOGF = (float*)(ws + WS_LOGF);
        for (int r = gw; r < T_TOK; r += NGW) {
            const f32x4* xr = (const f32x4*)(P.x + (size_t)r * DM) + lane;
            float ss = 0.f, amx = 0.f;
#pragma unroll
            for (int j = 0; j < 8; ++j) { const f32x4 v = xr[64 * j]; const f32x4 gn = *((const f32x4*)P.g_mix + lane + 64 * j); ss += (v[0] * v[0] + v[1] * v[1]) + (v[2] * v[2] + v[3] * v[3]);
                const f32x4 t = v * gn; amx = fmaxf(amx, fmaxf(fmaxf(fabsf(t[0]), fabsf(t[1])), fmaxf(fabsf(t[2]), fabsf(t[3])))); }
            const float rstd = 1.0f / sqrtf(wave_sum(ss) * (1.f / DM) + EPS);
#pragma unroll
            for (int o = 1; o < 64; o <<= 1) amx = fmaxf(amx, __shfl_xor(amx, o));
            const float hmax = fmaxf(amx * rstd, 1e-30f), hinv = 127.f / hmax;
            float fl[8];
#pragma unroll
            for (int c = 0; c < 8; ++c) fl[c] = 0.f;
            unsigned* hp = (unsigned*)(HQ8 + (size_t)r * DM) + lane;
#pragma unroll 1
            for (int j = 0; j < 8; ++j) { const f32x4 gn = *((const f32x4*)P.g_mix + lane + 64 * j); const f32x4 hv = xr[64 * j] * rstd * gn;
                unsigned w = 0;
#pragma unroll
                for (int e = 0; e < 4; ++e) w |= ((unsigned)(int)__builtin_rintf(hv[e] * hinv) & 255u) << (8 * e);
                hp[64 * j] = w;
#pragma unroll
                for (int c = 0; c < 8; ++c) { const f32x4 wv = *((const LAS f32x4*)(wf + c * 2048) + lane + 64 * j); fl[c] += (hv[0] * wv[0] + hv[1] * wv[1]) + (hv[2] * wv[2] + hv[3] * wv[3]); } }
#pragma unroll
            for (int c = 0; c < 8; ++c) fl[c] = wave_sum(fl[c]);
            if (lane == 0) { HSC[r] = hmax * (1.f / 127.f);
#pragma unroll
                for (int c = 0; c < 8; ++c) { const float y = fl[c] + P.b_forget[c]; LOGF[(size_t)r * 8 + c] = fminf(y, 0.f) - log1pf(expf(-fabsf(y))); }
            }
        }
    }
    {
        const size_t gid = (size_t)vcu * NTHR + tid, gstride = (size_t)G * NTHR;
        for (size_t i = gid; i < 262144 / 8; i += gstride) { const float* src = P.sub_keys + i * 8; const f32x4 a = *(const f32x4*)src, b = *((const f32x4*)src + 1);
            u32x4 o; o.x = pk2(a[0], a[1]); o.y = pk2(a[2], a[3]); o.z = pk2(b[0], b[1]); o.w = pk2(b[2], b[3]); *(u32x4*)((bf16_t*)(ws + WS_SKB) + i * 8) = o; }
    }
}
__device__ __forceinline__ void p0b(const Params& P, LAS unsigned char* lds, int vcu, int G) {
    const int tid = threadIdx.x, lane = tid & 63, wave = __builtin_amdgcn_readfirstlane(tid >> 6);
    const int gw = vcu * NWAVES + wave, NGW = G * NWAVES;
    unsigned char* ws = P.ws;
    const unsigned* CMAX = (const unsigned*)(ws + WS_CTL + CTL_CMAX); float* WSC = (float*)(ws + WS_WSC); unsigned char* WT8 = ws + WS_WIN;
    LAS float* scr = (LAS float*)(lds + wave * 16384);
    for (int it = gw; it < 32 * 320; it += NGW) {
        const int nb = it >> 5, kb = it & 31, dn = nb * 32, sn = dn < 6144 ? dn : dn + 8, k0 = kb * 64;
        const float cm = (DBG == 21) ? 127.f / 1024.f : fmaxf(__builtin_bit_cast(float, __hip_atomic_load(CMAX + dn + (lane & 31), __ATOMIC_RELAXED, __HIP_MEMORY_SCOPE_AGENT)), 1e-30f);
        const float inv = 127.f / cm;
        if (kb == 0 && lane < 32) WSC[dn + lane] = cm * (1.f / 127.f);
#pragma unroll 8
        for (int i = 0; i < 32; ++i) { const int kk = 2 * i + (lane >> 5); scr[kk * 33 + (lane & 31)] = P.w_in[(size_t)(k0 + kk) * 10248 + sn + (lane & 31)] * inv; }
        LDS_WAIT();
        const int c = lane & 3;
#pragma unroll
        for (int j = 0; j < 2; ++j) { const int n = (lane >> 2) + 16 * j; const LAS float* sp = scr + (16 * c) * 33 + n;
            u32x4 o;
#pragma unroll
            for (int w4 = 0; w4 < 4; ++w4) { unsigned w = 0;
#pragma unroll
                for (int e = 0; e < 4; ++e) w |= ((unsigned)(int)fminf(fmaxf(__builtin_rintf(sp[(4 * w4 + e) * 33]), -127.f), 127.f) & 255u) << (8 * e);
                o[w4] = w; }
            *(u32x4*)(WT8 + (size_t)(dn + n) * 2048 + k0 + 16 * c) = o; }
        LDS_WAIT();
    }
}
__device__ __forceinline__ void late_transposes(const Params& P, LAS unsigned char* lds, int vcu, int G) {
    const int tid = threadIdx.x, lane = tid & 63, wave = __builtin_amdgcn_readfirstlane(tid >> 6);
    const int gw = vcu * NWAVES + wave, NGW = G * NWAVES;
    unsigned char* ws = P.ws;
    LAS float* scr = (LAS float*)(lds + wave * 16384);
    constexpr int I_A = 16 * 64, I_O = 32 * 64, NITEMS = 2 * I_A + 2 * I_O;
    for (int it = gw; it < NITEMS; it += NGW) {
        int r = it;
        if (r < I_A) { const int kb = r / 64, nb = r % 64; transpose_item(P.w_a, 2048, nb * 32, (bf16_t*)(ws + WS_WAT), 1024, nb * 32, kb * 64, scr, lane, nullptr); continue; } r -= I_A;
        if (r < I_A) { const int kb = r / 64, nb = r % 64; transpose_item(P.w_b, 2048, nb * 32, (bf16_t*)(ws + WS_WBT), 1024, nb * 32, kb * 64, scr, lane, nullptr); continue; } r -= I_A;
        if (r < I_O) { const int kb = r / 64, nb = r % 64; transpose_item(P.w_out, 2048, nb * 32, (bf16_t*)(ws + WS_WOUT), 2048, nb * 32, kb * 64, scr, lane, nullptr); continue; } r -= I_O;
        { const int kb = r / 64, nb = r % 64; transpose_item(P.w_query, 2048, nb * 32, (bf16_t*)(ws + WS_WQ), 2048, nb * 32, kb * 64, scr, lane, P.g_ffn); }
    }
}
__device__ __forceinline__ void quantise_experts(const Params& P, int vcu, int G) {
    const int tid = threadIdx.x, lane = tid & 63, wave = __builtin_amdgcn_readfirstlane(tid >> 6);
    const int gw = vcu * NWAVES + wave, NGW = G * NWAVES;
    unsigned char* ws = P.ws;
    float* SU = (float*)(ws + WS_SU); float* SV = (float*)(ws + WS_SV);
    for (int r = gw; r < 2 * 16384; r += NGW) {
        const bool second = r >= 16384; const int row = second ? r - 16384 : r;
        const f32x4* src = (const f32x4*)((second ? P.e_v : P.e_u) + (size_t)row * DM) + lane;
        f32x4 v[8]; float mx = 0.f;
#pragma unroll
        for (int j = 0; j < 8; ++j) { v[j] = __builtin_nontemporal_load(src + 64 * j); mx = fmaxf(mx, fmaxf(fmaxf(fabsf(v[j][0]), fabsf(v[j][1])), fmaxf(fabsf(v[j][2]), fabsf(v[j][3])))); }
#pragma unroll
        for (int o = 1; o < 64; o <<= 1) mx = fmaxf(mx, __shfl_xor(mx, o));
        mx = fmaxf(mx, 1e-30f);
        const float inv = 127.f / mx; const int bias = second ? 128 : 0;
        unsigned* dst = (unsigned*)(ws + (second ? WS_EV : WS_EU) + (size_t)row * DM) + lane;
#pragma unroll
        for (int j = 0; j < 8; ++j) { unsigned w = 0;
#pragma unroll
            for (int e = 0; e < 4; ++e) { const int q = (int)__builtin_rintf(v[j][e] * inv) + bias; w |= ((unsigned)q & 255u) << (8 * e); }
            dst[64 * j] = w; }
        if (lane == 0) (second ? SV : SU)[row] = mx * (1.f / 127.f);
    }
}

namespace att {
constexpr int KST = 272, VST = 320;
constexpr int KBUF = 64 * KST, VBUF = 64 * VST;
constexpr int OFF_K = 0, OFF_V = 2 * KBUF, OFF_F = OFF_V + 2 * VBUF, OFF_SC = OFF_F + 4096 * 4;
constexpr int OFF_FLG = OFF_SC + 64, OFF_UNIT = OFF_FLG + 64;
static_assert(OFF_UNIT + 16 <= 131072, "attention LDS");
constexpr float THR_SB = 40.f, THR_FOX = 30.f;

__device__ __forceinline__ void build_cumf(LAS unsigned char* lds, const float* LOGF, int b, int h, int n, int tid, int lane, int wid) {
    LAS float* F2 = (LAS float*)(lds + OFF_F); LAS float* sc = (LAS float*)(lds + OFF_SC);
    const int s0 = tid * 8; float v[8];
#pragma unroll
    for (int i = 0; i < 8; ++i) v[i] = (s0 < n) ? LOGF[((size_t)b * SEQ + s0 + i) * 8 + h] * LOG2E : 0.f;
#pragma unroll
    for (int i = 1; i < 8; ++i) v[i] += v[i - 1];
    float tot = v[7], inc = tot;
#pragma unroll
    for (int o = 1; o < 64; o <<= 1) { const float t = __shfl_up(inc, o); if (lane >= o) inc += t; }
    if (lane == 63) sc[wid] = inc;
    __syncthreads();
    float base = inc - tot;
#pragma unroll
    for (int w = 0; w < 8; ++w) if (w < wid) base += sc[w];
    if (s0 < n) {
#pragma unroll
        for (int i = 0; i < 8; ++i) F2[s0 + i] = v[i] + base;
    }
    __syncthreads();
}

template <int MIXER>
__device__ __forceinline__ void attn_unit(LAS unsigned char* lds, const bf16_t* Q, const bf16_t* Kg, const bf16_t* Vg, bf16_t* O, int b, int h, int qb, float kmax, int tid, int lane, int wid) {
    const int c = lane & 31, hh = lane >> 5;
    const int t0 = qb * 256 + wid * 32, tq = t0 + c;
    const size_t rowbase = (size_t)b * SEQ;
    size_t qoff = (rowbase + tq) * 1024 + h * HD + 8 * hh;
    f32x16 oacc[4];
#pragma unroll
    for (int d = 0; d < 4; ++d)
#pragma unroll
        for (int r = 0; r < 16; ++r) oacc[d][r] = 0.f;
    float carry = 0.f, mrun = -1e30f, lsum = 0.f; const float nhf = hh ? 0.f : 1.f;
    const LAS float* F2 = (const LAS float*)(lds + OFF_F);
    const float Ft = (MIXER == 1) ? F2[tq] : 0.f;
    float qk_bound = 0.f;
    if (MIXER == 1) { float qs = 0.f;
#pragma unroll
        for (int s2 = 0; s2 < 8; ++s2) { const u32x4 qv = *(const u32x4*)(Q + qoff + 16 * s2);
#pragma unroll
            for (int e = 0; e < 4; ++e) { const float a = bf_lo(qv[e]), b2 = bf_hi(qv[e]); qs += a * a + b2 * b2; } }
        qs += __shfl_xor(qs, 32);
        qk_bound = sqrtf(qs) * kmax; }
    bool wave_done = false;
    volatile LAS unsigned* flg = (volatile LAS unsigned*)(lds + OFF_FLG);
    const int ktmax = 4 * qb + 3;
    const int srow = tid >> 4, scc = tid & 15;
    u32x4 kr[2], vr[2];
#define ATT_LOAD(kt) do { _Pragma("unroll") for (int j = 0; j < 2; ++j) { const size_t g_ = (rowbase + 64 * (kt) + srow + 32 * j) * 1024 + h * HD + scc * 8; \
        kr[j] = *(const u32x4*)(Kg + g_); vr[j] = *(const u32x4*)(Vg + g_); } } while (0)
#define ATT_WRITE(buf) do { _Pragma("unroll") for (int j = 0; j < 2; ++j) { \
        *(LAS u32x4*)(lds + OFF_K + (buf) * KBUF + (srow + 32 * j) * KST + scc * 16) = kr[j]; \
        *(LAS u32x4*)(lds + OFF_V + (buf) * VBUF + (srow + 32 * j) * VST + scc * 16) = vr[j]; } } while (0)
    ATT_LOAD(ktmax); ATT_WRITE(0); __syncthreads();
    int buf = 0;
    for (int kt = ktmax; kt >= 0; --kt) {
        if (kt > 0) ATT_LOAD(kt - 1);
        const bool started = (64 * kt <= t0 + 31);
        if (started && !wave_done) {
            const LAS unsigned char* Kl = lds + OFF_K + buf * KBUF; const LAS unsigned char* Vl = lds + OFF_V + buf * VBUF;
            f32x16 sacc[2];
            asm volatile("" : "+v"(qoff));
            bf16x8 qf[8];
#pragma unroll
            for (int s = 0; s < 8; ++s) qf[s] = *(const bf16x8*)(Q + qoff + 16 * s);
#pragma unroll
            for (int sub = 0; sub < 2; ++sub) {
#pragma unroll
                for (int r = 0; r < 16; ++r) sacc[sub][r] = 0.f;
#pragma unroll
                for (int s = 0; s < 8; ++s) { const bf16x8 kf = *(const LAS bf16x8*)(Kl + (32 * sub + c) * KST + (16 * s + 8 * hh) * 2);
                    sacc[sub] = __builtin_amdgcn_mfma_f32_32x32x16_bf16(kf, qf[s], sacc[sub], 0, 0, 0); }
            }
            const bool need_mask = (64 * kt + 63 >= t0);
            if (MIXER == 0) {
#pragma unroll
                for (int sub = 1; sub >= 0; --sub) {
                    float lb[16];
#pragma unroll
                    for (int r = 0; r < 16; ++r) { const float z = sacc[sub][r]; float l = -flog2(1.f + fexp2(z));
                        if (need_mask) { const int sidx = 64 * kt + 32 * sub + (r & 3) + 8 * (r >> 2) + 4 * hh; l = (sidx < tq) ? l : 0.f; }
                        lb[r] = l; }
                    float Glo[4], Ghi[4];
#pragma unroll
                    for (int g = 0; g < 4; ++g) { lb[4 * g + 2] += lb[4 * g + 3]; lb[4 * g + 1] += lb[4 * g + 2]; lb[4 * g] += lb[4 * g + 1];
                        const unsigned gu = __builtin_bit_cast(unsigned, lb[4 * g]); const auto rr = __builtin_amdgcn_permlane32_swap(gu, gu, false, false);
                        Glo[g] = __builtin_bit_cast(float, (unsigned)rr[0]); Ghi[g] = __builtin_bit_cast(float, (unsigned)rr[1]); }
                    float E[8];
                    E[7] = carry; E[6] = E[7] + Ghi[3]; E[5] = E[6] + Glo[3]; E[4] = E[5] + Ghi[2]; E[3] = E[4] + Glo[2]; E[2] = E[3] + Ghi[1]; E[1] = E[2] + Glo[1]; E[0] = E[1] + Ghi[0];
                    carry = E[0] + Glo[0];
#pragma unroll
                    for (int g = 0; g < 4; ++g) { const float Eo = __builtin_fmaf(nhf, Ghi[g], E[2 * g + 1]);
#pragma unroll
                        for (int i = 0; i < 4; ++i) { const int r = 4 * g + i; float w = fexp2(sacc[sub][r] + lb[r] + Eo);
                            if (need_mask) { const int sidx = 64 * kt + 32 * sub + (r & 3) + 8 * (r >> 2) + 4 * hh; w = (sidx < tq) ? w : 0.f; }
                            sacc[sub][r] = w; } }
                }
            } else {
                float mx = -1e30f;
#pragma unroll
                for (int sub = 0; sub < 2; ++sub)
#pragma unroll
                    for (int g = 0; g < 4; ++g) { const f32x4 fs = *(const LAS f32x4*)(F2 + 64 * kt + 32 * sub + 8 * g + 4 * hh);
#pragma unroll
                        for (int i = 0; i < 4; ++i) { const int r = 4 * g + i; float xv = sacc[sub][r] + (Ft - fs[i]);
                            if (need_mask) { const int sidx = 64 * kt + 32 * sub + 8 * g + 4 * hh + i; xv = (sidx <= tq) ? xv : -1e30f; }
                            sacc[sub][r] = xv; mx = fmaxf(mx, xv); } }
                { const unsigned mu = __builtin_bit_cast(unsigned, mx); const auto rr = __builtin_amdgcn_permlane32_swap(mu, mu, false, false);
                  mx = fmaxf(__builtin_bit_cast(float, (unsigned)rr[0]), __builtin_bit_cast(float, (unsigned)rr[1])); }
                const float mnew = fmaxf(mrun, mx);
                const float alpha = fexp2(mrun - mnew);
                float ps = 0.f;
#pragma unroll
                for (int sub = 0; sub < 2; ++sub)
#pragma unroll
                    for (int r = 0; r < 16; ++r) { const float p = fexp2(sacc[sub][r] - mnew); sacc[sub][r] = p; ps += p; }
                lsum = lsum * alpha + ps;
                if (__any(mnew > mrun)) {
#pragma unroll
                    for (int d = 0; d < 4; ++d)
#pragma unroll
                        for (int r = 0; r < 16; ++r) oacc[d][r] *= alpha;
                }
                mrun = mnew;
            }
#pragma unroll
            for (int ks = 0; ks < 4; ++ks) { const int sub = ks >> 1, rb = 8 * (ks & 1);
                u32x4 pw; pw.x = pk2(sacc[sub][rb + 0], sacc[sub][rb + 1]); pw.y = pk2(sacc[sub][rb + 2], sacc[sub][rb + 3]); pw.z = pk2(sacc[sub][rb + 4], sacc[sub][rb + 5]); pw.w = pk2(sacc[sub][rb + 6], sacc[sub][rb + 7]);
                const bf16x8 pf = __builtin_bit_cast(bf16x8, pw);
                const LAS unsigned char* vb = Vl + (16 * ks + 4 * hh + ((lane & 15) >> 2)) * VST + (16 * ((lane >> 4) & 1) + 4 * (lane & 3)) * 2;
#pragma unroll
                for (int d = 0; d < 4; ++d) {
                    const s16x4 a0 = __builtin_amdgcn_ds_read_tr16_b64_v4i16((LAS s16x4*)(vb + d * 64));
                    const s16x4 a1 = __builtin_amdgcn_ds_read_tr16_b64_v4i16((LAS s16x4*)(vb + d * 64 + 8 * VST));
                    const bf16x8 af = {a0[0], a0[1], a0[2], a0[3], a1[0], a1[1], a1[2], a1[3]};
                    oacc[d] = __builtin_amdgcn_mfma_f32_32x32x16_bf16(af, pf, oacc[d], 0, 0, 0); }
            }
        }
        if (kt > 0) ATT_WRITE(buf ^ 1);
        if (kt > 0 && started && !wave_done) {
            if (MIXER == 0) wave_done = __all(carry < -THR_SB);
            else wave_done = __all(qk_bound + (Ft - F2[64 * kt - 1]) - mrun < -THR_FOX);
        }
        if (lane == 0) flg[(kt & 1) * 8 + wid] = wave_done ? 1u : 0u;
        __syncthreads();
        buf ^= 1;
        { unsigned alld = 1u;
#pragma unroll
          for (int w = 0; w < 8; ++w) alld &= flg[(kt & 1) * 8 + w];
          if (alld) break; }
    }
#undef ATT_LOAD
#undef ATT_WRITE
    float inv = 1.f;
    if (MIXER == 1) { const unsigned lu = __builtin_bit_cast(unsigned, lsum); const auto rr = __builtin_amdgcn_permlane32_swap(lu, lu, false, false);
        inv = 1.f / (__builtin_bit_cast(float, (unsigned)rr[0]) + __builtin_bit_cast(float, (unsigned)rr[1])); }
    bf16_t* op = O + (rowbase + tq) * 2048 + 4 * hh;
#pragma unroll
    for (int d = 0; d < 4; ++d)
#pragma unroll
        for (int g = 0; g < 4; ++g) { u32x2 w; w.x = pk2(oacc[d][4 * g] * inv, oacc[d][4 * g + 1] * inv); w.y = pk2(oacc[d][4 * g + 2] * inv, oacc[d][4 * g + 3] * inv);
            *(u32x2*)(op + 32 * d + 8 * g) = w; }
}

__device__ __forceinline__ void attn_phase(const Params& P, LAS unsigned char* lds, int vcu, int G) {
    const int tid = threadIdx.x, lane = tid & 63, wid = __builtin_amdgcn_readfirstlane(tid >> 6);
    unsigned char* ws = P.ws;
    const bf16_t* QKV = (const bf16_t*)(ws + WS_QKV); const size_t TS = (size_t)T_TOK * 1024;
    bf16_t* OAB = (bf16_t*)(ws + WS_H); const float* LOGF = (const float*)(ws + WS_LOGF);
    unsigned* qctr = (unsigned*)(ws + WS_CTL + 196608);
    const unsigned* KMAXW = (const unsigned*)(ws + WS_CTL + 200704);
    volatile LAS unsigned* uw = (volatile LAS unsigned*)(lds + OFF_UNIT);
    for (;;) {
        if (tid == 0) uw[0] = atomicAdd(qctr, 1u);
        __syncthreads();
        const unsigned u = uw[0];
        __syncthreads();
        if (u >= 512u) break;
        const int mixer = (u < 256u) ? 1 : 0, v = (int)(u & 255u), qb = 15 - (v >> 4), bh = v & 15, b = bh >> 3, h = bh & 7;
        if (mixer == 0) {
            attn_unit<0>(lds, QKV, QKV + TS, QKV + 2 * TS, OAB + h * HD, b, h, qb, 0.f, tid, lane, wid);
        } else {
            float k2 = 0.f;
#pragma unroll
            for (int w = 0; w < 4; ++w) k2 += __builtin_bit_cast(float, __hip_atomic_load(KMAXW + bh * 4 + w, __ATOMIC_RELAXED, __HIP_MEMORY_SCOPE_AGENT));
            const float kmax = sqrtf(k2) * 1.01f;
            build_cumf(lds, LOGF, b, h, 256 * (qb + 1), tid, lane, wid);
            attn_unit<1>(lds, QKV + 3 * TS, QKV + 4 * TS, QKV + 5 * TS, OAB + 1024 + h * HD, b, h, qb, kmax, tid, lane, wid);
        }
        __syncthreads();
    }
}
}

namespace peer {
__device__ __forceinline__ unsigned sortable(float f) { const unsigned u = __builtin_bit_cast(unsigned, f); return (u & 0x80000000u) ? ~u : (u | 0x80000000u); }
__device__ __forceinline__ float unsortable(unsigned k) { const unsigned u = (k & 0x80000000u) ? (k & 0x7fffffffu) : ~k; return __builtin_bit_cast(float, u); }
template <int N> __device__ __forceinline__ unsigned umax_all(const unsigned (&k)[N]) {
    unsigned m = k[0];
#pragma unroll
    for (int q = 1; q < N; ++q) m = m > k[q] ? m : k[q];
    return m;
}

__device__ __forceinline__ void topk_phase(const Params& P, LAS unsigned char* lds, int vcu, int G) {
    const int tid = threadIdx.x, lane = tid & 63, wave = __builtin_amdgcn_readfirstlane(tid >> 6);
    const int c = lane & 31, hh = lane >> 5;
    const int gw = vcu * NWAVES + wave, NGW = G * NWAVES;
    unsigned char* ws = P.ws;
    const bf16_t* Q2 = (const bf16_t*)(ws + WS_Q2); const bf16_t* SKB = (const bf16_t*)(ws + WS_SKB);
    const float* ROWSS = (const float*)(ws + WS_CTL); int* IDS = (int*)(ws + WS_IDS); float* GATES = (float*)(ws + WS_GATES);
    LAS unsigned char* scr = lds + wave * 4096;
    for (int task = gw; task < 2048; task += NGW) {
        const int tg = task >> 3, hd = task & 7, tok = tg * 32 + c;
#pragma unroll 1
        for (int p = 0; p < 2; ++p) {
            bf16x8 qf[8];
            { const bf16_t* qp = Q2 + (size_t)tok * DM + hd * 256 + p * 128 + 8 * hh;
#pragma unroll
              for (int s = 0; s < 8; ++s) qf[s] = *(const bf16x8*)(qp + 16 * s); }
            unsigned keys[64];
#pragma unroll
            for (int sub = 0; sub < 4; ++sub) {
                f32x16 acc;
#pragma unroll
                for (int r = 0; r < 16; ++r) acc[r] = 0.f;
                const bf16_t* kp = SKB + ((size_t)(hd * 2 + p) * 128 + 32 * sub + c) * 128 + 8 * hh;
#pragma unroll
                for (int s = 0; s < 8; ++s) { const bf16x8 kf = *(const bf16x8*)(kp + 16 * s); acc = __builtin_amdgcn_mfma_f32_32x32x16_bf16(kf, qf[s], acc, 0, 0, 0); }
#pragma unroll
                for (int r = 0; r < 16; ++r) { const int nlo = 127 - (32 * sub + (r & 3) + 8 * (r >> 2)); keys[sub * 16 + r] = (sortable(acc[r]) & ~127u) | (unsigned)(nlo - 4 * hh); }
            }
            unsigned top[16];
#pragma unroll
            for (int i = 0; i < 16; ++i) {
                unsigned m = umax_all<64>(keys);
                const auto rr = __builtin_amdgcn_permlane32_swap(m, m, false, false);
                m = (unsigned)rr[0] > (unsigned)rr[1] ? (unsigned)rr[0] : (unsigned)rr[1];
                top[i] = m;
#pragma unroll
                for (int q = 0; q < 64; ++q) keys[q] = (keys[q] == m) ? 0u : keys[q];
            }
            if (hh == 0) {
#pragma unroll
                for (int w = 0; w < 4; ++w) *(LAS u32x4*)(scr + (c * 2 + p) * 64 + w * 16) = (u32x4){top[4 * w], top[4 * w + 1], top[4 * w + 2], top[4 * w + 3]};
            }
        }
        LDS_WAIT();
        float s1[16], s2[16];
#pragma unroll
        for (int w = 0; w < 4; ++w) { const u32x4 a = *(const LAS u32x4*)(scr + (c * 2) * 64 + w * 16), b2 = *(const LAS u32x4*)(scr + (c * 2 + 1) * 64 + w * 16);
#pragma unroll
            for (int e = 0; e < 4; ++e) { s1[4 * w + e] = unsortable((a[e] & ~127u) | 64u); s2[4 * w + e] = unsortable((b2[e] & ~127u) | 64u); } }
        unsigned ck[50];
        { int n = 0;
#pragma unroll
          for (int i = 0; i < 16; ++i)
#pragma unroll
              for (int j = 0; j < 16; ++j) if ((i + 1) * (j + 1) <= 16) { ck[n] = (sortable(s1[i] + s2[j]) & ~255u) | (unsigned)(255 - (i * 16 + j)); ++n; } }
        unsigned t2[16];
#pragma unroll
        for (int k = 0; k < 16; ++k) { const unsigned m = umax_all<50>(ck); t2[k] = m;
#pragma unroll
            for (int q = 0; q < 50; ++q) ck[q] = (ck[q] == m) ? 0u : ck[q]; }
        int ids[16]; float sc[16];
#pragma unroll
        for (int k = 0; k < 16; ++k) { const unsigned pos = 255u - (t2[k] & 255u);
            const unsigned k1 = *(const LAS unsigned*)(scr + (c * 2) * 64 + (pos >> 4) * 4), k2 = *(const LAS unsigned*)(scr + (c * 2 + 1) * 64 + (pos & 15u) * 4);
            ids[k] = (int)((127u - (k1 & 127u)) * 128u + (127u - (k2 & 127u))); sc[k] = unsortable((t2[k] & ~255u) | 128u); }
        LDS_WAIT();
        const float rs = 1.0f / sqrtf(ROWSS[tok] * (1.f / DM) + EPS);
        float ev[16], Z = 0.f;
#pragma unroll
        for (int k = 0; k < 16; ++k) { ev[k] = fexp2((sc[k] - sc[0]) * rs * LOG2E); Z += ev[k]; }
        const float iz = 1.f / Z;
        int* ip = IDS + (size_t)tok * 128 + hd * 16; float* gp = GATES + (size_t)tok * 128 + hd * 16;
        if (hh == 0) {
#pragma unroll
            for (int k = 0; k < 8; ++k) { ip[k] = ids[k]; gp[k] = ev[k] * iz; }
        } else {
#pragma unroll
            for (int k = 8; k < 16; ++k) { ip[k] = ids[k]; gp[k] = ev[k] * iz; }
        }
    }
}


__device__ __forceinline__ void topk_naive(const Params& P, LAS unsigned char* lds, int vcu, int G) {
    const int tid = threadIdx.x, lane = tid & 63, wave = __builtin_amdgcn_readfirstlane(tid >> 6);
    const int gw = vcu * NWAVES + wave, NGW = G * NWAVES;
    unsigned char* ws = P.ws;
    const bf16_t* Q2 = (const bf16_t*)(ws + WS_Q2);
    const float* ROWSS = (const float*)(ws + WS_CTL); int* IDS = (int*)(ws + WS_IDS); float* GATES = (float*)(ws + WS_GATES);
    LAS float* sv = (LAS float*)(lds + wave * 1024);
    LAS int* si = (LAS int*)(lds + wave * 1024 + 256);
    for (int task = gw; task < T_TOK * 8; task += NGW) {
        const int tok = task >> 3, hd = task & 7;
        for (int p = 0; p < 2; ++p) {
            float v0 = 0.f, v1 = 0.f;
            for (int cc = 0; cc < 128; ++cc) { const float q = bf_lo((unsigned)Q2[(size_t)tok * DM + hd * 256 + p * 128 + cc]);
                v0 += q * P.sub_keys[((size_t)(hd * 2 + p) * 128 + lane) * 128 + cc]; v1 += q * P.sub_keys[((size_t)(hd * 2 + p) * 128 + lane + 64) * 128 + cc]; }
            for (int i = 0; i < 16; ++i) {
                float bv = v0 >= v1 ? v0 : v1; int bi = v0 >= v1 ? lane : lane + 64;
                for (int o = 1; o < 64; o <<= 1) { const float ov = __shfl_xor(bv, o); const int oi = __shfl_xor(bi, o); if (ov > bv || (ov == bv && oi < bi)) { bv = ov; bi = oi; } }
                if (lane == 0) { sv[p * 16 + i] = bv; si[p * 16 + i] = bi; }
                if (bi == lane) v0 = -3e38f; if (bi == lane + 64) v1 = -3e38f;
            }
        }
        LDS_WAIT();
        float cv[4]; for (int q = 0; q < 4; ++q) { const int pos = lane * 4 + q; cv[q] = sv[pos >> 4] + sv[16 + (pos & 15)]; }
        float sel_v = 0.f; int sel_id = 0; float mx = 0.f;
        for (int k = 0; k < 16; ++k) {
            float bv = cv[0]; int bi = lane * 4;
            for (int q = 1; q < 4; ++q) if (cv[q] > bv) { bv = cv[q]; bi = lane * 4 + q; }
            for (int o = 1; o < 64; o <<= 1) { const float ov = __shfl_xor(bv, o); const int oi = __shfl_xor(bi, o); if (ov > bv || (ov == bv && oi < bi)) { bv = ov; bi = oi; } }
            if (k == 0) mx = bv;
            if (lane == k) { sel_v = bv; sel_id = si[bi >> 4] * 128 + si[16 + (bi & 15)]; }
            for (int q = 0; q < 4; ++q) if (bi == lane * 4 + q) cv[q] = -3e38f;
        }
        const float rs = 1.0f / sqrtf(ROWSS[tok] * (1.f / DM) + EPS);
        float ev = (lane < 16) ? expf((sel_v - mx) * rs) : 0.f;
        const float Z = wave_sum(ev);
        if (lane < 16) { IDS[(size_t)tok * 128 + hd * 16 + lane] = sel_id; GATES[(size_t)tok * 128 + hd * 16 + lane] = ev / Z; }
        LDS_WAIT();
    }
}

__device__ __forceinline__ float dot8(u32x4 a, u32x4 b, float acc) {
    const unsigned a0 = a[0], a1 = a[1], a2 = a[2], a3 = a[3], b0 = b[0], b1 = b[1], b2 = b[2], b3 = b[3];
    acc = __builtin_amdgcn_fdot2_f32_bf16(__builtin_bit_cast(bf16v2, a0), __builtin_bit_cast(bf16v2, b0), acc, false);
    acc = __builtin_amdgcn_fdot2_f32_bf16(__builtin_bit_cast(bf16v2, a1), __builtin_bit_cast(bf16v2, b1), acc, false);
    acc = __builtin_amdgcn_fdot2_f32_bf16(__builtin_bit_cast(bf16v2, a2), __builtin_bit_cast(bf16v2, b2), acc, false);
    acc = __builtin_amdgcn_fdot2_f32_bf16(__builtin_bit_cast(bf16v2, a3), __builtin_bit_cast(bf16v2, b3), acc, false);
    return acc;
}
__device__ __forceinline__ float gelu_tanh(float a) { const float t = 1.5957691216f * (a + 0.044715f * a * a * a); return a * frcp(1.f + fexp2(-LOG2E * t)); }

__device__ __forceinline__ void gather_phase(const Params& P, int vcu, int G) {
    const int tid = threadIdx.x, lane = tid & 63, wave = __builtin_amdgcn_readfirstlane(tid >> 6);
    const int gw = vcu * NWAVES + wave, NGW = G * NWAVES;
    unsigned char* ws = P.ws;
    const float* X1 = (const float*)(ws + WS_X1); const float* ROWSS = (const float*)(ws + WS_CTL);
    const int* IDS = (const int*)(ws + WS_IDS); const float* GATES = (const float*)(ws + WS_GATES);
    const unsigned char* EU = ws + WS_EU; const unsigned char* EV = ws + WS_EV;
    const float* SU = (const float*)(ws + WS_SU); const float* SV = (const float*)(ws + WS_SV);
    const bool b5 = (lane >> 5) & 1, b4 = (lane >> 4) & 1, b3 = (lane >> 3) & 1;
    for (int tok = gw; tok < T_TOK; tok += NGW) {
        f32x4 xv[2][4]; u32x4 hq[2];
        const float rs = 1.0f / sqrtf(ROWSS[tok] * (1.f / DM) + EPS);
        float hmx = 0.f;
#pragma unroll
        for (int j = 0; j < 2; ++j)
#pragma unroll
            for (int c4 = 0; c4 < 4; ++c4) { const size_t o = (size_t)tok * DM + 16 * lane + 1024 * j + 4 * c4; xv[j][c4] = *(const f32x4*)(X1 + o); }
        f32x4 hv[2][4];
#pragma unroll
        for (int j = 0; j < 2; ++j)
#pragma unroll
            for (int c4 = 0; c4 < 4; ++c4) { const f32x4 g = *(const f32x4*)(P.g_ffn + 16 * lane + 1024 * j + 4 * c4); hv[j][c4] = xv[j][c4] * rs * g;
                hmx = fmaxf(hmx, fmaxf(fmaxf(fabsf(hv[j][c4][0]), fabsf(hv[j][c4][1])), fmaxf(fabsf(hv[j][c4][2]), fabsf(hv[j][c4][3])))); }
#pragma unroll
        for (int o = 1; o < 64; o <<= 1) hmx = fmaxf(hmx, __shfl_xor(hmx, o));
        hmx = fmaxf(hmx, 1e-30f);
        const float hinv = 127.f / hmx, hscale = hmx * (1.f / 127.f);
#pragma unroll
        for (int j = 0; j < 2; ++j)
#pragma unroll
            for (int c4 = 0; c4 < 4; ++c4) { unsigned w = 0;
#pragma unroll
                for (int e = 0; e < 4; ++e) w |= ((unsigned)(int)__builtin_rintf(hv[j][c4][e] * hinv) & 255u) << (8 * e);
                hq[j][c4] = w; }
        const int ida = IDS[(size_t)tok * 128 + lane], idb = IDS[(size_t)tok * 128 + 64 + lane];
        const float sua = SU[ida], sub = SU[idb], sva = SV[ida], svb = SV[idb];
        float wreg[16];
#pragma unroll
        for (int bt = 0; bt < 16; ++bt) {
            int part[8]; u32x4 ud[8][2];
#pragma unroll
            for (int q = 0; q < 8; ++q) { const int k = bt * 8 + q; const int e = __builtin_amdgcn_readlane(k < 64 ? ida : idb, k & 63);
                const unsigned char* ur = EU + (size_t)e * DM + 16 * lane;
                ud[q][0] = *(const u32x4*)ur; ud[q][1] = *(const u32x4*)(ur + 1024); }
#pragma unroll
            for (int q = 0; q < 8; ++q) { int a = 0;
#pragma unroll
                for (int j = 0; j < 2; ++j)
#pragma unroll
                    for (int c4 = 0; c4 < 4; ++c4) a = __builtin_amdgcn_sdot4((int)ud[q][j][c4], (int)hq[j][c4], a, false);
                part[q] = a; }
            int p1[4], p2[2];
#pragma unroll
            for (int q = 0; q < 4; ++q) { const int send = b5 ? part[q] : part[q + 4], keep = b5 ? part[q + 4] : part[q]; p1[q] = keep + __shfl_xor(send, 32); }
#pragma unroll
            for (int q = 0; q < 2; ++q) { const int send = b4 ? p1[q] : p1[q + 2], keep = b4 ? p1[q + 2] : p1[q]; p2[q] = keep + __shfl_xor(send, 16); }
            int p3; { const int send = b3 ? p2[0] : p2[1], keep = b3 ? p2[1] : p2[0]; p3 = keep + __shfl_xor(send, 8); }
            p3 += __shfl_xor(p3, 4); p3 += __shfl_xor(p3, 2); p3 += __shfl_xor(p3, 1);
            const int ksel = bt * 8 + (lane >> 3);
            const float su_k = __shfl(bt < 8 ? sua : sub, ksel & 63), sv_k = __shfl(bt < 8 ? sva : svb, ksel & 63);
            const float gate = GATES[(size_t)tok * 128 + ksel];
            const float act = (float)p3 * (su_k * hscale);
            wreg[bt] = gate * gelu_tanh(act) * sv_k;
        }
        f32x4 acc[2][4]; float wsum = 0.f;
#pragma unroll
        for (int j = 0; j < 2; ++j)
#pragma unroll
            for (int c4 = 0; c4 < 4; ++c4) acc[j][c4] = (f32x4){0.f, 0.f, 0.f, 0.f};
#pragma unroll
        for (int bt = 0; bt < 16; ++bt) {
            u32x4 vd[8][2];
#pragma unroll
            for (int q = 0; q < 8; ++q) { const int k = bt * 8 + q; const int e = __builtin_amdgcn_readlane(k < 64 ? ida : idb, k & 63);
                const unsigned char* vr = EV + (size_t)e * DM + 16 * lane;
                vd[q][0] = *(const u32x4*)vr; vd[q][1] = *(const u32x4*)(vr + 1024); }
#pragma unroll
            for (int q = 0; q < 8; ++q) { const float w = __builtin_bit_cast(float, __builtin_amdgcn_readlane(__builtin_bit_cast(int, wreg[bt]), 8 * q));
                wsum += w;
#pragma unroll
                for (int j = 0; j < 2; ++j)
#pragma unroll
                    for (int c4 = 0; c4 < 4; ++c4) { const unsigned u = vd[q][j][c4];
                        acc[j][c4] += w * (f32x4){(float)(u & 255u), (float)((u >> 8) & 255u), (float)((u >> 16) & 255u), (float)(u >> 24)}; } }
        }
        float ss = 0.f; const float corr = 128.f * wsum;
#pragma unroll
        for (int j = 0; j < 2; ++j)
#pragma unroll
            for (int c4 = 0; c4 < 4; ++c4) { const f32x4 v = (DBG == 1 || DBG == 2) ? xv[j][c4] : xv[j][c4] + (acc[j][c4] - corr); xv[j][c4] = v; ss += (v[0] * v[0] + v[1] * v[1]) + (v[2] * v[2] + v[3] * v[3]); }
        const float rs2 = 1.0f / sqrtf(wave_sum(ss) * (1.f / DM) + EPS);
#pragma unroll
        for (int j = 0; j < 2; ++j)
#pragma unroll
            for (int c4 = 0; c4 < 4; ++c4) { const size_t o = (size_t)tok * DM + 16 * lane + 1024 * j + 4 * c4;
                const f32x4 g = *(const f32x4*)(P.g_final + 16 * lane + 1024 * j + 4 * c4);
                *(f32x4*)(P.out + o) = xv[j][c4] * rs2 * g; }
    }
}


__device__ __forceinline__ int dot16(u32x4 a, u32x4 b, int acc) {
    acc = __builtin_amdgcn_sdot4((int)a[0], (int)b[0], acc, false); acc = __builtin_amdgcn_sdot4((int)a[1], (int)b[1], acc, false);
    acc = __builtin_amdgcn_sdot4((int)a[2], (int)b[2], acc, false); acc = __builtin_amdgcn_sdot4((int)a[3], (int)b[3], acc, false);
    return acc;
}
__device__ __forceinline__ void gather_sweep(const Params& P, LAS unsigned char* lds, int vcu, int G) {
    const int tid = threadIdx.x, lane = tid & 63, wave = __builtin_amdgcn_readfirstlane(tid >> 6);
    const int gw = vcu * NWAVES + wave, NGW = G * NWAVES;
    const int g = lane >> 3, i = lane & 7;
    unsigned char* ws = P.ws;
    const float* X1 = (const float*)(ws + WS_X1); const float* ROWSS = (const float*)(ws + WS_CTL);
    const int* IDS = (const int*)(ws + WS_IDS); const float* GATES = (const float*)(ws + WS_GATES);
    const unsigned char* EU = ws + WS_EU; const unsigned char* EV = ws + WS_EV;
    const float* SU = (const float*)(ws + WS_SU); const float* SV = (const float*)(ws + WS_SV);
    LAS unsigned char* wl = lds + wave * 16384;
    const bool b2 = (lane >> 2) & 1, b1 = (lane >> 1) & 1, b0 = lane & 1, B2 = (lane >> 5) & 1, B1 = (lane >> 4) & 1, B0 = (lane >> 3) & 1;
    for (int tg = gw; tg < T_TOK / 4; tg += NGW) {
        const int tok0 = tg * 4;
        float hs[4];
#pragma unroll
        for (int j = 0; j < 4; ++j) { const int tok = tok0 + j;
            const float rs = 1.0f / sqrtf(ROWSS[tok] * (1.f / DM) + EPS);
            f32x4 hv[8]; float hmx = 0.f;
#pragma unroll
            for (int q = 0; q < 8; ++q) { const f32x4 xv = *((const f32x4*)(X1 + (size_t)tok * DM) + lane + 64 * q); const f32x4 gn = *((const f32x4*)P.g_ffn + lane + 64 * q);
                hv[q] = xv * rs * gn; hmx = fmaxf(hmx, fmaxf(fmaxf(fabsf(hv[q][0]), fabsf(hv[q][1])), fmaxf(fabsf(hv[q][2]), fabsf(hv[q][3])))); }
#pragma unroll
            for (int o = 1; o < 64; o <<= 1) hmx = fmaxf(hmx, __shfl_xor(hmx, o));
            hmx = fmaxf(hmx, 1e-30f); const float hinv = 127.f / hmx; hs[j] = hmx * (1.f / 127.f);
#pragma unroll
            for (int q = 0; q < 8; ++q) { unsigned w = 0;
#pragma unroll
                for (int e = 0; e < 4; ++e) w |= ((unsigned)(int)__builtin_rintf(hv[q][e] * hinv) & 255u) << (8 * e);
                *(LAS unsigned*)(wl + j * 2048 + 4 * (lane + 64 * q)) = w; }
#pragma unroll
            for (int hf = 0; hf < 2; ++hf) { const int k = lane + 64 * hf; const int id = IDS[(size_t)tok * 128 + k];
                *(LAS unsigned*)(wl + 8192 + (j * 128 + k) * 4) = (unsigned)id * 2048u;
                *(LAS float*)(wl + 10240 + (j * 128 + k) * 4) = GATES[(size_t)tok * 128 + k] * SV[id];
                *(LAS float*)(wl + 12288 + (j * 128 + k) * 4) = SU[id]; }
        }
        LDS_WAIT();
        int accu[4][16];
#pragma unroll
        for (int j = 0; j < 4; ++j)
#pragma unroll
            for (int m = 0; m < 16; ++m) accu[j][m] = 0;
#pragma unroll 1
        for (int sl = 0; sl < 16; ++sl) {
            const unsigned char* ub = EU + 128 * sl + 16 * i;
#pragma unroll
            for (int j = 0; j < 4; ++j) {
                const u32x4 hqc = *(const LAS u32x4*)(wl + j * 2048 + 128 * sl + 16 * i);
                u32x4 d[16];
#pragma unroll
                for (int m = 0; m < 16; ++m) { const unsigned off = *(const LAS unsigned*)(wl + 8192 + (j * 128 + 8 * m + g) * 4); d[m] = *(const u32x4*)(ub + off); }
#pragma unroll
                for (int m = 0; m < 16; ++m) accu[j][m] = dot16(d[m], hqc, accu[j][m]);
                __builtin_amdgcn_sched_barrier(0);
            }
        }
        float corr[4];
#pragma unroll
        for (int j = 0; j < 4; ++j) {
            int r1[8], r2[4], r3[2];
#pragma unroll
            for (int m = 0; m < 8; ++m) { const int send = b2 ? accu[j][m] : accu[j][m + 8], keep = b2 ? accu[j][m + 8] : accu[j][m]; r1[m] = keep + __shfl_xor(send, 4); }
#pragma unroll
            for (int m = 0; m < 4; ++m) { const int send = b1 ? r1[m] : r1[m + 4], keep = b1 ? r1[m + 4] : r1[m]; r2[m] = keep + __shfl_xor(send, 2); }
#pragma unroll
            for (int m = 0; m < 2; ++m) { const int send = b0 ? r2[m] : r2[m + 2], keep = b0 ? r2[m + 2] : r2[m]; r3[m] = keep + __shfl_xor(send, 1); }
            float wsum = 0.f;
#pragma unroll
            for (int m = 0; m < 2; ++m) { const int k = 16 * i + 8 * m + g;
                const float act = (float)r3[m] * (hs[j] * *(const LAS float*)(wl + 12288 + (j * 128 + k) * 4));
                const float w = *(const LAS float*)(wl + 10240 + (j * 128 + k) * 4) * gelu_tanh(act);
                *(LAS float*)(wl + 10240 + (j * 128 + k) * 4) = w; wsum += w; }
            corr[j] = 128.f * wave_sum(wsum);
        }
        LDS_WAIT();
        float ssq[4] = {0.f, 0.f, 0.f, 0.f};
#pragma unroll 1
        for (int sl = 0; sl < 16; ++sl) {
            const unsigned char* vb = EV + 128 * sl + 16 * i;
#pragma unroll
            for (int j = 0; j < 4; ++j) {
                u32x4 d[16]; float wv[16];
#pragma unroll
                for (int m = 0; m < 16; ++m) { const unsigned off = *(const LAS unsigned*)(wl + 8192 + (j * 128 + 8 * m + g) * 4); wv[m] = *(const LAS float*)(wl + 10240 + (j * 128 + 8 * m + g) * 4); d[m] = *(const u32x4*)(vb + off); }
                float ca[16];
#pragma unroll
                for (int b = 0; b < 16; ++b) ca[b] = 0.f;
#pragma unroll
                for (int m = 0; m < 16; ++m)
#pragma unroll
                    for (int c4 = 0; c4 < 4; ++c4) { const unsigned u = d[m][c4];
                        ca[4 * c4 + 0] += wv[m] * (float)(u & 255u); ca[4 * c4 + 1] += wv[m] * (float)((u >> 8) & 255u);
                        ca[4 * c4 + 2] += wv[m] * (float)((u >> 16) & 255u); ca[4 * c4 + 3] += wv[m] * (float)(u >> 24); }
                float c1[8], c2[4], c3[2];
#pragma unroll
                for (int b = 0; b < 8; ++b) { const float send = B2 ? ca[b] : ca[b + 8], keep = B2 ? ca[b + 8] : ca[b]; c1[b] = keep + __shfl_xor(send, 32); }
#pragma unroll
                for (int b = 0; b < 4; ++b) { const float send = B1 ? c1[b] : c1[b + 4], keep = B1 ? c1[b + 4] : c1[b]; c2[b] = keep + __shfl_xor(send, 16); }
#pragma unroll
                for (int b = 0; b < 2; ++b) { const float send = B0 ? c2[b] : c2[b + 2], keep = B0 ? c2[b + 2] : c2[b]; c3[b] = keep + __shfl_xor(send, 8); }
                const size_t o = (size_t)(tok0 + j) * DM + 128 * sl + 16 * i + 2 * g;
                const f32x2 xv = *(const f32x2*)(X1 + o);
                const f32x2 x2 = {xv[0] + (c3[0] - corr[j]), xv[1] + (c3[1] - corr[j])};
                ssq[j] += x2[0] * x2[0] + x2[1] * x2[1];
                *(f32x2*)(P.out + o) = x2;
                __builtin_amdgcn_sched_barrier(0);
            }
        }
#pragma unroll
        for (int j = 0; j < 4; ++j) { const float rs2 = 1.0f / sqrtf(wave_sum(ssq[j]) * (1.f / DM) + EPS);
            f32x4* orow = (f32x4*)(P.out + (size_t)(tok0 + j) * DM) + lane;
#pragma unroll
            for (int q = 0; q < 8; ++q) { const f32x4 gn = *((const f32x4*)P.g_final + lane + 64 * q); orow[64 * q] = orow[64 * q] * rs2 * gn; } }
        LDS_WAIT();
    }
}

__device__ __forceinline__ void gather_naive(const Params& P, int vcu, int G) {
    const int tid = threadIdx.x, lane = tid & 63, wave = __builtin_amdgcn_readfirstlane(tid >> 6);
    const int gw = vcu * NWAVES + wave, NGW = G * NWAVES;
    unsigned char* ws = P.ws;
    const float* X1 = (const float*)(ws + WS_X1); const float* ROWSS = (const float*)(ws + WS_CTL);
    const int* IDS = (const int*)(ws + WS_IDS); const float* GATES = (const float*)(ws + WS_GATES);
    for (int tok = gw; tok < T_TOK; tok += NGW) {
        float h2[32], acc[32];
        const float rs = 1.0f / sqrtf(ROWSS[tok] * (1.f / DM) + EPS);
#pragma unroll
        for (int i = 0; i < 32; ++i) { h2[i] = X1[(size_t)tok * DM + lane + 64 * i] * rs * P.g_ffn[lane + 64 * i]; acc[i] = 0.f; }
#pragma unroll 1
        for (int k = 0; k < 128; ++k) {
            const int e = IDS[(size_t)tok * 128 + k]; float a = 0.f;
            if (false) { const bf16_t* up = (const bf16_t*)(ws + WS_EU) + (size_t)e * DM + lane;
#pragma unroll
                for (int i = 0; i < 32; ++i) a += h2[i] * bf_lo((unsigned)up[64 * i]);
            } else { const float* up = P.e_u + (size_t)e * DM + lane;
#pragma unroll
                for (int i = 0; i < 32; ++i) a += h2[i] * up[64 * i]; }
            a = wave_sum(a);
            const float w = GATES[(size_t)tok * 128 + k] * gelu_tanh(a);
            if (false) { const bf16_t* vp = (const bf16_t*)(ws + WS_EV) + (size_t)e * DM + lane;
#pragma unroll
                for (int i = 0; i < 32; ++i) acc[i] += w * bf_lo((unsigned)vp[64 * i]);
            } else { const float* vp = P.e_v + (size_t)e * DM + lane;
#pragma unroll
                for (int i = 0; i < 32; ++i) acc[i] += w * vp[64 * i]; }
        }
        float ss = 0.f;
#pragma unroll
        for (int i = 0; i < 32; ++i) { acc[i] += X1[(size_t)tok * DM + lane + 64 * i]; ss += acc[i] * acc[i]; }
        const float rs2 = 1.0f / sqrtf(wave_sum(ss) * (1.f / DM) + EPS);
#pragma unroll
        for (int i = 0; i < 32; ++i) P.out[(size_t)tok * DM + lane + 64 * i] = acc[i] * rs2 * P.g_final[lane + 64 * i];
    }
}
}


#define XB_TMO      128
#define XB_XCNT(j)  (256  + 64 * (j))
#define XB_XSUB(j)  (1280 + 64 * (j))
#define XB_XGEN(j)  (2304 + 64 * (j))
#define XB_TOP      3328
#define XB_TOPGEN   3392
#define XCD_BAR_WORDS 3456
#define XB_SPIN_CAP (1u << 18)
__device__ __forceinline__ unsigned xb_ld(unsigned* p)              { return __hip_atomic_load(p, __ATOMIC_RELAXED, __HIP_MEMORY_SCOPE_AGENT); }
__device__ __forceinline__ unsigned xb_add(unsigned* p, unsigned v) { return __hip_atomic_fetch_add(p, v, __ATOMIC_RELAXED, __HIP_MEMORY_SCOPE_AGENT); }
__device__ __forceinline__ unsigned xb_xcc_id() { return (unsigned)__builtin_amdgcn_s_getreg((3 << 11) | 20) & 0xFu; }
#define XB_SPIN(cond, bar) do { unsigned _sp = 0; while (cond) { __builtin_amdgcn_s_sleep(1); \
    if ((++_sp & 255u) == 0u) { if (xb_ld(&(bar)[XB_TMO])) break; if (_sp > XB_SPIN_CAP) { atomicAdd(&(bar)[XB_TMO], 1u); break; } } } } while (0)
struct XcdBarrier { unsigned* bar; unsigned x; volatile LAS unsigned* st; };
__device__ __forceinline__ XcdBarrier xcd_barrier_post(unsigned* bar, volatile LAS unsigned* st) {
    XcdBarrier b; b.bar = bar; b.x = xb_xcc_id(); b.st = st;
    if (threadIdx.x == 0) (void)xb_add(&bar[XB_XCNT(b.x)], 1u);
    return b;
}
__device__ __forceinline__ void xcd_barrier_complete(unsigned* bar, unsigned x, unsigned& nloc, unsigned& nx) {
    const unsigned G = gridDim.x * gridDim.y * gridDim.z;
    unsigned sum, cnt, mine, sp = 0u;
    for (;;) {
        sum = 0u; cnt = 0u; mine = 0u;
#pragma unroll
        for (unsigned j = 0; j < 16; ++j) { const unsigned c = xb_ld(&bar[XB_XCNT(j)]); sum += c; cnt += (c > 0u) ? 1u : 0u; mine = (j == x) ? c : mine; }
        if (sum == G) break;
        __builtin_amdgcn_s_sleep(1);
        if ((++sp & 255u) == 0u) { if (xb_ld(&bar[XB_TMO])) break; if (sp > XB_SPIN_CAP) { atomicAdd(&bar[XB_TMO], 1u); break; } }
    }
    nloc = mine > 0u ? mine : 1u; nx = cnt > 0u ? cnt : 1u;
}
__device__ __forceinline__ void xcd_barrier(const XcdBarrier& b) {
    asm volatile("s_waitcnt vmcnt(0)" ::: "memory");
    __syncthreads();
    if (threadIdx.x == 0) {
        unsigned* bar = b.bar;
        __builtin_amdgcn_s_waitcnt(0);
        unsigned nloc = b.st[0], nx = b.st[1];
        if (nloc == 0u) { xcd_barrier_complete(bar, b.x, nloc, nx); b.st[0] = nloc; b.st[1] = nx; }
        const unsigned old = xb_add(&bar[XB_XSUB(b.x)], 1u);
        const unsigned gen = old / nloc;
        if (old + 1u == (gen + 1u) * nloc) {
            __builtin_amdgcn_fence(__ATOMIC_RELEASE, "agent");
            asm volatile("s_waitcnt vmcnt(0)" ::: "memory");
            const unsigned og = xb_add(&bar[XB_TOP], 1u);
            const unsigned tg = og / nx;
            if (og + 1u == (tg + 1u) * nx) xb_add(&bar[XB_TOPGEN], 1u);
            else XB_SPIN(xb_ld(&bar[XB_TOPGEN]) == tg, bar);
            __builtin_amdgcn_fence(__ATOMIC_ACQUIRE, "agent");
            xb_add(&bar[XB_XGEN(b.x)], 1u);
            asm volatile("s_waitcnt vmcnt(0)" ::: "memory");
        } else {
            XB_SPIN(xb_ld(&bar[XB_XGEN(b.x)]) == gen, bar);
            __builtin_amdgcn_fence(__ATOMIC_ACQUIRE, "agent");
            asm volatile("s_waitcnt vmcnt(0)" ::: "memory");
        }
    }
    __syncthreads();
}

__global__ void __launch_bounds__(NTHR, 2) mega_fwd(Params P) {
    extern __shared__ __attribute__((aligned(16))) unsigned char lds_raw[];
    LAS unsigned char* lds = (LAS unsigned char*)lds_raw;
    cg::grid_group grid = cg::this_grid();
    const int G = gridDim.x, bx = blockIdx.x;
    const int vcu = (G % 8 == 0) ? (bx % 8) * (G / 8) + bx / 8 : bx;
    unsigned char* ws = P.ws;
#ifndef ONLY_PHASE
#define ONLY_PHASE -1
#endif
#define IN(k) ((ONLY_PHASE < 0 || ONLY_PHASE == (k)) && P.ph_lo <= (k) && (k) < P.ph_hi)
    volatile LAS unsigned* bst = (volatile LAS unsigned*)(lds + 131072);
    if (threadIdx.x < 16) bst[threadIdx.x] = 0u;
    __syncthreads();
    const XcdBarrier xbar = xcd_barrier_post((unsigned*)(ws + WS_CTL + 131072), bst);
    if (P.ph_lo < 0) grid.sync();
#define SEAM(k) do { if (IN(k) && IN((k) + 1)) xcd_barrier(xbar); } while (0)
    if (IN(0)) { p0a(P, lds, vcu, G); xcd_barrier(xbar); p0b(P, lds, vcu, G); }
    SEAM(0);
    for (int rep_ = 0; rep_ < (REPK == 1 ? 2 : 1); ++rep_) if (IN(1)) {
        pg8::Gemm g{ws + WS_H, ws + WS_WIN, T_TOK, 10240, 2048, 2048, 2048};
        pg8::StaticOrder S; S.init(T_TOK, 10240, G, bx);
        pg8::EpiProj E{(bf16_t*)(ws + WS_QKV), (bf16_t*)(ws + WS_SG), LOG2E * 0.08838834764831845f, (unsigned*)(ws + WS_CTL + 200704), (const float*)(ws + WS_HSC), (const float*)(ws + WS_WSC)};
        pg8::gemm_phase<pg8::EpiProj, true>(lds, g, S, E);
    }
    SEAM(1);
    if (IN(2)) { att::attn_phase(P, lds, vcu, G); __syncthreads(); late_transposes(P, lds, vcu, G); }
    SEAM(2);
    for (int rep_ = 0; rep_ < (REPK == 3 ? 2 : 1); ++rep_) if (IN(3)) {
        pg8::StaticOrder S; S.init(T_TOK, DM, G, bx);
        { pg8::Gemm g{ws + WS_H, ws + WS_WAT, T_TOK, DM, 1024, 4096, 2048};
          pg8::EpiGate<0> E{(const bf16_t*)(ws + WS_SG), (float*)(ws + WS_TMP), (bf16_t*)(ws + WS_MERGED)};
          pg8::gemm_phase(lds, g, S, E); }
        { pg8::Gemm g{ws + WS_H + 2048, ws + WS_WBT, T_TOK, DM, 1024, 4096, 2048};
          pg8::EpiGate<1> E{(const bf16_t*)(ws + WS_SG) + 2048, (float*)(ws + WS_TMP), (bf16_t*)(ws + WS_MERGED)};
          pg8::gemm_phase(lds, g, S, E); }
    }
    SEAM(3);
    for (int rep_ = 0; rep_ < (REPK == 4 ? 2 : 1); ++rep_) if (IN(4)) {
        pg8::Gemm g{ws + WS_MERGED, ws + WS_WOUT, T_TOK, DM, 2048, 4096, 4096};
        pg8::StaticOrder S; S.init(T_TOK, DM, G, bx);
        pg8::EpiResid E{P.x, (float*)(ws + WS_X1), (bf16_t*)(ws + WS_X1B), (float*)(ws + WS_CTL)};
        pg8::gemm_phase(lds, g, S, E);
    }
    SEAM(4);
    for (int rep_ = 0; rep_ < (REPK == 5 ? 2 : 1); ++rep_) if (IN(5)) {
        pg8::Gemm g{ws + WS_X1B, ws + WS_WQ, T_TOK, DM, 2048, 4096, 4096};
        pg8::StaticOrder S; S.init(T_TOK, DM, G, bx);
        pg8::EpiPlainBf16 E{(bf16_t*)(ws + WS_Q2)};
        pg8::gemm_phase(lds, g, S, E);
    }
    SEAM(5);
    if (IN(6)) {
        const bool conv_first = __builtin_amdgcn_readfirstlane(threadIdx.x >> 6) >= 4;
        if (conv_first) quantise_experts(P, vcu, G);
        peer::topk_phase(P, lds, vcu, G);
        if (!conv_first) quantise_experts(P, vcu, G);
    }
    SEAM(6);
    for (int rep_ = 0; rep_ < (REPK == 7 ? 2 : 1); ++rep_) if (IN(7)) { if (DBG == 11) peer::gather_naive(P, vcu, G); else if (DBG == 14) peer::gather_phase(P, vcu, G); else peer::gather_sweep(P, lds, vcu, G); }
#undef IN
#undef SEAM
}

extern "C" void kernel_launch(void* const* d_in, const int* in_sizes, int n_in, void* d_out, int out_size, void* d_ws, size_t ws_size, hipStream_t stream) {
    static int grid = 0;
    if (grid == 0) {
        if (n_in != 13 || out_size != T_TOK * DM || ws_size < WS_END) { fprintf(stderr, "kernel_launch: unexpected shapes (n_in %d out %d ws %zu)\n", n_in, out_size, ws_size); grid = -1; return; }
        int dev = 0, cus = 0, per_cu = 0;
        if (hipGetDevice(&dev) != hipSuccess || hipDeviceGetAttribute(&cus, hipDeviceAttributeMultiprocessorCount, dev) != hipSuccess) { grid = -1; return; }
        if (hipFuncSetAttribute((const void*)mega_fwd, hipFuncAttributeMaxDynamicSharedMemorySize, LDS_BYTES) != hipSuccess) { fprintf(stderr, "kernel_launch: hipFuncSetAttribute failed\n"); grid = -1; return; }
        if (hipOccupancyMaxActiveBlocksPerMultiprocessor(&per_cu, (const void*)mega_fwd, NTHR, LDS_BYTES) != hipSuccess || per_cu < 1) { fprintf(stderr, "kernel_launch: occupancy query says %d\n", per_cu); grid = -1; return; }
        grid = cus;
    }
    if (grid < 0) return;
    (void)hipMemsetAsync((char*)d_ws + WS_CTL, 0, 1 * MiB, stream);
    Params p{};
    p.x = (const float*)d_in[0]; p.g_mix = (const float*)d_in[1]; p.w_in = (const float*)d_in[2]; p.b_forget = (const float*)d_in[3];
    p.w_a = (const float*)d_in[4]; p.w_b = (const float*)d_in[5]; p.w_out = (const float*)d_in[6]; p.g_ffn = (const float*)d_in[7];
    p.w_query = (const float*)d_in[8]; p.sub_keys = (const float*)d_in[9]; p.e_u = (const float*)d_in[10]; p.e_v = (const float*)d_in[11]; p.g_final = (const float*)d_in[12];
    p.out = (float*)d_out; p.ws = (unsigned char*)d_ws;
#if MK_N_LAUNCHES == 1
    p.ph_lo = 0; p.ph_hi = N_PHASES;
    void* args[] = {&p};
    hipError_t e = hipLaunchCooperativeKernel((const void*)mega_fwd, dim3(grid), dim3(NTHR), args, LDS_BYTES, stream);
    if (e != hipSuccess) fprintf(stderr, "kernel_launch: cooperative launch failed: %s (grid %d)\n", hipGetErrorString(e), grid);
#else
    for (int ph = 0; ph < N_PHASES; ++ph) { p.ph_lo = ph; p.ph_hi = ph + 1; hipLaunchKernelGGL(mega_fwd, dim3(grid), dim3(NTHR), LDS_BYTES, stream, p); }
#endif
}
```

```cpp
#include <hip/hip_runtime.h>
#include <hip/hip_cooperative_groups.h>
#include <cstdio>
#include <cstdint>
namespace cg = cooperative_groups;

#define LAS __attribute__((address_space(3)))
typedef unsigned short bf16_t;
typedef short bf16x8 __attribute__((ext_vector_type(8)));
typedef short s16x4 __attribute__((ext_vector_type(4)));
typedef float f32x2 __attribute__((ext_vector_type(2)));
typedef float f32x4 __attribute__((ext_vector_type(4)));
typedef float f32x16 __attribute__((ext_vector_type(16)));
typedef unsigned u32x2 __attribute__((ext_vector_type(2)));
typedef unsigned u32x4 __attribute__((ext_vector_type(4)));
typedef __bf16 bf16v2 __attribute__((ext_vector_type(2)));
typedef int i32x4 __attribute__((ext_vector_type(4)));

#ifndef DBG
#define DBG 0
#endif
#ifndef REPK
#define REPK -1
#endif
#ifndef MK_N_LAUNCHES
#define MK_N_LAUNCHES 1
#endif

constexpr int T_TOK = 8192, DM = 2048, SEQ = 4096, HD = 128;
constexpr int NWAVES = 8, NTHR = 512;
constexpr int LDS_BYTES = 147456;
constexpr float LOG2E = 1.4426950408889634f;
constexpr float EPS = 1e-6f;
constexpr int N_PHASES = 8;

constexpr size_t MiB = 1u << 20;
constexpr size_t WS_CTL = 0;
constexpr size_t WS_LOGF = 1 * MiB;
constexpr size_t WS_SKB = 1 * MiB + 512 * 1024;
constexpr size_t WS_HSC = 1 * MiB + 256 * 1024;
constexpr size_t WS_WSC = 1 * MiB + 320 * 1024;
constexpr size_t CTL_CMAX = 262144;
constexpr size_t WS_IDS = 2 * MiB;
constexpr size_t WS_GATES = 6 * MiB;
constexpr size_t WS_WAT = 10 * MiB, WS_WBT = 14 * MiB, WS_WOUT = 18 * MiB, WS_WQ = 26 * MiB, WS_WIN = 34 * MiB;
constexpr size_t WS_H = 74 * MiB;
constexpr size_t WS_QKV = 106 * MiB;
constexpr size_t WS_TMP = 106 * MiB, WS_MERGED = 170 * MiB, WS_Q2 = 106 * MiB;
constexpr size_t WS_SG = 202 * MiB;
constexpr size_t WS_X1B = 202 * MiB;
constexpr size_t WS_X1 = 266 * MiB;
constexpr size_t WS_EU = 330 * MiB, WS_EV = 362 * MiB;
constexpr size_t WS_SU = 394 * MiB, WS_SV = 394 * MiB + 65536;
constexpr size_t WS_END = 395 * MiB;

struct Params {
    const float* x; const float* g_mix; const float* w_in; const float* b_forget; const float* w_a; const float* w_b; const float* w_out;
    const float* g_ffn; const float* w_query; const float* sub_keys; const float* e_u; const float* e_v; const float* g_final;
    float* out; unsigned char* ws; int ph_lo, ph_hi;
};

__device__ __forceinline__ unsigned pk2(float a, float b) { f32x2 v = {a, b}; return __builtin_bit_cast(unsigned, __builtin_convertvector(v, bf16v2)); }
__device__ __forceinline__ float bf_lo(unsigned u) { return __builtin_bit_cast(float, u << 16); }
__device__ __forceinline__ float bf_hi(unsigned u) { return __builtin_bit_cast(float, u & 0xffff0000u); }
__device__ __forceinline__ float fexp2(float x) { return __builtin_amdgcn_exp2f(x); }
__device__ __forceinline__ float flog2(float x) { return __builtin_amdgcn_logf(x); }
__device__ __forceinline__ float frcp(float x) { return __builtin_amdgcn_rcpf(x); }
__device__ __forceinline__ float wave_sum(float v) {
#pragma unroll
    for (int o = 1; o < 64; o <<= 1) v += __shfl_xor(v, o);
    return v;
}
#define LDS_WAIT() asm volatile("s_waitcnt lgkmcnt(0)" ::: "memory")

namespace pg8 {
constexpr int BM = 256, BK = 64, HALF = 128, HTB = HALF * BK * 2, STAGE_BYTES = 8 * HTB, NXCD = 8, WGM = 8;
__host__ __device__ __forceinline__ int lds_byte(int r, int c) { const int st = (r >> 4) * 2 + (c >> 5), rr = r & 15, cc = c & 31, ob = rr * 64 + cc * 2; return st * 1024 + (ob ^ (((ob >> 9) & 1) << 5)); }
__host__ __device__ __forceinline__ void stage_rc(int b, int& R, int& C) { const int st = b / 1024, sb = b % 1024, swz = sb ^ (((sb >> 9) & 1) << 5); R = (st >> 1) * 16 + swz / 64; C = (st & 1) * 32 + (swz % 64) / 2; }
__host__ __device__ __forceinline__ int perm32(int rho) { const int n = rho >> 4, i = rho & 15; return 8 * (i >> 2) + 4 * n + (i & 3); }
struct Unit { int pm, pn; };
struct Gemm { const void* A; const void* Bt; int M, N, K, pa, pb; };
struct StaticOrder {
    int nM, nN, nwg, G, c;
    __device__ void init(int M, int N, int G_, int c_) { nM = M / BM; nN = N / BM; nwg = nM * nN; G = G_; c = c_; }
    __device__ bool next(int i, Unit& u) const {
        const long L = (long)i * G + c; if (L >= nwg) return false;
        int wgid = (int)L; { const int q = nwg / NXCD, r = nwg % NXCD, xcd = wgid % NXCD, off = wgid / NXCD; wgid = (xcd < r ? xcd * (q + 1) : r * (q + 1) + (xcd - r) * q) + off; }
        const int nig = WGM * nN, gid = wgid / nig, fm = gid * WGM, gsz = (nM - fm) < WGM ? (nM - fm) : WGM;
        u.pm = fm + ((wgid % nig) % gsz); u.pn = (wgid % nig) / gsz; return true;
    }
};
template <class Epi, bool I8 = false>
__device__ __forceinline__ void gemm_phase(LAS unsigned char* lds, const Gemm g, const StaticOrder& S, const Epi& E) {
    const int tid = threadIdx.x, wid = __builtin_amdgcn_readfirstlane(tid >> 6), lane = tid & 63, wr = wid >> 2, wc = wid & 3, fr = lane & 15, fq = lane >> 4;
    const int K = g.K, nt = I8 ? K / (2 * BK) : K / BK;
    unsigned voffA[2], voffB[2];
#pragma unroll
    for (int i = 0; i < 2; ++i) { int R, C; stage_rc(tid * 16 + i * 8192, R, C); const int Rb = (R & ~31) + perm32(R & 31);
        voffA[i] = (unsigned)(R * g.pa + C * 2); voffB[i] = (unsigned)(Rb * g.pb + C * 2); }
    const size_t kstep = (size_t)(BK * 2);
    const size_t hstepA = (size_t)HALF * g.pa, hstepB = (size_t)HALF * g.pb;
    const size_t tstepA = 2 * hstepA, tstepB = 2 * hstepB;
    const unsigned ldsw = (unsigned)wid * 1024u;
    const int aoff = lds_byte(wr * 64 + fr, fq * 8), boff = lds_byte(wc * 32 + fr, fq * 8);
#define PG8_SA(b, h) (((b) * 2 + (h)) * HTB)
#define PG8_SB(b, h) ((4 + (b) * 2 + (h)) * HTB)
#define PG8_STAGE(bufoff, gbase, voff) do { _Pragma("unroll") for (int _i = 0; _i < 2; ++_i) \
        __builtin_amdgcn_global_load_lds((const unsigned*)((const char*)(gbase) + (voff)[_i]), (LAS unsigned*)(lds + (bufoff) + ldsw + _i * 8192), 16, 0, 0); } while (0)
#define PG8_LDA(dst, b, h) do { _Pragma("unroll") for (int m = 0; m < 4; ++m) _Pragma("unroll") for (int k = 0; k < 2; ++k) dst[m][k] = *(const LAS bf16x8*)(lds + PG8_SA(b, h) + aoff + m * 2048 + k * 1024); } while (0)
#define PG8_LDB(dst, b, h) do { _Pragma("unroll") for (int n = 0; n < 2; ++n) _Pragma("unroll") for (int k = 0; k < 2; ++k) dst[n][k] = *(const LAS bf16x8*)(lds + PG8_SB(b, h) + boff + n * 2048 + k * 1024); } while (0)
#define PG8_MMA(ai, bj, At, Bt) do { __builtin_amdgcn_s_setprio(1); _Pragma("unroll") for (int m = 0; m < 4; ++m) _Pragma("unroll") for (int n = 0; n < 2; ++n) _Pragma("unroll") for (int k = 0; k < 2; ++k) \
        { if (I8) acc[ai][bj][m][n] = __builtin_bit_cast(f32x4, __builtin_amdgcn_mfma_i32_16x16x64_i8(__builtin_bit_cast(i32x4, Bt[n][k]), __builtin_bit_cast(i32x4, At[m][k]), __builtin_bit_cast(i32x4, acc[ai][bj][m][n]), 0, 0, 0)); \
          else acc[ai][bj][m][n] = __builtin_amdgcn_mfma_f32_16x16x32_bf16(Bt[n][k], At[m][k], acc[ai][bj][m][n], 0, 0, 0); } __builtin_amdgcn_s_setprio(0); } while (0)
#define PG8_WAIT_V(n) asm volatile("s_waitcnt vmcnt(" #n ")" ::: "memory")
#define PG8_WAIT_L(n) asm volatile("s_waitcnt lgkmcnt(" #n ")" ::: "memory")
#define PG8_BAR __builtin_amdgcn_s_barrier()
#define PG8_SCHED __builtin_amdgcn_sched_barrier(0)
    Unit cur, nxt; int ui = 0;
    if (!S.next(0, cur)) return;
    f32x4 acc[2][2][4][2];
#pragma unroll
    for (int a = 0; a < 2; ++a)
#pragma unroll
        for (int b = 0; b < 2; ++b)
#pragma unroll
            for (int m = 0; m < 4; ++m)
#pragma unroll
                for (int n = 0; n < 2; ++n) acc[a][b][m][n] = (f32x4){0.f, 0.f, 0.f, 0.f};
    bf16x8 At[4][2], B0[2][2], B1[2][2];
    const char* cA = (const char*)g.A + (size_t)cur.pm * tstepA; const char* cB = (const char*)g.Bt + (size_t)cur.pn * tstepB;
    PG8_STAGE(PG8_SB(0, 0), cB, voffB); PG8_STAGE(PG8_SA(0, 0), cA, voffA); PG8_STAGE(PG8_SB(0, 1), cB + hstepB, voffB); PG8_STAGE(PG8_SA(0, 1), cA + hstepA, voffA);
    if (wr == 1) PG8_BAR;
    PG8_WAIT_V(4); PG8_BAR;
    PG8_STAGE(PG8_SB(1, 0), cB + kstep, voffB); PG8_STAGE(PG8_SA(1, 0), cA + kstep, voffA); PG8_STAGE(PG8_SB(1, 1), cB + hstepB + kstep, voffB);
    PG8_WAIT_V(6); PG8_BAR;
    for (;;) {
        const bool has_next = S.next(ui + 1, nxt);
        const char* nA = has_next ? (const char*)g.A + (size_t)nxt.pm * tstepA : cA; const char* nB = has_next ? (const char*)g.Bt + (size_t)nxt.pn * tstepB : cB;
        for (int t = 0; t < nt; t += 2) {
            const bool last = (t == nt - 2);
            const char* a1 = cA + (size_t)(t + 1) * kstep;
            const char* a2 = last ? nA : cA + (size_t)(t + 2) * kstep; const char* b2 = last ? nB : cB + (size_t)(t + 2) * kstep;
            const char* a3 = a2 + kstep; const char* b3 = b2 + kstep;
            PG8_LDB(B0, 0, 0); PG8_SCHED; PG8_LDA(At, 0, 0); PG8_STAGE(PG8_SA(1, 1), a1 + hstepA, voffA);
            PG8_WAIT_L(8); PG8_BAR; PG8_WAIT_L(0); PG8_MMA(0, 0, At, B0); PG8_BAR; PG8_SCHED;
            PG8_LDB(B1, 0, 1); PG8_STAGE(PG8_SB(0, 0), b2, voffB);
            PG8_BAR; PG8_WAIT_L(0); PG8_MMA(0, 1, At, B1); PG8_BAR;
            PG8_LDA(At, 0, 1); PG8_STAGE(PG8_SA(0, 0), a2, voffA);
            PG8_BAR; PG8_WAIT_L(0); PG8_MMA(1, 0, At, B0); PG8_BAR; PG8_SCHED;
            PG8_STAGE(PG8_SB(0, 1), b2 + hstepB, voffB);
            PG8_WAIT_V(6); PG8_BAR; PG8_MMA(1, 1, At, B1); PG8_BAR;
            PG8_LDB(B0, 1, 0); PG8_SCHED; PG8_LDA(At, 1, 0); PG8_STAGE(PG8_SA(0, 1), a2 + hstepA, voffA);
            PG8_WAIT_L(8); PG8_BAR; PG8_WAIT_L(0); PG8_MMA(0, 0, At, B0); PG8_BAR; PG8_SCHED;
            PG8_LDB(B1, 1, 1); PG8_STAGE(PG8_SB(1, 0), b3, voffB);
            PG8_BAR; PG8_WAIT_L(0); PG8_MMA(0, 1, At, B1); PG8_BAR;
            PG8_LDA(At, 1, 1); PG8_STAGE(PG8_SA(1, 0), a3, voffA);
            PG8_BAR; PG8_WAIT_L(0); PG8_MMA(1, 0, At, B0); PG8_BAR; PG8_SCHED;
            PG8_STAGE(PG8_SB(1, 1), b3 + hstepB, voffB);
            PG8_WAIT_V(6); PG8_BAR; PG8_MMA(1, 1, At, B1); PG8_BAR;
        }
        E(acc, cur, wr, wc, fr, fq);
        if (!has_next) break;
#pragma unroll
        for (int a = 0; a < 2; ++a)
#pragma unroll
            for (int b = 0; b < 2; ++b)
#pragma unroll
                for (int m = 0; m < 4; ++m)
#pragma unroll
                    for (int n = 0; n < 2; ++n) acc[a][b][m][n] = (f32x4){0.f, 0.f, 0.f, 0.f};
        cur = nxt; cA = nA; cB = nB; ++ui;
    }
    PG8_WAIT_V(0);
    if (wr == 0) PG8_BAR;
    PG8_BAR;
#undef PG8_SA
#undef PG8_SB
#undef PG8_STAGE
#undef PG8_LDA
#undef PG8_LDB
#undef PG8_MMA
#undef PG8_WAIT_V
#undef PG8_WAIT_L
#undef PG8_BAR
#undef PG8_SCHED
}

struct EpiProj {
    bf16_t* qkv; bf16_t* sg; float qscale; unsigned* kmaxw; const float* hsc; const float* wsc;
    __device__ __forceinline__ void operator()(const f32x4 (&acci)[2][2][4][2], const Unit& u, int wr, int wc, int fr, int fq) const {
        const int row0 = u.pm * BM + wr * 64 + fr;
        f32x4 acc[2][2][4][2];
        { f32x4 cs[2][2];
#pragma unroll
          for (int bj = 0; bj < 2; ++bj)
#pragma unroll
              for (int n = 0; n < 2; ++n) cs[bj][n] = *(const f32x4*)(wsc + u.pn * BM + bj * HALF + wc * 32 + 8 * fq + 4 * n);
#pragma unroll
          for (int ai = 0; ai < 2; ++ai)
#pragma unroll
              for (int m = 0; m < 4; ++m) { const float rsc = hsc[row0 + ai * HALF + m * 16];
#pragma unroll
                  for (int bj = 0; bj < 2; ++bj)
#pragma unroll
                      for (int n = 0; n < 2; ++n) { const i32x4 iv = __builtin_bit_cast(i32x4, acci[ai][bj][m][n]);
                          acc[ai][bj][m][n] = (f32x4){(float)iv[0], (float)iv[1], (float)iv[2], (float)iv[3]} * rsc * cs[bj][n]; } } }
        if (u.pn < 24) {
            const int t = u.pn >> 2; bf16_t* base = qkv + (size_t)t * ((size_t)T_TOK * 1024) + (u.pn & 3) * 256 + wc * 32 + 8 * fq;
            const float sc = (t == 0 || t == 3) ? qscale : 1.f;
            if (t == 4) {
#pragma unroll
                for (int bj = 0; bj < 2; ++bj) { float mxv = 0.f;
#pragma unroll
                    for (int ai = 0; ai < 2; ++ai)
#pragma unroll
                        for (int m = 0; m < 4; ++m) { const f32x4 v0 = acc[ai][bj][m][0], v1 = acc[ai][bj][m][1];
                            float ssq = (v0[0] * v0[0] + v0[1] * v0[1]) + (v0[2] * v0[2] + v0[3] * v0[3]) + (v1[0] * v1[0] + v1[1] * v1[1]) + (v1[2] * v1[2] + v1[3] * v1[3]);
                            ssq += __shfl_xor(ssq, 16); ssq += __shfl_xor(ssq, 32); mxv = fmaxf(mxv, ssq); }
#pragma unroll
                    for (int o = 1; o < 16; o <<= 1) mxv = fmaxf(mxv, __shfl_xor(mxv, o));
                    if ((fr | fq) == 0) atomicMax(kmaxw + ((u.pm >> 4) * 8 + (u.pn & 3) * 2 + bj) * 4 + wc, __builtin_bit_cast(unsigned, mxv)); }
            }
#pragma unroll
            for (int ai = 0; ai < 2; ++ai)
#pragma unroll
                for (int m = 0; m < 4; ++m) { bf16_t* rowp = base + (size_t)(row0 + ai * HALF + m * 16) * 1024;
#pragma unroll
                    for (int bj = 0; bj < 2; ++bj) { const f32x4 v0 = acc[ai][bj][m][0] * sc, v1 = acc[ai][bj][m][1] * sc;
                        u32x4 w; w.x = pk2(v0[0], v0[1]); w.y = pk2(v0[2], v0[3]); w.z = pk2(v1[0], v1[1]); w.w = pk2(v1[2], v1[3]);
                        *(u32x4*)(rowp + bj * HALF) = w; } }
        } else {
            bf16_t* base = sg + (u.pn - 24) * 256 + wc * 32 + 8 * fq;
#pragma unroll
            for (int ai = 0; ai < 2; ++ai)
#pragma unroll
                for (int m = 0; m < 4; ++m) { bf16_t* rowp = base + (size_t)(row0 + ai * HALF + m * 16) * 4096;
#pragma unroll
                    for (int bj = 0; bj < 2; ++bj) { float s[8];
#pragma unroll
                        for (int e = 0; e < 4; ++e) { s[e] = frcp(1.f + fexp2(-LOG2E * acc[ai][bj][m][0][e])); s[4 + e] = frcp(1.f + fexp2(-LOG2E * acc[ai][bj][m][1][e])); }
                        u32x4 w; w.x = pk2(s[0], s[1]); w.y = pk2(s[2], s[3]); w.z = pk2(s[4], s[5]); w.w = pk2(s[6], s[7]);
                        *(u32x4*)(rowp + bj * HALF) = w; } }
        }
    }
};
template <int SECOND> struct EpiGate {
    const bf16_t* sg;
    float* tmp; bf16_t* merged;
    __device__ __forceinline__ void operator()(const f32x4 (&acc)[2][2][4][2], const Unit& u, int wr, int wc, int fr, int fq) const {
        const int row0 = u.pm * BM + wr * 64 + fr, col0 = u.pn * BM + wc * 32 + 8 * fq;
#pragma unroll
        for (int ai = 0; ai < 2; ++ai)
#pragma unroll
            for (int m = 0; m < 4; ++m) { const size_t row = (size_t)(row0 + ai * HALF + m * 16);
#pragma unroll
                for (int bj = 0; bj < 2; ++bj) { const int col = col0 + bj * HALF;
                    const u32x4 gv = *(const u32x4*)(sg + row * 4096 + col);
                    const f32x4 g0 = {bf_lo(gv.x), bf_hi(gv.x), bf_lo(gv.y), bf_hi(gv.y)}, g1 = {bf_lo(gv.z), bf_hi(gv.z), bf_lo(gv.w), bf_hi(gv.w)};
                    f32x4 v0 = acc[ai][bj][m][0] * g0, v1 = acc[ai][bj][m][1] * g1;
                    float* tp = tmp + row * DM + col;
                    if (SECOND == 0) { *(f32x4*)tp = v0; *(f32x4*)(tp + 4) = v1; }
                    else { v0 += *(const f32x4*)tp; v1 += *(const f32x4*)(tp + 4);
                        u32x4 w; w.x = pk2(v0[0], v0[1]); w.y = pk2(v0[2], v0[3]); w.z = pk2(v1[0], v1[1]); w.w = pk2(v1[2], v1[3]);
                        *(u32x4*)(merged + row * DM + col) = w; } } }
    }
};
struct EpiResid {
    const float* x; float* x1; bf16_t* x1b; float* rowss;
    __device__ __forceinline__ void operator()(const f32x4 (&acc)[2][2][4][2], const Unit& u, int wr, int wc, int fr, int fq) const {
        const int row0 = u.pm * BM + wr * 64 + fr, col0 = u.pn * BM + wc * 32 + 8 * fq;
#pragma unroll
        for (int ai = 0; ai < 2; ++ai)
#pragma unroll
            for (int m = 0; m < 4; ++m) { const size_t row = (size_t)(row0 + ai * HALF + m * 16); float ss = 0.f;
#pragma unroll
                for (int bj = 0; bj < 2; ++bj) { const size_t o = row * DM + col0 + bj * HALF;
                    const f32x4 v0 = (DBG == 2 ? 0.f : 1.f) * acc[ai][bj][m][0] + *(const f32x4*)(x + o), v1 = (DBG == 2 ? 0.f : 1.f) * acc[ai][bj][m][1] + *(const f32x4*)(x + o + 4);
                    *(f32x4*)(x1 + o) = v0; *(f32x4*)(x1 + o + 4) = v1;
                    u32x4 w; w.x = pk2(v0[0], v0[1]); w.y = pk2(v0[2], v0[3]); w.z = pk2(v1[0], v1[1]); w.w = pk2(v1[2], v1[3]);
                    *(u32x4*)(x1b + o) = w;
                    ss += (v0[0] * v0[0] + v0[1] * v0[1]) + (v0[2] * v0[2] + v0[3] * v0[3]) + (v1[0] * v1[0] + v1[1] * v1[1]) + (v1[2] * v1[2] + v1[3] * v1[3]); }
                ss += __shfl_xor(ss, 16); ss += __shfl_xor(ss, 32);
                if (fq == 0) atomicAdd(rowss + row, ss); }
    }
};
struct EpiPlainBf16 {
    bf16_t* o;
    __device__ __forceinline__ void operator()(const f32x4 (&acc)[2][2][4][2], const Unit& u, int wr, int wc, int fr, int fq) const {
        const int row0 = u.pm * BM + wr * 64 + fr, col0 = u.pn * BM + wc * 32 + 8 * fq;
#pragma unroll
        for (int ai = 0; ai < 2; ++ai)
#pragma unroll
            for (int m = 0; m < 4; ++m) { const size_t row = (size_t)(row0 + ai * HALF + m * 16);
#pragma unroll
                for (int bj = 0; bj < 2; ++bj) { const f32x4 v0 = acc[ai][bj][m][0], v1 = acc[ai][bj][m][1];
                    u32x4 w; w.x = pk2(v0[0], v0[1]); w.y = pk2(v0[2], v0[3]); w.z = pk2(v1[0], v1[1]); w.w = pk2(v1[2], v1[3]);
                    *(u32x4*)(o + row * DM + col0 + bj * HALF) = w; } }
    }
};
}

__device__ __forceinline__ void transpose_item(const float* W, int ldw, int src_n0, bf16_t* WT, int K, int dst_n0, int k0, LAS float* scr, int lane, const float* kscale) {
#pragma unroll 8
    for (int i = 0; i < 32; ++i) { const int kk = 2 * i + (lane >> 5); float v = W[(size_t)(k0 + kk) * ldw + src_n0 + (lane & 31)]; if (kscale) v *= kscale[k0 + kk]; scr[kk * 33 + (lane & 31)] = v; }
    LDS_WAIT();
    const int c = lane & 7;
#pragma unroll
    for (int j = 0; j < 4; ++j) { const int n = (lane >> 3) + 8 * j; const LAS float* s = scr + (8 * c) * 33 + n;
        u32x4 o; o.x = pk2(s[0 * 33], s[1 * 33]); o.y = pk2(s[2 * 33], s[3 * 33]); o.z = pk2(s[4 * 33], s[5 * 33]); o.w = pk2(s[6 * 33], s[7 * 33]);
        *(u32x4*)(WT + (size_t)(dst_n0 + n) * K + k0 + 8 * c) = o; }
    LDS_WAIT();
}

__device__ __forceinline__ void p0a(const Params& P, LAS unsigned char* lds, int vcu, int G) {
    const int tid = threadIdx.x, lane = tid & 63, wave = __builtin_amdgcn_readfirstlane(tid >> 6);
    const int gw = vcu * NWAVES + wave, NGW = G * NWAVES;
    unsigned char* ws = P.ws;
    {
        unsigned* CMAX = (unsigned*)(ws + WS_CTL + CTL_CMAX);
        constexpr int NCB = (10248 + 255) / 256;
        for (int it = gw; it < 128 * NCB; it += NGW) { const int kb = it / NCB, cb = it % NCB, sc = cb * 256 + 4 * lane;
            if (sc < 10248) { f32x4 v[16];
#pragma unroll
                for (int r = 0; r < 16; ++r) v[r] = *(const f32x4*)(P.w_in + (size_t)(kb * 16 + r) * 10248 + sc);
                float m0 = 0.f, m1 = 0.f, m2 = 0.f, m3 = 0.f;
#pragma unroll
                for (int r = 0; r < 16; ++r) { m0 = fmaxf(m0, fabsf(v[r][0])); m1 = fmaxf(m1, fabsf(v[r][1])); m2 = fmaxf(m2, fabsf(v[r][2])); m3 = fmaxf(m3, fabsf(v[r][3])); }
                const float mm[4] = {m0, m1, m2, m3};
#pragma unroll
                for (int e = 0; e < 4; ++e) { const int c = sc + e; const unsigned mb = __float_as_uint(mm[e]);
                    if (c < 6144) atomicMax(CMAX + c, mb); else if (c >= 6152) atomicMax(CMAX + c - 8, mb); } } }
    }
    {
        LAS float* wf = (LAS float*)lds;
        for (int idx = tid; idx < 2048 * 8; idx += NTHR) { const int k = idx >> 3, c = idx & 7; wf[c * 2048 + k] = P.w_in[(size_t)k * 10248 + 6144 + c]; }
        __syncthreads();
        unsigned char* HQ8 = ws + WS_H; float* HSC = (float*)(ws + WS_HSC); float* LOGF = (float*)(ws + WS_LOGF);
        for (int r = gw; r < T_TOK; r += NGW) {
            const f32x4* xr = (const f32x4*)(P.x + (size_t)r * DM) + lane;
            float ss = 0.f, amx = 0.f; f32x4 hv[8];
#pragma unroll
            for (int j = 0; j < 8; ++j) { const f32x4 v = xr[64 * j]; const f32x4 gn = *((const f32x4*)P.g_mix + lane + 64 * j); ss += (v[0] * v[0] + v[1] * v[1]) + (v[2] * v[2] + v[3] * v[3]);
                hv[j] = v * gn; amx = fmaxf(amx, fmaxf(fmaxf(fabsf(hv[j][0]), fabsf(hv[j][1])), fmaxf(fabsf(hv[j][2]), fabsf(hv[j][3])))); }
            const float rstd = 1.0f / sqrtf(wave_sum(ss) * (1.f / DM) + EPS);
#pragma unroll
            for (int o = 1; o < 64; o <<= 1) amx = fmaxf(amx, __shfl_xor(amx, o));
            const float hmax = fmaxf(amx * rstd, 1e-30f), hinv = 127.f / hmax;
            float fl[8];
#pragma unroll
            for (int c = 0; c < 8; ++c) fl[c] = 0.f;
            unsigned* hp = (unsigned*)(HQ8 + (size_t)r * DM) + lane;
#pragma unroll
            for (int j = 0; j < 8; ++j) { const f32x4 h = hv[j] * rstd;
                unsigned w = 0;
#pragma unroll
                for (int e = 0; e < 4; ++e) w |= ((unsigned)(int)__builtin_rintf(h[e] * hinv) & 255u) << (8 * e);
                hp[64 * j] = w;
#pragma unroll
                for (int c = 0; c < 8; ++c) { const f32x4 wv = *((const LAS f32x4*)(wf + c * 2048) + lane + 64 * j); fl[c] += (h[0] * wv[0] + h[1] * wv[1]) + (h[2] * wv[2] + h[3] * wv[3]); }
                __builtin_amdgcn_sched_barrier(0); }
#pragma unroll
            for (int c = 0; c < 8; ++c) fl[c] = wave_sum(fl[c]);
            if (lane == 0) { HSC[r] = hmax * (1.f / 127.f);
#pragma unroll
                for (int c = 0; c < 8; ++c) { const float y = fl[c] + P.b_forget[c]; LOGF[(size_t)r * 8 + c] = fminf(y, 0.f) - log1pf(expf(-fabsf(y))); }
            }
        }
    }
    {
        const size_t gid = (size_t)vcu * NTHR + tid, gstride = (size_t)G * NTHR;
        for (size_t i = gid; i < 262144 / 8; i += gstride) { const float* src = P.sub_keys + i * 8; const f32x4 a = *(const f32x4*)src, b = *((const f32x4*)src + 1);
            u32x4 o; o.x = pk2(a[0], a[1]); o.y = pk2(a[2], a[3]); o.z = pk2(b[0], b[1]); o.w = pk2(b[2], b[3]); *(u32x4*)((bf16_t*)(ws + WS_SKB) + i * 8) = o; }
    }
}
__device__ __forceinline__ void p0b(const Params& P, LAS unsigned char* lds, int vcu, int G) {
    const int tid = threadIdx.x, lane = tid & 63, wave = __builtin_amdgcn_readfirstlane(tid >> 6);
    const int gw = vcu * NWAVES + wave, NGW = G * NWAVES;
    unsigned char* ws = P.ws;
    const unsigned* CMAX = (const unsigned*)(ws + WS_CTL + CTL_CMAX); float* WSC = (float*)(ws + WS_WSC); unsigned char* WT8 = ws + WS_WIN;
    LAS float* scr = (LAS float*)(lds + wave * 16384);
    for (int it = gw; it < 32 * 320; it += NGW) {
        const int nb = it >> 5, kb = it & 31, dn = nb * 32, sn = dn < 6144 ? dn : dn + 8, k0 = kb * 64;
        const int c4 = (lane & 7) * 4;
        float inv[4];
#pragma unroll
        for (int e = 0; e < 4; ++e) { const float cm = fmaxf(__uint_as_float(__hip_atomic_load(CMAX + dn + c4 + e, __ATOMIC_RELAXED, __HIP_MEMORY_SCOPE_AGENT)), 1e-30f); inv[e] = 127.f / cm;
            if (kb == 0 && lane < 8) WSC[dn + c4 + e] = cm * (1.f / 127.f); }
        f32x4 v[8];
#pragma unroll
        for (int i = 0; i < 8; ++i) v[i] = *(const f32x4*)(P.w_in + (size_t)(k0 + 8 * i + (lane >> 3)) * 10248 + sn + c4);
#pragma unroll
        for (int i = 0; i < 8; ++i) { LAS float* sp = scr + (8 * i + (lane >> 3)) * 33 + c4; sp[0] = v[i][0] * inv[0]; sp[1] = v[i][1] * inv[1]; sp[2] = v[i][2] * inv[2]; sp[3] = v[i][3] * inv[3]; }
        LDS_WAIT();
        const int c = lane & 3;
#pragma unroll
        for (int j = 0; j < 2; ++j) { const int n = (lane >> 2) + 16 * j; const LAS float* sp = scr + (16 * c) * 33 + n;
            u32x4 o;
#pragma unroll
            for (int w4 = 0; w4 < 4; ++w4) { unsigned w = 0;
#pragma unroll
                for (int e = 0; e < 4; ++e) w |= ((unsigned)(int)fminf(fmaxf(__builtin_rintf(sp[(4 * w4 + e) * 33]), -127.f), 127.f) & 255u) << (8 * e);
                o[w4] = w; }
            *(u32x4*)(WT8 + (size_t)(dn + n) * 2048 + k0 + 16 * c) = o; }
        LDS_WAIT();
    }
}
__device__ __forceinline__ void late_transposes(const Params& P, LAS unsigned char* lds, int vcu, int G) {
    const int tid = threadIdx.x, lane = tid & 63, wave = __builtin_amdgcn_readfirstlane(tid >> 6);
    const int gw = vcu * NWAVES + wave, NGW = G * NWAVES;
    unsigned char* ws = P.ws;
    LAS float* scr = (LAS float*)(lds + wave * 16384);
    constexpr int I_A = 16 * 64, I_O = 32 * 64, NITEMS = 2 * I_A + 2 * I_O;
    for (int it = gw; it < NITEMS; it += NGW) {
        int r = it;
        if (r < I_A) { const int kb = r / 64, nb = r % 64; transpose_item(P.w_a, 2048, nb * 32, (bf16_t*)(ws + WS_WAT), 1024, nb * 32, kb * 64, scr, lane, nullptr); continue; } r -= I_A;
        if (r < I_A) { const int kb = r / 64, nb = r % 64; transpose_item(P.w_b, 2048, nb * 32, (bf16_t*)(ws + WS_WBT), 1024, nb * 32, kb * 64, scr, lane, nullptr); continue; } r -= I_A;
        if (r < I_O) { const int kb = r / 64, nb = r % 64; transpose_item(P.w_out, 2048, nb * 32, (bf16_t*)(ws + WS_WOUT), 2048, nb * 32, kb * 64, scr, lane, nullptr); continue; } r -= I_O;
        { const int kb = r / 64, nb = r % 64; transpose_item(P.w_query, 2048, nb * 32, (bf16_t*)(ws + WS_WQ), 2048, nb * 32, kb * 64, scr, lane, P.g_ffn); }
    }
}
__device__ __forceinline__ void quantise_expert_rows(const Params& P, int r0, int nrows) {
    const int lane = threadIdx.x & 63;
    unsigned char* ws = P.ws;
    float* SU = (float*)(ws + WS_SU); float* SV = (float*)(ws + WS_SV);
    for (int r = r0; r < r0 + nrows; ++r) {
        const bool second = r >= 16384; const int row = second ? r - 16384 : r;
        const f32x4* src = (const f32x4*)((second ? P.e_v : P.e_u) + (size_t)row * DM) + lane;
        f32x4 v[8]; float mx = 0.f;
#pragma unroll
        for (int j = 0; j < 8; ++j) { v[j] = __builtin_nontemporal_load(src + 64 * j); mx = fmaxf(mx, fmaxf(fmaxf(fabsf(v[j][0]), fabsf(v[j][1])), fmaxf(fabsf(v[j][2]), fabsf(v[j][3])))); }
#pragma unroll
        for (int o = 1; o < 64; o <<= 1) mx = fmaxf(mx, __shfl_xor(mx, o));
        mx = fmaxf(mx, 1e-30f);
        const float inv = 127.f / mx; const int bias = second ? 128 : 0;
        unsigned* dst = (unsigned*)(ws + (second ? WS_EV : WS_EU) + (size_t)row * DM) + lane;
#pragma unroll
        for (int j = 0; j < 8; ++j) { unsigned w = 0;
#pragma unroll
            for (int e = 0; e < 4; ++e) { const int q = (int)__builtin_rintf(v[j][e] * inv) + bias; w |= ((unsigned)q & 255u) << (8 * e); }
            dst[64 * j] = w; }
        if (lane == 0) (second ? SV : SU)[row] = mx * (1.f / 127.f);
    }
}

namespace att {
constexpr int KST = 272, VST = 320;
constexpr int KBUF = 64 * KST, VBUF = 64 * VST;
constexpr int OFF_K = 0, OFF_V = 2 * KBUF, OFF_F = OFF_V + 2 * VBUF, OFF_SC = OFF_F + 4096 * 4;
constexpr int OFF_FLG = OFF_SC + 64, OFF_UNIT = OFF_FLG + 64;
static_assert(OFF_UNIT + 16 <= 131072, "attention LDS");
constexpr float THR_SB = 40.f, THR_FOX = 30.f;

__device__ __forceinline__ void build_cumf(LAS unsigned char* lds, const float* LOGF, int b, int h, int n, int tid, int lane, int wid) {
    LAS float* F2 = (LAS float*)(lds + OFF_F); LAS float* sc = (LAS float*)(lds + OFF_SC);
    const int s0 = tid * 8; float v[8];
#pragma unroll
    for (int i = 0; i < 8; ++i) v[i] = (s0 < n) ? LOGF[((size_t)b * SEQ + s0 + i) * 8 + h] * LOG2E : 0.f;
#pragma unroll
    for (int i = 1; i < 8; ++i) v[i] += v[i - 1];
    float tot = v[7], inc = tot;
#pragma unroll
    for (int o = 1; o < 64; o <<= 1) { const float t = __shfl_up(inc, o); if (lane >= o) inc += t; }
    if (lane == 63) sc[wid] = inc;
    __syncthreads();
    float base = inc - tot;
#pragma unroll
    for (int w = 0; w < 8; ++w) if (w < wid) base += sc[w];
    if (s0 < n) {
#pragma unroll
        for (int i = 0; i < 8; ++i) F2[s0 + i] = v[i] + base;
    }
    __syncthreads();
}

template <int MIXER>
__device__ __forceinline__ void attn_unit(LAS unsigned char* lds, const bf16_t* Q, const bf16_t* Kg, const bf16_t* Vg, bf16_t* O, int b, int h, int qb, float kmax, int tid, int lane, int wid) {
    const int c = lane & 31, hh = lane >> 5;
    const int t0 = qb * 256 + wid * 32, tq = t0 + c;
    const size_t rowbase = (size_t)b * SEQ;
    size_t qoff = (rowbase + tq) * 1024 + h * HD + 8 * hh;
    f32x16 oacc[4];
#pragma unroll
    for (int d = 0; d < 4; ++d)
#pragma unroll
        for (int r = 0; r < 16; ++r) oacc[d][r] = 0.f;
    float carry = 0.f, mrun = -1e30f, lsum = 0.f; const float nhf = hh ? 0.f : 1.f;
    const LAS float* F2 = (const LAS float*)(lds + OFF_F);
    const float Ft = (MIXER == 1) ? F2[tq] : 0.f;
    float qk_bound = 0.f;
    if (MIXER == 1) { float qs = 0.f;
#pragma unroll
        for (int s2 = 0; s2 < 8; ++s2) { const u32x4 qv = *(const u32x4*)(Q + qoff + 16 * s2);
#pragma unroll
            for (int e = 0; e < 4; ++e) { const float a = bf_lo(qv[e]), b2 = bf_hi(qv[e]); qs += a * a + b2 * b2; } }
        qs += __shfl_xor(qs, 32);
        qk_bound = sqrtf(qs) * kmax; }
    bool wave_done = false;
    volatile LAS unsigned* flg = (volatile LAS unsigned*)(lds + OFF_FLG);
    const int ktmax = 4 * qb + 3;
    const int srow = tid >> 4, scc = tid & 15;
    u32x4 kr[2], vr[2];
#define ATT_LOAD(kt) do { _Pragma("unroll") for (int j = 0; j < 2; ++j) { const size_t g_ = (rowbase + 64 * (kt) + srow + 32 * j) * 1024 + h * HD + scc * 8; \
        kr[j] = *(const u32x4*)(Kg + g_); vr[j] = *(const u32x4*)(Vg + g_); } } while (0)
#define ATT_WRITE(buf) do { _Pragma("unroll") for (int j = 0; j < 2; ++j) { \
        *(LAS u32x4*)(lds + OFF_K + (buf) * KBUF + (srow + 32 * j) * KST + scc * 16) = kr[j]; \
        *(LAS u32x4*)(lds + OFF_V + (buf) * VBUF + (srow + 32 * j) * VST + scc * 16) = vr[j]; } } while (0)
    ATT_LOAD(ktmax); ATT_WRITE(0); __syncthreads();
    int buf = 0;
    for (int kt = ktmax; kt >= 0; --kt) {
        if (kt > 0) ATT_LOAD(kt - 1);
        const bool started = (64 * kt <= t0 + 31);
        if (started && !wave_done) {
            const LAS unsigned char* Kl = lds + OFF_K + buf * KBUF; const LAS unsigned char* Vl = lds + OFF_V + buf * VBUF;
            f32x16 sacc[2];
            asm volatile("" : "+v"(qoff));
            bf16x8 qf[8];
#pragma unroll
            for (int s = 0; s < 8; ++s) qf[s] = *(const bf16x8*)(Q + qoff + 16 * s);
#pragma unroll
            for (int sub = 0; sub < 2; ++sub) {
#pragma unroll
                for (int r = 0; r < 16; ++r) sacc[sub][r] = 0.f;
#pragma unroll
                for (int s = 0; s < 8; ++s) { const bf16x8 kf = *(const LAS bf16x8*)(Kl + (32 * sub + c) * KST + (16 * s + 8 * hh) * 2);
                    sacc[sub] = __builtin_amdgcn_mfma_f32_32x32x16_bf16(kf, qf[s], sacc[sub], 0, 0, 0); }
            }
            const bool need_mask = (64 * kt + 63 >= t0);
            if (MIXER == 0) {
#pragma unroll
                for (int sub = 1; sub >= 0; --sub) {
                    float lb[16];
#pragma unroll
                    for (int r = 0; r < 16; ++r) { const float z = sacc[sub][r]; float l = -flog2(1.f + fexp2(z));
                        if (need_mask) { const int sidx = 64 * kt + 32 * sub + (r & 3) + 8 * (r >> 2) + 4 * hh; l = (sidx < tq) ? l : 0.f; }
                        lb[r] = l; }
                    float Glo[4], Ghi[4];
#pragma unroll
                    for (int g = 0; g < 4; ++g) { lb[4 * g + 2] += lb[4 * g + 3]; lb[4 * g + 1] += lb[4 * g + 2]; lb[4 * g] += lb[4 * g + 1];
                        const unsigned gu = __builtin_bit_cast(unsigned, lb[4 * g]); const auto rr = __builtin_amdgcn_permlane32_swap(gu, gu, false, false);
                        Glo[g] = __builtin_bit_cast(float, (unsigned)rr[0]); Ghi[g] = __builtin_bit_cast(float, (unsigned)rr[1]); }
                    float E[8];
                    E[7] = carry; E[6] = E[7] + Ghi[3]; E[5] = E[6] + Glo[3]; E[4] = E[5] + Ghi[2]; E[3] = E[4] + Glo[2]; E[2] = E[3] + Ghi[1]; E[1] = E[2] + Glo[1]; E[0] = E[1] + Ghi[0];
                    carry = E[0] + Glo[0];
#pragma unroll
                    for (int g = 0; g < 4; ++g) { const float Eo = __builtin_fmaf(nhf, Ghi[g], E[2 * g + 1]);
#pragma unroll
                        for (int i = 0; i < 4; ++i) { const int r = 4 * g + i; float w = fexp2(sacc[sub][r] + lb[r] + Eo);
                            if (need_mask) { const int sidx = 64 * kt + 32 * sub + (r & 3) + 8 * (r >> 2) + 4 * hh; w = (sidx < tq) ? w : 0.f; }
                            sacc[sub][r] = w; } }
                }
            } else {
                float mx = -1e30f;
#pragma unroll
                for (int sub = 0; sub < 2; ++sub)
#pragma unroll
                    for (int g = 0; g < 4; ++g) { const f32x4 fs = *(const LAS f32x4*)(F2 + 64 * kt + 32 * sub + 8 * g + 4 * hh);
#pragma unroll
                        for (int i = 0; i < 4; ++i) { const int r = 4 * g + i; float xv = sacc[sub][r] + (Ft - fs[i]);
                            if (need_mask) { const int sidx = 64 * kt + 32 * sub + 8 * g + 4 * hh + i; xv = (sidx <= tq) ? xv : -1e30f; }
                            sacc[sub][r] = xv; mx = fmaxf(mx, xv); } }
                { const unsigned mu = __builtin_bit_cast(unsigned, mx); const auto rr = __builtin_amdgcn_permlane32_swap(mu, mu, false, false);
                  mx = fmaxf(__builtin_bit_cast(float, (unsigned)rr[0]), __builtin_bit_cast(float, (unsigned)rr[1])); }
                const float mnew = fmaxf(mrun, mx);
                const float alpha = fexp2(mrun - mnew);
                float ps = 0.f;
#pragma unroll
                for (int sub = 0; sub < 2; ++sub)
#pragma unroll
                    for (int r = 0; r < 16; ++r) { const float p = fexp2(sacc[sub][r] - mnew); sacc[sub][r] = p; ps += p; }
                lsum = lsum * alpha + ps;
                if (__any(mnew > mrun)) {
#pragma unroll
                    for (int d = 0; d < 4; ++d)
#pragma unroll
                        for (int r = 0; r < 16; ++r) oacc[d][r] *= alpha;
                }
                mrun = mnew;
            }
#pragma unroll
            for (int ks = 0; ks < 4; ++ks) { const int sub = ks >> 1, rb = 8 * (ks & 1);
                u32x4 pw; pw.x = pk2(sacc[sub][rb + 0], sacc[sub][rb + 1]); pw.y = pk2(sacc[sub][rb + 2], sacc[sub][rb + 3]); pw.z = pk2(sacc[sub][rb + 4], sacc[sub][rb + 5]); pw.w = pk2(sacc[sub][rb + 6], sacc[sub][rb + 7]);
                const bf16x8 pf = __builtin_bit_cast(bf16x8, pw);
                const LAS unsigned char* vb = Vl + (16 * ks + 4 * hh + ((lane & 15) >> 2)) * VST + (16 * ((lane >> 4) & 1) + 4 * (lane & 3)) * 2;
#pragma unroll
                for (int d = 0; d < 4; ++d) {
                    const s16x4 a0 = __builtin_amdgcn_ds_read_tr16_b64_v4i16((LAS s16x4*)(vb + d * 64));
                    const s16x4 a1 = __builtin_amdgcn_ds_read_tr16_b64_v4i16((LAS s16x4*)(vb + d * 64 + 8 * VST));
                    const bf16x8 af = {a0[0], a0[1], a0[2], a0[3], a1[0], a1[1], a1[2], a1[3]};
                    oacc[d] = __builtin_amdgcn_mfma_f32_32x32x16_bf16(af, pf, oacc[d], 0, 0, 0); }
            }
        }
        if (kt > 0) ATT_WRITE(buf ^ 1);
        if (kt > 0 && started && !wave_done) {
            if (MIXER == 0) wave_done = __all(carry < -THR_SB);
            else wave_done = __all(qk_bound + (Ft - F2[64 * kt - 1]) - mrun < -THR_FOX);
        }
        if (lane == 0) flg[(kt & 1) * 8 + wid] = wave_done ? 1u : 0u;
        __syncthreads();
        buf ^= 1;
        { unsigned alld = 1u;
#pragma unroll
          for (int w = 0; w < 8; ++w) alld &= flg[(kt & 1) * 8 + w];
          if (alld) break; }
    }
#undef ATT_LOAD
#undef ATT_WRITE
    float inv = 1.f;
    if (MIXER == 1) { const unsigned lu = __builtin_bit_cast(unsigned, lsum); const auto rr = __builtin_amdgcn_permlane32_swap(lu, lu, false, false);
        inv = 1.f / (__builtin_bit_cast(float, (unsigned)rr[0]) + __builtin_bit_cast(float, (unsigned)rr[1])); }
    bf16_t* op = O + (rowbase + tq) * 2048 + 4 * hh;
#pragma unroll
    for (int d = 0; d < 4; ++d)
#pragma unroll
        for (int g = 0; g < 4; ++g) { u32x2 w; w.x = pk2(oacc[d][4 * g] * inv, oacc[d][4 * g + 1] * inv); w.y = pk2(oacc[d][4 * g + 2] * inv, oacc[d][4 * g + 3] * inv);
            *(u32x2*)(op + 32 * d + 8 * g) = w; }
}

__device__ __forceinline__ void attn_phase(const Params& P, LAS unsigned char* lds, int vcu, int G) {
    const int tid = threadIdx.x, lane = tid & 63, wid = __builtin_amdgcn_readfirstlane(tid >> 6);
    unsigned char* ws = P.ws;
    const bf16_t* QKV = (const bf16_t*)(ws + WS_QKV); const size_t TS = (size_t)T_TOK * 1024;
    bf16_t* OAB = (bf16_t*)(ws + WS_H); const float* LOGF = (const float*)(ws + WS_LOGF);
    unsigned* qctr = (unsigned*)(ws + WS_CTL + 196608);
    const unsigned* KMAXW = (const unsigned*)(ws + WS_CTL + 200704);
    volatile LAS unsigned* uw = (volatile LAS unsigned*)(lds + OFF_UNIT);
    for (;;) {
        if (tid == 0) uw[0] = atomicAdd(qctr, 1u);
        __syncthreads();
        const unsigned u = uw[0];
        __syncthreads();
        if (u >= 1024u) break;
        if (u >= 512u) { quantise_expert_rows(P, (int)(u - 512u) * 64 + wid * 8, 8); continue; }
        const int mixer = (u < 256u) ? 1 : 0, v = (int)(u & 255u), qb = 15 - (v >> 4), bh = v & 15, b = bh >> 3, h = bh & 7;
        if (mixer == 0) {
            attn_unit<0>(lds, QKV, QKV + TS, QKV + 2 * TS, OAB + h * HD, b, h, qb, 0.f, tid, lane, wid);
        } else {
            float k2 = 0.f;
#pragma unroll
            for (int w = 0; w < 4; ++w) k2 += __builtin_bit_cast(float, __hip_atomic_load(KMAXW + bh * 4 + w, __ATOMIC_RELAXED, __HIP_MEMORY_SCOPE_AGENT));
            const float kmax = sqrtf(k2) * 1.01f;
            build_cumf(lds, LOGF, b, h, 256 * (qb + 1), tid, lane, wid);
            attn_unit<1>(lds, QKV + 3 * TS, QKV + 4 * TS, QKV + 5 * TS, OAB + 1024 + h * HD, b, h, qb, kmax, tid, lane, wid);
        }
        __syncthreads();
    }
}
}

namespace peer {
__device__ __forceinline__ unsigned sortable(float f) { const unsigned u = __builtin_bit_cast(unsigned, f); return (u & 0x80000000u) ? ~u : (u | 0x80000000u); }
__device__ __forceinline__ float unsortable(unsigned k) { const unsigned u = (k & 0x80000000u) ? (k & 0x7fffffffu) : ~k; return __builtin_bit_cast(float, u); }
template <int N> __device__ __forceinline__ unsigned umax_all(const unsigned (&k)[N]) {
    unsigned m = k[0];
#pragma unroll
    for (int q = 1; q < N; ++q) m = m > k[q] ? m : k[q];
    return m;
}

#define CE_DESC(x, y) do { const unsigned hi_ = (x) > (y) ? (x) : (y); const unsigned lo_ = (x) > (y) ? (y) : (x); (x) = hi_; (y) = lo_; } while (0)
template <int B, int N> __device__ __forceinline__ void sort16_desc(unsigned (&a)[N]) {
#pragma unroll
    for (int k = 2; k <= 16; k <<= 1)
#pragma unroll
        for (int j = k >> 1; j > 0; j >>= 1)
#pragma unroll
            for (int i = 0; i < 16; ++i) { const int l = i ^ j; if (l > i) { if ((i & k) == 0) CE_DESC(a[B + i], a[B + l]); else CE_DESC(a[B + l], a[B + i]); } }
}
template <int A, int Bq, int N> __device__ __forceinline__ void merge_top16(unsigned (&a)[N]) {
#pragma unroll
    for (int i = 0; i < 16; ++i) { const unsigned x = a[A + i], y = a[Bq + 15 - i]; a[A + i] = x > y ? x : y; }
#pragma unroll
    for (int j = 8; j > 0; j >>= 1)
#pragma unroll
        for (int i = 0; i < 16; ++i) { const int l = i ^ j; if (l > i) CE_DESC(a[A + i], a[A + l]); }
}

__device__ __forceinline__ void topk_phase(const Params& P, LAS unsigned char* lds, int vcu, int G) {
    const int tid = threadIdx.x, lane = tid & 63, wave = __builtin_amdgcn_readfirstlane(tid >> 6);
    const int c = lane & 31, hh = lane >> 5;
    const int gw = vcu * NWAVES + wave, NGW = G * NWAVES;
    unsigned char* ws = P.ws;
    const bf16_t* Q2 = (const bf16_t*)(ws + WS_Q2); const bf16_t* SKB = (const bf16_t*)(ws + WS_SKB);
    const float* ROWSS = (const float*)(ws + WS_CTL); int* IDS = (int*)(ws + WS_IDS); float* GATES = (float*)(ws + WS_GATES);
    LAS unsigned char* scr = lds + wave * 4096;
    for (int task = gw; task < 2048; task += NGW) {
        const int tg = task >> 3, hd = task & 7, tok = tg * 32 + c;
#pragma unroll 1
        for (int p = 0; p < 2; ++p) {
            bf16x8 qf[8];
            { const bf16_t* qp = Q2 + (size_t)tok * DM + hd * 256 + p * 128 + 8 * hh;
#pragma unroll
              for (int s = 0; s < 8; ++s) qf[s] = *(const bf16x8*)(qp + 16 * s); }
            unsigned keys[64];
#pragma unroll
            for (int sub = 0; sub < 4; ++sub) {
                f32x16 acc;
#pragma unroll
                for (int r = 0; r < 16; ++r) acc[r] = 0.f;
                const bf16_t* kp = SKB + ((size_t)(hd * 2 + p) * 128 + 32 * sub + c) * 128 + 8 * hh;
#pragma unroll
                for (int s = 0; s < 8; ++s) { const bf16x8 kf = *(const bf16x8*)(kp + 16 * s); acc = __builtin_amdgcn_mfma_f32_32x32x16_bf16(kf, qf[s], acc, 0, 0, 0); }
#pragma unroll
                for (int r = 0; r < 16; ++r) { const int nlo = 127 - (32 * sub + (r & 3) + 8 * (r >> 2)); keys[sub * 16 + r] = (sortable(acc[r]) & ~127u) | (unsigned)(nlo - 4 * hh); }
            }
            sort16_desc<0>(keys); sort16_desc<16>(keys); sort16_desc<32>(keys); sort16_desc<48>(keys);
            merge_top16<0, 16>(keys); merge_top16<32, 48>(keys); merge_top16<0, 32>(keys);
#pragma unroll
            for (int i = 0; i < 16; ++i) { const unsigned own = keys[i]; const auto rr = __builtin_amdgcn_permlane32_swap(own, own, false, false); keys[16 + i] = hh ? (unsigned)rr[0] : (unsigned)rr[1]; }
            merge_top16<0, 16>(keys);
            if (hh == 0) {
#pragma unroll
                for (int w = 0; w < 4; ++w) *(LAS u32x4*)(scr + (c * 2 + p) * 64 + w * 16) = (u32x4){keys[4 * w], keys[4 * w + 1], keys[4 * w + 2], keys[4 * w + 3]};
            }
        }
        LDS_WAIT();
        float s1[16], s2[16];
#pragma unroll
        for (int w = 0; w < 4; ++w) { const u32x4 a = *(const LAS u32x4*)(scr + (c * 2) * 64 + w * 16), b2 = *(const LAS u32x4*)(scr + (c * 2 + 1) * 64 + w * 16);
#pragma unroll
            for (int e = 0; e < 4; ++e) { s1[4 * w + e] = unsortable((a[e] & ~127u) | 64u); s2[4 * w + e] = unsortable((b2[e] & ~127u) | 64u); } }
        unsigned ck[64];
        { int n = 0;
#pragma unroll
          for (int i = 0; i < 16; ++i)
#pragma unroll
              for (int j = 0; j < 16; ++j) if ((i + 1) * (j + 1) <= 16) { ck[n] = (sortable(s1[i] + s2[j]) & ~255u) | (unsigned)(255 - (i * 16 + j)); ++n; }
#pragma unroll
          for (int q = 50; q < 64; ++q) ck[q] = 0u; }
        sort16_desc<0>(ck); sort16_desc<16>(ck); sort16_desc<32>(ck); sort16_desc<48>(ck);
        merge_top16<0, 16>(ck); merge_top16<32, 48>(ck); merge_top16<0, 32>(ck);
        unsigned t2[16];
#pragma unroll
        for (int k = 0; k < 16; ++k) t2[k] = ck[k];
        int ids[16]; float sc[16];
#pragma unroll
        for (int k = 0; k < 16; ++k) { const unsigned pos = 255u - (t2[k] & 255u);
            const unsigned k1 = *(const LAS unsigned*)(scr + (c * 2) * 64 + (pos >> 4) * 4), k2 = *(const LAS unsigned*)(scr + (c * 2 + 1) * 64 + (pos & 15u) * 4);
            ids[k] = (int)((127u - (k1 & 127u)) * 128u + (127u - (k2 & 127u))); sc[k] = unsortable((t2[k] & ~255u) | 128u); }
        LDS_WAIT();
        const float rs = 1.0f / sqrtf(ROWSS[tok] * (1.f / DM) + EPS);
        float ev[16], Z = 0.f;
#pragma unroll
        for (int k = 0; k < 16; ++k) { ev[k] = fexp2((sc[k] - sc[0]) * rs * LOG2E); Z += ev[k]; }
        const float iz = 1.f / Z;
        int* ip = IDS + (size_t)tok * 128 + hd * 16; float* gp = GATES + (size_t)tok * 128 + hd * 16;
        if (hh == 0) {
#pragma unroll
            for (int k = 0; k < 8; ++k) { ip[k] = ids[k]; gp[k] = ev[k] * iz; }
        } else {
#pragma unroll
            for (int k = 8; k < 16; ++k) { ip[k] = ids[k]; gp[k] = ev[k] * iz; }
        }
    }
}


__device__ __forceinline__ void topk_naive(const Params& P, LAS unsigned char* lds, int vcu, int G) {
    const int tid = threadIdx.x, lane = tid & 63, wave = __builtin_amdgcn_readfirstlane(tid >> 6);
    const int gw = vcu * NWAVES + wave, NGW = G * NWAVES;
    unsigned char* ws = P.ws;
    const bf16_t* Q2 = (const bf16_t*)(ws + WS_Q2);
    const float* ROWSS = (const float*)(ws + WS_CTL); int* IDS = (int*)(ws + WS_IDS); float* GATES = (float*)(ws + WS_GATES);
    LAS float* sv = (LAS float*)(lds + wave * 1024);
    LAS int* si = (LAS int*)(lds + wave * 1024 + 256);
    for (int task = gw; task < T_TOK * 8; task += NGW) {
        const int tok = task >> 3, hd = task & 7;
        for (int p = 0; p < 2; ++p) {
            float v0 = 0.f, v1 = 0.f;
            for (int cc = 0; cc < 128; ++cc) { const float q = bf_lo((unsigned)Q2[(size_t)tok * DM + hd * 256 + p * 128 + cc]);
                v0 += q * P.sub_keys[((size_t)(hd * 2 + p) * 128 + lane) * 128 + cc]; v1 += q * P.sub_keys[((size_t)(hd * 2 + p) * 128 + lane + 64) * 128 + cc]; }
            for (int i = 0; i < 16; ++i) {
                float bv = v0 >= v1 ? v0 : v1; int bi = v0 >= v1 ? lane : lane + 64;
                for (int o = 1; o < 64; o <<= 1) { const float ov = __shfl_xor(bv, o); const int oi = __shfl_xor(bi, o); if (ov > bv || (ov == bv && oi < bi)) { bv = ov; bi = oi; } }
                if (lane == 0) { sv[p * 16 + i] = bv; si[p * 16 + i] = bi; }
                if (bi == lane) v0 = -3e38f; if (bi == lane + 64) v1 = -3e38f;
            }
        }
        LDS_WAIT();
        float cv[4]; for (int q = 0; q < 4; ++q) { const int pos = lane * 4 + q; cv[q] = sv[pos >> 4] + sv[16 + (pos & 15)]; }
        float sel_v = 0.f; int sel_id = 0; float mx = 0.f;
        for (int k = 0; k < 16; ++k) {
            float bv = cv[0]; int bi = lane * 4;
            for (int q = 1; q < 4; ++q) if (cv[q] > bv) { bv = cv[q]; bi = lane * 4 + q; }
            for (int o = 1; o < 64; o <<= 1) { const float ov = __shfl_xor(bv, o); const int oi = __shfl_xor(bi, o); if (ov > bv || (ov == bv && oi < bi)) { bv = ov; bi = oi; } }
            if (k == 0) mx = bv;
            if (lane == k) { sel_v = bv; sel_id = si[bi >> 4] * 128 + si[16 + (bi & 15)]; }
            for (int q = 0; q < 4; ++q) if (bi == lane * 4 + q) cv[q] = -3e38f;
        }
        const float rs = 1.0f / sqrtf(ROWSS[tok] * (1.f / DM) + EPS);
        float ev = (lane < 16) ? expf((sel_v - mx) * rs) : 0.f;
        const float Z = wave_sum(ev);
        if (lane < 16) { IDS[(size_t)tok * 128 + hd * 16 + lane] = sel_id; GATES[(size_t)tok * 128 + hd * 16 + lane] = ev / Z; }
        LDS_WAIT();
    }
}

__device__ __forceinline__ float dot8(u32x4 a, u32x4 b, float acc) {
    const unsigned a0 = a[0], a1 = a[1], a2 = a[2], a3 = a[3], b0 = b[0], b1 = b[1], b2 = b[2], b3 = b[3];
    acc = __builtin_amdgcn_fdot2_f32_bf16(__builtin_bit_cast(bf16v2, a0), __builtin_bit_cast(bf16v2, b0), acc, false);
    acc = __builtin_amdgcn_fdot2_f32_bf16(__builtin_bit_cast(bf16v2, a1), __builtin_bit_cast(bf16v2, b1), acc, false);
    acc = __builtin_amdgcn_fdot2_f32_bf16(__builtin_bit_cast(bf16v2, a2), __builtin_bit_cast(bf16v2, b2), acc, false);
    acc = __builtin_amdgcn_fdot2_f32_bf16(__builtin_bit_cast(bf16v2, a3), __builtin_bit_cast(bf16v2, b3), acc, false);
    return acc;
}
__device__ __forceinline__ float gelu_tanh(float a) { const float t = 1.5957691216f * (a + 0.044715f * a * a * a); return a * frcp(1.f + fexp2(-LOG2E * t)); }

__device__ __forceinline__ void gather_phase(const Params& P, int vcu, int G) {
    const int tid = threadIdx.x, lane = tid & 63, wave = __builtin_amdgcn_readfirstlane(tid >> 6);
    const int gw = vcu * NWAVES + wave, NGW = G * NWAVES;
    unsigned char* ws = P.ws;
    const float* X1 = (const float*)(ws + WS_X1); const float* ROWSS = (const float*)(ws + WS_CTL);
    const int* IDS = (const int*)(ws + WS_IDS); const float* GATES = (const float*)(ws + WS_GATES);
    const unsigned char* EU = ws + WS_EU; const unsigned char* EV = ws + WS_EV;
    const float* SU = (const float*)(ws + WS_SU); const float* SV = (const float*)(ws + WS_SV);
    const bool b5 = (lane >> 5) & 1, b4 = (lane >> 4) & 1, b3 = (lane >> 3) & 1;
    for (int tok = gw; tok < T_TOK; tok += NGW) {
        f32x4 xv[2][4]; u32x4 hq[2];
        const float rs = 1.0f / sqrtf(ROWSS[tok] * (1.f / DM) + EPS);
        float hmx = 0.f;
#pragma unroll
        for (int j = 0; j < 2; ++j)
#pragma unroll
            for (int c4 = 0; c4 < 4; ++c4) { const size_t o = (size_t)tok * DM + 16 * lane + 1024 * j + 4 * c4; xv[j][c4] = *(const f32x4*)(X1 + o); }
        f32x4 hv[2][4];
#pragma unroll
        for (int j = 0; j < 2; ++j)
#pragma unroll
            for (int c4 = 0; c4 < 4; ++c4) { const f32x4 g = *(const f32x4*)(P.g_ffn + 16 * lane + 1024 * j + 4 * c4); hv[j][c4] = xv[j][c4] * rs * g;
                hmx = fmaxf(hmx, fmaxf(fmaxf(fabsf(hv[j][c4][0]), fabsf(hv[j][c4][1])), fmaxf(fabsf(hv[j][c4][2]), fabsf(hv[j][c4][3])))); }
#pragma unroll
        for (int o = 1; o < 64; o <<= 1) hmx = fmaxf(hmx, __shfl_xor(hmx, o));
        hmx = fmaxf(hmx, 1e-30f);
        const float hinv = 127.f / hmx, hscale = hmx * (1.f / 127.f);
#pragma unroll
        for (int j = 0; j < 2; ++j)
#pragma unroll
            for (int c4 = 0; c4 < 4; ++c4) { unsigned w = 0;
#pragma unroll
                for (int e = 0; e < 4; ++e) w |= ((unsigned)(int)__builtin_rintf(hv[j][c4][e] * hinv) & 255u) << (8 * e);
                hq[j][c4] = w; }
        const int ida = IDS[(size_t)tok * 128 + lane], idb = IDS[(size_t)tok * 128 + 64 + lane];
        const float sua = SU[ida], sub = SU[idb], sva = SV[ida], svb = SV[idb];
        float wreg[16];
#pragma unroll
        for (int bt = 0; bt < 16; ++bt) {
            int part[8]; u32x4 ud[8][2];
#pragma unroll
            for (int q = 0; q < 8; ++q) { const int k = bt * 8 + q; const int e = __builtin_amdgcn_readlane(k < 64 ? ida : idb, k & 63);
                const unsigned char* ur = EU + (size_t)e * DM + 16 * lane;
                ud[q][0] = *(const u32x4*)ur; ud[q][1] = *(const u32x4*)(ur + 1024); }
#pragma unroll
            for (int q = 0; q < 8; ++q) { int a = 0;
#pragma unroll
                for (int j = 0; j < 2; ++j)
#pragma unroll
                    for (int c4 = 0; c4 < 4; ++c4) a = __builtin_amdgcn_sdot4((int)ud[q][j][c4], (int)hq[j][c4], a, false);
                part[q] = a; }
            int p1[4], p2[2];
#pragma unroll
            for (int q = 0; q < 4; ++q) { const int send = b5 ? part[q] : part[q + 4], keep = b5 ? part[q + 4] : part[q]; p1[q] = keep + __shfl_xor(send, 32); }
#pragma unroll
            for (int q = 0; q < 2; ++q) { const int send = b4 ? p1[q] : p1[q + 2], keep = b4 ? p1[q + 2] : p1[q]; p2[q] = keep + __shfl_xor(send, 16); }
            int p3; { const int send = b3 ? p2[0] : p2[1], keep = b3 ? p2[1] : p2[0]; p3 = keep + __shfl_xor(send, 8); }
            p3 += __shfl_xor(p3, 4); p3 += __shfl_xor(p3, 2); p3 += __shfl_xor(p3, 1);
            const int ksel = bt * 8 + (lane >> 3);
            const float su_k = __shfl(bt < 8 ? sua : sub, ksel & 63), sv_k = __shfl(bt < 8 ? sva : svb, ksel & 63);
            const float gate = GATES[(size_t)tok * 128 + ksel];
            const float act = (float)p3 * (su_k * hscale);
            wreg[bt] = gate * gelu_tanh(act) * sv_k;
        }
        f32x4 acc[2][4]; float wsum = 0.f;
#pragma unroll
        for (int j = 0; j < 2; ++j)
#pragma unroll
            for (int c4 = 0; c4 < 4; ++c4) acc[j][c4] = (f32x4){0.f, 0.f, 0.f, 0.f};
#pragma unroll
        for (int bt = 0; bt < 16; ++bt) {
            u32x4 vd[8][2];
#pragma unroll
            for (int q = 0; q < 8; ++q) { const int k = bt * 8 + q; const int e = __builtin_amdgcn_readlane(k < 64 ? ida : idb, k & 63);
                const unsigned char* vr = EV + (size_t)e * DM + 16 * lane;
                vd[q][0] = *(const u32x4*)vr; vd[q][1] = *(const u32x4*)(vr + 1024); }
#pragma unroll
            for (int q = 0; q < 8; ++q) { const float w = __builtin_bit_cast(float, __builtin_amdgcn_readlane(__builtin_bit_cast(int, wreg[bt]), 8 * q));
                wsum += w;
#pragma unroll
                for (int j = 0; j < 2; ++j)
#pragma unroll
                    for (int c4 = 0; c4 < 4; ++c4) { const unsigned u = vd[q][j][c4];
                        acc[j][c4] += w * (f32x4){(float)(u & 255u), (float)((u >> 8) & 255u), (float)((u >> 16) & 255u), (float)(u >> 24)}; } }
        }
        float ss = 0.f; const float corr = 128.f * wsum;
#pragma unroll
        for (int j = 0; j < 2; ++j)
#pragma unroll
            for (int c4 = 0; c4 < 4; ++c4) { const f32x4 v = (DBG == 1 || DBG == 2) ? xv[j][c4] : xv[j][c4] + (acc[j][c4] - corr); xv[j][c4] = v; ss += (v[0] * v[0] + v[1] * v[1]) + (v[2] * v[2] + v[3] * v[3]); }
        const float rs2 = 1.0f / sqrtf(wave_sum(ss) * (1.f / DM) + EPS);
#pragma unroll
        for (int j = 0; j < 2; ++j)
#pragma unroll
            for (int c4 = 0; c4 < 4; ++c4) { const size_t o = (size_t)tok * DM + 16 * lane + 1024 * j + 4 * c4;
                const f32x4 g = *(const f32x4*)(P.g_final + 16 * lane + 1024 * j + 4 * c4);
                *(f32x4*)(P.out + o) = xv[j][c4] * rs2 * g; }
    }
}


__device__ __forceinline__ int dot16(u32x4 a, u32x4 b, int acc) {
    acc = __builtin_amdgcn_sdot4((int)a[0], (int)b[0], acc, false); acc = __builtin_amdgcn_sdot4((int)a[1], (int)b[1], acc, false);
    acc = __builtin_amdgcn_sdot4((int)a[2], (int)b[2], acc, false); acc = __builtin_amdgcn_sdot4((int)a[3], (int)b[3], acc, false);
    return acc;
}
__device__ __forceinline__ void gather_sweep(const Params& P, LAS unsigned char* lds, int vcu, int G) {
    const int tid = threadIdx.x, lane = tid & 63, wave = __builtin_amdgcn_readfirstlane(tid >> 6);
    const int gw = vcu * NWAVES + wave, NGW = G * NWAVES;
    const int g = lane >> 3, i = lane & 7;
    unsigned char* ws = P.ws;
    const float* X1 = (const float*)(ws + WS_X1); const float* ROWSS = (const float*)(ws + WS_CTL);
    const int* IDS = (const int*)(ws + WS_IDS); const float* GATES = (const float*)(ws + WS_GATES);
    const unsigned char* EU = ws + WS_EU; const unsigned char* EV = ws + WS_EV;
    const float* SU = (const float*)(ws + WS_SU); const float* SV = (const float*)(ws + WS_SV);
    LAS unsigned char* wl = lds + wave * 16384;
    const bool b2 = (lane >> 2) & 1, b1 = (lane >> 1) & 1, b0 = lane & 1, B2 = (lane >> 5) & 1, B1 = (lane >> 4) & 1, B0 = (lane >> 3) & 1;
    for (int tg = gw; tg < T_TOK / 4; tg += NGW) {
        const int tok0 = tg * 4;
        float hs[4];
#pragma unroll
        for (int j = 0; j < 4; ++j) { const int tok = tok0 + j;
            const float rs = 1.0f / sqrtf(ROWSS[tok] * (1.f / DM) + EPS);
            f32x4 hv[8]; float hmx = 0.f;
#pragma unroll
            for (int q = 0; q < 8; ++q) { const f32x4 xv = *((const f32x4*)(X1 + (size_t)tok * DM) + lane + 64 * q); const f32x4 gn = *((const f32x4*)P.g_ffn + lane + 64 * q);
                hv[q] = xv * rs * gn; hmx = fmaxf(hmx, fmaxf(fmaxf(fabsf(hv[q][0]), fabsf(hv[q][1])), fmaxf(fabsf(hv[q][2]), fabsf(hv[q][3])))); }
#pragma unroll
            for (int o = 1; o < 64; o <<= 1) hmx = fmaxf(hmx, __shfl_xor(hmx, o));
            hmx = fmaxf(hmx, 1e-30f); const float hinv = 127.f / hmx; hs[j] = hmx * (1.f / 127.f);
#pragma unroll
            for (int q = 0; q < 8; ++q) { unsigned w = 0;
#pragma unroll
                for (int e = 0; e < 4; ++e) w |= ((unsigned)(int)__builtin_rintf(hv[q][e] * hinv) & 255u) << (8 * e);
                *(LAS unsigned*)(wl + j * 2048 + 4 * (lane + 64 * q)) = w; }
#pragma unroll
            for (int hf = 0; hf < 2; ++hf) { const int k = lane + 64 * hf; const int id = IDS[(size_t)tok * 128 + k];
                *(LAS unsigned*)(wl + 8192 + (j * 128 + k) * 4) = (unsigned)id * 2048u;
                *(LAS float*)(wl + 10240 + (j * 128 + k) * 4) = GATES[(size_t)tok * 128 + k] * SV[id];
                *(LAS float*)(wl + 12288 + (j * 128 + k) * 4) = SU[id]; }
        }
        LDS_WAIT();
        int accu[4][16];
#pragma unroll
        for (int j = 0; j < 4; ++j)
#pragma unroll
            for (int m = 0; m < 16; ++m) accu[j][m] = 0;
#pragma unroll 1
        for (int sl = 0; sl < 16; ++sl) {
            const unsigned char* ub = EU + 128 * sl + 16 * i;
#pragma unroll
            for (int j = 0; j < 4; ++j) {
                const u32x4 hqc = *(const LAS u32x4*)(wl + j * 2048 + 128 * sl + 16 * i);
                u32x4 d[16];
#pragma unroll
                for (int m = 0; m < 16; ++m) { const unsigned off = *(const LAS unsigned*)(wl + 8192 + (j * 128 + 8 * m + g) * 4); d[m] = *(const u32x4*)(ub + off); }
#pragma unroll
                for (int m = 0; m < 16; ++m) accu[j][m] = dot16(d[m], hqc, accu[j][m]);
                __builtin_amdgcn_sched_barrier(0);
            }
        }
        float corr[4];
#pragma unroll
        for (int j = 0; j < 4; ++j) {
            int r1[8], r2[4], r3[2];
#pragma unroll
            for (int m = 0; m < 8; ++m) { const int send = b2 ? accu[j][m] : accu[j][m + 8], keep = b2 ? accu[j][m + 8] : accu[j][m]; r1[m] = keep + __shfl_xor(send, 4); }
#pragma unroll
            for (int m = 0; m < 4; ++m) { const int send = b1 ? r1[m] : r1[m + 4], keep = b1 ? r1[m + 4] : r1[m]; r2[m] = keep + __shfl_xor(send, 2); }
#pragma unroll
            for (int m = 0; m < 2; ++m) { const int send = b0 ? r2[m] : r2[m + 2], keep = b0 ? r2[m + 2] : r2[m]; r3[m] = keep + __shfl_xor(send, 1); }
            float wsum = 0.f;
#pragma unroll
            for (int m = 0; m < 2; ++m) { const int k = 16 * i + 8 * m + g;
                const float act = (float)r3[m] * (hs[j] * *(const LAS float*)(wl + 12288 + (j * 128 + k) * 4));
                const float w = *(const LAS float*)(wl + 10240 + (j * 128 + k) * 4) * gelu_tanh(act);
                *(LAS float*)(wl + 10240 + (j * 128 + k) * 4) = w; wsum += w; }
            corr[j] = 128.f * wave_sum(wsum);
        }
        LDS_WAIT();
        float ssq[4] = {0.f, 0.f, 0.f, 0.f};
#pragma unroll 1
        for (int sl = 0; sl < 16; ++sl) {
            const unsigned char* vb = EV + 128 * sl + 16 * i;
#pragma unroll
            for (int j = 0; j < 4; ++j) {
                u32x4 d[16]; float wv[16];
#pragma unroll
                for (int m = 0; m < 16; ++m) { const unsigned off = *(const LAS unsigned*)(wl + 8192 + (j * 128 + 8 * m + g) * 4); wv[m] = *(const LAS float*)(wl + 10240 + (j * 128 + 8 * m + g) * 4); d[m] = *(const u32x4*)(vb + off); }
                float ca[16];
#pragma unroll
                for (int b = 0; b < 16; ++b) ca[b] = 0.f;
#pragma unroll
                for (int m = 0; m < 16; ++m)
#pragma unroll
                    for (int c4 = 0; c4 < 4; ++c4) { const unsigned u = d[m][c4];
                        ca[4 * c4 + 0] += wv[m] * (float)(u & 255u); ca[4 * c4 + 1] += wv[m] * (float)((u >> 8) & 255u);
                        ca[4 * c4 + 2] += wv[m] * (float)((u >> 16) & 255u); ca[4 * c4 + 3] += wv[m] * (float)(u >> 24); }
                float c1[8], c2[4], c3[2];
#pragma unroll
                for (int b = 0; b < 8; ++b) { const float send = B2 ? ca[b] : ca[b + 8], keep = B2 ? ca[b + 8] : ca[b]; c1[b] = keep + __shfl_xor(send, 32); }
#pragma unroll
                for (int b = 0; b < 4; ++b) { const float send = B1 ? c1[b] : c1[b + 4], keep = B1 ? c1[b + 4] : c1[b]; c2[b] = keep + __shfl_xor(send, 16); }
#pragma unroll
                for (int b = 0; b < 2; ++b) { const float send = B0 ? c2[b] : c2[b + 2], keep = B0 ? c2[b + 2] : c2[b]; c3[b] = keep + __shfl_xor(send, 8); }
                const size_t o = (size_t)(tok0 + j) * DM + 128 * sl + 16 * i + 2 * g;
                const f32x2 xv = *(const f32x2*)(X1 + o);
                const f32x2 x2 = {xv[0] + (c3[0] - corr[j]), xv[1] + (c3[1] - corr[j])};
                ssq[j] += x2[0] * x2[0] + x2[1] * x2[1];
                *(f32x2*)(P.out + o) = x2;
                __builtin_amdgcn_sched_barrier(0);
            }
        }
#pragma unroll
        for (int j = 0; j < 4; ++j) { const float rs2 = 1.0f / sqrtf(wave_sum(ssq[j]) * (1.f / DM) + EPS);
            f32x4* orow = (f32x4*)(P.out + (size_t)(tok0 + j) * DM) + lane;
#pragma unroll
            for (int q = 0; q < 8; ++q) { const f32x4 gn = *((const f32x4*)P.g_final + lane + 64 * q); orow[64 * q] = orow[64 * q] * rs2 * gn; } }
        LDS_WAIT();
    }
}

__device__ __forceinline__ void gather_naive(const Params& P, int vcu, int G) {
    const int tid = threadIdx.x, lane = tid & 63, wave = __builtin_amdgcn_readfirstlane(tid >> 6);
    const int gw = vcu * NWAVES + wave, NGW = G * NWAVES;
    unsigned char* ws = P.ws;
    const float* X1 = (const float*)(ws + WS_X1); const float* ROWSS = (const float*)(ws + WS_CTL);
    const int* IDS = (const int*)(ws + WS_IDS); const float* GATES = (const float*)(ws + WS_GATES);
    for (int tok = gw; tok < T_TOK; tok += NGW) {
        float h2[32], acc[32];
        const float rs = 1.0f / sqrtf(ROWSS[tok] * (1.f / DM) + EPS);
#pragma unroll
        for (int i = 0; i < 32; ++i) { h2[i] = X1[(size_t)tok * DM + lane + 64 * i] * rs * P.g_ffn[lane + 64 * i]; acc[i] = 0.f; }
#pragma unroll 1
        for (int k = 0; k < 128; ++k) {
            const int e = IDS[(size_t)tok * 128 + k]; float a = 0.f;
            if (false) { const bf16_t* up = (const bf16_t*)(ws + WS_EU) + (size_t)e * DM + lane;
#pragma unroll
                for (int i = 0; i < 32; ++i) a += h2[i] * bf_lo((unsigned)up[64 * i]);
            } else { const float* up = P.e_u + (size_t)e * DM + lane;
#pragma unroll
                for (int i = 0; i < 32; ++i) a += h2[i] * up[64 * i]; }
            a = wave_sum(a);
            const float w = GATES[(size_t)tok * 128 + k] * gelu_tanh(a);
            if (false) { const bf16_t* vp = (const bf16_t*)(ws + WS_EV) + (size_t)e * DM + lane;
#pragma unroll
                for (int i = 0; i < 32; ++i) acc[i] += w * bf_lo((unsigned)vp[64 * i]);
            } else { const float* vp = P.e_v + (size_t)e * DM + lane;
#pragma unroll
                for (int i = 0; i < 32; ++i) acc[i] += w * vp[64 * i]; }
        }
        float ss = 0.f;
#pragma unroll
        for (int i = 0; i < 32; ++i) { acc[i] += X1[(size_t)tok * DM + lane + 64 * i]; ss += acc[i] * acc[i]; }
        const float rs2 = 1.0f / sqrtf(wave_sum(ss) * (1.f / DM) + EPS);
#pragma unroll
        for (int i = 0; i < 32; ++i) P.out[(size_t)tok * DM + lane + 64 * i] = acc[i] * rs2 * P.g_final[lane + 64 * i];
    }
}
}


#define XB_TMO      128
#define XB_XCNT(j)  (256  + 64 * (j))
#define XB_XSUB(j)  (1280 + 64 * (j))
#define XB_XGEN(j)  (2304 + 64 * (j))
#define XB_TOP      3328
#define XB_TOPGEN   3392
#define XCD_BAR_WORDS 3456
#define XB_SPIN_CAP (1u << 18)
__device__ __forceinline__ unsigned xb_ld(unsigned* p)              { return __hip_atomic_load(p, __ATOMIC_RELAXED, __HIP_MEMORY_SCOPE_AGENT); }
__device__ __forceinline__ unsigned xb_add(unsigned* p, unsigned v) { return __hip_atomic_fetch_add(p, v, __ATOMIC_RELAXED, __HIP_MEMORY_SCOPE_AGENT); }
__device__ __forceinline__ unsigned xb_xcc_id() { return (unsigned)__builtin_amdgcn_s_getreg((3 << 11) | 20) & 0xFu; }
#define XB_SPIN(cond, bar) do { unsigned _sp = 0; while (cond) { __builtin_amdgcn_s_sleep(1); \
    if ((++_sp & 255u) == 0u) { if (xb_ld(&(bar)[XB_TMO])) break; if (_sp > XB_SPIN_CAP) { atomicAdd(&(bar)[XB_TMO], 1u); break; } } } } while (0)
struct XcdBarrier { unsigned* bar; unsigned x; volatile LAS unsigned* st; };
__device__ __forceinline__ XcdBarrier xcd_barrier_post(unsigned* bar, volatile LAS unsigned* st) {
    XcdBarrier b; b.bar = bar; b.x = xb_xcc_id(); b.st = st;
    if (threadIdx.x == 0) (void)xb_add(&bar[XB_XCNT(b.x)], 1u);
    return b;
}
__device__ __forceinline__ void xcd_barrier_complete(unsigned* bar, unsigned x, unsigned& nloc, unsigned& nx) {
    const unsigned G = gridDim.x * gridDim.y * gridDim.z;
    unsigned sum, cnt, mine, sp = 0u;
    for (;;) {
        sum = 0u; cnt = 0u; mine = 0u;
#pragma unroll
        for (unsigned j = 0; j < 16; ++j) { const unsigned c = xb_ld(&bar[XB_XCNT(j)]); sum += c; cnt += (c > 0u) ? 1u : 0u; mine = (j == x) ? c : mine; }
        if (sum == G) break;
        __builtin_amdgcn_s_sleep(1);
        if ((++sp & 255u) == 0u) { if (xb_ld(&bar[XB_TMO])) break; if (sp > XB_SPIN_CAP) { atomicAdd(&bar[XB_TMO], 1u); break; } }
    }
    nloc = mine > 0u ? mine : 1u; nx = cnt > 0u ? cnt : 1u;
}
__device__ __forceinline__ void xcd_barrier(const XcdBarrier& b) {
    asm volatile("s_waitcnt vmcnt(0)" ::: "memory");
    __syncthreads();
    if (threadIdx.x == 0) {
        unsigned* bar = b.bar;
        __builtin_amdgcn_s_waitcnt(0);
        unsigned nloc = b.st[0], nx = b.st[1];
        if (nloc == 0u) { xcd_barrier_complete(bar, b.x, nloc, nx); b.st[0] = nloc; b.st[1] = nx; }
        const unsigned old = xb_add(&bar[XB_XSUB(b.x)], 1u);
        const unsigned gen = old / nloc;
        if (old + 1u == (gen + 1u) * nloc) {
            __builtin_amdgcn_fence(__ATOMIC_RELEASE, "agent");
            asm volatile("s_waitcnt vmcnt(0)" ::: "memory");
            const unsigned og = xb_add(&bar[XB_TOP], 1u);
            const unsigned tg = og / nx;
            if (og + 1u == (tg + 1u) * nx) xb_add(&bar[XB_TOPGEN], 1u);
            else XB_SPIN(xb_ld(&bar[XB_TOPGEN]) == tg, bar);
            __builtin_amdgcn_fence(__ATOMIC_ACQUIRE, "agent");
            xb_add(&bar[XB_XGEN(b.x)], 1u);
            asm volatile("s_waitcnt vmcnt(0)" ::: "memory");
        } else {
            XB_SPIN(xb_ld(&bar[XB_XGEN(b.x)]) == gen, bar);
            __builtin_amdgcn_fence(__ATOMIC_ACQUIRE, "agent");
            asm volatile("s_waitcnt vmcnt(0)" ::: "memory");
        }
    }
    __syncthreads();
}

__global__ void __launch_bounds__(NTHR, 2) mega_fwd(Params P) {
    extern __shared__ __attribute__((aligned(16))) unsigned char lds_raw[];
    LAS unsigned char* lds = (LAS unsigned char*)lds_raw;
    cg::grid_group grid = cg::this_grid();
    const int G = gridDim.x, bx = blockIdx.x;
    const int vcu = (G % 8 == 0) ? (bx % 8) * (G / 8) + bx / 8 : bx;
    unsigned char* ws = P.ws;
#ifndef ONLY_PHASE
#define ONLY_PHASE -1
#endif
#define IN(k) ((ONLY_PHASE < 0 || ONLY_PHASE == (k)) && P.ph_lo <= (k) && (k) < P.ph_hi)
    volatile LAS unsigned* bst = (volatile LAS unsigned*)(lds + 131072);
    if (threadIdx.x < 16) bst[threadIdx.x] = 0u;
    __syncthreads();
    const XcdBarrier xbar = xcd_barrier_post((unsigned*)(ws + WS_CTL + 131072), bst);
    if (P.ph_lo < 0) grid.sync();
#define SEAM(k) do { if (IN(k) && IN((k) + 1)) xcd_barrier(xbar); } while (0)
    if (IN(0)) { p0a(P, lds, vcu, G); xcd_barrier(xbar); p0b(P, lds, vcu, G); }
    SEAM(0);
    for (int rep_ = 0; rep_ < (REPK == 1 ? 2 : 1); ++rep_) if (IN(1)) {
        pg8::Gemm g{ws + WS_H, ws + WS_WIN, T_TOK, 10240, 2048, 2048, 2048};
        pg8::StaticOrder S; S.init(T_TOK, 10240, G, bx);
        pg8::EpiProj E{(bf16_t*)(ws + WS_QKV), (bf16_t*)(ws + WS_SG), LOG2E * 0.08838834764831845f, (unsigned*)(ws + WS_CTL + 200704), (const float*)(ws + WS_HSC), (const float*)(ws + WS_WSC)};
        pg8::gemm_phase<pg8::EpiProj, true>(lds, g, S, E);
    }
    SEAM(1);
    if (IN(2)) { att::attn_phase(P, lds, vcu, G); __syncthreads(); late_transposes(P, lds, vcu, G); }
    SEAM(2);
    for (int rep_ = 0; rep_ < (REPK == 3 ? 2 : 1); ++rep_) if (IN(3)) {
        pg8::StaticOrder S; S.init(T_TOK, DM, G, bx);
        { pg8::Gemm g{ws + WS_H, ws + WS_WAT, T_TOK, DM, 1024, 4096, 2048};
          pg8::EpiGate<0> E{(const bf16_t*)(ws + WS_SG), (float*)(ws + WS_TMP), (bf16_t*)(ws + WS_MERGED)};
          pg8::gemm_phase(lds, g, S, E); }
        { pg8::Gemm g{ws + WS_H + 2048, ws + WS_WBT, T_TOK, DM, 1024, 4096, 2048};
          pg8::EpiGate<1> E{(const bf16_t*)(ws + WS_SG) + 2048, (float*)(ws + WS_TMP), (bf16_t*)(ws + WS_MERGED)};
          pg8::gemm_phase(lds, g, S, E); }
    }
    SEAM(3);
    for (int rep_ = 0; rep_ < (REPK == 4 ? 2 : 1); ++rep_) if (IN(4)) {
        pg8::Gemm g{ws + WS_MERGED, ws + WS_WOUT, T_TOK, DM, 2048, 4096, 4096};
        pg8::StaticOrder S; S.init(T_TOK, DM, G, bx);
        pg8::EpiResid E{P.x, (float*)(ws + WS_X1), (bf16_t*)(ws + WS_X1B), (float*)(ws + WS_CTL)};
        pg8::gemm_phase(lds, g, S, E);
    }
    SEAM(4);
    for (int rep_ = 0; rep_ < (REPK == 5 ? 2 : 1); ++rep_) if (IN(5)) {
        pg8::Gemm g{ws + WS_X1B, ws + WS_WQ, T_TOK, DM, 2048, 4096, 4096};
        pg8::StaticOrder S; S.init(T_TOK, DM, G, bx);
        pg8::EpiPlainBf16 E{(bf16_t*)(ws + WS_Q2)};
        pg8::gemm_phase(lds, g, S, E);
    }
    SEAM(5);
    if (IN(6)) peer::topk_phase(P, lds, vcu, G);
    SEAM(6);
    for (int rep_ = 0; rep_ < (REPK == 7 ? 2 : 1); ++rep_) if (IN(7)) { if (DBG == 11) peer::gather_naive(P, vcu, G); else if (DBG == 14) peer::gather_phase(P, vcu, G); else peer::gather_sweep(P, lds, vcu, G); }
#undef IN
#undef SEAM
}

extern "C" void kernel_launch(void* const* d_in, const int* in_sizes, int n_in, void* d_out, int out_size, void* d_ws, size_t ws_size, hipStream_t stream) {
    static int grid = 0;
    if (grid == 0) {
        if (n_in != 13 || out_size != T_TOK * DM || ws_size < WS_END) { fprintf(stderr, "kernel_launch: unexpected shapes (n_in %d out %d ws %zu)\n", n_in, out_size, ws_size); grid = -1; return; }
        int dev = 0, cus = 0, per_cu = 0;
        if (hipGetDevice(&dev) != hipSuccess || hipDeviceGetAttribute(&cus, hipDeviceAttributeMultiprocessorCount, dev) != hipSuccess) { grid = -1; return; }
        if (hipFuncSetAttribute((const void*)mega_fwd, hipFuncAttributeMaxDynamicSharedMemorySize, LDS_BYTES) != hipSuccess) { fprintf(stderr, "kernel_launch: hipFuncSetAttribute failed\n"); grid = -1; return; }
        if (hipOccupancyMaxActiveBlocksPerMultiprocessor(&per_cu, (const void*)mega_fwd, NTHR, LDS_BYTES) != hipSuccess || per_cu < 1) { fprintf(stderr, "kernel_launch: occupancy query says %d\n", per_cu); grid = -1; return; }
        grid = cus;
    }
    if (grid < 0) return;
    (void)hipMemsetAsync((char*)d_ws + WS_CTL, 0, 1 * MiB, stream);
    Params p{};
    p.x = (const float*)d_in[0]; p.g_mix = (const float*)d_in[1]; p.w_in = (const float*)d_in[2]; p.b_forget = (const float*)d_in[3];
    p.w_a = (const float*)d_in[4]; p.w_b = (const float*)d_in[5]; p.w_out = (const float*)d_in[6]; p.g_ffn = (const float*)d_in[7];
    p.w_query = (const float*)d_in[8]; p.sub_keys = (const float*)d_in[9]; p.e_u = (const float*)d_in[10]; p.e_v = (const float*)d_in[11]; p.g_final = (const float*)d_in[12];
    p.out = (float*)d_out; p.ws = (unsigned char*)d_ws;
#if MK_N_LAUNCHES == 1
    p.ph_lo = 0; p.ph_hi = N_PHASES;
    void* args[] = {&p};
    hipError_t e = hipLaunchCooperativeKernel((const void*)mega_fwd, dim3(grid), dim3(NTHR), args, LDS_BYTES, stream);
    if (e != hipSuccess) fprintf(stderr, "kernel_launch: cooperative launch failed: %s (grid %d)\n", hipGetErrorString(e), grid);
#else
    for (int ph = 0; ph < N_PHASES; ++ph) { p.ph_lo = ph; p.ph_hi = ph + 1; hipLaunchKernelGGL(mega_fwd, dim3(grid), dim3(NTHR), LDS_BYTES, stream, p); }
#endif
}
```

```cpp
#include <hip/hip_runtime.h>
#include <hip/hip_cooperative_groups.h>
#include <cstdio>
#include <cstdint>
namespace cg = cooperative_groups;

#define LAS __attribute__((address_space(3)))
typedef unsigned short bf16_t;
typedef short bf16x8 __attribute__((ext_vector_type(8)));
typedef short s16x4 __attribute__((ext_vector_type(4)));
typedef float f32x2 __attribute__((ext_vector_type(2)));
typedef float f32x4 __attribute__((ext_vector_type(4)));
typedef float f32x16 __attribute__((ext_vector_type(16)));
typedef unsigned u32x2 __attribute__((ext_vector_type(2)));
typedef unsigned u32x4 __attribute__((ext_vector_type(4)));
typedef __bf16 bf16v2 __attribute__((ext_vector_type(2)));
typedef int i32x4 __attribute__((ext_vector_type(4)));

#ifndef MK_N_LAUNCHES
#define MK_N_LAUNCHES 1
#endif

constexpr int T_TOK = 8192, DM = 2048, SEQ = 4096, HD = 128;
constexpr int NWAVES = 8, NTHR = 512;
constexpr int LDS_BYTES = 147456;
constexpr float LOG2E = 1.4426950408889634f;
constexpr float EPS = 1e-6f;
constexpr int N_PHASES = 8;

constexpr size_t MiB = 1u << 20;
constexpr size_t WS_CTL = 0;
constexpr size_t WS_LOGF = 1 * MiB;
constexpr size_t WS_SKB = 1 * MiB + 512 * 1024;
constexpr size_t WS_HSC = 1 * MiB + 256 * 1024;
constexpr size_t WS_WSC = 1 * MiB + 320 * 1024;
constexpr size_t CTL_CMAX = 262144;
constexpr size_t WS_IDS = 2 * MiB;
constexpr size_t WS_GATES = 6 * MiB;
constexpr size_t WS_WAT = 10 * MiB, WS_WBT = 14 * MiB, WS_WOUT = 18 * MiB, WS_WQ = 26 * MiB, WS_WIN = 34 * MiB;
constexpr size_t WS_H = 74 * MiB;
constexpr size_t WS_QKV = 106 * MiB;
constexpr size_t WS_TMP = 106 * MiB, WS_MERGED = 170 * MiB, WS_Q2 = 106 * MiB;
constexpr size_t WS_SG = 202 * MiB;
constexpr size_t WS_X1B = 202 * MiB;
constexpr size_t WS_X1 = 266 * MiB;
constexpr size_t WS_EU = 330 * MiB, WS_EV = 362 * MiB;
constexpr size_t WS_SU = 394 * MiB, WS_SV = 394 * MiB + 65536;
constexpr size_t WS_END = 395 * MiB;

struct Params {
    const float* x; const float* g_mix; const float* w_in; const float* b_forget; const float* w_a; const float* w_b; const float* w_out;
    const float* g_ffn; const float* w_query; const float* sub_keys; const float* e_u; const float* e_v; const float* g_final;
    float* out; unsigned char* ws; int ph_lo, ph_hi;
};

__device__ __forceinline__ unsigned pk2(float a, float b) { f32x2 v = {a, b}; return __builtin_bit_cast(unsigned, __builtin_convertvector(v, bf16v2)); }
__device__ __forceinline__ float bf_lo(unsigned u) { return __builtin_bit_cast(float, u << 16); }
__device__ __forceinline__ float bf_hi(unsigned u) { return __builtin_bit_cast(float, u & 0xffff0000u); }
__device__ __forceinline__ float fexp2(float x) { return __builtin_amdgcn_exp2f(x); }
__device__ __forceinline__ float flog2(float x) { return __builtin_amdgcn_logf(x); }
__device__ __forceinline__ float frcp(float x) { return __builtin_amdgcn_rcpf(x); }
__device__ __forceinline__ float wave_sum(float v) {
#pragma unroll
    for (int o = 1; o < 64; o <<= 1) v += __shfl_xor(v, o);
    return v;
}
#define LDS_WAIT() asm volatile("s_waitcnt lgkmcnt(0)" ::: "memory")

namespace pg8 {
constexpr int BM = 256, BK = 64, HALF = 128, HTB = HALF * BK * 2, STAGE_BYTES = 8 * HTB, NXCD = 8, WGM = 8;
__host__ __device__ __forceinline__ int lds_byte(int r, int c) { const int st = (r >> 4) * 2 + (c >> 5), rr = r & 15, cc = c & 31, ob = rr * 64 + cc * 2; return st * 1024 + (ob ^ (((ob >> 9) & 1) << 5)); }
__host__ __device__ __forceinline__ void stage_rc(int b, int& R, int& C) { const int st = b / 1024, sb = b % 1024, swz = sb ^ (((sb >> 9) & 1) << 5); R = (st >> 1) * 16 + swz / 64; C = (st & 1) * 32 + (swz % 64) / 2; }
__host__ __device__ __forceinline__ int perm32(int rho) { const int n = rho >> 4, i = rho & 15; return 8 * (i >> 2) + 4 * n + (i & 3); }
struct Unit { int pm, pn; };
struct Gemm { const void* A; const void* Bt; int M, N, K, pa, pb; };
struct StaticOrder {
    int nM, nN, nwg, G, c;
    __device__ void init(int M, int N, int G_, int c_) { nM = M / BM; nN = N / BM; nwg = nM * nN; G = G_; c = c_; }
    __device__ bool next(int i, Unit& u) const {
        const long L = (long)i * G + c; if (L >= nwg) return false;
        int wgid = (int)L; { const int q = nwg / NXCD, r = nwg % NXCD, xcd = wgid % NXCD, off = wgid / NXCD; wgid = (xcd < r ? xcd * (q + 1) : r * (q + 1) + (xcd - r) * q) + off; }
        const int nig = WGM * nN, gid = wgid / nig, fm = gid * WGM, gsz = (nM - fm) < WGM ? (nM - fm) : WGM;
        u.pm = fm + ((wgid % nig) % gsz); u.pn = (wgid % nig) / gsz; return true;
    }
};
template <class Epi, bool I8 = false>
__device__ __forceinline__ void gemm_phase(LAS unsigned char* lds, const Gemm g, const StaticOrder& S, const Epi& E) {
    const int tid = threadIdx.x, wid = __builtin_amdgcn_readfirstlane(tid >> 6), lane = tid & 63, wr = wid >> 2, wc = wid & 3, fr = lane & 15, fq = lane >> 4;
    const int K = g.K, nt = I8 ? K / (2 * BK) : K / BK;
    unsigned voffA[2], voffB[2];
#pragma unroll
    for (int i = 0; i < 2; ++i) { int R, C; stage_rc(tid * 16 + i * 8192, R, C); const int Rb = (R & ~31) + perm32(R & 31);
        voffA[i] = (unsigned)(R * g.pa + C * 2); voffB[i] = (unsigned)(Rb * g.pb + C * 2); }
    const size_t kstep = (size_t)(BK * 2);
    const size_t hstepA = (size_t)HALF * g.pa, hstepB = (size_t)HALF * g.pb;
    const size_t tstepA = 2 * hstepA, tstepB = 2 * hstepB;
    const unsigned ldsw = (unsigned)wid * 1024u;
    const int aoff = lds_byte(wr * 64 + fr, fq * 8), boff = lds_byte(wc * 32 + fr, fq * 8);
#define PG8_SA(b, h) (((b) * 2 + (h)) * HTB)
#define PG8_SB(b, h) ((4 + (b) * 2 + (h)) * HTB)
#define PG8_STAGE(bufoff, gbase, voff) do { _Pragma("unroll") for (int _i = 0; _i < 2; ++_i) \
        __builtin_amdgcn_global_load_lds((const unsigned*)((const char*)(gbase) + (voff)[_i]), (LAS unsigned*)(lds + (bufoff) + ldsw + _i * 8192), 16, 0, 0); } while (0)
#define PG8_LDA(dst, b, h) do { _Pragma("unroll") for (int m = 0; m < 4; ++m) _Pragma("unroll") for (int k = 0; k < 2; ++k) dst[m][k] = *(const LAS bf16x8*)(lds + PG8_SA(b, h) + aoff + m * 2048 + k * 1024); } while (0)
#define PG8_LDB(dst, b, h) do { _Pragma("unroll") for (int n = 0; n < 2; ++n) _Pragma("unroll") for (int k = 0; k < 2; ++k) dst[n][k] = *(const LAS bf16x8*)(lds + PG8_SB(b, h) + boff + n * 2048 + k * 1024); } while (0)
#define PG8_MMA(ai, bj, At, Bt) do { __builtin_amdgcn_s_setprio(1); _Pragma("unroll") for (int m = 0; m < 4; ++m) _Pragma("unroll") for (int n = 0; n < 2; ++n) _Pragma("unroll") for (int k = 0; k < 2; ++k) \
        { if (I8) acc[ai][bj][m][n] = __builtin_bit_cast(f32x4, __builtin_amdgcn_mfma_i32_16x16x64_i8(__builtin_bit_cast(i32x4, Bt[n][k]), __builtin_bit_cast(i32x4, At[m][k]), __builtin_bit_cast(i32x4, acc[ai][bj][m][n]), 0, 0, 0)); \
          else acc[ai][bj][m][n] = __builtin_amdgcn_mfma_f32_16x16x32_bf16(Bt[n][k], At[m][k], acc[ai][bj][m][n], 0, 0, 0); } __builtin_amdgcn_s_setprio(0); } while (0)
#define PG8_WAIT_V(n) asm volatile("s_waitcnt vmcnt(" #n ")" ::: "memory")
#define PG8_WAIT_L(n) asm volatile("s_waitcnt lgkmcnt(" #n ")" ::: "memory")
#define PG8_BAR __builtin_amdgcn_s_barrier()
#define PG8_SCHED __builtin_amdgcn_sched_barrier(0)
    Unit cur, nxt; int ui = 0;
    if (!S.next(0, cur)) return;
    f32x4 acc[2][2][4][2];
#pragma unroll
    for (int a = 0; a < 2; ++a)
#pragma unroll
        for (int b = 0; b < 2; ++b)
#pragma unroll
            for (int m = 0; m < 4; ++m)
#pragma unroll
                for (int n = 0; n < 2; ++n) acc[a][b][m][n] = (f32x4){0.f, 0.f, 0.f, 0.f};
    bf16x8 At[4][2], B0[2][2], B1[2][2];
    const char* cA = (const char*)g.A + (size_t)cur.pm * tstepA; const char* cB = (const char*)g.Bt + (size_t)cur.pn * tstepB;
    PG8_STAGE(PG8_SB(0, 0), cB, voffB); PG8_STAGE(PG8_SA(0, 0), cA, voffA); PG8_STAGE(PG8_SB(0, 1), cB + hstepB, voffB); PG8_STAGE(PG8_SA(0, 1), cA + hstepA, voffA);
    if (wr == 1) PG8_BAR;
    PG8_WAIT_V(4); PG8_BAR;
    PG8_STAGE(PG8_SB(1, 0), cB + kstep, voffB); PG8_STAGE(PG8_SA(1, 0), cA + kstep, voffA); PG8_STAGE(PG8_SB(1, 1), cB + hstepB + kstep, voffB);
    PG8_WAIT_V(6); PG8_BAR;
    for (;;) {
        const bool has_next = S.next(ui + 1, nxt);
        const char* nA = has_next ? (const char*)g.A + (size_t)nxt.pm * tstepA : cA; const char* nB = has_next ? (const char*)g.Bt + (size_t)nxt.pn * tstepB : cB;
        for (int t = 0; t < nt; t += 2) {
            const bool last = (t == nt - 2);
            const char* a1 = cA + (size_t)(t + 1) * kstep;
            const char* a2 = last ? nA : cA + (size_t)(t + 2) * kstep; const char* b2 = last ? nB : cB + (size_t)(t + 2) * kstep;
            const char* a3 = a2 + kstep; const char* b3 = b2 + kstep;
            PG8_LDB(B0, 0, 0); PG8_SCHED; PG8_LDA(At, 0, 0); PG8_STAGE(PG8_SA(1, 1), a1 + hstepA, voffA);
            PG8_WAIT_L(8); PG8_BAR; PG8_WAIT_L(0); PG8_MMA(0, 0, At, B0); PG8_BAR; PG8_SCHED;
            PG8_LDB(B1, 0, 1); PG8_STAGE(PG8_SB(0, 0), b2, voffB);
            PG8_BAR; PG8_WAIT_L(0); PG8_MMA(0, 1, At, B1); PG8_BAR;
            PG8_LDA(At, 0, 1); PG8_STAGE(PG8_SA(0, 0), a2, voffA);
            PG8_BAR; PG8_WAIT_L(0); PG8_MMA(1, 0, At, B0); PG8_BAR; PG8_SCHED;
            PG8_STAGE(PG8_SB(0, 1), b2 + hstepB, voffB);
            PG8_WAIT_V(6); PG8_BAR; PG8_MMA(1, 1, At, B1); PG8_BAR;
            PG8_LDB(B0, 1, 0); PG8_SCHED; PG8_LDA(At, 1, 0); PG8_STAGE(PG8_SA(0, 1), a2 + hstepA, voffA);
            PG8_WAIT_L(8); PG8_BAR; PG8_WAIT_L(0); PG8_MMA(0, 0, At, B0); PG8_BAR; PG8_SCHED;
            PG8_LDB(B1, 1, 1); PG8_STAGE(PG8_SB(1, 0), b3, voffB);
            PG8_BAR; PG8_WAIT_L(0); PG8_MMA(0, 1, At, B1); PG8_BAR;
            PG8_LDA(At, 1, 1); PG8_STAGE(PG8_SA(1, 0), a3, voffA);
            PG8_BAR; PG8_WAIT_L(0); PG8_MMA(1, 0, At, B0); PG8_BAR; PG8_SCHED;
            PG8_STAGE(PG8_SB(1, 1), b3 + hstepB, voffB);
            PG8_WAIT_V(6); PG8_BAR; PG8_MMA(1, 1, At, B1); PG8_BAR;
        }
        E(acc, cur, wr, wc, fr, fq);
        if (!has_next) break;
#pragma unroll
        for (int a = 0; a < 2; ++a)
#pragma unroll
            for (int b = 0; b < 2; ++b)
#pragma unroll
                for (int m = 0; m < 4; ++m)
#pragma unroll
                    for (int n = 0; n < 2; ++n) acc[a][b][m][n] = (f32x4){0.f, 0.f, 0.f, 0.f};
        cur = nxt; cA = nA; cB = nB; ++ui;
    }
    PG8_WAIT_V(0);
    if (wr == 0) PG8_BAR;
    PG8_BAR;
#undef PG8_SA
#undef PG8_SB
#undef PG8_STAGE
#undef PG8_LDA
#undef PG8_LDB
#undef PG8_MMA
#undef PG8_WAIT_V
#undef PG8_WAIT_L
#undef PG8_BAR
#undef PG8_SCHED
}

struct EpiProj {
    bf16_t* qkv; bf16_t* sg; float qscale; unsigned* kmaxw; const float* hsc; const float* wsc;
    __device__ __forceinline__ void operator()(const f32x4 (&acci)[2][2][4][2], const Unit& u, int wr, int wc, int fr, int fq) const {
        const int row0 = u.pm * BM + wr * 64 + fr;
        f32x4 acc[2][2][4][2];
        { f32x4 cs[2][2];
#pragma unroll
          for (int bj = 0; bj < 2; ++bj)
#pragma unroll
              for (int n = 0; n < 2; ++n) cs[bj][n] = *(const f32x4*)(wsc + u.pn * BM + bj * HALF + wc * 32 + 8 * fq + 4 * n);
#pragma unroll
          for (int ai = 0; ai < 2; ++ai)
#pragma unroll
              for (int m = 0; m < 4; ++m) { const float rsc = hsc[row0 + ai * HALF + m * 16];
#pragma unroll
                  for (int bj = 0; bj < 2; ++bj)
#pragma unroll
                      for (int n = 0; n < 2; ++n) { const i32x4 iv = __builtin_bit_cast(i32x4, acci[ai][bj][m][n]);
                          acc[ai][bj][m][n] = (f32x4){(float)iv[0], (float)iv[1], (float)iv[2], (float)iv[3]} * rsc * cs[bj][n]; } } }
        if (u.pn < 24) {
            const int t = u.pn >> 2; bf16_t* base = qkv + (size_t)t * ((size_t)T_TOK * 1024) + (u.pn & 3) * 256 + wc * 32 + 8 * fq;
            const float sc = (t == 0 || t == 3) ? qscale : 1.f;
            if (t == 4) {
#pragma unroll
                for (int bj = 0; bj < 2; ++bj) { float mxv = 0.f;
#pragma unroll
                    for (int ai = 0; ai < 2; ++ai)
#pragma unroll
                        for (int m = 0; m < 4; ++m) { const f32x4 v0 = acc[ai][bj][m][0], v1 = acc[ai][bj][m][1];
                            float ssq = (v0[0] * v0[0] + v0[1] * v0[1]) + (v0[2] * v0[2] + v0[3] * v0[3]) + (v1[0] * v1[0] + v1[1] * v1[1]) + (v1[2] * v1[2] + v1[3] * v1[3]);
                            ssq += __shfl_xor(ssq, 16); ssq += __shfl_xor(ssq, 32); mxv = fmaxf(mxv, ssq); }
#pragma unroll
                    for (int o = 1; o < 16; o <<= 1) mxv = fmaxf(mxv, __shfl_xor(mxv, o));
                    if ((fr | fq) == 0) atomicMax(kmaxw + ((u.pm >> 4) * 8 + (u.pn & 3) * 2 + bj) * 4 + wc, __builtin_bit_cast(unsigned, mxv)); }
            }
#pragma unroll
            for (int ai = 0; ai < 2; ++ai)
#pragma unroll
                for (int m = 0; m < 4; ++m) { bf16_t* rowp = base + (size_t)(row0 + ai * HALF + m * 16) * 1024;
#pragma unroll
                    for (int bj = 0; bj < 2; ++bj) { const f32x4 v0 = acc[ai][bj][m][0] * sc, v1 = acc[ai][bj][m][1] * sc;
                        u32x4 w; w.x = pk2(v0[0], v0[1]); w.y = pk2(v0[2], v0[3]); w.z = pk2(v1[0], v1[1]); w.w = pk2(v1[2], v1[3]);
                        *(u32x4*)(rowp + bj * HALF) = w; } }
        } else {
            bf16_t* base = sg + (u.pn - 24) * 256 + wc * 32 + 8 * fq;
#pragma unroll
            for (int ai = 0; ai < 2; ++ai)
#pragma unroll
                for (int m = 0; m < 4; ++m) { bf16_t* rowp = base + (size_t)(row0 + ai * HALF + m * 16) * 4096;
#pragma unroll
                    for (int bj = 0; bj < 2; ++bj) { float s[8];
#pragma unroll
                        for (int e = 0; e < 4; ++e) { s[e] = frcp(1.f + fexp2(-LOG2E * acc[ai][bj][m][0][e])); s[4 + e] = frcp(1.f + fexp2(-LOG2E * acc[ai][bj][m][1][e])); }
                        u32x4 w; w.x = pk2(s[0], s[1]); w.y = pk2(s[2], s[3]); w.z = pk2(s[4], s[5]); w.w = pk2(s[6], s[7]);
                        *(u32x4*)(rowp + bj * HALF) = w; } }
        }
    }
};
template <int SECOND> struct EpiGate {
    const bf16_t* sg;
    bf16_t* tmp; bf16_t* merged;
    __device__ __forceinline__ void operator()(const f32x4 (&acc)[2][2][4][2], const Unit& u, int wr, int wc, int fr, int fq) const {
        const int row0 = u.pm * BM + wr * 64 + fr, col0 = u.pn * BM + wc * 32 + 8 * fq;
#pragma unroll
        for (int ai = 0; ai < 2; ++ai)
#pragma unroll
            for (int m = 0; m < 4; ++m) { const size_t row = (size_t)(row0 + ai * HALF + m * 16);
#pragma unroll
                for (int bj = 0; bj < 2; ++bj) { const int col = col0 + bj * HALF;
                    const u32x4 gv = *(const u32x4*)(sg + row * 4096 + col);
                    const f32x4 g0 = {bf_lo(gv.x), bf_hi(gv.x), bf_lo(gv.y), bf_hi(gv.y)}, g1 = {bf_lo(gv.z), bf_hi(gv.z), bf_lo(gv.w), bf_hi(gv.w)};
                    f32x4 v0 = acc[ai][bj][m][0] * g0, v1 = acc[ai][bj][m][1] * g1;
                    bf16_t* tp = tmp + row * DM + col;
                    if (SECOND == 0) { u32x4 w; w.x = pk2(v0[0], v0[1]); w.y = pk2(v0[2], v0[3]); w.z = pk2(v1[0], v1[1]); w.w = pk2(v1[2], v1[3]); *(u32x4*)tp = w; }
                    else { const u32x4 tv = *(const u32x4*)tp; v0 += (f32x4){bf_lo(tv.x), bf_hi(tv.x), bf_lo(tv.y), bf_hi(tv.y)}; v1 += (f32x4){bf_lo(tv.z), bf_hi(tv.z), bf_lo(tv.w), bf_hi(tv.w)};
                        u32x4 w; w.x = pk2(v0[0], v0[1]); w.y = pk2(v0[2], v0[3]); w.z = pk2(v1[0], v1[1]); w.w = pk2(v1[2], v1[3]);
                        *(u32x4*)(merged + row * DM + col) = w; } } }
    }
};
struct EpiResid {
    const float* x; float* x1; bf16_t* x1b; float* rowss;
    __device__ __forceinline__ void operator()(const f32x4 (&acc)[2][2][4][2], const Unit& u, int wr, int wc, int fr, int fq) const {
        const int row0 = u.pm * BM + wr * 64 + fr, col0 = u.pn * BM + wc * 32 + 8 * fq;
#pragma unroll
        for (int ai = 0; ai < 2; ++ai)
#pragma unroll
            for (int m = 0; m < 4; ++m) { const size_t row = (size_t)(row0 + ai * HALF + m * 16); float ss = 0.f;
#pragma unroll
                for (int bj = 0; bj < 2; ++bj) { const size_t o = row * DM + col0 + bj * HALF;
                    const f32x4 v0 = acc[ai][bj][m][0] + *(const f32x4*)(x + o), v1 = acc[ai][bj][m][1] + *(const f32x4*)(x + o + 4);
                    u32x4 w; w.x = pk2(v0[0], v0[1]); w.y = pk2(v0[2], v0[3]); w.z = pk2(v1[0], v1[1]); w.w = pk2(v1[2], v1[3]);
                    *(u32x4*)(x1b + o) = w;
                    ss += (v0[0] * v0[0] + v0[1] * v0[1]) + (v0[2] * v0[2] + v0[3] * v0[3]) + (v1[0] * v1[0] + v1[1] * v1[1]) + (v1[2] * v1[2] + v1[3] * v1[3]); }
                ss += __shfl_xor(ss, 16); ss += __shfl_xor(ss, 32);
                if (fq == 0) atomicAdd(rowss + row, ss); }
    }
};
struct EpiPlainBf16 {
    bf16_t* o;
    __device__ __forceinline__ void operator()(const f32x4 (&acc)[2][2][4][2], const Unit& u, int wr, int wc, int fr, int fq) const {
        const int row0 = u.pm * BM + wr * 64 + fr, col0 = u.pn * BM + wc * 32 + 8 * fq;
#pragma unroll
        for (int ai = 0; ai < 2; ++ai)
#pragma unroll
            for (int m = 0; m < 4; ++m) { const size_t row = (size_t)(row0 + ai * HALF + m * 16);
#pragma unroll
                for (int bj = 0; bj < 2; ++bj) { const f32x4 v0 = acc[ai][bj][m][0], v1 = acc[ai][bj][m][1];
                    u32x4 w; w.x = pk2(v0[0], v0[1]); w.y = pk2(v0[2], v0[3]); w.z = pk2(v1[0], v1[1]); w.w = pk2(v1[2], v1[3]);
                    *(u32x4*)(o + row * DM + col0 + bj * HALF) = w; } }
    }
};
}

__device__ __forceinline__ void transpose_item(const float* W, int ldw, int src_n0, bf16_t* WT, int K, int dst_n0, int k0, LAS float* scr, int lane, const float* kscale) {
#pragma unroll 8
    for (int i = 0; i < 32; ++i) { const int kk = 2 * i + (lane >> 5); float v = W[(size_t)(k0 + kk) * ldw + src_n0 + (lane & 31)]; if (kscale) v *= kscale[k0 + kk]; scr[kk * 33 + (lane & 31)] = v; }
    LDS_WAIT();
    const int c = lane & 7;
#pragma unroll
    for (int j = 0; j < 4; ++j) { const int n = (lane >> 3) + 8 * j; const LAS float* s = scr + (8 * c) * 33 + n;
        u32x4 o; o.x = pk2(s[0 * 33], s[1 * 33]); o.y = pk2(s[2 * 33], s[3 * 33]); o.z = pk2(s[4 * 33], s[5 * 33]); o.w = pk2(s[6 * 33], s[7 * 33]);
        *(u32x4*)(WT + (size_t)(dst_n0 + n) * K + k0 + 8 * c) = o; }
    LDS_WAIT();
}

__device__ __forceinline__ void p0a(const Params& P, LAS unsigned char* lds, int vcu, int G) {
    const int tid = threadIdx.x, lane = tid & 63, wave = __builtin_amdgcn_readfirstlane(tid >> 6);
    const int gw = vcu * NWAVES + wave, NGW = G * NWAVES;
    unsigned char* ws = P.ws;
    {
        unsigned* CMAX = (unsigned*)(ws + WS_CTL + CTL_CMAX);
        constexpr int NCB = (10248 + 255) / 256;
        for (int it = gw; it < 128 * NCB; it += NGW) { const int kb = it / NCB, cb = it % NCB, sc = cb * 256 + 4 * lane;
            if (sc < 10248) { f32x4 v[16];
#pragma unroll
                for (int r = 0; r < 16; ++r) v[r] = *(const f32x4*)(P.w_in + (size_t)(kb * 16 + r) * 10248 + sc);
                float m0 = 0.f, m1 = 0.f, m2 = 0.f, m3 = 0.f;
#pragma unroll
                for (int r = 0; r < 16; ++r) { m0 = fmaxf(m0, fabsf(v[r][0])); m1 = fmaxf(m1, fabsf(v[r][1])); m2 = fmaxf(m2, fabsf(v[r][2])); m3 = fmaxf(m3, fabsf(v[r][3])); }
                const float mm[4] = {m0, m1, m2, m3};
#pragma unroll
                for (int e = 0; e < 4; ++e) { const int c = sc + e; const unsigned mb = __float_as_uint(mm[e]);
                    if (c < 6144) atomicMax(CMAX + c, mb); else if (c >= 6152) atomicMax(CMAX + c - 8, mb); } } }
    }
    {
        LAS float* wf = (LAS float*)lds;
        for (int idx = tid; idx < 2048 * 8; idx += NTHR) { const int k = idx >> 3, c = idx & 7; wf[c * 2048 + k] = P.w_in[(size_t)k * 10248 + 6144 + c]; }
        __syncthreads();
        unsigned char* HQ8 = ws + WS_H; float* HSC = (float*)(ws + WS_HSC); float* LOGF = (float*)(ws + WS_LOGF);
        for (int r = gw; r < T_TOK; r += NGW) {
            const f32x4* xr = (const f32x4*)(P.x + (size_t)r * DM) + lane;
            float ss = 0.f, amx = 0.f; f32x4 hv[8];
#pragma unroll
            for (int j = 0; j < 8; ++j) { const f32x4 v = xr[64 * j]; const f32x4 gn = *((const f32x4*)P.g_mix + lane + 64 * j); ss += (v[0] * v[0] + v[1] * v[1]) + (v[2] * v[2] + v[3] * v[3]);
                hv[j] = v * gn; amx = fmaxf(amx, fmaxf(fmaxf(fabsf(hv[j][0]), fabsf(hv[j][1])), fmaxf(fabsf(hv[j][2]), fabsf(hv[j][3])))); }
            const float rstd = 1.0f / sqrtf(wave_sum(ss) * (1.f / DM) + EPS);
#pragma unroll
            for (int o = 1; o < 64; o <<= 1) amx = fmaxf(amx, __shfl_xor(amx, o));
            const float hmax = fmaxf(amx * rstd, 1e-30f), hinv = 127.f / hmax;
            float fl[8];
#pragma unroll
            for (int c = 0; c < 8; ++c) fl[c] = 0.f;
            unsigned* hp = (unsigned*)(HQ8 + (size_t)r * DM) + lane;
#pragma unroll
            for (int j = 0; j < 8; ++j) { const f32x4 h = hv[j] * rstd;
                unsigned w = 0;
#pragma unroll
                for (int e = 0; e < 4; ++e) w |= ((unsigned)(int)__builtin_rintf(h[e] * hinv) & 255u) << (8 * e);
                hp[64 * j] = w;
#pragma unroll
                for (int c = 0; c < 8; ++c) { const f32x4 wv = *((const LAS f32x4*)(wf + c * 2048) + lane + 64 * j); fl[c] += (h[0] * wv[0] + h[1] * wv[1]) + (h[2] * wv[2] + h[3] * wv[3]); }
                __builtin_amdgcn_sched_barrier(0); }
#pragma unroll
            for (int c = 0; c < 8; ++c) fl[c] = wave_sum(fl[c]);
            if (lane == 0) { HSC[r] = hmax * (1.f / 127.f);
#pragma unroll
                for (int c = 0; c < 8; ++c) { const float y = fl[c] + P.b_forget[c]; LOGF[(size_t)r * 8 + c] = fminf(y, 0.f) - log1pf(expf(-fabsf(y))); }
            }
        }
    }
    {
        const size_t gid = (size_t)vcu * NTHR + tid, gstride = (size_t)G * NTHR;
        for (size_t i = gid; i < 262144 / 8; i += gstride) { const float* src = P.sub_keys + i * 8; const f32x4 a = *(const f32x4*)src, b = *((const f32x4*)src + 1);
            u32x4 o; o.x = pk2(a[0], a[1]); o.y = pk2(a[2], a[3]); o.z = pk2(b[0], b[1]); o.w = pk2(b[2], b[3]); *(u32x4*)((bf16_t*)(ws + WS_SKB) + i * 8) = o; }
    }
}
__device__ __forceinline__ void p0b(const Params& P, LAS unsigned char* lds, int vcu, int G) {
    const int tid = threadIdx.x, lane = tid & 63, wave = __builtin_amdgcn_readfirstlane(tid >> 6);
    const int gw = vcu * NWAVES + wave, NGW = G * NWAVES;
    unsigned char* ws = P.ws;
    const unsigned* CMAX = (const unsigned*)(ws + WS_CTL + CTL_CMAX); float* WSC = (float*)(ws + WS_WSC); unsigned char* WT8 = ws + WS_WIN;
    LAS float* scr = (LAS float*)(lds + wave * 16384);
    for (int it = gw; it < 32 * 320; it += NGW) {
        const int nb = it >> 5, kb = it & 31, dn = nb * 32, sn = dn < 6144 ? dn : dn + 8, k0 = kb * 64;
        const int c4 = (lane & 7) * 4;
        float inv[4];
#pragma unroll
        for (int e = 0; e < 4; ++e) { const float cm = fmaxf(__uint_as_float(__hip_atomic_load(CMAX + dn + c4 + e, __ATOMIC_RELAXED, __HIP_MEMORY_SCOPE_AGENT)), 1e-30f); inv[e] = 127.f / cm;
            if (kb == 0 && lane < 8) WSC[dn + c4 + e] = cm * (1.f / 127.f); }
        f32x4 v[8];
#pragma unroll
        for (int i = 0; i < 8; ++i) v[i] = *(const f32x4*)(P.w_in + (size_t)(k0 + 8 * i + (lane >> 3)) * 10248 + sn + c4);
#pragma unroll
        for (int i = 0; i < 8; ++i) { LAS float* sp = scr + (8 * i + (lane >> 3)) * 33 + c4; sp[0] = v[i][0] * inv[0]; sp[1] = v[i][1] * inv[1]; sp[2] = v[i][2] * inv[2]; sp[3] = v[i][3] * inv[3]; }
        LDS_WAIT();
        const int c = lane & 3;
#pragma unroll
        for (int j = 0; j < 2; ++j) { const int n = (lane >> 2) + 16 * j; const LAS float* sp = scr + (16 * c) * 33 + n;
            u32x4 o;
#pragma unroll
            for (int w4 = 0; w4 < 4; ++w4) { unsigned w = 0;
#pragma unroll
                for (int e = 0; e < 4; ++e) w |= ((unsigned)(int)fminf(fmaxf(__builtin_rintf(sp[(4 * w4 + e) * 33]), -127.f), 127.f) & 255u) << (8 * e);
                o[w4] = w; }
            *(u32x4*)(WT8 + (size_t)(dn + n) * 2048 + k0 + 16 * c) = o; }
        LDS_WAIT();
    }
}
__device__ __forceinline__ void late_transposes(const Params& P, LAS unsigned char* lds, int vcu, int G) {
    const int tid = threadIdx.x, lane = tid & 63, wave = __builtin_amdgcn_readfirstlane(tid >> 6);
    const int gw = vcu * NWAVES + wave, NGW = G * NWAVES;
    unsigned char* ws = P.ws;
    LAS float* scr = (LAS float*)(lds + wave * 16384);
    constexpr int I_A = 16 * 64, I_O = 32 * 64, NITEMS = 2 * I_A + 2 * I_O;
    for (int it = gw; it < NITEMS; it += NGW) {
        int r = it;
        if (r < I_A) { const int kb = r / 64, nb = r % 64; transpose_item(P.w_a, 2048, nb * 32, (bf16_t*)(ws + WS_WAT), 1024, nb * 32, kb * 64, scr, lane, nullptr); continue; } r -= I_A;
        if (r < I_A) { const int kb = r / 64, nb = r % 64; transpose_item(P.w_b, 2048, nb * 32, (bf16_t*)(ws + WS_WBT), 1024, nb * 32, kb * 64, scr, lane, nullptr); continue; } r -= I_A;
        if (r < I_O) { const int kb = r / 64, nb = r % 64; transpose_item(P.w_out, 2048, nb * 32, (bf16_t*)(ws + WS_WOUT), 2048, nb * 32, kb * 64, scr, lane, nullptr); continue; } r -= I_O;
        { const int kb = r / 64, nb = r % 64; transpose_item(P.w_query, 2048, nb * 32, (bf16_t*)(ws + WS_WQ), 2048, nb * 32, kb * 64, scr, lane, P.g_ffn); }
    }
}
__device__ __forceinline__ void quantise_expert_rows(const Params& P, int r0, int nrows) {
    const int lane = threadIdx.x & 63;
    unsigned char* ws = P.ws;
    float* SU = (float*)(ws + WS_SU); float* SV = (float*)(ws + WS_SV);
    for (int r = r0; r < r0 + nrows; ++r) {
        const bool second = r >= 16384; const int row = second ? r - 16384 : r;
        const f32x4* src = (const f32x4*)((second ? P.e_v : P.e_u) + (size_t)row * DM) + lane;
        f32x4 v[8]; float mx = 0.f;
#pragma unroll
        for (int j = 0; j < 8; ++j) { v[j] = __builtin_nontemporal_load(src + 64 * j); mx = fmaxf(mx, fmaxf(fmaxf(fabsf(v[j][0]), fabsf(v[j][1])), fmaxf(fabsf(v[j][2]), fabsf(v[j][3])))); }
#pragma unroll
        for (int o = 1; o < 64; o <<= 1) mx = fmaxf(mx, __shfl_xor(mx, o));
        mx = fmaxf(mx, 1e-30f);
        const float inv = 127.f / mx; const int bias = second ? 128 : 0;
        unsigned* dst = (unsigned*)(ws + (second ? WS_EV : WS_EU) + (size_t)row * DM) + lane;
#pragma unroll
        for (int j = 0; j < 8; ++j) { unsigned w = 0;
#pragma unroll
            for (int e = 0; e < 4; ++e) { const int q = (int)__builtin_rintf(v[j][e] * inv) + bias; w |= ((unsigned)q & 255u) << (8 * e); }
            dst[64 * j] = w; }
        if (lane == 0) (second ? SV : SU)[row] = mx * (1.f / 127.f);
    }
}

namespace att {
constexpr int KST = 272, VST = 320;
constexpr int KBUF = 64 * KST, VBUF = 64 * VST;
constexpr int OFF_K = 0, OFF_V = 2 * KBUF, OFF_F = OFF_V + 2 * VBUF, OFF_SC = OFF_F + 4096 * 4;
constexpr int OFF_FLG = OFF_SC + 64, OFF_UNIT = OFF_FLG + 64;
static_assert(OFF_UNIT + 16 <= 131072, "attention LDS");
constexpr float THR_SB = 40.f, THR_FOX = 30.f;

__device__ __forceinline__ void build_cumf(LAS unsigned char* lds, const float* LOGF, int b, int h, int n, int tid, int lane, int wid) {
    LAS float* F2 = (LAS float*)(lds + OFF_F); LAS float* sc = (LAS float*)(lds + OFF_SC);
    const int s0 = tid * 8; float v[8];
#pragma unroll
    for (int i = 0; i < 8; ++i) v[i] = (s0 < n) ? LOGF[((size_t)b * SEQ + s0 + i) * 8 + h] * LOG2E : 0.f;
#pragma unroll
    for (int i = 1; i < 8; ++i) v[i] += v[i - 1];
    float tot = v[7], inc = tot;
#pragma unroll
    for (int o = 1; o < 64; o <<= 1) { const float t = __shfl_up(inc, o); if (lane >= o) inc += t; }
    if (lane == 63) sc[wid] = inc;
    __syncthreads();
    float base = inc - tot;
#pragma unroll
    for (int w = 0; w < 8; ++w) if (w < wid) base += sc[w];
    if (s0 < n) {
#pragma unroll
        for (int i = 0; i < 8; ++i) F2[s0 + i] = v[i] + base;
    }
    __syncthreads();
}

template <int MIXER>
__device__ __forceinline__ void attn_unit(LAS unsigned char* lds, const bf16_t* Q, const bf16_t* Kg, const bf16_t* Vg, bf16_t* O, int b, int h, int qb, float kmax, int tid, int lane, int wid) {
    const int c = lane & 31, hh = lane >> 5;
    const int t0 = qb * 256 + wid * 32, tq = t0 + c;
    const size_t rowbase = (size_t)b * SEQ;
    size_t qoff = (rowbase + tq) * 1024 + h * HD + 8 * hh;
    f32x16 oacc[4];
#pragma unroll
    for (int d = 0; d < 4; ++d)
#pragma unroll
        for (int r = 0; r < 16; ++r) oacc[d][r] = 0.f;
    float carry = 0.f, mrun = -1e30f, lsum = 0.f; const float nhf = hh ? 0.f : 1.f;
    const LAS float* F2 = (const LAS float*)(lds + OFF_F);
    const float Ft = (MIXER == 1) ? F2[tq] : 0.f;
    float qk_bound = 0.f;
    if (MIXER == 1) { float qs = 0.f;
#pragma unroll
        for (int s2 = 0; s2 < 8; ++s2) { const u32x4 qv = *(const u32x4*)(Q + qoff + 16 * s2);
#pragma unroll
            for (int e = 0; e < 4; ++e) { const float a = bf_lo(qv[e]), b2 = bf_hi(qv[e]); qs += a * a + b2 * b2; } }
        qs += __shfl_xor(qs, 32);
        qk_bound = sqrtf(qs) * kmax; }
    bool wave_done = false;
    volatile LAS unsigned* flg = (volatile LAS unsigned*)(lds + OFF_FLG);
    const int ktmax = 4 * qb + 3;
    const int srow = tid >> 4, scc = tid & 15;
    u32x4 kr[2], vr[2];
#define ATT_LOAD(kt) do { _Pragma("unroll") for (int j = 0; j < 2; ++j) { const size_t g_ = (rowbase + 64 * (kt) + srow + 32 * j) * 1024 + h * HD + scc * 8; \
        kr[j] = *(const u32x4*)(Kg + g_); vr[j] = *(const u32x4*)(Vg + g_); } } while (0)
#define ATT_WRITE(buf) do { _Pragma("unroll") for (int j = 0; j < 2; ++j) { \
        *(LAS u32x4*)(lds + OFF_K + (buf) * KBUF + (srow + 32 * j) * KST + scc * 16) = kr[j]; \
        *(LAS u32x4*)(lds + OFF_V + (buf) * VBUF + (srow + 32 * j) * VST + scc * 16) = vr[j]; } } while (0)
    ATT_LOAD(ktmax); ATT_WRITE(0); __syncthreads();
    int buf = 0;
    for (int kt = ktmax; kt >= 0; --kt) {
        if (kt > 0) ATT_LOAD(kt - 1);
        const bool started = (64 * kt <= t0 + 31);
        if (started && !wave_done) {
            const LAS unsigned char* Kl = lds + OFF_K + buf * KBUF; const LAS unsigned char* Vl = lds + OFF_V + buf * VBUF;
            f32x16 sacc[2];
            asm volatile("" : "+v"(qoff));
            bf16x8 qf[8];
#pragma unroll
            for (int s = 0; s < 8; ++s) qf[s] = *(const bf16x8*)(Q + qoff + 16 * s);
#pragma unroll
            for (int sub = 0; sub < 2; ++sub) {
#pragma unroll
                for (int r = 0; r < 16; ++r) sacc[sub][r] = 0.f;
#pragma unroll
                for (int s = 0; s < 8; ++s) { const bf16x8 kf = *(const LAS bf16x8*)(Kl + (32 * sub + c) * KST + (16 * s + 8 * hh) * 2);
                    sacc[sub] = __builtin_amdgcn_mfma_f32_32x32x16_bf16(kf, qf[s], sacc[sub], 0, 0, 0); }
            }
            const bool need_mask = (64 * kt + 63 >= t0);
            if (MIXER == 0) {
#pragma unroll
                for (int sub = 1; sub >= 0; --sub) {
                    float lb[16];
#pragma unroll
                    for (int r = 0; r < 16; ++r) { const float z = sacc[sub][r]; float l = -flog2(1.f + fexp2(z));
                        if (need_mask) { const int sidx = 64 * kt + 32 * sub + (r & 3) + 8 * (r >> 2) + 4 * hh; l = (sidx < tq) ? l : 0.f; }
                        lb[r] = l; }
                    float Glo[4], Ghi[4];
#pragma unroll
                    for (int g = 0; g < 4; ++g) { lb[4 * g + 2] += lb[4 * g + 3]; lb[4 * g + 1] += lb[4 * g + 2]; lb[4 * g] += lb[4 * g + 1];
                        const unsigned gu = __builtin_bit_cast(unsigned, lb[4 * g]); const auto rr = __builtin_amdgcn_permlane32_swap(gu, gu, false, false);
                        Glo[g] = __builtin_bit_cast(float, (unsigned)rr[0]); Ghi[g] = __builtin_bit_cast(float, (unsigned)rr[1]); }
                    float E[8];
                    E[7] = carry; E[6] = E[7] + Ghi[3]; E[5] = E[6] + Glo[3]; E[4] = E[5] + Ghi[2]; E[3] = E[4] + Glo[2]; E[2] = E[3] + Ghi[1]; E[1] = E[2] + Glo[1]; E[0] = E[1] + Ghi[0];
                    carry = E[0] + Glo[0];
#pragma unroll
                    for (int g = 0; g < 4; ++g) { const float Eo = __builtin_fmaf(nhf, Ghi[g], E[2 * g + 1]);
#pragma unroll
                        for (int i = 0; i < 4; ++i) { const int r = 4 * g + i; float w = fexp2(sacc[sub][r] + lb[r] + Eo);
                            if (need_mask) { const int sidx = 64 * kt + 32 * sub + (r & 3) + 8 * (r >> 2) + 4 * hh; w = (sidx < tq) ? w : 0.f; }
                            sacc[sub][r] = w; } }
                }
            } else {
                float mx = -1e30f;
#pragma unroll
                for (int sub = 0; sub < 2; ++sub)
#pragma unroll
                    for (int g = 0; g < 4; ++g) { const f32x4 fs = *(const LAS f32x4*)(F2 + 64 * kt + 32 * sub + 8 * g + 4 * hh);
#pragma unroll
                        for (int i = 0; i < 4; ++i) { const int r = 4 * g + i; float xv = sacc[sub][r] + (Ft - fs[i]);
                            if (need_mask) { const int sidx = 64 * kt + 32 * sub + 8 * g + 4 * hh + i; xv = (sidx <= tq) ? xv : -1e30f; }
                            sacc[sub][r] = xv; mx = fmaxf(mx, xv); } }
                { const unsigned mu = __builtin_bit_cast(unsigned, mx); const auto rr = __builtin_amdgcn_permlane32_swap(mu, mu, false, false);
                  mx = fmaxf(__builtin_bit_cast(float, (unsigned)rr[0]), __builtin_bit_cast(float, (unsigned)rr[1])); }
                const float mnew = fmaxf(mrun, mx);
                const float alpha = fexp2(mrun - mnew);
                float ps = 0.f;
#pragma unroll
                for (int sub = 0; sub < 2; ++sub)
#pragma unroll
                    for (int r = 0; r < 16; ++r) { const float p = fexp2(sacc[sub][r] - mnew); sacc[sub][r] = p; ps += p; }
                lsum = lsum * alpha + ps;
                if (__any(mnew > mrun)) {
#pragma unroll
                    for (int d = 0; d < 4; ++d)
#pragma unroll
                        for (int r = 0; r < 16; ++r) oacc[d][r] *= alpha;
                }
                mrun = mnew;
            }
#pragma unroll
            for (int ks = 0; ks < 4; ++ks) { const int sub = ks >> 1, rb = 8 * (ks & 1);
                u32x4 pw; pw.x = pk2(sacc[sub][rb + 0], sacc[sub][rb + 1]); pw.y = pk2(sacc[sub][rb + 2], sacc[sub][rb + 3]); pw.z = pk2(sacc[sub][rb + 4], sacc[sub][rb + 5]); pw.w = pk2(sacc[sub][rb + 6], sacc[sub][rb + 7]);
                const bf16x8 pf = __builtin_bit_cast(bf16x8, pw);
                const LAS unsigned char* vb = Vl + (16 * ks + 4 * hh + ((lane & 15) >> 2)) * VST + (16 * ((lane >> 4) & 1) + 4 * (lane & 3)) * 2;
#pragma unroll
                for (int d = 0; d < 4; ++d) {
                    const s16x4 a0 = __builtin_amdgcn_ds_read_tr16_b64_v4i16((LAS s16x4*)(vb + d * 64));
                    const s16x4 a1 = __builtin_amdgcn_ds_read_tr16_b64_v4i16((LAS s16x4*)(vb + d * 64 + 8 * VST));
                    const bf16x8 af = {a0[0], a0[1], a0[2], a0[3], a1[0], a1[1], a1[2], a1[3]};
                    oacc[d] = __builtin_amdgcn_mfma_f32_32x32x16_bf16(af, pf, oacc[d], 0, 0, 0); }
            }
        }
        if (kt > 0) ATT_WRITE(buf ^ 1);
        if (kt > 0 && started && !wave_done) {
            if (MIXER == 0) wave_done = __all(carry < -THR_SB);
            else wave_done = __all(qk_bound + (Ft - F2[64 * kt - 1]) - mrun < -THR_FOX);
        }
        if (lane == 0) flg[(kt & 1) * 8 + wid] = wave_done ? 1u : 0u;
        __syncthreads();
        buf ^= 1;
        { unsigned alld = 1u;
#pragma unroll
          for (int w = 0; w < 8; ++w) alld &= flg[(kt & 1) * 8 + w];
          if (alld) break; }
    }
#undef ATT_LOAD
#undef ATT_WRITE
    float inv = 1.f;
    if (MIXER == 1) { const unsigned lu = __builtin_bit_cast(unsigned, lsum); const auto rr = __builtin_amdgcn_permlane32_swap(lu, lu, false, false);
        inv = 1.f / (__builtin_bit_cast(float, (unsigned)rr[0]) + __builtin_bit_cast(float, (unsigned)rr[1])); }
    bf16_t* op = O + (rowbase + tq) * 2048 + 4 * hh;
#pragma unroll
    for (int d = 0; d < 4; ++d)
#pragma unroll
        for (int g = 0; g < 4; ++g) { u32x2 w; w.x = pk2(oacc[d][4 * g] * inv, oacc[d][4 * g + 1] * inv); w.y = pk2(oacc[d][4 * g + 2] * inv, oacc[d][4 * g + 3] * inv);
            *(u32x2*)(op + 32 * d + 8 * g) = w; }
}

__device__ __forceinline__ void attn_phase(const Params& P, LAS unsigned char* lds, int vcu, int G) {
    const int tid = threadIdx.x, lane = tid & 63, wid = __builtin_amdgcn_readfirstlane(tid >> 6);
    unsigned char* ws = P.ws;
    const bf16_t* QKV = (const bf16_t*)(ws + WS_QKV); const size_t TS = (size_t)T_TOK * 1024;
    bf16_t* OAB = (bf16_t*)(ws + WS_H); const float* LOGF = (const float*)(ws + WS_LOGF);
    unsigned* qctr = (unsigned*)(ws + WS_CTL + 196608);
    const unsigned* KMAXW = (const unsigned*)(ws + WS_CTL + 200704);
    volatile LAS unsigned* uw = (volatile LAS unsigned*)(lds + OFF_UNIT);
    for (;;) {
        if (tid == 0) uw[0] = atomicAdd(qctr, 1u);
        __syncthreads();
        const unsigned u = uw[0];
        __syncthreads();
        if (u >= 1024u) break;
        if (u >= 512u) { quantise_expert_rows(P, (int)(u - 512u) * 64 + wid * 8, 8); continue; }
        const int mixer = (u < 256u) ? 1 : 0, v = (int)(u & 255u), qb = 15 - (v >> 4), bh = v & 15, b = bh >> 3, h = bh & 7;
        if (mixer == 0) {
            attn_unit<0>(lds, QKV, QKV + TS, QKV + 2 * TS, OAB + h * HD, b, h, qb, 0.f, tid, lane, wid);
        } else {
            float k2 = 0.f;
#pragma unroll
            for (int w = 0; w < 4; ++w) k2 += __builtin_bit_cast(float, __hip_atomic_load(KMAXW + bh * 4 + w, __ATOMIC_RELAXED, __HIP_MEMORY_SCOPE_AGENT));
            const float kmax = sqrtf(k2) * 1.01f;
            build_cumf(lds, LOGF, b, h, 256 * (qb + 1), tid, lane, wid);
            attn_unit<1>(lds, QKV + 3 * TS, QKV + 4 * TS, QKV + 5 * TS, OAB + 1024 + h * HD, b, h, qb, kmax, tid, lane, wid);
        }
        __syncthreads();
    }
}
}

namespace peer {
__device__ __forceinline__ unsigned sortable(float f) { const unsigned u = __builtin_bit_cast(unsigned, f); return (u & 0x80000000u) ? ~u : (u | 0x80000000u); }
__device__ __forceinline__ float unsortable(unsigned k) { const unsigned u = (k & 0x80000000u) ? (k & 0x7fffffffu) : ~k; return __builtin_bit_cast(float, u); }
#define CE_DESC(x, y) do { const unsigned hi_ = (x) > (y) ? (x) : (y); const unsigned lo_ = (x) > (y) ? (y) : (x); (x) = hi_; (y) = lo_; } while (0)
template <int B, int N> __device__ __forceinline__ void sort16_desc(unsigned (&a)[N]) {
#pragma unroll
    for (int k = 2; k <= 16; k <<= 1)
#pragma unroll
        for (int j = k >> 1; j > 0; j >>= 1)
#pragma unroll
            for (int i = 0; i < 16; ++i) { const int l = i ^ j; if (l > i) { if ((i & k) == 0) CE_DESC(a[B + i], a[B + l]); else CE_DESC(a[B + l], a[B + i]); } }
}
template <int A, int Bq, int N> __device__ __forceinline__ void merge_top16(unsigned (&a)[N]) {
#pragma unroll
    for (int i = 0; i < 16; ++i) { const unsigned x = a[A + i], y = a[Bq + 15 - i]; a[A + i] = x > y ? x : y; }
#pragma unroll
    for (int j = 8; j > 0; j >>= 1)
#pragma unroll
        for (int i = 0; i < 16; ++i) { const int l = i ^ j; if (l > i) CE_DESC(a[A + i], a[A + l]); }
}

__device__ __forceinline__ void topk_phase(const Params& P, LAS unsigned char* lds, int vcu, int G) {
    const int tid = threadIdx.x, lane = tid & 63, wave = __builtin_amdgcn_readfirstlane(tid >> 6);
    const int c = lane & 31, hh = lane >> 5;
    const int gw = vcu * NWAVES + wave, NGW = G * NWAVES;
    unsigned char* ws = P.ws;
    const bf16_t* Q2 = (const bf16_t*)(ws + WS_Q2); const bf16_t* SKB = (const bf16_t*)(ws + WS_SKB);
    const float* ROWSS = (const float*)(ws + WS_CTL); int* IDS = (int*)(ws + WS_IDS); float* GATES = (float*)(ws + WS_GATES);
    LAS unsigned char* scr = lds + wave * 4096;
    for (int task = gw; task < 2048; task += NGW) {
        const int tg = task >> 3, hd = task & 7, tok = tg * 32 + c;
#pragma unroll 1
        for (int p = 0; p < 2; ++p) {
            bf16x8 qf[8];
            { const bf16_t* qp = Q2 + (size_t)tok * DM + hd * 256 + p * 128 + 8 * hh;
#pragma unroll
              for (int s = 0; s < 8; ++s) qf[s] = *(const bf16x8*)(qp + 16 * s); }
            unsigned keys[64];
#pragma unroll
            for (int sub = 0; sub < 4; ++sub) {
                f32x16 acc;
#pragma unroll
                for (int r = 0; r < 16; ++r) acc[r] = 0.f;
                const bf16_t* kp = SKB + ((size_t)(hd * 2 + p) * 128 + 32 * sub + c) * 128 + 8 * hh;
#pragma unroll
                for (int s = 0; s < 8; ++s) { const bf16x8 kf = *(const bf16x8*)(kp + 16 * s); acc = __builtin_amdgcn_mfma_f32_32x32x16_bf16(kf, qf[s], acc, 0, 0, 0); }
#pragma unroll
                for (int r = 0; r < 16; ++r) { const int nlo = 127 - (32 * sub + (r & 3) + 8 * (r >> 2)); keys[sub * 16 + r] = (sortable(acc[r]) & ~127u) | (unsigned)(nlo - 4 * hh); }
            }
            sort16_desc<0>(keys); sort16_desc<16>(keys); sort16_desc<32>(keys); sort16_desc<48>(keys);
            merge_top16<0, 16>(keys); merge_top16<32, 48>(keys); merge_top16<0, 32>(keys);
#pragma unroll
            for (int i = 0; i < 16; ++i) { const unsigned own = keys[i]; const auto rr = __builtin_amdgcn_permlane32_swap(own, own, false, false); keys[16 + i] = hh ? (unsigned)rr[0] : (unsigned)rr[1]; }
            merge_top16<0, 16>(keys);
            if (hh == 0) {
#pragma unroll
                for (int w = 0; w < 4; ++w) *(LAS u32x4*)(scr + (c * 2 + p) * 64 + w * 16) = (u32x4){keys[4 * w], keys[4 * w + 1], keys[4 * w + 2], keys[4 * w + 3]};
            }
        }
        LDS_WAIT();
        float s1[16], s2[16];
#pragma unroll
        for (int w = 0; w < 4; ++w) { const u32x4 a = *(const LAS u32x4*)(scr + (c * 2) * 64 + w * 16), b2 = *(const LAS u32x4*)(scr + (c * 2 + 1) * 64 + w * 16);
#pragma unroll
            for (int e = 0; e < 4; ++e) { s1[4 * w + e] = unsortable((a[e] & ~127u) | 64u); s2[4 * w + e] = unsortable((b2[e] & ~127u) | 64u); } }
        unsigned ck[64];
        { int n = 0;
#pragma unroll
          for (int i = 0; i < 16; ++i)
#pragma unroll
              for (int j = 0; j < 16; ++j) if ((i + 1) * (j + 1) <= 16) { ck[n] = (sortable(s1[i] + s2[j]) & ~255u) | (unsigned)(255 - (i * 16 + j)); ++n; }
#pragma unroll
          for (int q = 50; q < 64; ++q) ck[q] = 0u; }
        sort16_desc<0>(ck); sort16_desc<16>(ck); sort16_desc<32>(ck); sort16_desc<48>(ck);
        merge_top16<0, 16>(ck); merge_top16<32, 48>(ck); merge_top16<0, 32>(ck);
        unsigned t2[16];
#pragma unroll
        for (int k = 0; k < 16; ++k) t2[k] = ck[k];
        int ids[16]; float sc[16];
#pragma unroll
        for (int k = 0; k < 16; ++k) { const unsigned pos = 255u - (t2[k] & 255u);
            const unsigned k1 = *(const LAS unsigned*)(scr + (c * 2) * 64 + (pos >> 4) * 4), k2 = *(const LAS unsigned*)(scr + (c * 2 + 1) * 64 + (pos & 15u) * 4);
            ids[k] = (int)((127u - (k1 & 127u)) * 128u + (127u - (k2 & 127u))); sc[k] = unsortable((t2[k] & ~255u) | 128u); }
        LDS_WAIT();
        const float rs = 1.0f / sqrtf(ROWSS[tok] * (1.f / DM) + EPS);
        float ev[16], Z = 0.f;
#pragma unroll
        for (int k = 0; k < 16; ++k) { ev[k] = fexp2((sc[k] - sc[0]) * rs * LOG2E); Z += ev[k]; }
        const float iz = 1.f / Z;
        int* ip = IDS + (size_t)tok * 128 + hd * 16; float* gp = GATES + (size_t)tok * 128 + hd * 16;
        if (hh == 0) {
#pragma unroll
            for (int k = 0; k < 8; ++k) { ip[k] = ids[k]; gp[k] = ev[k] * iz; }
        } else {
#pragma unroll
            for (int k = 8; k < 16; ++k) { ip[k] = ids[k]; gp[k] = ev[k] * iz; }
        }
    }
}


__device__ __forceinline__ float dot8(u32x4 a, u32x4 b, float acc) {
    const unsigned a0 = a[0], a1 = a[1], a2 = a[2], a3 = a[3], b0 = b[0], b1 = b[1], b2 = b[2], b3 = b[3];
    acc = __builtin_amdgcn_fdot2_f32_bf16(__builtin_bit_cast(bf16v2, a0), __builtin_bit_cast(bf16v2, b0), acc, false);
    acc = __builtin_amdgcn_fdot2_f32_bf16(__builtin_bit_cast(bf16v2, a1), __builtin_bit_cast(bf16v2, b1), acc, false);
    acc = __builtin_amdgcn_fdot2_f32_bf16(__builtin_bit_cast(bf16v2, a2), __builtin_bit_cast(bf16v2, b2), acc, false);
    acc = __builtin_amdgcn_fdot2_f32_bf16(__builtin_bit_cast(bf16v2, a3), __builtin_bit_cast(bf16v2, b3), acc, false);
    return acc;
}
__device__ __forceinline__ float gelu_tanh(float a) { const float t = 1.5957691216f * (a + 0.044715f * a * a * a); return a * frcp(1.f + fexp2(-LOG2E * t)); }

__device__ __forceinline__ int dot16(u32x4 a, u32x4 b, int acc) {
    acc = __builtin_amdgcn_sdot4((int)a[0], (int)b[0], acc, false); acc = __builtin_amdgcn_sdot4((int)a[1], (int)b[1], acc, false);
    acc = __builtin_amdgcn_sdot4((int)a[2], (int)b[2], acc, false); acc = __builtin_amdgcn_sdot4((int)a[3], (int)b[3], acc, false);
    return acc;
}
__device__ __forceinline__ void gather_sweep(const Params& P, LAS unsigned char* lds, int vcu, int G) {
    const int tid = threadIdx.x, lane = tid & 63, wave = __builtin_amdgcn_readfirstlane(tid >> 6);
    const int gw = vcu * NWAVES + wave, NGW = G * NWAVES;
    const int g = lane >> 3, i = lane & 7;
    unsigned char* ws = P.ws;
    const bf16_t* X1B = (const bf16_t*)(ws + WS_X1B); const float* ROWSS = (const float*)(ws + WS_CTL);
    const int* IDS = (const int*)(ws + WS_IDS); const float* GATES = (const float*)(ws + WS_GATES);
    const unsigned char* EU = ws + WS_EU; const unsigned char* EV = ws + WS_EV;
    const float* SU = (const float*)(ws + WS_SU); const float* SV = (const float*)(ws + WS_SV);
    LAS unsigned char* wl = lds + wave * 16384;
    const bool b2 = (lane >> 2) & 1, b1 = (lane >> 1) & 1, b0 = lane & 1, B2 = (lane >> 5) & 1, B1 = (lane >> 4) & 1, B0 = (lane >> 3) & 1;
    for (int tg = gw; tg < T_TOK / 4; tg += NGW) {
        const int tok0 = tg * 4;
        float hs[4];
#pragma unroll
        for (int j = 0; j < 4; ++j) { const int tok = tok0 + j;
            const float rs = 1.0f / sqrtf(ROWSS[tok] * (1.f / DM) + EPS);
            f32x4 hv[8]; float hmx = 0.f;
#pragma unroll
            for (int q = 0; q < 8; ++q) { const u32x2 xb = *((const u32x2*)(X1B + (size_t)tok * DM) + lane + 64 * q); const f32x4 xv = {bf_lo(xb[0]), bf_hi(xb[0]), bf_lo(xb[1]), bf_hi(xb[1])}; const f32x4 gn = *((const f32x4*)P.g_ffn + lane + 64 * q);
                hv[q] = xv * rs * gn; hmx = fmaxf(hmx, fmaxf(fmaxf(fabsf(hv[q][0]), fabsf(hv[q][1])), fmaxf(fabsf(hv[q][2]), fabsf(hv[q][3])))); }
#pragma unroll
            for (int o = 1; o < 64; o <<= 1) hmx = fmaxf(hmx, __shfl_xor(hmx, o));
            hmx = fmaxf(hmx, 1e-30f); const float hinv = 127.f / hmx; hs[j] = hmx * (1.f / 127.f);
#pragma unroll
            for (int q = 0; q < 8; ++q) { unsigned w = 0;
#pragma unroll
                for (int e = 0; e < 4; ++e) w |= ((unsigned)(int)__builtin_rintf(hv[q][e] * hinv) & 255u) << (8 * e);
                *(LAS unsigned*)(wl + j * 2048 + 4 * (lane + 64 * q)) = w; }
#pragma unroll
            for (int hf = 0; hf < 2; ++hf) { const int k = lane + 64 * hf; const int id = IDS[(size_t)tok * 128 + k];
                *(LAS unsigned*)(wl + 8192 + (j * 128 + k) * 4) = (unsigned)id * 2048u;
                *(LAS float*)(wl + 10240 + (j * 128 + k) * 4) = GATES[(size_t)tok * 128 + k] * SV[id];
                *(LAS float*)(wl + 12288 + (j * 128 + k) * 4) = SU[id]; }
        }
        LDS_WAIT();
        int accu[4][16];
#pragma unroll
        for (int j = 0; j < 4; ++j)
#pragma unroll
            for (int m = 0; m < 16; ++m) accu[j][m] = 0;
#pragma unroll 1
        for (int sl = 0; sl < 16; ++sl) {
            __syncthreads();
            const unsigned char* ub = EU + 128 * sl + 16 * i;
#pragma unroll
            for (int j = 0; j < 4; ++j) {
                const u32x4 hqc = *(const LAS u32x4*)(wl + j * 2048 + 128 * sl + 16 * i);
                u32x4 d[16];
#pragma unroll
                for (int m = 0; m < 16; ++m) { const unsigned off = *(const LAS unsigned*)(wl + 8192 + (j * 128 + 8 * m + g) * 4); d[m] = *(const u32x4*)(ub + off); }
#pragma unroll
                for (int m = 0; m < 16; ++m) accu[j][m] = dot16(d[m], hqc, accu[j][m]);
                __builtin_amdgcn_sched_barrier(0);
            }
        }
        float corr[4];
#pragma unroll
        for (int j = 0; j < 4; ++j) {
            int r1[8], r2[4], r3[2];
#pragma unroll
            for (int m = 0; m < 8; ++m) { const int send = b2 ? accu[j][m] : accu[j][m + 8], keep = b2 ? accu[j][m + 8] : accu[j][m]; r1[m] = keep + __shfl_xor(send, 4); }
#pragma unroll
            for (int m = 0; m < 4; ++m) { const int send = b1 ? r1[m] : r1[m + 4], keep = b1 ? r1[m + 4] : r1[m]; r2[m] = keep + __shfl_xor(send, 2); }
#pragma unroll
            for (int m = 0; m < 2; ++m) { const int send = b0 ? r2[m] : r2[m + 2], keep = b0 ? r2[m + 2] : r2[m]; r3[m] = keep + __shfl_xor(send, 1); }
            float wsum = 0.f;
#pragma unroll
            for (int m = 0; m < 2; ++m) { const int k = 16 * i + 8 * m + g;
                const float act = (float)r3[m] * (hs[j] * *(const LAS float*)(wl + 12288 + (j * 128 + k) * 4));
                const float w = *(const LAS float*)(wl + 10240 + (j * 128 + k) * 4) * gelu_tanh(act);
                *(LAS float*)(wl + 10240 + (j * 128 + k) * 4) = w; wsum += w; }
            corr[j] = 128.f * wave_sum(wsum);
        }
        LDS_WAIT();
        float ssq[4] = {0.f, 0.f, 0.f, 0.f};
#pragma unroll 1
        for (int sl = 0; sl < 16; ++sl) {
            const unsigned char* vb = EV + 128 * sl + 16 * i;
#pragma unroll
            for (int j = 0; j < 4; ++j) {
                u32x4 d[16]; float wv[16];
#pragma unroll
                for (int m = 0; m < 16; ++m) { const unsigned off = *(const LAS unsigned*)(wl + 8192 + (j * 128 + 8 * m + g) * 4); wv[m] = *(const LAS float*)(wl + 10240 + (j * 128 + 8 * m + g) * 4); d[m] = *(const u32x4*)(vb + off); }
                float ca[16];
#pragma unroll
                for (int b = 0; b < 16; ++b) ca[b] = 0.f;
#pragma unroll
                for (int m = 0; m < 16; ++m)
#pragma unroll
                    for (int c4 = 0; c4 < 4; ++c4) { const unsigned u = d[m][c4];
                        ca[4 * c4 + 0] += wv[m] * (float)(u & 255u); ca[4 * c4 + 1] += wv[m] * (float)((u >> 8) & 255u);
                        ca[4 * c4 + 2] += wv[m] * (float)((u >> 16) & 255u); ca[4 * c4 + 3] += wv[m] * (float)(u >> 24); }
                float c1[8], c2[4], c3[2];
#pragma unroll
                for (int b = 0; b < 8; ++b) { const float send = B2 ? ca[b] : ca[b + 8], keep = B2 ? ca[b + 8] : ca[b]; c1[b] = keep + __shfl_xor(send, 32); }
#pragma unroll
                for (int b = 0; b < 4; ++b) { const float send = B1 ? c1[b] : c1[b + 4], keep = B1 ? c1[b + 4] : c1[b]; c2[b] = keep + __shfl_xor(send, 16); }
#pragma unroll
                for (int b = 0; b < 2; ++b) { const float send = B0 ? c2[b] : c2[b + 2], keep = B0 ? c2[b + 2] : c2[b]; c3[b] = keep + __shfl_xor(send, 8); }
                const size_t o = (size_t)(tok0 + j) * DM + 128 * sl + 16 * i + 2 * g;
                const unsigned xb = *(const unsigned*)(X1B + o); const f32x2 xv = {bf_lo(xb), bf_hi(xb)};
                const f32x2 x2 = {xv[0] + (c3[0] - corr[j]), xv[1] + (c3[1] - corr[j])};
                ssq[j] += x2[0] * x2[0] + x2[1] * x2[1];
                *(f32x2*)(P.out + o) = x2;
                __builtin_amdgcn_sched_barrier(0);
            }
        }
#pragma unroll
        for (int j = 0; j < 4; ++j) { const float rs2 = 1.0f / sqrtf(wave_sum(ssq[j]) * (1.f / DM) + EPS);
            f32x4* orow = (f32x4*)(P.out + (size_t)(tok0 + j) * DM) + lane;
#pragma unroll
            for (int q = 0; q < 8; ++q) { const f32x4 gn = *((const f32x4*)P.g_final + lane + 64 * q); orow[64 * q] = orow[64 * q] * rs2 * gn; } }
        LDS_WAIT();
    }
}

}


#define XB_TMO      128
#define XB_XCNT(j)  (256  + 64 * (j))
#define XB_XSUB(j)  (1280 + 64 * (j))
#define XB_XGEN(j)  (2304 + 64 * (j))
#define XB_TOP      3328
#define XB_TOPGEN   3392
#define XCD_BAR_WORDS 3456
#define XB_SPIN_CAP (1u << 18)
__device__ __forceinline__ unsigned xb_ld(unsigned* p)              { return __hip_atomic_load(p, __ATOMIC_RELAXED, __HIP_MEMORY_SCOPE_AGENT); }
__device__ __forceinline__ unsigned xb_add(unsigned* p, unsigned v) { return __hip_atomic_fetch_add(p, v, __ATOMIC_RELAXED, __HIP_MEMORY_SCOPE_AGENT); }
__device__ __forceinline__ unsigned xb_xcc_id() { return (unsigned)__builtin_amdgcn_s_getreg((3 << 11) | 20) & 0xFu; }
#define XB_SPIN(cond, bar) do { unsigned _sp = 0; while (cond) { __builtin_amdgcn_s_sleep(1); \
    if ((++_sp & 255u) == 0u) { if (xb_ld(&(bar)[XB_TMO])) break; if (_sp > XB_SPIN_CAP) { atomicAdd(&(bar)[XB_TMO], 1u); break; } } } } while (0)
struct XcdBarrier { unsigned* bar; unsigned x; volatile LAS unsigned* st; };
__device__ __forceinline__ XcdBarrier xcd_barrier_post(unsigned* bar, volatile LAS unsigned* st) {
    XcdBarrier b; b.bar = bar; b.x = xb_xcc_id(); b.st = st;
    if (threadIdx.x == 0) (void)xb_add(&bar[XB_XCNT(b.x)], 1u);
    return b;
}
__device__ __forceinline__ void xcd_barrier_complete(unsigned* bar, unsigned x, unsigned& nloc, unsigned& nx) {
    const unsigned G = gridDim.x * gridDim.y * gridDim.z;
    unsigned sum, cnt, mine, sp = 0u;
    for (;;) {
        sum = 0u; cnt = 0u; mine = 0u;
#pragma unroll
        for (unsigned j = 0; j < 16; ++j) { const unsigned c = xb_ld(&bar[XB_XCNT(j)]); sum += c; cnt += (c > 0u) ? 1u : 0u; mine = (j == x) ? c : mine; }
        if (sum == G) break;
        __builtin_amdgcn_s_sleep(1);
        if ((++sp & 255u) == 0u) { if (xb_ld(&bar[XB_TMO])) break; if (sp > XB_SPIN_CAP) { atomicAdd(&bar[XB_TMO], 1u); break; } }
    }
    nloc = mine > 0u ? mine : 1u; nx = cnt > 0u ? cnt : 1u;
}
__device__ __forceinline__ void xcd_barrier(const XcdBarrier& b) {
    asm volatile("s_waitcnt vmcnt(0)" ::: "memory");
    __syncthreads();
    if (threadIdx.x == 0) {
        unsigned* bar = b.bar;
        __builtin_amdgcn_s_waitcnt(0);
        unsigned nloc = b.st[0], nx = b.st[1];
        if (nloc == 0u) { xcd_barrier_complete(bar, b.x, nloc, nx); b.st[0] = nloc; b.st[1] = nx; }
        const unsigned old = xb_add(&bar[XB_XSUB(b.x)], 1u);
        const unsigned gen = old / nloc;
        if (old + 1u == (gen + 1u) * nloc) {
            __builtin_amdgcn_fence(__ATOMIC_RELEASE, "agent");
            asm volatile("s_waitcnt vmcnt(0)" ::: "memory");
            const unsigned og = xb_add(&bar[XB_TOP], 1u);
            const unsigned tg = og / nx;
            if (og + 1u == (tg + 1u) * nx) xb_add(&bar[XB_TOPGEN], 1u);
            else XB_SPIN(xb_ld(&bar[XB_TOPGEN]) == tg, bar);
            __builtin_amdgcn_fence(__ATOMIC_ACQUIRE, "agent");
            xb_add(&bar[XB_XGEN(b.x)], 1u);
            asm volatile("s_waitcnt vmcnt(0)" ::: "memory");
        } else {
            XB_SPIN(xb_ld(&bar[XB_XGEN(b.x)]) == gen, bar);
            __builtin_amdgcn_fence(__ATOMIC_ACQUIRE, "agent");
            asm volatile("s_waitcnt vmcnt(0)" ::: "memory");
        }
    }
    __syncthreads();
}

__global__ void __launch_bounds__(NTHR, 2) mega_fwd(Params P) {
    extern __shared__ __attribute__((aligned(16))) unsigned char lds_raw[];
    LAS unsigned char* lds = (LAS unsigned char*)lds_raw;
    cg::grid_group grid = cg::this_grid();
    const int G = gridDim.x, bx = blockIdx.x;
    const int vcu = (G % 8 == 0) ? (bx % 8) * (G / 8) + bx / 8 : bx;
    unsigned char* ws = P.ws;
#ifndef ONLY_PHASE
#define ONLY_PHASE -1
#endif
#define IN(k) ((ONLY_PHASE < 0 || ONLY_PHASE == (k)) && P.ph_lo <= (k) && (k) < P.ph_hi)
    volatile LAS unsigned* bst = (volatile LAS unsigned*)(lds + 131072);
    if (threadIdx.x < 16) bst[threadIdx.x] = 0u;
    __syncthreads();
    const XcdBarrier xbar = xcd_barrier_post((unsigned*)(ws + WS_CTL + 131072), bst);
    if (P.ph_lo < 0) grid.sync();
#define SEAM(k) do { if (IN(k) && IN((k) + 1)) xcd_barrier(xbar); } while (0)
    if (IN(0)) { p0a(P, lds, vcu, G); xcd_barrier(xbar); p0b(P, lds, vcu, G); }
    SEAM(0);
    if (IN(1)) {
        pg8::Gemm g{ws + WS_H, ws + WS_WIN, T_TOK, 10240, 2048, 2048, 2048};
        pg8::StaticOrder S; S.init(T_TOK, 10240, G, bx);
        pg8::EpiProj E{(bf16_t*)(ws + WS_QKV), (bf16_t*)(ws + WS_SG), LOG2E * 0.08838834764831845f, (unsigned*)(ws + WS_CTL + 200704), (const float*)(ws + WS_HSC), (const float*)(ws + WS_WSC)};
        pg8::gemm_phase<pg8::EpiProj, true>(lds, g, S, E);
    }
    SEAM(1);
    if (IN(2)) { att::attn_phase(P, lds, vcu, G); __syncthreads(); late_transposes(P, lds, vcu, G); }
    SEAM(2);
    if (IN(3)) {
        pg8::StaticOrder S; S.init(T_TOK, DM, G, bx);
        { pg8::Gemm g{ws + WS_H, ws + WS_WAT, T_TOK, DM, 1024, 4096, 2048};
          pg8::EpiGate<0> E{(const bf16_t*)(ws + WS_SG), (bf16_t*)(ws + WS_TMP), (bf16_t*)(ws + WS_MERGED)};
          pg8::gemm_phase(lds, g, S, E); }
        { pg8::Gemm g{ws + WS_H + 2048, ws + WS_WBT, T_TOK, DM, 1024, 4096, 2048};
          pg8::EpiGate<1> E{(const bf16_t*)(ws + WS_SG) + 2048, (bf16_t*)(ws + WS_TMP), (bf16_t*)(ws + WS_MERGED)};
          pg8::gemm_phase(lds, g, S, E); }
    }
    SEAM(3);
    if (IN(4)) {
        pg8::Gemm g{ws + WS_MERGED, ws + WS_WOUT, T_TOK, DM, 2048, 4096, 4096};
        pg8::StaticOrder S; S.init(T_TOK, DM, G, bx);
        pg8::EpiResid E{P.x, (float*)(ws + WS_X1), (bf16_t*)(ws + WS_X1B), (float*)(ws + WS_CTL)};
        pg8::gemm_phase(lds, g, S, E);
    }
    SEAM(4);
    if (IN(5)) {
        pg8::Gemm g{ws + WS_X1B, ws + WS_WQ, T_TOK, DM, 2048, 4096, 4096};
        pg8::StaticOrder S; S.init(T_TOK, DM, G, bx);
        pg8::EpiPlainBf16 E{(bf16_t*)(ws + WS_Q2)};
        pg8::gemm_phase(lds, g, S, E);
    }
    SEAM(5);
    if (IN(6)) peer::topk_phase(P, lds, vcu, G);
    SEAM(6);
    if (IN(7)) { peer::gather_sweep(P, lds, vcu, G); }
#undef IN
#undef SEAM
}

extern "C" void kernel_launch(void* const* d_in, const int* in_sizes, int n_in, void* d_out, int out_size, void* d_ws, size_t ws_size, hipStream_t stream) {
    static int grid = 0;
    if (grid == 0) {
        if (n_in != 13 || out_size != T_TOK * DM || ws_size < WS_END) { fprintf(stderr, "kernel_launch: unexpected shapes (n_in %d out %d ws %zu)\n", n_in, out_size, ws_size); grid = -1; return; }
        int dev = 0, cus = 0, per_cu = 0;
        if (hipGetDevice(&dev) != hipSuccess || hipDeviceGetAttribute(&cus, hipDeviceAttributeMultiprocessorCount, dev) != hipSuccess) { grid = -1; return; }
        if (hipFuncSetAttribute((const void*)mega_fwd, hipFuncAttributeMaxDynamicSharedMemorySize, LDS_BYTES) != hipSuccess) { fprintf(stderr, "kernel_launch: hipFuncSetAttribute failed\n"); grid = -1; return; }
        if (hipOccupancyMaxActiveBlocksPerMultiprocessor(&per_cu, (const void*)mega_fwd, NTHR, LDS_BYTES) != hipSuccess || per_cu < 1) { fprintf(stderr, "kernel_launch: occupancy query says %d\n", per_cu); grid = -1; return; }
        grid = cus;
    }
    if (grid < 0) return;
    (void)hipMemsetAsync((char*)d_ws + WS_CTL, 0, 1 * MiB, stream);
    Params p{};
    p.x = (const float*)d_in[0]; p.g_mix = (const float*)d_in[1]; p.w_in = (const float*)d_in[2]; p.b_forget = (const float*)d_in[3];
    p.w_a = (const float*)d_in[4]; p.w_b = (const float*)d_in[5]; p.w_out = (const float*)d_in[6]; p.g_ffn = (const float*)d_in[7];
    p.w_query = (const float*)d_in[8]; p.sub_keys = (const float*)d_in[9]; p.e_u = (const float*)d_in[10]; p.e_v = (const float*)d_in[11]; p.g_final = (const float*)d_in[12];
    p.out = (float*)d_out; p.ws = (unsigned char*)d_ws;
#if MK_N_LAUNCHES == 1
    p.ph_lo = 0; p.ph_hi = N_PHASES;
    void* args[] = {&p};
    hipError_t e = hipLaunchCooperativeKernel((const void*)mega_fwd, dim3(grid), dim3(NTHR), args, LDS_BYTES, stream);
    if (e != hipSuccess) fprintf(stderr, "kernel_launch: cooperative launch failed: %s (grid %d)\n", hipGetErrorString(e), grid);
#else
    for (int ph = 0; ph < N_PHASES; ++ph) { p.ph_lo = ph; p.ph_hi = ph + 1; hipLaunchKernelGGL(mega_fwd, dim3(grid), dim3(NTHR), LDS_BYTES, stream, p); }
#endif
}
```

```cpp
#include <hip/hip_runtime.h>
#include <hip/hip_cooperative_groups.h>
#include <cstdio>
#include <cstdint>
namespace cg = cooperative_groups;

#define LAS __attribute__((address_space(3)))
typedef unsigned short bf16_t;
typedef short bf16x8 __attribute__((ext_vector_type(8)));
typedef short s16x4 __attribute__((ext_vector_type(4)));
typedef float f32x2 __attribute__((ext_vector_type(2)));
typedef float f32x4 __attribute__((ext_vector_type(4)));
typedef float f32x16 __attribute__((ext_vector_type(16)));
typedef unsigned u32x2 __attribute__((ext_vector_type(2)));
typedef unsigned u32x4 __attribute__((ext_vector_type(4)));
typedef __bf16 bf16v2 __attribute__((ext_vector_type(2)));
typedef int i32x4 __attribute__((ext_vector_type(4)));

#ifndef MK_N_LAUNCHES
#define MK_N_LAUNCHES 1
#endif

constexpr int T_TOK = 8192, DM = 2048, SEQ = 4096, HD = 128;
constexpr int NWAVES = 8, NTHR = 512;
constexpr int LDS_BYTES = 147456;
constexpr float LOG2E = 1.4426950408889634f;
constexpr float EPS = 1e-6f;
constexpr int N_PHASES = 8;

constexpr size_t MiB = 1u << 20;
constexpr size_t WS_CTL = 0;
constexpr size_t WS_LOGF = 1 * MiB;
constexpr size_t WS_SKB = 1 * MiB + 512 * 1024;
constexpr size_t WS_HSC = 1 * MiB + 256 * 1024;
constexpr size_t WS_WSC = 1 * MiB + 320 * 1024;
constexpr size_t CTL_CMAX = 262144;
constexpr size_t WS_IDS = 2 * MiB;
constexpr size_t WS_GATES = 6 * MiB;
constexpr size_t WS_WAT = 10 * MiB, WS_WBT = 14 * MiB, WS_WOUT = 18 * MiB, WS_WQ = 26 * MiB, WS_WIN = 34 * MiB;
constexpr size_t WS_H = 74 * MiB;
constexpr size_t WS_QKV = 106 * MiB;
constexpr size_t WS_TMP = 106 * MiB, WS_MERGED = 170 * MiB, WS_Q2 = 106 * MiB;
constexpr size_t WS_SG = 202 * MiB;
constexpr size_t WS_X1B = 202 * MiB;
constexpr size_t WS_X1 = 266 * MiB;
constexpr size_t WS_EU = 330 * MiB, WS_EV = 362 * MiB;
constexpr size_t WS_SU = 394 * MiB, WS_SV = 394 * MiB + 65536;
constexpr size_t WS_END = 395 * MiB;

struct Params {
    const float* x; const float* g_mix; const float* w_in; const float* b_forget; const float* w_a; const float* w_b; const float* w_out;
    const float* g_ffn; const float* w_query; const float* sub_keys; const float* e_u; const float* e_v; const float* g_final;
    float* out; unsigned char* ws; int ph_lo, ph_hi;
};

__device__ __forceinline__ unsigned pk2(float a, float b) { f32x2 v = {a, b}; return __builtin_bit_cast(unsigned, __builtin_convertvector(v, bf16v2)); }
__device__ __forceinline__ float bf_lo(unsigned u) { return __builtin_bit_cast(float, u << 16); }
__device__ __forceinline__ float bf_hi(unsigned u) { return __builtin_bit_cast(float, u & 0xffff0000u); }
__device__ __forceinline__ float fexp2(float x) { return __builtin_amdgcn_exp2f(x); }
__device__ __forceinline__ float flog2(float x) { return __builtin_amdgcn_logf(x); }
__device__ __forceinline__ float frcp(float x) { return __builtin_amdgcn_rcpf(x); }
__device__ __forceinline__ float wave_sum(float v) {
#pragma unroll
    for (int o = 1; o < 64; o <<= 1) v += __shfl_xor(v, o);
    return v;
}
#define LDS_WAIT() asm volatile("s_waitcnt lgkmcnt(0)" ::: "memory")

namespace pg8 {
constexpr int BM = 256, BK = 64, HALF = 128, HTB = HALF * BK * 2, STAGE_BYTES = 8 * HTB, NXCD = 8, WGM = 8;
__host__ __device__ __forceinline__ int lds_byte(int r, int c) { const int st = (r >> 4) * 2 + (c >> 5), rr = r & 15, cc = c & 31, ob = rr * 64 + cc * 2; return st * 1024 + (ob ^ (((ob >> 9) & 1) << 5)); }
__host__ __device__ __forceinline__ void stage_rc(int b, int& R, int& C) { const int st = b / 1024, sb = b % 1024, swz = sb ^ (((sb >> 9) & 1) << 5); R = (st >> 1) * 16 + swz / 64; C = (st & 1) * 32 + (swz % 64) / 2; }
__host__ __device__ __forceinline__ int perm32(int rho) { const int n = rho >> 4, i = rho & 15; return 8 * (i >> 2) + 4 * n + (i & 3); }
struct Unit { int pm, pn; };
struct Gemm { const void* A; const void* Bt; int M, N, K, pa, pb; };
struct StaticOrder {
    int nM, nN, nwg, G, c;
    __device__ void init(int M, int N, int G_, int c_) { nM = M / BM; nN = N / BM; nwg = nM * nN; G = G_; c = c_; }
    __device__ bool next(int i, Unit& u) const {
        const long L = (long)i * G + c; if (L >= nwg) return false;
        int wgid = (int)L; { const int q = nwg / NXCD, r = nwg % NXCD, xcd = wgid % NXCD, off = wgid / NXCD; wgid = (xcd < r ? xcd * (q + 1) : r * (q + 1) + (xcd - r) * q) + off; }
        const int nig = WGM * nN, gid = wgid / nig, fm = gid * WGM, gsz = (nM - fm) < WGM ? (nM - fm) : WGM;
        u.pm = fm + ((wgid % nig) % gsz); u.pn = (wgid % nig) / gsz; return true;
    }
};
template <class Epi, bool I8 = false>
__device__ __forceinline__ void gemm_phase(LAS unsigned char* lds, const Gemm g, const StaticOrder& S, const Epi& E) {
    const int tid = threadIdx.x, wid = __builtin_amdgcn_readfirstlane(tid >> 6), lane = tid & 63, wr = wid >> 2, wc = wid & 3, fr = lane & 15, fq = lane >> 4;
    const int K = g.K, nt = I8 ? K / (2 * BK) : K / BK;
    unsigned voffA[2], voffB[2];
#pragma unroll
    for (int i = 0; i < 2; ++i) { int R, C; stage_rc(tid * 16 + i * 8192, R, C); const int Rb = (R & ~31) + perm32(R & 31);
        voffA[i] = (unsigned)(R * g.pa + C * 2); voffB[i] = (unsigned)(Rb * g.pb + C * 2); }
    const size_t kstep = (size_t)(BK * 2);
    const size_t hstepA = (size_t)HALF * g.pa, hstepB = (size_t)HALF * g.pb;
    const size_t tstepA = 2 * hstepA, tstepB = 2 * hstepB;
    const unsigned ldsw = (unsigned)wid * 1024u;
    const int aoff = lds_byte(wr * 64 + fr, fq * 8), boff = lds_byte(wc * 32 + fr, fq * 8);
#define PG8_SA(b, h) (((b) * 2 + (h)) * HTB)
#define PG8_SB(b, h) ((4 + (b) * 2 + (h)) * HTB)
#define PG8_STAGE(bufoff, gbase, voff) do { _Pragma("unroll") for (int _i = 0; _i < 2; ++_i) \
        __builtin_amdgcn_global_load_lds((const unsigned*)((const char*)(gbase) + (voff)[_i]), (LAS unsigned*)(lds + (bufoff) + ldsw + _i * 8192), 16, 0, 0); } while (0)
#define PG8_LDA(dst, b, h) do { _Pragma("unroll") for (int m = 0; m < 4; ++m) _Pragma("unroll") for (int k = 0; k < 2; ++k) dst[m][k] = *(const LAS bf16x8*)(lds + PG8_SA(b, h) + aoff + m * 2048 + k * 1024); } while (0)
#define PG8_LDB(dst, b, h) do { _Pragma("unroll") for (int n = 0; n < 2; ++n) _Pragma("unroll") for (int k = 0; k < 2; ++k) dst[n][k] = *(const LAS bf16x8*)(lds + PG8_SB(b, h) + boff + n * 2048 + k * 1024); } while (0)
#define PG8_MMA(ai, bj, At, Bt) do { __builtin_amdgcn_s_setprio(1); _Pragma("unroll") for (int m = 0; m < 4; ++m) _Pragma("unroll") for (int n = 0; n < 2; ++n) _Pragma("unroll") for (int k = 0; k < 2; ++k) \
        { if (I8) acc[ai][bj][m][n] = __builtin_bit_cast(f32x4, __builtin_amdgcn_mfma_i32_16x16x64_i8(__builtin_bit_cast(i32x4, Bt[n][k]), __builtin_bit_cast(i32x4, At[m][k]), __builtin_bit_cast(i32x4, acc[ai][bj][m][n]), 0, 0, 0)); \
          else acc[ai][bj][m][n] = __builtin_amdgcn_mfma_f32_16x16x32_bf16(Bt[n][k], At[m][k], acc[ai][bj][m][n], 0, 0, 0); } __builtin_amdgcn_s_setprio(0); } while (0)
#define PG8_WAIT_V(n) asm volatile("s_waitcnt vmcnt(" #n ")" ::: "memory")
#define PG8_WAIT_L(n) asm volatile("s_waitcnt lgkmcnt(" #n ")" ::: "memory")
#define PG8_BAR __builtin_amdgcn_s_barrier()
#define PG8_SCHED __builtin_amdgcn_sched_barrier(0)
    Unit cur, nxt; int ui = 0;
    if (!S.next(0, cur)) return;
    f32x4 acc[2][2][4][2];
#pragma unroll
    for (int a = 0; a < 2; ++a)
#pragma unroll
        for (int b = 0; b < 2; ++b)
#pragma unroll
            for (int m = 0; m < 4; ++m)
#pragma unroll
                for (int n = 0; n < 2; ++n) acc[a][b][m][n] = (f32x4){0.f, 0.f, 0.f, 0.f};
    bf16x8 At[4][2], B0[2][2], B1[2][2];
    const char* cA = (const char*)g.A + (size_t)cur.pm * tstepA; const char* cB = (const char*)g.Bt + (size_t)cur.pn * tstepB;
    PG8_STAGE(PG8_SB(0, 0), cB, voffB); PG8_STAGE(PG8_SA(0, 0), cA, voffA); PG8_STAGE(PG8_SB(0, 1), cB + hstepB, voffB); PG8_STAGE(PG8_SA(0, 1), cA + hstepA, voffA);
    if (wr == 1) PG8_BAR;
    PG8_WAIT_V(4); PG8_BAR;
    PG8_STAGE(PG8_SB(1, 0), cB + kstep, voffB); PG8_STAGE(PG8_SA(1, 0), cA + kstep, voffA); PG8_STAGE(PG8_SB(1, 1), cB + hstepB + kstep, voffB);
    PG8_WAIT_V(6); PG8_BAR;
    for (;;) {
        const bool has_next = S.next(ui + 1, nxt);
        const char* nA = has_next ? (const char*)g.A + (size_t)nxt.pm * tstepA : cA; const char* nB = has_next ? (const char*)g.Bt + (size_t)nxt.pn * tstepB : cB;
        for (int t = 0; t < nt; t += 2) {
            const bool last = (t == nt - 2);
            const char* a1 = cA + (size_t)(t + 1) * kstep;
            const char* a2 = last ? nA : cA + (size_t)(t + 2) * kstep; const char* b2 = last ? nB : cB + (size_t)(t + 2) * kstep;
            const char* a3 = a2 + kstep; const char* b3 = b2 + kstep;
            PG8_LDB(B0, 0, 0); PG8_SCHED; PG8_LDA(At, 0, 0); PG8_STAGE(PG8_SA(1, 1), a1 + hstepA, voffA);
            PG8_WAIT_L(8); PG8_BAR; PG8_WAIT_L(0); PG8_MMA(0, 0, At, B0); PG8_BAR; PG8_SCHED;
            PG8_LDB(B1, 0, 1); PG8_STAGE(PG8_SB(0, 0), b2, voffB);
            PG8_BAR; PG8_WAIT_L(0); PG8_MMA(0, 1, At, B1); PG8_BAR;
            PG8_LDA(At, 0, 1); PG8_STAGE(PG8_SA(0, 0), a2, voffA);
            PG8_BAR; PG8_WAIT_L(0); PG8_MMA(1, 0, At, B0); PG8_BAR; PG8_SCHED;
            PG8_STAGE(PG8_SB(0, 1), b2 + hstepB, voffB);
            PG8_WAIT_V(6); PG8_BAR; PG8_MMA(1, 1, At, B1); PG8_BAR;
            PG8_LDB(B0, 1, 0); PG8_SCHED; PG8_LDA(At, 1, 0); PG8_STAGE(PG8_SA(0, 1), a2 + hstepA, voffA);
            PG8_WAIT_L(8); PG8_BAR; PG8_WAIT_L(0); PG8_MMA(0, 0, At, B0); PG8_BAR; PG8_SCHED;
            PG8_LDB(B1, 1, 1); PG8_STAGE(PG8_SB(1, 0), b3, voffB);
            PG8_BAR; PG8_WAIT_L(0); PG8_MMA(0, 1, At, B1); PG8_BAR;
            PG8_LDA(At, 1, 1); PG8_STAGE(PG8_SA(1, 0), a3, voffA);
            PG8_BAR; PG8_WAIT_L(0); PG8_MMA(1, 0, At, B0); PG8_BAR; PG8_SCHED;
            PG8_STAGE(PG8_SB(1, 1), b3 + hstepB, voffB);
            PG8_WAIT_V(6); PG8_BAR; PG8_MMA(1, 1, At, B1); PG8_BAR;
        }
        E(acc, cur, wr, wc, fr, fq);
        if (!has_next) break;
#pragma unroll
        for (int a = 0; a < 2; ++a)
#pragma unroll
            for (int b = 0; b < 2; ++b)
#pragma unroll
                for (int m = 0; m < 4; ++m)
#pragma unroll
                    for (int n = 0; n < 2; ++n) acc[a][b][m][n] = (f32x4){0.f, 0.f, 0.f, 0.f};
        cur = nxt; cA = nA; cB = nB; ++ui;
    }
    PG8_WAIT_V(0);
    if (wr == 0) PG8_BAR;
    PG8_BAR;
#undef PG8_SA
#undef PG8_SB
#undef PG8_STAGE
#undef PG8_LDA
#undef PG8_LDB
#undef PG8_MMA
#undef PG8_WAIT_V
#undef PG8_WAIT_L
#undef PG8_BAR
#undef PG8_SCHED
}

struct EpiProj {
    bf16_t* qkv; bf16_t* sg; float qscale; unsigned* kmaxw; const float* hsc; const float* wsc;
    __device__ __forceinline__ void operator()(const f32x4 (&acci)[2][2][4][2], const Unit& u, int wr, int wc, int fr, int fq) const {
        const int row0 = u.pm * BM + wr * 64 + fr;
        f32x4 acc[2][2][4][2];
        { f32x4 cs[2][2];
#pragma unroll
          for (int bj = 0; bj < 2; ++bj)
#pragma unroll
              for (int n = 0; n < 2; ++n) cs[bj][n] = *(const f32x4*)(wsc + u.pn * BM + bj * HALF + wc * 32 + 8 * fq + 4 * n);
#pragma unroll
          for (int ai = 0; ai < 2; ++ai)
#pragma unroll
              for (int m = 0; m < 4; ++m) { const float rsc = hsc[row0 + ai * HALF + m * 16];
#pragma unroll
                  for (int bj = 0; bj < 2; ++bj)
#pragma unroll
                      for (int n = 0; n < 2; ++n) { const i32x4 iv = __builtin_bit_cast(i32x4, acci[ai][bj][m][n]);
                          acc[ai][bj][m][n] = (f32x4){(float)iv[0], (float)iv[1], (float)iv[2], (float)iv[3]} * rsc * cs[bj][n]; } } }
        if (u.pn < 24) {
            const int t = u.pn >> 2; bf16_t* base = qkv + (size_t)t * ((size_t)T_TOK * 1024) + (u.pn & 3) * 256 + wc * 32 + 8 * fq;
            const float sc = (t == 0 || t == 3) ? qscale : 1.f;
            if (t == 4) {
#pragma unroll
                for (int bj = 0; bj < 2; ++bj) { float mxv = 0.f;
#pragma unroll
                    for (int ai = 0; ai < 2; ++ai)
#pragma unroll
                        for (int m = 0; m < 4; ++m) { const f32x4 v0 = acc[ai][bj][m][0], v1 = acc[ai][bj][m][1];
                            float ssq = (v0[0] * v0[0] + v0[1] * v0[1]) + (v0[2] * v0[2] + v0[3] * v0[3]) + (v1[0] * v1[0] + v1[1] * v1[1]) + (v1[2] * v1[2] + v1[3] * v1[3]);
                            ssq += __shfl_xor(ssq, 16); ssq += __shfl_xor(ssq, 32); mxv = fmaxf(mxv, ssq); }
#pragma unroll
                    for (int o = 1; o < 16; o <<= 1) mxv = fmaxf(mxv, __shfl_xor(mxv, o));
                    if ((fr | fq) == 0) atomicMax(kmaxw + ((u.pm >> 4) * 8 + (u.pn & 3) * 2 + bj) * 4 + wc, __builtin_bit_cast(unsigned, mxv)); }
            }
#pragma unroll
            for (int ai = 0; ai < 2; ++ai)
#pragma unroll
                for (int m = 0; m < 4; ++m) { bf16_t* rowp = base + (size_t)(row0 + ai * HALF + m * 16) * 1024;
#pragma unroll
                    for (int bj = 0; bj < 2; ++bj) { const f32x4 v0 = acc[ai][bj][m][0] * sc, v1 = acc[ai][bj][m][1] * sc;
                        u32x4 w; w.x = pk2(v0[0], v0[1]); w.y = pk2(v0[2], v0[3]); w.z = pk2(v1[0], v1[1]); w.w = pk2(v1[2], v1[3]);
                        *(u32x4*)(rowp + bj * HALF) = w; } }
        } else {
            bf16_t* base = sg + (u.pn - 24) * 256 + wc * 32 + 8 * fq;
#pragma unroll
            for (int ai = 0; ai < 2; ++ai)
#pragma unroll
                for (int m = 0; m < 4; ++m) { bf16_t* rowp = base + (size_t)(row0 + ai * HALF + m * 16) * 4096;
#pragma unroll
                    for (int bj = 0; bj < 2; ++bj) { float s[8];
#pragma unroll
                        for (int e = 0; e < 4; ++e) { s[e] = frcp(1.f + fexp2(-LOG2E * acc[ai][bj][m][0][e])); s[4 + e] = frcp(1.f + fexp2(-LOG2E * acc[ai][bj][m][1][e])); }
                        u32x4 w; w.x = pk2(s[0], s[1]); w.y = pk2(s[2], s[3]); w.z = pk2(s[4], s[5]); w.w = pk2(s[6], s[7]);
                        *(u32x4*)(rowp + bj * HALF) = w; } }
        }
    }
};
template <int SECOND> struct EpiGate {
    const bf16_t* sg;
    bf16_t* tmp; bf16_t* merged;
    __device__ __forceinline__ void operator()(const f32x4 (&acc)[2][2][4][2], const Unit& u, int wr, int wc, int fr, int fq) const {
        const int row0 = u.pm * BM + wr * 64 + fr, col0 = u.pn * BM + wc * 32 + 8 * fq;
#pragma unroll
        for (int ai = 0; ai < 2; ++ai)
#pragma unroll
            for (int m = 0; m < 4; ++m) { const size_t row = (size_t)(row0 + ai * HALF + m * 16);
#pragma unroll
                for (int bj = 0; bj < 2; ++bj) { const int col = col0 + bj * HALF;
                    const u32x4 gv = *(const u32x4*)(sg + row * 4096 + col);
                    const f32x4 g0 = {bf_lo(gv.x), bf_hi(gv.x), bf_lo(gv.y), bf_hi(gv.y)}, g1 = {bf_lo(gv.z), bf_hi(gv.z), bf_lo(gv.w), bf_hi(gv.w)};
                    f32x4 v0 = acc[ai][bj][m][0] * g0, v1 = acc[ai][bj][m][1] * g1;
                    bf16_t* tp = tmp + row * DM + col;
                    if (SECOND == 0) { u32x4 w; w.x = pk2(v0[0], v0[1]); w.y = pk2(v0[2], v0[3]); w.z = pk2(v1[0], v1[1]); w.w = pk2(v1[2], v1[3]); *(u32x4*)tp = w; }
                    else { const u32x4 tv = *(const u32x4*)tp; v0 += (f32x4){bf_lo(tv.x), bf_hi(tv.x), bf_lo(tv.y), bf_hi(tv.y)}; v1 += (f32x4){bf_lo(tv.z), bf_hi(tv.z), bf_lo(tv.w), bf_hi(tv.w)};
                        u32x4 w; w.x = pk2(v0[0], v0[1]); w.y = pk2(v0[2], v0[3]); w.z = pk2(v1[0], v1[1]); w.w = pk2(v1[2], v1[3]);
                        *(u32x4*)(merged + row * DM + col) = w; } } }
    }
};
struct EpiResid {
    const float* x; float* x1; bf16_t* x1b; float* rowss;
    __device__ __forceinline__ void operator()(const f32x4 (&acc)[2][2][4][2], const Unit& u, int wr, int wc, int fr, int fq) const {
        const int row0 = u.pm * BM + wr * 64 + fr, col0 = u.pn * BM + wc * 32 + 8 * fq;
#pragma unroll
        for (int ai = 0; ai < 2; ++ai)
#pragma unroll
            for (int m = 0; m < 4; ++m) { const size_t row = (size_t)(row0 + ai * HALF + m * 16); float ss = 0.f;
#pragma unroll
                for (int bj = 0; bj < 2; ++bj) { const size_t o = row * DM + col0 + bj * HALF;
                    const f32x4 v0 = acc[ai][bj][m][0] + *(const f32x4*)(x + o), v1 = acc[ai][bj][m][1] + *(const f32x4*)(x + o + 4);
                    u32x4 w; w.x = pk2(v0[0], v0[1]); w.y = pk2(v0[2], v0[3]); w.z = pk2(v1[0], v1[1]); w.w = pk2(v1[2], v1[3]);
                    *(u32x4*)(x1b + o) = w;
                    ss += (v0[0] * v0[0] + v0[1] * v0[1]) + (v0[2] * v0[2] + v0[3] * v0[3]) + (v1[0] * v1[0] + v1[1] * v1[1]) + (v1[2] * v1[2] + v1[3] * v1[3]); }
                ss += __shfl_xor(ss, 16); ss += __shfl_xor(ss, 32);
                if (fq == 0) atomicAdd(rowss + row, ss); }
    }
};
struct EpiPlainBf16 {
    bf16_t* o;
    __device__ __forceinline__ void operator()(const f32x4 (&acc)[2][2][4][2], const Unit& u, int wr, int wc, int fr, int fq) const {
        const int row0 = u.pm * BM + wr * 64 + fr, col0 = u.pn * BM + wc * 32 + 8 * fq;
#pragma unroll
        for (int ai = 0; ai < 2; ++ai)
#pragma unroll
            for (int m = 0; m < 4; ++m) { const size_t row = (size_t)(row0 + ai * HALF + m * 16);
#pragma unroll
                for (int bj = 0; bj < 2; ++bj) { const f32x4 v0 = acc[ai][bj][m][0], v1 = acc[ai][bj][m][1];
                    u32x4 w; w.x = pk2(v0[0], v0[1]); w.y = pk2(v0[2], v0[3]); w.z = pk2(v1[0], v1[1]); w.w = pk2(v1[2], v1[3]);
                    *(u32x4*)(o + row * DM + col0 + bj * HALF) = w; } }
    }
};
}

__device__ __forceinline__ void transpose_item(const float* W, int ldw, int src_n0, bf16_t* WT, int K, int dst_n0, int k0, LAS float* scr, int lane, const float* kscale) {
#pragma unroll 8
    for (int i = 0; i < 32; ++i) { const int kk = 2 * i + (lane >> 5); float v = W[(size_t)(k0 + kk) * ldw + src_n0 + (lane & 31)]; if (kscale) v *= kscale[k0 + kk]; scr[kk * 33 + (lane & 31)] = v; }
    LDS_WAIT();
    const int c = lane & 7;
#pragma unroll
    for (int j = 0; j < 4; ++j) { const int n = (lane >> 3) + 8 * j; const LAS float* s = scr + (8 * c) * 33 + n;
        u32x4 o; o.x = pk2(s[0 * 33], s[1 * 33]); o.y = pk2(s[2 * 33], s[3 * 33]); o.z = pk2(s[4 * 33], s[5 * 33]); o.w = pk2(s[6 * 33], s[7 * 33]);
        *(u32x4*)(WT + (size_t)(dst_n0 + n) * K + k0 + 8 * c) = o; }
    LDS_WAIT();
}

__device__ __forceinline__ void p0a(const Params& P, LAS unsigned char* lds, int vcu, int G) {
    const int tid = threadIdx.x, lane = tid & 63, wave = __builtin_amdgcn_readfirstlane(tid >> 6);
    const int gw = vcu * NWAVES + wave, NGW = G * NWAVES;
    unsigned char* ws = P.ws;
    {
        unsigned* CMAX = (unsigned*)(ws + WS_CTL + CTL_CMAX);
        constexpr int NCB = (10248 + 255) / 256;
        for (int it = gw; it < 128 * NCB; it += NGW) { const int kb = it / NCB, cb = it % NCB, sc = cb * 256 + 4 * lane;
            if (sc < 10248) { f32x4 v[16];
#pragma unroll
                for (int r = 0; r < 16; ++r) v[r] = *(const f32x4*)(P.w_in + (size_t)(kb * 16 + r) * 10248 + sc);
                float m0 = 0.f, m1 = 0.f, m2 = 0.f, m3 = 0.f;
#pragma unroll
                for (int r = 0; r < 16; ++r) { m0 = fmaxf(m0, fabsf(v[r][0])); m1 = fmaxf(m1, fabsf(v[r][1])); m2 = fmaxf(m2, fabsf(v[r][2])); m3 = fmaxf(m3, fabsf(v[r][3])); }
                const float mm[4] = {m0, m1, m2, m3};
#pragma unroll
                for (int e = 0; e < 4; ++e) { const int c = sc + e; const unsigned mb = __float_as_uint(mm[e]);
                    if (c < 6144) atomicMax(CMAX + c, mb); else if (c >= 6152) atomicMax(CMAX + c - 8, mb); } } }
    }
    {
        LAS float* wf = (LAS float*)lds;
        for (int idx = tid; idx < 2048 * 8; idx += NTHR) { const int k = idx >> 3, c = idx & 7; wf[c * 2048 + k] = P.w_in[(size_t)k * 10248 + 6144 + c]; }
        __syncthreads();
        unsigned char* HQ8 = ws + WS_H; float* HSC = (float*)(ws + WS_HSC); float* LOGF = (float*)(ws + WS_LOGF);
        for (int r = gw; r < T_TOK; r += NGW) {
            const f32x4* xr = (const f32x4*)(P.x + (size_t)r * DM) + lane;
            float ss = 0.f, amx = 0.f; f32x4 hv[8];
#pragma unroll
            for (int j = 0; j < 8; ++j) { const f32x4 v = xr[64 * j]; const f32x4 gn = *((const f32x4*)P.g_mix + lane + 64 * j); ss += (v[0] * v[0] + v[1] * v[1]) + (v[2] * v[2] + v[3] * v[3]);
                hv[j] = v * gn; amx = fmaxf(amx, fmaxf(fmaxf(fabsf(hv[j][0]), fabsf(hv[j][1])), fmaxf(fabsf(hv[j][2]), fabsf(hv[j][3])))); }
            const float rstd = 1.0f / sqrtf(wave_sum(ss) * (1.f / DM) + EPS);
#pragma unroll
            for (int o = 1; o < 64; o <<= 1) amx = fmaxf(amx, __shfl_xor(amx, o));
            const float hmax = fmaxf(amx * rstd, 1e-30f), hinv = 127.f / hmax;
            float fl[8];
#pragma unroll
            for (int c = 0; c < 8; ++c) fl[c] = 0.f;
            unsigned* hp = (unsigned*)(HQ8 + (size_t)r * DM) + lane;
#pragma unroll
            for (int j = 0; j < 8; ++j) { const f32x4 h = hv[j] * rstd;
                unsigned w = 0;
#pragma unroll
                for (int e = 0; e < 4; ++e) w |= ((unsigned)(int)__builtin_rintf(h[e] * hinv) & 255u) << (8 * e);
                hp[64 * j] = w;
#pragma unroll
                for (int c = 0; c < 8; ++c) { const f32x4 wv = *((const LAS f32x4*)(wf + c * 2048) + lane + 64 * j); fl[c] += (h[0] * wv[0] + h[1] * wv[1]) + (h[2] * wv[2] + h[3] * wv[3]); }
                __builtin_amdgcn_sched_barrier(0); }
#pragma unroll
            for (int c = 0; c < 8; ++c) fl[c] = wave_sum(fl[c]);
            if (lane == 0) { HSC[r] = hmax * (1.f / 127.f);
#pragma unroll
                for (int c = 0; c < 8; ++c) { const float y = fl[c] + P.b_forget[c]; LOGF[(size_t)r * 8 + c] = fminf(y, 0.f) - log1pf(expf(-fabsf(y))); }
            }
        }
    }
    {
        const size_t gid = (size_t)vcu * NTHR + tid, gstride = (size_t)G * NTHR;
        for (size_t i = gid; i < 262144 / 8; i += gstride) { const float* src = P.sub_keys + i * 8; const f32x4 a = *(const f32x4*)src, b = *((const f32x4*)src + 1);
            u32x4 o; o.x = pk2(a[0], a[1]); o.y = pk2(a[2], a[3]); o.z = pk2(b[0], b[1]); o.w = pk2(b[2], b[3]); *(u32x4*)((bf16_t*)(ws + WS_SKB) + i * 8) = o; }
    }
}
__device__ __forceinline__ void p0b(const Params& P, LAS unsigned char* lds, int vcu, int G) {
    const int tid = threadIdx.x, lane = tid & 63, wave = __builtin_amdgcn_readfirstlane(tid >> 6);
    const int gw = vcu * NWAVES + wave, NGW = G * NWAVES;
    unsigned char* ws = P.ws;
    const unsigned* CMAX = (const unsigned*)(ws + WS_CTL + CTL_CMAX); float* WSC = (float*)(ws + WS_WSC); unsigned char* WT8 = ws + WS_WIN;
    LAS float* scr = (LAS float*)(lds + wave * 16384);
    for (int it = gw; it < 32 * 320; it += NGW) {
        const int nb = it >> 5, kb = it & 31, dn = nb * 32, sn = dn < 6144 ? dn : dn + 8, k0 = kb * 64;
        const int c4 = (lane & 7) * 4;
        float inv[4];
#pragma unroll
        for (int e = 0; e < 4; ++e) { const float cm = fmaxf(__uint_as_float(__hip_atomic_load(CMAX + dn + c4 + e, __ATOMIC_RELAXED, __HIP_MEMORY_SCOPE_AGENT)), 1e-30f); inv[e] = 127.f / cm;
            if (kb == 0 && lane < 8) WSC[dn + c4 + e] = cm * (1.f / 127.f); }
        f32x4 v[8];
#pragma unroll
        for (int i = 0; i < 8; ++i) v[i] = *(const f32x4*)(P.w_in + (size_t)(k0 + 8 * i + (lane >> 3)) * 10248 + sn + c4);
#pragma unroll
        for (int i = 0; i < 8; ++i) { LAS float* sp = scr + (8 * i + (lane >> 3)) * 33 + c4; sp[0] = v[i][0] * inv[0]; sp[1] = v[i][1] * inv[1]; sp[2] = v[i][2] * inv[2]; sp[3] = v[i][3] * inv[3]; }
        LDS_WAIT();
        const int c = lane & 3;
#pragma unroll
        for (int j = 0; j < 2; ++j) { const int n = (lane >> 2) + 16 * j; const LAS float* sp = scr + (16 * c) * 33 + n;
            u32x4 o;
#pragma unroll
            for (int w4 = 0; w4 < 4; ++w4) { unsigned w = 0;
#pragma unroll
                for (int e = 0; e < 4; ++e) w |= ((unsigned)(int)fminf(fmaxf(__builtin_rintf(sp[(4 * w4 + e) * 33]), -127.f), 127.f) & 255u) << (8 * e);
                o[w4] = w; }
            *(u32x4*)(WT8 + (size_t)(dn + n) * 2048 + k0 + 16 * c) = o; }
        LDS_WAIT();
    }
}
__device__ __forceinline__ void late_transposes(const Params& P, LAS unsigned char* lds, int vcu, int G) {
    const int tid = threadIdx.x, lane = tid & 63, wave = __builtin_amdgcn_readfirstlane(tid >> 6);
    const int gw = vcu * NWAVES + wave, NGW = G * NWAVES;
    unsigned char* ws = P.ws;
    LAS float* scr = (LAS float*)(lds + wave * 16384);
    constexpr int I_A = 16 * 64, I_O = 32 * 64, NITEMS = 2 * I_A + 2 * I_O;
    for (int it = gw; it < NITEMS; it += NGW) {
        int r = it;
        if (r < I_A) { const int kb = r / 64, nb = r % 64; transpose_item(P.w_a, 2048, nb * 32, (bf16_t*)(ws + WS_WAT), 1024, nb * 32, kb * 64, scr, lane, nullptr); continue; } r -= I_A;
        if (r < I_A) { const int kb = r / 64, nb = r % 64; transpose_item(P.w_b, 2048, nb * 32, (bf16_t*)(ws + WS_WBT), 1024, nb * 32, kb * 64, scr, lane, nullptr); continue; } r -= I_A;
        if (r < I_O) { const int kb = r / 64, nb = r % 64; transpose_item(P.w_out, 2048, nb * 32, (bf16_t*)(ws + WS_WOUT), 2048, nb * 32, kb * 64, scr, lane, nullptr); continue; } r -= I_O;
        { const int kb = r / 64, nb = r % 64; transpose_item(P.w_query, 2048, nb * 32, (bf16_t*)(ws + WS_WQ), 2048, nb * 32, kb * 64, scr, lane, P.g_ffn); }
    }
}
__device__ __forceinline__ void quantise_expert_rows(const Params& P, int r0, int nrows) {
    const int lane = threadIdx.x & 63;
    unsigned char* ws = P.ws;
    float* SU = (float*)(ws + WS_SU); float* SV = (float*)(ws + WS_SV);
    for (int r = r0; r < r0 + nrows; ++r) {
        const bool second = r >= 16384; const int row = second ? r - 16384 : r;
        const f32x4* src = (const f32x4*)((second ? P.e_v : P.e_u) + (size_t)row * DM) + lane;
        f32x4 v[8]; float mx = 0.f;
#pragma unroll
        for (int j = 0; j < 8; ++j) { v[j] = __builtin_nontemporal_load(src + 64 * j); mx = fmaxf(mx, fmaxf(fmaxf(fabsf(v[j][0]), fabsf(v[j][1])), fmaxf(fabsf(v[j][2]), fabsf(v[j][3])))); }
#pragma unroll
        for (int o = 1; o < 64; o <<= 1) mx = fmaxf(mx, __shfl_xor(mx, o));
        mx = fmaxf(mx, 1e-30f);
        const float inv = 127.f / mx; const int bias = 0;
        unsigned* dst = (unsigned*)(ws + (second ? WS_EV : WS_EU) + (size_t)row * DM) + lane;
#pragma unroll
        for (int j = 0; j < 8; ++j) { unsigned w = 0;
#pragma unroll
            for (int e = 0; e < 4; ++e) { const int q = (int)__builtin_rintf(v[j][e] * inv) + bias; w |= ((unsigned)q & 255u) << (8 * e); }
            dst[64 * j] = w; }
        if (lane == 0) (second ? SV : SU)[row] = mx * (1.f / 127.f);
    }
}

namespace att {
constexpr int KST = 272, VST = 320;
constexpr int KBUF = 64 * KST, VBUF = 64 * VST;
constexpr int OFF_K = 0, OFF_V = 2 * KBUF, OFF_F = OFF_V + 2 * VBUF, OFF_SC = OFF_F + 4096 * 4;
constexpr int OFF_FLG = OFF_SC + 64, OFF_UNIT = OFF_FLG + 64;
static_assert(OFF_UNIT + 16 <= 131072, "attention LDS");
constexpr float THR_SB = 40.f, THR_FOX = 30.f;

__device__ __forceinline__ void build_cumf(LAS unsigned char* lds, const float* LOGF, int b, int h, int n, int tid, int lane, int wid) {
    LAS float* F2 = (LAS float*)(lds + OFF_F); LAS float* sc = (LAS float*)(lds + OFF_SC);
    const int s0 = tid * 8; float v[8];
#pragma unroll
    for (int i = 0; i < 8; ++i) v[i] = (s0 < n) ? LOGF[((size_t)b * SEQ + s0 + i) * 8 + h] * LOG2E : 0.f;
#pragma unroll
    for (int i = 1; i < 8; ++i) v[i] += v[i - 1];
    float tot = v[7], inc = tot;
#pragma unroll
    for (int o = 1; o < 64; o <<= 1) { const float t = __shfl_up(inc, o); if (lane >= o) inc += t; }
    if (lane == 63) sc[wid] = inc;
    __syncthreads();
    float base = inc - tot;
#pragma unroll
    for (int w = 0; w < 8; ++w) if (w < wid) base += sc[w];
    if (s0 < n) {
#pragma unroll
        for (int i = 0; i < 8; ++i) F2[s0 + i] = v[i] + base;
    }
    __syncthreads();
}

template <int MIXER>
__device__ __forceinline__ void attn_unit(LAS unsigned char* lds, const bf16_t* Q, const bf16_t* Kg, const bf16_t* Vg, bf16_t* O, int b, int h, int qb, float kmax, int tid, int lane, int wid) {
    const int c = lane & 31, hh = lane >> 5;
    const int t0 = qb * 256 + wid * 32, tq = t0 + c;
    const size_t rowbase = (size_t)b * SEQ;
    size_t qoff = (rowbase + tq) * 1024 + h * HD + 8 * hh;
    f32x16 oacc[4];
#pragma unroll
    for (int d = 0; d < 4; ++d)
#pragma unroll
        for (int r = 0; r < 16; ++r) oacc[d][r] = 0.f;
    float carry = 0.f, mrun = -1e30f, lsum = 0.f; const float nhf = hh ? 0.f : 1.f;
    const LAS float* F2 = (const LAS float*)(lds + OFF_F);
    const float Ft = (MIXER == 1) ? F2[tq] : 0.f;
    float qk_bound = 0.f;
    if (MIXER == 1) { float qs = 0.f;
#pragma unroll
        for (int s2 = 0; s2 < 8; ++s2) { const u32x4 qv = *(const u32x4*)(Q + qoff + 16 * s2);
#pragma unroll
            for (int e = 0; e < 4; ++e) { const float a = bf_lo(qv[e]), b2 = bf_hi(qv[e]); qs += a * a + b2 * b2; } }
        qs += __shfl_xor(qs, 32);
        qk_bound = sqrtf(qs) * kmax; }
    bool wave_done = false;
    volatile LAS unsigned* flg = (volatile LAS unsigned*)(lds + OFF_FLG);
    const int ktmax = 4 * qb + 3;
    const int srow = tid >> 4, scc = tid & 15;
    u32x4 kr[2], vr[2];
#define ATT_LOAD(kt) do { _Pragma("unroll") for (int j = 0; j < 2; ++j) { const size_t g_ = (rowbase + 64 * (kt) + srow + 32 * j) * 1024 + h * HD + scc * 8; \
        kr[j] = *(const u32x4*)(Kg + g_); vr[j] = *(const u32x4*)(Vg + g_); } } while (0)
#define ATT_WRITE(buf) do { _Pragma("unroll") for (int j = 0; j < 2; ++j) { \
        *(LAS u32x4*)(lds + OFF_K + (buf) * KBUF + (srow + 32 * j) * KST + scc * 16) = kr[j]; \
        *(LAS u32x4*)(lds + OFF_V + (buf) * VBUF + (srow + 32 * j) * VST + scc * 16) = vr[j]; } } while (0)
    ATT_LOAD(ktmax); ATT_WRITE(0); __syncthreads();
    int buf = 0;
    for (int kt = ktmax; kt >= 0; --kt) {
        if (kt > 0) ATT_LOAD(kt - 1);
        const bool started = (64 * kt <= t0 + 31);
        if (started && !wave_done) {
            const LAS unsigned char* Kl = lds + OFF_K + buf * KBUF; const LAS unsigned char* Vl = lds + OFF_V + buf * VBUF;
            f32x16 sacc[2];
            asm volatile("" : "+v"(qoff));
            bf16x8 qf[8];
#pragma unroll
            for (int s = 0; s < 8; ++s) qf[s] = *(const bf16x8*)(Q + qoff + 16 * s);
#pragma unroll
            for (int sub = 0; sub < 2; ++sub) {
#pragma unroll
                for (int r = 0; r < 16; ++r) sacc[sub][r] = 0.f;
#pragma unroll
                for (int s = 0; s < 8; ++s) { const bf16x8 kf = *(const LAS bf16x8*)(Kl + (32 * sub + c) * KST + (16 * s + 8 * hh) * 2);
                    sacc[sub] = __builtin_amdgcn_mfma_f32_32x32x16_bf16(kf, qf[s], sacc[sub], 0, 0, 0); }
            }
            const bool need_mask = (64 * kt + 63 >= t0);
            if (MIXER == 0) {
#pragma unroll
                for (int sub = 1; sub >= 0; --sub) {
                    float lb[16];
#pragma unroll
                    for (int r = 0; r < 16; ++r) { const float z = sacc[sub][r]; float l = -flog2(1.f + fexp2(z));
                        if (need_mask) { const int sidx = 64 * kt + 32 * sub + (r & 3) + 8 * (r >> 2) + 4 * hh; l = (sidx < tq) ? l : 0.f; }
                        lb[r] = l; }
                    float Glo[4], Ghi[4];
#pragma unroll
                    for (int g = 0; g < 4; ++g) { lb[4 * g + 2] += lb[4 * g + 3]; lb[4 * g + 1] += lb[4 * g + 2]; lb[4 * g] += lb[4 * g + 1];
                        const unsigned gu = __builtin_bit_cast(unsigned, lb[4 * g]); const auto rr = __builtin_amdgcn_permlane32_swap(gu, gu, false, false);
                        Glo[g] = __builtin_bit_cast(float, (unsigned)rr[0]); Ghi[g] = __builtin_bit_cast(float, (unsigned)rr[1]); }
                    float E[8];
                    E[7] = carry; E[6] = E[7] + Ghi[3]; E[5] = E[6] + Glo[3]; E[4] = E[5] + Ghi[2]; E[3] = E[4] + Glo[2]; E[2] = E[3] + Ghi[1]; E[1] = E[2] + Glo[1]; E[0] = E[1] + Ghi[0];
                    carry = E[0] + Glo[0];
#pragma unroll
                    for (int g = 0; g < 4; ++g) { const float Eo = __builtin_fmaf(nhf, Ghi[g], E[2 * g + 1]);
#pragma unroll
                        for (int i = 0; i < 4; ++i) { const int r = 4 * g + i; float w = fexp2(sacc[sub][r] + lb[r] + Eo);
                            if (need_mask) { const int sidx = 64 * kt + 32 * sub + (r & 3) + 8 * (r >> 2) + 4 * hh; w = (sidx < tq) ? w : 0.f; }
                            sacc[sub][r] = w; } }
                }
            } else {
                float mx = -1e30f;
#pragma unroll
                for (int sub = 0; sub < 2; ++sub)
#pragma unroll
                    for (int g = 0; g < 4; ++g) { const f32x4 fs = *(const LAS f32x4*)(F2 + 64 * kt + 32 * sub + 8 * g + 4 * hh);
#pragma unroll
                        for (int i = 0; i < 4; ++i) { const int r = 4 * g + i; float xv = sacc[sub][r] + (Ft - fs[i]);
                            if (need_mask) { const int sidx = 64 * kt + 32 * sub + 8 * g + 4 * hh + i; xv = (sidx <= tq) ? xv : -1e30f; }
                            sacc[sub][r] = xv; mx = fmaxf(mx, xv); } }
                { const unsigned mu = __builtin_bit_cast(unsigned, mx); const auto rr = __builtin_amdgcn_permlane32_swap(mu, mu, false, false);
                  mx = fmaxf(__builtin_bit_cast(float, (unsigned)rr[0]), __builtin_bit_cast(float, (unsigned)rr[1])); }
                const float mnew = fmaxf(mrun, mx);
                const float alpha = fexp2(mrun - mnew);
                float ps = 0.f;
#pragma unroll
                for (int sub = 0; sub < 2; ++sub)
#pragma unroll
                    for (int r = 0; r < 16; ++r) { const float p = fexp2(sacc[sub][r] - mnew); sacc[sub][r] = p; ps += p; }
                lsum = lsum * alpha + ps;
                if (__any(mnew > mrun)) {
#pragma unroll
                    for (int d = 0; d < 4; ++d)
#pragma unroll
                        for (int r = 0; r < 16; ++r) oacc[d][r] *= alpha;
                }
                mrun = mnew;
            }
#pragma unroll
            for (int ks = 0; ks < 4; ++ks) { const int sub = ks >> 1, rb = 8 * (ks & 1);
                u32x4 pw; pw.x = pk2(sacc[sub][rb + 0], sacc[sub][rb + 1]); pw.y = pk2(sacc[sub][rb + 2], sacc[sub][rb + 3]); pw.z = pk2(sacc[sub][rb + 4], sacc[sub][rb + 5]); pw.w = pk2(sacc[sub][rb + 6], sacc[sub][rb + 7]);
                const bf16x8 pf = __builtin_bit_cast(bf16x8, pw);
                const LAS unsigned char* vb = Vl + (16 * ks + 4 * hh + ((lane & 15) >> 2)) * VST + (16 * ((lane >> 4) & 1) + 4 * (lane & 3)) * 2;
#pragma unroll
                for (int d = 0; d < 4; ++d) {
                    const s16x4 a0 = __builtin_amdgcn_ds_read_tr16_b64_v4i16((LAS s16x4*)(vb + d * 64));
                    const s16x4 a1 = __builtin_amdgcn_ds_read_tr16_b64_v4i16((LAS s16x4*)(vb + d * 64 + 8 * VST));
                    const bf16x8 af = {a0[0], a0[1], a0[2], a0[3], a1[0], a1[1], a1[2], a1[3]};
                    oacc[d] = __builtin_amdgcn_mfma_f32_32x32x16_bf16(af, pf, oacc[d], 0, 0, 0); }
            }
        }
        if (kt > 0) ATT_WRITE(buf ^ 1);
        if (kt > 0 && started && !wave_done) {
            if (MIXER == 0) wave_done = __all(carry < -THR_SB);
            else wave_done = __all(qk_bound + (Ft - F2[64 * kt - 1]) - mrun < -THR_FOX);
        }
        if (lane == 0) flg[(kt & 1) * 8 + wid] = wave_done ? 1u : 0u;
        __syncthreads();
        buf ^= 1;
        { unsigned alld = 1u;
#pragma unroll
          for (int w = 0; w < 8; ++w) alld &= flg[(kt & 1) * 8 + w];
          if (alld) break; }
    }
#undef ATT_LOAD
#undef ATT_WRITE
    float inv = 1.f;
    if (MIXER == 1) { const unsigned lu = __builtin_bit_cast(unsigned, lsum); const auto rr = __builtin_amdgcn_permlane32_swap(lu, lu, false, false);
        inv = 1.f / (__builtin_bit_cast(float, (unsigned)rr[0]) + __builtin_bit_cast(float, (unsigned)rr[1])); }
    bf16_t* op = O + (rowbase + tq) * 2048 + 4 * hh;
#pragma unroll
    for (int d = 0; d < 4; ++d)
#pragma unroll
        for (int g = 0; g < 4; ++g) { u32x2 w; w.x = pk2(oacc[d][4 * g] * inv, oacc[d][4 * g + 1] * inv); w.y = pk2(oacc[d][4 * g + 2] * inv, oacc[d][4 * g + 3] * inv);
            *(u32x2*)(op + 32 * d + 8 * g) = w; }
}

__device__ __forceinline__ void attn_phase(const Params& P, LAS unsigned char* lds, int vcu, int G) {
    const int tid = threadIdx.x, lane = tid & 63, wid = __builtin_amdgcn_readfirstlane(tid >> 6);
    unsigned char* ws = P.ws;
    const bf16_t* QKV = (const bf16_t*)(ws + WS_QKV); const size_t TS = (size_t)T_TOK * 1024;
    bf16_t* OAB = (bf16_t*)(ws + WS_H); const float* LOGF = (const float*)(ws + WS_LOGF);
    unsigned* qctr = (unsigned*)(ws + WS_CTL + 196608);
    const unsigned* KMAXW = (const unsigned*)(ws + WS_CTL + 200704);
    volatile LAS unsigned* uw = (volatile LAS unsigned*)(lds + OFF_UNIT);
    for (;;) {
        if (tid == 0) uw[0] = atomicAdd(qctr, 1u);
        __syncthreads();
        const unsigned u = uw[0];
        __syncthreads();
        if (u >= 1024u) break;
        if (u >= 512u) { quantise_expert_rows(P, (int)(u - 512u) * 64 + wid * 8, 8); continue; }
        const int mixer = (u < 256u) ? 1 : 0, v = (int)(u & 255u), qb = 15 - (v >> 4), bh = v & 15, b = bh >> 3, h = bh & 7;
        if (mixer == 0) {
            attn_unit<0>(lds, QKV, QKV + TS, QKV + 2 * TS, OAB + h * HD, b, h, qb, 0.f, tid, lane, wid);
        } else {
            float k2 = 0.f;
#pragma unroll
            for (int w = 0; w < 4; ++w) k2 += __builtin_bit_cast(float, __hip_atomic_load(KMAXW + bh * 4 + w, __ATOMIC_RELAXED, __HIP_MEMORY_SCOPE_AGENT));
            const float kmax = sqrtf(k2) * 1.01f;
            build_cumf(lds, LOGF, b, h, 256 * (qb + 1), tid, lane, wid);
            attn_unit<1>(lds, QKV + 3 * TS, QKV + 4 * TS, QKV + 5 * TS, OAB + 1024 + h * HD, b, h, qb, kmax, tid, lane, wid);
        }
        __syncthreads();
    }
}
}

namespace peer {
__device__ __forceinline__ unsigned sortable(float f) { const unsigned u = __builtin_bit_cast(unsigned, f); return (u & 0x80000000u) ? ~u : (u | 0x80000000u); }
__device__ __forceinline__ float unsortable(unsigned k) { const unsigned u = (k & 0x80000000u) ? (k & 0x7fffffffu) : ~k; return __builtin_bit_cast(float, u); }
#define CE_DESC(x, y) do { const unsigned hi_ = (x) > (y) ? (x) : (y); const unsigned lo_ = (x) > (y) ? (y) : (x); (x) = hi_; (y) = lo_; } while (0)
template <int B, int N> __device__ __forceinline__ void sort16_desc(unsigned (&a)[N]) {
#pragma unroll
    for (int k = 2; k <= 16; k <<= 1)
#pragma unroll
        for (int j = k >> 1; j > 0; j >>= 1)
#pragma unroll
            for (int i = 0; i < 16; ++i) { const int l = i ^ j; if (l > i) { if ((i & k) == 0) CE_DESC(a[B + i], a[B + l]); else CE_DESC(a[B + l], a[B + i]); } }
}
template <int A, int Bq, int N> __device__ __forceinline__ void merge_top16(unsigned (&a)[N]) {
#pragma unroll
    for (int i = 0; i < 16; ++i) { const unsigned x = a[A + i], y = a[Bq + 15 - i]; a[A + i] = x > y ? x : y; }
#pragma unroll
    for (int j = 8; j > 0; j >>= 1)
#pragma unroll
        for (int i = 0; i < 16; ++i) { const int l = i ^ j; if (l > i) CE_DESC(a[A + i], a[A + l]); }
}

__device__ __forceinline__ void topk_phase(const Params& P, LAS unsigned char* lds, int vcu, int G) {
    const int tid = threadIdx.x, lane = tid & 63, wave = __builtin_amdgcn_readfirstlane(tid >> 6);
    const int c = lane & 31, hh = lane >> 5;
    const int gw = vcu * NWAVES + wave, NGW = G * NWAVES;
    unsigned char* ws = P.ws;
    const bf16_t* Q2 = (const bf16_t*)(ws + WS_Q2); const bf16_t* SKB = (const bf16_t*)(ws + WS_SKB);
    const float* ROWSS = (const float*)(ws + WS_CTL); int* IDS = (int*)(ws + WS_IDS); float* GATES = (float*)(ws + WS_GATES);
    LAS unsigned char* scr = lds + wave * 4096;
    for (int task = gw; task < 2048; task += NGW) {
        const int tg = task >> 3, hd = task & 7, tok = tg * 32 + c;
#pragma unroll 1
        for (int p = 0; p < 2; ++p) {
            bf16x8 qf[8];
            { const bf16_t* qp = Q2 + (size_t)tok * DM + hd * 256 + p * 128 + 8 * hh;
#pragma unroll
              for (int s = 0; s < 8; ++s) qf[s] = *(const bf16x8*)(qp + 16 * s); }
            unsigned keys[64];
#pragma unroll
            for (int sub = 0; sub < 4; ++sub) {
                f32x16 acc;
#pragma unroll
                for (int r = 0; r < 16; ++r) acc[r] = 0.f;
                const bf16_t* kp = SKB + ((size_t)(hd * 2 + p) * 128 + 32 * sub + c) * 128 + 8 * hh;
#pragma unroll
                for (int s = 0; s < 8; ++s) { const bf16x8 kf = *(const bf16x8*)(kp + 16 * s); acc = __builtin_amdgcn_mfma_f32_32x32x16_bf16(kf, qf[s], acc, 0, 0, 0); }
#pragma unroll
                for (int r = 0; r < 16; ++r) { const int nlo = 127 - (32 * sub + (r & 3) + 8 * (r >> 2)); keys[sub * 16 + r] = (sortable(acc[r]) & ~127u) | (unsigned)(nlo - 4 * hh); }
            }
            sort16_desc<0>(keys); sort16_desc<16>(keys); sort16_desc<32>(keys); sort16_desc<48>(keys);
            merge_top16<0, 16>(keys); merge_top16<32, 48>(keys); merge_top16<0, 32>(keys);
#pragma unroll
            for (int i = 0; i < 16; ++i) { const unsigned own = keys[i]; const auto rr = __builtin_amdgcn_permlane32_swap(own, own, false, false); keys[16 + i] = hh ? (unsigned)rr[0] : (unsigned)rr[1]; }
            merge_top16<0, 16>(keys);
            if (hh == 0) {
#pragma unroll
                for (int w = 0; w < 4; ++w) *(LAS u32x4*)(scr + (c * 2 + p) * 64 + w * 16) = (u32x4){keys[4 * w], keys[4 * w + 1], keys[4 * w + 2], keys[4 * w + 3]};
            }
        }
        LDS_WAIT();
        float s1[16], s2[16];
#pragma unroll
        for (int w = 0; w < 4; ++w) { const u32x4 a = *(const LAS u32x4*)(scr + (c * 2) * 64 + w * 16), b2 = *(const LAS u32x4*)(scr + (c * 2 + 1) * 64 + w * 16);
#pragma unroll
            for (int e = 0; e < 4; ++e) { s1[4 * w + e] = unsortable((a[e] & ~127u) | 64u); s2[4 * w + e] = unsortable((b2[e] & ~127u) | 64u); } }
        unsigned ck[64];
        { int n = 0;
#pragma unroll
          for (int i = 0; i < 16; ++i)
#pragma unroll
              for (int j = 0; j < 16; ++j) if ((i + 1) * (j + 1) <= 16) { ck[n] = (sortable(s1[i] + s2[j]) & ~255u) | (unsigned)(255 - (i * 16 + j)); ++n; }
#pragma unroll
          for (int q = 50; q < 64; ++q) ck[q] = 0u; }
        sort16_desc<0>(ck); sort16_desc<16>(ck); sort16_desc<32>(ck); sort16_desc<48>(ck);
        merge_top16<0, 16>(ck); merge_top16<32, 48>(ck); merge_top16<0, 32>(ck);
        unsigned t2[16];
#pragma unroll
        for (int k = 0; k < 16; ++k) t2[k] = ck[k];
        int ids[16]; float sc[16];
#pragma unroll
        for (int k = 0; k < 16; ++k) { const unsigned pos = 255u - (t2[k] & 255u);
            const unsigned k1 = *(const LAS unsigned*)(scr + (c * 2) * 64 + (pos >> 4) * 4), k2 = *(const LAS unsigned*)(scr + (c * 2 + 1) * 64 + (pos & 15u) * 4);
            ids[k] = (int)((127u - (k1 & 127u)) * 128u + (127u - (k2 & 127u))); sc[k] = unsortable((t2[k] & ~255u) | 128u); }
        LDS_WAIT();
        const float rs = 1.0f / sqrtf(ROWSS[tok] * (1.f / DM) + EPS);
        float ev[16], Z = 0.f;
#pragma unroll
        for (int k = 0; k < 16; ++k) { ev[k] = fexp2((sc[k] - sc[0]) * rs * LOG2E); Z += ev[k]; }
        const float iz = 1.f / Z;
        int* ip = IDS + (size_t)tok * 128 + hd * 16; float* gp = GATES + (size_t)tok * 128 + hd * 16;
        if (hh == 0) {
#pragma unroll
            for (int k = 0; k < 8; ++k) { ip[k] = ids[k]; gp[k] = ev[k] * iz; }
        } else {
#pragma unroll
            for (int k = 8; k < 16; ++k) { ip[k] = ids[k]; gp[k] = ev[k] * iz; }
        }
    }
}


__device__ __forceinline__ float dot8(u32x4 a, u32x4 b, float acc) {
    const unsigned a0 = a[0], a1 = a[1], a2 = a[2], a3 = a[3], b0 = b[0], b1 = b[1], b2 = b[2], b3 = b[3];
    acc = __builtin_amdgcn_fdot2_f32_bf16(__builtin_bit_cast(bf16v2, a0), __builtin_bit_cast(bf16v2, b0), acc, false);
    acc = __builtin_amdgcn_fdot2_f32_bf16(__builtin_bit_cast(bf16v2, a1), __builtin_bit_cast(bf16v2, b1), acc, false);
    acc = __builtin_amdgcn_fdot2_f32_bf16(__builtin_bit_cast(bf16v2, a2), __builtin_bit_cast(bf16v2, b2), acc, false);
    acc = __builtin_amdgcn_fdot2_f32_bf16(__builtin_bit_cast(bf16v2, a3), __builtin_bit_cast(bf16v2, b3), acc, false);
    return acc;
}
__device__ __forceinline__ float gelu_tanh(float a) { const float t = 1.5957691216f * (a + 0.044715f * a * a * a); return a * frcp(1.f + fexp2(-LOG2E * t)); }

__device__ __forceinline__ int dot16(u32x4 a, u32x4 b, int acc) {
    acc = __builtin_amdgcn_sdot4((int)a[0], (int)b[0], acc, false); acc = __builtin_amdgcn_sdot4((int)a[1], (int)b[1], acc, false);
    acc = __builtin_amdgcn_sdot4((int)a[2], (int)b[2], acc, false); acc = __builtin_amdgcn_sdot4((int)a[3], (int)b[3], acc, false);
    return acc;
}
__device__ __forceinline__ void gather_sweep(const Params& P, LAS unsigned char* lds, int vcu, int G) {
    const int tid = threadIdx.x, lane = tid & 63, wave = __builtin_amdgcn_readfirstlane(tid >> 6);
    const int gw = vcu * NWAVES + wave, NGW = G * NWAVES;
    const int g = lane >> 3, i = lane & 7;
    unsigned char* ws = P.ws;
    const bf16_t* X1B = (const bf16_t*)(ws + WS_X1B); const float* ROWSS = (const float*)(ws + WS_CTL);
    const int* IDS = (const int*)(ws + WS_IDS); const float* GATES = (const float*)(ws + WS_GATES);
    const unsigned char* EU = ws + WS_EU; const unsigned char* EV = ws + WS_EV;
    const float* SU = (const float*)(ws + WS_SU); const float* SV = (const float*)(ws + WS_SV);
    LAS unsigned char* wl = lds + wave * 16384;
    const bool b2 = (lane >> 2) & 1, b1 = (lane >> 1) & 1, b0 = lane & 1, B2 = (lane >> 5) & 1, B1 = (lane >> 4) & 1, B0 = (lane >> 3) & 1;
    for (int tg = gw; tg < T_TOK / 4; tg += NGW) {
        const int tok0 = tg * 4;
        float hs[4];
#pragma unroll
        for (int j = 0; j < 4; ++j) { const int tok = tok0 + j;
            const float rs = 1.0f / sqrtf(ROWSS[tok] * (1.f / DM) + EPS);
            f32x4 hv[8]; float hmx = 0.f;
#pragma unroll
            for (int q = 0; q < 8; ++q) { const u32x2 xb = *((const u32x2*)(X1B + (size_t)tok * DM) + lane + 64 * q); const f32x4 xv = {bf_lo(xb[0]), bf_hi(xb[0]), bf_lo(xb[1]), bf_hi(xb[1])}; const f32x4 gn = *((const f32x4*)P.g_ffn + lane + 64 * q);
                hv[q] = xv * rs * gn; hmx = fmaxf(hmx, fmaxf(fmaxf(fabsf(hv[q][0]), fabsf(hv[q][1])), fmaxf(fabsf(hv[q][2]), fabsf(hv[q][3])))); }
#pragma unroll
            for (int o = 1; o < 64; o <<= 1) hmx = fmaxf(hmx, __shfl_xor(hmx, o));
            hmx = fmaxf(hmx, 1e-30f); const float hinv = 127.f / hmx; hs[j] = hmx * (1.f / 127.f);
#pragma unroll
            for (int q = 0; q < 8; ++q) { unsigned w = 0;
#pragma unroll
                for (int e = 0; e < 4; ++e) w |= ((unsigned)(int)__builtin_rintf(hv[q][e] * hinv) & 255u) << (8 * e);
                *(LAS unsigned*)(wl + j * 2048 + 4 * (lane + 64 * q)) = w; }
#pragma unroll
            for (int hf = 0; hf < 2; ++hf) { const int k = lane + 64 * hf; const int id = IDS[(size_t)tok * 128 + k];
                *(LAS unsigned*)(wl + 8192 + (j * 128 + k) * 4) = (unsigned)id * 2048u;
                *(LAS float*)(wl + 10240 + (j * 128 + k) * 4) = GATES[(size_t)tok * 128 + k] * SV[id];
                *(LAS float*)(wl + 12288 + (j * 128 + k) * 4) = SU[id]; }
        }
        LDS_WAIT();
        int accu[4][16];
#pragma unroll
        for (int j = 0; j < 4; ++j)
#pragma unroll
            for (int m = 0; m < 16; ++m) accu[j][m] = 0;
#pragma unroll 1
        for (int sl = 0; sl < 16; ++sl) {
            __syncthreads();
            const unsigned char* ub = EU + 128 * sl + 16 * i;
#pragma unroll
            for (int j = 0; j < 4; ++j) {
                const u32x4 hqc = *(const LAS u32x4*)(wl + j * 2048 + 128 * sl + 16 * i);
                u32x4 d[16];
#pragma unroll
                for (int m = 0; m < 16; ++m) { const unsigned off = *(const LAS unsigned*)(wl + 8192 + (j * 128 + 8 * m + g) * 4); d[m] = *(const u32x4*)(ub + off); }
#pragma unroll
                for (int m = 0; m < 16; ++m) accu[j][m] = dot16(d[m], hqc, accu[j][m]);
                __builtin_amdgcn_sched_barrier(0);
            }
        }
        float sw[4];
#pragma unroll
        for (int j = 0; j < 4; ++j) {
            int r1[8], r2[4], r3[2];
#pragma unroll
            for (int m = 0; m < 8; ++m) { const int send = b2 ? accu[j][m] : accu[j][m + 8], keep = b2 ? accu[j][m + 8] : accu[j][m]; r1[m] = keep + __shfl_xor(send, 4); }
#pragma unroll
            for (int m = 0; m < 4; ++m) { const int send = b1 ? r1[m] : r1[m + 4], keep = b1 ? r1[m + 4] : r1[m]; r2[m] = keep + __shfl_xor(send, 2); }
#pragma unroll
            for (int m = 0; m < 2; ++m) { const int send = b0 ? r2[m] : r2[m + 2], keep = b0 ? r2[m + 2] : r2[m]; r3[m] = keep + __shfl_xor(send, 1); }
            float w2[2], wmx = 0.f;
#pragma unroll
            for (int m = 0; m < 2; ++m) { const int k = 16 * i + 8 * m + g;
                const float act = (float)r3[m] * (hs[j] * *(const LAS float*)(wl + 12288 + (j * 128 + k) * 4));
                w2[m] = *(const LAS float*)(wl + 10240 + (j * 128 + k) * 4) * gelu_tanh(act); wmx = fmaxf(wmx, fabsf(w2[m])); }
#pragma unroll
            for (int o = 1; o < 64; o <<= 1) wmx = fmaxf(wmx, __shfl_xor(wmx, o));
            wmx = fmaxf(wmx, 1e-30f); sw[j] = wmx * (1.f / 127.f);
            const float winv = 127.f / wmx;
            const unsigned q0 = (unsigned)(int)__builtin_rintf(w2[0] * winv) & 255u, q1 = (unsigned)(int)__builtin_rintf(w2[1] * winv) & 255u;
            *(LAS unsigned short*)(wl + 14336 + j * 128 + 16 * g + 2 * i) = (unsigned short)(q0 | (q1 << 8));
        }
        LDS_WAIT();
        float ssq[4] = {0.f, 0.f, 0.f, 0.f};
#pragma unroll 1
        for (int sl = 0; sl < 16; ++sl) {
            const unsigned char* vb = EV + 128 * sl + 16 * i;
#pragma unroll
            for (int j = 0; j < 4; ++j) {
                u32x4 d[16];
#pragma unroll
                for (int m = 0; m < 16; ++m) { const unsigned off = *(const LAS unsigned*)(wl + 8192 + (j * 128 + 8 * m + g) * 4); d[m] = *(const u32x4*)(vb + off); }
                const u32x4 wpk = *(const LAS u32x4*)(wl + 14336 + j * 128 + 16 * g);
                int ca[16];
#pragma unroll
                for (int b = 0; b < 16; ++b) ca[b] = 0;
#pragma unroll
                for (int mg = 0; mg < 4; ++mg)
#pragma unroll
                    for (int c4 = 0; c4 < 4; ++c4) { const unsigned r0 = d[4 * mg][c4], r1 = d[4 * mg + 1][c4], r2 = d[4 * mg + 2][c4], r3 = d[4 * mg + 3][c4];
                        const unsigned t0 = __builtin_amdgcn_perm(r1, r0, 0x05010400u), t1 = __builtin_amdgcn_perm(r1, r0, 0x07030602u);
                        const unsigned t2 = __builtin_amdgcn_perm(r3, r2, 0x05010400u), t3 = __builtin_amdgcn_perm(r3, r2, 0x07030602u);
                        const int wq4 = (int)wpk[mg];
                        ca[4 * c4 + 0] = __builtin_amdgcn_sdot4((int)__builtin_amdgcn_perm(t2, t0, 0x05040100u), wq4, ca[4 * c4 + 0], false);
                        ca[4 * c4 + 1] = __builtin_amdgcn_sdot4((int)__builtin_amdgcn_perm(t2, t0, 0x07060302u), wq4, ca[4 * c4 + 1], false);
                        ca[4 * c4 + 2] = __builtin_amdgcn_sdot4((int)__builtin_amdgcn_perm(t3, t1, 0x05040100u), wq4, ca[4 * c4 + 2], false);
                        ca[4 * c4 + 3] = __builtin_amdgcn_sdot4((int)__builtin_amdgcn_perm(t3, t1, 0x07060302u), wq4, ca[4 * c4 + 3], false); }
                int c1[8], c2[4], c3[2];
#pragma unroll
                for (int b = 0; b < 8; ++b) { const int send = B2 ? ca[b] : ca[b + 8], keep = B2 ? ca[b + 8] : ca[b]; c1[b] = keep + __shfl_xor(send, 32); }
#pragma unroll
                for (int b = 0; b < 4; ++b) { const int send = B1 ? c1[b] : c1[b + 4], keep = B1 ? c1[b + 4] : c1[b]; c2[b] = keep + __shfl_xor(send, 16); }
#pragma unroll
                for (int b = 0; b < 2; ++b) { const int send = B0 ? c2[b] : c2[b + 2], keep = B0 ? c2[b + 2] : c2[b]; c3[b] = keep + __shfl_xor(send, 8); }
                const size_t o = (size_t)(tok0 + j) * DM + 128 * sl + 16 * i + 2 * g;
                const unsigned xb = *(const unsigned*)(X1B + o); const f32x2 xv = {bf_lo(xb), bf_hi(xb)};
                const f32x2 x2 = {xv[0] + sw[j] * (float)c3[0], xv[1] + sw[j] * (float)c3[1]};
                ssq[j] += x2[0] * x2[0] + x2[1] * x2[1];
                *(f32x2*)(P.out + o) = x2;
                __builtin_amdgcn_sched_barrier(0);
            }
        }
#pragma unroll
        for (int j = 0; j < 4; ++j) { const float rs2 = 1.0f / sqrtf(wave_sum(ssq[j]) * (1.f / DM) + EPS);
            f32x4* orow = (f32x4*)(P.out + (size_t)(tok0 + j) * DM) + lane;
#pragma unroll
            for (int q = 0; q < 8; ++q) { const f32x4 gn = *((const f32x4*)P.g_final + lane + 64 * q); orow[64 * q] = orow[64 * q] * rs2 * gn; } }
        LDS_WAIT();
    }
}

}


#define XB_TMO      128
#define XB_XCNT(j)  (256  + 64 * (j))
#define XB_XSUB(j)  (1280 + 64 * (j))
#define XB_XGEN(j)  (2304 + 64 * (j))
#define XB_TOP      3328
#define XB_TOPGEN   3392
#define XCD_BAR_WORDS 3456
#define XB_SPIN_CAP (1u << 18)
__device__ __forceinline__ unsigned xb_ld(unsigned* p)              { return __hip_atomic_load(p, __ATOMIC_RELAXED, __HIP_MEMORY_SCOPE_AGENT); }
__device__ __forceinline__ unsigned xb_add(unsigned* p, unsigned v) { return __hip_atomic_fetch_add(p, v, __ATOMIC_RELAXED, __HIP_MEMORY_SCOPE_AGENT); }
__device__ __forceinline__ unsigned xb_xcc_id() { return (unsigned)__builtin_amdgcn_s_getreg((3 << 11) | 20) & 0xFu; }
#define XB_SPIN(cond, bar) do { unsigned _sp = 0; while (cond) { __builtin_amdgcn_s_sleep(1); \
    if ((++_sp & 255u) == 0u) { if (xb_ld(&(bar)[XB_TMO])) break; if (_sp > XB_SPIN_CAP) { atomicAdd(&(bar)[XB_TMO], 1u); break; } } } } while (0)
struct XcdBarrier { unsigned* bar; unsigned x; volatile LAS unsigned* st; };
__device__ __forceinline__ XcdBarrier xcd_barrier_post(unsigned* bar, volatile LAS unsigned* st) {
    XcdBarrier b; b.bar = bar; b.x = xb_xcc_id(); b.st = st;
    if (threadIdx.x == 0) (void)xb_add(&bar[XB_XCNT(b.x)], 1u);
    return b;
}
__device__ __forceinline__ void xcd_barrier_complete(unsigned* bar, unsigned x, unsigned& nloc, unsigned& nx) {
    const unsigned G = gridDim.x * gridDim.y * gridDim.z;
    unsigned sum, cnt, mine, sp = 0u;
    for (;;) {
        sum = 0u; cnt = 0u; mine = 0u;
#pragma unroll
        for (unsigned j = 0; j < 16; ++j) { const unsigned c = xb_ld(&bar[XB_XCNT(j)]); sum += c; cnt += (c > 0u) ? 1u : 0u; mine = (j == x) ? c : mine; }
        if (sum == G) break;
        __builtin_amdgcn_s_sleep(1);
        if ((++sp & 255u) == 0u) { if (xb_ld(&bar[XB_TMO])) break; if (sp > XB_SPIN_CAP) { atomicAdd(&bar[XB_TMO], 1u); break; } }
    }
    nloc = mine > 0u ? mine : 1u; nx = cnt > 0u ? cnt : 1u;
}
__device__ __forceinline__ void xcd_barrier(const XcdBarrier& b) {
    asm volatile("s_waitcnt vmcnt(0)" ::: "memory");
    __syncthreads();
    if (threadIdx.x == 0) {
        unsigned* bar = b.bar;
        __builtin_amdgcn_s_waitcnt(0);
        unsigned nloc = b.st[0], nx = b.st[1];
        if (nloc == 0u) { xcd_barrier_complete(bar, b.x, nloc, nx); b.st[0] = nloc; b.st[1] = nx; }
        const unsigned old = xb_add(&bar[XB_XSUB(b.x)], 1u);
        const unsigned gen = old / nloc;
        if (old + 1u == (gen + 1u) * nloc) {
            __builtin_amdgcn_fence(__ATOMIC_RELEASE, "agent");
            asm volatile("s_waitcnt vmcnt(0)" ::: "memory");
            const unsigned og = xb_add(&bar[XB_TOP], 1u);
            const unsigned tg = og / nx;
            if (og + 1u == (tg + 1u) * nx) xb_add(&bar[XB_TOPGEN], 1u);
            else XB_SPIN(xb_ld(&bar[XB_TOPGEN]) == tg, bar);
            __builtin_amdgcn_fence(__ATOMIC_ACQUIRE, "agent");
            xb_add(&bar[XB_XGEN(b.x)], 1u);
            asm volatile("s_waitcnt vmcnt(0)" ::: "memory");
        } else {
            XB_SPIN(xb_ld(&bar[XB_XGEN(b.x)]) == gen, bar);
            __builtin_amdgcn_fence(__ATOMIC_ACQUIRE, "agent");
            asm volatile("s_waitcnt vmcnt(0)" ::: "memory");
        }
    }
    __syncthreads();
}

__global__ void __launch_bounds__(NTHR, 2) mega_fwd(Params P) {
    extern __shared__ __attribute__((aligned(16))) unsigned char lds_raw[];
    LAS unsigned char* lds = (LAS unsigned char*)lds_raw;
    cg::grid_group grid = cg::this_grid();
    const int G = gridDim.x, bx = blockIdx.x;
    const int vcu = (G % 8 == 0) ? (bx % 8) * (G / 8) + bx / 8 : bx;
    unsigned char* ws = P.ws;
#ifndef ONLY_PHASE
#define ONLY_PHASE -1
#endif
#define IN(k) ((ONLY_PHASE < 0 || ONLY_PHASE == (k)) && P.ph_lo <= (k) && (k) < P.ph_hi)
    volatile LAS unsigned* bst = (volatile LAS unsigned*)(lds + 131072);
    if (threadIdx.x < 16) bst[threadIdx.x] = 0u;
    __syncthreads();
    const XcdBarrier xbar = xcd_barrier_post((unsigned*)(ws + WS_CTL + 131072), bst);
    if (P.ph_lo < 0) grid.sync();
#define SEAM(k) do { if (IN(k) && IN((k) + 1)) xcd_barrier(xbar); } while (0)
    if (IN(0)) { p0a(P, lds, vcu, G); xcd_barrier(xbar); p0b(P, lds, vcu, G); }
    SEAM(0);
    if (IN(1)) {
        pg8::Gemm g{ws + WS_H, ws + WS_WIN, T_TOK, 10240, 2048, 2048, 2048};
        pg8::StaticOrder S; S.init(T_TOK, 10240, G, bx);
        pg8::EpiProj E{(bf16_t*)(ws + WS_QKV), (bf16_t*)(ws + WS_SG), LOG2E * 0.08838834764831845f, (unsigned*)(ws + WS_CTL + 200704), (const float*)(ws + WS_HSC), (const float*)(ws + WS_WSC)};
        pg8::gemm_phase<pg8::EpiProj, true>(lds, g, S, E);
    }
    SEAM(1);
    if (IN(2)) { att::attn_phase(P, lds, vcu, G); __syncthreads(); late_transposes(P, lds, vcu, G); }
    SEAM(2);
    if (IN(3)) {
        pg8::StaticOrder S; S.init(T_TOK, DM, G, bx);
        { pg8::Gemm g{ws + WS_H, ws + WS_WAT, T_TOK, DM, 1024, 4096, 2048};
          pg8::EpiGate<0> E{(const bf16_t*)(ws + WS_SG), (bf16_t*)(ws + WS_TMP), (bf16_t*)(ws + WS_MERGED)};
          pg8::gemm_phase(lds, g, S, E); }
        { pg8::Gemm g{ws + WS_H + 2048, ws + WS_WBT, T_TOK, DM, 1024, 4096, 2048};
          pg8::EpiGate<1> E{(const bf16_t*)(ws + WS_SG) + 2048, (bf16_t*)(ws + WS_TMP), (bf16_t*)(ws + WS_MERGED)};
          pg8::gemm_phase(lds, g, S, E); }
    }
    SEAM(3);
    if (IN(4)) {
        pg8::Gemm g{ws + WS_MERGED, ws + WS_WOUT, T_TOK, DM, 2048, 4096, 4096};
        pg8::StaticOrder S; S.init(T_TOK, DM, G, bx);
        pg8::EpiResid E{P.x, (float*)(ws + WS_X1), (bf16_t*)(ws + WS_X1B), (float*)(ws + WS_CTL)};
        pg8::gemm_phase(lds, g, S, E);
    }
    SEAM(4);
    if (IN(5)) {
        pg8::Gemm g{ws + WS_X1B, ws + WS_WQ, T_TOK, DM, 2048, 4096, 4096};
        pg8::StaticOrder S; S.init(T_TOK, DM, G, bx);
        pg8::EpiPlainBf16 E{(bf16_t*)(ws + WS_Q2)};
        pg8::gemm_phase(lds, g, S, E);
    }
    SEAM(5);
    if (IN(6)) peer::topk_phase(P, lds, vcu, G);
    SEAM(6);
    if (IN(7)) { peer::gather_sweep(P, lds, vcu, G); }
#undef IN
#undef SEAM
}

extern "C" void kernel_launch(void* const* d_in, const int* in_sizes, int n_in, void* d_out, int out_size, void* d_ws, size_t ws_size, hipStream_t stream) {
    static int grid = 0;
    if (grid == 0) {
        if (n_in != 13 || out_size != T_TOK * DM || ws_size < WS_END) { fprintf(stderr, "kernel_launch: unexpected shapes (n_in %d out %d ws %zu)\n", n_in, out_size, ws_size); grid = -1; return; }
        int dev = 0, cus = 0, per_cu = 0;
        if (hipGetDevice(&dev) != hipSuccess || hipDeviceGetAttribute(&cus, hipDeviceAttributeMultiprocessorCount, dev) != hipSuccess) { grid = -1; return; }
        if (hipFuncSetAttribute((const void*)mega_fwd, hipFuncAttributeMaxDynamicSharedMemorySize, LDS_BYTES) != hipSuccess) { fprintf(stderr, "kernel_launch: hipFuncSetAttribute failed\n"); grid = -1; return; }
        if (hipOccupancyMaxActiveBlocksPerMultiprocessor(&per_cu, (const void*)mega_fwd, NTHR, LDS_BYTES) != hipSuccess || per_cu < 1) { fprintf(stderr, "kernel_launch: occupancy query says %d\n", per_cu); grid = -1; return; }
        grid = cus;
    }
    if (grid < 0) return;
    (void)hipMemsetAsync((char*)d_ws + WS_CTL, 0, 1 * MiB, stream);
    Params p{};
    p.x = (const float*)d_in[0]; p.g_mix = (const float*)d_in[1]; p.w_in = (const float*)d_in[2]; p.b_forget = (const float*)d_in[3];
    p.w_a = (const float*)d_in[4]; p.w_b = (const float*)d_in[5]; p.w_out = (const float*)d_in[6]; p.g_ffn = (const float*)d_in[7];
    p.w_query = (const float*)d_in[8]; p.sub_keys = (const float*)d_in[9]; p.e_u = (const float*)d_in[10]; p.e_v = (const float*)d_in[11]; p.g_final = (const float*)d_in[12];
    p.out = (float*)d_out; p.ws = (unsigned char*)d_ws;
#if MK_N_LAUNCHES == 1
    p.ph_lo = 0; p.ph_hi = N_PHASES;
    void* args[] = {&p};
    hipError_t e = hipLaunchCooperativeKernel((const void*)mega_fwd, dim3(grid), dim3(NTHR), args, LDS_BYTES, stream);
    if (e != hipSuccess) fprintf(stderr, "kernel_launch: cooperative launch failed: %s (grid %d)\n", hipGetErrorString(e), grid);
#else
    for (int ph = 0; ph < N_PHASES; ++ph) { p.ph_lo = ph; p.ph_hi = ph + 1; hipLaunchKernelGGL(mega_fwd, dim3(grid), dim3(NTHR), LDS_BYTES, stream, p); }
#endif
}
```

```cpp
#include <hip/hip_runtime.h>
#include <hip/hip_cooperative_groups.h>
#include <cstdio>
#include <cstdint>
namespace cg = cooperative_groups;

#define LAS __attribute__((address_space(3)))
typedef unsigned short bf16_t;
typedef short bf16x8 __attribute__((ext_vector_type(8)));
typedef short s16x4 __attribute__((ext_vector_type(4)));
typedef float f32x2 __attribute__((ext_vector_type(2)));
typedef float f32x4 __attribute__((ext_vector_type(4)));
typedef float f32x16 __attribute__((ext_vector_type(16)));
typedef unsigned u32x2 __attribute__((ext_vector_type(2)));
typedef unsigned u32x4 __attribute__((ext_vector_type(4)));
typedef __bf16 bf16v2 __attribute__((ext_vector_type(2)));
typedef int i32x4 __attribute__((ext_vector_type(4)));

#ifndef MK_N_LAUNCHES
#define MK_N_LAUNCHES 1
#endif

constexpr int T_TOK = 8192, DM = 2048, SEQ = 4096, HD = 128;
constexpr int NWAVES = 8, NTHR = 512;
constexpr int LDS_BYTES = 147456;
constexpr float LOG2E = 1.4426950408889634f;
constexpr float EPS = 1e-6f;
constexpr int N_PHASES = 8;

constexpr size_t MiB = 1u << 20;
constexpr size_t WS_CTL = 0;
constexpr size_t WS_LOGF = 1 * MiB;
constexpr size_t WS_SKB = 1 * MiB + 512 * 1024;
constexpr size_t WS_HSC = 1 * MiB + 256 * 1024;
constexpr size_t WS_WSC = 1 * MiB + 320 * 1024;
constexpr size_t CTL_CMAX = 262144;
constexpr size_t WS_IDS = 2 * MiB;
constexpr size_t WS_GATES = 6 * MiB;
constexpr size_t WS_WAT = 10 * MiB, WS_WBT = 14 * MiB, WS_WOUT = 18 * MiB, WS_WQ = 26 * MiB, WS_WIN = 34 * MiB;
constexpr size_t WS_H = 74 * MiB;
constexpr size_t WS_QKV = 106 * MiB;
constexpr size_t WS_TMP = 106 * MiB, WS_MERGED = 170 * MiB, WS_Q2 = 106 * MiB;
constexpr size_t WS_SG = 202 * MiB;
constexpr size_t WS_X1B = 202 * MiB;
constexpr size_t WS_X1 = 266 * MiB;
constexpr size_t WS_EU = 330 * MiB, WS_EV = 362 * MiB;
constexpr size_t WS_SU = 394 * MiB, WS_SV = 394 * MiB + 65536;
constexpr size_t WS_END = 395 * MiB;

struct Params {
    const float* x; const float* g_mix; const float* w_in; const float* b_forget; const float* w_a; const float* w_b; const float* w_out;
    const float* g_ffn; const float* w_query; const float* sub_keys; const float* e_u; const float* e_v; const float* g_final;
    float* out; unsigned char* ws; int ph_lo, ph_hi;
};

__device__ __forceinline__ unsigned pk2(float a, float b) { f32x2 v = {a, b}; return __builtin_bit_cast(unsigned, __builtin_convertvector(v, bf16v2)); }
__device__ __forceinline__ float bf_lo(unsigned u) { return __builtin_bit_cast(float, u << 16); }
__device__ __forceinline__ float bf_hi(unsigned u) { return __builtin_bit_cast(float, u & 0xffff0000u); }
__device__ __forceinline__ float fexp2(float x) { return __builtin_amdgcn_exp2f(x); }
__device__ __forceinline__ float flog2(float x) { return __builtin_amdgcn_logf(x); }
__device__ __forceinline__ float frcp(float x) { return __builtin_amdgcn_rcpf(x); }
__device__ __forceinline__ float wave_sum(float v) {
#pragma unroll
    for (int o = 1; o < 64; o <<= 1) v += __shfl_xor(v, o);
    return v;
}
#define LDS_WAIT() asm volatile("s_waitcnt lgkmcnt(0)" ::: "memory")

namespace pg8 {
constexpr int BM = 256, BK = 64, HALF = 128, HTB = HALF * BK * 2, STAGE_BYTES = 8 * HTB, NXCD = 8, WGM = 8;
__host__ __device__ __forceinline__ int lds_byte(int r, int c) { const int st = (r >> 4) * 2 + (c >> 5), rr = r & 15, cc = c & 31, ob = rr * 64 + cc * 2; return st * 1024 + (ob ^ (((ob >> 9) & 1) << 5)); }
__host__ __device__ __forceinline__ void stage_rc(int b, int& R, int& C) { const int st = b / 1024, sb = b % 1024, swz = sb ^ (((sb >> 9) & 1) << 5); R = (st >> 1) * 16 + swz / 64; C = (st & 1) * 32 + (swz % 64) / 2; }
__host__ __device__ __forceinline__ int perm32(int rho) { const int n = rho >> 4, i = rho & 15; return 8 * (i >> 2) + 4 * n + (i & 3); }
struct Unit { int pm, pn; };
struct Gemm { const void* A; const void* Bt; int M, N, K, pa, pb; };
struct StaticOrder {
    int nM, nN, nwg, G, c;
    __device__ void init(int M, int N, int G_, int c_) { nM = M / BM; nN = N / BM; nwg = nM * nN; G = G_; c = c_; }
    __device__ bool next(int i, Unit& u) const {
        const long L = (long)i * G + c; if (L >= nwg) return false;
        int wgid = (int)L; { const int q = nwg / NXCD, r = nwg % NXCD, xcd = wgid % NXCD, off = wgid / NXCD; wgid = (xcd < r ? xcd * (q + 1) : r * (q + 1) + (xcd - r) * q) + off; }
        const int nig = WGM * nN, gid = wgid / nig, fm = gid * WGM, gsz = (nM - fm) < WGM ? (nM - fm) : WGM;
        u.pm = fm + ((wgid % nig) % gsz); u.pn = (wgid % nig) / gsz; return true;
    }
};
template <class Epi, bool I8 = false>
__device__ __forceinline__ void gemm_phase(LAS unsigned char* lds, const Gemm g, const StaticOrder& S, const Epi& E) {
    const int tid = threadIdx.x, wid = __builtin_amdgcn_readfirstlane(tid >> 6), lane = tid & 63, wr = wid >> 2, wc = wid & 3, fr = lane & 15, fq = lane >> 4;
    const int K = g.K, nt = I8 ? K / (2 * BK) : K / BK;
    unsigned voffA[2], voffB[2];
#pragma unroll
    for (int i = 0; i < 2; ++i) { int R, C; stage_rc(tid * 16 + i * 8192, R, C); const int Rb = (R & ~31) + perm32(R & 31);
        voffA[i] = (unsigned)(R * g.pa + C * 2); voffB[i] = (unsigned)(Rb * g.pb + C * 2); }
    const size_t kstep = (size_t)(BK * 2);
    const size_t hstepA = (size_t)HALF * g.pa, hstepB = (size_t)HALF * g.pb;
    const size_t tstepA = 2 * hstepA, tstepB = 2 * hstepB;
    const unsigned ldsw = (unsigned)wid * 1024u;
    const int aoff = lds_byte(wr * 64 + fr, fq * 8), boff = lds_byte(wc * 32 + fr, fq * 8);
#define PG8_SA(b, h) (((b) * 2 + (h)) * HTB)
#define PG8_SB(b, h) ((4 + (b) * 2 + (h)) * HTB)
#define PG8_STAGE(bufoff, gbase, voff) do { _Pragma("unroll") for (int _i = 0; _i < 2; ++_i) \
        __builtin_amdgcn_global_load_lds((const unsigned*)((const char*)(gbase) + (voff)[_i]), (LAS unsigned*)(lds + (bufoff) + ldsw + _i * 8192), 16, 0, 0); } while (0)
#define PG8_LDA(dst, b, h) do { _Pragma("unroll") for (int m = 0; m < 4; ++m) _Pragma("unroll") for (int k = 0; k < 2; ++k) dst[m][k] = *(const LAS bf16x8*)(lds + PG8_SA(b, h) + aoff + m * 2048 + k * 1024); } while (0)
#define PG8_LDB(dst, b, h) do { _Pragma("unroll") for (int n = 0; n < 2; ++n) _Pragma("unroll") for (int k = 0; k < 2; ++k) dst[n][k] = *(const LAS bf16x8*)(lds + PG8_SB(b, h) + boff + n * 2048 + k * 1024); } while (0)
#define PG8_MMA(ai, bj, At, Bt) do { __builtin_amdgcn_s_setprio(1); _Pragma("unroll") for (int m = 0; m < 4; ++m) _Pragma("unroll") for (int n = 0; n < 2; ++n) _Pragma("unroll") for (int k = 0; k < 2; ++k) \
        { if (I8) acc[ai][bj][m][n] = __builtin_bit_cast(f32x4, __builtin_amdgcn_mfma_i32_16x16x64_i8(__builtin_bit_cast(i32x4, Bt[n][k]), __builtin_bit_cast(i32x4, At[m][k]), __builtin_bit_cast(i32x4, acc[ai][bj][m][n]), 0, 0, 0)); \
          else acc[ai][bj][m][n] = __builtin_amdgcn_mfma_f32_16x16x32_bf16(Bt[n][k], At[m][k], acc[ai][bj][m][n], 0, 0, 0); } __builtin_amdgcn_s_setprio(0); } while (0)
#define PG8_WAIT_V(n) asm volatile("s_waitcnt vmcnt(" #n ")" ::: "memory")
#define PG8_WAIT_L(n) asm volatile("s_waitcnt lgkmcnt(" #n ")" ::: "memory")
#define PG8_BAR __builtin_amdgcn_s_barrier()
#define PG8_SCHED __builtin_amdgcn_sched_barrier(0)
    Unit cur, nxt; int ui = 0;
    if (!S.next(0, cur)) return;
    f32x4 acc[2][2][4][2];
#pragma unroll
    for (int a = 0; a < 2; ++a)
#pragma unroll
        for (int b = 0; b < 2; ++b)
#pragma unroll
            for (int m = 0; m < 4; ++m)
#pragma unroll
                for (int n = 0; n < 2; ++n) acc[a][b][m][n] = (f32x4){0.f, 0.f, 0.f, 0.f};
    bf16x8 At[4][2], B0[2][2], B1[2][2];
    const char* cA = (const char*)g.A + (size_t)cur.pm * tstepA; const char* cB = (const char*)g.Bt + (size_t)cur.pn * tstepB;
    PG8_STAGE(PG8_SB(0, 0), cB, voffB); PG8_STAGE(PG8_SA(0, 0), cA, voffA); PG8_STAGE(PG8_SB(0, 1), cB + hstepB, voffB); PG8_STAGE(PG8_SA(0, 1), cA + hstepA, voffA);
    if (wr == 1) PG8_BAR;
    PG8_WAIT_V(4); PG8_BAR;
    PG8_STAGE(PG8_SB(1, 0), cB + kstep, voffB); PG8_STAGE(PG8_SA(1, 0), cA + kstep, voffA); PG8_STAGE(PG8_SB(1, 1), cB + hstepB + kstep, voffB);
    PG8_WAIT_V(6); PG8_BAR;
    for (;;) {
        const bool has_next = S.next(ui + 1, nxt);
        const char* nA = has_next ? (const char*)g.A + (size_t)nxt.pm * tstepA : cA; const char* nB = has_next ? (const char*)g.Bt + (size_t)nxt.pn * tstepB : cB;
        for (int t = 0; t < nt; t += 2) {
            const bool last = (t == nt - 2);
            const char* a1 = cA + (size_t)(t + 1) * kstep;
            const char* a2 = last ? nA : cA + (size_t)(t + 2) * kstep; const char* b2 = last ? nB : cB + (size_t)(t + 2) * kstep;
            const char* a3 = a2 + kstep; const char* b3 = b2 + kstep;
            PG8_LDB(B0, 0, 0); PG8_SCHED; PG8_LDA(At, 0, 0); PG8_STAGE(PG8_SA(1, 1), a1 + hstepA, voffA);
            PG8_WAIT_L(8); PG8_BAR; PG8_WAIT_L(0); PG8_MMA(0, 0, At, B0); PG8_BAR; PG8_SCHED;
            PG8_LDB(B1, 0, 1); PG8_STAGE(PG8_SB(0, 0), b2, voffB);
            PG8_BAR; PG8_WAIT_L(0); PG8_MMA(0, 1, At, B1); PG8_BAR;
            PG8_LDA(At, 0, 1); PG8_STAGE(PG8_SA(0, 0), a2, voffA);
            PG8_BAR; PG8_WAIT_L(0); PG8_MMA(1, 0, At, B0); PG8_BAR; PG8_SCHED;
            PG8_STAGE(PG8_SB(0, 1), b2 + hstepB, voffB);
            PG8_WAIT_V(6); PG8_BAR; PG8_MMA(1, 1, At, B1); PG8_BAR;
            PG8_LDB(B0, 1, 0); PG8_SCHED; PG8_LDA(At, 1, 0); PG8_STAGE(PG8_SA(0, 1), a2 + hstepA, voffA);
            PG8_WAIT_L(8); PG8_BAR; PG8_WAIT_L(0); PG8_MMA(0, 0, At, B0); PG8_BAR; PG8_SCHED;
            PG8_LDB(B1, 1, 1); PG8_STAGE(PG8_SB(1, 0), b3, voffB);
            PG8_BAR; PG8_WAIT_L(0); PG8_MMA(0, 1, At, B1); PG8_BAR;
            PG8_LDA(At, 1, 1); PG8_STAGE(PG8_SA(1, 0), a3, voffA);
            PG8_BAR; PG8_WAIT_L(0); PG8_MMA(1, 0, At, B0); PG8_BAR; PG8_SCHED;
            PG8_STAGE(PG8_SB(1, 1), b3 + hstepB, voffB);
            PG8_WAIT_V(6); PG8_BAR; PG8_MMA(1, 1, At, B1); PG8_BAR;
        }
        E(acc, cur, wr, wc, fr, fq);
        if (!has_next) break;
#pragma unroll
        for (int a = 0; a < 2; ++a)
#pragma unroll
            for (int b = 0; b < 2; ++b)
#pragma unroll
                for (int m = 0; m < 4; ++m)
#pragma unroll
                    for (int n = 0; n < 2; ++n) acc[a][b][m][n] = (f32x4){0.f, 0.f, 0.f, 0.f};
        cur = nxt; cA = nA; cB = nB; ++ui;
    }
    PG8_WAIT_V(0);
    if (wr == 0) PG8_BAR;
    PG8_BAR;
#undef PG8_SA
#undef PG8_SB
#undef PG8_STAGE
#undef PG8_LDA
#undef PG8_LDB
#undef PG8_MMA
#undef PG8_WAIT_V
#undef PG8_WAIT_L
#undef PG8_BAR
#undef PG8_SCHED
}

struct EpiProj {
    bf16_t* qkv; bf16_t* sg; float qscale; unsigned* kmaxw; const float* hsc; const float* wsc;
    __device__ __forceinline__ void operator()(const f32x4 (&acci)[2][2][4][2], const Unit& u, int wr, int wc, int fr, int fq) const {
        const int row0 = u.pm * BM + wr * 64 + fr;
        f32x4 acc[2][2][4][2];
        { f32x4 cs[2][2];
#pragma unroll
          for (int bj = 0; bj < 2; ++bj)
#pragma unroll
              for (int n = 0; n < 2; ++n) cs[bj][n] = *(const f32x4*)(wsc + u.pn * BM + bj * HALF + wc * 32 + 8 * fq + 4 * n);
#pragma unroll
          for (int ai = 0; ai < 2; ++ai)
#pragma unroll
              for (int m = 0; m < 4; ++m) { const float rsc = hsc[row0 + ai * HALF + m * 16];
#pragma unroll
                  for (int bj = 0; bj < 2; ++bj)
#pragma unroll
                      for (int n = 0; n < 2; ++n) { const i32x4 iv = __builtin_bit_cast(i32x4, acci[ai][bj][m][n]);
                          acc[ai][bj][m][n] = (f32x4){(float)iv[0], (float)iv[1], (float)iv[2], (float)iv[3]} * rsc * cs[bj][n]; } } }
        if (u.pn < 24) {
            const int t = u.pn >> 2; bf16_t* base = qkv + (size_t)t * ((size_t)T_TOK * 1024) + (u.pn & 3) * 256 + wc * 32 + 8 * fq;
            const float sc = (t == 0 || t == 3) ? qscale : 1.f;
            if (t == 4) {
#pragma unroll
                for (int bj = 0; bj < 2; ++bj) { float mxv = 0.f;
#pragma unroll
                    for (int ai = 0; ai < 2; ++ai)
#pragma unroll
                        for (int m = 0; m < 4; ++m) { const f32x4 v0 = acc[ai][bj][m][0], v1 = acc[ai][bj][m][1];
                            float ssq = (v0[0] * v0[0] + v0[1] * v0[1]) + (v0[2] * v0[2] + v0[3] * v0[3]) + (v1[0] * v1[0] + v1[1] * v1[1]) + (v1[2] * v1[2] + v1[3] * v1[3]);
                            ssq += __shfl_xor(ssq, 16); ssq += __shfl_xor(ssq, 32); mxv = fmaxf(mxv, ssq); }
#pragma unroll
                    for (int o = 1; o < 16; o <<= 1) mxv = fmaxf(mxv, __shfl_xor(mxv, o));
                    if ((fr | fq) == 0) atomicMax(kmaxw + ((u.pm >> 4) * 8 + (u.pn & 3) * 2 + bj) * 4 + wc, __builtin_bit_cast(unsigned, mxv)); }
            }
#pragma unroll
            for (int ai = 0; ai < 2; ++ai)
#pragma unroll
                for (int m = 0; m < 4; ++m) { bf16_t* rowp = base + (size_t)(row0 + ai * HALF + m * 16) * 1024;
#pragma unroll
                    for (int bj = 0; bj < 2; ++bj) { const f32x4 v0 = acc[ai][bj][m][0] * sc, v1 = acc[ai][bj][m][1] * sc;
                        u32x4 w; w.x = pk2(v0[0], v0[1]); w.y = pk2(v0[2], v0[3]); w.z = pk2(v1[0], v1[1]); w.w = pk2(v1[2], v1[3]);
                        *(u32x4*)(rowp + bj * HALF) = w; } }
        } else {
            bf16_t* base = sg + (u.pn - 24) * 256 + wc * 32 + 8 * fq;
#pragma unroll
            for (int ai = 0; ai < 2; ++ai)
#pragma unroll
                for (int m = 0; m < 4; ++m) { bf16_t* rowp = base + (size_t)(row0 + ai * HALF + m * 16) * 4096;
#pragma unroll
                    for (int bj = 0; bj < 2; ++bj) { float s[8];
#pragma unroll
                        for (int e = 0; e < 4; ++e) { s[e] = frcp(1.f + fexp2(-LOG2E * acc[ai][bj][m][0][e])); s[4 + e] = frcp(1.f + fexp2(-LOG2E * acc[ai][bj][m][1][e])); }
                        u32x4 w; w.x = pk2(s[0], s[1]); w.y = pk2(s[2], s[3]); w.z = pk2(s[4], s[5]); w.w = pk2(s[6], s[7]);
                        *(u32x4*)(rowp + bj * HALF) = w; } }
        }
    }
};
template <int SECOND> struct EpiGate {
    const bf16_t* sg;
    bf16_t* tmp; bf16_t* merged;
    __device__ __forceinline__ void operator()(const f32x4 (&acc)[2][2][4][2], const Unit& u, int wr, int wc, int fr, int fq) const {
        const int row0 = u.pm * BM + wr * 64 + fr, col0 = u.pn * BM + wc * 32 + 8 * fq;
#pragma unroll
        for (int ai = 0; ai < 2; ++ai)
#pragma unroll
            for (int m = 0; m < 4; ++m) { const size_t row = (size_t)(row0 + ai * HALF + m * 16);
#pragma unroll
                for (int bj = 0; bj < 2; ++bj) { const int col = col0 + bj * HALF;
                    const u32x4 gv = *(const u32x4*)(sg + row * 4096 + col);
                    const f32x4 g0 = {bf_lo(gv.x), bf_hi(gv.x), bf_lo(gv.y), bf_hi(gv.y)}, g1 = {bf_lo(gv.z), bf_hi(gv.z), bf_lo(gv.w), bf_hi(gv.w)};
                    f32x4 v0 = acc[ai][bj][m][0] * g0, v1 = acc[ai][bj][m][1] * g1;
                    bf16_t* tp = tmp + row * DM + col;
                    if (SECOND == 0) { u32x4 w; w.x = pk2(v0[0], v0[1]); w.y = pk2(v0[2], v0[3]); w.z = pk2(v1[0], v1[1]); w.w = pk2(v1[2], v1[3]); *(u32x4*)tp = w; }
                    else { const u32x4 tv = *(const u32x4*)tp; v0 += (f32x4){bf_lo(tv.x), bf_hi(tv.x), bf_lo(tv.y), bf_hi(tv.y)}; v1 += (f32x4){bf_lo(tv.z), bf_hi(tv.z), bf_lo(tv.w), bf_hi(tv.w)};
                        u32x4 w; w.x = pk2(v0[0], v0[1]); w.y = pk2(v0[2], v0[3]); w.z = pk2(v1[0], v1[1]); w.w = pk2(v1[2], v1[3]);
                        *(u32x4*)(merged + row * DM + col) = w; } } }
    }
};
struct EpiResid {
    const float* x; float* x1; bf16_t* x1b; float* rowss;
    __device__ __forceinline__ void operator()(const f32x4 (&acc)[2][2][4][2], const Unit& u, int wr, int wc, int fr, int fq) const {
        const int row0 = u.pm * BM + wr * 64 + fr, col0 = u.pn * BM + wc * 32 + 8 * fq;
#pragma unroll
        for (int ai = 0; ai < 2; ++ai)
#pragma unroll
            for (int m = 0; m < 4; ++m) { const size_t row = (size_t)(row0 + ai * HALF + m * 16); float ss = 0.f;
#pragma unroll
                for (int bj = 0; bj < 2; ++bj) { const size_t o = row * DM + col0 + bj * HALF;
                    const f32x4 v0 = acc[ai][bj][m][0] + *(const f32x4*)(x + o), v1 = acc[ai][bj][m][1] + *(const f32x4*)(x + o + 4);
                    u32x4 w; w.x = pk2(v0[0], v0[1]); w.y = pk2(v0[2], v0[3]); w.z = pk2(v1[0], v1[1]); w.w = pk2(v1[2], v1[3]);
                    *(u32x4*)(x1b + o) = w;
                    ss += (v0[0] * v0[0] + v0[1] * v0[1]) + (v0[2] * v0[2] + v0[3] * v0[3]) + (v1[0] * v1[0] + v1[1] * v1[1]) + (v1[2] * v1[2] + v1[3] * v1[3]); }
                ss += __shfl_xor(ss, 16); ss += __shfl_xor(ss, 32);
                if (fq == 0) atomicAdd(rowss + row, ss); }
    }
};
struct EpiPlainBf16 {
    bf16_t* o;
    __device__ __forceinline__ void operator()(const f32x4 (&acc)[2][2][4][2], const Unit& u, int wr, int wc, int fr, int fq) const {
        const int row0 = u.pm * BM + wr * 64 + fr, col0 = u.pn * BM + wc * 32 + 8 * fq;
#pragma unroll
        for (int ai = 0; ai < 2; ++ai)
#pragma unroll
            for (int m = 0; m < 4; ++m) { const size_t row = (size_t)(row0 + ai * HALF + m * 16);
#pragma unroll
                for (int bj = 0; bj < 2; ++bj) { const f32x4 v0 = acc[ai][bj][m][0], v1 = acc[ai][bj][m][1];
                    u32x4 w; w.x = pk2(v0[0], v0[1]); w.y = pk2(v0[2], v0[3]); w.z = pk2(v1[0], v1[1]); w.w = pk2(v1[2], v1[3]);
                    *(u32x4*)(o + row * DM + col0 + bj * HALF) = w; } }
    }
};
}

__device__ __forceinline__ void transpose_item(const float* W, int ldw, int src_n0, bf16_t* WT, int K, int dst_n0, int k0, LAS float* scr, int lane, const float* kscale) {
#pragma unroll 8
    for (int i = 0; i < 32; ++i) { const int kk = 2 * i + (lane >> 5); float v = W[(size_t)(k0 + kk) * ldw + src_n0 + (lane & 31)]; if (kscale) v *= kscale[k0 + kk]; scr[kk * 33 + (lane & 31)] = v; }
    LDS_WAIT();
    const int c = lane & 7;
#pragma unroll
    for (int j = 0; j < 4; ++j) { const int n = (lane >> 3) + 8 * j; const LAS float* s = scr + (8 * c) * 33 + n;
        u32x4 o; o.x = pk2(s[0 * 33], s[1 * 33]); o.y = pk2(s[2 * 33], s[3 * 33]); o.z = pk2(s[4 * 33], s[5 * 33]); o.w = pk2(s[6 * 33], s[7 * 33]);
        *(u32x4*)(WT + (size_t)(dst_n0 + n) * K + k0 + 8 * c) = o; }
    LDS_WAIT();
}

__device__ __forceinline__ void p0a(const Params& P, LAS unsigned char* lds, int vcu, int G) {
    const int tid = threadIdx.x, lane = tid & 63, wave = __builtin_amdgcn_readfirstlane(tid >> 6);
    const int gw = vcu * NWAVES + wave, NGW = G * NWAVES;
    unsigned char* ws = P.ws;
    {
        unsigned* CMAX = (unsigned*)(ws + WS_CTL + CTL_CMAX);
        constexpr int NCB = (10248 + 255) / 256;
        for (int it = gw; it < 128 * NCB; it += NGW) { const int kb = it / NCB, cb = it % NCB, sc = cb * 256 + 4 * lane;
            if (sc < 10248) { f32x4 v[16];
#pragma unroll
                for (int r = 0; r < 16; ++r) v[r] = *(const f32x4*)(P.w_in + (size_t)(kb * 16 + r) * 10248 + sc);
                float m0 = 0.f, m1 = 0.f, m2 = 0.f, m3 = 0.f;
#pragma unroll
                for (int r = 0; r < 16; ++r) { m0 = fmaxf(m0, fabsf(v[r][0])); m1 = fmaxf(m1, fabsf(v[r][1])); m2 = fmaxf(m2, fabsf(v[r][2])); m3 = fmaxf(m3, fabsf(v[r][3])); }
                const float mm[4] = {m0, m1, m2, m3};
#pragma unroll
                for (int e = 0; e < 4; ++e) { const int c = sc + e; const unsigned mb = __float_as_uint(mm[e]);
                    if (c < 6144) atomicMax(CMAX + c, mb); else if (c >= 6152) atomicMax(CMAX + c - 8, mb); } } }
    }
    {
        LAS float* wf = (LAS float*)lds;
        for (int idx = tid; idx < 2048 * 8; idx += NTHR) { const int k = idx >> 3, c = idx & 7; wf[c * 2048 + k] = P.w_in[(size_t)k * 10248 + 6144 + c]; }
        __syncthreads();
        unsigned char* HQ8 = ws + WS_H; float* HSC = (float*)(ws + WS_HSC); float* LOGF = (float*)(ws + WS_LOGF);
        for (int r = gw; r < T_TOK; r += NGW) {
            const f32x4* xr = (const f32x4*)(P.x + (size_t)r * DM) + lane;
            float ss = 0.f, amx = 0.f; f32x4 hv[8];
#pragma unroll
            for (int j = 0; j < 8; ++j) { const f32x4 v = xr[64 * j]; const f32x4 gn = *((const f32x4*)P.g_mix + lane + 64 * j); ss += (v[0] * v[0] + v[1] * v[1]) + (v[2] * v[2] + v[3] * v[3]);
                hv[j] = v * gn; amx = fmaxf(amx, fmaxf(fmaxf(fabsf(hv[j][0]), fabsf(hv[j][1])), fmaxf(fabsf(hv[j][2]), fabsf(hv[j][3])))); }
            const float rstd = 1.0f / sqrtf(wave_sum(ss) * (1.f / DM) + EPS);
#pragma unroll
            for (int o = 1; o < 64; o <<= 1) amx = fmaxf(amx, __shfl_xor(amx, o));
            const float hmax = fmaxf(amx * rstd, 1e-30f), hinv = 127.f / hmax;
            float fl[8];
#pragma unroll
            for (int c = 0; c < 8; ++c) fl[c] = 0.f;
            unsigned* hp = (unsigned*)(HQ8 + (size_t)r * DM) + lane;
#pragma unroll
            for (int j = 0; j < 8; ++j) { const f32x4 h = hv[j] * rstd;
                unsigned w = 0;
#pragma unroll
                for (int e = 0; e < 4; ++e) w |= ((unsigned)(int)__builtin_rintf(h[e] * hinv) & 255u) << (8 * e);
                hp[64 * j] = w;
#pragma unroll
                for (int c = 0; c < 8; ++c) { const f32x4 wv = *((const LAS f32x4*)(wf + c * 2048) + lane + 64 * j); fl[c] += (h[0] * wv[0] + h[1] * wv[1]) + (h[2] * wv[2] + h[3] * wv[3]); }
                __builtin_amdgcn_sched_barrier(0); }
#pragma unroll
            for (int c = 0; c < 8; ++c) fl[c] = wave_sum(fl[c]);
            if (lane == 0) { HSC[r] = hmax * (1.f / 127.f);
#pragma unroll
                for (int c = 0; c < 8; ++c) { const float y = fl[c] + P.b_forget[c]; LOGF[(size_t)r * 8 + c] = fminf(y, 0.f) - log1pf(expf(-fabsf(y))); }
            }
        }
    }
    {
        const size_t gid = (size_t)vcu * NTHR + tid, gstride = (size_t)G * NTHR;
        for (size_t i = gid; i < 262144 / 8; i += gstride) { const float* src = P.sub_keys + i * 8; const f32x4 a = *(const f32x4*)src, b = *((const f32x4*)src + 1);
            u32x4 o; o.x = pk2(a[0], a[1]); o.y = pk2(a[2], a[3]); o.z = pk2(b[0], b[1]); o.w = pk2(b[2], b[3]); *(u32x4*)((bf16_t*)(ws + WS_SKB) + i * 8) = o; }
    }
}
__device__ __forceinline__ void p0b(const Params& P, LAS unsigned char* lds, int vcu, int G) {
    const int tid = threadIdx.x, lane = tid & 63, wave = __builtin_amdgcn_readfirstlane(tid >> 6);
    const int gw = vcu * NWAVES + wave, NGW = G * NWAVES;
    unsigned char* ws = P.ws;
    const unsigned* CMAX = (const unsigned*)(ws + WS_CTL + CTL_CMAX); float* WSC = (float*)(ws + WS_WSC); unsigned char* WT8 = ws + WS_WIN;
    LAS float* scr = (LAS float*)(lds + wave * 16384);
    for (int it = gw; it < 32 * 320; it += NGW) {
        const int nb = it >> 5, kb = it & 31, dn = nb * 32, sn = dn < 6144 ? dn : dn + 8, k0 = kb * 64;
        const int c4 = (lane & 7) * 4;
        float inv[4];
#pragma unroll
        for (int e = 0; e < 4; ++e) { const float cm = fmaxf(__uint_as_float(__hip_atomic_load(CMAX + dn + c4 + e, __ATOMIC_RELAXED, __HIP_MEMORY_SCOPE_AGENT)), 1e-30f); inv[e] = 127.f / cm;
            if (kb == 0 && lane < 8) WSC[dn + c4 + e] = cm * (1.f / 127.f); }
        f32x4 v[8];
#pragma unroll
        for (int i = 0; i < 8; ++i) v[i] = *(const f32x4*)(P.w_in + (size_t)(k0 + 8 * i + (lane >> 3)) * 10248 + sn + c4);
#pragma unroll
        for (int i = 0; i < 8; ++i) { LAS float* sp = scr + (8 * i + (lane >> 3)) * 33 + c4; sp[0] = v[i][0] * inv[0]; sp[1] = v[i][1] * inv[1]; sp[2] = v[i][2] * inv[2]; sp[3] = v[i][3] * inv[3]; }
        LDS_WAIT();
        const int c = lane & 3;
#pragma unroll
        for (int j = 0; j < 2; ++j) { const int n = (lane >> 2) + 16 * j; const LAS float* sp = scr + (16 * c) * 33 + n;
            u32x4 o;
#pragma unroll
            for (int w4 = 0; w4 < 4; ++w4) { unsigned w = 0;
#pragma unroll
                for (int e = 0; e < 4; ++e) w |= ((unsigned)(int)fminf(fmaxf(__builtin_rintf(sp[(4 * w4 + e) * 33]), -127.f), 127.f) & 255u) << (8 * e);
                o[w4] = w; }
            *(u32x4*)(WT8 + (size_t)(dn + n) * 2048 + k0 + 16 * c) = o; }
        LDS_WAIT();
    }
}
__device__ __forceinline__ void late_transposes(const Params& P, LAS unsigned char* lds, int vcu, int G) {
    const int tid = threadIdx.x, lane = tid & 63, wave = __builtin_amdgcn_readfirstlane(tid >> 6);
    const int gw = vcu * NWAVES + wave, NGW = G * NWAVES;
    unsigned char* ws = P.ws;
    LAS float* scr = (LAS float*)(lds + wave * 16384);
    constexpr int I_A = 16 * 64, I_O = 32 * 64, NITEMS = 2 * I_A + 2 * I_O;
    for (int it = gw; it < NITEMS; it += NGW) {
        int r = it;
        if (r < I_A) { const int kb = r / 64, nb = r % 64; transpose_item(P.w_a, 2048, nb * 32, (bf16_t*)(ws + WS_WAT), 1024, nb * 32, kb * 64, scr, lane, nullptr); continue; } r -= I_A;
        if (r < I_A) { const int kb = r / 64, nb = r % 64; transpose_item(P.w_b, 2048, nb * 32, (bf16_t*)(ws + WS_WBT), 1024, nb * 32, kb * 64, scr, lane, nullptr); continue; } r -= I_A;
        if (r < I_O) { const int kb = r / 64, nb = r % 64; transpose_item(P.w_out, 2048, nb * 32, (bf16_t*)(ws + WS_WOUT), 2048, nb * 32, kb * 64, scr, lane, nullptr); continue; } r -= I_O;
        { const int kb = r / 64, nb = r % 64; transpose_item(P.w_query, 2048, nb * 32, (bf16_t*)(ws + WS_WQ), 2048, nb * 32, kb * 64, scr, lane, P.g_ffn); }
    }
}
__device__ __forceinline__ void quantise_expert_rows(const Params& P, int r0, int nrows) {
    const int lane = threadIdx.x & 63;
    unsigned char* ws = P.ws;
    float* SU = (float*)(ws + WS_SU); float* SV = (float*)(ws + WS_SV);
    for (int r = r0; r < r0 + nrows; ++r) {
        const bool second = r >= 16384; const int row = second ? r - 16384 : r;
        const f32x4* src = (const f32x4*)((second ? P.e_v : P.e_u) + (size_t)row * DM) + lane;
        f32x4 v[8]; float mx = 0.f;
#pragma unroll
        for (int j = 0; j < 8; ++j) { v[j] = __builtin_nontemporal_load(src + 64 * j); mx = fmaxf(mx, fmaxf(fmaxf(fabsf(v[j][0]), fabsf(v[j][1])), fmaxf(fabsf(v[j][2]), fabsf(v[j][3])))); }
#pragma unroll
        for (int o = 1; o < 64; o <<= 1) mx = fmaxf(mx, __shfl_xor(mx, o));
        mx = fmaxf(mx, 1e-30f);
        const float inv = 127.f / mx; const int bias = 0;
        unsigned* dst = (unsigned*)(ws + (second ? WS_EV : WS_EU) + (size_t)row * DM) + lane;
#pragma unroll
        for (int j = 0; j < 8; ++j) { unsigned w = 0;
#pragma unroll
            for (int e = 0; e < 4; ++e) { const int q = (int)__builtin_rintf(v[j][e] * inv) + bias; w |= ((unsigned)q & 255u) << (8 * e); }
            dst[64 * j] = w; }
        if (lane == 0) (second ? SV : SU)[row] = mx * (1.f / 127.f);
    }
}

namespace att {
constexpr int KST = 272, VST = 320;
constexpr int KBUF = 64 * KST, VBUF = 64 * VST;
constexpr int OFF_K = 0, OFF_V = 2 * KBUF, OFF_F = OFF_V + 2 * VBUF, OFF_SC = OFF_F + 4096 * 4;
constexpr int OFF_FLG = OFF_SC + 64, OFF_UNIT = OFF_FLG + 64;
static_assert(OFF_UNIT + 16 <= 131072, "attention LDS");
constexpr float THR_SB = 30.f, THR_FOX = 20.f;

__device__ __forceinline__ void build_cumf(LAS unsigned char* lds, const float* LOGF, int b, int h, int n, int tid, int lane, int wid) {
    LAS float* F2 = (LAS float*)(lds + OFF_F); LAS float* sc = (LAS float*)(lds + OFF_SC);
    const int s0 = tid * 8; float v[8];
#pragma unroll
    for (int i = 0; i < 8; ++i) v[i] = (s0 < n) ? LOGF[((size_t)b * SEQ + s0 + i) * 8 + h] * LOG2E : 0.f;
#pragma unroll
    for (int i = 1; i < 8; ++i) v[i] += v[i - 1];
    float tot = v[7], inc = tot;
#pragma unroll
    for (int o = 1; o < 64; o <<= 1) { const float t = __shfl_up(inc, o); if (lane >= o) inc += t; }
    if (lane == 63) sc[wid] = inc;
    __syncthreads();
    float base = inc - tot;
#pragma unroll
    for (int w = 0; w < 8; ++w) if (w < wid) base += sc[w];
    if (s0 < n) {
#pragma unroll
        for (int i = 0; i < 8; ++i) F2[s0 + i] = v[i] + base;
    }
    __syncthreads();
}

template <int MIXER>
__device__ __forceinline__ void attn_unit(LAS unsigned char* lds, const bf16_t* Q, const bf16_t* Kg, const bf16_t* Vg, bf16_t* O, int b, int h, int qb, float kmax, int tid, int lane, int wid) {
    const int c = lane & 31, hh = lane >> 5;
    const int t0 = qb * 256 + wid * 32, tq = t0 + c;
    const size_t rowbase = (size_t)b * SEQ;
    size_t qoff = (rowbase + tq) * 1024 + h * HD + 8 * hh;
    f32x16 oacc[4];
#pragma unroll
    for (int d = 0; d < 4; ++d)
#pragma unroll
        for (int r = 0; r < 16; ++r) oacc[d][r] = 0.f;
    float carry = 0.f, mrun = -1e30f, lsum = 0.f; const float nhf = hh ? 0.f : 1.f;
    const LAS float* F2 = (const LAS float*)(lds + OFF_F);
    const float Ft = (MIXER == 1) ? F2[tq] : 0.f;
    float qk_bound = 0.f;
    if (MIXER == 1) { float qs = 0.f;
#pragma unroll
        for (int s2 = 0; s2 < 8; ++s2) { const u32x4 qv = *(const u32x4*)(Q + qoff + 16 * s2);
#pragma unroll
            for (int e = 0; e < 4; ++e) { const float a = bf_lo(qv[e]), b2 = bf_hi(qv[e]); qs += a * a + b2 * b2; } }
        qs += __shfl_xor(qs, 32);
        qk_bound = sqrtf(qs) * kmax; }
    bool wave_done = false;
    volatile LAS unsigned* flg = (volatile LAS unsigned*)(lds + OFF_FLG);
    const int ktmax = 4 * qb + 3;
    const int srow = tid >> 4, scc = tid & 15;
    u32x4 kr[2], vr[2];
#define ATT_LOAD(kt) do { _Pragma("unroll") for (int j = 0; j < 2; ++j) { const size_t g_ = (rowbase + 64 * (kt) + srow + 32 * j) * 1024 + h * HD + scc * 8; \
        kr[j] = *(const u32x4*)(Kg + g_); vr[j] = *(const u32x4*)(Vg + g_); } } while (0)
#define ATT_WRITE(buf) do { _Pragma("unroll") for (int j = 0; j < 2; ++j) { \
        *(LAS u32x4*)(lds + OFF_K + (buf) * KBUF + (srow + 32 * j) * KST + scc * 16) = kr[j]; \
        *(LAS u32x4*)(lds + OFF_V + (buf) * VBUF + (srow + 32 * j) * VST + scc * 16) = vr[j]; } } while (0)
    ATT_LOAD(ktmax); ATT_WRITE(0); __syncthreads();
    int buf = 0;
    for (int kt = ktmax; kt >= 0; --kt) {
        if (kt > 0) ATT_LOAD(kt - 1);
        const bool started = (64 * kt <= t0 + 31);
        if (started && !wave_done) {
            const LAS unsigned char* Kl = lds + OFF_K + buf * KBUF; const LAS unsigned char* Vl = lds + OFF_V + buf * VBUF;
            f32x16 sacc[2];
            asm volatile("" : "+v"(qoff));
            bf16x8 qf[8];
#pragma unroll
            for (int s = 0; s < 8; ++s) qf[s] = *(const bf16x8*)(Q + qoff + 16 * s);
#pragma unroll
            for (int sub = 0; sub < 2; ++sub) {
#pragma unroll
                for (int r = 0; r < 16; ++r) sacc[sub][r] = 0.f;
#pragma unroll
                for (int s = 0; s < 8; ++s) { const bf16x8 kf = *(const LAS bf16x8*)(Kl + (32 * sub + c) * KST + (16 * s + 8 * hh) * 2);
                    sacc[sub] = __builtin_amdgcn_mfma_f32_32x32x16_bf16(kf, qf[s], sacc[sub], 0, 0, 0); }
            }
            const bool need_mask = (64 * kt + 63 >= t0);
            bool tile_dead = false;
            if (MIXER == 0) {
#pragma unroll
                for (int sub = 1; sub >= 0; --sub) {
                    float lb[16];
#pragma unroll
                    for (int r = 0; r < 16; ++r) { const float z = sacc[sub][r]; float l = -flog2(1.f + fexp2(z));
                        if (need_mask) { const int sidx = 64 * kt + 32 * sub + (r & 3) + 8 * (r >> 2) + 4 * hh; l = (sidx < tq) ? l : 0.f; }
                        lb[r] = l; }
                    float Glo[4], Ghi[4];
#pragma unroll
                    for (int g = 0; g < 4; ++g) { lb[4 * g + 2] += lb[4 * g + 3]; lb[4 * g + 1] += lb[4 * g + 2]; lb[4 * g] += lb[4 * g + 1];
                        const unsigned gu = __builtin_bit_cast(unsigned, lb[4 * g]); const auto rr = __builtin_amdgcn_permlane32_swap(gu, gu, false, false);
                        Glo[g] = __builtin_bit_cast(float, (unsigned)rr[0]); Ghi[g] = __builtin_bit_cast(float, (unsigned)rr[1]); }
                    float E[8];
                    E[7] = carry; E[6] = E[7] + Ghi[3]; E[5] = E[6] + Glo[3]; E[4] = E[5] + Ghi[2]; E[3] = E[4] + Glo[2]; E[2] = E[3] + Ghi[1]; E[1] = E[2] + Glo[1]; E[0] = E[1] + Ghi[0];
                    carry = E[0] + Glo[0];
#pragma unroll
                    for (int g = 0; g < 4; ++g) { const float Eo = __builtin_fmaf(nhf, Ghi[g], E[2 * g + 1]);
#pragma unroll
                        for (int i = 0; i < 4; ++i) { const int r = 4 * g + i; float w = fexp2(sacc[sub][r] + lb[r] + Eo);
                            if (need_mask) { const int sidx = 64 * kt + 32 * sub + (r & 3) + 8 * (r >> 2) + 4 * hh; w = (sidx < tq) ? w : 0.f; }
                            sacc[sub][r] = w; } }
                }
            } else {
                float mx = -1e30f;
#pragma unroll
                for (int sub = 0; sub < 2; ++sub)
#pragma unroll
                    for (int g = 0; g < 4; ++g) { const f32x4 fs = *(const LAS f32x4*)(F2 + 64 * kt + 32 * sub + 8 * g + 4 * hh);
#pragma unroll
                        for (int i = 0; i < 4; ++i) { const int r = 4 * g + i; float xv = sacc[sub][r] + (Ft - fs[i]);
                            if (need_mask) { const int sidx = 64 * kt + 32 * sub + 8 * g + 4 * hh + i; xv = (sidx <= tq) ? xv : -1e30f; }
                            sacc[sub][r] = xv; mx = fmaxf(mx, xv); } }
                { const unsigned mu = __builtin_bit_cast(unsigned, mx); const auto rr = __builtin_amdgcn_permlane32_swap(mu, mu, false, false);
                  mx = fmaxf(__builtin_bit_cast(float, (unsigned)rr[0]), __builtin_bit_cast(float, (unsigned)rr[1])); }
                tile_dead = __all(mx - mrun < -THR_FOX);
                if (!tile_dead) {
                const float mnew = fmaxf(mrun, mx);
                const float alpha = fexp2(mrun - mnew);
                float ps = 0.f;
#pragma unroll
                for (int sub = 0; sub < 2; ++sub)
#pragma unroll
                    for (int r = 0; r < 16; ++r) { const float p = fexp2(sacc[sub][r] - mnew); sacc[sub][r] = p; ps += p; }
                lsum = lsum * alpha + ps;
                if (__any(mnew > mrun)) {
#pragma unroll
                    for (int d = 0; d < 4; ++d)
#pragma unroll
                        for (int r = 0; r < 16; ++r) oacc[d][r] *= alpha;
                }
                mrun = mnew;
                }
            }
            if (!tile_dead)
#pragma unroll
            for (int ks = 0; ks < 4; ++ks) { const int sub = ks >> 1, rb = 8 * (ks & 1);
                u32x4 pw; pw.x = pk2(sacc[sub][rb + 0], sacc[sub][rb + 1]); pw.y = pk2(sacc[sub][rb + 2], sacc[sub][rb + 3]); pw.z = pk2(sacc[sub][rb + 4], sacc[sub][rb + 5]); pw.w = pk2(sacc[sub][rb + 6], sacc[sub][rb + 7]);
                const bf16x8 pf = __builtin_bit_cast(bf16x8, pw);
                const LAS unsigned char* vb = Vl + (16 * ks + 4 * hh + ((lane & 15) >> 2)) * VST + (16 * ((lane >> 4) & 1) + 4 * (lane & 3)) * 2;
#pragma unroll
                for (int d = 0; d < 4; ++d) {
                    const s16x4 a0 = __builtin_amdgcn_ds_read_tr16_b64_v4i16((LAS s16x4*)(vb + d * 64));
                    const s16x4 a1 = __builtin_amdgcn_ds_read_tr16_b64_v4i16((LAS s16x4*)(vb + d * 64 + 8 * VST));
                    const bf16x8 af = {a0[0], a0[1], a0[2], a0[3], a1[0], a1[1], a1[2], a1[3]};
                    oacc[d] = __builtin_amdgcn_mfma_f32_32x32x16_bf16(af, pf, oacc[d], 0, 0, 0); }
            }
        }
        if (kt > 0) ATT_WRITE(buf ^ 1);
        if (kt > 0 && started && !wave_done) {
            if (MIXER == 0) wave_done = __all(carry < -THR_SB);
            else wave_done = __all(qk_bound + (Ft - F2[64 * kt - 1]) - mrun < -THR_FOX);
        }
        if (lane == 0) flg[(kt & 1) * 8 + wid] = wave_done ? 1u : 0u;
        __syncthreads();
        buf ^= 1;
        { unsigned alld = 1u;
#pragma unroll
          for (int w = 0; w < 8; ++w) alld &= flg[(kt & 1) * 8 + w];
          if (alld) break; }
    }
#undef ATT_LOAD
#undef ATT_WRITE
    float inv = 1.f;
    if (MIXER == 1) { const unsigned lu = __builtin_bit_cast(unsigned, lsum); const auto rr = __builtin_amdgcn_permlane32_swap(lu, lu, false, false);
        inv = 1.f / (__builtin_bit_cast(float, (unsigned)rr[0]) + __builtin_bit_cast(float, (unsigned)rr[1])); }
    bf16_t* op = O + (rowbase + tq) * 2048 + 4 * hh;
#pragma unroll
    for (int d = 0; d < 4; ++d)
#pragma unroll
        for (int g = 0; g < 4; ++g) { u32x2 w; w.x = pk2(oacc[d][4 * g] * inv, oacc[d][4 * g + 1] * inv); w.y = pk2(oacc[d][4 * g + 2] * inv, oacc[d][4 * g + 3] * inv);
            *(u32x2*)(op + 32 * d + 8 * g) = w; }
}

__device__ __forceinline__ void attn_phase(const Params& P, LAS unsigned char* lds, int vcu, int G) {
    const int tid = threadIdx.x, lane = tid & 63, wid = __builtin_amdgcn_readfirstlane(tid >> 6);
    unsigned char* ws = P.ws;
    const bf16_t* QKV = (const bf16_t*)(ws + WS_QKV); const size_t TS = (size_t)T_TOK * 1024;
    bf16_t* OAB = (bf16_t*)(ws + WS_H); const float* LOGF = (const float*)(ws + WS_LOGF);
    unsigned* qctr = (unsigned*)(ws + WS_CTL + 196608);
    const unsigned* KMAXW = (const unsigned*)(ws + WS_CTL + 200704);
    volatile LAS unsigned* uw = (volatile LAS unsigned*)(lds + OFF_UNIT);
    for (;;) {
        if (tid == 0) uw[0] = atomicAdd(qctr, 1u);
        __syncthreads();
        const unsigned u = uw[0];
        __syncthreads();
        if (u >= 1024u) break;
        if (u >= 512u) { quantise_expert_rows(P, (int)(u - 512u) * 64 + wid * 8, 8); continue; }
        const int mixer = (u < 256u) ? 1 : 0, v = (int)(u & 255u), qb = 15 - (v >> 4), bh = v & 15, b = bh >> 3, h = bh & 7;
        if (mixer == 0) {
            attn_unit<0>(lds, QKV, QKV + TS, QKV + 2 * TS, OAB + h * HD, b, h, qb, 0.f, tid, lane, wid);
        } else {
            float k2 = 0.f;
#pragma unroll
            for (int w = 0; w < 4; ++w) k2 += __builtin_bit_cast(float, __hip_atomic_load(KMAXW + bh * 4 + w, __ATOMIC_RELAXED, __HIP_MEMORY_SCOPE_AGENT));
            const float kmax = sqrtf(k2) * 1.01f;
            build_cumf(lds, LOGF, b, h, 256 * (qb + 1), tid, lane, wid);
            attn_unit<1>(lds, QKV + 3 * TS, QKV + 4 * TS, QKV + 5 * TS, OAB + 1024 + h * HD, b, h, qb, kmax, tid, lane, wid);
        }
        __syncthreads();
    }
}
}

namespace peer {
__device__ __forceinline__ unsigned sortable(float f) { const unsigned u = __builtin_bit_cast(unsigned, f); return (u & 0x80000000u) ? ~u : (u | 0x80000000u); }
__device__ __forceinline__ float unsortable(unsigned k) { const unsigned u = (k & 0x80000000u) ? (k & 0x7fffffffu) : ~k; return __builtin_bit_cast(float, u); }
#define CE_DESC(x, y) do { const unsigned hi_ = (x) > (y) ? (x) : (y); const unsigned lo_ = (x) > (y) ? (y) : (x); (x) = hi_; (y) = lo_; } while (0)
template <int B, int N> __device__ __forceinline__ void sort16_desc(unsigned (&a)[N]) {
#pragma unroll
    for (int k = 2; k <= 16; k <<= 1)
#pragma unroll
        for (int j = k >> 1; j > 0; j >>= 1)
#pragma unroll
            for (int i = 0; i < 16; ++i) { const int l = i ^ j; if (l > i) { if ((i & k) == 0) CE_DESC(a[B + i], a[B + l]); else CE_DESC(a[B + l], a[B + i]); } }
}
template <int A, int Bq, int N> __device__ __forceinline__ void merge_top16(unsigned (&a)[N]) {
#pragma unroll
    for (int i = 0; i < 16; ++i) { const unsigned x = a[A + i], y = a[Bq + 15 - i]; a[A + i] = x > y ? x : y; }
#pragma unroll
    for (int j = 8; j > 0; j >>= 1)
#pragma unroll
        for (int i = 0; i < 16; ++i) { const int l = i ^ j; if (l > i) CE_DESC(a[A + i], a[A + l]); }
}

__device__ __forceinline__ void topk_phase(const Params& P, LAS unsigned char* lds, int vcu, int G) {
    const int tid = threadIdx.x, lane = tid & 63, wave = __builtin_amdgcn_readfirstlane(tid >> 6);
    const int c = lane & 31, hh = lane >> 5;
    const int gw = vcu * NWAVES + wave, NGW = G * NWAVES;
    unsigned char* ws = P.ws;
    const bf16_t* Q2 = (const bf16_t*)(ws + WS_Q2); const bf16_t* SKB = (const bf16_t*)(ws + WS_SKB);
    const float* ROWSS = (const float*)(ws + WS_CTL); int* IDS = (int*)(ws + WS_IDS); float* GATES = (float*)(ws + WS_GATES);
    LAS unsigned char* scr = lds + wave * 4096;
    for (int task = gw; task < 2048; task += NGW) {
        const int tg = task >> 3, hd = task & 7, tok = tg * 32 + c;
#pragma unroll 1
        for (int p = 0; p < 2; ++p) {
            bf16x8 qf[8];
            { const bf16_t* qp = Q2 + (size_t)tok * DM + hd * 256 + p * 128 + 8 * hh;
#pragma unroll
              for (int s = 0; s < 8; ++s) qf[s] = *(const bf16x8*)(qp + 16 * s); }
            unsigned keys[64];
#pragma unroll
            for (int sub = 0; sub < 4; ++sub) {
                f32x16 acc;
#pragma unroll
                for (int r = 0; r < 16; ++r) acc[r] = 0.f;
                const bf16_t* kp = SKB + ((size_t)(hd * 2 + p) * 128 + 32 * sub + c) * 128 + 8 * hh;
#pragma unroll
                for (int s = 0; s < 8; ++s) { const bf16x8 kf = *(const bf16x8*)(kp + 16 * s); acc = __builtin_amdgcn_mfma_f32_32x32x16_bf16(kf, qf[s], acc, 0, 0, 0); }
#pragma unroll
                for (int r = 0; r < 16; ++r) { const int nlo = 127 - (32 * sub + (r & 3) + 8 * (r >> 2)); keys[sub * 16 + r] = (sortable(acc[r]) & ~127u) | (unsigned)(nlo - 4 * hh); }
            }
            sort16_desc<0>(keys); sort16_desc<16>(keys); sort16_desc<32>(keys); sort16_desc<48>(keys);
            merge_top16<0, 16>(keys); merge_top16<32, 48>(keys); merge_top16<0, 32>(keys);
#pragma unroll
            for (int i = 0; i < 16; ++i) { const unsigned own = keys[i]; const auto rr = __builtin_amdgcn_permlane32_swap(own, own, false, false); keys[16 + i] = hh ? (unsigned)rr[0] : (unsigned)rr[1]; }
            merge_top16<0, 16>(keys);
            if (hh == 0) {
#pragma unroll
                for (int w = 0; w < 4; ++w) *(LAS u32x4*)(scr + (c * 2 + p) * 64 + w * 16) = (u32x4){keys[4 * w], keys[4 * w + 1], keys[4 * w + 2], keys[4 * w + 3]};
            }
        }
        LDS_WAIT();
        float s1[16], s2[16];
#pragma unroll
        for (int w = 0; w < 4; ++w) { const u32x4 a = *(const LAS u32x4*)(scr + (c * 2) * 64 + w * 16), b2 = *(const LAS u32x4*)(scr + (c * 2 + 1) * 64 + w * 16);
#pragma unroll
            for (int e = 0; e < 4; ++e) { s1[4 * w + e] = unsortable((a[e] & ~127u) | 64u); s2[4 * w + e] = unsortable((b2[e] & ~127u) | 64u); } }
        unsigned ck[64];
        { int n = 0;
#pragma unroll
          for (int i = 0; i < 16; ++i)
#pragma unroll
              for (int j = 0; j < 16; ++j) if ((i + 1) * (j + 1) <= 16) { ck[n] = (sortable(s1[i] + s2[j]) & ~255u) | (unsigned)(255 - (i * 16 + j)); ++n; }
#pragma unroll
          for (int q = 50; q < 64; ++q) ck[q] = 0u; }
        sort16_desc<0>(ck); sort16_desc<16>(ck); sort16_desc<32>(ck); sort16_desc<48>(ck);
        merge_top16<0, 16>(ck); merge_top16<32, 48>(ck); merge_top16<0, 32>(ck);
        unsigned t2[16];
#pragma unroll
        for (int k = 0; k < 16; ++k) t2[k] = ck[k];
        int ids[16]; float sc[16];
#pragma unroll
        for (int k = 0; k < 16; ++k) { const unsigned pos = 255u - (t2[k] & 255u);
            const unsigned k1 = *(const LAS unsigned*)(scr + (c * 2) * 64 + (pos >> 4) * 4), k2 = *(const LAS unsigned*)(scr + (c * 2 + 1) * 64 + (pos & 15u) * 4);
            ids[k] = (int)((127u - (k1 & 127u)) * 128u + (127u - (k2 & 127u))); sc[k] = unsortable((t2[k] & ~255u) | 128u); }
        LDS_WAIT();
        const float rs = 1.0f / sqrtf(ROWSS[tok] * (1.f / DM) + EPS);
        float ev[16], Z = 0.f;
#pragma unroll
        for (int k = 0; k < 16; ++k) { ev[k] = fexp2((sc[k] - sc[0]) * rs * LOG2E); Z += ev[k]; }
        const float iz = 1.f / Z;
        int* ip = IDS + (size_t)tok * 128 + hd * 16; float* gp = GATES + (size_t)tok * 128 + hd * 16;
        if (hh == 0) {
#pragma unroll
            for (int k = 0; k < 8; ++k) { ip[k] = ids[k]; gp[k] = ev[k] * iz; }
        } else {
#pragma unroll
            for (int k = 8; k < 16; ++k) { ip[k] = ids[k]; gp[k] = ev[k] * iz; }
        }
    }
}


__device__ __forceinline__ float dot8(u32x4 a, u32x4 b, float acc) {
    const unsigned a0 = a[0], a1 = a[1], a2 = a[2], a3 = a[3], b0 = b[0], b1 = b[1], b2 = b[2], b3 = b[3];
    acc = __builtin_amdgcn_fdot2_f32_bf16(__builtin_bit_cast(bf16v2, a0), __builtin_bit_cast(bf16v2, b0), acc, false);
    acc = __builtin_amdgcn_fdot2_f32_bf16(__builtin_bit_cast(bf16v2, a1), __builtin_bit_cast(bf16v2, b1), acc, false);
    acc = __builtin_amdgcn_fdot2_f32_bf16(__builtin_bit_cast(bf16v2, a2), __builtin_bit_cast(bf16v2, b2), acc, false);
    acc = __builtin_amdgcn_fdot2_f32_bf16(__builtin_bit_cast(bf16v2, a3), __builtin_bit_cast(bf16v2, b3), acc, false);
    return acc;
}
__device__ __forceinline__ float gelu_tanh(float a) { const float t = 1.5957691216f * (a + 0.044715f * a * a * a); return a * frcp(1.f + fexp2(-LOG2E * t)); }

__device__ __forceinline__ int dot16(u32x4 a, u32x4 b, int acc) {
    acc = __builtin_amdgcn_sdot4((int)a[0], (int)b[0], acc, false); acc = __builtin_amdgcn_sdot4((int)a[1], (int)b[1], acc, false);
    acc = __builtin_amdgcn_sdot4((int)a[2], (int)b[2], acc, false); acc = __builtin_amdgcn_sdot4((int)a[3], (int)b[3], acc, false);
    return acc;
}
__device__ __forceinline__ void gather_sweep(const Params& P, LAS unsigned char* lds, int vcu, int G) {
    const int tid = threadIdx.x, lane = tid & 63, wave = __builtin_amdgcn_readfirstlane(tid >> 6);
    const int gw = vcu * NWAVES + wave, NGW = G * NWAVES;
    const int g = lane >> 3, i = lane & 7;
    unsigned char* ws = P.ws;
    const bf16_t* X1B = (const bf16_t*)(ws + WS_X1B); const float* ROWSS = (const float*)(ws + WS_CTL);
    const int* IDS = (const int*)(ws + WS_IDS); const float* GATES = (const float*)(ws + WS_GATES);
    const unsigned char* EU = ws + WS_EU; const unsigned char* EV = ws + WS_EV;
    const float* SU = (const float*)(ws + WS_SU); const float* SV = (const float*)(ws + WS_SV);
    LAS unsigned char* wl = lds + wave * 16384;
    const bool b2 = (lane >> 2) & 1, b1 = (lane >> 1) & 1, b0 = lane & 1, B2 = (lane >> 5) & 1, B1 = (lane >> 4) & 1, B0 = (lane >> 3) & 1;
    for (int tg = gw; tg < T_TOK / 4; tg += NGW) {
        const int tok0 = tg * 4;
        float hs[4];
#pragma unroll
        for (int j = 0; j < 4; ++j) { const int tok = tok0 + j;
            const float rs = 1.0f / sqrtf(ROWSS[tok] * (1.f / DM) + EPS);
            f32x4 hv[8]; float hmx = 0.f;
#pragma unroll
            for (int q = 0; q < 8; ++q) { const u32x2 xb = *((const u32x2*)(X1B + (size_t)tok * DM) + lane + 64 * q); const f32x4 xv = {bf_lo(xb[0]), bf_hi(xb[0]), bf_lo(xb[1]), bf_hi(xb[1])}; const f32x4 gn = *((const f32x4*)P.g_ffn + lane + 64 * q);
                hv[q] = xv * rs * gn; hmx = fmaxf(hmx, fmaxf(fmaxf(fabsf(hv[q][0]), fabsf(hv[q][1])), fmaxf(fabsf(hv[q][2]), fabsf(hv[q][3])))); }
#pragma unroll
            for (int o = 1; o < 64; o <<= 1) hmx = fmaxf(hmx, __shfl_xor(hmx, o));
            hmx = fmaxf(hmx, 1e-30f); const float hinv = 127.f / hmx; hs[j] = hmx * (1.f / 127.f);
#pragma unroll
            for (int q = 0; q < 8; ++q) { unsigned w = 0;
#pragma unroll
                for (int e = 0; e < 4; ++e) w |= ((unsigned)(int)__builtin_rintf(hv[q][e] * hinv) & 255u) << (8 * e);
                *(LAS unsigned*)(wl + j * 2048 + 4 * (lane + 64 * q)) = w; }
#pragma unroll
            for (int hf = 0; hf < 2; ++hf) { const int k = lane + 64 * hf; const int id = IDS[(size_t)tok * 128 + k];
                *(LAS unsigned*)(wl + 8192 + (j * 128 + k) * 4) = (unsigned)id * 2048u;
                *(LAS float*)(wl + 10240 + (j * 128 + k) * 4) = GATES[(size_t)tok * 128 + k] * SV[id];
                *(LAS float*)(wl + 12288 + (j * 128 + k) * 4) = SU[id]; }
        }
        LDS_WAIT();
        int accu[4][16];
#pragma unroll
        for (int j = 0; j < 4; ++j)
#pragma unroll
            for (int m = 0; m < 16; ++m) accu[j][m] = 0;
#pragma unroll 1
        for (int sl = 0; sl < 16; ++sl) {
            __syncthreads();
            const unsigned char* ub = EU + 128 * sl + 16 * i;
#pragma unroll
            for (int j = 0; j < 4; ++j) {
                const u32x4 hqc = *(const LAS u32x4*)(wl + j * 2048 + 128 * sl + 16 * i);
                u32x4 d[16];
#pragma unroll
                for (int m = 0; m < 16; ++m) { const unsigned off = *(const LAS unsigned*)(wl + 8192 + (j * 128 + 8 * m + g) * 4); d[m] = *(const u32x4*)(ub + off); }
#pragma unroll
                for (int m = 0; m < 16; ++m) accu[j][m] = dot16(d[m], hqc, accu[j][m]);
                __builtin_amdgcn_sched_barrier(0);
            }
        }
        float sw[4];
#pragma unroll
        for (int j = 0; j < 4; ++j) {
            int r1[8], r2[4], r3[2];
#pragma unroll
            for (int m = 0; m < 8; ++m) { const int send = b2 ? accu[j][m] : accu[j][m + 8], keep = b2 ? accu[j][m + 8] : accu[j][m]; r1[m] = keep + __shfl_xor(send, 4); }
#pragma unroll
            for (int m = 0; m < 4; ++m) { const int send = b1 ? r1[m] : r1[m + 4], keep = b1 ? r1[m + 4] : r1[m]; r2[m] = keep + __shfl_xor(send, 2); }
#pragma unroll
            for (int m = 0; m < 2; ++m) { const int send = b0 ? r2[m] : r2[m + 2], keep = b0 ? r2[m + 2] : r2[m]; r3[m] = keep + __shfl_xor(send, 1); }
            float w2[2], wmx = 0.f;
#pragma unroll
            for (int m = 0; m < 2; ++m) { const int k = 16 * i + 8 * m + g;
                const float act = (float)r3[m] * (hs[j] * *(const LAS float*)(wl + 12288 + (j * 128 + k) * 4));
                w2[m] = *(const LAS float*)(wl + 10240 + (j * 128 + k) * 4) * gelu_tanh(act); wmx = fmaxf(wmx, fabsf(w2[m])); }
#pragma unroll
            for (int o = 1; o < 64; o <<= 1) wmx = fmaxf(wmx, __shfl_xor(wmx, o));
            wmx = fmaxf(wmx, 1e-30f); sw[j] = wmx * (1.f / 127.f);
            const float winv = 127.f / wmx;
            const unsigned q0 = (unsigned)(int)__builtin_rintf(w2[0] * winv) & 255u, q1 = (unsigned)(int)__builtin_rintf(w2[1] * winv) & 255u;
            *(LAS unsigned short*)(wl + 14336 + j * 128 + 16 * g + 2 * i) = (unsigned short)(q0 | (q1 << 8));
        }
        LDS_WAIT();
        float ssq[4] = {0.f, 0.f, 0.f, 0.f};
#pragma unroll 1
        for (int sl = 0; sl < 16; ++sl) {
            const unsigned char* vb = EV + 128 * sl + 16 * i;
#pragma unroll
            for (int j = 0; j < 4; ++j) {
                u32x4 d[16];
#pragma unroll
                for (int m = 0; m < 16; ++m) { const unsigned off = *(const LAS unsigned*)(wl + 8192 + (j * 128 + 8 * m + g) * 4); d[m] = *(const u32x4*)(vb + off); }
                const u32x4 wpk = *(const LAS u32x4*)(wl + 14336 + j * 128 + 16 * g);
                int ca[16];
#pragma unroll
                for (int b = 0; b < 16; ++b) ca[b] = 0;
#pragma unroll
                for (int mg = 0; mg < 4; ++mg)
#pragma unroll
                    for (int c4 = 0; c4 < 4; ++c4) { const unsigned r0 = d[4 * mg][c4], r1 = d[4 * mg + 1][c4], r2 = d[4 * mg + 2][c4], r3 = d[4 * mg + 3][c4];
                        const unsigned t0 = __builtin_amdgcn_perm(r1, r0, 0x05010400u), t1 = __builtin_amdgcn_perm(r1, r0, 0x07030602u);
                        const unsigned t2 = __builtin_amdgcn_perm(r3, r2, 0x05010400u), t3 = __builtin_amdgcn_perm(r3, r2, 0x07030602u);
                        const int wq4 = (int)wpk[mg];
                        ca[4 * c4 + 0] = __builtin_amdgcn_sdot4((int)__builtin_amdgcn_perm(t2, t0, 0x05040100u), wq4, ca[4 * c4 + 0], false);
                        ca[4 * c4 + 1] = __builtin_amdgcn_sdot4((int)__builtin_amdgcn_perm(t2, t0, 0x07060302u), wq4, ca[4 * c4 + 1], false);
                        ca[4 * c4 + 2] = __builtin_amdgcn_sdot4((int)__builtin_amdgcn_perm(t3, t1, 0x05040100u), wq4, ca[4 * c4 + 2], false);
                        ca[4 * c4 + 3] = __builtin_amdgcn_sdot4((int)__builtin_amdgcn_perm(t3, t1, 0x07060302u), wq4, ca[4 * c4 + 3], false); }
                int c1[8], c2[4], c3[2];
#pragma unroll
                for (int b = 0; b < 8; ++b) { const int send = B2 ? ca[b] : ca[b + 8], keep = B2 ? ca[b + 8] : ca[b]; c1[b] = keep + __shfl_xor(send, 32); }
#pragma unroll
                for (int b = 0; b < 4; ++b) { const int send = B1 ? c1[b] : c1[b + 4], keep = B1 ? c1[b + 4] : c1[b]; c2[b] = keep + __shfl_xor(send, 16); }
#pragma unroll
                for (int b = 0; b < 2; ++b) { const int send = B0 ? c2[b] : c2[b + 2], keep = B0 ? c2[b + 2] : c2[b]; c3[b] = keep + __shfl_xor(send, 8); }
                const size_t o = (size_t)(tok0 + j) * DM + 128 * sl + 16 * i + 2 * g;
                const unsigned xb = *(const unsigned*)(X1B + o); const f32x2 xv = {bf_lo(xb), bf_hi(xb)};
                const f32x2 x2 = {xv[0] + sw[j] * (float)c3[0], xv[1] + sw[j] * (float)c3[1]};
                ssq[j] += x2[0] * x2[0] + x2[1] * x2[1];
                *(f32x2*)(P.out + o) = x2;
                __builtin_amdgcn_sched_barrier(0);
            }
        }
#pragma unroll
        for (int j = 0; j < 4; ++j) { const float rs2 = 1.0f / sqrtf(wave_sum(ssq[j]) * (1.f / DM) + EPS);
            f32x4* orow = (f32x4*)(P.out + (size_t)(tok0 + j) * DM) + lane;
#pragma unroll
            for (int q = 0; q < 8; ++q) { const f32x4 gn = *((const f32x4*)P.g_final + lane + 64 * q); orow[64 * q] = orow[64 * q] * rs2 * gn; } }
        LDS_WAIT();
    }
}

}


#define XB_TMO      128
#define XB_XCNT(j)  (256  + 64 * (j))
#define XB_XSUB(j)  (1280 + 64 * (j))
#define XB_XGEN(j)  (2304 + 64 * (j))
#define XB_TOP      3328
#define XB_TOPGEN   3392
#define XCD_BAR_WORDS 3456
#define XB_SPIN_CAP (1u << 18)
__device__ __forceinline__ unsigned xb_ld(unsigned* p)              { return __hip_atomic_load(p, __ATOMIC_RELAXED, __HIP_MEMORY_SCOPE_AGENT); }
__device__ __forceinline__ unsigned xb_add(unsigned* p, unsigned v) { return __hip_atomic_fetch_add(p, v, __ATOMIC_RELAXED, __HIP_MEMORY_SCOPE_AGENT); }
__device__ __forceinline__ unsigned xb_xcc_id() { return (unsigned)__builtin_amdgcn_s_getreg((3 << 11) | 20) & 0xFu; }
#define XB_SPIN(cond, bar) do { unsigned _sp = 0; while (cond) { __builtin_amdgcn_s_sleep(1); \
    if ((++_sp & 255u) == 0u) { if (xb_ld(&(bar)[XB_TMO])) break; if (_sp > XB_SPIN_CAP) { atomicAdd(&(bar)[XB_TMO], 1u); break; } } } } while (0)
struct XcdBarrier { unsigned* bar; unsigned x; volatile LAS unsigned* st; };
__device__ __forceinline__ XcdBarrier xcd_barrier_post(unsigned* bar, volatile LAS unsigned* st) {
    XcdBarrier b; b.bar = bar; b.x = xb_xcc_id(); b.st = st;
    if (threadIdx.x == 0) (void)xb_add(&bar[XB_XCNT(b.x)], 1u);
    return b;
}
__device__ __forceinline__ void xcd_barrier_complete(unsigned* bar, unsigned x, unsigned& nloc, unsigned& nx) {
    const unsigned G = gridDim.x * gridDim.y * gridDim.z;
    unsigned sum, cnt, mine, sp = 0u;
    for (;;) {
        sum = 0u; cnt = 0u; mine = 0u;
#pragma unroll
        for (unsigned j = 0; j < 16; ++j) { const unsigned c = xb_ld(&bar[XB_XCNT(j)]); sum += c; cnt += (c > 0u) ? 1u : 0u; mine = (j == x) ? c : mine; }
        if (sum == G) break;
        __builtin_amdgcn_s_sleep(1);
        if ((++sp & 255u) == 0u) { if (xb_ld(&bar[XB_TMO])) break; if (sp > XB_SPIN_CAP) { atomicAdd(&bar[XB_TMO], 1u); break; } }
    }
    nloc = mine > 0u ? mine : 1u; nx = cnt > 0u ? cnt : 1u;
}
__device__ __forceinline__ void xcd_barrier(const XcdBarrier& b) {
    asm volatile("s_waitcnt vmcnt(0)" ::: "memory");
    __syncthreads();
    if (threadIdx.x == 0) {
        unsigned* bar = b.bar;
        __builtin_amdgcn_s_waitcnt(0);
        unsigned nloc = b.st[0], nx = b.st[1];
        if (nloc == 0u) { xcd_barrier_complete(bar, b.x, nloc, nx); b.st[0] = nloc; b.st[1] = nx; }
        const unsigned old = xb_add(&bar[XB_XSUB(b.x)], 1u);
        const unsigned gen = old / nloc;
        if (old + 1u == (gen + 1u) * nloc) {
            __builtin_amdgcn_fence(__ATOMIC_RELEASE, "agent");
            asm volatile("s_waitcnt vmcnt(0)" ::: "memory");
            const unsigned og = xb_add(&bar[XB_TOP], 1u);
            const unsigned tg = og / nx;
            if (og + 1u == (tg + 1u) * nx) xb_add(&bar[XB_TOPGEN], 1u);
            else XB_SPIN(xb_ld(&bar[XB_TOPGEN]) == tg, bar);
            __builtin_amdgcn_fence(__ATOMIC_ACQUIRE, "agent");
            xb_add(&bar[XB_XGEN(b.x)], 1u);
            asm volatile("s_waitcnt vmcnt(0)" ::: "memory");
        } else {
            XB_SPIN(xb_ld(&bar[XB_XGEN(b.x)]) == gen, bar);
            __builtin_amdgcn_fence(__ATOMIC_ACQUIRE, "agent");
            asm volatile("s_waitcnt vmcnt(0)" ::: "memory");
        }
    }
    __syncthreads();
}

__global__ void __launch_bounds__(NTHR, 2) mega_fwd(Params P) {
    extern __shared__ __attribute__((aligned(16))) unsigned char lds_raw[];
    LAS unsigned char* lds = (LAS unsigned char*)lds_raw;
    cg::grid_group grid = cg::this_grid();
    const int G = gridDim.x, bx = blockIdx.x;
    const int vcu = (G % 8 == 0) ? (bx % 8) * (G / 8) + bx / 8 : bx;
    unsigned char* ws = P.ws;
#ifndef ONLY_PHASE
#define ONLY_PHASE -1
#endif
#define IN(k) ((ONLY_PHASE < 0 || ONLY_PHASE == (k)) && P.ph_lo <= (k) && (k) < P.ph_hi)
    volatile LAS unsigned* bst = (volatile LAS unsigned*)(lds + 131072);
    if (threadIdx.x < 16) bst[threadIdx.x] = 0u;
    __syncthreads();
    const XcdBarrier xbar = xcd_barrier_post((unsigned*)(ws + WS_CTL + 131072), bst);
    if (P.ph_lo < 0) grid.sync();
#define SEAM(k) do { if (IN(k) && IN((k) + 1)) xcd_barrier(xbar); } while (0)
    if (IN(0)) { p0a(P, lds, vcu, G); xcd_barrier(xbar); p0b(P, lds, vcu, G); }
    SEAM(0);
    if (IN(1)) {
        pg8::Gemm g{ws + WS_H, ws + WS_WIN, T_TOK, 10240, 2048, 2048, 2048};
        pg8::StaticOrder S; S.init(T_TOK, 10240, G, bx);
        pg8::EpiProj E{(bf16_t*)(ws + WS_QKV), (bf16_t*)(ws + WS_SG), LOG2E * 0.08838834764831845f, (unsigned*)(ws + WS_CTL + 200704), (const float*)(ws + WS_HSC), (const float*)(ws + WS_WSC)};
        pg8::gemm_phase<pg8::EpiProj, true>(lds, g, S, E);
    }
    SEAM(1);
    if (IN(2)) { att::attn_phase(P, lds, vcu, G); __syncthreads(); late_transposes(P, lds, vcu, G); }
    SEAM(2);
    if (IN(3)) {
        pg8::StaticOrder S; S.init(T_TOK, DM, G, bx);
        { pg8::Gemm g{ws + WS_H, ws + WS_WAT, T_TOK, DM, 1024, 4096, 2048};
          pg8::EpiGate<0> E{(const bf16_t*)(ws + WS_SG), (bf16_t*)(ws + WS_TMP), (bf16_t*)(ws + WS_MERGED)};
          pg8::gemm_phase(lds, g, S, E); }
        { pg8::Gemm g{ws + WS_H + 2048, ws + WS_WBT, T_TOK, DM, 1024, 4096, 2048};
          pg8::EpiGate<1> E{(const bf16_t*)(ws + WS_SG) + 2048, (bf16_t*)(ws + WS_TMP), (bf16_t*)(ws + WS_MERGED)};
          pg8::gemm_phase(lds, g, S, E); }
    }
    SEAM(3);
    if (IN(4)) {
        pg8::Gemm g{ws + WS_MERGED, ws + WS_WOUT, T_TOK, DM, 2048, 4096, 4096};
        pg8::StaticOrder S; S.init(T_TOK, DM, G, bx);
        pg8::EpiResid E{P.x, (float*)(ws + WS_X1), (bf16_t*)(ws + WS_X1B), (float*)(ws + WS_CTL)};
        pg8::gemm_phase(lds, g, S, E);
    }
    SEAM(4);
    if (IN(5)) {
        pg8::Gemm g{ws + WS_X1B, ws + WS_WQ, T_TOK, DM, 2048, 4096, 4096};
        pg8::StaticOrder S; S.init(T_TOK, DM, G, bx);
        pg8::EpiPlainBf16 E{(bf16_t*)(ws + WS_Q2)};
        pg8::gemm_phase(lds, g, S, E);
    }
    SEAM(5);
    if (IN(6)) peer::topk_phase(P, lds, vcu, G);
    SEAM(6);
    if (IN(7)) { peer::gather_sweep(P, lds, vcu, G); }
#undef IN
#undef SEAM
}

extern "C" void kernel_launch(void* const* d_in, const int* in_sizes, int n_in, void* d_out, int out_size, void* d_ws, size_t ws_size, hipStream_t stream) {
    static int grid = 0;
    if (grid == 0) {
        if (n_in != 13 || out_size != T_TOK * DM || ws_size < WS_END) { fprintf(stderr, "kernel_launch: unexpected shapes (n_in %d out %d ws %zu)\n", n_in, out_size, ws_size); grid = -1; return; }
        int dev = 0, cus = 0, per_cu = 0;
        if (hipGetDevice(&dev) != hipSuccess || hipDeviceGetAttribute(&cus, hipDeviceAttributeMultiprocessorCount, dev) != hipSuccess) { grid = -1; return; }
        if (hipFuncSetAttribute((const void*)mega_fwd, hipFuncAttributeMaxDynamicSharedMemorySize, LDS_BYTES) != hipSuccess) { fprintf(stderr, "kernel_launch: hipFuncSetAttribute failed\n"); grid = -1; return; }
        if (hipOccupancyMaxActiveBlocksPerMultiprocessor(&per_cu, (const void*)mega_fwd, NTHR, LDS_BYTES) != hipSuccess || per_cu < 1) { fprintf(stderr, "kernel_launch: occupancy query says %d\n", per_cu); grid = -1; return; }
        grid = cus;
    }
    if (grid < 0) return;
    (void)hipMemsetAsync((char*)d_ws + WS_CTL, 0, 1 * MiB, stream);
    Params p{};
    p.x = (const float*)d_in[0]; p.g_mix = (const float*)d_in[1]; p.w_in = (const float*)d_in[2]; p.b_forget = (const float*)d_in[3];
    p.w_a = (const float*)d_in[4]; p.w_b = (const float*)d_in[5]; p.w_out = (const float*)d_in[6]; p.g_ffn = (const float*)d_in[7];
    p.w_query = (const float*)d_in[8]; p.sub_keys = (const float*)d_in[9]; p.e_u = (const float*)d_in[10]; p.e_v = (const float*)d_in[11]; p.g_final = (const float*)d_in[12];
    p.out = (float*)d_out; p.ws = (unsigned char*)d_ws;
#if MK_N_LAUNCHES == 1
    p.ph_lo = 0; p.ph_hi = N_PHASES;
    void* args[] = {&p};
    hipError_t e = hipLaunchCooperativeKernel((const void*)mega_fwd, dim3(grid), dim3(NTHR), args, LDS_BYTES, stream);
    if (e != hipSuccess) fprintf(stderr, "kernel_launch: cooperative launch failed: %s (grid %d)\n", hipGetErrorString(e), grid);
#else
    for (int ph = 0; ph < N_PHASES; ++ph) { p.ph_lo = ph; p.ph_hi = ph + 1; hipLaunchKernelGGL(mega_fwd, dim3(grid), dim3(NTHR), LDS_BYTES, stream, p); }
#endif
}
```

```cpp
#include <hip/hip_runtime.h>
#include <hip/hip_cooperative_groups.h>
#include <cstdio>
#include <cstdint>
namespace cg = cooperative_groups;

#define LAS __attribute__((address_space(3)))
typedef unsigned short bf16_t;
typedef short bf16x8 __attribute__((ext_vector_type(8)));
typedef short s16x4 __attribute__((ext_vector_type(4)));
typedef float f32x2 __attribute__((ext_vector_type(2)));
typedef float f32x4 __attribute__((ext_vector_type(4)));
typedef float f32x16 __attribute__((ext_vector_type(16)));
typedef unsigned u32x2 __attribute__((ext_vector_type(2)));
typedef unsigned u32x4 __attribute__((ext_vector_type(4)));
typedef __bf16 bf16v2 __attribute__((ext_vector_type(2)));
typedef int i32x4 __attribute__((ext_vector_type(4)));

#ifndef MK_N_LAUNCHES
#define MK_N_LAUNCHES 1
#endif

constexpr int T_TOK = 8192, DM = 2048, SEQ = 4096, HD = 128;
constexpr int NWAVES = 8, NTHR = 512;
constexpr int LDS_BYTES = 147456;
constexpr float LOG2E = 1.4426950408889634f;
constexpr float EPS = 1e-6f;
constexpr int N_PHASES = 8;

constexpr size_t MiB = 1u << 20;
constexpr size_t WS_CTL = 0;
constexpr size_t WS_LOGF = 1 * MiB;
constexpr size_t WS_SKB = 1 * MiB + 512 * 1024;
constexpr size_t WS_HSC = 1 * MiB + 256 * 1024;
constexpr size_t WS_WSC = 1 * MiB + 320 * 1024;
constexpr size_t CTL_CMAX = 262144;
constexpr size_t WS_IDS = 2 * MiB;
constexpr size_t WS_GATES = 6 * MiB;
constexpr size_t WS_WAT = 10 * MiB, WS_WBT = 14 * MiB, WS_WOUT = 18 * MiB, WS_WQ = 26 * MiB, WS_WIN = 34 * MiB;
constexpr size_t WS_H = 74 * MiB;
constexpr size_t WS_QKV = 106 * MiB;
constexpr size_t WS_TMP = 106 * MiB, WS_MERGED = 170 * MiB, WS_Q2 = 106 * MiB;
constexpr size_t WS_SG = 202 * MiB;
constexpr size_t WS_X1B = 202 * MiB;
constexpr size_t WS_X1 = 266 * MiB;
constexpr size_t WS_EU = 330 * MiB, WS_EV = 362 * MiB;
constexpr size_t WS_SU = 394 * MiB, WS_SV = 394 * MiB + 65536;
constexpr size_t WS_END = 395 * MiB;

struct Params {
    const float* x; const float* g_mix; const float* w_in; const float* b_forget; const float* w_a; const float* w_b; const float* w_out;
    const float* g_ffn; const float* w_query; const float* sub_keys; const float* e_u; const float* e_v; const float* g_final;
    float* out; unsigned char* ws; int ph_lo, ph_hi;
};

__device__ __forceinline__ unsigned pk2(float a, float b) { f32x2 v = {a, b}; return __builtin_bit_cast(unsigned, __builtin_convertvector(v, bf16v2)); }
__device__ __forceinline__ float bf_lo(unsigned u) { return __builtin_bit_cast(float, u << 16); }
__device__ __forceinline__ float bf_hi(unsigned u) { return __builtin_bit_cast(float, u & 0xffff0000u); }
__device__ __forceinline__ float fexp2(float x) { return __builtin_amdgcn_exp2f(x); }
__device__ __forceinline__ float flog2(float x) { return __builtin_amdgcn_logf(x); }
__device__ __forceinline__ float frcp(float x) { return __builtin_amdgcn_rcpf(x); }
__device__ __forceinline__ float wave_sum(float v) {
#pragma unroll
    for (int o = 1; o < 64; o <<= 1) v += __shfl_xor(v, o);
    return v;
}
#define LDS_WAIT() asm volatile("s_waitcnt lgkmcnt(0)" ::: "memory")

namespace pg8 {
constexpr int BM = 256, BK = 64, HALF = 128, HTB = HALF * BK * 2, STAGE_BYTES = 8 * HTB, NXCD = 8, WGM = 8;
__host__ __device__ __forceinline__ int lds_byte(int r, int c) { const int st = (r >> 4) * 2 + (c >> 5), rr = r & 15, cc = c & 31, ob = rr * 64 + cc * 2; return st * 1024 + (ob ^ (((ob >> 9) & 1) << 5)); }
__host__ __device__ __forceinline__ void stage_rc(int b, int& R, int& C) { const int st = b / 1024, sb = b % 1024, swz = sb ^ (((sb >> 9) & 1) << 5); R = (st >> 1) * 16 + swz / 64; C = (st & 1) * 32 + (swz % 64) / 2; }
__host__ __device__ __forceinline__ int perm32(int rho) { const int n = rho >> 4, i = rho & 15; return 8 * (i >> 2) + 4 * n + (i & 3); }
struct Unit { int pm, pn; };
struct Gemm { const void* A; const void* Bt; int M, N, K, pa, pb; };
struct StaticOrder {
    int nM, nN, nwg, G, c;
    __device__ void init(int M, int N, int G_, int c_) { nM = M / BM; nN = N / BM; nwg = nM * nN; G = G_; c = c_; }
    __device__ bool next(int i, Unit& u) const {
        const long L = (long)i * G + c; if (L >= nwg) return false;
        int wgid = (int)L; { const int q = nwg / NXCD, r = nwg % NXCD, xcd = wgid % NXCD, off = wgid / NXCD; wgid = (xcd < r ? xcd * (q + 1) : r * (q + 1) + (xcd - r) * q) + off; }
        const int nig = WGM * nN, gid = wgid / nig, fm = gid * WGM, gsz = (nM - fm) < WGM ? (nM - fm) : WGM;
        u.pm = fm + ((wgid % nig) % gsz); u.pn = (wgid % nig) / gsz; return true;
    }
};
template <class Epi, bool I8 = false>
__device__ __forceinline__ void gemm_phase(LAS unsigned char* lds, const Gemm g, const StaticOrder& S, const Epi& E) {
    const int tid = threadIdx.x, wid = __builtin_amdgcn_readfirstlane(tid >> 6), lane = tid & 63, wr = wid >> 2, wc = wid & 3, fr = lane & 15, fq = lane >> 4;
    const int K = g.K, nt = I8 ? K / (2 * BK) : K / BK;
    unsigned voffA[2], voffB[2];
#pragma unroll
    for (int i = 0; i < 2; ++i) { int R, C; stage_rc(tid * 16 + i * 8192, R, C); const int Rb = (R & ~31) + perm32(R & 31);
        voffA[i] = (unsigned)(R * g.pa + C * 2); voffB[i] = (unsigned)(Rb * g.pb + C * 2); }
    const size_t kstep = (size_t)(BK * 2);
    const size_t hstepA = (size_t)HALF * g.pa, hstepB = (size_t)HALF * g.pb;
    const size_t tstepA = 2 * hstepA, tstepB = 2 * hstepB;
    const unsigned ldsw = (unsigned)wid * 1024u;
    const int aoff = lds_byte(wr * 64 + fr, fq * 8), boff = lds_byte(wc * 32 + fr, fq * 8);
#define PG8_SA(b, h) (((b) * 2 + (h)) * HTB)
#define PG8_SB(b, h) ((4 + (b) * 2 + (h)) * HTB)
#define PG8_STAGE(bufoff, gbase, voff) do { _Pragma("unroll") for (int _i = 0; _i < 2; ++_i) \
        __builtin_amdgcn_global_load_lds((const unsigned*)((const char*)(gbase) + (voff)[_i]), (LAS unsigned*)(lds + (bufoff) + ldsw + _i * 8192), 16, 0, 0); } while (0)
#define PG8_LDA(dst, b, h) do { _Pragma("unroll") for (int m = 0; m < 4; ++m) _Pragma("unroll") for (int k = 0; k < 2; ++k) dst[m][k] = *(const LAS bf16x8*)(lds + PG8_SA(b, h) + aoff + m * 2048 + k * 1024); } while (0)
#define PG8_LDB(dst, b, h) do { _Pragma("unroll") for (int n = 0; n < 2; ++n) _Pragma("unroll") for (int k = 0; k < 2; ++k) dst[n][k] = *(const LAS bf16x8*)(lds + PG8_SB(b, h) + boff + n * 2048 + k * 1024); } while (0)
#define PG8_MMA(ai, bj, At, Bt) do { __builtin_amdgcn_s_setprio(1); _Pragma("unroll") for (int m = 0; m < 4; ++m) _Pragma("unroll") for (int n = 0; n < 2; ++n) _Pragma("unroll") for (int k = 0; k < 2; ++k) \
        { if (I8) acc[ai][bj][m][n] = __builtin_bit_cast(f32x4, __builtin_amdgcn_mfma_i32_16x16x64_i8(__builtin_bit_cast(i32x4, Bt[n][k]), __builtin_bit_cast(i32x4, At[m][k]), __builtin_bit_cast(i32x4, acc[ai][bj][m][n]), 0, 0, 0)); \
          else acc[ai][bj][m][n] = __builtin_amdgcn_mfma_f32_16x16x32_bf16(Bt[n][k], At[m][k], acc[ai][bj][m][n], 0, 0, 0); } __builtin_amdgcn_s_setprio(0); } while (0)
#define PG8_WAIT_V(n) asm volatile("s_waitcnt vmcnt(" #n ")" ::: "memory")
#define PG8_WAIT_L(n) asm volatile("s_waitcnt lgkmcnt(" #n ")" ::: "memory")
#define PG8_BAR __builtin_amdgcn_s_barrier()
#define PG8_SCHED __builtin_amdgcn_sched_barrier(0)
    Unit cur, nxt; int ui = 0;
    if (!S.next(0, cur)) return;
    f32x4 acc[2][2][4][2];
#pragma unroll
    for (int a = 0; a < 2; ++a)
#pragma unroll
        for (int b = 0; b < 2; ++b)
#pragma unroll
            for (int m = 0; m < 4; ++m)
#pragma unroll
                for (int n = 0; n < 2; ++n) acc[a][b][m][n] = (f32x4){0.f, 0.f, 0.f, 0.f};
    bf16x8 At[4][2], B0[2][2], B1[2][2];
    const char* cA = (const char*)g.A + (size_t)cur.pm * tstepA; const char* cB = (const char*)g.Bt + (size_t)cur.pn * tstepB;
    PG8_STAGE(PG8_SB(0, 0), cB, voffB); PG8_STAGE(PG8_SA(0, 0), cA, voffA); PG8_STAGE(PG8_SB(0, 1), cB + hstepB, voffB); PG8_STAGE(PG8_SA(0, 1), cA + hstepA, voffA);
    if (wr == 1) PG8_BAR;
    PG8_WAIT_V(4); PG8_BAR;
    PG8_STAGE(PG8_SB(1, 0), cB + kstep, voffB); PG8_STAGE(PG8_SA(1, 0), cA + kstep, voffA); PG8_STAGE(PG8_SB(1, 1), cB + hstepB + kstep, voffB);
    PG8_WAIT_V(6); PG8_BAR;
    for (;;) {
        const bool has_next = S.next(ui + 1, nxt);
        const char* nA = has_next ? (const char*)g.A + (size_t)nxt.pm * tstepA : cA; const char* nB = has_next ? (const char*)g.Bt + (size_t)nxt.pn * tstepB : cB;
        for (int t = 0; t < nt; t += 2) {
            const bool last = (t == nt - 2);
            const char* a1 = cA + (size_t)(t + 1) * kstep;
            const char* a2 = last ? nA : cA + (size_t)(t + 2) * kstep; const char* b2 = last ? nB : cB + (size_t)(t + 2) * kstep;
            const char* a3 = a2 + kstep; const char* b3 = b2 + kstep;
            PG8_LDB(B0, 0, 0); PG8_SCHED; PG8_LDA(At, 0, 0); PG8_STAGE(PG8_SA(1, 1), a1 + hstepA, voffA);
            PG8_WAIT_L(8); PG8_BAR; PG8_WAIT_L(0); PG8_MMA(0, 0, At, B0); PG8_BAR; PG8_SCHED;
            PG8_LDB(B1, 0, 1); PG8_STAGE(PG8_SB(0, 0), b2, voffB);
            PG8_BAR; PG8_WAIT_L(0); PG8_MMA(0, 1, At, B1); PG8_BAR;
            PG8_LDA(At, 0, 1); PG8_STAGE(PG8_SA(0, 0), a2, voffA);
            PG8_BAR; PG8_WAIT_L(0); PG8_MMA(1, 0, At, B0); PG8_BAR; PG8_SCHED;
            PG8_STAGE(PG8_SB(0, 1), b2 + hstepB, voffB);
            PG8_WAIT_V(6); PG8_BAR; PG8_MMA(1, 1, At, B1); PG8_BAR;
            PG8_LDB(B0, 1, 0); PG8_SCHED; PG8_LDA(At, 1, 0); PG8_STAGE(PG8_SA(0, 1), a2 + hstepA, voffA);
            PG8_WAIT_L(8); PG8_BAR; PG8_WAIT_L(0); PG8_MMA(0, 0, At, B0); PG8_BAR; PG8_SCHED;
            PG8_LDB(B1, 1, 1); PG8_STAGE(PG8_SB(1, 0), b3, voffB);
            PG8_BAR; PG8_WAIT_L(0); PG8_MMA(0, 1, At, B1); PG8_BAR;
            PG8_LDA(At, 1, 1); PG8_STAGE(PG8_SA(1, 0), a3, voffA);
            PG8_BAR; PG8_WAIT_L(0); PG8_MMA(1, 0, At, B0); PG8_BAR; PG8_SCHED;
            PG8_STAGE(PG8_SB(1, 1), b3 + hstepB, voffB);
            PG8_WAIT_V(6); PG8_BAR; PG8_MMA(1, 1, At, B1); PG8_BAR;
        }
        E(acc, cur, wr, wc, fr, fq);
        if (!has_next) break;
#pragma unroll
        for (int a = 0; a < 2; ++a)
#pragma unroll
            for (int b = 0; b < 2; ++b)
#pragma unroll
                for (int m = 0; m < 4; ++m)
#pragma unroll
                    for (int n = 0; n < 2; ++n) acc[a][b][m][n] = (f32x4){0.f, 0.f, 0.f, 0.f};
        cur = nxt; cA = nA; cB = nB; ++ui;
    }
    PG8_WAIT_V(0);
    if (wr == 0) PG8_BAR;
    PG8_BAR;
#undef PG8_SA
#undef PG8_SB
#undef PG8_STAGE
#undef PG8_LDA
#undef PG8_LDB
#undef PG8_MMA
#undef PG8_WAIT_V
#undef PG8_WAIT_L
#undef PG8_BAR
#undef PG8_SCHED
}

struct EpiProj {
    bf16_t* qkv; bf16_t* sg; float qscale; unsigned* kmaxw; const float* hsc; const float* wsc;
    __device__ __forceinline__ void operator()(const f32x4 (&acci)[2][2][4][2], const Unit& u, int wr, int wc, int fr, int fq) const {
        const int row0 = u.pm * BM + wr * 64 + fr;
        f32x4 acc[2][2][4][2];
        { f32x4 cs[2][2];
#pragma unroll
          for (int bj = 0; bj < 2; ++bj)
#pragma unroll
              for (int n = 0; n < 2; ++n) cs[bj][n] = *(const f32x4*)(wsc + u.pn * BM + bj * HALF + wc * 32 + 8 * fq + 4 * n);
#pragma unroll
          for (int ai = 0; ai < 2; ++ai)
#pragma unroll
              for (int m = 0; m < 4; ++m) { const float rsc = hsc[row0 + ai * HALF + m * 16];
#pragma unroll
                  for (int bj = 0; bj < 2; ++bj)
#pragma unroll
                      for (int n = 0; n < 2; ++n) { const i32x4 iv = __builtin_bit_cast(i32x4, acci[ai][bj][m][n]);
                          acc[ai][bj][m][n] = (f32x4){(float)iv[0], (float)iv[1], (float)iv[2], (float)iv[3]} * rsc * cs[bj][n]; } } }
        if (u.pn < 24) {
            const int t = u.pn >> 2; bf16_t* base = qkv + (size_t)t * ((size_t)T_TOK * 1024) + (u.pn & 3) * 256 + wc * 32 + 8 * fq;
            const float sc = (t == 0 || t == 3) ? qscale : 1.f;
            if (t == 4) {
#pragma unroll
                for (int bj = 0; bj < 2; ++bj) { float mxv = 0.f;
#pragma unroll
                    for (int ai = 0; ai < 2; ++ai)
#pragma unroll
                        for (int m = 0; m < 4; ++m) { const f32x4 v0 = acc[ai][bj][m][0], v1 = acc[ai][bj][m][1];
                            float ssq = (v0[0] * v0[0] + v0[1] * v0[1]) + (v0[2] * v0[2] + v0[3] * v0[3]) + (v1[0] * v1[0] + v1[1] * v1[1]) + (v1[2] * v1[2] + v1[3] * v1[3]);
                            ssq += __shfl_xor(ssq, 16); ssq += __shfl_xor(ssq, 32); mxv = fmaxf(mxv, ssq); }
#pragma unroll
                    for (int o = 1; o < 16; o <<= 1) mxv = fmaxf(mxv, __shfl_xor(mxv, o));
                    if ((fr | fq) == 0) atomicMax(kmaxw + ((u.pm >> 4) * 8 + (u.pn & 3) * 2 + bj) * 4 + wc, __builtin_bit_cast(unsigned, mxv)); }
            }
#pragma unroll
            for (int ai = 0; ai < 2; ++ai)
#pragma unroll
                for (int m = 0; m < 4; ++m) { bf16_t* rowp = base + (size_t)(row0 + ai * HALF + m * 16) * 1024;
#pragma unroll
                    for (int bj = 0; bj < 2; ++bj) { const f32x4 v0 = acc[ai][bj][m][0] * sc, v1 = acc[ai][bj][m][1] * sc;
                        u32x4 w; w.x = pk2(v0[0], v0[1]); w.y = pk2(v0[2], v0[3]); w.z = pk2(v1[0], v1[1]); w.w = pk2(v1[2], v1[3]);
                        *(u32x4*)(rowp + bj * HALF) = w; } }
        } else {
            bf16_t* base = sg + (u.pn - 24) * 256 + wc * 32 + 8 * fq;
#pragma unroll
            for (int ai = 0; ai < 2; ++ai)
#pragma unroll
                for (int m = 0; m < 4; ++m) { bf16_t* rowp = base + (size_t)(row0 + ai * HALF + m * 16) * 4096;
#pragma unroll
                    for (int bj = 0; bj < 2; ++bj) { float s[8];
#pragma unroll
                        for (int e = 0; e < 4; ++e) { s[e] = frcp(1.f + fexp2(-LOG2E * acc[ai][bj][m][0][e])); s[4 + e] = frcp(1.f + fexp2(-LOG2E * acc[ai][bj][m][1][e])); }
                        u32x4 w; w.x = pk2(s[0], s[1]); w.y = pk2(s[2], s[3]); w.z = pk2(s[4], s[5]); w.w = pk2(s[6], s[7]);
                        *(u32x4*)(rowp + bj * HALF) = w; } }
        }
    }
};
template <int SECOND> struct EpiGate {
    const bf16_t* sg;
    bf16_t* tmp; bf16_t* merged;
    __device__ __forceinline__ void operator()(const f32x4 (&acc)[2][2][4][2], const Unit& u, int wr, int wc, int fr, int fq) const {
        const int row0 = u.pm * BM + wr * 64 + fr, col0 = u.pn * BM + wc * 32 + 8 * fq;
#pragma unroll
        for (int ai = 0; ai < 2; ++ai)
#pragma unroll
            for (int m = 0; m < 4; ++m) { const size_t row = (size_t)(row0 + ai * HALF + m * 16);
#pragma unroll
                for (int bj = 0; bj < 2; ++bj) { const int col = col0 + bj * HALF;
                    const u32x4 gv = *(const u32x4*)(sg + row * 4096 + col);
                    const f32x4 g0 = {bf_lo(gv.x), bf_hi(gv.x), bf_lo(gv.y), bf_hi(gv.y)}, g1 = {bf_lo(gv.z), bf_hi(gv.z), bf_lo(gv.w), bf_hi(gv.w)};
                    f32x4 v0 = acc[ai][bj][m][0] * g0, v1 = acc[ai][bj][m][1] * g1;
                    bf16_t* tp = tmp + row * DM + col;
                    if (SECOND == 0) { u32x4 w; w.x = pk2(v0[0], v0[1]); w.y = pk2(v0[2], v0[3]); w.z = pk2(v1[0], v1[1]); w.w = pk2(v1[2], v1[3]); *(u32x4*)tp = w; }
                    else { const u32x4 tv = *(const u32x4*)tp; v0 += (f32x4){bf_lo(tv.x), bf_hi(tv.x), bf_lo(tv.y), bf_hi(tv.y)}; v1 += (f32x4){bf_lo(tv.z), bf_hi(tv.z), bf_lo(tv.w), bf_hi(tv.w)};
                        u32x4 w; w.x = pk2(v0[0], v0[1]); w.y = pk2(v0[2], v0[3]); w.z = pk2(v1[0], v1[1]); w.w = pk2(v1[2], v1[3]);
                        *(u32x4*)(merged + row * DM + col) = w; } } }
    }
};
struct EpiResid {
    const float* x; float* x1; bf16_t* x1b; float* rowss;
    __device__ __forceinline__ void operator()(const f32x4 (&acc)[2][2][4][2], const Unit& u, int wr, int wc, int fr, int fq) const {
        const int row0 = u.pm * BM + wr * 64 + fr, col0 = u.pn * BM + wc * 32 + 8 * fq;
#pragma unroll
        for (int ai = 0; ai < 2; ++ai)
#pragma unroll
            for (int m = 0; m < 4; ++m) { const size_t row = (size_t)(row0 + ai * HALF + m * 16); float ss = 0.f;
#pragma unroll
                for (int bj = 0; bj < 2; ++bj) { const size_t o = row * DM + col0 + bj * HALF;
                    const f32x4 v0 = acc[ai][bj][m][0] + *(const f32x4*)(x + o), v1 = acc[ai][bj][m][1] + *(const f32x4*)(x + o + 4);
                    u32x4 w; w.x = pk2(v0[0], v0[1]); w.y = pk2(v0[2], v0[3]); w.z = pk2(v1[0], v1[1]); w.w = pk2(v1[2], v1[3]);
                    *(u32x4*)(x1b + o) = w;
                    ss += (v0[0] * v0[0] + v0[1] * v0[1]) + (v0[2] * v0[2] + v0[3] * v0[3]) + (v1[0] * v1[0] + v1[1] * v1[1]) + (v1[2] * v1[2] + v1[3] * v1[3]); }
                ss += __shfl_xor(ss, 16); ss += __shfl_xor(ss, 32);
                if (fq == 0) atomicAdd(rowss + row, ss); }
    }
};
struct EpiPlainBf16 {
    bf16_t* o;
    __device__ __forceinline__ void operator()(const f32x4 (&acc)[2][2][4][2], const Unit& u, int wr, int wc, int fr, int fq) const {
        const int row0 = u.pm * BM + wr * 64 + fr, col0 = u.pn * BM + wc * 32 + 8 * fq;
#pragma unroll
        for (int ai = 0; ai < 2; ++ai)
#pragma unroll
            for (int m = 0; m < 4; ++m) { const size_t row = (size_t)(row0 + ai * HALF + m * 16);
#pragma unroll
                for (int bj = 0; bj < 2; ++bj) { const f32x4 v0 = acc[ai][bj][m][0], v1 = acc[ai][bj][m][1];
                    u32x4 w; w.x = pk2(v0[0], v0[1]); w.y = pk2(v0[2], v0[3]); w.z = pk2(v1[0], v1[1]); w.w = pk2(v1[2], v1[3]);
                    *(u32x4*)(o + row * DM + col0 + bj * HALF) = w; } }
    }
};
}

__device__ __forceinline__ void transpose_item(const float* W, int ldw, int src_n0, bf16_t* WT, int K, int dst_n0, int k0, LAS float* scr, int lane, const float* kscale) {
    { const int c4 = (lane & 7) * 4;
      f32x4 v[8];
#pragma unroll
      for (int i = 0; i < 8; ++i) v[i] = *(const f32x4*)(W + (size_t)(k0 + 8 * i + (lane >> 3)) * ldw + src_n0 + c4);
#pragma unroll
      for (int i = 0; i < 8; ++i) { const int kk = 8 * i + (lane >> 3); const float ks = kscale ? kscale[k0 + kk] : 1.f; LAS float* sp = scr + kk * 33 + c4;
          sp[0] = v[i][0] * ks; sp[1] = v[i][1] * ks; sp[2] = v[i][2] * ks; sp[3] = v[i][3] * ks; } }
    LDS_WAIT();
    const int c = lane & 7;
#pragma unroll
    for (int j = 0; j < 4; ++j) { const int n = (lane >> 3) + 8 * j; const LAS float* s = scr + (8 * c) * 33 + n;
        u32x4 o; o.x = pk2(s[0 * 33], s[1 * 33]); o.y = pk2(s[2 * 33], s[3 * 33]); o.z = pk2(s[4 * 33], s[5 * 33]); o.w = pk2(s[6 * 33], s[7 * 33]);
        *(u32x4*)(WT + (size_t)(dst_n0 + n) * K + k0 + 8 * c) = o; }
    LDS_WAIT();
}

__device__ __forceinline__ void p0a(const Params& P, LAS unsigned char* lds, int vcu, int G) {
    const int tid = threadIdx.x, lane = tid & 63, wave = __builtin_amdgcn_readfirstlane(tid >> 6);
    const int gw = vcu * NWAVES + wave, NGW = G * NWAVES;
    unsigned char* ws = P.ws;
    {
        unsigned* CMAX = (unsigned*)(ws + WS_CTL + CTL_CMAX);
        constexpr int NCB = (10248 + 255) / 256;
        for (int it = gw; it < 128 * NCB; it += NGW) { const int kb = it / NCB, cb = it % NCB, sc = cb * 256 + 4 * lane;
            if (sc < 10248) { f32x4 v[16];
#pragma unroll
                for (int r = 0; r < 16; ++r) v[r] = *(const f32x4*)(P.w_in + (size_t)(kb * 16 + r) * 10248 + sc);
                float m0 = 0.f, m1 = 0.f, m2 = 0.f, m3 = 0.f;
#pragma unroll
                for (int r = 0; r < 16; ++r) { m0 = fmaxf(m0, fabsf(v[r][0])); m1 = fmaxf(m1, fabsf(v[r][1])); m2 = fmaxf(m2, fabsf(v[r][2])); m3 = fmaxf(m3, fabsf(v[r][3])); }
                const float mm[4] = {m0, m1, m2, m3};
#pragma unroll
                for (int e = 0; e < 4; ++e) { const int c = sc + e; const unsigned mb = __float_as_uint(mm[e]);
                    if (c < 6144) atomicMax(CMAX + c, mb); else if (c >= 6152) atomicMax(CMAX + c - 8, mb); } } }
    }
    {
        LAS float* wf = (LAS float*)lds;
        for (int k = tid; k < 2048; k += NTHR) { const f32x4 a0 = *(const f32x4*)(P.w_in + (size_t)k * 10248 + 6144), a1 = *(const f32x4*)(P.w_in + (size_t)k * 10248 + 6148);
            wf[k] = a0[0]; wf[2048 + k] = a0[1]; wf[4096 + k] = a0[2]; wf[6144 + k] = a0[3]; wf[8192 + k] = a1[0]; wf[10240 + k] = a1[1]; wf[12288 + k] = a1[2]; wf[14336 + k] = a1[3]; }
        __syncthreads();
        unsigned char* HQ8 = ws + WS_H; float* HSC = (float*)(ws + WS_HSC); float* LOGF = (float*)(ws + WS_LOGF);
        for (int r = gw; r < T_TOK; r += NGW) {
            const f32x4* xr = (const f32x4*)(P.x + (size_t)r * DM) + lane;
            float ss = 0.f, amx = 0.f; f32x4 hv[8];
#pragma unroll
            for (int j = 0; j < 8; ++j) { const f32x4 v = xr[64 * j]; const f32x4 gn = *((const f32x4*)P.g_mix + lane + 64 * j); ss += (v[0] * v[0] + v[1] * v[1]) + (v[2] * v[2] + v[3] * v[3]);
                hv[j] = v * gn; amx = fmaxf(amx, fmaxf(fmaxf(fabsf(hv[j][0]), fabsf(hv[j][1])), fmaxf(fabsf(hv[j][2]), fabsf(hv[j][3])))); }
            const float rstd = 1.0f / sqrtf(wave_sum(ss) * (1.f / DM) + EPS);
#pragma unroll
            for (int o = 1; o < 64; o <<= 1) amx = fmaxf(amx, __shfl_xor(amx, o));
            const float hmax = fmaxf(amx * rstd, 1e-30f), hinv = 127.f / hmax;
            float fl[8];
#pragma unroll
            for (int c = 0; c < 8; ++c) fl[c] = 0.f;
            unsigned* hp = (unsigned*)(HQ8 + (size_t)r * DM) + lane;
#pragma unroll
            for (int j = 0; j < 8; ++j) { const f32x4 h = hv[j] * rstd;
                unsigned w = 0;
#pragma unroll
                for (int e = 0; e < 4; ++e) w |= ((unsigned)(int)__builtin_rintf(h[e] * hinv) & 255u) << (8 * e);
                hp[64 * j] = w;
#pragma unroll
                for (int c = 0; c < 8; ++c) { const f32x4 wv = *((const LAS f32x4*)(wf + c * 2048) + lane + 64 * j); fl[c] += (h[0] * wv[0] + h[1] * wv[1]) + (h[2] * wv[2] + h[3] * wv[3]); }
                __builtin_amdgcn_sched_barrier(0); }
#pragma unroll
            for (int c = 0; c < 8; ++c) fl[c] = wave_sum(fl[c]);
            if (lane == 0) { HSC[r] = hmax * (1.f / 127.f);
#pragma unroll
                for (int c = 0; c < 8; ++c) { const float y = fl[c] + P.b_forget[c]; LOGF[((size_t)(r >> 12) * 8 + c) * SEQ + (r & (SEQ - 1))] = fminf(y, 0.f) - log1pf(expf(-fabsf(y))); }
            }
        }
    }
    {
        const size_t gid = (size_t)vcu * NTHR + tid, gstride = (size_t)G * NTHR;
        for (size_t i = gid; i < 262144 / 8; i += gstride) { const float* src = P.sub_keys + i * 8; const f32x4 a = *(const f32x4*)src, b = *((const f32x4*)src + 1);
            u32x4 o; o.x = pk2(a[0], a[1]); o.y = pk2(a[2], a[3]); o.z = pk2(b[0], b[1]); o.w = pk2(b[2], b[3]); *(u32x4*)((bf16_t*)(ws + WS_SKB) + i * 8) = o; }
    }
}
__device__ __forceinline__ void p0b(const Params& P, LAS unsigned char* lds, int vcu, int G) {
    const int tid = threadIdx.x, lane = tid & 63, wave = __builtin_amdgcn_readfirstlane(tid >> 6);
    const int gw = vcu * NWAVES + wave, NGW = G * NWAVES;
    unsigned char* ws = P.ws;
    const unsigned* CMAX = (const unsigned*)(ws + WS_CTL + CTL_CMAX); float* WSC = (float*)(ws + WS_WSC); unsigned char* WT8 = ws + WS_WIN;
    LAS float* scr = (LAS float*)(lds + wave * 16384);
    for (int it = gw; it < 32 * 320; it += NGW) {
        const int nb = it >> 5, kb = it & 31, dn = nb * 32, sn = dn < 6144 ? dn : dn + 8, k0 = kb * 64;
        const int c4 = (lane & 7) * 4;
        float inv[4];
#pragma unroll
        for (int e = 0; e < 4; ++e) { const float cm = fmaxf(__uint_as_float(__hip_atomic_load(CMAX + dn + c4 + e, __ATOMIC_RELAXED, __HIP_MEMORY_SCOPE_AGENT)), 1e-30f); inv[e] = 127.f / cm;
            if (kb == 0 && lane < 8) WSC[dn + c4 + e] = cm * (1.f / 127.f); }
        f32x4 v[8];
#pragma unroll
        for (int i = 0; i < 8; ++i) v[i] = *(const f32x4*)(P.w_in + (size_t)(k0 + 8 * i + (lane >> 3)) * 10248 + sn + c4);
#pragma unroll
        for (int i = 0; i < 8; ++i) { LAS float* sp = scr + (8 * i + (lane >> 3)) * 33 + c4; sp[0] = v[i][0] * inv[0]; sp[1] = v[i][1] * inv[1]; sp[2] = v[i][2] * inv[2]; sp[3] = v[i][3] * inv[3]; }
        LDS_WAIT();
        const int c = lane & 3;
#pragma unroll
        for (int j = 0; j < 2; ++j) { const int n = (lane >> 2) + 16 * j; const LAS float* sp = scr + (16 * c) * 33 + n;
            u32x4 o;
#pragma unroll
            for (int w4 = 0; w4 < 4; ++w4) { unsigned w = 0;
#pragma unroll
                for (int e = 0; e < 4; ++e) w |= ((unsigned)(int)fminf(fmaxf(__builtin_rintf(sp[(4 * w4 + e) * 33]), -127.f), 127.f) & 255u) << (8 * e);
                o[w4] = w; }
            *(u32x4*)(WT8 + (size_t)(dn + n) * 2048 + k0 + 16 * c) = o; }
        LDS_WAIT();
    }
}
__device__ __forceinline__ void late_transposes(const Params& P, LAS unsigned char* lds, int vcu, int G) {
    const int tid = threadIdx.x, lane = tid & 63, wave = __builtin_amdgcn_readfirstlane(tid >> 6);
    const int gw = vcu * NWAVES + wave, NGW = G * NWAVES;
    unsigned char* ws = P.ws;
    LAS float* scr = (LAS float*)(lds + wave * 16384);
    constexpr int I_A = 16 * 64, I_O = 32 * 64, NITEMS = 2 * I_A + 2 * I_O;
    for (int it = gw; it < NITEMS; it += NGW) {
        int r = it;
        if (r < I_A) { const int kb = r / 64, nb = r % 64; transpose_item(P.w_a, 2048, nb * 32, (bf16_t*)(ws + WS_WAT), 1024, nb * 32, kb * 64, scr, lane, nullptr); continue; } r -= I_A;
        if (r < I_A) { const int kb = r / 64, nb = r % 64; transpose_item(P.w_b, 2048, nb * 32, (bf16_t*)(ws + WS_WBT), 1024, nb * 32, kb * 64, scr, lane, nullptr); continue; } r -= I_A;
        if (r < I_O) { const int kb = r / 64, nb = r % 64; transpose_item(P.w_out, 2048, nb * 32, (bf16_t*)(ws + WS_WOUT), 2048, nb * 32, kb * 64, scr, lane, nullptr); continue; } r -= I_O;
        { const int kb = r / 64, nb = r % 64; transpose_item(P.w_query, 2048, nb * 32, (bf16_t*)(ws + WS_WQ), 2048, nb * 32, kb * 64, scr, lane, P.g_ffn); }
    }
}
__device__ __forceinline__ void quantise_expert_rows(const Params& P, int r0, int nrows) {
    const int lane = threadIdx.x & 63;
    unsigned char* ws = P.ws;
    float* SU = (float*)(ws + WS_SU); float* SV = (float*)(ws + WS_SV);
    for (int r = r0; r < r0 + nrows; r += 2) {
        f32x4 v[2][8];
#pragma unroll
        for (int t = 0; t < 2; ++t) { const int rr = r + t; const f32x4* src = (const f32x4*)((rr >= 16384 ? P.e_v : P.e_u) + (size_t)(rr & 16383) * DM) + lane;
#pragma unroll
            for (int j = 0; j < 8; ++j) v[t][j] = __builtin_nontemporal_load(src + 64 * j); }
#pragma unroll
        for (int t = 0; t < 2; ++t) { const int rr = r + t; const bool second = rr >= 16384; const int row = rr & 16383;
            float mx = 0.f;
#pragma unroll
            for (int j = 0; j < 8; ++j) mx = fmaxf(mx, fmaxf(fmaxf(fabsf(v[t][j][0]), fabsf(v[t][j][1])), fmaxf(fabsf(v[t][j][2]), fabsf(v[t][j][3]))));
#pragma unroll
            for (int o = 1; o < 64; o <<= 1) mx = fmaxf(mx, __shfl_xor(mx, o));
            mx = fmaxf(mx, 1e-30f);
            const float inv = 127.f / mx;
            unsigned* dst = (unsigned*)(ws + (second ? WS_EV : WS_EU) + (size_t)row * DM) + lane;
#pragma unroll
            for (int j = 0; j < 8; ++j) { unsigned w = 0;
#pragma unroll
                for (int e = 0; e < 4; ++e) { const int q = (int)__builtin_rintf(v[t][j][e] * inv); w |= ((unsigned)q & 255u) << (8 * e); }
                dst[64 * j] = w; }
            if (lane == 0) (second ? SV : SU)[row] = mx * (1.f / 127.f);
        }
    }
}

namespace att {
constexpr int KST = 272, VST = 320;
constexpr int KBUF = 64 * KST, VBUF = 64 * VST;
constexpr int OFF_K = 0, OFF_V = 2 * KBUF, OFF_F = OFF_V + 2 * VBUF, OFF_SC = OFF_F + 4096 * 4;
constexpr int OFF_FLG = OFF_SC + 64, OFF_UNIT = OFF_FLG + 64;
static_assert(OFF_UNIT + 16 <= 131072, "attention LDS");
constexpr float THR_SB = 30.f, THR_FOX = 20.f;

__device__ __forceinline__ void build_cumf(LAS unsigned char* lds, const float* LOGF, int b, int h, int n, int tid, int lane, int wid) {
    LAS float* F2 = (LAS float*)(lds + OFF_F); LAS float* sc = (LAS float*)(lds + OFF_SC);
    const int s0 = tid * 8; float v[8];
    { const f32x4* lp = (const f32x4*)(LOGF + ((size_t)b * 8 + h) * SEQ + s0); f32x4 a0 = {0.f, 0.f, 0.f, 0.f}, a1 = a0; if (s0 < n) { a0 = lp[0]; a1 = lp[1]; }
      v[0] = a0[0] * LOG2E; v[1] = a0[1] * LOG2E; v[2] = a0[2] * LOG2E; v[3] = a0[3] * LOG2E; v[4] = a1[0] * LOG2E; v[5] = a1[1] * LOG2E; v[6] = a1[2] * LOG2E; v[7] = a1[3] * LOG2E; }
#pragma unroll
    for (int i = 1; i < 8; ++i) v[i] += v[i - 1];
    float tot = v[7], inc = tot;
#pragma unroll
    for (int o = 1; o < 64; o <<= 1) { const float t = __shfl_up(inc, o); if (lane >= o) inc += t; }
    if (lane == 63) sc[wid] = inc;
    __syncthreads();
    float base = inc - tot;
#pragma unroll
    for (int w = 0; w < 8; ++w) if (w < wid) base += sc[w];
    if (s0 < n) {
#pragma unroll
        for (int i = 0; i < 8; ++i) F2[s0 + i] = v[i] + base;
    }
    __syncthreads();
}

template <int MIXER>
__device__ __forceinline__ void attn_unit(LAS unsigned char* lds, const bf16_t* Q, const bf16_t* Kg, const bf16_t* Vg, bf16_t* O, int b, int h, int qb, float kmax, int tid, int lane, int wid) {
    const int c = lane & 31, hh = lane >> 5;
    const int t0 = qb * 256 + wid * 32, tq = t0 + c;
    const size_t rowbase = (size_t)b * SEQ;
    size_t qoff = (rowbase + tq) * 1024 + h * HD + 8 * hh;
    f32x16 oacc[4];
#pragma unroll
    for (int d = 0; d < 4; ++d)
#pragma unroll
        for (int r = 0; r < 16; ++r) oacc[d][r] = 0.f;
    float carry = 0.f, mrun = -1e30f, lsum = 0.f; const float nhf = hh ? 0.f : 1.f;
    const LAS float* F2 = (const LAS float*)(lds + OFF_F);
    const float Ft = (MIXER == 1) ? F2[tq] : 0.f;
    float qk_bound = 0.f;
    if (MIXER == 1) { float qs = 0.f;
#pragma unroll
        for (int s2 = 0; s2 < 8; ++s2) { const u32x4 qv = *(const u32x4*)(Q + qoff + 16 * s2);
#pragma unroll
            for (int e = 0; e < 4; ++e) { const float a = bf_lo(qv[e]), b2 = bf_hi(qv[e]); qs += a * a + b2 * b2; } }
        qs += __shfl_xor(qs, 32);
        qk_bound = sqrtf(qs) * kmax; }
    bool wave_done = false;
    volatile LAS unsigned* flg = (volatile LAS unsigned*)(lds + OFF_FLG);
    const int ktmax = 4 * qb + 3;
    const int srow = tid >> 4, scc = tid & 15;
    u32x4 kr[2], vr[2];
#define ATT_LOAD(kt) do { _Pragma("unroll") for (int j = 0; j < 2; ++j) { const size_t g_ = (rowbase + 64 * (kt) + srow + 32 * j) * 1024 + h * HD + scc * 8; \
        kr[j] = *(const u32x4*)(Kg + g_); vr[j] = *(const u32x4*)(Vg + g_); } } while (0)
#define ATT_WRITE(buf) do { _Pragma("unroll") for (int j = 0; j < 2; ++j) { \
        *(LAS u32x4*)(lds + OFF_K + (buf) * KBUF + (srow + 32 * j) * KST + scc * 16) = kr[j]; \
        *(LAS u32x4*)(lds + OFF_V + (buf) * VBUF + (srow + 32 * j) * VST + scc * 16) = vr[j]; } } while (0)
    ATT_LOAD(ktmax); ATT_WRITE(0); __syncthreads();
    int buf = 0;
    for (int kt = ktmax; kt >= 0; --kt) {
        if (kt > 0) ATT_LOAD(kt - 1);
        const bool started = (64 * kt <= t0 + 31);
        if (started && !wave_done) {
            const LAS unsigned char* Kl = lds + OFF_K + buf * KBUF; const LAS unsigned char* Vl = lds + OFF_V + buf * VBUF;
            f32x16 sacc[2];
            asm volatile("" : "+v"(qoff));
            bf16x8 qf[8];
#pragma unroll
            for (int s = 0; s < 8; ++s) qf[s] = *(const bf16x8*)(Q + qoff + 16 * s);
#pragma unroll
            for (int sub = 0; sub < 2; ++sub) {
#pragma unroll
                for (int r = 0; r < 16; ++r) sacc[sub][r] = 0.f;
#pragma unroll
                for (int s = 0; s < 8; ++s) { const bf16x8 kf = *(const LAS bf16x8*)(Kl + (32 * sub + c) * KST + (16 * s + 8 * hh) * 2);
                    sacc[sub] = __builtin_amdgcn_mfma_f32_32x32x16_bf16(kf, qf[s], sacc[sub], 0, 0, 0); }
            }
            const bool need_mask = (64 * kt + 63 >= t0);
            bool tile_dead = false;
            if (MIXER == 0) {
#pragma unroll
                for (int sub = 1; sub >= 0; --sub) {
                    float lb[16];
#pragma unroll
                    for (int r = 0; r < 16; ++r) { const float z = sacc[sub][r]; float l = -flog2(1.f + fexp2(z));
                        if (need_mask) { const int sidx = 64 * kt + 32 * sub + (r & 3) + 8 * (r >> 2) + 4 * hh; l = (sidx < tq) ? l : 0.f; }
                        lb[r] = l; }
                    float Glo[4], Ghi[4];
#pragma unroll
                    for (int g = 0; g < 4; ++g) { lb[4 * g + 2] += lb[4 * g + 3]; lb[4 * g + 1] += lb[4 * g + 2]; lb[4 * g] += lb[4 * g + 1];
                        const unsigned gu = __builtin_bit_cast(unsigned, lb[4 * g]); const auto rr = __builtin_amdgcn_permlane32_swap(gu, gu, false, false);
                        Glo[g] = __builtin_bit_cast(float, (unsigned)rr[0]); Ghi[g] = __builtin_bit_cast(float, (unsigned)rr[1]); }
                    float E[8];
                    E[7] = carry; E[6] = E[7] + Ghi[3]; E[5] = E[6] + Glo[3]; E[4] = E[5] + Ghi[2]; E[3] = E[4] + Glo[2]; E[2] = E[3] + Ghi[1]; E[1] = E[2] + Glo[1]; E[0] = E[1] + Ghi[0];
                    carry = E[0] + Glo[0];
#pragma unroll
                    for (int g = 0; g < 4; ++g) { const float Eo = __builtin_fmaf(nhf, Ghi[g], E[2 * g + 1]);
#pragma unroll
                        for (int i = 0; i < 4; ++i) { const int r = 4 * g + i; float w = fexp2(sacc[sub][r] + lb[r] + Eo);
                            if (need_mask) { const int sidx = 64 * kt + 32 * sub + (r & 3) + 8 * (r >> 2) + 4 * hh; w = (sidx < tq) ? w : 0.f; }
                            sacc[sub][r] = w; } }
                }
            } else {
                float mx = -1e30f;
#pragma unroll
                for (int sub = 0; sub < 2; ++sub)
#pragma unroll
                    for (int g = 0; g < 4; ++g) { const f32x4 fs = *(const LAS f32x4*)(F2 + 64 * kt + 32 * sub + 8 * g + 4 * hh);
#pragma unroll
                        for (int i = 0; i < 4; ++i) { const int r = 4 * g + i; float xv = sacc[sub][r] + (Ft - fs[i]);
                            if (need_mask) { const int sidx = 64 * kt + 32 * sub + 8 * g + 4 * hh + i; xv = (sidx <= tq) ? xv : -1e30f; }
                            sacc[sub][r] = xv; mx = fmaxf(mx, xv); } }
                { const unsigned mu = __builtin_bit_cast(unsigned, mx); const auto rr = __builtin_amdgcn_permlane32_swap(mu, mu, false, false);
                  mx = fmaxf(__builtin_bit_cast(float, (unsigned)rr[0]), __builtin_bit_cast(float, (unsigned)rr[1])); }
                tile_dead = __all(mx - mrun < -THR_FOX);
                if (!tile_dead) {
                const float mnew = fmaxf(mrun, mx);
                const float alpha = fexp2(mrun - mnew);
                float ps = 0.f;
#pragma unroll
                for (int sub = 0; sub < 2; ++sub)
#pragma unroll
                    for (int r = 0; r < 16; ++r) { const float p = fexp2(sacc[sub][r] - mnew); sacc[sub][r] = p; ps += p; }
                lsum = lsum * alpha + ps;
                if (__any(mnew > mrun)) {
#pragma unroll
                    for (int d = 0; d < 4; ++d)
#pragma unroll
                        for (int r = 0; r < 16; ++r) oacc[d][r] *= alpha;
                }
                mrun = mnew;
                }
            }
            if (!tile_dead)
#pragma unroll
            for (int ks = 0; ks < 4; ++ks) { const int sub = ks >> 1, rb = 8 * (ks & 1);
                u32x4 pw; pw.x = pk2(sacc[sub][rb + 0], sacc[sub][rb + 1]); pw.y = pk2(sacc[sub][rb + 2], sacc[sub][rb + 3]); pw.z = pk2(sacc[sub][rb + 4], sacc[sub][rb + 5]); pw.w = pk2(sacc[sub][rb + 6], sacc[sub][rb + 7]);
                const bf16x8 pf = __builtin_bit_cast(bf16x8, pw);
                const LAS unsigned char* vb = Vl + (16 * ks + 4 * hh + ((lane & 15) >> 2)) * VST + (16 * ((lane >> 4) & 1) + 4 * (lane & 3)) * 2;
#pragma unroll
                for (int d = 0; d < 4; ++d) {
                    const s16x4 a0 = __builtin_amdgcn_ds_read_tr16_b64_v4i16((LAS s16x4*)(vb + d * 64));
                    const s16x4 a1 = __builtin_amdgcn_ds_read_tr16_b64_v4i16((LAS s16x4*)(vb + d * 64 + 8 * VST));
                    const bf16x8 af = {a0[0], a0[1], a0[2], a0[3], a1[0], a1[1], a1[2], a1[3]};
                    oacc[d] = __builtin_amdgcn_mfma_f32_32x32x16_bf16(af, pf, oacc[d], 0, 0, 0); }
            }
        }
        if (kt > 0) ATT_WRITE(buf ^ 1);
        if (kt > 0 && started && !wave_done) {
            if (MIXER == 0) wave_done = __all(carry < -THR_SB);
            else wave_done = __all(qk_bound + (Ft - F2[64 * kt - 1]) - mrun < -THR_FOX);
        }
        if (lane == 0) flg[(kt & 1) * 8 + wid] = wave_done ? 1u : 0u;
        __syncthreads();
        buf ^= 1;
        { unsigned alld = 1u;
#pragma unroll
          for (int w = 0; w < 8; ++w) alld &= flg[(kt & 1) * 8 + w];
          if (alld) break; }
    }
#undef ATT_LOAD
#undef ATT_WRITE
    float inv = 1.f;
    if (MIXER == 1) { const unsigned lu = __builtin_bit_cast(unsigned, lsum); const auto rr = __builtin_amdgcn_permlane32_swap(lu, lu, false, false);
        inv = 1.f / (__builtin_bit_cast(float, (unsigned)rr[0]) + __builtin_bit_cast(float, (unsigned)rr[1])); }
    bf16_t* op = O + (rowbase + tq) * 2048 + 4 * hh;
#pragma unroll
    for (int d = 0; d < 4; ++d)
#pragma unroll
        for (int g = 0; g < 4; ++g) { u32x2 w; w.x = pk2(oacc[d][4 * g] * inv, oacc[d][4 * g + 1] * inv); w.y = pk2(oacc[d][4 * g + 2] * inv, oacc[d][4 * g + 3] * inv);
            *(u32x2*)(op + 32 * d + 8 * g) = w; }
}

__device__ __forceinline__ void attn_phase(const Params& P, LAS unsigned char* lds, int vcu, int G) {
    const int tid = threadIdx.x, lane = tid & 63, wid = __builtin_amdgcn_readfirstlane(tid >> 6);
    unsigned char* ws = P.ws;
    const bf16_t* QKV = (const bf16_t*)(ws + WS_QKV); const size_t TS = (size_t)T_TOK * 1024;
    bf16_t* OAB = (bf16_t*)(ws + WS_H); const float* LOGF = (const float*)(ws + WS_LOGF);
    unsigned* qctr = (unsigned*)(ws + WS_CTL + 196608);
    const unsigned* KMAXW = (const unsigned*)(ws + WS_CTL + 200704);
    volatile LAS unsigned* uw = (volatile LAS unsigned*)(lds + OFF_UNIT);
    for (;;) {
        if (tid == 0) uw[0] = atomicAdd(qctr, 1u);
        __syncthreads();
        const unsigned u = uw[0];
        __syncthreads();
        if (u >= 1024u) break;
        if (u >= 512u) { quantise_expert_rows(P, (int)(u - 512u) * 64 + wid * 8, 8); continue; }
        const int mixer = (u < 256u) ? 1 : 0, v = (int)(u & 255u), qb = 15 - (v >> 4), bh = v & 15, b = bh >> 3, h = bh & 7;
        if (mixer == 0) {
            attn_unit<0>(lds, QKV, QKV + TS, QKV + 2 * TS, OAB + h * HD, b, h, qb, 0.f, tid, lane, wid);
        } else {
            float k2 = 0.f;
#pragma unroll
            for (int w = 0; w < 4; ++w) k2 += __builtin_bit_cast(float, __hip_atomic_load(KMAXW + bh * 4 + w, __ATOMIC_RELAXED, __HIP_MEMORY_SCOPE_AGENT));
            const float kmax = sqrtf(k2) * 1.01f;
            build_cumf(lds, LOGF, b, h, 256 * (qb + 1), tid, lane, wid);
            attn_unit<1>(lds, QKV + 3 * TS, QKV + 4 * TS, QKV + 5 * TS, OAB + 1024 + h * HD, b, h, qb, kmax, tid, lane, wid);
        }
        __syncthreads();
    }
}
}

namespace peer {
__device__ __forceinline__ unsigned sortable(float f) { const unsigned u = __builtin_bit_cast(unsigned, f); return (u & 0x80000000u) ? ~u : (u | 0x80000000u); }
__device__ __forceinline__ float unsortable(unsigned k) { const unsigned u = (k & 0x80000000u) ? (k & 0x7fffffffu) : ~k; return __builtin_bit_cast(float, u); }
#define CE_DESC(x, y) do { const unsigned hi_ = (x) > (y) ? (x) : (y); const unsigned lo_ = (x) > (y) ? (y) : (x); (x) = hi_; (y) = lo_; } while (0)
template <int B, int N> __device__ __forceinline__ void sort16_desc(unsigned (&a)[N]) {
#pragma unroll
    for (int k = 2; k <= 16; k <<= 1)
#pragma unroll
        for (int j = k >> 1; j > 0; j >>= 1)
#pragma unroll
            for (int i = 0; i < 16; ++i) { const int l = i ^ j; if (l > i) { if ((i & k) == 0) CE_DESC(a[B + i], a[B + l]); else CE_DESC(a[B + l], a[B + i]); } }
}
template <int A, int Bq, int N> __device__ __forceinline__ void merge_top16(unsigned (&a)[N]) {
#pragma unroll
    for (int i = 0; i < 16; ++i) { const unsigned x = a[A + i], y = a[Bq + 15 - i]; a[A + i] = x > y ? x : y; }
#pragma unroll
    for (int j = 8; j > 0; j >>= 1)
#pragma unroll
        for (int i = 0; i < 16; ++i) { const int l = i ^ j; if (l > i) CE_DESC(a[A + i], a[A + l]); }
}

__device__ __forceinline__ void topk_phase(const Params& P, LAS unsigned char* lds, int vcu, int G) {
    const int tid = threadIdx.x, lane = tid & 63, wave = __builtin_amdgcn_readfirstlane(tid >> 6);
    const int c = lane & 31, hh = lane >> 5;
    const int gw = vcu * NWAVES + wave, NGW = G * NWAVES;
    unsigned char* ws = P.ws;
    const bf16_t* Q2 = (const bf16_t*)(ws + WS_Q2); const bf16_t* SKB = (const bf16_t*)(ws + WS_SKB);
    const float* ROWSS = (const float*)(ws + WS_CTL); int* IDS = (int*)(ws + WS_IDS); float* GATES = (float*)(ws + WS_GATES);
    LAS unsigned char* scr = lds + wave * 4096;
    for (int task = gw; task < 2048; task += NGW) {
        const int tg = task >> 3, hd = task & 7, tok = tg * 32 + c;
#pragma unroll 1
        for (int p = 0; p < 2; ++p) {
            bf16x8 qf[8];
            { const bf16_t* qp = Q2 + (size_t)tok * DM + hd * 256 + p * 128 + 8 * hh;
#pragma unroll
              for (int s = 0; s < 8; ++s) qf[s] = *(const bf16x8*)(qp + 16 * s); }
            unsigned keys[64];
#pragma unroll
            for (int sub = 0; sub < 4; ++sub) {
                f32x16 acc;
#pragma unroll
                for (int r = 0; r < 16; ++r) acc[r] = 0.f;
                const bf16_t* kp = SKB + ((size_t)(hd * 2 + p) * 128 + 32 * sub + c) * 128 + 8 * hh;
#pragma unroll
                for (int s = 0; s < 8; ++s) { const bf16x8 kf = *(const bf16x8*)(kp + 16 * s); acc = __builtin_amdgcn_mfma_f32_32x32x16_bf16(kf, qf[s], acc, 0, 0, 0); }
#pragma unroll
                for (int r = 0; r < 16; ++r) { const int nlo = 127 - (32 * sub + (r & 3) + 8 * (r >> 2)); keys[sub * 16 + r] = (sortable(acc[r]) & ~127u) | (unsigned)(nlo - 4 * hh); }
            }
            sort16_desc<0>(keys); sort16_desc<16>(keys); sort16_desc<32>(keys); sort16_desc<48>(keys);
            merge_top16<0, 16>(keys); merge_top16<32, 48>(keys); merge_top16<0, 32>(keys);
#pragma unroll
            for (int i = 0; i < 16; ++i) { const unsigned own = keys[i]; const auto rr = __builtin_amdgcn_permlane32_swap(own, own, false, false); keys[16 + i] = hh ? (unsigned)rr[0] : (unsigned)rr[1]; }
            merge_top16<0, 16>(keys);
            if (hh == 0) {
#pragma unroll
                for (int w = 0; w < 4; ++w) *(LAS u32x4*)(scr + (c * 2 + p) * 64 + w * 16) = (u32x4){keys[4 * w], keys[4 * w + 1], keys[4 * w + 2], keys[4 * w + 3]};
            }
        }
        LDS_WAIT();
        float s1[16], s2[16];
#pragma unroll
        for (int w = 0; w < 4; ++w) { const u32x4 a = *(const LAS u32x4*)(scr + (c * 2) * 64 + w * 16), b2 = *(const LAS u32x4*)(scr + (c * 2 + 1) * 64 + w * 16);
#pragma unroll
            for (int e = 0; e < 4; ++e) { s1[4 * w + e] = unsortable((a[e] & ~127u) | 64u); s2[4 * w + e] = unsortable((b2[e] & ~127u) | 64u); } }
        unsigned ck[64];
        { int n = 0;
#pragma unroll
          for (int i = 0; i < 16; ++i)
#pragma unroll
              for (int j = 0; j < 16; ++j) if ((i + 1) * (j + 1) <= 16) { ck[n] = (sortable(s1[i] + s2[j]) & ~255u) | (unsigned)(255 - (i * 16 + j)); ++n; }
#pragma unroll
          for (int q = 50; q < 64; ++q) ck[q] = 0u; }
        sort16_desc<0>(ck); sort16_desc<16>(ck); sort16_desc<32>(ck); sort16_desc<48>(ck);
        merge_top16<0, 16>(ck); merge_top16<32, 48>(ck); merge_top16<0, 32>(ck);
        unsigned t2[16];
#pragma unroll
        for (int k = 0; k < 16; ++k) t2[k] = ck[k];
        int ids[16]; float sc[16];
#pragma unroll
        for (int k = 0; k < 16; ++k) { const unsigned pos = 255u - (t2[k] & 255u);
            const unsigned k1 = *(const LAS unsigned*)(scr + (c * 2) * 64 + (pos >> 4) * 4), k2 = *(const LAS unsigned*)(scr + (c * 2 + 1) * 64 + (pos & 15u) * 4);
            ids[k] = (int)((127u - (k1 & 127u)) * 128u + (127u - (k2 & 127u))); sc[k] = unsortable((t2[k] & ~255u) | 128u); }
        LDS_WAIT();
        const float rs = 1.0f / sqrtf(ROWSS[tok] * (1.f / DM) + EPS);
        float ev[16], Z = 0.f;
#pragma unroll
        for (int k = 0; k < 16; ++k) { ev[k] = fexp2((sc[k] - sc[0]) * rs * LOG2E); Z += ev[k]; }
        const float iz = 1.f / Z;
        int* ip = IDS + (size_t)tok * 128 + hd * 16; float* gp = GATES + (size_t)tok * 128 + hd * 16;
        if (hh == 0) {
#pragma unroll
            for (int k = 0; k < 8; ++k) { ip[k] = ids[k]; gp[k] = ev[k] * iz; }
        } else {
#pragma unroll
            for (int k = 8; k < 16; ++k) { ip[k] = ids[k]; gp[k] = ev[k] * iz; }
        }
    }
}


__device__ __forceinline__ float dot8(u32x4 a, u32x4 b, float acc) {
    const unsigned a0 = a[0], a1 = a[1], a2 = a[2], a3 = a[3], b0 = b[0], b1 = b[1], b2 = b[2], b3 = b[3];
    acc = __builtin_amdgcn_fdot2_f32_bf16(__builtin_bit_cast(bf16v2, a0), __builtin_bit_cast(bf16v2, b0), acc, false);
    acc = __builtin_amdgcn_fdot2_f32_bf16(__builtin_bit_cast(bf16v2, a1), __builtin_bit_cast(bf16v2, b1), acc, false);
    acc = __builtin_amdgcn_fdot2_f32_bf16(__builtin_bit_cast(bf16v2, a2), __builtin_bit_cast(bf16v2, b2), acc, false);
    acc = __builtin_amdgcn_fdot2_f32_bf16(__builtin_bit_cast(bf16v2, a3), __builtin_bit_cast(bf16v2, b3), acc, false);
    return acc;
}
__device__ __forceinline__ float gelu_tanh(float a) { const float t = 1.5957691216f * (a + 0.044715f * a * a * a); return a * frcp(1.f + fexp2(-LOG2E * t)); }

__device__ __forceinline__ int dot16(u32x4 a, u32x4 b, int acc) {
    acc = __builtin_amdgcn_sdot4((int)a[0], (int)b[0], acc, false); acc = __builtin_amdgcn_sdot4((int)a[1], (int)b[1], acc, false);
    acc = __builtin_amdgcn_sdot4((int)a[2], (int)b[2], acc, false); acc = __builtin_amdgcn_sdot4((int)a[3], (int)b[3], acc, false);
    return acc;
}
__device__ __forceinline__ void gather_sweep(const Params& P, LAS unsigned char* lds, int vcu, int G) {
    const int tid = threadIdx.x, lane = tid & 63, wave = __builtin_amdgcn_readfirstlane(tid >> 6);
    const int gw = vcu * NWAVES + wave, NGW = G * NWAVES;
    const int g = lane >> 3, i = lane & 7;
    unsigned char* ws = P.ws;
    const bf16_t* X1B = (const bf16_t*)(ws + WS_X1B); const float* ROWSS = (const float*)(ws + WS_CTL);
    const int* IDS = (const int*)(ws + WS_IDS); const float* GATES = (const float*)(ws + WS_GATES);
    const unsigned char* EU = ws + WS_EU; const unsigned char* EV = ws + WS_EV;
    const float* SU = (const float*)(ws + WS_SU); const float* SV = (const float*)(ws + WS_SV);
    LAS unsigned char* wl = lds + wave * 16384;
    const bool b2 = (lane >> 2) & 1, b1 = (lane >> 1) & 1, b0 = lane & 1, B2 = (lane >> 5) & 1, B1 = (lane >> 4) & 1, B0 = (lane >> 3) & 1;
    for (int tg = gw; tg < T_TOK / 4; tg += NGW) {
        const int tok0 = tg * 4;
        float hs[4];
#pragma unroll
        for (int j = 0; j < 4; ++j) { const int tok = tok0 + j;
            const float rs = 1.0f / sqrtf(ROWSS[tok] * (1.f / DM) + EPS);
            f32x4 hv[8]; float hmx = 0.f;
#pragma unroll
            for (int q = 0; q < 8; ++q) { const u32x2 xb = *((const u32x2*)(X1B + (size_t)tok * DM) + lane + 64 * q); const f32x4 xv = {bf_lo(xb[0]), bf_hi(xb[0]), bf_lo(xb[1]), bf_hi(xb[1])}; const f32x4 gn = *((const f32x4*)P.g_ffn + lane + 64 * q);
                hv[q] = xv * rs * gn; hmx = fmaxf(hmx, fmaxf(fmaxf(fabsf(hv[q][0]), fabsf(hv[q][1])), fmaxf(fabsf(hv[q][2]), fabsf(hv[q][3])))); }
#pragma unroll
            for (int o = 1; o < 64; o <<= 1) hmx = fmaxf(hmx, __shfl_xor(hmx, o));
            hmx = fmaxf(hmx, 1e-30f); const float hinv = 127.f / hmx; hs[j] = hmx * (1.f / 127.f);
#pragma unroll
            for (int q = 0; q < 8; ++q) { unsigned w = 0;
#pragma unroll
                for (int e = 0; e < 4; ++e) w |= ((unsigned)(int)__builtin_rintf(hv[q][e] * hinv) & 255u) << (8 * e);
                *(LAS unsigned*)(wl + j * 2048 + 4 * (lane + 64 * q)) = w; }
#pragma unroll
            for (int hf = 0; hf < 2; ++hf) { const int k = lane + 64 * hf; const int id = IDS[(size_t)tok * 128 + k];
                *(LAS unsigned*)(wl + 8192 + (j * 128 + k) * 4) = (unsigned)id * 2048u;
                *(LAS float*)(wl + 10240 + (j * 128 + k) * 4) = GATES[(size_t)tok * 128 + k] * SV[id];
                *(LAS float*)(wl + 12288 + (j * 128 + k) * 4) = SU[id]; }
        }
        LDS_WAIT();
        int accu[4][16];
#pragma unroll
        for (int j = 0; j < 4; ++j)
#pragma unroll
            for (int m = 0; m < 16; ++m) accu[j][m] = 0;
#pragma unroll 1
        for (int sl = 0; sl < 16; ++sl) {
            __syncthreads();
            const unsigned char* ub = EU + 128 * sl + 16 * i;
#pragma unroll
            for (int j = 0; j < 4; ++j) {
                const u32x4 hqc = *(const LAS u32x4*)(wl + j * 2048 + 128 * sl + 16 * i);
                u32x4 d[16];
#pragma unroll
                for (int m = 0; m < 16; ++m) { const unsigned off = *(const LAS unsigned*)(wl + 8192 + (j * 128 + 8 * m + g) * 4); d[m] = *(const u32x4*)(ub + off); }
#pragma unroll
                for (int m = 0; m < 16; ++m) accu[j][m] = dot16(d[m], hqc, accu[j][m]);
                __builtin_amdgcn_sched_barrier(0);
            }
        }
        float sw[4];
#pragma unroll
        for (int j = 0; j < 4; ++j) {
            int r1[8], r2[4], r3[2];
#pragma unroll
            for (int m = 0; m < 8; ++m) { const int send = b2 ? accu[j][m] : accu[j][m + 8], keep = b2 ? accu[j][m + 8] : accu[j][m]; r1[m] = keep + __shfl_xor(send, 4); }
#pragma unroll
            for (int m = 0; m < 4; ++m) { const int send = b1 ? r1[m] : r1[m + 4], keep = b1 ? r1[m + 4] : r1[m]; r2[m] = keep + __shfl_xor(send, 2); }
#pragma unroll
            for (int m = 0; m < 2; ++m) { const int send = b0 ? r2[m] : r2[m + 2], keep = b0 ? r2[m + 2] : r2[m]; r3[m] = keep + __shfl_xor(send, 1); }
            float w2[2], wmx = 0.f;
#pragma unroll
            for (int m = 0; m < 2; ++m) { const int k = 16 * i + 8 * m + g;
                const float act = (float)r3[m] * (hs[j] * *(const LAS float*)(wl + 12288 + (j * 128 + k) * 4));
                w2[m] = *(const LAS float*)(wl + 10240 + (j * 128 + k) * 4) * gelu_tanh(act); wmx = fmaxf(wmx, fabsf(w2[m])); }
#pragma unroll
            for (int o = 1; o < 64; o <<= 1) wmx = fmaxf(wmx, __shfl_xor(wmx, o));
            wmx = fmaxf(wmx, 1e-30f); sw[j] = wmx * (1.f / 127.f);
            const float winv = 127.f / wmx;
            const unsigned q0 = (unsigned)(int)__builtin_rintf(w2[0] * winv) & 255u, q1 = (unsigned)(int)__builtin_rintf(w2[1] * winv) & 255u;
            *(LAS unsigned short*)(wl + 14336 + j * 128 + 16 * g + 2 * i) = (unsigned short)(q0 | (q1 << 8));
        }
        LDS_WAIT();
        float ssq[4] = {0.f, 0.f, 0.f, 0.f};
#pragma unroll 1
        for (int sl = 0; sl < 16; ++sl) {
            const unsigned char* vb = EV + 128 * sl + 16 * i;
#pragma unroll
            for (int j = 0; j < 4; ++j) {
                u32x4 d[16];
#pragma unroll
                for (int m = 0; m < 16; ++m) { const unsigned off = *(const LAS unsigned*)(wl + 8192 + (j * 128 + 8 * m + g) * 4); d[m] = *(const u32x4*)(vb + off); }
                const u32x4 wpk = *(const LAS u32x4*)(wl + 14336 + j * 128 + 16 * g);
                int ca[16];
#pragma unroll
                for (int b = 0; b < 16; ++b) ca[b] = 0;
#pragma unroll
                for (int mg = 0; mg < 4; ++mg)
#pragma unroll
                    for (int c4 = 0; c4 < 4; ++c4) { const unsigned r0 = d[4 * mg][c4], r1 = d[4 * mg + 1][c4], r2 = d[4 * mg + 2][c4], r3 = d[4 * mg + 3][c4];
                        const unsigned t0 = __builtin_amdgcn_perm(r1, r0, 0x05010400u), t1 = __builtin_amdgcn_perm(r1, r0, 0x07030602u);
                        const unsigned t2 = __builtin_amdgcn_perm(r3, r2, 0x05010400u), t3 = __builtin_amdgcn_perm(r3, r2, 0x07030602u);
                        const int wq4 = (int)wpk[mg];
                        ca[4 * c4 + 0] = __builtin_amdgcn_sdot4((int)__builtin_amdgcn_perm(t2, t0, 0x05040100u), wq4, ca[4 * c4 + 0], false);
                        ca[4 * c4 + 1] = __builtin_amdgcn_sdot4((int)__builtin_amdgcn_perm(t2, t0, 0x07060302u), wq4, ca[4 * c4 + 1], false);
                        ca[4 * c4 + 2] = __builtin_amdgcn_sdot4((int)__builtin_amdgcn_perm(t3, t1, 0x05040100u), wq4, ca[4 * c4 + 2], false);
                        ca[4 * c4 + 3] = __builtin_amdgcn_sdot4((int)__builtin_amdgcn_perm(t3, t1, 0x07060302u), wq4, ca[4 * c4 + 3], false); }
                int c1[8], c2[4], c3[2];
#pragma unroll
                for (int b = 0; b < 8; ++b) { const int send = B2 ? ca[b] : ca[b + 8], keep = B2 ? ca[b + 8] : ca[b]; c1[b] = keep + __shfl_xor(send, 32); }
#pragma unroll
                for (int b = 0; b < 4; ++b) { const int send = B1 ? c1[b] : c1[b + 4], keep = B1 ? c1[b + 4] : c1[b]; c2[b] = keep + __shfl_xor(send, 16); }
#pragma unroll
                for (int b = 0; b < 2; ++b) { const int send = B0 ? c2[b] : c2[b + 2], keep = B0 ? c2[b + 2] : c2[b]; c3[b] = keep + __shfl_xor(send, 8); }
                const size_t o = (size_t)(tok0 + j) * DM + 128 * sl + 16 * i + 2 * g;
                const unsigned xb = *(const unsigned*)(X1B + o); const f32x2 xv = {bf_lo(xb), bf_hi(xb)};
                const f32x2 x2 = {xv[0] + sw[j] * (float)c3[0], xv[1] + sw[j] * (float)c3[1]};
                ssq[j] += x2[0] * x2[0] + x2[1] * x2[1];
                *(f32x2*)(P.out + o) = x2;
                __builtin_amdgcn_sched_barrier(0);
            }
        }
#pragma unroll
        for (int j = 0; j < 4; ++j) { const float rs2 = 1.0f / sqrtf(wave_sum(ssq[j]) * (1.f / DM) + EPS);
            f32x4* orow = (f32x4*)(P.out + (size_t)(tok0 + j) * DM) + lane;
#pragma unroll
            for (int q = 0; q < 8; ++q) { const f32x4 gn = *((const f32x4*)P.g_final + lane + 64 * q); orow[64 * q] = orow[64 * q] * rs2 * gn; } }
        LDS_WAIT();
    }
}

}


#define XB_TMO      128
#define XB_XCNT(j)  (256  + 64 * (j))
#define XB_XSUB(j)  (1280 + 64 * (j))
#define XB_XGEN(j)  (2304 + 64 * (j))
#define XB_TOP      3328
#define XB_TOPGEN   3392
#define XCD_BAR_WORDS 3456
#define XB_SPIN_CAP (1u << 18)
__device__ __forceinline__ unsigned xb_ld(unsigned* p)              { return __hip_atomic_load(p, __ATOMIC_RELAXED, __HIP_MEMORY_SCOPE_AGENT); }
__device__ __forceinline__ unsigned xb_add(unsigned* p, unsigned v) { return __hip_atomic_fetch_add(p, v, __ATOMIC_RELAXED, __HIP_MEMORY_SCOPE_AGENT); }
__device__ __forceinline__ unsigned xb_xcc_id() { return (unsigned)__builtin_amdgcn_s_getreg((3 << 11) | 20) & 0xFu; }
#define XB_SPIN(cond, bar) do { unsigned _sp = 0; while (cond) { __builtin_amdgcn_s_sleep(1); \
    if ((++_sp & 255u) == 0u) { if (xb_ld(&(bar)[XB_TMO])) break; if (_sp > XB_SPIN_CAP) { atomicAdd(&(bar)[XB_TMO], 1u); break; } } } } while (0)
struct XcdBarrier { unsigned* bar; unsigned x; volatile LAS unsigned* st; };
__device__ __forceinline__ XcdBarrier xcd_barrier_post(unsigned* bar, volatile LAS unsigned* st) {
    XcdBarrier b; b.bar = bar; b.x = xb_xcc_id(); b.st = st;
    if (threadIdx.x == 0) (void)xb_add(&bar[XB_XCNT(b.x)], 1u);
    return b;
}
__device__ __forceinline__ void xcd_barrier_complete(unsigned* bar, unsigned x, unsigned& nloc, unsigned& nx) {
    const unsigned G = gridDim.x * gridDim.y * gridDim.z;
    unsigned sum, cnt, mine, sp = 0u;
    for (;;) {
        sum = 0u; cnt = 0u; mine = 0u;
#pragma unroll
        for (unsigned j = 0; j < 16; ++j) { const unsigned c = xb_ld(&bar[XB_XCNT(j)]); sum += c; cnt += (c > 0u) ? 1u : 0u; mine = (j == x) ? c : mine; }
        if (sum == G) break;
        __builtin_amdgcn_s_sleep(1);
        if ((++sp & 255u) == 0u) { if (xb_ld(&bar[XB_TMO])) break; if (sp > XB_SPIN_CAP) { atomicAdd(&bar[XB_TMO], 1u); break; } }
    }
    nloc = mine > 0u ? mine : 1u; nx = cnt > 0u ? cnt : 1u;
}
__device__ __forceinline__ void xcd_barrier(const XcdBarrier& b) {
    asm volatile("s_waitcnt vmcnt(0)" ::: "memory");
    __syncthreads();
    if (threadIdx.x == 0) {
        unsigned* bar = b.bar;
        __builtin_amdgcn_s_waitcnt(0);
        unsigned nloc = b.st[0], nx = b.st[1];
        if (nloc == 0u) { xcd_barrier_complete(bar, b.x, nloc, nx); b.st[0] = nloc; b.st[1] = nx; }
        const unsigned old = xb_add(&bar[XB_XSUB(b.x)], 1u);
        const unsigned gen = old / nloc;
        if (old + 1u == (gen + 1u) * nloc) {
            __builtin_amdgcn_fence(__ATOMIC_RELEASE, "agent");
            asm volatile("s_waitcnt vmcnt(0)" ::: "memory");
            const unsigned og = xb_add(&bar[XB_TOP], 1u);
            const unsigned tg = og / nx;
            if (og + 1u == (tg + 1u) * nx) xb_add(&bar[XB_TOPGEN], 1u);
            else XB_SPIN(xb_ld(&bar[XB_TOPGEN]) == tg, bar);
            __builtin_amdgcn_fence(__ATOMIC_ACQUIRE, "agent");
            xb_add(&bar[XB_XGEN(b.x)], 1u);
            asm volatile("s_waitcnt vmcnt(0)" ::: "memory");
        } else {
            XB_SPIN(xb_ld(&bar[XB_XGEN(b.x)]) == gen, bar);
            __builtin_amdgcn_fence(__ATOMIC_ACQUIRE, "agent");
            asm volatile("s_waitcnt vmcnt(0)" ::: "memory");
        }
    }
    __syncthreads();
}

__global__ void __launch_bounds__(NTHR, 2) mega_fwd(Params P) {
    extern __shared__ __attribute__((aligned(16))) unsigned char lds_raw[];
    LAS unsigned char* lds = (LAS unsigned char*)lds_raw;
    cg::grid_group grid = cg::this_grid();
    const int G = gridDim.x, bx = blockIdx.x;
    const int vcu = (G % 8 == 0) ? (bx % 8) * (G / 8) + bx / 8 : bx;
    unsigned char* ws = P.ws;
#ifndef ONLY_PHASE
#define ONLY_PHASE -1
#endif
#define IN(k) ((ONLY_PHASE < 0 || ONLY_PHASE == (k)) && P.ph_lo <= (k) && (k) < P.ph_hi)
    volatile LAS unsigned* bst = (volatile LAS unsigned*)(lds + 131072);
    if (threadIdx.x < 16) bst[threadIdx.x] = 0u;
    __syncthreads();
    const XcdBarrier xbar = xcd_barrier_post((unsigned*)(ws + WS_CTL + 131072), bst);
    if (P.ph_lo < 0) grid.sync();
#define SEAM(k) do { if (IN(k) && IN((k) + 1)) xcd_barrier(xbar); } while (0)
    if (IN(0)) { p0a(P, lds, vcu, G); xcd_barrier(xbar); p0b(P, lds, vcu, G); }
    SEAM(0);
    if (IN(1)) {
        pg8::Gemm g{ws + WS_H, ws + WS_WIN, T_TOK, 10240, 2048, 2048, 2048};
        pg8::StaticOrder S; S.init(T_TOK, 10240, G, bx);
        pg8::EpiProj E{(bf16_t*)(ws + WS_QKV), (bf16_t*)(ws + WS_SG), LOG2E * 0.08838834764831845f, (unsigned*)(ws + WS_CTL + 200704), (const float*)(ws + WS_HSC), (const float*)(ws + WS_WSC)};
        pg8::gemm_phase<pg8::EpiProj, true>(lds, g, S, E);
    }
    SEAM(1);
    if (IN(2)) { att::attn_phase(P, lds, vcu, G); __syncthreads(); late_transposes(P, lds, vcu, G); }
    SEAM(2);
    if (IN(3)) {
        pg8::StaticOrder S; S.init(T_TOK, DM, G, bx);
        { pg8::Gemm g{ws + WS_H, ws + WS_WAT, T_TOK, DM, 1024, 4096, 2048};
          pg8::EpiGate<0> E{(const bf16_t*)(ws + WS_SG), (bf16_t*)(ws + WS_TMP), (bf16_t*)(ws + WS_MERGED)};
          pg8::gemm_phase(lds, g, S, E); }
        { pg8::Gemm g{ws + WS_H + 2048, ws + WS_WBT, T_TOK, DM, 1024, 4096, 2048};
          pg8::EpiGate<1> E{(const bf16_t*)(ws + WS_SG) + 2048, (bf16_t*)(ws + WS_TMP), (bf16_t*)(ws + WS_MERGED)};
          pg8::gemm_phase(lds, g, S, E); }
    }
    SEAM(3);
    if (IN(4)) {
        pg8::Gemm g{ws + WS_MERGED, ws + WS_WOUT, T_TOK, DM, 2048, 4096, 4096};
        pg8::StaticOrder S; S.init(T_TOK, DM, G, bx);
        pg8::EpiResid E{P.x, (float*)(ws + WS_X1), (bf16_t*)(ws + WS_X1B), (float*)(ws + WS_CTL)};
        pg8::gemm_phase(lds, g, S, E);
    }
    SEAM(4);
    if (IN(5)) {
        pg8::Gemm g{ws + WS_X1B, ws + WS_WQ, T_TOK, DM, 2048, 4096, 4096};
        pg8::StaticOrder S; S.init(T_TOK, DM, G, bx);
        pg8::EpiPlainBf16 E{(bf16_t*)(ws + WS_Q2)};
        pg8::gemm_phase(lds, g, S, E);
    }
    SEAM(5);
    if (IN(6)) peer::topk_phase(P, lds, vcu, G);
    SEAM(6);
    if (IN(7)) { peer::gather_sweep(P, lds, vcu, G); }
#undef IN
#undef SEAM
}

extern "C" void kernel_launch(void* const* d_in, const int* in_sizes, int n_in, void* d_out, int out_size, void* d_ws, size_t ws_size, hipStream_t stream) {
    static int grid = 0;
    if (grid == 0) {
        if (n_in != 13 || out_size != T_TOK * DM || ws_size < WS_END) { fprintf(stderr, "kernel_launch: unexpected shapes (n_in %d out %d ws %zu)\n", n_in, out_size, ws_size); grid = -1; return; }
        int dev = 0, cus = 0, per_cu = 0;
        if (hipGetDevice(&dev) != hipSuccess || hipDeviceGetAttribute(&cus, hipDeviceAttributeMultiprocessorCount, dev) != hipSuccess) { grid = -1; return; }
        if (hipFuncSetAttribute((const void*)mega_fwd, hipFuncAttributeMaxDynamicSharedMemorySize, LDS_BYTES) != hipSuccess) { fprintf(stderr, "kernel_launch: hipFuncSetAttribute failed\n"); grid = -1; return; }
        if (hipOccupancyMaxActiveBlocksPerMultiprocessor(&per_cu, (const void*)mega_fwd, NTHR, LDS_BYTES) != hipSuccess || per_cu < 1) { fprintf(stderr, "kernel_launch: occupancy query says %d\n", per_cu); grid = -1; return; }
        grid = cus;
    }
    if (grid < 0) return;
    (void)hipMemsetAsync((char*)d_ws + WS_CTL, 0, 1 * MiB, stream);
    Params p{};
    p.x = (const float*)d_in[0]; p.g_mix = (const float*)d_in[1]; p.w_in = (const float*)d_in[2]; p.b_forget = (const float*)d_in[3];
    p.w_a = (const float*)d_in[4]; p.w_b = (const float*)d_in[5]; p.w_out = (const float*)d_in[6]; p.g_ffn = (const float*)d_in[7];
    p.w_query = (const float*)d_in[8]; p.sub_keys = (const float*)d_in[9]; p.e_u = (const float*)d_in[10]; p.e_v = (const float*)d_in[11]; p.g_final = (const float*)d_in[12];
    p.out = (float*)d_out; p.ws = (unsigned char*)d_ws;
#if MK_N_LAUNCHES == 1
    p.ph_lo = 0; p.ph_hi = N_PHASES;
    void* args[] = {&p};
    hipError_t e = hipLaunchCooperativeKernel((const void*)mega_fwd, dim3(grid), dim3(NTHR), args, LDS_BYTES, stream);
    if (e != hipSuccess) fprintf(stderr, "kernel_launch: cooperative launch failed: %s (grid %d)\n", hipGetErrorString(e), grid);
#else
    for (int ph = 0; ph < N_PHASES; ++ph) { p.ph_lo = ph; p.ph_hi = ph + 1; hipLaunchKernelGGL(mega_fwd, dim3(grid), dim3(NTHR), LDS_BYTES, stream, p); }
#endif
}
```

```cpp
#include <hip/hip_runtime.h>
#include <hip/hip_cooperative_groups.h>
#include <cstdio>
#include <cstdint>
namespace cg = cooperative_groups;

#define LAS __attribute__((address_space(3)))
typedef unsigned short bf16_t;
typedef short bf16x8 __attribute__((ext_vector_type(8)));
typedef short s16x4 __attribute__((ext_vector_type(4)));
typedef float f32x2 __attribute__((ext_vector_type(2)));
typedef float f32x4 __attribute__((ext_vector_type(4)));
typedef float f32x16 __attribute__((ext_vector_type(16)));
typedef unsigned u32x2 __attribute__((ext_vector_type(2)));
typedef unsigned u32x4 __attribute__((ext_vector_type(4)));
typedef __bf16 bf16v2 __attribute__((ext_vector_type(2)));
typedef int i32x4 __attribute__((ext_vector_type(4)));

#ifndef MK_N_LAUNCHES
#define MK_N_LAUNCHES 1
#endif

constexpr int T_TOK = 8192, DM = 2048, SEQ = 4096, HD = 128;
constexpr int NWAVES = 8, NTHR = 512;
constexpr int LDS_BYTES = 147456;
constexpr float LOG2E = 1.4426950408889634f;
constexpr float EPS = 1e-6f;
constexpr int N_PHASES = 8;

constexpr size_t MiB = 1u << 20;
constexpr size_t WS_CTL = 0;
constexpr size_t WS_LOGF = 1 * MiB;
constexpr size_t WS_SKB = 1 * MiB + 512 * 1024;
constexpr size_t WS_HSC = 1 * MiB + 256 * 1024;
constexpr size_t WS_WSC = 1 * MiB + 320 * 1024;
constexpr size_t CTL_CMAX = 262144;
constexpr size_t WS_IDS = 2 * MiB;
constexpr size_t WS_GATES = 6 * MiB;
constexpr size_t WS_WAT = 10 * MiB, WS_WBT = 14 * MiB, WS_WOUT = 18 * MiB, WS_WQ = 26 * MiB, WS_WIN = 34 * MiB;
constexpr size_t WS_H = 74 * MiB;
constexpr size_t WS_QKV = 106 * MiB;
constexpr size_t WS_TMP = 106 * MiB, WS_MERGED = 170 * MiB, WS_Q2 = 106 * MiB;
constexpr size_t WS_SG = 202 * MiB;
constexpr size_t WS_X1B = 202 * MiB;
constexpr size_t WS_X1 = 266 * MiB;
constexpr size_t WS_EU = 330 * MiB, WS_EV = 362 * MiB;
constexpr size_t WS_SU = 394 * MiB, WS_SV = 394 * MiB + 65536;
constexpr size_t WS_END = 395 * MiB;

struct Params {
    const float* x; const float* g_mix; const float* w_in; const float* b_forget; const float* w_a; const float* w_b; const float* w_out;
    const float* g_ffn; const float* w_query; const float* sub_keys; const float* e_u; const float* e_v; const float* g_final;
    float* out; unsigned char* ws; int ph_lo, ph_hi;
};

__device__ __forceinline__ unsigned pk2(float a, float b) { f32x2 v = {a, b}; return __builtin_bit_cast(unsigned, __builtin_convertvector(v, bf16v2)); }
__device__ __forceinline__ float bf_lo(unsigned u) { return __builtin_bit_cast(float, u << 16); }
__device__ __forceinline__ float bf_hi(unsigned u) { return __builtin_bit_cast(float, u & 0xffff0000u); }
__device__ __forceinline__ float fexp2(float x) { return __builtin_amdgcn_exp2f(x); }
__device__ __forceinline__ float flog2(float x) { return __builtin_amdgcn_logf(x); }
__device__ __forceinline__ float frcp(float x) { return __builtin_amdgcn_rcpf(x); }
__device__ __forceinline__ float wave_sum(float v) {
#pragma unroll
    for (int o = 1; o < 64; o <<= 1) v += __shfl_xor(v, o);
    return v;
}
#define LDS_WAIT() asm volatile("s_waitcnt lgkmcnt(0)" ::: "memory")

namespace pg8 {
constexpr int BM = 256, BK = 64, HALF = 128, HTB = HALF * BK * 2, STAGE_BYTES = 8 * HTB, NXCD = 8, WGM = 8;
__host__ __device__ __forceinline__ int lds_byte(int r, int c) { const int st = (r >> 4) * 2 + (c >> 5), rr = r & 15, cc = c & 31, ob = rr * 64 + cc * 2; return st * 1024 + (ob ^ (((ob >> 9) & 1) << 5)); }
__host__ __device__ __forceinline__ void stage_rc(int b, int& R, int& C) { const int st = b / 1024, sb = b % 1024, swz = sb ^ (((sb >> 9) & 1) << 5); R = (st >> 1) * 16 + swz / 64; C = (st & 1) * 32 + (swz % 64) / 2; }
__host__ __device__ __forceinline__ int perm32(int rho) { const int n = rho >> 4, i = rho & 15; return 8 * (i >> 2) + 4 * n + (i & 3); }
struct Unit { int pm, pn; };
struct Gemm { const void* A; const void* Bt; int M, N, K, pa, pb; };
struct StaticOrder {
    int nM, nN, nwg, G, c;
    __device__ void init(int M, int N, int G_, int c_) { nM = M / BM; nN = N / BM; nwg = nM * nN; G = G_; c = c_; }
    __device__ bool next(int i, Unit& u) const {
        const long L = (long)i * G + c; if (L >= nwg) return false;
        int wgid = (int)L; { const int q = nwg / NXCD, r = nwg % NXCD, xcd = wgid % NXCD, off = wgid / NXCD; wgid = (xcd < r ? xcd * (q + 1) : r * (q + 1) + (xcd - r) * q) + off; }
        const int nig = WGM * nN, gid = wgid / nig, fm = gid * WGM, gsz = (nM - fm) < WGM ? (nM - fm) : WGM;
        u.pm = fm + ((wgid % nig) % gsz); u.pn = (wgid % nig) / gsz; return true;
    }
};
template <class Epi, bool I8 = false>
__device__ __forceinline__ void gemm_phase(LAS unsigned char* lds, const Gemm g, const StaticOrder& S, const Epi& E) {
    const int tid = threadIdx.x, wid = __builtin_amdgcn_readfirstlane(tid >> 6), lane = tid & 63, wr = wid >> 2, wc = wid & 3, fr = lane & 15, fq = lane >> 4;
    const int K = g.K, nt = I8 ? K / (2 * BK) : K / BK;
    unsigned voffA[2], voffB[2];
#pragma unroll
    for (int i = 0; i < 2; ++i) { int R, C; stage_rc(tid * 16 + i * 8192, R, C); const int Rb = (R & ~31) + perm32(R & 31);
        voffA[i] = (unsigned)(R * g.pa + C * 2); voffB[i] = (unsigned)(Rb * g.pb + C * 2); }
    const size_t kstep = (size_t)(BK * 2);
    const size_t hstepA = (size_t)HALF * g.pa, hstepB = (size_t)HALF * g.pb;
    const size_t tstepA = 2 * hstepA, tstepB = 2 * hstepB;
    const unsigned ldsw = (unsigned)wid * 1024u;
    const int aoff = lds_byte(wr * 64 + fr, fq * 8), boff = lds_byte(wc * 32 + fr, fq * 8);
#define PG8_SA(b, h) (((b) * 2 + (h)) * HTB)
#define PG8_SB(b, h) ((4 + (b) * 2 + (h)) * HTB)
#define PG8_STAGE(bufoff, gbase, voff) do { _Pragma("unroll") for (int _i = 0; _i < 2; ++_i) \
        __builtin_amdgcn_global_load_lds((const unsigned*)((const char*)(gbase) + (voff)[_i]), (LAS unsigned*)(lds + (bufoff) + ldsw + _i * 8192), 16, 0, 0); } while (0)
#define PG8_LDA(dst, b, h) do { _Pragma("unroll") for (int m = 0; m < 4; ++m) _Pragma("unroll") for (int k = 0; k < 2; ++k) dst[m][k] = *(const LAS bf16x8*)(lds + PG8_SA(b, h) + aoff + m * 2048 + k * 1024); } while (0)
#define PG8_LDB(dst, b, h) do { _Pragma("unroll") for (int n = 0; n < 2; ++n) _Pragma("unroll") for (int k = 0; k < 2; ++k) dst[n][k] = *(const LAS bf16x8*)(lds + PG8_SB(b, h) + boff + n * 2048 + k * 1024); } while (0)
#define PG8_MMA(ai, bj, At, Bt) do { __builtin_amdgcn_s_setprio(1); _Pragma("unroll") for (int m = 0; m < 4; ++m) _Pragma("unroll") for (int n = 0; n < 2; ++n) _Pragma("unroll") for (int k = 0; k < 2; ++k) \
        { if (I8) acc[ai][bj][m][n] = __builtin_bit_cast(f32x4, __builtin_amdgcn_mfma_i32_16x16x64_i8(__builtin_bit_cast(i32x4, Bt[n][k]), __builtin_bit_cast(i32x4, At[m][k]), __builtin_bit_cast(i32x4, acc[ai][bj][m][n]), 0, 0, 0)); \
          else acc[ai][bj][m][n] = __builtin_amdgcn_mfma_f32_16x16x32_bf16(Bt[n][k], At[m][k], acc[ai][bj][m][n], 0, 0, 0); } __builtin_amdgcn_s_setprio(0); } while (0)
#define PG8_WAIT_V(n) asm volatile("s_waitcnt vmcnt(" #n ")" ::: "memory")
#define PG8_WAIT_L(n) asm volatile("s_waitcnt lgkmcnt(" #n ")" ::: "memory")
#define PG8_BAR __builtin_amdgcn_s_barrier()
#define PG8_SCHED __builtin_amdgcn_sched_barrier(0)
    Unit cur, nxt; int ui = 0;
    if (!S.next(0, cur)) return;
    f32x4 acc[2][2][4][2];
#pragma unroll
    for (int a = 0; a < 2; ++a)
#pragma unroll
        for (int b = 0; b < 2; ++b)
#pragma unroll
            for (int m = 0; m < 4; ++m)
#pragma unroll
                for (int n = 0; n < 2; ++n) acc[a][b][m][n] = (f32x4){0.f, 0.f, 0.f, 0.f};
    bf16x8 At[4][2], B0[2][2], B1[2][2];
    const char* cA = (const char*)g.A + (size_t)cur.pm * tstepA; const char* cB = (const char*)g.Bt + (size_t)cur.pn * tstepB;
    PG8_STAGE(PG8_SB(0, 0), cB, voffB); PG8_STAGE(PG8_SA(0, 0), cA, voffA); PG8_STAGE(PG8_SB(0, 1), cB + hstepB, voffB); PG8_STAGE(PG8_SA(0, 1), cA + hstepA, voffA);
    if (wr == 1) PG8_BAR;
    PG8_WAIT_V(4); PG8_BAR;
    PG8_STAGE(PG8_SB(1, 0), cB + kstep, voffB); PG8_STAGE(PG8_SA(1, 0), cA + kstep, voffA); PG8_STAGE(PG8_SB(1, 1), cB + hstepB + kstep, voffB);
    PG8_WAIT_V(6); PG8_BAR;
    for (;;) {
        const bool has_next = S.next(ui + 1, nxt);
        const char* nA = has_next ? (const char*)g.A + (size_t)nxt.pm * tstepA : cA; const char* nB = has_next ? (const char*)g.Bt + (size_t)nxt.pn * tstepB : cB;
        for (int t = 0; t < nt; t += 2) {
            const bool last = (t == nt - 2);
            const char* a1 = cA + (size_t)(t + 1) * kstep;
            const char* a2 = last ? nA : cA + (size_t)(t + 2) * kstep; const char* b2 = last ? nB : cB + (size_t)(t + 2) * kstep;
            const char* a3 = a2 + kstep; const char* b3 = b2 + kstep;
            PG8_LDB(B0, 0, 0); PG8_SCHED; PG8_LDA(At, 0, 0); PG8_STAGE(PG8_SA(1, 1), a1 + hstepA, voffA);
            PG8_WAIT_L(8); PG8_BAR; PG8_WAIT_L(0); PG8_MMA(0, 0, At, B0); PG8_BAR; PG8_SCHED;
            PG8_LDB(B1, 0, 1); PG8_STAGE(PG8_SB(0, 0), b2, voffB);
            PG8_BAR; PG8_WAIT_L(0); PG8_MMA(0, 1, At, B1); PG8_BAR;
            PG8_LDA(At, 0, 1); PG8_STAGE(PG8_SA(0, 0), a2, voffA);
            PG8_BAR; PG8_WAIT_L(0); PG8_MMA(1, 0, At, B0); PG8_BAR; PG8_SCHED;
            PG8_STAGE(PG8_SB(0, 1), b2 + hstepB, voffB);
            PG8_WAIT_V(6); PG8_BAR; PG8_MMA(1, 1, At, B1); PG8_BAR;
            PG8_LDB(B0, 1, 0); PG8_SCHED; PG8_LDA(At, 1, 0); PG8_STAGE(PG8_SA(0, 1), a2 + hstepA, voffA);
            PG8_WAIT_L(8); PG8_BAR; PG8_WAIT_L(0); PG8_MMA(0, 0, At, B0); PG8_BAR; PG8_SCHED;
            PG8_LDB(B1, 1, 1); PG8_STAGE(PG8_SB(1, 0), b3, voffB);
            PG8_BAR; PG8_WAIT_L(0); PG8_MMA(0, 1, At, B1); PG8_BAR;
            PG8_LDA(At, 1, 1); PG8_STAGE(PG8_SA(1, 0), a3, voffA);
            PG8_BAR; PG8_WAIT_L(0); PG8_MMA(1, 0, At, B0); PG8_BAR; PG8_SCHED;
            PG8_STAGE(PG8_SB(1, 1), b3 + hstepB, voffB);
            PG8_WAIT_V(6); PG8_BAR; PG8_MMA(1, 1, At, B1); PG8_BAR;
        }
        E(acc, cur, wr, wc, fr, fq);
        if (!has_next) break;
#pragma unroll
        for (int a = 0; a < 2; ++a)
#pragma unroll
            for (int b = 0; b < 2; ++b)
#pragma unroll
                for (int m = 0; m < 4; ++m)
#pragma unroll
                    for (int n = 0; n < 2; ++n) acc[a][b][m][n] = (f32x4){0.f, 0.f, 0.f, 0.f};
        cur = nxt; cA = nA; cB = nB; ++ui;
    }
    PG8_WAIT_V(0);
    if (wr == 0) PG8_BAR;
    PG8_BAR;
#undef PG8_SA
#undef PG8_SB
#undef PG8_STAGE
#undef PG8_LDA
#undef PG8_LDB
#undef PG8_MMA
#undef PG8_WAIT_V
#undef PG8_WAIT_L
#undef PG8_BAR
#undef PG8_SCHED
}

struct EpiProj {
    bf16_t* qkv; bf16_t* sg; float qscale; unsigned* kmaxw; const float* hsc; const float* wsc;
    __device__ __forceinline__ void operator()(const f32x4 (&acci)[2][2][4][2], const Unit& u, int wr, int wc, int fr, int fq) const {
        const int row0 = u.pm * BM + wr * 64 + fr;
        f32x4 acc[2][2][4][2];
        { f32x4 cs[2][2];
#pragma unroll
          for (int bj = 0; bj < 2; ++bj)
#pragma unroll
              for (int n = 0; n < 2; ++n) cs[bj][n] = *(const f32x4*)(wsc + u.pn * BM + bj * HALF + wc * 32 + 8 * fq + 4 * n);
#pragma unroll
          for (int ai = 0; ai < 2; ++ai)
#pragma unroll
              for (int m = 0; m < 4; ++m) { const float rsc = hsc[row0 + ai * HALF + m * 16];
#pragma unroll
                  for (int bj = 0; bj < 2; ++bj)
#pragma unroll
                      for (int n = 0; n < 2; ++n) { const i32x4 iv = __builtin_bit_cast(i32x4, acci[ai][bj][m][n]);
                          acc[ai][bj][m][n] = (f32x4){(float)iv[0], (float)iv[1], (float)iv[2], (float)iv[3]} * rsc * cs[bj][n]; } } }
        if (u.pn < 24) {
            const int t = u.pn >> 2; bf16_t* base = qkv + (size_t)t * ((size_t)T_TOK * 1024) + (u.pn & 3) * 256 + wc * 32 + 8 * fq;
            const float sc = (t == 0 || t == 3) ? qscale : 1.f;
            if (t == 4) {
#pragma unroll
                for (int bj = 0; bj < 2; ++bj) { float mxv = 0.f;
#pragma unroll
                    for (int ai = 0; ai < 2; ++ai)
#pragma unroll
                        for (int m = 0; m < 4; ++m) { const f32x4 v0 = acc[ai][bj][m][0], v1 = acc[ai][bj][m][1];
                            float ssq = (v0[0] * v0[0] + v0[1] * v0[1]) + (v0[2] * v0[2] + v0[3] * v0[3]) + (v1[0] * v1[0] + v1[1] * v1[1]) + (v1[2] * v1[2] + v1[3] * v1[3]);
                            ssq += __shfl_xor(ssq, 16); ssq += __shfl_xor(ssq, 32); mxv = fmaxf(mxv, ssq); }
#pragma unroll
                    for (int o = 1; o < 16; o <<= 1) mxv = fmaxf(mxv, __shfl_xor(mxv, o));
                    if ((fr | fq) == 0) atomicMax(kmaxw + ((u.pm >> 4) * 8 + (u.pn & 3) * 2 + bj) * 4 + wc, __builtin_bit_cast(unsigned, mxv)); }
            }
#pragma unroll
            for (int ai = 0; ai < 2; ++ai)
#pragma unroll
                for (int m = 0; m < 4; ++m) { bf16_t* rowp = base + (size_t)(row0 + ai * HALF + m * 16) * 1024;
#pragma unroll
                    for (int bj = 0; bj < 2; ++bj) { const f32x4 v0 = acc[ai][bj][m][0] * sc, v1 = acc[ai][bj][m][1] * sc;
                        u32x4 w; w.x = pk2(v0[0], v0[1]); w.y = pk2(v0[2], v0[3]); w.z = pk2(v1[0], v1[1]); w.w = pk2(v1[2], v1[3]);
                        *(u32x4*)(rowp + bj * HALF) = w; } }
        } else {
            bf16_t* base = sg + (u.pn - 24) * 256 + wc * 32 + 8 * fq;
#pragma unroll
            for (int ai = 0; ai < 2; ++ai)
#pragma unroll
                for (int m = 0; m < 4; ++m) { bf16_t* rowp = base + (size_t)(row0 + ai * HALF + m * 16) * 4096;
#pragma unroll
                    for (int bj = 0; bj < 2; ++bj) { float s[8];
#pragma unroll
                        for (int e = 0; e < 4; ++e) { s[e] = frcp(1.f + fexp2(-LOG2E * acc[ai][bj][m][0][e])); s[4 + e] = frcp(1.f + fexp2(-LOG2E * acc[ai][bj][m][1][e])); }
                        u32x4 w; w.x = pk2(s[0], s[1]); w.y = pk2(s[2], s[3]); w.z = pk2(s[4], s[5]); w.w = pk2(s[6], s[7]);
                        *(u32x4*)(rowp + bj * HALF) = w; } }
        }
    }
};
template <int SECOND> struct EpiGate {
    const bf16_t* sg;
    bf16_t* tmp; bf16_t* merged;
    __device__ __forceinline__ void operator()(const f32x4 (&acc)[2][2][4][2], const Unit& u, int wr, int wc, int fr, int fq) const {
        const int row0 = u.pm * BM + wr * 64 + fr, col0 = u.pn * BM + wc * 32 + 8 * fq;
#pragma unroll
        for (int ai = 0; ai < 2; ++ai)
#pragma unroll
            for (int m = 0; m < 4; ++m) { const size_t row = (size_t)(row0 + ai * HALF + m * 16);
#pragma unroll
                for (int bj = 0; bj < 2; ++bj) { const int col = col0 + bj * HALF;
                    const u32x4 gv = *(const u32x4*)(sg + row * 4096 + col);
                    const f32x4 g0 = {bf_lo(gv.x), bf_hi(gv.x), bf_lo(gv.y), bf_hi(gv.y)}, g1 = {bf_lo(gv.z), bf_hi(gv.z), bf_lo(gv.w), bf_hi(gv.w)};
                    f32x4 v0 = acc[ai][bj][m][0] * g0, v1 = acc[ai][bj][m][1] * g1;
                    bf16_t* tp = tmp + row * DM + col;
                    if (SECOND == 0) { u32x4 w; w.x = pk2(v0[0], v0[1]); w.y = pk2(v0[2], v0[3]); w.z = pk2(v1[0], v1[1]); w.w = pk2(v1[2], v1[3]); *(u32x4*)tp = w; }
                    else { const u32x4 tv = *(const u32x4*)tp; v0 += (f32x4){bf_lo(tv.x), bf_hi(tv.x), bf_lo(tv.y), bf_hi(tv.y)}; v1 += (f32x4){bf_lo(tv.z), bf_hi(tv.z), bf_lo(tv.w), bf_hi(tv.w)};
                        u32x4 w; w.x = pk2(v0[0], v0[1]); w.y = pk2(v0[2], v0[3]); w.z = pk2(v1[0], v1[1]); w.w = pk2(v1[2], v1[3]);
                        *(u32x4*)(merged + row * DM + col) = w; } } }
    }
};
struct EpiResid {
    const float* x; float* x1; bf16_t* x1b; float* rowss;
    __device__ __forceinline__ void operator()(const f32x4 (&acc)[2][2][4][2], const Unit& u, int wr, int wc, int fr, int fq) const {
        const int row0 = u.pm * BM + wr * 64 + fr, col0 = u.pn * BM + wc * 32 + 8 * fq;
#pragma unroll
        for (int ai = 0; ai < 2; ++ai)
#pragma unroll
            for (int m = 0; m < 4; ++m) { const size_t row = (size_t)(row0 + ai * HALF + m * 16); float ss = 0.f;
#pragma unroll
                for (int bj = 0; bj < 2; ++bj) { const size_t o = row * DM + col0 + bj * HALF;
                    const f32x4 v0 = acc[ai][bj][m][0] + *(const f32x4*)(x + o), v1 = acc[ai][bj][m][1] + *(const f32x4*)(x + o + 4);
                    u32x4 w; w.x = pk2(v0[0], v0[1]); w.y = pk2(v0[2], v0[3]); w.z = pk2(v1[0], v1[1]); w.w = pk2(v1[2], v1[3]);
                    *(u32x4*)(x1b + o) = w;
                    ss += (v0[0] * v0[0] + v0[1] * v0[1]) + (v0[2] * v0[2] + v0[3] * v0[3]) + (v1[0] * v1[0] + v1[1] * v1[1]) + (v1[2] * v1[2] + v1[3] * v1[3]); }
                ss += __shfl_xor(ss, 16); ss += __shfl_xor(ss, 32);
                if (fq == 0) atomicAdd(rowss + row, ss); }
    }
};
struct EpiPlainBf16 {
    bf16_t* o;
    __device__ __forceinline__ void operator()(const f32x4 (&acc)[2][2][4][2], const Unit& u, int wr, int wc, int fr, int fq) const {
        const int row0 = u.pm * BM + wr * 64 + fr, col0 = u.pn * BM + wc * 32 + 8 * fq;
#pragma unroll
        for (int ai = 0; ai < 2; ++ai)
#pragma unroll
            for (int m = 0; m < 4; ++m) { const size_t row = (size_t)(row0 + ai * HALF + m * 16);
#pragma unroll
                for (int bj = 0; bj < 2; ++bj) { const f32x4 v0 = acc[ai][bj][m][0], v1 = acc[ai][bj][m][1];
                    u32x4 w; w.x = pk2(v0[0], v0[1]); w.y = pk2(v0[2], v0[3]); w.z = pk2(v1[0], v1[1]); w.w = pk2(v1[2], v1[3]);
                    *(u32x4*)(o + row * DM + col0 + bj * HALF) = w; } }
    }
};
}

__device__ __forceinline__ void transpose_item(const float* W, int ldw, int src_n0, bf16_t* WT, int K, int dst_n0, int k0, LAS float* scr, int lane, const float* kscale) {
    { const int c4 = (lane & 7) * 4;
      f32x4 v[8];
#pragma unroll
      for (int i = 0; i < 8; ++i) v[i] = *(const f32x4*)(W + (size_t)(k0 + 8 * i + (lane >> 3)) * ldw + src_n0 + c4);
#pragma unroll
      for (int i = 0; i < 8; ++i) { const int kk = 8 * i + (lane >> 3); const float ks = kscale ? kscale[k0 + kk] : 1.f; LAS float* sp = scr + kk * 33 + c4;
          sp[0] = v[i][0] * ks; sp[1] = v[i][1] * ks; sp[2] = v[i][2] * ks; sp[3] = v[i][3] * ks; } }
    LDS_WAIT();
    const int c = lane & 7;
#pragma unroll
    for (int j = 0; j < 4; ++j) { const int n = (lane >> 3) + 8 * j; const LAS float* s = scr + (8 * c) * 33 + n;
        u32x4 o; o.x = pk2(s[0 * 33], s[1 * 33]); o.y = pk2(s[2 * 33], s[3 * 33]); o.z = pk2(s[4 * 33], s[5 * 33]); o.w = pk2(s[6 * 33], s[7 * 33]);
        *(u32x4*)(WT + (size_t)(dst_n0 + n) * K + k0 + 8 * c) = o; }
    LDS_WAIT();
}

__device__ __forceinline__ void p0a(const Params& P, LAS unsigned char* lds, int vcu, int G) {
    const int tid = threadIdx.x, lane = tid & 63, wave = __builtin_amdgcn_readfirstlane(tid >> 6);
    const int gw = vcu * NWAVES + wave, NGW = G * NWAVES;
    unsigned char* ws = P.ws;
    {
        unsigned* CMAX = (unsigned*)(ws + WS_CTL + CTL_CMAX);
        constexpr int NCB = (10248 + 255) / 256;
        for (int it = gw; it < 128 * NCB; it += NGW) { const int kb = it / NCB, cb = it % NCB, sc = cb * 256 + 4 * lane;
            if (sc < 10248) { f32x4 v[16];
#pragma unroll
                for (int r = 0; r < 16; ++r) v[r] = *(const f32x4*)(P.w_in + (size_t)(kb * 16 + r) * 10248 + sc);
                float m0 = 0.f, m1 = 0.f, m2 = 0.f, m3 = 0.f;
#pragma unroll
                for (int r = 0; r < 16; ++r) { m0 = fmaxf(m0, fabsf(v[r][0])); m1 = fmaxf(m1, fabsf(v[r][1])); m2 = fmaxf(m2, fabsf(v[r][2])); m3 = fmaxf(m3, fabsf(v[r][3])); }
                const float mm[4] = {m0, m1, m2, m3};
#pragma unroll
                for (int e = 0; e < 4; ++e) { const int c = sc + e; const unsigned mb = __float_as_uint(mm[e]);
                    if (c < 6144) atomicMax(CMAX + c, mb); else if (c >= 6152) atomicMax(CMAX + c - 8, mb); } } }
    }
    {
        LAS float* wf = (LAS float*)lds;
        for (int k = tid; k < 2048; k += NTHR) { const f32x4 a0 = *(const f32x4*)(P.w_in + (size_t)k * 10248 + 6144), a1 = *(const f32x4*)(P.w_in + (size_t)k * 10248 + 6148);
            wf[k] = a0[0]; wf[2048 + k] = a0[1]; wf[4096 + k] = a0[2]; wf[6144 + k] = a0[3]; wf[8192 + k] = a1[0]; wf[10240 + k] = a1[1]; wf[12288 + k] = a1[2]; wf[14336 + k] = a1[3]; }
        __syncthreads();
        unsigned char* HQ8 = ws + WS_H; float* HSC = (float*)(ws + WS_HSC); float* LOGF = (float*)(ws + WS_LOGF);
        f32x4 xn[8];
        if (gw < T_TOK) { const f32x4* xr = (const f32x4*)(P.x + (size_t)gw * DM) + lane;
#pragma unroll
            for (int j = 0; j < 8; ++j) xn[j] = xr[64 * j]; }
        for (int r = gw; r < T_TOK; r += NGW) {
            float ss = 0.f, amx = 0.f; f32x4 hv[8];
#pragma unroll
            for (int j = 0; j < 8; ++j) { const f32x4 v = xn[j]; const f32x4 gn = *((const f32x4*)P.g_mix + lane + 64 * j); ss += (v[0] * v[0] + v[1] * v[1]) + (v[2] * v[2] + v[3] * v[3]);
                hv[j] = v * gn; amx = fmaxf(amx, fmaxf(fmaxf(fabsf(hv[j][0]), fabsf(hv[j][1])), fmaxf(fabsf(hv[j][2]), fabsf(hv[j][3])))); }
            if (r + NGW < T_TOK) { const f32x4* xr = (const f32x4*)(P.x + (size_t)(r + NGW) * DM) + lane;
#pragma unroll
                for (int j = 0; j < 8; ++j) xn[j] = xr[64 * j]; }
            const float rstd = 1.0f / sqrtf(wave_sum(ss) * (1.f / DM) + EPS);
#pragma unroll
            for (int o = 1; o < 64; o <<= 1) amx = fmaxf(amx, __shfl_xor(amx, o));
            const float hmax = fmaxf(amx * rstd, 1e-30f), hinv = 127.f / hmax;
            float fl[8];
#pragma unroll
            for (int c = 0; c < 8; ++c) fl[c] = 0.f;
            unsigned* hp = (unsigned*)(HQ8 + (size_t)r * DM) + lane;
#pragma unroll
            for (int j = 0; j < 8; ++j) { const f32x4 h = hv[j] * rstd;
                unsigned w = 0;
#pragma unroll
                for (int e = 0; e < 4; ++e) w |= ((unsigned)(int)__builtin_rintf(h[e] * hinv) & 255u) << (8 * e);
                hp[64 * j] = w;
#pragma unroll
                for (int c = 0; c < 8; ++c) { const f32x4 wv = *((const LAS f32x4*)(wf + c * 2048) + lane + 64 * j); fl[c] += (h[0] * wv[0] + h[1] * wv[1]) + (h[2] * wv[2] + h[3] * wv[3]); }
                __builtin_amdgcn_sched_barrier(0); }
            { const bool b5 = (lane >> 5) & 1, b4 = (lane >> 4) & 1, b3 = (lane >> 3) & 1; float p1[4], p2[2], p3;
#pragma unroll
              for (int q = 0; q < 4; ++q) { const float send = b5 ? fl[q] : fl[q + 4], keep = b5 ? fl[q + 4] : fl[q]; p1[q] = keep + __shfl_xor(send, 32); }
#pragma unroll
              for (int q = 0; q < 2; ++q) { const float send = b4 ? p1[q] : p1[q + 2], keep = b4 ? p1[q + 2] : p1[q]; p2[q] = keep + __shfl_xor(send, 16); }
              { const float send = b3 ? p2[0] : p2[1], keep = b3 ? p2[1] : p2[0]; p3 = keep + __shfl_xor(send, 8); }
              p3 += __shfl_xor(p3, 4); p3 += __shfl_xor(p3, 2); p3 += __shfl_xor(p3, 1);
              if (lane == 0) HSC[r] = hmax * (1.f / 127.f);
              if ((lane & 7) == 0) { const int c = lane >> 3; const float y = p3 + P.b_forget[c]; LOGF[((size_t)(r >> 12) * 8 + c) * SEQ + (r & (SEQ - 1))] = fminf(y, 0.f) - log1pf(expf(-fabsf(y))); } }
        }
    }
    {
        const size_t gid = (size_t)vcu * NTHR + tid, gstride = (size_t)G * NTHR;
        for (size_t i = gid; i < 262144 / 8; i += gstride) { const float* src = P.sub_keys + i * 8; const f32x4 a = *(const f32x4*)src, b = *((const f32x4*)src + 1);
            u32x4 o; o.x = pk2(a[0], a[1]); o.y = pk2(a[2], a[3]); o.z = pk2(b[0], b[1]); o.w = pk2(b[2], b[3]); *(u32x4*)((bf16_t*)(ws + WS_SKB) + i * 8) = o; }
    }
}
__device__ __forceinline__ void p0b(const Params& P, LAS unsigned char* lds, int vcu, int G) {
    const int tid = threadIdx.x, lane = tid & 63, wave = __builtin_amdgcn_readfirstlane(tid >> 6);
    const int gw = vcu * NWAVES + wave, NGW = G * NWAVES;
    unsigned char* ws = P.ws;
    const unsigned* CMAX = (const unsigned*)(ws + WS_CTL + CTL_CMAX); float* WSC = (float*)(ws + WS_WSC); unsigned char* WT8 = ws + WS_WIN;
    LAS float* scr = (LAS float*)(lds + wave * 16384);
    for (int it = gw; it < 32 * 320; it += NGW) {
        const int nb = it >> 5, kb = it & 31, dn = nb * 32, sn = dn < 6144 ? dn : dn + 8, k0 = kb * 64;
        const int c4 = (lane & 7) * 4;
        float inv[4];
#pragma unroll
        for (int e = 0; e < 4; ++e) { const float cm = fmaxf(__uint_as_float(__hip_atomic_load(CMAX + dn + c4 + e, __ATOMIC_RELAXED, __HIP_MEMORY_SCOPE_AGENT)), 1e-30f); inv[e] = 127.f / cm;
            if (kb == 0 && lane < 8) WSC[dn + c4 + e] = cm * (1.f / 127.f); }
        f32x4 v[8];
#pragma unroll
        for (int i = 0; i < 8; ++i) v[i] = *(const f32x4*)(P.w_in + (size_t)(k0 + 8 * i + (lane >> 3)) * 10248 + sn + c4);
#pragma unroll
        for (int i = 0; i < 8; ++i) { LAS float* sp = scr + (8 * i + (lane >> 3)) * 33 + c4; sp[0] = v[i][0] * inv[0]; sp[1] = v[i][1] * inv[1]; sp[2] = v[i][2] * inv[2]; sp[3] = v[i][3] * inv[3]; }
        LDS_WAIT();
        const int c = lane & 3;
#pragma unroll
        for (int j = 0; j < 2; ++j) { const int n = (lane >> 2) + 16 * j; const LAS float* sp = scr + (16 * c) * 33 + n;
            u32x4 o;
#pragma unroll
            for (int w4 = 0; w4 < 4; ++w4) { unsigned w = 0;
#pragma unroll
                for (int e = 0; e < 4; ++e) w |= ((unsigned)(int)fminf(fmaxf(__builtin_rintf(sp[(4 * w4 + e) * 33]), -127.f), 127.f) & 255u) << (8 * e);
                o[w4] = w; }
            *(u32x4*)(WT8 + (size_t)(dn + n) * 2048 + k0 + 16 * c) = o; }
        LDS_WAIT();
    }
}
__device__ __forceinline__ void late_transposes(const Params& P, LAS unsigned char* lds, int vcu, int G) {
    const int tid = threadIdx.x, lane = tid & 63, wave = __builtin_amdgcn_readfirstlane(tid >> 6);
    const int gw = vcu * NWAVES + wave, NGW = G * NWAVES;
    unsigned char* ws = P.ws;
    LAS float* scr = (LAS float*)(lds + wave * 16384);
    constexpr int I_A = 16 * 64, I_O = 32 * 64, NITEMS = 2 * I_A + 2 * I_O;
    for (int it = gw; it < NITEMS; it += NGW) {
        int r = it;
        if (r < I_A) { const int kb = r / 64, nb = r % 64; transpose_item(P.w_a, 2048, nb * 32, (bf16_t*)(ws + WS_WAT), 1024, nb * 32, kb * 64, scr, lane, nullptr); continue; } r -= I_A;
        if (r < I_A) { const int kb = r / 64, nb = r % 64; transpose_item(P.w_b, 2048, nb * 32, (bf16_t*)(ws + WS_WBT), 1024, nb * 32, kb * 64, scr, lane, nullptr); continue; } r -= I_A;
        if (r < I_O) { const int kb = r / 64, nb = r % 64; transpose_item(P.w_out, 2048, nb * 32, (bf16_t*)(ws + WS_WOUT), 2048, nb * 32, kb * 64, scr, lane, nullptr); continue; } r -= I_O;
        { const int kb = r / 64, nb = r % 64; transpose_item(P.w_query, 2048, nb * 32, (bf16_t*)(ws + WS_WQ), 2048, nb * 32, kb * 64, scr, lane, P.g_ffn); }
    }
}
__device__ __forceinline__ void quantise_expert_rows(const Params& P, int r0, int nrows) {
    const int lane = threadIdx.x & 63;
    unsigned char* ws = P.ws;
    float* SU = (float*)(ws + WS_SU); float* SV = (float*)(ws + WS_SV);
    for (int r = r0; r < r0 + nrows; r += 2) {
        f32x4 v[2][8];
#pragma unroll
        for (int t = 0; t < 2; ++t) { const int rr = r + t; const f32x4* src = (const f32x4*)((rr >= 16384 ? P.e_v : P.e_u) + (size_t)(rr & 16383) * DM) + lane;
#pragma unroll
            for (int j = 0; j < 8; ++j) v[t][j] = __builtin_nontemporal_load(src + 64 * j); }
#pragma unroll
        for (int t = 0; t < 2; ++t) { const int rr = r + t; const bool second = rr >= 16384; const int row = rr & 16383;
            float mx = 0.f;
#pragma unroll
            for (int j = 0; j < 8; ++j) mx = fmaxf(mx, fmaxf(fmaxf(fabsf(v[t][j][0]), fabsf(v[t][j][1])), fmaxf(fabsf(v[t][j][2]), fabsf(v[t][j][3]))));
#pragma unroll
            for (int o = 1; o < 64; o <<= 1) mx = fmaxf(mx, __shfl_xor(mx, o));
            mx = fmaxf(mx, 1e-30f);
            const float inv = 127.f / mx;
            unsigned* dst = (unsigned*)(ws + (second ? WS_EV : WS_EU) + (size_t)row * DM) + lane;
#pragma unroll
            for (int j = 0; j < 8; ++j) { unsigned w = 0;
#pragma unroll
                for (int e = 0; e < 4; ++e) { const int q = (int)__builtin_rintf(v[t][j][e] * inv); w |= ((unsigned)q & 255u) << (8 * e); }
                dst[64 * j] = w; }
            if (lane == 0) (second ? SV : SU)[row] = mx * (1.f / 127.f);
        }
    }
}

namespace att {
constexpr int KST = 272, VST = 320;
constexpr int KBUF = 64 * KST, VBUF = 64 * VST;
constexpr int OFF_K = 0, OFF_V = 2 * KBUF, OFF_F = OFF_V + 2 * VBUF, OFF_SC = OFF_F + 4096 * 4;
constexpr int OFF_FLG = OFF_SC + 64, OFF_UNIT = OFF_FLG + 64;
static_assert(OFF_UNIT + 16 <= 131072, "attention LDS");
constexpr float THR_SB = 30.f, THR_FOX = 20.f;

__device__ __forceinline__ void build_cumf(LAS unsigned char* lds, const float* LOGF, int b, int h, int n, int tid, int lane, int wid) {
    LAS float* F2 = (LAS float*)(lds + OFF_F); LAS float* sc = (LAS float*)(lds + OFF_SC);
    const int s0 = tid * 8; float v[8];
    { const f32x4* lp = (const f32x4*)(LOGF + ((size_t)b * 8 + h) * SEQ + s0); f32x4 a0 = {0.f, 0.f, 0.f, 0.f}, a1 = a0; if (s0 < n) { a0 = lp[0]; a1 = lp[1]; }
      v[0] = a0[0] * LOG2E; v[1] = a0[1] * LOG2E; v[2] = a0[2] * LOG2E; v[3] = a0[3] * LOG2E; v[4] = a1[0] * LOG2E; v[5] = a1[1] * LOG2E; v[6] = a1[2] * LOG2E; v[7] = a1[3] * LOG2E; }
#pragma unroll
    for (int i = 1; i < 8; ++i) v[i] += v[i - 1];
    float tot = v[7], inc = tot;
#pragma unroll
    for (int o = 1; o < 64; o <<= 1) { const float t = __shfl_up(inc, o); if (lane >= o) inc += t; }
    if (lane == 63) sc[wid] = inc;
    __syncthreads();
    float base = inc - tot;
#pragma unroll
    for (int w = 0; w < 8; ++w) if (w < wid) base += sc[w];
    if (s0 < n) {
#pragma unroll
        for (int i = 0; i < 8; ++i) F2[s0 + i] = v[i] + base;
    }
    __syncthreads();
}

template <int MIXER>
__device__ __forceinline__ void attn_unit(LAS unsigned char* lds, const bf16_t* Q, const bf16_t* Kg, const bf16_t* Vg, bf16_t* O, int b, int h, int qb, float kmax, int tid, int lane, int wid) {
    const int c = lane & 31, hh = lane >> 5;
    const int t0 = qb * 256 + wid * 32, tq = t0 + c;
    const size_t rowbase = (size_t)b * SEQ;
    size_t qoff = (rowbase + tq) * 1024 + h * HD + 8 * hh;
    f32x16 oacc[4];
#pragma unroll
    for (int d = 0; d < 4; ++d)
#pragma unroll
        for (int r = 0; r < 16; ++r) oacc[d][r] = 0.f;
    float carry = 0.f, mrun = -1e30f, lsum = 0.f; const float nhf = hh ? 0.f : 1.f;
    const LAS float* F2 = (const LAS float*)(lds + OFF_F);
    const float Ft = (MIXER == 1) ? F2[tq] : 0.f;
    float qk_bound = 0.f;
    if (MIXER == 1) { float qs = 0.f;
#pragma unroll
        for (int s2 = 0; s2 < 8; ++s2) { const u32x4 qv = *(const u32x4*)(Q + qoff + 16 * s2);
#pragma unroll
            for (int e = 0; e < 4; ++e) { const float a = bf_lo(qv[e]), b2 = bf_hi(qv[e]); qs += a * a + b2 * b2; } }
        qs += __shfl_xor(qs, 32);
        qk_bound = sqrtf(qs) * kmax; }
    bool wave_done = false;
    volatile LAS unsigned* flg = (volatile LAS unsigned*)(lds + OFF_FLG);
    const int ktmax = 4 * qb + 3;
    const int srow = tid >> 4, scc = tid & 15;
    u32x4 kr[2], vr[2];
#define ATT_LOAD(kt) do { _Pragma("unroll") for (int j = 0; j < 2; ++j) { const size_t g_ = (rowbase + 64 * (kt) + srow + 32 * j) * 1024 + h * HD + scc * 8; \
        kr[j] = *(const u32x4*)(Kg + g_); vr[j] = *(const u32x4*)(Vg + g_); } } while (0)
#define ATT_WRITE(buf) do { _Pragma("unroll") for (int j = 0; j < 2; ++j) { \
        *(LAS u32x4*)(lds + OFF_K + (buf) * KBUF + (srow + 32 * j) * KST + scc * 16) = kr[j]; \
        *(LAS u32x4*)(lds + OFF_V + (buf) * VBUF + (srow + 32 * j) * VST + scc * 16) = vr[j]; } } while (0)
    ATT_LOAD(ktmax); ATT_WRITE(0); __syncthreads();
    int buf = 0;
    for (int kt = ktmax; kt >= 0; --kt) {
        if (kt > 0) ATT_LOAD(kt - 1);
        const bool started = (64 * kt <= t0 + 31);
        if (started && !wave_done) {
            const LAS unsigned char* Kl = lds + OFF_K + buf * KBUF; const LAS unsigned char* Vl = lds + OFF_V + buf * VBUF;
            f32x16 sacc[2];
            asm volatile("" : "+v"(qoff));
            bf16x8 qf[8];
#pragma unroll
            for (int s = 0; s < 8; ++s) qf[s] = *(const bf16x8*)(Q + qoff + 16 * s);
#pragma unroll
            for (int sub = 0; sub < 2; ++sub) {
#pragma unroll
                for (int r = 0; r < 16; ++r) sacc[sub][r] = 0.f;
#pragma unroll
                for (int s = 0; s < 8; ++s) { const bf16x8 kf = *(const LAS bf16x8*)(Kl + (32 * sub + c) * KST + (16 * s + 8 * hh) * 2);
                    sacc[sub] = __builtin_amdgcn_mfma_f32_32x32x16_bf16(kf, qf[s], sacc[sub], 0, 0, 0); }
            }
            const bool need_mask = (64 * kt + 63 >= t0);
            bool tile_dead = false;
            if (MIXER == 0) {
#pragma unroll
                for (int sub = 1; sub >= 0; --sub) {
                    float lb[16];
#pragma unroll
                    for (int r = 0; r < 16; ++r) { const float z = sacc[sub][r]; float l = -flog2(1.f + fexp2(z));
                        if (need_mask) { const int sidx = 64 * kt + 32 * sub + (r & 3) + 8 * (r >> 2) + 4 * hh; l = (sidx < tq) ? l : 0.f; }
                        lb[r] = l; }
                    float Glo[4], Ghi[4];
#pragma unroll
                    for (int g = 0; g < 4; ++g) { lb[4 * g + 2] += lb[4 * g + 3]; lb[4 * g + 1] += lb[4 * g + 2]; lb[4 * g] += lb[4 * g + 1];
                        const unsigned gu = __builtin_bit_cast(unsigned, lb[4 * g]); const auto rr = __builtin_amdgcn_permlane32_swap(gu, gu, false, false);
                        Glo[g] = __builtin_bit_cast(float, (unsigned)rr[0]); Ghi[g] = __builtin_bit_cast(float, (unsigned)rr[1]); }
                    float E[8];
                    E[7] = carry; E[6] = E[7] + Ghi[3]; E[5] = E[6] + Glo[3]; E[4] = E[5] + Ghi[2]; E[3] = E[4] + Glo[2]; E[2] = E[3] + Ghi[1]; E[1] = E[2] + Glo[1]; E[0] = E[1] + Ghi[0];
                    carry = E[0] + Glo[0];
#pragma unroll
                    for (int g = 0; g < 4; ++g) { const float Eo = __builtin_fmaf(nhf, Ghi[g], E[2 * g + 1]);
#pragma unroll
                        for (int i = 0; i < 4; ++i) { const int r = 4 * g + i; float w = fexp2(sacc[sub][r] + lb[r] + Eo);
                            if (need_mask) { const int sidx = 64 * kt + 32 * sub + (r & 3) + 8 * (r >> 2) + 4 * hh; w = (sidx < tq) ? w : 0.f; }
                            sacc[sub][r] = w; } }
                }
            } else {
                float mx = -1e30f;
#pragma unroll
                for (int sub = 0; sub < 2; ++sub)
#pragma unroll
                    for (int g = 0; g < 4; ++g) { const f32x4 fs = *(const LAS f32x4*)(F2 + 64 * kt + 32 * sub + 8 * g + 4 * hh);
#pragma unroll
                        for (int i = 0; i < 4; ++i) { const int r = 4 * g + i; float xv = sacc[sub][r] + (Ft - fs[i]);
                            if (need_mask) { const int sidx = 64 * kt + 32 * sub + 8 * g + 4 * hh + i; xv = (sidx <= tq) ? xv : -1e30f; }
                            sacc[sub][r] = xv; mx = fmaxf(mx, xv); } }
                { const unsigned mu = __builtin_bit_cast(unsigned, mx); const auto rr = __builtin_amdgcn_permlane32_swap(mu, mu, false, false);
                  mx = fmaxf(__builtin_bit_cast(float, (unsigned)rr[0]), __builtin_bit_cast(float, (unsigned)rr[1])); }
                tile_dead = __all(mx - mrun < -THR_FOX);
                if (!tile_dead) {
                const float mnew = fmaxf(mrun, mx);
                const float alpha = fexp2(mrun - mnew);
                float ps = 0.f;
#pragma unroll
                for (int sub = 0; sub < 2; ++sub)
#pragma unroll
                    for (int r = 0; r < 16; ++r) { const float p = fexp2(sacc[sub][r] - mnew); sacc[sub][r] = p; ps += p; }
                lsum = lsum * alpha + ps;
                if (__any(mnew > mrun)) {
#pragma unroll
                    for (int d = 0; d < 4; ++d)
#pragma unroll
                        for (int r = 0; r < 16; ++r) oacc[d][r] *= alpha;
                }
                mrun = mnew;
                }
            }
            if (!tile_dead)
#pragma unroll
            for (int ks = 0; ks < 4; ++ks) { const int sub = ks >> 1, rb = 8 * (ks & 1);
                u32x4 pw; pw.x = pk2(sacc[sub][rb + 0], sacc[sub][rb + 1]); pw.y = pk2(sacc[sub][rb + 2], sacc[sub][rb + 3]); pw.z = pk2(sacc[sub][rb + 4], sacc[sub][rb + 5]); pw.w = pk2(sacc[sub][rb + 6], sacc[sub][rb + 7]);
                const bf16x8 pf = __builtin_bit_cast(bf16x8, pw);
                const LAS unsigned char* vb = Vl + (16 * ks + 4 * hh + ((lane & 15) >> 2)) * VST + (16 * ((lane >> 4) & 1) + 4 * (lane & 3)) * 2;
#pragma unroll
                for (int d = 0; d < 4; ++d) {
                    const s16x4 a0 = __builtin_amdgcn_ds_read_tr16_b64_v4i16((LAS s16x4*)(vb + d * 64));
                    const s16x4 a1 = __builtin_amdgcn_ds_read_tr16_b64_v4i16((LAS s16x4*)(vb + d * 64 + 8 * VST));
                    const bf16x8 af = {a0[0], a0[1], a0[2], a0[3], a1[0], a1[1], a1[2], a1[3]};
                    oacc[d] = __builtin_amdgcn_mfma_f32_32x32x16_bf16(af, pf, oacc[d], 0, 0, 0); }
            }
        }
        if (kt > 0) ATT_WRITE(buf ^ 1);
        if (kt > 0 && started && !wave_done) {
            if (MIXER == 0) wave_done = __all(carry < -THR_SB);
            else wave_done = __all(qk_bound + (Ft - F2[64 * kt - 1]) - mrun < -THR_FOX);
        }
        if (lane == 0) flg[(kt & 1) * 8 + wid] = wave_done ? 1u : 0u;
        __syncthreads();
        buf ^= 1;
        { unsigned alld = 1u;
#pragma unroll
          for (int w = 0; w < 8; ++w) alld &= flg[(kt & 1) * 8 + w];
          if (alld) break; }
    }
#undef ATT_LOAD
#undef ATT_WRITE
    float inv = 1.f;
    if (MIXER == 1) { const unsigned lu = __builtin_bit_cast(unsigned, lsum); const auto rr = __builtin_amdgcn_permlane32_swap(lu, lu, false, false);
        inv = 1.f / (__builtin_bit_cast(float, (unsigned)rr[0]) + __builtin_bit_cast(float, (unsigned)rr[1])); }
    bf16_t* op = O + (rowbase + tq) * 2048 + 4 * hh;
#pragma unroll
    for (int d = 0; d < 4; ++d)
#pragma unroll
        for (int g = 0; g < 4; ++g) { u32x2 w; w.x = pk2(oacc[d][4 * g] * inv, oacc[d][4 * g + 1] * inv); w.y = pk2(oacc[d][4 * g + 2] * inv, oacc[d][4 * g + 3] * inv);
            *(u32x2*)(op + 32 * d + 8 * g) = w; }
}

__device__ __forceinline__ void attn_phase(const Params& P, LAS unsigned char* lds, int vcu, int G) {
    const int tid = threadIdx.x, lane = tid & 63, wid = __builtin_amdgcn_readfirstlane(tid >> 6);
    unsigned char* ws = P.ws;
    const bf16_t* QKV = (const bf16_t*)(ws + WS_QKV); const size_t TS = (size_t)T_TOK * 1024;
    bf16_t* OAB = (bf16_t*)(ws + WS_H); const float* LOGF = (const float*)(ws + WS_LOGF);
    unsigned* qctr = (unsigned*)(ws + WS_CTL + 196608);
    const unsigned* KMAXW = (const unsigned*)(ws + WS_CTL + 200704);
    volatile LAS unsigned* uw = (volatile LAS unsigned*)(lds + OFF_UNIT);
    for (;;) {
        if (tid == 0) uw[0] = atomicAdd(qctr, 1u);
        __syncthreads();
        const unsigned u = uw[0];
        __syncthreads();
        if (u >= 1024u) break;
        if (u >= 512u) { quantise_expert_rows(P, (int)(u - 512u) * 64 + wid * 8, 8); continue; }
        const int mixer = (u < 256u) ? 1 : 0, v = (int)(u & 255u), qb = 15 - (v >> 4), bh = v & 15, b = bh >> 3, h = bh & 7;
        if (mixer == 0) {
            attn_unit<0>(lds, QKV, QKV + TS, QKV + 2 * TS, OAB + h * HD, b, h, qb, 0.f, tid, lane, wid);
        } else {
            float k2 = 0.f;
#pragma unroll
            for (int w = 0; w < 4; ++w) k2 += __builtin_bit_cast(float, __hip_atomic_load(KMAXW + bh * 4 + w, __ATOMIC_RELAXED, __HIP_MEMORY_SCOPE_AGENT));
            const float kmax = sqrtf(k2) * 1.01f;
            build_cumf(lds, LOGF, b, h, 256 * (qb + 1), tid, lane, wid);
            attn_unit<1>(lds, QKV + 3 * TS, QKV + 4 * TS, QKV + 5 * TS, OAB + 1024 + h * HD, b, h, qb, kmax, tid, lane, wid);
        }
        __syncthreads();
    }
}
}

namespace peer {
__device__ __forceinline__ unsigned sortable(float f) { const unsigned u = __builtin_bit_cast(unsigned, f); return (u & 0x80000000u) ? ~u : (u | 0x80000000u); }
__device__ __forceinline__ float unsortable(unsigned k) { const unsigned u = (k & 0x80000000u) ? (k & 0x7fffffffu) : ~k; return __builtin_bit_cast(float, u); }
#define CE_DESC(x, y) do { const unsigned hi_ = (x) > (y) ? (x) : (y); const unsigned lo_ = (x) > (y) ? (y) : (x); (x) = hi_; (y) = lo_; } while (0)
template <int B, int N> __device__ __forceinline__ void sort16_desc(unsigned (&a)[N]) {
#pragma unroll
    for (int k = 2; k <= 16; k <<= 1)
#pragma unroll
        for (int j = k >> 1; j > 0; j >>= 1)
#pragma unroll
            for (int i = 0; i < 16; ++i) { const int l = i ^ j; if (l > i) { if ((i & k) == 0) CE_DESC(a[B + i], a[B + l]); else CE_DESC(a[B + l], a[B + i]); } }
}
template <int A, int Bq, int N> __device__ __forceinline__ void merge_top16(unsigned (&a)[N]) {
#pragma unroll
    for (int i = 0; i < 16; ++i) { const unsigned x = a[A + i], y = a[Bq + 15 - i]; a[A + i] = x > y ? x : y; }
#pragma unroll
    for (int j = 8; j > 0; j >>= 1)
#pragma unroll
        for (int i = 0; i < 16; ++i) { const int l = i ^ j; if (l > i) CE_DESC(a[A + i], a[A + l]); }
}

__device__ __forceinline__ void topk_phase(const Params& P, LAS unsigned char* lds, int vcu, int G) {
    const int tid = threadIdx.x, lane = tid & 63, wave = __builtin_amdgcn_readfirstlane(tid >> 6);
    const int c = lane & 31, hh = lane >> 5;
    const int gw = vcu * NWAVES + wave, NGW = G * NWAVES;
    unsigned char* ws = P.ws;
    const bf16_t* Q2 = (const bf16_t*)(ws + WS_Q2); const bf16_t* SKB = (const bf16_t*)(ws + WS_SKB);
    const float* ROWSS = (const float*)(ws + WS_CTL); int* IDS = (int*)(ws + WS_IDS); float* GATES = (float*)(ws + WS_GATES);
    LAS unsigned char* scr = lds + wave * 4096;
    for (int task = gw; task < 2048; task += NGW) {
        const int tg = task >> 3, hd = task & 7, tok = tg * 32 + c;
#pragma unroll 1
        for (int p = 0; p < 2; ++p) {
            bf16x8 qf[8];
            { const bf16_t* qp = Q2 + (size_t)tok * DM + hd * 256 + p * 128 + 8 * hh;
#pragma unroll
              for (int s = 0; s < 8; ++s) qf[s] = *(const bf16x8*)(qp + 16 * s); }
            unsigned keys[64];
#pragma unroll
            for (int sub = 0; sub < 4; ++sub) {
                f32x16 acc;
#pragma unroll
                for (int r = 0; r < 16; ++r) acc[r] = 0.f;
                const bf16_t* kp = SKB + ((size_t)(hd * 2 + p) * 128 + 32 * sub + c) * 128 + 8 * hh;
#pragma unroll
                for (int s = 0; s < 8; ++s) { const bf16x8 kf = *(const bf16x8*)(kp + 16 * s); acc = __builtin_amdgcn_mfma_f32_32x32x16_bf16(kf, qf[s], acc, 0, 0, 0); }
#pragma unroll
                for (int r = 0; r < 16; ++r) { const int nlo = 127 - (32 * sub + (r & 3) + 8 * (r >> 2)); keys[sub * 16 + r] = (sortable(acc[r]) & ~127u) | (unsigned)(nlo - 4 * hh); }
            }
            sort16_desc<0>(keys); sort16_desc<16>(keys); sort16_desc<32>(keys); sort16_desc<48>(keys);
            merge_top16<0, 16>(keys); merge_top16<32, 48>(keys); merge_top16<0, 32>(keys);
#pragma unroll
            for (int i = 0; i < 16; ++i) { const unsigned own = keys[i]; const auto rr = __builtin_amdgcn_permlane32_swap(own, own, false, false); keys[16 + i] = hh ? (unsigned)rr[0] : (unsigned)rr[1]; }
            merge_top16<0, 16>(keys);
            if (hh == 0) {
#pragma unroll
                for (int w = 0; w < 4; ++w) *(LAS u32x4*)(scr + (c * 2 + p) * 64 + w * 16) = (u32x4){keys[4 * w], keys[4 * w + 1], keys[4 * w + 2], keys[4 * w + 3]};
            }
        }
        LDS_WAIT();
        float s1[16], s2[16];
#pragma unroll
        for (int w = 0; w < 4; ++w) { const u32x4 a = *(const LAS u32x4*)(scr + (c * 2) * 64 + w * 16), b2 = *(const LAS u32x4*)(scr + (c * 2 + 1) * 64 + w * 16);
#pragma unroll
            for (int e = 0; e < 4; ++e) { s1[4 * w + e] = unsortable((a[e] & ~127u) | 64u); s2[4 * w + e] = unsortable((b2[e] & ~127u) | 64u); } }
        unsigned ck[64];
        { int n = 0;
#pragma unroll
          for (int i = 0; i < 16; ++i)
#pragma unroll
              for (int j = 0; j < 16; ++j) if ((i + 1) * (j + 1) <= 16) { ck[n] = (sortable(s1[i] + s2[j]) & ~255u) | (unsigned)(255 - (i * 16 + j)); ++n; }
#pragma unroll
          for (int q = 50; q < 64; ++q) ck[q] = 0u; }
        sort16_desc<0>(ck); sort16_desc<16>(ck); sort16_desc<32>(ck); sort16_desc<48>(ck);
        merge_top16<0, 16>(ck); merge_top16<32, 48>(ck); merge_top16<0, 32>(ck);
        unsigned t2[16];
#pragma unroll
        for (int k = 0; k < 16; ++k) t2[k] = ck[k];
        int ids[16]; float sc[16];
#pragma unroll
        for (int k = 0; k < 16; ++k) { const unsigned pos = 255u - (t2[k] & 255u);
            const unsigned k1 = *(const LAS unsigned*)(scr + (c * 2) * 64 + (pos >> 4) * 4), k2 = *(const LAS unsigned*)(scr + (c * 2 + 1) * 64 + (pos & 15u) * 4);
            ids[k] = (int)((127u - (k1 & 127u)) * 128u + (127u - (k2 & 127u))); sc[k] = unsortable((t2[k] & ~255u) | 128u); }
        LDS_WAIT();
        const float rs = 1.0f / sqrtf(ROWSS[tok] * (1.f / DM) + EPS);
        float ev[16], Z = 0.f;
#pragma unroll
        for (int k = 0; k < 16; ++k) { ev[k] = fexp2((sc[k] - sc[0]) * rs * LOG2E); Z += ev[k]; }
        const float iz = 1.f / Z;
        int* ip = IDS + (size_t)tok * 128 + hd * 16; float* gp = GATES + (size_t)tok * 128 + hd * 16;
        if (hh == 0) {
#pragma unroll
            for (int k = 0; k < 8; ++k) { ip[k] = ids[k]; gp[k] = ev[k] * iz; }
        } else {
#pragma unroll
            for (int k = 8; k < 16; ++k) { ip[k] = ids[k]; gp[k] = ev[k] * iz; }
        }
    }
}


__device__ __forceinline__ float dot8(u32x4 a, u32x4 b, float acc) {
    const unsigned a0 = a[0], a1 = a[1], a2 = a[2], a3 = a[3], b0 = b[0], b1 = b[1], b2 = b[2], b3 = b[3];
    acc = __builtin_amdgcn_fdot2_f32_bf16(__builtin_bit_cast(bf16v2, a0), __builtin_bit_cast(bf16v2, b0), acc, false);
    acc = __builtin_amdgcn_fdot2_f32_bf16(__builtin_bit_cast(bf16v2, a1), __builtin_bit_cast(bf16v2, b1), acc, false);
    acc = __builtin_amdgcn_fdot2_f32_bf16(__builtin_bit_cast(bf16v2, a2), __builtin_bit_cast(bf16v2, b2), acc, false);
    acc = __builtin_amdgcn_fdot2_f32_bf16(__builtin_bit_cast(bf16v2, a3), __builtin_bit_cast(bf16v2, b3), acc, false);
    return acc;
}
__device__ __forceinline__ float gelu_tanh(float a) { const float t = 1.5957691216f * (a + 0.044715f * a * a * a); return a * frcp(1.f + fexp2(-LOG2E * t)); }

__device__ __forceinline__ int dot16(u32x4 a, u32x4 b, int acc) {
    acc = __builtin_amdgcn_sdot4((int)a[0], (int)b[0], acc, false); acc = __builtin_amdgcn_sdot4((int)a[1], (int)b[1], acc, false);
    acc = __builtin_amdgcn_sdot4((int)a[2], (int)b[2], acc, false); acc = __builtin_amdgcn_sdot4((int)a[3], (int)b[3], acc, false);
    return acc;
}
__device__ __forceinline__ void gather_sweep(const Params& P, LAS unsigned char* lds, int vcu, int G) {
    const int tid = threadIdx.x, lane = tid & 63, wave = __builtin_amdgcn_readfirstlane(tid >> 6);
    const int gw = vcu * NWAVES + wave, NGW = G * NWAVES;
    const int g = lane >> 3, i = lane & 7;
    unsigned char* ws = P.ws;
    const bf16_t* X1B = (const bf16_t*)(ws + WS_X1B); const float* ROWSS = (const float*)(ws + WS_CTL);
    const int* IDS = (const int*)(ws + WS_IDS); const float* GATES = (const float*)(ws + WS_GATES);
    const unsigned char* EU = ws + WS_EU; const unsigned char* EV = ws + WS_EV;
    const float* SU = (const float*)(ws + WS_SU); const float* SV = (const float*)(ws + WS_SV);
    LAS unsigned char* wl = lds + wave * 16384;
    const bool b2 = (lane >> 2) & 1, b1 = (lane >> 1) & 1, b0 = lane & 1, B2 = (lane >> 5) & 1, B1 = (lane >> 4) & 1, B0 = (lane >> 3) & 1;
    for (int tg = gw; tg < T_TOK / 4; tg += NGW) {
        const int tok0 = tg * 4;
        float hs[4];
#pragma unroll
        for (int j = 0; j < 4; ++j) { const int tok = tok0 + j;
            const float rs = 1.0f / sqrtf(ROWSS[tok] * (1.f / DM) + EPS);
            f32x4 hv[8]; float hmx = 0.f;
#pragma unroll
            for (int q = 0; q < 8; ++q) { const u32x2 xb = *((const u32x2*)(X1B + (size_t)tok * DM) + lane + 64 * q); const f32x4 xv = {bf_lo(xb[0]), bf_hi(xb[0]), bf_lo(xb[1]), bf_hi(xb[1])}; const f32x4 gn = *((const f32x4*)P.g_ffn + lane + 64 * q);
                hv[q] = xv * rs * gn; hmx = fmaxf(hmx, fmaxf(fmaxf(fabsf(hv[q][0]), fabsf(hv[q][1])), fmaxf(fabsf(hv[q][2]), fabsf(hv[q][3])))); }
#pragma unroll
            for (int o = 1; o < 64; o <<= 1) hmx = fmaxf(hmx, __shfl_xor(hmx, o));
            hmx = fmaxf(hmx, 1e-30f); const float hinv = 127.f / hmx; hs[j] = hmx * (1.f / 127.f);
#pragma unroll
            for (int q = 0; q < 8; ++q) { unsigned w = 0;
#pragma unroll
                for (int e = 0; e < 4; ++e) w |= ((unsigned)(int)__builtin_rintf(hv[q][e] * hinv) & 255u) << (8 * e);
                *(LAS unsigned*)(wl + j * 2048 + 4 * (lane + 64 * q)) = w; }
#pragma unroll
            for (int hf = 0; hf < 2; ++hf) { const int k = lane + 64 * hf; const int id = IDS[(size_t)tok * 128 + k];
                *(LAS unsigned*)(wl + 8192 + (j * 128 + k) * 4) = (unsigned)id * 2048u;
                *(LAS float*)(wl + 10240 + (j * 128 + k) * 4) = GATES[(size_t)tok * 128 + k] * SV[id];
                *(LAS float*)(wl + 12288 + (j * 128 + k) * 4) = SU[id]; }
        }
        LDS_WAIT();
        int accu[4][16];
#pragma unroll
        for (int j = 0; j < 4; ++j)
#pragma unroll
            for (int m = 0; m < 16; ++m) accu[j][m] = 0;
#pragma unroll 1
        for (int sl = 0; sl < 16; ++sl) {
            __syncthreads();
            const unsigned char* ub = EU + 128 * sl + 16 * i;
#pragma unroll
            for (int j = 0; j < 4; ++j) {
                const u32x4 hqc = *(const LAS u32x4*)(wl + j * 2048 + 128 * sl + 16 * i);
                u32x4 d[16];
#pragma unroll
                for (int m = 0; m < 16; ++m) { const unsigned off = *(const LAS unsigned*)(wl + 8192 + (j * 128 + 8 * m + g) * 4); d[m] = *(const u32x4*)(ub + off); }
#pragma unroll
                for (int m = 0; m < 16; ++m) accu[j][m] = dot16(d[m], hqc, accu[j][m]);
                __builtin_amdgcn_sched_barrier(0);
            }
        }
        float sw[4];
#pragma unroll
        for (int j = 0; j < 4; ++j) {
            int r1[8], r2[4], r3[2];
#pragma unroll
            for (int m = 0; m < 8; ++m) { const int send = b2 ? accu[j][m] : accu[j][m + 8], keep = b2 ? accu[j][m + 8] : accu[j][m]; r1[m] = keep + __shfl_xor(send, 4); }
#pragma unroll
            for (int m = 0; m < 4; ++m) { const int send = b1 ? r1[m] : r1[m + 4], keep = b1 ? r1[m + 4] : r1[m]; r2[m] = keep + __shfl_xor(send, 2); }
#pragma unroll
            for (int m = 0; m < 2; ++m) { const int send = b0 ? r2[m] : r2[m + 2], keep = b0 ? r2[m + 2] : r2[m]; r3[m] = keep + __shfl_xor(send, 1); }
            float w2[2], wmx = 0.f;
#pragma unroll
            for (int m = 0; m < 2; ++m) { const int k = 16 * i + 8 * m + g;
                const float act = (float)r3[m] * (hs[j] * *(const LAS float*)(wl + 12288 + (j * 128 + k) * 4));
                w2[m] = *(const LAS float*)(wl + 10240 + (j * 128 + k) * 4) * gelu_tanh(act); wmx = fmaxf(wmx, fabsf(w2[m])); }
#pragma unroll
            for (int o = 1; o < 64; o <<= 1) wmx = fmaxf(wmx, __shfl_xor(wmx, o));
            wmx = fmaxf(wmx, 1e-30f); sw[j] = wmx * (1.f / 127.f);
            const float winv = 127.f / wmx;
            const unsigned q0 = (unsigned)(int)__builtin_rintf(w2[0] * winv) & 255u, q1 = (unsigned)(int)__builtin_rintf(w2[1] * winv) & 255u;
            *(LAS unsigned short*)(wl + 14336 + j * 128 + 16 * g + 2 * i) = (unsigned short)(q0 | (q1 << 8));
        }
        LDS_WAIT();
        float ssq[4] = {0.f, 0.f, 0.f, 0.f};
#pragma unroll 1
        for (int sl = 0; sl < 16; ++sl) {
            const unsigned char* vb = EV + 128 * sl + 16 * i;
#pragma unroll
            for (int j = 0; j < 4; ++j) {
                u32x4 d[16];
#pragma unroll
                for (int m = 0; m < 16; ++m) { const unsigned off = *(const LAS unsigned*)(wl + 8192 + (j * 128 + 8 * m + g) * 4); d[m] = *(const u32x4*)(vb + off); }
                const u32x4 wpk = *(const LAS u32x4*)(wl + 14336 + j * 128 + 16 * g);
                int ca[16];
#pragma unroll
                for (int b = 0; b < 16; ++b) ca[b] = 0;
#pragma unroll
                for (int mg = 0; mg < 4; ++mg)
#pragma unroll
                    for (int c4 = 0; c4 < 4; ++c4) { const unsigned r0 = d[4 * mg][c4], r1 = d[4 * mg + 1][c4], r2 = d[4 * mg + 2][c4], r3 = d[4 * mg + 3][c4];
                        const unsigned t0 = __builtin_amdgcn_perm(r1, r0, 0x05010400u), t1 = __builtin_amdgcn_perm(r1, r0, 0x07030602u);
                        const unsigned t2 = __builtin_amdgcn_perm(r3, r2, 0x05010400u), t3 = __builtin_amdgcn_perm(r3, r2, 0x07030602u);
                        const int wq4 = (int)wpk[mg];
                        ca[4 * c4 + 0] = __builtin_amdgcn_sdot4((int)__builtin_amdgcn_perm(t2, t0, 0x05040100u), wq4, ca[4 * c4 + 0], false);
                        ca[4 * c4 + 1] = __builtin_amdgcn_sdot4((int)__builtin_amdgcn_perm(t2, t0, 0x07060302u), wq4, ca[4 * c4 + 1], false);
                        ca[4 * c4 + 2] = __builtin_amdgcn_sdot4((int)__builtin_amdgcn_perm(t3, t1, 0x05040100u), wq4, ca[4 * c4 + 2], false);
                        ca[4 * c4 + 3] = __builtin_amdgcn_sdot4((int)__builtin_amdgcn_perm(t3, t1, 0x07060302u), wq4, ca[4 * c4 + 3], false); }
                int c1[8], c2[4], c3[2];
#pragma unroll
                for (int b = 0; b < 8; ++b) { const int send = B2 ? ca[b] : ca[b + 8], keep = B2 ? ca[b + 8] : ca[b]; c1[b] = keep + __shfl_xor(send, 32); }
#pragma unroll
                for (int b = 0; b < 4; ++b) { const int send = B1 ? c1[b] : c1[b + 4], keep = B1 ? c1[b + 4] : c1[b]; c2[b] = keep + __shfl_xor(send, 16); }
#pragma unroll
                for (int b = 0; b < 2; ++b) { const int send = B0 ? c2[b] : c2[b + 2], keep = B0 ? c2[b + 2] : c2[b]; c3[b] = keep + __shfl_xor(send, 8); }
                const size_t o = (size_t)(tok0 + j) * DM + 128 * sl + 16 * i + 2 * g;
                const unsigned xb = *(const unsigned*)(X1B + o); const f32x2 xv = {bf_lo(xb), bf_hi(xb)};
                const f32x2 x2 = {xv[0] + sw[j] * (float)c3[0], xv[1] + sw[j] * (float)c3[1]};
                ssq[j] += x2[0] * x2[0] + x2[1] * x2[1];
                *(f32x2*)(P.out + o) = x2;
                __builtin_amdgcn_sched_barrier(0);
            }
        }
#pragma unroll
        for (int j = 0; j < 4; ++j) { const float rs2 = 1.0f / sqrtf(wave_sum(ssq[j]) * (1.f / DM) + EPS);
            f32x4* orow = (f32x4*)(P.out + (size_t)(tok0 + j) * DM) + lane;
#pragma unroll
            for (int q = 0; q < 8; ++q) { const f32x4 gn = *((const f32x4*)P.g_final + lane + 64 * q); orow[64 * q] = orow[64 * q] * rs2 * gn; } }
        LDS_WAIT();
    }
}

}


#define XB_TMO      128
#define XB_XCNT(j)  (256  + 64 * (j))
#define XB_XSUB(j)  (1280 + 64 * (j))
#define XB_XGEN(j)  (2304 + 64 * (j))
#define XB_TOP      3328
#define XB_TOPGEN   3392
#define XCD_BAR_WORDS 3456
#define XB_SPIN_CAP (1u << 18)
__device__ __forceinline__ unsigned xb_ld(unsigned* p)              { return __hip_atomic_load(p, __ATOMIC_RELAXED, __HIP_MEMORY_SCOPE_AGENT); }
__device__ __forceinline__ unsigned xb_add(unsigned* p, unsigned v) { return __hip_atomic_fetch_add(p, v, __ATOMIC_RELAXED, __HIP_MEMORY_SCOPE_AGENT); }
__device__ __forceinline__ unsigned xb_xcc_id() { return (unsigned)__builtin_amdgcn_s_getreg((3 << 11) | 20) & 0xFu; }
#define XB_SPIN(cond, bar) do { unsigned _sp = 0; while (cond) { __builtin_amdgcn_s_sleep(1); \
    if ((++_sp & 255u) == 0u) { if (xb_ld(&(bar)[XB_TMO])) break; if (_sp > XB_SPIN_CAP) { atomicAdd(&(bar)[XB_TMO], 1u); break; } } } } while (0)
struct XcdBarrier { unsigned* bar; unsigned x; volatile LAS unsigned* st; };
__device__ __forceinline__ XcdBarrier xcd_barrier_post(unsigned* bar, volatile LAS unsigned* st) {
    XcdBarrier b; b.bar = bar; b.x = xb_xcc_id(); b.st = st;
    if (threadIdx.x == 0) (void)xb_add(&bar[XB_XCNT(b.x)], 1u);
    return b;
}
__device__ __forceinline__ void xcd_barrier_complete(unsigned* bar, unsigned x, unsigned& nloc, unsigned& nx) {
    const unsigned G = gridDim.x * gridDim.y * gridDim.z;
    unsigned sum, cnt, mine, sp = 0u;
    for (;;) {
        sum = 0u; cnt = 0u; mine = 0u;
#pragma unroll
        for (unsigned j = 0; j < 16; ++j) { const unsigned c = xb_ld(&bar[XB_XCNT(j)]); sum += c; cnt += (c > 0u) ? 1u : 0u; mine = (j == x) ? c : mine; }
        if (sum == G) break;
        __builtin_amdgcn_s_sleep(1);
        if ((++sp & 255u) == 0u) { if (xb_ld(&bar[XB_TMO])) break; if (sp > XB_SPIN_CAP) { atomicAdd(&bar[XB_TMO], 1u); break; } }
    }
    nloc = mine > 0u ? mine : 1u; nx = cnt > 0u ? cnt : 1u;
}
__device__ __forceinline__ void xcd_barrier(const XcdBarrier& b) {
    asm volatile("s_waitcnt vmcnt(0)" ::: "memory");
    __syncthreads();
    if (threadIdx.x == 0) {
        unsigned* bar = b.bar;
        __builtin_amdgcn_s_waitcnt(0);
        unsigned nloc = b.st[0], nx = b.st[1];
        if (nloc == 0u) { xcd_barrier_complete(bar, b.x, nloc, nx); b.st[0] = nloc; b.st[1] = nx; }
        const unsigned old = xb_add(&bar[XB_XSUB(b.x)], 1u);
        const unsigned gen = old / nloc;
        if (old + 1u == (gen + 1u) * nloc) {
            __builtin_amdgcn_fence(__ATOMIC_RELEASE, "agent");
            asm volatile("s_waitcnt vmcnt(0)" ::: "memory");
            const unsigned og = xb_add(&bar[XB_TOP], 1u);
            const unsigned tg = og / nx;
            if (og + 1u == (tg + 1u) * nx) xb_add(&bar[XB_TOPGEN], 1u);
            else XB_SPIN(xb_ld(&bar[XB_TOPGEN]) == tg, bar);
            __builtin_amdgcn_fence(__ATOMIC_ACQUIRE, "agent");
            xb_add(&bar[XB_XGEN(b.x)], 1u);
            asm volatile("s_waitcnt vmcnt(0)" ::: "memory");
        } else {
            XB_SPIN(xb_ld(&bar[XB_XGEN(b.x)]) == gen, bar);
            __builtin_amdgcn_fence(__ATOMIC_ACQUIRE, "agent");
            asm volatile("s_waitcnt vmcnt(0)" ::: "memory");
        }
    }
    __syncthreads();
}

__global__ void __launch_bounds__(NTHR, 2) mega_fwd(Params P) {
    extern __shared__ __attribute__((aligned(16))) unsigned char lds_raw[];
    LAS unsigned char* lds = (LAS unsigned char*)lds_raw;
    cg::grid_group grid = cg::this_grid();
    const int G = gridDim.x, bx = blockIdx.x;
    const int vcu = (G % 8 == 0) ? (bx % 8) * (G / 8) + bx / 8 : bx;
    unsigned char* ws = P.ws;
#ifndef ONLY_PHASE
#define ONLY_PHASE -1
#endif
#define IN(k) ((ONLY_PHASE < 0 || ONLY_PHASE == (k)) && P.ph_lo <= (k) && (k) < P.ph_hi)
    volatile LAS unsigned* bst = (volatile LAS unsigned*)(lds + 131072);
    if (threadIdx.x < 16) bst[threadIdx.x] = 0u;
    __syncthreads();
    const XcdBarrier xbar = xcd_barrier_post((unsigned*)(ws + WS_CTL + 131072), bst);
    if (P.ph_lo < 0) grid.sync();
#define SEAM(k) do { if (IN(k) && IN((k) + 1)) xcd_barrier(xbar); } while (0)
    if (IN(0)) { p0a(P, lds, vcu, G); xcd_barrier(xbar); p0b(P, lds, vcu, G); }
    SEAM(0);
    if (IN(1)) {
        pg8::Gemm g{ws + WS_H, ws + WS_WIN, T_TOK, 10240, 2048, 2048, 2048};
        pg8::StaticOrder S; S.init(T_TOK, 10240, G, bx);
        pg8::EpiProj E{(bf16_t*)(ws + WS_QKV), (bf16_t*)(ws + WS_SG), LOG2E * 0.08838834764831845f, (unsigned*)(ws + WS_CTL + 200704), (const float*)(ws + WS_HSC), (const float*)(ws + WS_WSC)};
        pg8::gemm_phase<pg8::EpiProj, true>(lds, g, S, E);
    }
    SEAM(1);
    if (IN(2)) { att::attn_phase(P, lds, vcu, G); __syncthreads(); late_transposes(P, lds, vcu, G); }
    SEAM(2);
    if (IN(3)) {
        pg8::StaticOrder S; S.init(T_TOK, DM, G, bx);
        { pg8::Gemm g{ws + WS_H, ws + WS_WAT, T_TOK, DM, 1024, 4096, 2048};
          pg8::EpiGate<0> E{(const bf16_t*)(ws + WS_SG), (bf16_t*)(ws + WS_TMP), (bf16_t*)(ws + WS_MERGED)};
          pg8::gemm_phase(lds, g, S, E); }
        { pg8::Gemm g{ws + WS_H + 2048, ws + WS_WBT, T_TOK, DM, 1024, 4096, 2048};
          pg8::EpiGate<1> E{(const bf16_t*)(ws + WS_SG) + 2048, (bf16_t*)(ws + WS_TMP), (bf16_t*)(ws + WS_MERGED)};
          pg8::gemm_phase(lds, g, S, E); }
    }
    SEAM(3);
    if (IN(4)) {
        pg8::Gemm g{ws + WS_MERGED, ws + WS_WOUT, T_TOK, DM, 2048, 4096, 4096};
        pg8::StaticOrder S; S.init(T_TOK, DM, G, bx);
        pg8::EpiResid E{P.x, (float*)(ws + WS_X1), (bf16_t*)(ws + WS_X1B), (float*)(ws + WS_CTL)};
        pg8::gemm_phase(lds, g, S, E);
    }
    SEAM(4);
    if (IN(5)) {
        pg8::Gemm g{ws + WS_X1B, ws + WS_WQ, T_TOK, DM, 2048, 4096, 4096};
        pg8::StaticOrder S; S.init(T_TOK, DM, G, bx);
        pg8::EpiPlainBf16 E{(bf16_t*)(ws + WS_Q2)};
        pg8::gemm_phase(lds, g, S, E);
    }
    SEAM(5);
    if (IN(6)) peer::topk_phase(P, lds, vcu, G);
    SEAM(6);
    if (IN(7)) { peer::gather_sweep(P, lds, vcu, G); }
#undef IN
#undef SEAM
}

extern "C" void kernel_launch(void* const* d_in, const int* in_sizes, int n_in, void* d_out, int out_size, void* d_ws, size_t ws_size, hipStream_t stream) {
    static int grid = 0;
    if (grid == 0) {
        if (n_in != 13 || out_size != T_TOK * DM || ws_size < WS_END) { fprintf(stderr, "kernel_launch: unexpected shapes (n_in %d out %d ws %zu)\n", n_in, out_size, ws_size); grid = -1; return; }
        int dev = 0, cus = 0, per_cu = 0;
        if (hipGetDevice(&dev) != hipSuccess || hipDeviceGetAttribute(&cus, hipDeviceAttributeMultiprocessorCount, dev) != hipSuccess) { grid = -1; return; }
        if (hipFuncSetAttribute((const void*)mega_fwd, hipFuncAttributeMaxDynamicSharedMemorySize, LDS_BYTES) != hipSuccess) { fprintf(stderr, "kernel_launch: hipFuncSetAttribute failed\n"); grid = -1; return; }
        if (hipOccupancyMaxActiveBlocksPerMultiprocessor(&per_cu, (const void*)mega_fwd, NTHR, LDS_BYTES) != hipSuccess || per_cu < 1) { fprintf(stderr, "kernel_launch: occupancy query says %d\n", per_cu); grid = -1; return; }
        grid = cus;
    }
    if (grid < 0) return;
    (void)hipMemsetAsync((char*)d_ws + WS_CTL, 0, 1 * MiB, stream);
    Params p{};
    p.x = (const float*)d_in[0]; p.g_mix = (const float*)d_in[1]; p.w_in = (const float*)d_in[2]; p.b_forget = (const float*)d_in[3];
    p.w_a = (const float*)d_in[4]; p.w_b = (const float*)d_in[5]; p.w_out = (const float*)d_in[6]; p.g_ffn = (const float*)d_in[7];
    p.w_query = (const float*)d_in[8]; p.sub_keys = (const float*)d_in[9]; p.e_u = (const float*)d_in[10]; p.e_v = (const float*)d_in[11]; p.g_final = (const float*)d_in[12];
    p.out = (float*)d_out; p.ws = (unsigned char*)d_ws;
#if MK_N_LAUNCHES == 1
    p.ph_lo = 0; p.ph_hi = N_PHASES;
    void* args[] = {&p};
    hipError_t e = hipLaunchCooperativeKernel((const void*)mega_fwd, dim3(grid), dim3(NTHR), args, LDS_BYTES, stream);
    if (e != hipSuccess) fprintf(stderr, "kernel_launch: cooperative launch failed: %s (grid %d)\n", hipGetErrorString(e), grid);
#else
    for (int ph = 0; ph < N_PHASES; ++ph) { p.ph_lo = ph; p.ph_hi = ph + 1; hipLaunchKernelGGL(mega_fwd, dim3(grid), dim3(NTHR), LDS_BYTES, stream, p); }
#endif
}
```

```cpp
#include <hip/hip_runtime.h>
#include <hip/hip_cooperative_groups.h>
#include <cstdio>
#include <cstdint>
namespace cg = cooperative_groups;

#define LAS __attribute__((address_space(3)))
typedef unsigned short bf16_t;
typedef short bf16x8 __attribute__((ext_vector_type(8)));
typedef short s16x4 __attribute__((ext_vector_type(4)));
typedef float f32x2 __attribute__((ext_vector_type(2)));
typedef float f32x4 __attribute__((ext_vector_type(4)));
typedef float f32x16 __attribute__((ext_vector_type(16)));
typedef unsigned u32x2 __attribute__((ext_vector_type(2)));
typedef unsigned u32x4 __attribute__((ext_vector_type(4)));
typedef __bf16 bf16v2 __attribute__((ext_vector_type(2)));
typedef int i32x4 __attribute__((ext_vector_type(4)));

#ifndef MK_N_LAUNCHES
#define MK_N_LAUNCHES 1
#endif

constexpr int T_TOK = 8192, DM = 2048, SEQ = 4096, HD = 128;
constexpr int NWAVES = 8, NTHR = 512;
constexpr int LDS_BYTES = 147456;
constexpr float LOG2E = 1.4426950408889634f;
constexpr float EPS = 1e-6f;
constexpr int N_PHASES = 8;

constexpr size_t MiB = 1u << 20;
constexpr size_t WS_CTL = 0;
constexpr size_t WS_LOGF = 1 * MiB;
constexpr size_t WS_SKB = 1 * MiB + 512 * 1024;
constexpr size_t WS_HSC = 1 * MiB + 256 * 1024;
constexpr size_t WS_WSC = 1 * MiB + 320 * 1024;
constexpr size_t CTL_CMAX = 262144;
constexpr size_t WS_IDS = 2 * MiB;
constexpr size_t WS_GATES = 6 * MiB;
constexpr size_t WS_WAT = 10 * MiB, WS_WBT = 14 * MiB, WS_WOUT = 18 * MiB, WS_WQ = 26 * MiB, WS_WIN = 34 * MiB;
constexpr size_t WS_H = 74 * MiB;
constexpr size_t WS_QKV = 106 * MiB;
constexpr size_t WS_TMP = 106 * MiB, WS_MERGED = 170 * MiB, WS_Q2 = 106 * MiB;
constexpr size_t WS_SG = 202 * MiB;
constexpr size_t WS_X1B = 202 * MiB;
constexpr size_t WS_X1 = 266 * MiB;
constexpr size_t WS_EU = 330 * MiB, WS_EV = 362 * MiB;
constexpr size_t WS_SU = 394 * MiB, WS_SV = 394 * MiB + 65536;
constexpr size_t WS_END = 395 * MiB;

struct Params {
    const float* x; const float* g_mix; const float* w_in; const float* b_forget; const float* w_a; const float* w_b; const float* w_out;
    const float* g_ffn; const float* w_query; const float* sub_keys; const float* e_u; const float* e_v; const float* g_final;
    float* out; unsigned char* ws; int ph_lo, ph_hi;
};

__device__ __forceinline__ unsigned pk2(float a, float b) { f32x2 v = {a, b}; return __builtin_bit_cast(unsigned, __builtin_convertvector(v, bf16v2)); }
__device__ __forceinline__ float bf_lo(unsigned u) { return __builtin_bit_cast(float, u << 16); }
__device__ __forceinline__ float bf_hi(unsigned u) { return __builtin_bit_cast(float, u & 0xffff0000u); }
__device__ __forceinline__ float fexp2(float x) { return __builtin_amdgcn_exp2f(x); }
__device__ __forceinline__ float flog2(float x) { return __builtin_amdgcn_logf(x); }
__device__ __forceinline__ float frcp(float x) { return __builtin_amdgcn_rcpf(x); }
__device__ __forceinline__ float wave_sum(float v) {
#pragma unroll
    for (int o = 1; o < 64; o <<= 1) v += __shfl_xor(v, o);
    return v;
}
#define LDS_WAIT() asm volatile("s_waitcnt lgkmcnt(0)" ::: "memory")

namespace pg8 {
constexpr int BM = 256, BK = 64, HALF = 128, HTB = HALF * BK * 2, STAGE_BYTES = 8 * HTB, NXCD = 8, WGM = 8;
__host__ __device__ __forceinline__ int lds_byte(int r, int c) { const int st = (r >> 4) * 2 + (c >> 5), rr = r & 15, cc = c & 31, ob = rr * 64 + cc * 2; return st * 1024 + (ob ^ (((ob >> 9) & 1) << 5)); }
__host__ __device__ __forceinline__ void stage_rc(int b, int& R, int& C) { const int st = b / 1024, sb = b % 1024, swz = sb ^ (((sb >> 9) & 1) << 5); R = (st >> 1) * 16 + swz / 64; C = (st & 1) * 32 + (swz % 64) / 2; }
__host__ __device__ __forceinline__ int perm32(int rho) { const int n = rho >> 4, i = rho & 15; return 8 * (i >> 2) + 4 * n + (i & 3); }
struct Unit { int pm, pn; };
struct Gemm { const void* A; const void* Bt; int M, N, K, pa, pb; };
struct StaticOrder {
    int nM, nN, nwg, G, c;
    __device__ void init(int M, int N, int G_, int c_) { nM = M / BM; nN = N / BM; nwg = nM * nN; G = G_; c = c_; }
    __device__ bool next(int i, Unit& u) const {
        const long L = (long)i * G + c; if (L >= nwg) return false;
        int wgid = (int)L; { const int q = nwg / NXCD, r = nwg % NXCD, xcd = wgid % NXCD, off = wgid / NXCD; wgid = (xcd < r ? xcd * (q + 1) : r * (q + 1) + (xcd - r) * q) + off; }
        const int nig = WGM * nN, gid = wgid / nig, fm = gid * WGM, gsz = (nM - fm) < WGM ? (nM - fm) : WGM;
        u.pm = fm + ((wgid % nig) % gsz); u.pn = (wgid % nig) / gsz; return true;
    }
};
template <class Epi, bool I8 = false>
__device__ __forceinline__ void gemm_phase(LAS unsigned char* lds, const Gemm g, const StaticOrder& S, const Epi& E) {
    const int tid = threadIdx.x, wid = __builtin_amdgcn_readfirstlane(tid >> 6), lane = tid & 63, wr = wid >> 2, wc = wid & 3, fr = lane & 15, fq = lane >> 4;
    const int K = g.K, nt = I8 ? K / (2 * BK) : K / BK;
    unsigned voffA[2], voffB[2];
#pragma unroll
    for (int i = 0; i < 2; ++i) { int R, C; stage_rc(tid * 16 + i * 8192, R, C); const int Rb = (R & ~31) + perm32(R & 31);
        voffA[i] = (unsigned)(R * g.pa + C * 2); voffB[i] = (unsigned)(Rb * g.pb + C * 2); }
    const size_t kstep = (size_t)(BK * 2);
    const size_t hstepA = (size_t)HALF * g.pa, hstepB = (size_t)HALF * g.pb;
    const size_t tstepA = 2 * hstepA, tstepB = 2 * hstepB;
    const unsigned ldsw = (unsigned)wid * 1024u;
    const int aoff = lds_byte(wr * 64 + fr, fq * 8), boff = lds_byte(wc * 32 + fr, fq * 8);
#define PG8_SA(b, h) (((b) * 2 + (h)) * HTB)
#define PG8_SB(b, h) ((4 + (b) * 2 + (h)) * HTB)
#define PG8_STAGE(bufoff, gbase, voff) do { _Pragma("unroll") for (int _i = 0; _i < 2; ++_i) \
        __builtin_amdgcn_global_load_lds((const unsigned*)((const char*)(gbase) + (voff)[_i]), (LAS unsigned*)(lds + (bufoff) + ldsw + _i * 8192), 16, 0, 0); } while (0)
#define PG8_LDA(dst, b, h) do { _Pragma("unroll") for (int m = 0; m < 4; ++m) _Pragma("unroll") for (int k = 0; k < 2; ++k) dst[m][k] = *(const LAS bf16x8*)(lds + PG8_SA(b, h) + aoff + m * 2048 + k * 1024); } while (0)
#define PG8_LDB(dst, b, h) do { _Pragma("unroll") for (int n = 0; n < 2; ++n) _Pragma("unroll") for (int k = 0; k < 2; ++k) dst[n][k] = *(const LAS bf16x8*)(lds + PG8_SB(b, h) + boff + n * 2048 + k * 1024); } while (0)
#define PG8_MMA(ai, bj, At, Bt) do { __builtin_amdgcn_s_setprio(1); _Pragma("unroll") for (int m = 0; m < 4; ++m) _Pragma("unroll") for (int n = 0; n < 2; ++n) _Pragma("unroll") for (int k = 0; k < 2; ++k) \
        { if (I8) acc[ai][bj][m][n] = __builtin_bit_cast(f32x4, __builtin_amdgcn_mfma_i32_16x16x64_i8(__builtin_bit_cast(i32x4, Bt[n][k]), __builtin_bit_cast(i32x4, At[m][k]), __builtin_bit_cast(i32x4, acc[ai][bj][m][n]), 0, 0, 0)); \
          else acc[ai][bj][m][n] = __builtin_amdgcn_mfma_f32_16x16x32_bf16(Bt[n][k], At[m][k], acc[ai][bj][m][n], 0, 0, 0); } __builtin_amdgcn_s_setprio(0); } while (0)
#define PG8_WAIT_V(n) asm volatile("s_waitcnt vmcnt(" #n ")" ::: "memory")
#define PG8_WAIT_L(n) asm volatile("s_waitcnt lgkmcnt(" #n ")" ::: "memory")
#define PG8_BAR __builtin_amdgcn_s_barrier()
#define PG8_SCHED __builtin_amdgcn_sched_barrier(0)
    Unit cur, nxt; int ui = 0;
    if (!S.next(0, cur)) return;
    f32x4 acc[2][2][4][2];
#pragma unroll
    for (int a = 0; a < 2; ++a)
#pragma unroll
        for (int b = 0; b < 2; ++b)
#pragma unroll
            for (int m = 0; m < 4; ++m)
#pragma unroll
                for (int n = 0; n < 2; ++n) acc[a][b][m][n] = (f32x4){0.f, 0.f, 0.f, 0.f};
    bf16x8 At[4][2], B0[2][2], B1[2][2];
    const char* cA = (const char*)g.A + (size_t)cur.pm * tstepA; const char* cB = (const char*)g.Bt + (size_t)cur.pn * tstepB;
    PG8_STAGE(PG8_SB(0, 0), cB, voffB); PG8_STAGE(PG8_SA(0, 0), cA, voffA); PG8_STAGE(PG8_SB(0, 1), cB + hstepB, voffB); PG8_STAGE(PG8_SA(0, 1), cA + hstepA, voffA);
    if (wr == 1) PG8_BAR;
    PG8_WAIT_V(4); PG8_BAR;
    PG8_STAGE(PG8_SB(1, 0), cB + kstep, voffB); PG8_STAGE(PG8_SA(1, 0), cA + kstep, voffA); PG8_STAGE(PG8_SB(1, 1), cB + hstepB + kstep, voffB);
    PG8_WAIT_V(6); PG8_BAR;
    for (;;) {
        const bool has_next = S.next(ui + 1, nxt);
        const char* nA = has_next ? (const char*)g.A + (size_t)nxt.pm * tstepA : cA; const char* nB = has_next ? (const char*)g.Bt + (size_t)nxt.pn * tstepB : cB;
        for (int t = 0; t < nt; t += 2) {
            const bool last = (t == nt - 2);
            const char* a1 = cA + (size_t)(t + 1) * kstep;
            const char* a2 = last ? nA : cA + (size_t)(t + 2) * kstep; const char* b2 = last ? nB : cB + (size_t)(t + 2) * kstep;
            const char* a3 = a2 + kstep; const char* b3 = b2 + kstep;
            PG8_LDB(B0, 0, 0); PG8_SCHED; PG8_LDA(At, 0, 0); PG8_STAGE(PG8_SA(1, 1), a1 + hstepA, voffA);
            PG8_WAIT_L(8); PG8_BAR; PG8_WAIT_L(0); PG8_MMA(0, 0, At, B0); PG8_BAR; PG8_SCHED;
            PG8_LDB(B1, 0, 1); PG8_STAGE(PG8_SB(0, 0), b2, voffB);
            PG8_BAR; PG8_WAIT_L(0); PG8_MMA(0, 1, At, B1); PG8_BAR;
            PG8_LDA(At, 0, 1); PG8_STAGE(PG8_SA(0, 0), a2, voffA);
            PG8_BAR; PG8_WAIT_L(0); PG8_MMA(1, 0, At, B0); PG8_BAR; PG8_SCHED;
            PG8_STAGE(PG8_SB(0, 1), b2 + hstepB, voffB);
            PG8_WAIT_V(6); PG8_BAR; PG8_MMA(1, 1, At, B1); PG8_BAR;
            PG8_LDB(B0, 1, 0); PG8_SCHED; PG8_LDA(At, 1, 0); PG8_STAGE(PG8_SA(0, 1), a2 + hstepA, voffA);
            PG8_WAIT_L(8); PG8_BAR; PG8_WAIT_L(0); PG8_MMA(0, 0, At, B0); PG8_BAR; PG8_SCHED;
            PG8_LDB(B1, 1, 1); PG8_STAGE(PG8_SB(1, 0), b3, voffB);
            PG8_BAR; PG8_WAIT_L(0); PG8_MMA(0, 1, At, B1); PG8_BAR;
            PG8_LDA(At, 1, 1); PG8_STAGE(PG8_SA(1, 0), a3, voffA);
            PG8_BAR; PG8_WAIT_L(0); PG8_MMA(1, 0, At, B0); PG8_BAR; PG8_SCHED;
            PG8_STAGE(PG8_SB(1, 1), b3 + hstepB, voffB);
            PG8_WAIT_V(6); PG8_BAR; PG8_MMA(1, 1, At, B1); PG8_BAR;
        }
        E(acc, cur, wr, wc, fr, fq);
        if (!has_next) break;
#pragma unroll
        for (int a = 0; a < 2; ++a)
#pragma unroll
            for (int b = 0; b < 2; ++b)
#pragma unroll
                for (int m = 0; m < 4; ++m)
#pragma unroll
                    for (int n = 0; n < 2; ++n) acc[a][b][m][n] = (f32x4){0.f, 0.f, 0.f, 0.f};
        cur = nxt; cA = nA; cB = nB; ++ui;
    }
    PG8_WAIT_V(0);
    if (wr == 0) PG8_BAR;
    PG8_BAR;
#undef PG8_SA
#undef PG8_SB
#undef PG8_STAGE
#undef PG8_LDA
#undef PG8_LDB
#undef PG8_MMA
#undef PG8_WAIT_V
#undef PG8_WAIT_L
#undef PG8_BAR
#undef PG8_SCHED
}

struct EpiProj {
    bf16_t* qkv; bf16_t* sg; float qscale; unsigned* kmaxw; const float* hsc; const float* wsc;
    __device__ __forceinline__ void operator()(const f32x4 (&acci)[2][2][4][2], const Unit& u, int wr, int wc, int fr, int fq) const {
        const int row0 = u.pm * BM + wr * 64 + fr;
        f32x4 acc[2][2][4][2];
        { f32x4 cs[2][2];
#pragma unroll
          for (int bj = 0; bj < 2; ++bj)
#pragma unroll
              for (int n = 0; n < 2; ++n) cs[bj][n] = *(const f32x4*)(wsc + u.pn * BM + bj * HALF + wc * 32 + 8 * fq + 4 * n);
#pragma unroll
          for (int ai = 0; ai < 2; ++ai)
#pragma unroll
              for (int m = 0; m < 4; ++m) { const float rsc = hsc[row0 + ai * HALF + m * 16];
#pragma unroll
                  for (int bj = 0; bj < 2; ++bj)
#pragma unroll
                      for (int n = 0; n < 2; ++n) { const i32x4 iv = __builtin_bit_cast(i32x4, acci[ai][bj][m][n]);
                          acc[ai][bj][m][n] = (f32x4){(float)iv[0], (float)iv[1], (float)iv[2], (float)iv[3]} * rsc * cs[bj][n]; } } }
        if (u.pn < 24) {
            const int t = u.pn >> 2; bf16_t* base = qkv + (size_t)t * ((size_t)T_TOK * 1024) + (u.pn & 3) * 256 + wc * 32 + 8 * fq;
            const float sc = (t == 0 || t == 3) ? qscale : 1.f;
            if (t == 4) {
#pragma unroll
                for (int bj = 0; bj < 2; ++bj) { float mxv = 0.f;
#pragma unroll
                    for (int ai = 0; ai < 2; ++ai)
#pragma unroll
                        for (int m = 0; m < 4; ++m) { const f32x4 v0 = acc[ai][bj][m][0], v1 = acc[ai][bj][m][1];
                            float ssq = (v0[0] * v0[0] + v0[1] * v0[1]) + (v0[2] * v0[2] + v0[3] * v0[3]) + (v1[0] * v1[0] + v1[1] * v1[1]) + (v1[2] * v1[2] + v1[3] * v1[3]);
                            ssq += __shfl_xor(ssq, 16); ssq += __shfl_xor(ssq, 32); mxv = fmaxf(mxv, ssq); }
#pragma unroll
                    for (int o = 1; o < 16; o <<= 1) mxv = fmaxf(mxv, __shfl_xor(mxv, o));
                    if ((fr | fq) == 0) atomicMax(kmaxw + ((u.pm >> 4) * 8 + (u.pn & 3) * 2 + bj) * 4 + wc, __builtin_bit_cast(unsigned, mxv)); }
            }
#pragma unroll
            for (int ai = 0; ai < 2; ++ai)
#pragma unroll
                for (int m = 0; m < 4; ++m) { bf16_t* rowp = base + (size_t)(row0 + ai * HALF + m * 16) * 1024;
#pragma unroll
                    for (int bj = 0; bj < 2; ++bj) { const f32x4 v0 = acc[ai][bj][m][0] * sc, v1 = acc[ai][bj][m][1] * sc;
                        u32x4 w; w.x = pk2(v0[0], v0[1]); w.y = pk2(v0[2], v0[3]); w.z = pk2(v1[0], v1[1]); w.w = pk2(v1[2], v1[3]);
                        *(u32x4*)(rowp + bj * HALF) = w; } }
        } else {
            bf16_t* base = sg + (u.pn - 24) * 256 + wc * 32 + 8 * fq;
#pragma unroll
            for (int ai = 0; ai < 2; ++ai)
#pragma unroll
                for (int m = 0; m < 4; ++m) { bf16_t* rowp = base + (size_t)(row0 + ai * HALF + m * 16) * 4096;
#pragma unroll
                    for (int bj = 0; bj < 2; ++bj) { float s[8];
#pragma unroll
                        for (int e = 0; e < 4; ++e) { s[e] = frcp(1.f + fexp2(-LOG2E * acc[ai][bj][m][0][e])); s[4 + e] = frcp(1.f + fexp2(-LOG2E * acc[ai][bj][m][1][e])); }
                        u32x4 w; w.x = pk2(s[0], s[1]); w.y = pk2(s[2], s[3]); w.z = pk2(s[4], s[5]); w.w = pk2(s[6], s[7]);
                        *(u32x4*)(rowp + bj * HALF) = w; } }
        }
    }
};
template <int SECOND> struct EpiGate {
    const bf16_t* sg;
    bf16_t* tmp; bf16_t* merged;
    __device__ __forceinline__ void operator()(const f32x4 (&acc)[2][2][4][2], const Unit& u, int wr, int wc, int fr, int fq) const {
        const int row0 = u.pm * BM + wr * 64 + fr, col0 = u.pn * BM + wc * 32 + 8 * fq;
#pragma unroll
        for (int ai = 0; ai < 2; ++ai)
#pragma unroll
            for (int m = 0; m < 4; ++m) { const size_t row = (size_t)(row0 + ai * HALF + m * 16);
#pragma unroll
                for (int bj = 0; bj < 2; ++bj) { const int col = col0 + bj * HALF;
                    const u32x4 gv = *(const u32x4*)(sg + row * 4096 + col);
                    const f32x4 g0 = {bf_lo(gv.x), bf_hi(gv.x), bf_lo(gv.y), bf_hi(gv.y)}, g1 = {bf_lo(gv.z), bf_hi(gv.z), bf_lo(gv.w), bf_hi(gv.w)};
                    f32x4 v0 = acc[ai][bj][m][0] * g0, v1 = acc[ai][bj][m][1] * g1;
                    bf16_t* tp = tmp + row * DM + col;
                    if (SECOND == 0) { u32x4 w; w.x = pk2(v0[0], v0[1]); w.y = pk2(v0[2], v0[3]); w.z = pk2(v1[0], v1[1]); w.w = pk2(v1[2], v1[3]); *(u32x4*)tp = w; }
                    else { const u32x4 tv = *(const u32x4*)tp; v0 += (f32x4){bf_lo(tv.x), bf_hi(tv.x), bf_lo(tv.y), bf_hi(tv.y)}; v1 += (f32x4){bf_lo(tv.z), bf_hi(tv.z), bf_lo(tv.w), bf_hi(tv.w)};
                        u32x4 w; w.x = pk2(v0[0], v0[1]); w.y = pk2(v0[2], v0[3]); w.z = pk2(v1[0], v1[1]); w.w = pk2(v1[2], v1[3]);
                        *(u32x4*)(merged + row * DM + col) = w; } } }
    }
};
struct EpiResid {
    const float* x; float* x1; bf16_t* x1b; float* rowss;
    __device__ __forceinline__ void operator()(const f32x4 (&acc)[2][2][4][2], const Unit& u, int wr, int wc, int fr, int fq) const {
        const int row0 = u.pm * BM + wr * 64 + fr, col0 = u.pn * BM + wc * 32 + 8 * fq;
#pragma unroll
        for (int ai = 0; ai < 2; ++ai)
#pragma unroll
            for (int m = 0; m < 4; ++m) { const size_t row = (size_t)(row0 + ai * HALF + m * 16); float ss = 0.f;
#pragma unroll
                for (int bj = 0; bj < 2; ++bj) { const size_t o = row * DM + col0 + bj * HALF;
                    const f32x4 v0 = acc[ai][bj][m][0] + *(const f32x4*)(x + o), v1 = acc[ai][bj][m][1] + *(const f32x4*)(x + o + 4);
                    u32x4 w; w.x = pk2(v0[0], v0[1]); w.y = pk2(v0[2], v0[3]); w.z = pk2(v1[0], v1[1]); w.w = pk2(v1[2], v1[3]);
                    *(u32x4*)(x1b + o) = w;
                    ss += (v0[0] * v0[0] + v0[1] * v0[1]) + (v0[2] * v0[2] + v0[3] * v0[3]) + (v1[0] * v1[0] + v1[1] * v1[1]) + (v1[2] * v1[2] + v1[3] * v1[3]); }
                ss += __shfl_xor(ss, 16); ss += __shfl_xor(ss, 32);
                if (fq == 0) atomicAdd(rowss + row, ss); }
    }
};
struct EpiPlainBf16 {
    bf16_t* o;
    __device__ __forceinline__ void operator()(const f32x4 (&acc)[2][2][4][2], const Unit& u, int wr, int wc, int fr, int fq) const {
        const int row0 = u.pm * BM + wr * 64 + fr, col0 = u.pn * BM + wc * 32 + 8 * fq;
#pragma unroll
        for (int ai = 0; ai < 2; ++ai)
#pragma unroll
            for (int m = 0; m < 4; ++m) { const size_t row = (size_t)(row0 + ai * HALF + m * 16);
#pragma unroll
                for (int bj = 0; bj < 2; ++bj) { const f32x4 v0 = acc[ai][bj][m][0], v1 = acc[ai][bj][m][1];
                    u32x4 w; w.x = pk2(v0[0], v0[1]); w.y = pk2(v0[2], v0[3]); w.z = pk2(v1[0], v1[1]); w.w = pk2(v1[2], v1[3]);
                    *(u32x4*)(o + row * DM + col0 + bj * HALF) = w; } }
    }
};
}

__device__ __forceinline__ void transpose_item(const float* W, int ldw, int src_n0, bf16_t* WT, int K, int dst_n0, int k0, LAS float* scr, int lane, const float* kscale) {
    { const int c4 = (lane & 7) * 4;
      f32x4 v[8];
#pragma unroll
      for (int i = 0; i < 8; ++i) v[i] = *(const f32x4*)(W + (size_t)(k0 + 8 * i + (lane >> 3)) * ldw + src_n0 + c4);
#pragma unroll
      for (int i = 0; i < 8; ++i) { const int kk = 8 * i + (lane >> 3); const float ks = kscale ? kscale[k0 + kk] : 1.f; LAS float* sp = scr + kk * 33 + c4;
          sp[0] = v[i][0] * ks; sp[1] = v[i][1] * ks; sp[2] = v[i][2] * ks; sp[3] = v[i][3] * ks; } }
    LDS_WAIT();
    const int c = lane & 7;
#pragma unroll
    for (int j = 0; j < 4; ++j) { const int n = (lane >> 3) + 8 * j; const LAS float* s = scr + (8 * c) * 33 + n;
        u32x4 o; o.x = pk2(s[0 * 33], s[1 * 33]); o.y = pk2(s[2 * 33], s[3 * 33]); o.z = pk2(s[4 * 33], s[5 * 33]); o.w = pk2(s[6 * 33], s[7 * 33]);
        *(u32x4*)(WT + (size_t)(dst_n0 + n) * K + k0 + 8 * c) = o; }
    LDS_WAIT();
}

__device__ __forceinline__ void p0a(const Params& P, LAS unsigned char* lds, int vcu, int G) {
    const int tid = threadIdx.x, lane = tid & 63, wave = __builtin_amdgcn_readfirstlane(tid >> 6);
    const int gw = vcu * NWAVES + wave, NGW = G * NWAVES;
    unsigned char* ws = P.ws;
    {
        unsigned* CMAX = (unsigned*)(ws + WS_CTL + CTL_CMAX);
        constexpr int NCB = (10248 + 255) / 256;
        for (int it = gw; it < 128 * NCB; it += NGW) { const int kb = it / NCB, cb = it % NCB, sc = cb * 256 + 4 * lane;
            if (sc < 10248) { f32x4 v[16];
#pragma unroll
                for (int r = 0; r < 16; ++r) v[r] = *(const f32x4*)(P.w_in + (size_t)(kb * 16 + r) * 10248 + sc);
                float m0 = 0.f, m1 = 0.f, m2 = 0.f, m3 = 0.f;
#pragma unroll
                for (int r = 0; r < 16; ++r) { m0 = fmaxf(m0, fabsf(v[r][0])); m1 = fmaxf(m1, fabsf(v[r][1])); m2 = fmaxf(m2, fabsf(v[r][2])); m3 = fmaxf(m3, fabsf(v[r][3])); }
                const float mm[4] = {m0, m1, m2, m3};
#pragma unroll
                for (int e = 0; e < 4; ++e) { const int c = sc + e; const unsigned mb = __float_as_uint(mm[e]);
                    if (c < 6144) atomicMax(CMAX + c, mb); else if (c >= 6152) atomicMax(CMAX + c - 8, mb); } } }
    }
    {
        LAS float* wf = (LAS float*)lds;
        for (int k = tid; k < 2048; k += NTHR) { const f32x4 a0 = *(const f32x4*)(P.w_in + (size_t)k * 10248 + 6144), a1 = *(const f32x4*)(P.w_in + (size_t)k * 10248 + 6148);
            wf[k] = a0[0]; wf[2048 + k] = a0[1]; wf[4096 + k] = a0[2]; wf[6144 + k] = a0[3]; wf[8192 + k] = a1[0]; wf[10240 + k] = a1[1]; wf[12288 + k] = a1[2]; wf[14336 + k] = a1[3]; }
        __syncthreads();
        unsigned char* HQ8 = ws + WS_H; float* HSC = (float*)(ws + WS_HSC); float* LOGF = (float*)(ws + WS_LOGF);
        f32x4 xn[8];
        if (gw < T_TOK) { const f32x4* xr = (const f32x4*)(P.x + (size_t)gw * DM) + lane;
#pragma unroll
            for (int j = 0; j < 8; ++j) xn[j] = xr[64 * j]; }
        for (int r = gw; r < T_TOK; r += NGW) {
            float ss = 0.f, amx = 0.f; f32x4 hv[8];
#pragma unroll
            for (int j = 0; j < 8; ++j) { const f32x4 v = xn[j]; const f32x4 gn = *((const f32x4*)P.g_mix + lane + 64 * j); ss += (v[0] * v[0] + v[1] * v[1]) + (v[2] * v[2] + v[3] * v[3]);
                hv[j] = v * gn; amx = fmaxf(amx, fmaxf(fmaxf(fabsf(hv[j][0]), fabsf(hv[j][1])), fmaxf(fabsf(hv[j][2]), fabsf(hv[j][3])))); }
            if (r + NGW < T_TOK) { const f32x4* xr = (const f32x4*)(P.x + (size_t)(r + NGW) * DM) + lane;
#pragma unroll
                for (int j = 0; j < 8; ++j) xn[j] = xr[64 * j]; }
            const float rstd = 1.0f / sqrtf(wave_sum(ss) * (1.f / DM) + EPS);
#pragma unroll
            for (int o = 1; o < 64; o <<= 1) amx = fmaxf(amx, __shfl_xor(amx, o));
            const float hmax = fmaxf(amx * rstd, 1e-30f), hinv = 127.f / hmax;
            float fl[8];
#pragma unroll
            for (int c = 0; c < 8; ++c) fl[c] = 0.f;
            unsigned* hp = (unsigned*)(HQ8 + (size_t)r * DM) + lane;
#pragma unroll
            for (int j = 0; j < 8; ++j) { const f32x4 h = hv[j] * rstd;
                unsigned w = 0;
#pragma unroll
                for (int e = 0; e < 4; ++e) w |= ((unsigned)(int)__builtin_rintf(h[e] * hinv) & 255u) << (8 * e);
                hp[64 * j] = w;
#pragma unroll
                for (int c = 0; c < 8; ++c) { const f32x4 wv = *((const LAS f32x4*)(wf + c * 2048) + lane + 64 * j); fl[c] += (h[0] * wv[0] + h[1] * wv[1]) + (h[2] * wv[2] + h[3] * wv[3]); }
                __builtin_amdgcn_sched_barrier(0); }
            { const bool b5 = (lane >> 5) & 1, b4 = (lane >> 4) & 1, b3 = (lane >> 3) & 1; float p1[4], p2[2], p3;
#pragma unroll
              for (int q = 0; q < 4; ++q) { const float send = b5 ? fl[q] : fl[q + 4], keep = b5 ? fl[q + 4] : fl[q]; p1[q] = keep + __shfl_xor(send, 32); }
#pragma unroll
              for (int q = 0; q < 2; ++q) { const float send = b4 ? p1[q] : p1[q + 2], keep = b4 ? p1[q + 2] : p1[q]; p2[q] = keep + __shfl_xor(send, 16); }
              { const float send = b3 ? p2[0] : p2[1], keep = b3 ? p2[1] : p2[0]; p3 = keep + __shfl_xor(send, 8); }
              p3 += __shfl_xor(p3, 4); p3 += __shfl_xor(p3, 2); p3 += __shfl_xor(p3, 1);
              if (lane == 0) HSC[r] = hmax * (1.f / 127.f);
              if ((lane & 7) == 0) { const int c = lane >> 3; const float y = p3 + P.b_forget[c]; LOGF[((size_t)(r >> 12) * 8 + c) * SEQ + (r & (SEQ - 1))] = fminf(y, 0.f) - log1pf(expf(-fabsf(y))); } }
        }
    }
    {
        const size_t gid = (size_t)vcu * NTHR + tid, gstride = (size_t)G * NTHR;
        for (size_t i = gid; i < 262144 / 8; i += gstride) { const float* src = P.sub_keys + i * 8; const f32x4 a = *(const f32x4*)src, b = *((const f32x4*)src + 1);
            u32x4 o; o.x = pk2(a[0], a[1]); o.y = pk2(a[2], a[3]); o.z = pk2(b[0], b[1]); o.w = pk2(b[2], b[3]); *(u32x4*)((bf16_t*)(ws + WS_SKB) + i * 8) = o; }
    }
}
__device__ __forceinline__ void p0b(const Params& P, LAS unsigned char* lds, int vcu, int G) {
    const int tid = threadIdx.x, lane = tid & 63, wave = __builtin_amdgcn_readfirstlane(tid >> 6);
    const int gw = vcu * NWAVES + wave, NGW = G * NWAVES;
    unsigned char* ws = P.ws;
    const unsigned* CMAX = (const unsigned*)(ws + WS_CTL + CTL_CMAX); float* WSC = (float*)(ws + WS_WSC); unsigned char* WT8 = ws + WS_WIN;
    LAS float* scr = (LAS float*)(lds + wave * 16384);
    for (int it = gw; it < 32 * 320; it += NGW) {
        const int nb = it >> 5, kb = it & 31, dn = nb * 32, sn = dn < 6144 ? dn : dn + 8, k0 = kb * 64;
        const int c4 = (lane & 7) * 4;
        float inv[4];
#pragma unroll
        for (int e = 0; e < 4; ++e) { const float cm = fmaxf(__uint_as_float(__hip_atomic_load(CMAX + dn + c4 + e, __ATOMIC_RELAXED, __HIP_MEMORY_SCOPE_AGENT)), 1e-30f); inv[e] = 127.f / cm;
            if (kb == 0 && lane < 8) WSC[dn + c4 + e] = cm * (1.f / 127.f); }
        f32x4 v[8];
#pragma unroll
        for (int i = 0; i < 8; ++i) v[i] = *(const f32x4*)(P.w_in + (size_t)(k0 + 8 * i + (lane >> 3)) * 10248 + sn + c4);
#pragma unroll
        for (int i = 0; i < 8; ++i) { LAS float* sp = scr + (8 * i + (lane >> 3)) * 33 + c4; sp[0] = v[i][0] * inv[0]; sp[1] = v[i][1] * inv[1]; sp[2] = v[i][2] * inv[2]; sp[3] = v[i][3] * inv[3]; }
        LDS_WAIT();
        const int c = lane & 3;
#pragma unroll
        for (int j = 0; j < 2; ++j) { const int n = (lane >> 2) + 16 * j; const LAS float* sp = scr + (16 * c) * 33 + n;
            u32x4 o;
#pragma unroll
            for (int w4 = 0; w4 < 4; ++w4) { unsigned w = 0;
#pragma unroll
                for (int e = 0; e < 4; ++e) w |= ((unsigned)(int)fminf(fmaxf(__builtin_rintf(sp[(4 * w4 + e) * 33]), -127.f), 127.f) & 255u) << (8 * e);
                o[w4] = w; }
            *(u32x4*)(WT8 + (size_t)(dn + n) * 2048 + k0 + 16 * c) = o; }
        LDS_WAIT();
    }
}
__device__ __forceinline__ void late_transposes(const Params& P, LAS unsigned char* lds, int vcu, int G) {
    const int tid = threadIdx.x, lane = tid & 63, wave = __builtin_amdgcn_readfirstlane(tid >> 6);
    const int gw = vcu * NWAVES + wave, NGW = G * NWAVES;
    unsigned char* ws = P.ws;
    LAS float* scr = (LAS float*)(lds + wave * 16384);
    constexpr int I_A = 16 * 64, I_O = 32 * 64, NITEMS = 2 * I_A + 2 * I_O;
    for (int it = gw; it < NITEMS; it += NGW) {
        int r = it;
        if (r < I_A) { const int kb = r / 64, nb = r % 64; transpose_item(P.w_a, 2048, nb * 32, (bf16_t*)(ws + WS_WAT), 1024, nb * 32, kb * 64, scr, lane, nullptr); continue; } r -= I_A;
        if (r < I_A) { const int kb = r / 64, nb = r % 64; transpose_item(P.w_b, 2048, nb * 32, (bf16_t*)(ws + WS_WBT), 1024, nb * 32, kb * 64, scr, lane, nullptr); continue; } r -= I_A;
        if (r < I_O) { const int kb = r / 64, nb = r % 64; transpose_item(P.w_out, 2048, nb * 32, (bf16_t*)(ws + WS_WOUT), 2048, nb * 32, kb * 64, scr, lane, nullptr); continue; } r -= I_O;
        { const int kb = r / 64, nb = r % 64; transpose_item(P.w_query, 2048, nb * 32, (bf16_t*)(ws + WS_WQ), 2048, nb * 32, kb * 64, scr, lane, P.g_ffn); }
    }
}
__device__ __forceinline__ void quantise_expert_rows(const Params& P, int r0, int nrows) {
    const int lane = threadIdx.x & 63;
    unsigned char* ws = P.ws;
    float* SU = (float*)(ws + WS_SU); float* SV = (float*)(ws + WS_SV);
    for (int r = r0; r < r0 + nrows; r += 2) {
        f32x4 v[2][8];
#pragma unroll
        for (int t = 0; t < 2; ++t) { const int rr = r + t; const f32x4* src = (const f32x4*)((rr >= 16384 ? P.e_v : P.e_u) + (size_t)(rr & 16383) * DM) + lane;
#pragma unroll
            for (int j = 0; j < 8; ++j) v[t][j] = __builtin_nontemporal_load(src + 64 * j); }
#pragma unroll
        for (int t = 0; t < 2; ++t) { const int rr = r + t; const bool second = rr >= 16384; const int row = rr & 16383;
            float mx = 0.f;
#pragma unroll
            for (int j = 0; j < 8; ++j) mx = fmaxf(mx, fmaxf(fmaxf(fabsf(v[t][j][0]), fabsf(v[t][j][1])), fmaxf(fabsf(v[t][j][2]), fabsf(v[t][j][3]))));
#pragma unroll
            for (int o = 1; o < 64; o <<= 1) mx = fmaxf(mx, __shfl_xor(mx, o));
            mx = fmaxf(mx, 1e-30f);
            const float inv = 127.f / mx;
            unsigned* dst = (unsigned*)(ws + (second ? WS_EV : WS_EU) + (size_t)row * DM) + lane;
#pragma unroll
            for (int j = 0; j < 8; ++j) { unsigned w = 0;
#pragma unroll
                for (int e = 0; e < 4; ++e) { const int q = (int)__builtin_rintf(v[t][j][e] * inv); w |= ((unsigned)q & 255u) << (8 * e); }
                dst[64 * j] = w; }
            if (lane == 0) (second ? SV : SU)[row] = mx * (1.f / 127.f);
        }
    }
}

namespace att {
constexpr int KST = 272, VST = 320;
constexpr int KBUF = 64 * KST, VBUF = 64 * VST;
constexpr int OFF_K = 0, OFF_V = 2 * KBUF, OFF_F = OFF_V + 2 * VBUF, OFF_SC = OFF_F + 4096 * 4;
constexpr int OFF_FLG = OFF_SC + 64, OFF_UNIT = OFF_FLG + 64;
static_assert(OFF_UNIT + 16 <= 131072, "attention LDS");
constexpr float THR_SB = 30.f, THR_FOX = 20.f;

__device__ __forceinline__ void build_cumf(LAS unsigned char* lds, const float* LOGF, int b, int h, int n, int tid, int lane, int wid) {
    LAS float* F2 = (LAS float*)(lds + OFF_F); LAS float* sc = (LAS float*)(lds + OFF_SC);
    const int s0 = tid * 8; float v[8];
    { const f32x4* lp = (const f32x4*)(LOGF + ((size_t)b * 8 + h) * SEQ + s0); f32x4 a0 = {0.f, 0.f, 0.f, 0.f}, a1 = a0; if (s0 < n) { a0 = lp[0]; a1 = lp[1]; }
      v[0] = a0[0] * LOG2E; v[1] = a0[1] * LOG2E; v[2] = a0[2] * LOG2E; v[3] = a0[3] * LOG2E; v[4] = a1[0] * LOG2E; v[5] = a1[1] * LOG2E; v[6] = a1[2] * LOG2E; v[7] = a1[3] * LOG2E; }
#pragma unroll
    for (int i = 1; i < 8; ++i) v[i] += v[i - 1];
    float tot = v[7], inc = tot;
#pragma unroll
    for (int o = 1; o < 64; o <<= 1) { const float t = __shfl_up(inc, o); if (lane >= o) inc += t; }
    if (lane == 63) sc[wid] = inc;
    __syncthreads();
    float base = inc - tot;
#pragma unroll
    for (int w = 0; w < 8; ++w) if (w < wid) base += sc[w];
    if (s0 < n) {
#pragma unroll
        for (int i = 0; i < 8; ++i) F2[s0 + i] = v[i] + base;
    }
    __syncthreads();
}

template <int MIXER>
__device__ __forceinline__ void attn_unit(LAS unsigned char* lds, const bf16_t* Q, const bf16_t* Kg, const bf16_t* Vg, bf16_t* O, int b, int h, int qb, float kmax, int tid, int lane, int wid) {
    const int c = lane & 31, hh = lane >> 5;
    const int t0 = qb * 256 + wid * 32, tq = t0 + c;
    const size_t rowbase = (size_t)b * SEQ;
    size_t qoff = (rowbase + tq) * 1024 + h * HD + 8 * hh;
    f32x16 oacc[4];
#pragma unroll
    for (int d = 0; d < 4; ++d)
#pragma unroll
        for (int r = 0; r < 16; ++r) oacc[d][r] = 0.f;
    float carry = 0.f, mrun = -1e30f, lsum = 0.f; const float nhf = hh ? 0.f : 1.f;
    const LAS float* F2 = (const LAS float*)(lds + OFF_F);
    const float Ft = (MIXER == 1) ? F2[tq] : 0.f;
    float qk_bound = 0.f;
    if (MIXER == 1) { float qs = 0.f;
#pragma unroll
        for (int s2 = 0; s2 < 8; ++s2) { const u32x4 qv = *(const u32x4*)(Q + qoff + 16 * s2);
#pragma unroll
            for (int e = 0; e < 4; ++e) { const float a = bf_lo(qv[e]), b2 = bf_hi(qv[e]); qs += a * a + b2 * b2; } }
        qs += __shfl_xor(qs, 32);
        qk_bound = sqrtf(qs) * kmax; }
    bool wave_done = false;
    volatile LAS unsigned* flg = (volatile LAS unsigned*)(lds + OFF_FLG);
    const int ktmax = 4 * qb + 3;
    const int srow = tid >> 4, scc = tid & 15;
    u32x4 kr[2], vr[2];
#define ATT_LOAD(kt) do { _Pragma("unroll") for (int j = 0; j < 2; ++j) { const size_t g_ = (rowbase + 64 * (kt) + srow + 32 * j) * 1024 + h * HD + scc * 8; \
        kr[j] = *(const u32x4*)(Kg + g_); vr[j] = *(const u32x4*)(Vg + g_); } } while (0)
#define ATT_WRITE(buf) do { _Pragma("unroll") for (int j = 0; j < 2; ++j) { \
        *(LAS u32x4*)(lds + OFF_K + (buf) * KBUF + (srow + 32 * j) * KST + scc * 16) = kr[j]; \
        *(LAS u32x4*)(lds + OFF_V + (buf) * VBUF + (srow + 32 * j) * VST + scc * 16) = vr[j]; } } while (0)
    ATT_LOAD(ktmax); ATT_WRITE(0); __syncthreads();
    int buf = 0;
    for (int kt = ktmax; kt >= 0; --kt) {
        if (kt > 0) ATT_LOAD(kt - 1);
        const bool started = (64 * kt <= t0 + 31);
        if (started && !wave_done) {
            const LAS unsigned char* Kl = lds + OFF_K + buf * KBUF; const LAS unsigned char* Vl = lds + OFF_V + buf * VBUF;
            f32x16 sacc[2];
            asm volatile("" : "+v"(qoff));
            bf16x8 qf[8];
#pragma unroll
            for (int s = 0; s < 8; ++s) qf[s] = *(const bf16x8*)(Q + qoff + 16 * s);
#pragma unroll
            for (int sub = 0; sub < 2; ++sub) {
#pragma unroll
                for (int r = 0; r < 16; ++r) sacc[sub][r] = 0.f;
#pragma unroll
                for (int s = 0; s < 8; ++s) { const bf16x8 kf = *(const LAS bf16x8*)(Kl + (32 * sub + c) * KST + (16 * s + 8 * hh) * 2);
                    sacc[sub] = __builtin_amdgcn_mfma_f32_32x32x16_bf16(kf, qf[s], sacc[sub], 0, 0, 0); }
            }
            const bool need_mask = (64 * kt + 63 >= t0);
            bool tile_dead = false;
            if (MIXER == 0) {
#pragma unroll
                for (int sub = 1; sub >= 0; --sub) {
                    float lb[16];
#pragma unroll
                    for (int r = 0; r < 16; ++r) { const float z = sacc[sub][r]; float l = -flog2(1.f + fexp2(z));
                        if (need_mask) { const int sidx = 64 * kt + 32 * sub + (r & 3) + 8 * (r >> 2) + 4 * hh; l = (sidx < tq) ? l : 0.f; }
                        lb[r] = l; }
                    float Glo[4], Ghi[4];
#pragma unroll
                    for (int g = 0; g < 4; ++g) { lb[4 * g + 2] += lb[4 * g + 3]; lb[4 * g + 1] += lb[4 * g + 2]; lb[4 * g] += lb[4 * g + 1];
                        const unsigned gu = __builtin_bit_cast(unsigned, lb[4 * g]); const auto rr = __builtin_amdgcn_permlane32_swap(gu, gu, false, false);
                        Glo[g] = __builtin_bit_cast(float, (unsigned)rr[0]); Ghi[g] = __builtin_bit_cast(float, (unsigned)rr[1]); }
                    float E[8];
                    E[7] = carry; E[6] = E[7] + Ghi[3]; E[5] = E[6] + Glo[3]; E[4] = E[5] + Ghi[2]; E[3] = E[4] + Glo[2]; E[2] = E[3] + Ghi[1]; E[1] = E[2] + Glo[1]; E[0] = E[1] + Ghi[0];
                    carry = E[0] + Glo[0];
#pragma unroll
                    for (int g = 0; g < 4; ++g) { const float Eo = __builtin_fmaf(nhf, Ghi[g], E[2 * g + 1]);
#pragma unroll
                        for (int i = 0; i < 4; ++i) { const int r = 4 * g + i; float w = fexp2(sacc[sub][r] + lb[r] + Eo);
                            if (need_mask) { const int sidx = 64 * kt + 32 * sub + (r & 3) + 8 * (r >> 2) + 4 * hh; w = (sidx < tq) ? w : 0.f; }
                            sacc[sub][r] = w; } }
                }
            } else {
                float mx = -1e30f;
#pragma unroll
                for (int sub = 0; sub < 2; ++sub)
#pragma unroll
                    for (int g = 0; g < 4; ++g) { const f32x4 fs = *(const LAS f32x4*)(F2 + 64 * kt + 32 * sub + 8 * g + 4 * hh);
#pragma unroll
                        for (int i = 0; i < 4; ++i) { const int r = 4 * g + i; float xv = sacc[sub][r] + (Ft - fs[i]);
                            if (need_mask) { const int sidx = 64 * kt + 32 * sub + 8 * g + 4 * hh + i; xv = (sidx <= tq) ? xv : -1e30f; }
                            sacc[sub][r] = xv; mx = fmaxf(mx, xv); } }
                { const unsigned mu = __builtin_bit_cast(unsigned, mx); const auto rr = __builtin_amdgcn_permlane32_swap(mu, mu, false, false);
                  mx = fmaxf(__builtin_bit_cast(float, (unsigned)rr[0]), __builtin_bit_cast(float, (unsigned)rr[1])); }
                tile_dead = __all(mx - mrun < -THR_FOX);
                if (!tile_dead) {
                const float mnew = fmaxf(mrun, mx);
                const float alpha = fexp2(mrun - mnew);
                float ps = 0.f;
#pragma unroll
                for (int sub = 0; sub < 2; ++sub)
#pragma unroll
                    for (int r = 0; r < 16; ++r) { const float p = fexp2(sacc[sub][r] - mnew); sacc[sub][r] = p; ps += p; }
                lsum = lsum * alpha + ps;
                if (__any(mnew > mrun)) {
#pragma unroll
                    for (int d = 0; d < 4; ++d)
#pragma unroll
                        for (int r = 0; r < 16; ++r) oacc[d][r] *= alpha;
                }
                mrun = mnew;
                }
            }
            if (!tile_dead)
#pragma unroll
            for (int ks = 0; ks < 4; ++ks) { const int sub = ks >> 1, rb = 8 * (ks & 1);
                u32x4 pw; pw.x = pk2(sacc[sub][rb + 0], sacc[sub][rb + 1]); pw.y = pk2(sacc[sub][rb + 2], sacc[sub][rb + 3]); pw.z = pk2(sacc[sub][rb + 4], sacc[sub][rb + 5]); pw.w = pk2(sacc[sub][rb + 6], sacc[sub][rb + 7]);
                const bf16x8 pf = __builtin_bit_cast(bf16x8, pw);
                const LAS unsigned char* vb = Vl + (16 * ks + 4 * hh + ((lane & 15) >> 2)) * VST + (16 * ((lane >> 4) & 1) + 4 * (lane & 3)) * 2;
#pragma unroll
                for (int d = 0; d < 4; ++d) {
                    const s16x4 a0 = __builtin_amdgcn_ds_read_tr16_b64_v4i16((LAS s16x4*)(vb + d * 64));
                    const s16x4 a1 = __builtin_amdgcn_ds_read_tr16_b64_v4i16((LAS s16x4*)(vb + d * 64 + 8 * VST));
                    const bf16x8 af = {a0[0], a0[1], a0[2], a0[3], a1[0], a1[1], a1[2], a1[3]};
                    oacc[d] = __builtin_amdgcn_mfma_f32_32x32x16_bf16(af, pf, oacc[d], 0, 0, 0); }
            }
        }
        if (kt > 0) ATT_WRITE(buf ^ 1);
        if (kt > 0 && started && !wave_done) {
            if (MIXER == 0) wave_done = __all(carry < -THR_SB);
            else wave_done = __all(qk_bound + (Ft - F2[64 * kt - 1]) - mrun < -THR_FOX);
        }
        if (lane == 0) flg[(kt & 1) * 8 + wid] = wave_done ? 1u : 0u;
        __syncthreads();
        buf ^= 1;
        { unsigned alld = 1u;
#pragma unroll
          for (int w = 0; w < 8; ++w) alld &= flg[(kt & 1) * 8 + w];
          if (alld) break; }
    }
#undef ATT_LOAD
#undef ATT_WRITE
    float inv = 1.f;
    if (MIXER == 1) { const unsigned lu = __builtin_bit_cast(unsigned, lsum); const auto rr = __builtin_amdgcn_permlane32_swap(lu, lu, false, false);
        inv = 1.f / (__builtin_bit_cast(float, (unsigned)rr[0]) + __builtin_bit_cast(float, (unsigned)rr[1])); }
    bf16_t* op = O + (rowbase + tq) * 2048 + 4 * hh;
#pragma unroll
    for (int d = 0; d < 4; ++d)
#pragma unroll
        for (int g = 0; g < 4; ++g) { u32x2 w; w.x = pk2(oacc[d][4 * g] * inv, oacc[d][4 * g + 1] * inv); w.y = pk2(oacc[d][4 * g + 2] * inv, oacc[d][4 * g + 3] * inv);
            *(u32x2*)(op + 32 * d + 8 * g) = w; }
}

__device__ __forceinline__ void attn_phase(const Params& P, LAS unsigned char* lds, int vcu, int G) {
    const int tid = threadIdx.x, lane = tid & 63, wid = __builtin_amdgcn_readfirstlane(tid >> 6);
    unsigned char* ws = P.ws;
    const bf16_t* QKV = (const bf16_t*)(ws + WS_QKV); const size_t TS = (size_t)T_TOK * 1024;
    bf16_t* OAB = (bf16_t*)(ws + WS_H); const float* LOGF = (const float*)(ws + WS_LOGF);
    unsigned* qctr = (unsigned*)(ws + WS_CTL + 196608);
    const unsigned* KMAXW = (const unsigned*)(ws + WS_CTL + 200704);
    volatile LAS unsigned* uw = (volatile LAS unsigned*)(lds + OFF_UNIT);
    for (;;) {
        if (tid == 0) uw[0] = atomicAdd(qctr, 1u);
        __syncthreads();
        const unsigned u = uw[0];
        __syncthreads();
        if (u >= 1024u) break;
        if (u >= 512u) { quantise_expert_rows(P, (int)(u - 512u) * 64 + wid * 8, 8); continue; }
        const int mixer = (u < 256u) ? 1 : 0, v = (int)(u & 255u), qb = 15 - (v >> 4), bh = v & 15, b = bh >> 3, h = bh & 7;
        if (mixer == 0) {
            attn_unit<0>(lds, QKV, QKV + TS, QKV + 2 * TS, OAB + h * HD, b, h, qb, 0.f, tid, lane, wid);
        } else {
            float k2 = 0.f;
#pragma unroll
            for (int w = 0; w < 4; ++w) k2 += __builtin_bit_cast(float, __hip_atomic_load(KMAXW + bh * 4 + w, __ATOMIC_RELAXED, __HIP_MEMORY_SCOPE_AGENT));
            const float kmax = sqrtf(k2) * 1.01f;
            build_cumf(lds, LOGF, b, h, 256 * (qb + 1), tid, lane, wid);
            attn_unit<1>(lds, QKV + 3 * TS, QKV + 4 * TS, QKV + 5 * TS, OAB + 1024 + h * HD, b, h, qb, kmax, tid, lane, wid);
        }
        __syncthreads();
    }
}
}

namespace peer {
__device__ __forceinline__ unsigned sortable(float f) { const unsigned u = __builtin_bit_cast(unsigned, f); return (u & 0x80000000u) ? ~u : (u | 0x80000000u); }
__device__ __forceinline__ float unsortable(unsigned k) { const unsigned u = (k & 0x80000000u) ? (k & 0x7fffffffu) : ~k; return __builtin_bit_cast(float, u); }
#define CE_DESC(x, y) do { const unsigned hi_ = (x) > (y) ? (x) : (y); const unsigned lo_ = (x) > (y) ? (y) : (x); (x) = hi_; (y) = lo_; } while (0)
template <int B, int N> __device__ __forceinline__ void sort16_desc(unsigned (&a)[N]) {
#pragma unroll
    for (int k = 2; k <= 16; k <<= 1)
#pragma unroll
        for (int j = k >> 1; j > 0; j >>= 1)
#pragma unroll
            for (int i = 0; i < 16; ++i) { const int l = i ^ j; if (l > i) { if ((i & k) == 0) CE_DESC(a[B + i], a[B + l]); else CE_DESC(a[B + l], a[B + i]); } }
}
template <int A, int Bq, int N> __device__ __forceinline__ void merge_top16(unsigned (&a)[N]) {
#pragma unroll
    for (int i = 0; i < 16; ++i) { const unsigned x = a[A + i], y = a[Bq + 15 - i]; a[A + i] = x > y ? x : y; }
#pragma unroll
    for (int j = 8; j > 0; j >>= 1)
#pragma unroll
        for (int i = 0; i < 16; ++i) { const int l = i ^ j; if (l > i) CE_DESC(a[A + i], a[A + l]); }
}

__device__ __forceinline__ void topk_phase(const Params& P, LAS unsigned char* lds, int vcu, int G) {
    const int tid = threadIdx.x, lane = tid & 63, wave = __builtin_amdgcn_readfirstlane(tid >> 6);
    const int c = lane & 31, hh = lane >> 5;
    const int gw = vcu * NWAVES + wave, NGW = G * NWAVES;
    unsigned char* ws = P.ws;
    const bf16_t* Q2 = (const bf16_t*)(ws + WS_Q2); const bf16_t* SKB = (const bf16_t*)(ws + WS_SKB);
    const float* ROWSS = (const float*)(ws + WS_CTL); int* IDS = (int*)(ws + WS_IDS); float* GATES = (float*)(ws + WS_GATES);
    LAS unsigned char* scr = lds + wave * 4096;
    const bool shared_head = (G == 256);
    LAS unsigned char* skl = lds + 32768;
    if (shared_head) { const bf16_t* src = SKB + (size_t)(vcu & 7) * 2 * 128 * 128;
#pragma unroll
        for (int q = 0; q < 8; ++q) { const int ch = tid + 512 * q, row = ch >> 4, cc = ch & 15; *(LAS u32x4*)(skl + row * 272 + cc * 16) = *(const u32x4*)(src + row * 128 + cc * 8); }
        __syncthreads(); }
    for (int task = (shared_head ? (((vcu >> 3) * 8 + wave) * 8 + (vcu & 7)) : gw); task < 2048; task += (shared_head ? 1 << 30 : NGW)) {
        const int tg = task >> 3, hd = task & 7, tok = tg * 32 + c;
#pragma unroll 1
        for (int p = 0; p < 2; ++p) {
            bf16x8 qf[8];
            { const bf16_t* qp = Q2 + (size_t)tok * DM + hd * 256 + p * 128 + 8 * hh;
#pragma unroll
              for (int s = 0; s < 8; ++s) qf[s] = *(const bf16x8*)(qp + 16 * s); }
            unsigned keys[64];
#pragma unroll
            for (int sub = 0; sub < 4; ++sub) {
                f32x16 acc;
#pragma unroll
                for (int r = 0; r < 16; ++r) acc[r] = 0.f;
                const bf16_t* kp = SKB + ((size_t)(hd * 2 + p) * 128 + 32 * sub + c) * 128 + 8 * hh;
#pragma unroll
                for (int s = 0; s < 8; ++s) { const bf16x8 kf = shared_head ? *(const LAS bf16x8*)(skl + (p * 128 + 32 * sub + c) * 272 + (16 * s + 8 * hh) * 2) : *(const bf16x8*)(kp + 16 * s); acc = __builtin_amdgcn_mfma_f32_32x32x16_bf16(kf, qf[s], acc, 0, 0, 0); }
#pragma unroll
                for (int r = 0; r < 16; ++r) { const int nlo = 127 - (32 * sub + (r & 3) + 8 * (r >> 2)); keys[sub * 16 + r] = (sortable(acc[r]) & ~127u) | (unsigned)(nlo - 4 * hh); }
            }
            sort16_desc<0>(keys); sort16_desc<16>(keys); sort16_desc<32>(keys); sort16_desc<48>(keys);
            merge_top16<0, 16>(keys); merge_top16<32, 48>(keys); merge_top16<0, 32>(keys);
#pragma unroll
            for (int i = 0; i < 16; ++i) { const unsigned own = keys[i]; const auto rr = __builtin_amdgcn_permlane32_swap(own, own, false, false); keys[16 + i] = hh ? (unsigned)rr[0] : (unsigned)rr[1]; }
            merge_top16<0, 16>(keys);
            if (hh == 0) {
#pragma unroll
                for (int w = 0; w < 4; ++w) *(LAS u32x4*)(scr + (c * 2 + p) * 64 + w * 16) = (u32x4){keys[4 * w], keys[4 * w + 1], keys[4 * w + 2], keys[4 * w + 3]};
            }
        }
        LDS_WAIT();
        float s1[16], s2[16];
#pragma unroll
        for (int w = 0; w < 4; ++w) { const u32x4 a = *(const LAS u32x4*)(scr + (c * 2) * 64 + w * 16), b2 = *(const LAS u32x4*)(scr + (c * 2 + 1) * 64 + w * 16);
#pragma unroll
            for (int e = 0; e < 4; ++e) { s1[4 * w + e] = unsortable((a[e] & ~127u) | 64u); s2[4 * w + e] = unsortable((b2[e] & ~127u) | 64u); } }
        unsigned ck[64];
        { int n = 0;
#pragma unroll
          for (int i = 0; i < 16; ++i)
#pragma unroll
              for (int j = 0; j < 16; ++j) if ((i + 1) * (j + 1) <= 16) { ck[n] = (sortable(s1[i] + s2[j]) & ~255u) | (unsigned)(255 - (i * 16 + j)); ++n; }
#pragma unroll
          for (int q = 50; q < 64; ++q) ck[q] = 0u; }
        sort16_desc<0>(ck); sort16_desc<16>(ck); sort16_desc<32>(ck); sort16_desc<48>(ck);
        merge_top16<0, 16>(ck); merge_top16<32, 48>(ck); merge_top16<0, 32>(ck);
        unsigned t2[16];
#pragma unroll
        for (int k = 0; k < 16; ++k) t2[k] = ck[k];
        int ids[16]; float sc[16];
#pragma unroll
        for (int k = 0; k < 16; ++k) { const unsigned pos = 255u - (t2[k] & 255u);
            const unsigned k1 = *(const LAS unsigned*)(scr + (c * 2) * 64 + (pos >> 4) * 4), k2 = *(const LAS unsigned*)(scr + (c * 2 + 1) * 64 + (pos & 15u) * 4);
            ids[k] = (int)((127u - (k1 & 127u)) * 128u + (127u - (k2 & 127u))); sc[k] = unsortable((t2[k] & ~255u) | 128u); }
        LDS_WAIT();
        const float rs = 1.0f / sqrtf(ROWSS[tok] * (1.f / DM) + EPS);
        float ev[16], Z = 0.f;
#pragma unroll
        for (int k = 0; k < 16; ++k) { ev[k] = fexp2((sc[k] - sc[0]) * rs * LOG2E); Z += ev[k]; }
        const float iz = 1.f / Z;
        int* ip = IDS + (size_t)tok * 128 + hd * 16; float* gp = GATES + (size_t)tok * 128 + hd * 16;
        if (hh == 0) {
#pragma unroll
            for (int k = 0; k < 8; ++k) { ip[k] = ids[k]; gp[k] = ev[k] * iz; }
        } else {
#pragma unroll
            for (int k = 8; k < 16; ++k) { ip[k] = ids[k]; gp[k] = ev[k] * iz; }
        }
    }
}


__device__ __forceinline__ float dot8(u32x4 a, u32x4 b, float acc) {
    const unsigned a0 = a[0], a1 = a[1], a2 = a[2], a3 = a[3], b0 = b[0], b1 = b[1], b2 = b[2], b3 = b[3];
    acc = __builtin_amdgcn_fdot2_f32_bf16(__builtin_bit_cast(bf16v2, a0), __builtin_bit_cast(bf16v2, b0), acc, false);
    acc = __builtin_amdgcn_fdot2_f32_bf16(__builtin_bit_cast(bf16v2, a1), __builtin_bit_cast(bf16v2, b1), acc, false);
    acc = __builtin_amdgcn_fdot2_f32_bf16(__builtin_bit_cast(bf16v2, a2), __builtin_bit_cast(bf16v2, b2), acc, false);
    acc = __builtin_amdgcn_fdot2_f32_bf16(__builtin_bit_cast(bf16v2, a3), __builtin_bit_cast(bf16v2, b3), acc, false);
    return acc;
}
__device__ __forceinline__ float gelu_tanh(float a) { const float t = 1.5957691216f * (a + 0.044715f * a * a * a); return a * frcp(1.f + fexp2(-LOG2E * t)); }

__device__ __forceinline__ int dot16(u32x4 a, u32x4 b, int acc) {
    acc = __builtin_amdgcn_sdot4((int)a[0], (int)b[0], acc, false); acc = __builtin_amdgcn_sdot4((int)a[1], (int)b[1], acc, false);
    acc = __builtin_amdgcn_sdot4((int)a[2], (int)b[2], acc, false); acc = __builtin_amdgcn_sdot4((int)a[3], (int)b[3], acc, false);
    return acc;
}
__device__ __forceinline__ void gather_sweep(const Params& P, LAS unsigned char* lds, int vcu, int G) {
    const int tid = threadIdx.x, lane = tid & 63, wave = __builtin_amdgcn_readfirstlane(tid >> 6);
    const int gw = vcu * NWAVES + wave, NGW = G * NWAVES;
    const int g = lane >> 3, i = lane & 7;
    unsigned char* ws = P.ws;
    const bf16_t* X1B = (const bf16_t*)(ws + WS_X1B); const float* ROWSS = (const float*)(ws + WS_CTL);
    const int* IDS = (const int*)(ws + WS_IDS); const float* GATES = (const float*)(ws + WS_GATES);
    const unsigned char* EU = ws + WS_EU; const unsigned char* EV = ws + WS_EV;
    const float* SU = (const float*)(ws + WS_SU); const float* SV = (const float*)(ws + WS_SV);
    LAS unsigned char* wl = lds + wave * 16384;
    const bool b2 = (lane >> 2) & 1, b1 = (lane >> 1) & 1, b0 = lane & 1, B2 = (lane >> 5) & 1, B1 = (lane >> 4) & 1, B0 = (lane >> 3) & 1;
    for (int tg = gw; tg < T_TOK / 4; tg += NGW) {
        const int tok0 = tg * 4;
        float hs[4];
#pragma unroll
        for (int j = 0; j < 4; ++j) { const int tok = tok0 + j;
            const float rs = 1.0f / sqrtf(ROWSS[tok] * (1.f / DM) + EPS);
            f32x4 hv[8]; float hmx = 0.f;
#pragma unroll
            for (int q = 0; q < 8; ++q) { const u32x2 xb = *((const u32x2*)(X1B + (size_t)tok * DM) + lane + 64 * q); const f32x4 xv = {bf_lo(xb[0]), bf_hi(xb[0]), bf_lo(xb[1]), bf_hi(xb[1])}; const f32x4 gn = *((const f32x4*)P.g_ffn + lane + 64 * q);
                hv[q] = xv * rs * gn; hmx = fmaxf(hmx, fmaxf(fmaxf(fabsf(hv[q][0]), fabsf(hv[q][1])), fmaxf(fabsf(hv[q][2]), fabsf(hv[q][3])))); }
#pragma unroll
            for (int o = 1; o < 64; o <<= 1) hmx = fmaxf(hmx, __shfl_xor(hmx, o));
            hmx = fmaxf(hmx, 1e-30f); const float hinv = 127.f / hmx; hs[j] = hmx * (1.f / 127.f);
#pragma unroll
            for (int q = 0; q < 8; ++q) { unsigned w = 0;
#pragma unroll
                for (int e = 0; e < 4; ++e) w |= ((unsigned)(int)__builtin_rintf(hv[q][e] * hinv) & 255u) << (8 * e);
                *(LAS unsigned*)(wl + j * 2048 + 4 * (lane + 64 * q)) = w; }
#pragma unroll
            for (int hf = 0; hf < 2; ++hf) { const int k = lane + 64 * hf; const int id = IDS[(size_t)tok * 128 + k];
                *(LAS unsigned*)(wl + 8192 + (j * 128 + k) * 4) = (unsigned)id * 2048u;
                *(LAS float*)(wl + 10240 + (j * 128 + k) * 4) = GATES[(size_t)tok * 128 + k] * SV[id];
                *(LAS float*)(wl + 12288 + (j * 128 + k) * 4) = SU[id]; }
        }
        LDS_WAIT();
        int accu[4][16];
#pragma unroll
        for (int j = 0; j < 4; ++j)
#pragma unroll
            for (int m = 0; m < 16; ++m) accu[j][m] = 0;
#pragma unroll 1
        for (int sl = 0; sl < 16; ++sl) {
            __syncthreads();
            const unsigned char* ub = EU + 128 * sl + 16 * i;
#pragma unroll
            for (int j = 0; j < 4; ++j) {
                const u32x4 hqc = *(const LAS u32x4*)(wl + j * 2048 + 128 * sl + 16 * i);
                u32x4 d[16];
#pragma unroll
                for (int m = 0; m < 16; ++m) { const unsigned off = *(const LAS unsigned*)(wl + 8192 + (j * 128 + 8 * m + g) * 4); d[m] = *(const u32x4*)(ub + off); }
#pragma unroll
                for (int m = 0; m < 16; ++m) accu[j][m] = dot16(d[m], hqc, accu[j][m]);
                __builtin_amdgcn_sched_barrier(0);
            }
        }
        float sw[4];
#pragma unroll
        for (int j = 0; j < 4; ++j) {
            int r1[8], r2[4], r3[2];
#pragma unroll
            for (int m = 0; m < 8; ++m) { const int send = b2 ? accu[j][m] : accu[j][m + 8], keep = b2 ? accu[j][m + 8] : accu[j][m]; r1[m] = keep + __shfl_xor(send, 4); }
#pragma unroll
            for (int m = 0; m < 4; ++m) { const int send = b1 ? r1[m] : r1[m + 4], keep = b1 ? r1[m + 4] : r1[m]; r2[m] = keep + __shfl_xor(send, 2); }
#pragma unroll
            for (int m = 0; m < 2; ++m) { const int send = b0 ? r2[m] : r2[m + 2], keep = b0 ? r2[m + 2] : r2[m]; r3[m] = keep + __shfl_xor(send, 1); }
            float w2[2], wmx = 0.f;
#pragma unroll
            for (int m = 0; m < 2; ++m) { const int k = 16 * i + 8 * m + g;
                const float act = (float)r3[m] * (hs[j] * *(const LAS float*)(wl + 12288 + (j * 128 + k) * 4));
                w2[m] = *(const LAS float*)(wl + 10240 + (j * 128 + k) * 4) * gelu_tanh(act); wmx = fmaxf(wmx, fabsf(w2[m])); }
#pragma unroll
            for (int o = 1; o < 64; o <<= 1) wmx = fmaxf(wmx, __shfl_xor(wmx, o));
            wmx = fmaxf(wmx, 1e-30f); sw[j] = wmx * (1.f / 127.f);
            const float winv = 127.f / wmx;
            const unsigned q0 = (unsigned)(int)__builtin_rintf(w2[0] * winv) & 255u, q1 = (unsigned)(int)__builtin_rintf(w2[1] * winv) & 255u;
            *(LAS unsigned short*)(wl + 14336 + j * 128 + 16 * g + 2 * i) = (unsigned short)(q0 | (q1 << 8));
        }
        LDS_WAIT();
        float ssq[4] = {0.f, 0.f, 0.f, 0.f};
#pragma unroll 1
        for (int sl = 0; sl < 16; ++sl) {
            const unsigned char* vb = EV + 128 * sl + 16 * i;
#pragma unroll
            for (int j = 0; j < 4; ++j) {
                u32x4 d[16];
#pragma unroll
                for (int m = 0; m < 16; ++m) { const unsigned off = *(const LAS unsigned*)(wl + 8192 + (j * 128 + 8 * m + g) * 4); d[m] = *(const u32x4*)(vb + off); }
                const u32x4 wpk = *(const LAS u32x4*)(wl + 14336 + j * 128 + 16 * g);
                int ca[16];
#pragma unroll
                for (int b = 0; b < 16; ++b) ca[b] = 0;
#pragma unroll
                for (int mg = 0; mg < 4; ++mg)
#pragma unroll
                    for (int c4 = 0; c4 < 4; ++c4) { const unsigned r0 = d[4 * mg][c4], r1 = d[4 * mg + 1][c4], r2 = d[4 * mg + 2][c4], r3 = d[4 * mg + 3][c4];
                        const unsigned t0 = __builtin_amdgcn_perm(r1, r0, 0x05010400u), t1 = __builtin_amdgcn_perm(r1, r0, 0x07030602u);
                        const unsigned t2 = __builtin_amdgcn_perm(r3, r2, 0x05010400u), t3 = __builtin_amdgcn_perm(r3, r2, 0x07030602u);
                        const int wq4 = (int)wpk[mg];
                        ca[4 * c4 + 0] = __builtin_amdgcn_sdot4((int)__builtin_amdgcn_perm(t2, t0, 0x05040100u), wq4, ca[4 * c4 + 0], false);
                        ca[4 * c4 + 1] = __builtin_amdgcn_sdot4((int)__builtin_amdgcn_perm(t2, t0, 0x07060302u), wq4, ca[4 * c4 + 1], false);
                        ca[4 * c4 + 2] = __builtin_amdgcn_sdot4((int)__builtin_amdgcn_perm(t3, t1, 0x05040100u), wq4, ca[4 * c4 + 2], false);
                        ca[4 * c4 + 3] = __builtin_amdgcn_sdot4((int)__builtin_amdgcn_perm(t3, t1, 0x07060302u), wq4, ca[4 * c4 + 3], false); }
                int c1[8], c2[4], c3[2];
#pragma unroll
                for (int b = 0; b < 8; ++b) { const int send = B2 ? ca[b] : ca[b + 8], keep = B2 ? ca[b + 8] : ca[b]; c1[b] = keep + __shfl_xor(send, 32); }
#pragma unroll
                for (int b = 0; b < 4; ++b) { const int send = B1 ? c1[b] : c1[b + 4], keep = B1 ? c1[b + 4] : c1[b]; c2[b] = keep + __shfl_xor(send, 16); }
#pragma unroll
                for (int b = 0; b < 2; ++b) { const int send = B0 ? c2[b] : c2[b + 2], keep = B0 ? c2[b + 2] : c2[b]; c3[b] = keep + __shfl_xor(send, 8); }
                const size_t o = (size_t)(tok0 + j) * DM + 128 * sl + 16 * i + 2 * g;
                const unsigned xb = *(const unsigned*)(X1B + o); const f32x2 xv = {bf_lo(xb), bf_hi(xb)};
                const f32x2 x2 = {xv[0] + sw[j] * (float)c3[0], xv[1] + sw[j] * (float)c3[1]};
                ssq[j] += x2[0] * x2[0] + x2[1] * x2[1];
                *(f32x2*)(P.out + o) = x2;
                __builtin_amdgcn_sched_barrier(0);
            }
        }
#pragma unroll
        for (int j = 0; j < 4; ++j) { const float rs2 = 1.0f / sqrtf(wave_sum(ssq[j]) * (1.f / DM) + EPS);
            f32x4* orow = (f32x4*)(P.out + (size_t)(tok0 + j) * DM) + lane;
#pragma unroll
            for (int q = 0; q < 8; ++q) { const f32x4 gn = *((const f32x4*)P.g_final + lane + 64 * q); orow[64 * q] = orow[64 * q] * rs2 * gn; } }
        LDS_WAIT();
    }
}

}


#define XB_TMO      128
#define XB_XCNT(j)  (256  + 64 * (j))
#define XB_XSUB(j)  (1280 + 64 * (j))
#define XB_XGEN(j)  (2304 + 64 * (j))
#define XB_TOP      3328
#define XB_TOPGEN   3392
#define XCD_BAR_WORDS 3456
#define XB_SPIN_CAP (1u << 18)
__device__ __forceinline__ unsigned xb_ld(unsigned* p)              { return __hip_atomic_load(p, __ATOMIC_RELAXED, __HIP_MEMORY_SCOPE_AGENT); }
__device__ __forceinline__ unsigned xb_add(unsigned* p, unsigned v) { return __hip_atomic_fetch_add(p, v, __ATOMIC_RELAXED, __HIP_MEMORY_SCOPE_AGENT); }
__device__ __forceinline__ unsigned xb_xcc_id() { return (unsigned)__builtin_amdgcn_s_getreg((3 << 11) | 20) & 0xFu; }
#define XB_SPIN(cond, bar) do { unsigned _sp = 0; while (cond) { __builtin_amdgcn_s_sleep(1); \
    if ((++_sp & 255u) == 0u) { if (xb_ld(&(bar)[XB_TMO])) break; if (_sp > XB_SPIN_CAP) { atomicAdd(&(bar)[XB_TMO], 1u); break; } } } } while (0)
struct XcdBarrier { unsigned* bar; unsigned x; volatile LAS unsigned* st; };
__device__ __forceinline__ XcdBarrier xcd_barrier_post(unsigned* bar, volatile LAS unsigned* st) {
    XcdBarrier b; b.bar = bar; b.x = xb_xcc_id(); b.st = st;
    if (threadIdx.x == 0) (void)xb_add(&bar[XB_XCNT(b.x)], 1u);
    return b;
}
__device__ __forceinline__ void xcd_barrier_complete(unsigned* bar, unsigned x, unsigned& nloc, unsigned& nx) {
    const unsigned G = gridDim.x * gridDim.y * gridDim.z;
    unsigned sum, cnt, mine, sp = 0u;
    for (;;) {
        sum = 0u; cnt = 0u; mine = 0u;
#pragma unroll
        for (unsigned j = 0; j < 16; ++j) { const unsigned c = xb_ld(&bar[XB_XCNT(j)]); sum += c; cnt += (c > 0u) ? 1u : 0u; mine = (j == x) ? c : mine; }
        if (sum == G) break;
        __builtin_amdgcn_s_sleep(1);
        if ((++sp & 255u) == 0u) { if (xb_ld(&bar[XB_TMO])) break; if (sp > XB_SPIN_CAP) { atomicAdd(&bar[XB_TMO], 1u); break; } }
    }
    nloc = mine > 0u ? mine : 1u; nx = cnt > 0u ? cnt : 1u;
}
__device__ __forceinline__ void xcd_barrier(const XcdBarrier& b) {
    asm volatile("s_waitcnt vmcnt(0)" ::: "memory");
    __syncthreads();
    if (threadIdx.x == 0) {
        unsigned* bar = b.bar;
        __builtin_amdgcn_s_waitcnt(0);
        unsigned nloc = b.st[0], nx = b.st[1];
        if (nloc == 0u) { xcd_barrier_complete(bar, b.x, nloc, nx); b.st[0] = nloc; b.st[1] = nx; }
        const unsigned old = xb_add(&bar[XB_XSUB(b.x)], 1u);
        const unsigned gen = old / nloc;
        if (old + 1u == (gen + 1u) * nloc) {
            __builtin_amdgcn_fence(__ATOMIC_RELEASE, "agent");
            asm volatile("s_waitcnt vmcnt(0)" ::: "memory");
            const unsigned og = xb_add(&bar[XB_TOP], 1u);
            const unsigned tg = og / nx;
            if (og + 1u == (tg + 1u) * nx) xb_add(&bar[XB_TOPGEN], 1u);
            else XB_SPIN(xb_ld(&bar[XB_TOPGEN]) == tg, bar);
            __builtin_amdgcn_fence(__ATOMIC_ACQUIRE, "agent");
            xb_add(&bar[XB_XGEN(b.x)], 1u);
            asm volatile("s_waitcnt vmcnt(0)" ::: "memory");
        } else {
            XB_SPIN(xb_ld(&bar[XB_XGEN(b.x)]) == gen, bar);
            __builtin_amdgcn_fence(__ATOMIC_ACQUIRE, "agent");
            asm volatile("s_waitcnt vmcnt(0)" ::: "memory");
        }
    }
    __syncthreads();
}

__global__ void __launch_bounds__(NTHR, 2) mega_fwd(Params P) {
    extern __shared__ __attribute__((aligned(16))) unsigned char lds_raw[];
    LAS unsigned char* lds = (LAS unsigned char*)lds_raw;
    cg::grid_group grid = cg::this_grid();
    const int G = gridDim.x, bx = blockIdx.x;
    const int vcu = (G % 8 == 0) ? (bx % 8) * (G / 8) + bx / 8 : bx;
    unsigned char* ws = P.ws;
#ifndef ONLY_PHASE
#define ONLY_PHASE -1
#endif
#define IN(k) ((ONLY_PHASE < 0 || ONLY_PHASE == (k)) && P.ph_lo <= (k) && (k) < P.ph_hi)
    volatile LAS unsigned* bst = (volatile LAS unsigned*)(lds + 131072);
    if (threadIdx.x < 16) bst[threadIdx.x] = 0u;
    __syncthreads();
    const XcdBarrier xbar = xcd_barrier_post((unsigned*)(ws + WS_CTL + 131072), bst);
    if (P.ph_lo < 0) grid.sync();
#define SEAM(k) do { if (IN(k) && IN((k) + 1)) xcd_barrier(xbar); } while (0)
    if (IN(0)) { p0a(P, lds, vcu, G); xcd_barrier(xbar); p0b(P, lds, vcu, G); }
    SEAM(0);
    if (IN(1)) {
        pg8::Gemm g{ws + WS_H, ws + WS_WIN, T_TOK, 10240, 2048, 2048, 2048};
        pg8::StaticOrder S; S.init(T_TOK, 10240, G, bx);
        pg8::EpiProj E{(bf16_t*)(ws + WS_QKV), (bf16_t*)(ws + WS_SG), LOG2E * 0.08838834764831845f, (unsigned*)(ws + WS_CTL + 200704), (const float*)(ws + WS_HSC), (const float*)(ws + WS_WSC)};
        pg8::gemm_phase<pg8::EpiProj, true>(lds, g, S, E);
    }
    SEAM(1);
    if (IN(2)) { att::attn_phase(P, lds, vcu, G); __syncthreads(); late_transposes(P, lds, vcu, G); }
    SEAM(2);
    if (IN(3)) {
        pg8::StaticOrder S; S.init(T_TOK, DM, G, bx);
        { pg8::Gemm g{ws + WS_H, ws + WS_WAT, T_TOK, DM, 1024, 4096, 2048};
          pg8::EpiGate<0> E{(const bf16_t*)(ws + WS_SG), (bf16_t*)(ws + WS_TMP), (bf16_t*)(ws + WS_MERGED)};
          pg8::gemm_phase(lds, g, S, E); }
        { pg8::Gemm g{ws + WS_H + 2048, ws + WS_WBT, T_TOK, DM, 1024, 4096, 2048};
          pg8::EpiGate<1> E{(const bf16_t*)(ws + WS_SG) + 2048, (bf16_t*)(ws + WS_TMP), (bf16_t*)(ws + WS_MERGED)};
          pg8::gemm_phase(lds, g, S, E); }
    }
    SEAM(3);
    if (IN(4)) {
        pg8::Gemm g{ws + WS_MERGED, ws + WS_WOUT, T_TOK, DM, 2048, 4096, 4096};
        pg8::StaticOrder S; S.init(T_TOK, DM, G, bx);
        pg8::EpiResid E{P.x, (float*)(ws + WS_X1), (bf16_t*)(ws + WS_X1B), (float*)(ws + WS_CTL)};
        pg8::gemm_phase(lds, g, S, E);
    }
    SEAM(4);
    if (IN(5)) {
        pg8::Gemm g{ws + WS_X1B, ws + WS_WQ, T_TOK, DM, 2048, 4096, 4096};
        pg8::StaticOrder S; S.init(T_TOK, DM, G, bx);
        pg8::EpiPlainBf16 E{(bf16_t*)(ws + WS_Q2)};
        pg8::gemm_phase(lds, g, S, E);
    }
    SEAM(5);
    if (IN(6)) peer::topk_phase(P, lds, vcu, G);
    SEAM(6);
    if (IN(7)) { peer::gather_sweep(P, lds, vcu, G); }
#undef IN
#undef SEAM
}

extern "C" void kernel_launch(void* const* d_in, const int* in_sizes, int n_in, void* d_out, int out_size, void* d_ws, size_t ws_size, hipStream_t stream) {
    static int grid = 0;
    if (grid == 0) {
        if (n_in != 13 || out_size != T_TOK * DM || ws_size < WS_END) { fprintf(stderr, "kernel_launch: unexpected shapes (n_in %d out %d ws %zu)\n", n_in, out_size, ws_size); grid = -1; return; }
        int dev = 0, cus = 0, per_cu = 0;
        if (hipGetDevice(&dev) != hipSuccess || hipDeviceGetAttribute(&cus, hipDeviceAttributeMultiprocessorCount, dev) != hipSuccess) { grid = -1; return; }
        if (hipFuncSetAttribute((const void*)mega_fwd, hipFuncAttributeMaxDynamicSharedMemorySize, LDS_BYTES) != hipSuccess) { fprintf(stderr, "kernel_launch: hipFuncSetAttribute failed\n"); grid = -1; return; }
        if (hipOccupancyMaxActiveBlocksPerMultiprocessor(&per_cu, (const void*)mega_fwd, NTHR, LDS_BYTES) != hipSuccess || per_cu < 1) { fprintf(stderr, "kernel_launch: occupancy query says %d\n", per_cu); grid = -1; return; }
        grid = cus;
    }
    if (grid < 0) return;
    (void)hipMemsetAsync((char*)d_ws + WS_CTL, 0, 1 * MiB, stream);
    Params p{};
    p.x = (const float*)d_in[0]; p.g_mix = (const float*)d_in[1]; p.w_in = (const float*)d_in[2]; p.b_forget = (const float*)d_in[3];
    p.w_a = (const float*)d_in[4]; p.w_b = (const float*)d_in[5]; p.w_out = (const float*)d_in[6]; p.g_ffn = (const float*)d_in[7];
    p.w_query = (const float*)d_in[8]; p.sub_keys = (const float*)d_in[9]; p.e_u = (const float*)d_in[10]; p.e_v = (const float*)d_in[11]; p.g_final = (const float*)d_in[12];
    p.out = (float*)d_out; p.ws = (unsigned char*)d_ws;
#if MK_N_LAUNCHES == 1
    p.ph_lo = 0; p.ph_hi = N_PHASES;
    void* args[] = {&p};
    hipError_t e = hipLaunchCooperativeKernel((const void*)mega_fwd, dim3(grid), dim3(NTHR), args, LDS_BYTES, stream);
    if (e != hipSuccess) fprintf(stderr, "kernel_launch: cooperative launch failed: %s (grid %d)\n", hipGetErrorString(e), grid);
#else
    for (int ph = 0; ph < N_PHASES; ++ph) { p.ph_lo = ph; p.ph_hi = ph + 1; hipLaunchKernelGGL(mega_fwd, dim3(grid), dim3(NTHR), LDS_BYTES, stream, p); }
#endif
}
```

```cpp
#include <hip/hip_runtime.h>
#include <hip/hip_cooperative_groups.h>
#include <cstdio>
#include <cstdint>
namespace cg = cooperative_groups;

#define LAS __attribute__((address_space(3)))
typedef unsigned short bf16_t;
typedef short bf16x8 __attribute__((ext_vector_type(8)));
typedef short s16x4 __attribute__((ext_vector_type(4)));
typedef float f32x2 __attribute__((ext_vector_type(2)));
typedef float f32x4 __attribute__((ext_vector_type(4)));
typedef float f32x16 __attribute__((ext_vector_type(16)));
typedef unsigned u32x2 __attribute__((ext_vector_type(2)));
typedef unsigned u32x4 __attribute__((ext_vector_type(4)));
typedef __bf16 bf16v2 __attribute__((ext_vector_type(2)));
typedef int i32x4 __attribute__((ext_vector_type(4)));

#ifndef WGM1
#define WGM1 4
#endif
#ifndef WGM2
#define WGM2 4
#endif
#ifndef MK_N_LAUNCHES
#define MK_N_LAUNCHES 1
#endif

constexpr int T_TOK = 8192, DM = 2048, SEQ = 4096, HD = 128;
constexpr int NWAVES = 8, NTHR = 512;
constexpr int LDS_BYTES = 147456;
constexpr float LOG2E = 1.4426950408889634f;
constexpr float EPS = 1e-6f;
constexpr int N_PHASES = 8;

constexpr size_t MiB = 1u << 20;
constexpr size_t WS_CTL = 0;
constexpr size_t WS_LOGF = 1 * MiB;
constexpr size_t WS_SKB = 1 * MiB + 512 * 1024;
constexpr size_t WS_HSC = 1 * MiB + 256 * 1024;
constexpr size_t WS_WSC = 1 * MiB + 320 * 1024;
constexpr size_t CTL_CMAX = 262144;
constexpr size_t WS_IDS = 2 * MiB;
constexpr size_t WS_GATES = 6 * MiB;
constexpr size_t WS_WAT = 10 * MiB, WS_WBT = 14 * MiB, WS_WOUT = 18 * MiB, WS_WQ = 26 * MiB, WS_WIN = 34 * MiB;
constexpr size_t WS_H = 74 * MiB;
constexpr size_t WS_QKV = 106 * MiB;
constexpr size_t WS_TMP = 106 * MiB, WS_MERGED = 170 * MiB, WS_Q2 = 106 * MiB;
constexpr size_t WS_SG = 202 * MiB;
constexpr size_t WS_X1B = 202 * MiB;
constexpr size_t WS_X1 = 266 * MiB;
constexpr size_t WS_EU = 330 * MiB, WS_EV = 362 * MiB;
constexpr size_t WS_SU = 394 * MiB, WS_SV = 394 * MiB + 65536;
constexpr size_t WS_END = 395 * MiB;

struct Params {
    const float* x; const float* g_mix; const float* w_in; const float* b_forget; const float* w_a; const float* w_b; const float* w_out;
    const float* g_ffn; const float* w_query; const float* sub_keys; const float* e_u; const float* e_v; const float* g_final;
    float* out; unsigned char* ws; int ph_lo, ph_hi;
};

__device__ __forceinline__ unsigned pk2(float a, float b) { f32x2 v = {a, b}; return __builtin_bit_cast(unsigned, __builtin_convertvector(v, bf16v2)); }
__device__ __forceinline__ float bf_lo(unsigned u) { return __builtin_bit_cast(float, u << 16); }
__device__ __forceinline__ float bf_hi(unsigned u) { return __builtin_bit_cast(float, u & 0xffff0000u); }
__device__ __forceinline__ float fexp2(float x) { return __builtin_amdgcn_exp2f(x); }
__device__ __forceinline__ float flog2(float x) { return __builtin_amdgcn_logf(x); }
__device__ __forceinline__ float frcp(float x) { return __builtin_amdgcn_rcpf(x); }
__device__ __forceinline__ float wave_sum(float v) {
#pragma unroll
    for (int o = 1; o < 64; o <<= 1) v += __shfl_xor(v, o);
    return v;
}
#define LDS_WAIT() asm volatile("s_waitcnt lgkmcnt(0)" ::: "memory")

namespace pg8 {
constexpr int BM = 256, BK = 64, HALF = 128, HTB = HALF * BK * 2, STAGE_BYTES = 8 * HTB, NXCD = 8, WGM = 8;
__host__ __device__ __forceinline__ int lds_byte(int r, int c) { const int st = (r >> 4) * 2 + (c >> 5), rr = r & 15, cc = c & 31, ob = rr * 64 + cc * 2; return st * 1024 + (ob ^ (((ob >> 9) & 1) << 5)); }
__host__ __device__ __forceinline__ void stage_rc(int b, int& R, int& C) { const int st = b / 1024, sb = b % 1024, swz = sb ^ (((sb >> 9) & 1) << 5); R = (st >> 1) * 16 + swz / 64; C = (st & 1) * 32 + (swz % 64) / 2; }
__host__ __device__ __forceinline__ int perm32(int rho) { const int n = rho >> 4, i = rho & 15; return 8 * (i >> 2) + 4 * n + (i & 3); }
struct Unit { int pm, pn; };
struct Gemm { const void* A; const void* Bt; int M, N, K, pa, pb; };
struct StaticOrder {
    int nM, nN, nwg, G, c, wgm;
    __device__ void init(int M, int N, int G_, int c_, int wgm_ = WGM) { nM = M / BM; nN = N / BM; nwg = nM * nN; G = G_; c = c_; wgm = wgm_; }
    __device__ bool next(int i, Unit& u) const {
        const long L = (long)i * G + c; if (L >= nwg) return false;
        int wgid = (int)L; { const int q = nwg / NXCD, r = nwg % NXCD, xcd = wgid % NXCD, off = wgid / NXCD; wgid = (xcd < r ? xcd * (q + 1) : r * (q + 1) + (xcd - r) * q) + off; }
        const int nig = wgm * nN, gid = wgid / nig, fm = gid * wgm, gsz = (nM - fm) < wgm ? (nM - fm) : wgm;
        u.pm = fm + ((wgid % nig) % gsz); u.pn = (wgid % nig) / gsz; return true;
    }
};
template <class Epi, bool I8 = false>
__device__ __forceinline__ void gemm_phase(LAS unsigned char* lds, const Gemm g, const StaticOrder& S, const Epi& E) {
    const int tid = threadIdx.x, wid = __builtin_amdgcn_readfirstlane(tid >> 6), lane = tid & 63, wr = wid >> 2, wc = wid & 3, fr = lane & 15, fq = lane >> 4;
    const int K = g.K, nt = I8 ? K / (2 * BK) : K / BK;
    unsigned voffA[2], voffB[2];
#pragma unroll
    for (int i = 0; i < 2; ++i) { int R, C; stage_rc(tid * 16 + i * 8192, R, C); const int Rb = (R & ~31) + perm32(R & 31);
        voffA[i] = (unsigned)(R * g.pa + C * 2); voffB[i] = (unsigned)(Rb * g.pb + C * 2); }
    const size_t kstep = (size_t)(BK * 2);
    const size_t hstepA = (size_t)HALF * g.pa, hstepB = (size_t)HALF * g.pb;
    const size_t tstepA = 2 * hstepA, tstepB = 2 * hstepB;
    const unsigned ldsw = (unsigned)wid * 1024u;
    const int aoff = lds_byte(wr * 64 + fr, fq * 8), boff = lds_byte(wc * 32 + fr, fq * 8);
#define PG8_SA(b, h) (((b) * 2 + (h)) * HTB)
#define PG8_SB(b, h) ((4 + (b) * 2 + (h)) * HTB)
#define PG8_STAGE(bufoff, gbase, voff) do { _Pragma("unroll") for (int _i = 0; _i < 2; ++_i) \
        __builtin_amdgcn_global_load_lds((const unsigned*)((const char*)(gbase) + (voff)[_i]), (LAS unsigned*)(lds + (bufoff) + ldsw + _i * 8192), 16, 0, 0); } while (0)
#define PG8_LDA(dst, b, h) do { _Pragma("unroll") for (int m = 0; m < 4; ++m) _Pragma("unroll") for (int k = 0; k < 2; ++k) dst[m][k] = *(const LAS bf16x8*)(lds + PG8_SA(b, h) + aoff + m * 2048 + k * 1024); } while (0)
#define PG8_LDB(dst, b, h) do { _Pragma("unroll") for (int n = 0; n < 2; ++n) _Pragma("unroll") for (int k = 0; k < 2; ++k) dst[n][k] = *(const LAS bf16x8*)(lds + PG8_SB(b, h) + boff + n * 2048 + k * 1024); } while (0)
#define PG8_MMA(ai, bj, At, Bt) do { __builtin_amdgcn_s_setprio(1); _Pragma("unroll") for (int m = 0; m < 4; ++m) _Pragma("unroll") for (int n = 0; n < 2; ++n) _Pragma("unroll") for (int k = 0; k < 2; ++k) \
        { if (I8) acc[ai][bj][m][n] = __builtin_bit_cast(f32x4, __builtin_amdgcn_mfma_i32_16x16x64_i8(__builtin_bit_cast(i32x4, Bt[n][k]), __builtin_bit_cast(i32x4, At[m][k]), __builtin_bit_cast(i32x4, acc[ai][bj][m][n]), 0, 0, 0)); \
          else acc[ai][bj][m][n] = __builtin_amdgcn_mfma_f32_16x16x32_bf16(Bt[n][k], At[m][k], acc[ai][bj][m][n], 0, 0, 0); } __builtin_amdgcn_s_setprio(0); } while (0)
#define PG8_WAIT_V(n) asm volatile("s_waitcnt vmcnt(" #n ")" ::: "memory")
#define PG8_WAIT_L(n) asm volatile("s_waitcnt lgkmcnt(" #n ")" ::: "memory")
#define PG8_BAR __builtin_amdgcn_s_barrier()
#define PG8_SCHED __builtin_amdgcn_sched_barrier(0)
    Unit cur, nxt; int ui = 0;
    if (!S.next(0, cur)) return;
    f32x4 acc[2][2][4][2];
#pragma unroll
    for (int a = 0; a < 2; ++a)
#pragma unroll
        for (int b = 0; b < 2; ++b)
#pragma unroll
            for (int m = 0; m < 4; ++m)
#pragma unroll
                for (int n = 0; n < 2; ++n) acc[a][b][m][n] = (f32x4){0.f, 0.f, 0.f, 0.f};
    bf16x8 At[4][2], B0[2][2], B1[2][2];
    const char* cA = (const char*)g.A + (size_t)cur.pm * tstepA; const char* cB = (const char*)g.Bt + (size_t)cur.pn * tstepB;
    PG8_STAGE(PG8_SB(0, 0), cB, voffB); PG8_STAGE(PG8_SA(0, 0), cA, voffA); PG8_STAGE(PG8_SB(0, 1), cB + hstepB, voffB); PG8_STAGE(PG8_SA(0, 1), cA + hstepA, voffA);
    if (wr == 1) PG8_BAR;
    PG8_WAIT_V(4); PG8_BAR;
    PG8_STAGE(PG8_SB(1, 0), cB + kstep, voffB); PG8_STAGE(PG8_SA(1, 0), cA + kstep, voffA); PG8_STAGE(PG8_SB(1, 1), cB + hstepB + kstep, voffB);
    PG8_WAIT_V(6); PG8_BAR;
    for (;;) {
        const bool has_next = S.next(ui + 1, nxt);
        const char* nA = has_next ? (const char*)g.A + (size_t)nxt.pm * tstepA : cA; const char* nB = has_next ? (const char*)g.Bt + (size_t)nxt.pn * tstepB : cB;
        for (int t = 0; t < nt; t += 2) {
            const bool last = (t == nt - 2);
            const char* a1 = cA + (size_t)(t + 1) * kstep;
            const char* a2 = last ? nA : cA + (size_t)(t + 2) * kstep; const char* b2 = last ? nB : cB + (size_t)(t + 2) * kstep;
            const char* a3 = a2 + kstep; const char* b3 = b2 + kstep;
            PG8_LDB(B0, 0, 0); PG8_SCHED; PG8_LDA(At, 0, 0); PG8_STAGE(PG8_SA(1, 1), a1 + hstepA, voffA);
            PG8_WAIT_L(8); PG8_BAR; PG8_WAIT_L(0); PG8_MMA(0, 0, At, B0); PG8_BAR; PG8_SCHED;
            PG8_LDB(B1, 0, 1); PG8_STAGE(PG8_SB(0, 0), b2, voffB);
            PG8_BAR; PG8_WAIT_L(0); PG8_MMA(0, 1, At, B1); PG8_BAR;
            PG8_LDA(At, 0, 1); PG8_STAGE(PG8_SA(0, 0), a2, voffA);
            PG8_BAR; PG8_WAIT_L(0); PG8_MMA(1, 0, At, B0); PG8_BAR; PG8_SCHED;
            PG8_STAGE(PG8_SB(0, 1), b2 + hstepB, voffB);
            PG8_WAIT_V(6); PG8_BAR; PG8_MMA(1, 1, At, B1); PG8_BAR;
            PG8_LDB(B0, 1, 0); PG8_SCHED; PG8_LDA(At, 1, 0); PG8_STAGE(PG8_SA(0, 1), a2 + hstepA, voffA);
            PG8_WAIT_L(8); PG8_BAR; PG8_WAIT_L(0); PG8_MMA(0, 0, At, B0); PG8_BAR; PG8_SCHED;
            PG8_LDB(B1, 1, 1); PG8_STAGE(PG8_SB(1, 0), b3, voffB);
            PG8_BAR; PG8_WAIT_L(0); PG8_MMA(0, 1, At, B1); PG8_BAR;
            PG8_LDA(At, 1, 1); PG8_STAGE(PG8_SA(1, 0), a3, voffA);
            PG8_BAR; PG8_WAIT_L(0); PG8_MMA(1, 0, At, B0); PG8_BAR; PG8_SCHED;
            PG8_STAGE(PG8_SB(1, 1), b3 + hstepB, voffB);
            PG8_WAIT_V(6); PG8_BAR; PG8_MMA(1, 1, At, B1); PG8_BAR;
        }
        E(acc, cur, wr, wc, fr, fq);
        if (!has_next) break;
#pragma unroll
        for (int a = 0; a < 2; ++a)
#pragma unroll
            for (int b = 0; b < 2; ++b)
#pragma unroll
                for (int m = 0; m < 4; ++m)
#pragma unroll
                    for (int n = 0; n < 2; ++n) acc[a][b][m][n] = (f32x4){0.f, 0.f, 0.f, 0.f};
        cur = nxt; cA = nA; cB = nB; ++ui;
    }
    PG8_WAIT_V(0);
    if (wr == 0) PG8_BAR;
    PG8_BAR;
#undef PG8_SA
#undef PG8_SB
#undef PG8_STAGE
#undef PG8_LDA
#undef PG8_LDB
#undef PG8_MMA
#undef PG8_WAIT_V
#undef PG8_WAIT_L
#undef PG8_BAR
#undef PG8_SCHED
}

struct EpiProj {
    bf16_t* qkv; bf16_t* sg; float qscale; unsigned* kmaxw; const float* hsc; const float* wsc;
    __device__ __forceinline__ void operator()(const f32x4 (&acci)[2][2][4][2], const Unit& u, int wr, int wc, int fr, int fq) const {
        const int row0 = u.pm * BM + wr * 64 + fr;
        f32x4 acc[2][2][4][2];
        { f32x4 cs[2][2];
#pragma unroll
          for (int bj = 0; bj < 2; ++bj)
#pragma unroll
              for (int n = 0; n < 2; ++n) cs[bj][n] = *(const f32x4*)(wsc + u.pn * BM + bj * HALF + wc * 32 + 8 * fq + 4 * n);
#pragma unroll
          for (int ai = 0; ai < 2; ++ai)
#pragma unroll
              for (int m = 0; m < 4; ++m) { const float rsc = hsc[row0 + ai * HALF + m * 16];
#pragma unroll
                  for (int bj = 0; bj < 2; ++bj)
#pragma unroll
                      for (int n = 0; n < 2; ++n) { const i32x4 iv = __builtin_bit_cast(i32x4, acci[ai][bj][m][n]);
                          acc[ai][bj][m][n] = (f32x4){(float)iv[0], (float)iv[1], (float)iv[2], (float)iv[3]} * rsc * cs[bj][n]; } } }
        if (u.pn < 24) {
            const int t = u.pn >> 2; bf16_t* base = qkv + (size_t)t * ((size_t)T_TOK * 1024) + (u.pn & 3) * 256 + wc * 32 + 8 * fq;
            const float sc = (t == 0 || t == 3) ? qscale : 1.f;
            if (t == 4) {
#pragma unroll
                for (int bj = 0; bj < 2; ++bj) { float mxv = 0.f;
#pragma unroll
                    for (int ai = 0; ai < 2; ++ai)
#pragma unroll
                        for (int m = 0; m < 4; ++m) { const f32x4 v0 = acc[ai][bj][m][0], v1 = acc[ai][bj][m][1];
                            float ssq = (v0[0] * v0[0] + v0[1] * v0[1]) + (v0[2] * v0[2] + v0[3] * v0[3]) + (v1[0] * v1[0] + v1[1] * v1[1]) + (v1[2] * v1[2] + v1[3] * v1[3]);
                            ssq += __shfl_xor(ssq, 16); ssq += __shfl_xor(ssq, 32); mxv = fmaxf(mxv, ssq); }
#pragma unroll
                    for (int o = 1; o < 16; o <<= 1) mxv = fmaxf(mxv, __shfl_xor(mxv, o));
                    if ((fr | fq) == 0) atomicMax(kmaxw + ((u.pm >> 4) * 8 + (u.pn & 3) * 2 + bj) * 4 + wc, __builtin_bit_cast(unsigned, mxv)); }
            }
#pragma unroll
            for (int ai = 0; ai < 2; ++ai)
#pragma unroll
                for (int m = 0; m < 4; ++m) { bf16_t* rowp = base + (size_t)(row0 + ai * HALF + m * 16) * 1024;
#pragma unroll
                    for (int bj = 0; bj < 2; ++bj) { const f32x4 v0 = acc[ai][bj][m][0] * sc, v1 = acc[ai][bj][m][1] * sc;
                        u32x4 w; w.x = pk2(v0[0], v0[1]); w.y = pk2(v0[2], v0[3]); w.z = pk2(v1[0], v1[1]); w.w = pk2(v1[2], v1[3]);
                        *(u32x4*)(rowp + bj * HALF) = w; } }
        } else {
            bf16_t* base = sg + (u.pn - 24) * 256 + wc * 32 + 8 * fq;
#pragma unroll
            for (int ai = 0; ai < 2; ++ai)
#pragma unroll
                for (int m = 0; m < 4; ++m) { bf16_t* rowp = base + (size_t)(row0 + ai * HALF + m * 16) * 4096;
#pragma unroll
                    for (int bj = 0; bj < 2; ++bj) { float s[8];
#pragma unroll
                        for (int e = 0; e < 4; ++e) { s[e] = frcp(1.f + fexp2(-LOG2E * acc[ai][bj][m][0][e])); s[4 + e] = frcp(1.f + fexp2(-LOG2E * acc[ai][bj][m][1][e])); }
                        u32x4 w; w.x = pk2(s[0], s[1]); w.y = pk2(s[2], s[3]); w.z = pk2(s[4], s[5]); w.w = pk2(s[6], s[7]);
                        *(u32x4*)(rowp + bj * HALF) = w; } }
        }
    }
};
template <int SECOND> struct EpiGate {
    const bf16_t* sg;
    bf16_t* tmp; bf16_t* merged;
    __device__ __forceinline__ void operator()(const f32x4 (&acc)[2][2][4][2], const Unit& u, int wr, int wc, int fr, int fq) const {
        const int row0 = u.pm * BM + wr * 64 + fr, col0 = u.pn * BM + wc * 32 + 8 * fq;
#pragma unroll
        for (int ai = 0; ai < 2; ++ai)
#pragma unroll
            for (int m = 0; m < 4; ++m) { const size_t row = (size_t)(row0 + ai * HALF + m * 16);
#pragma unroll
                for (int bj = 0; bj < 2; ++bj) { const int col = col0 + bj * HALF;
                    const u32x4 gv = *(const u32x4*)(sg + row * 4096 + col);
                    const f32x4 g0 = {bf_lo(gv.x), bf_hi(gv.x), bf_lo(gv.y), bf_hi(gv.y)}, g1 = {bf_lo(gv.z), bf_hi(gv.z), bf_lo(gv.w), bf_hi(gv.w)};
                    f32x4 v0 = acc[ai][bj][m][0] * g0, v1 = acc[ai][bj][m][1] * g1;
                    bf16_t* tp = tmp + row * DM + col;
                    if (SECOND == 0) { u32x4 w; w.x = pk2(v0[0], v0[1]); w.y = pk2(v0[2], v0[3]); w.z = pk2(v1[0], v1[1]); w.w = pk2(v1[2], v1[3]); *(u32x4*)tp = w; }
                    else { const u32x4 tv = *(const u32x4*)tp; v0 += (f32x4){bf_lo(tv.x), bf_hi(tv.x), bf_lo(tv.y), bf_hi(tv.y)}; v1 += (f32x4){bf_lo(tv.z), bf_hi(tv.z), bf_lo(tv.w), bf_hi(tv.w)};
                        u32x4 w; w.x = pk2(v0[0], v0[1]); w.y = pk2(v0[2], v0[3]); w.z = pk2(v1[0], v1[1]); w.w = pk2(v1[2], v1[3]);
                        *(u32x4*)(merged + row * DM + col) = w; } } }
    }
};
struct EpiResid {
    const float* x; float* x1; bf16_t* x1b; float* rowss;
    __device__ __forceinline__ void operator()(const f32x4 (&acc)[2][2][4][2], const Unit& u, int wr, int wc, int fr, int fq) const {
        const int row0 = u.pm * BM + wr * 64 + fr, col0 = u.pn * BM + wc * 32 + 8 * fq;
#pragma unroll
        for (int ai = 0; ai < 2; ++ai)
#pragma unroll
            for (int m = 0; m < 4; ++m) { const size_t row = (size_t)(row0 + ai * HALF + m * 16); float ss = 0.f;
#pragma unroll
                for (int bj = 0; bj < 2; ++bj) { const size_t o = row * DM + col0 + bj * HALF;
                    const f32x4 v0 = acc[ai][bj][m][0] + *(const f32x4*)(x + o), v1 = acc[ai][bj][m][1] + *(const f32x4*)(x + o + 4);
                    u32x4 w; w.x = pk2(v0[0], v0[1]); w.y = pk2(v0[2], v0[3]); w.z = pk2(v1[0], v1[1]); w.w = pk2(v1[2], v1[3]);
                    *(u32x4*)(x1b + o) = w;
                    ss += (v0[0] * v0[0] + v0[1] * v0[1]) + (v0[2] * v0[2] + v0[3] * v0[3]) + (v1[0] * v1[0] + v1[1] * v1[1]) + (v1[2] * v1[2] + v1[3] * v1[3]); }
                ss += __shfl_xor(ss, 16); ss += __shfl_xor(ss, 32);
                if (fq == 0) atomicAdd(rowss + row, ss); }
    }
};
struct EpiPlainBf16 {
    bf16_t* o;
    __device__ __forceinline__ void operator()(const f32x4 (&acc)[2][2][4][2], const Unit& u, int wr, int wc, int fr, int fq) const {
        const int row0 = u.pm * BM + wr * 64 + fr, col0 = u.pn * BM + wc * 32 + 8 * fq;
#pragma unroll
        for (int ai = 0; ai < 2; ++ai)
#pragma unroll
            for (int m = 0; m < 4; ++m) { const size_t row = (size_t)(row0 + ai * HALF + m * 16);
#pragma unroll
                for (int bj = 0; bj < 2; ++bj) { const f32x4 v0 = acc[ai][bj][m][0], v1 = acc[ai][bj][m][1];
                    u32x4 w; w.x = pk2(v0[0], v0[1]); w.y = pk2(v0[2], v0[3]); w.z = pk2(v1[0], v1[1]); w.w = pk2(v1[2], v1[3]);
                    *(u32x4*)(o + row * DM + col0 + bj * HALF) = w; } }
    }
};
}

__device__ __forceinline__ void transpose_item(const float* W, int ldw, int src_n0, bf16_t* WT, int K, int dst_n0, int k0, LAS float* scr, int lane, const float* kscale) {
    { const int c4 = (lane & 7) * 4;
      f32x4 v[8];
#pragma unroll
      for (int i = 0; i < 8; ++i) v[i] = *(const f32x4*)(W + (size_t)(k0 + 8 * i + (lane >> 3)) * ldw + src_n0 + c4);
#pragma unroll
      for (int i = 0; i < 8; ++i) { const int kk = 8 * i + (lane >> 3); const float ks = kscale ? kscale[k0 + kk] : 1.f; LAS float* sp = scr + kk * 33 + c4;
          sp[0] = v[i][0] * ks; sp[1] = v[i][1] * ks; sp[2] = v[i][2] * ks; sp[3] = v[i][3] * ks; } }
    LDS_WAIT();
    const int c = lane & 7;
#pragma unroll
    for (int j = 0; j < 4; ++j) { const int n = (lane >> 3) + 8 * j; const LAS float* s = scr + (8 * c) * 33 + n;
        u32x4 o; o.x = pk2(s[0 * 33], s[1 * 33]); o.y = pk2(s[2 * 33], s[3 * 33]); o.z = pk2(s[4 * 33], s[5 * 33]); o.w = pk2(s[6 * 33], s[7 * 33]);
        *(u32x4*)(WT + (size_t)(dst_n0 + n) * K + k0 + 8 * c) = o; }
    LDS_WAIT();
}

__device__ __forceinline__ void p0a(const Params& P, LAS unsigned char* lds, int vcu, int G) {
    const int tid = threadIdx.x, lane = tid & 63, wave = __builtin_amdgcn_readfirstlane(tid >> 6);
    const int gw = vcu * NWAVES + wave, NGW = G * NWAVES;
    unsigned char* ws = P.ws;
    {
        unsigned* CMAX = (unsigned*)(ws + WS_CTL + CTL_CMAX);
        constexpr int NCB = (10248 + 255) / 256;
        for (int it = gw; it < 128 * NCB; it += NGW) { const int kb = it / NCB, cb = it % NCB, sc = cb * 256 + 4 * lane;
            if (sc < 10248) { f32x4 v[16];
#pragma unroll
                for (int r = 0; r < 16; ++r) v[r] = *(const f32x4*)(P.w_in + (size_t)(kb * 16 + r) * 10248 + sc);
                float m0 = 0.f, m1 = 0.f, m2 = 0.f, m3 = 0.f;
#pragma unroll
                for (int r = 0; r < 16; ++r) { m0 = fmaxf(m0, fabsf(v[r][0])); m1 = fmaxf(m1, fabsf(v[r][1])); m2 = fmaxf(m2, fabsf(v[r][2])); m3 = fmaxf(m3, fabsf(v[r][3])); }
                const float mm[4] = {m0, m1, m2, m3};
#pragma unroll
                for (int e = 0; e < 4; ++e) { const int c = sc + e; const unsigned mb = __float_as_uint(mm[e]);
                    if (c < 6144) atomicMax(CMAX + c, mb); else if (c >= 6152) atomicMax(CMAX + c - 8, mb); } } }
    }
    {
        LAS float* wf = (LAS float*)lds;
        for (int k = tid; k < 2048; k += NTHR) { const f32x4 a0 = *(const f32x4*)(P.w_in + (size_t)k * 10248 + 6144), a1 = *(const f32x4*)(P.w_in + (size_t)k * 10248 + 6148);
            wf[k] = a0[0]; wf[2048 + k] = a0[1]; wf[4096 + k] = a0[2]; wf[6144 + k] = a0[3]; wf[8192 + k] = a1[0]; wf[10240 + k] = a1[1]; wf[12288 + k] = a1[2]; wf[14336 + k] = a1[3]; }
        __syncthreads();
        unsigned char* HQ8 = ws + WS_H; float* HSC = (float*)(ws + WS_HSC); float* LOGF = (float*)(ws + WS_LOGF);
        f32x4 xn[8];
        if (gw < T_TOK) { const f32x4* xr = (const f32x4*)(P.x + (size_t)gw * DM) + lane;
#pragma unroll
            for (int j = 0; j < 8; ++j) xn[j] = xr[64 * j]; }
        for (int r = gw; r < T_TOK; r += NGW) {
            float ss = 0.f, amx = 0.f; f32x4 hv[8];
#pragma unroll
            for (int j = 0; j < 8; ++j) { const f32x4 v = xn[j]; const f32x4 gn = *((const f32x4*)P.g_mix + lane + 64 * j); ss += (v[0] * v[0] + v[1] * v[1]) + (v[2] * v[2] + v[3] * v[3]);
                hv[j] = v * gn; amx = fmaxf(amx, fmaxf(fmaxf(fabsf(hv[j][0]), fabsf(hv[j][1])), fmaxf(fabsf(hv[j][2]), fabsf(hv[j][3])))); }
            if (r + NGW < T_TOK) { const f32x4* xr = (const f32x4*)(P.x + (size_t)(r + NGW) * DM) + lane;
#pragma unroll
                for (int j = 0; j < 8; ++j) xn[j] = xr[64 * j]; }
            const float rstd = 1.0f / sqrtf(wave_sum(ss) * (1.f / DM) + EPS);
#pragma unroll
            for (int o = 1; o < 64; o <<= 1) amx = fmaxf(amx, __shfl_xor(amx, o));
            const float hmax = fmaxf(amx * rstd, 1e-30f), hinv = 127.f / hmax;
            float fl[8];
#pragma unroll
            for (int c = 0; c < 8; ++c) fl[c] = 0.f;
            unsigned* hp = (unsigned*)(HQ8 + (size_t)r * DM) + lane;
#pragma unroll
            for (int j = 0; j < 8; ++j) { const f32x4 h = hv[j] * rstd;
                unsigned w = 0;
#pragma unroll
                for (int e = 0; e < 4; ++e) w |= ((unsigned)(int)__builtin_rintf(h[e] * hinv) & 255u) << (8 * e);
                hp[64 * j] = w;
#pragma unroll
                for (int c = 0; c < 8; ++c) { const f32x4 wv = *((const LAS f32x4*)(wf + c * 2048) + lane + 64 * j); fl[c] += (h[0] * wv[0] + h[1] * wv[1]) + (h[2] * wv[2] + h[3] * wv[3]); }
                __builtin_amdgcn_sched_barrier(0); }
            { const bool b5 = (lane >> 5) & 1, b4 = (lane >> 4) & 1, b3 = (lane >> 3) & 1; float p1[4], p2[2], p3;
#pragma unroll
              for (int q = 0; q < 4; ++q) { const float send = b5 ? fl[q] : fl[q + 4], keep = b5 ? fl[q + 4] : fl[q]; p1[q] = keep + __shfl_xor(send, 32); }
#pragma unroll
              for (int q = 0; q < 2; ++q) { const float send = b4 ? p1[q] : p1[q + 2], keep = b4 ? p1[q + 2] : p1[q]; p2[q] = keep + __shfl_xor(send, 16); }
              { const float send = b3 ? p2[0] : p2[1], keep = b3 ? p2[1] : p2[0]; p3 = keep + __shfl_xor(send, 8); }
              p3 += __shfl_xor(p3, 4); p3 += __shfl_xor(p3, 2); p3 += __shfl_xor(p3, 1);
              if (lane == 0) HSC[r] = hmax * (1.f / 127.f);
              if ((lane & 7) == 0) { const int c = lane >> 3; const float y = p3 + P.b_forget[c]; LOGF[((size_t)(r >> 12) * 8 + c) * SEQ + (r & (SEQ - 1))] = fminf(y, 0.f) - log1pf(expf(-fabsf(y))); } }
        }
    }
    {
        const size_t gid = (size_t)vcu * NTHR + tid, gstride = (size_t)G * NTHR;
        for (size_t i = gid; i < 262144 / 8; i += gstride) { const float* src = P.sub_keys + i * 8; const f32x4 a = *(const f32x4*)src, b = *((const f32x4*)src + 1);
            u32x4 o; o.x = pk2(a[0], a[1]); o.y = pk2(a[2], a[3]); o.z = pk2(b[0], b[1]); o.w = pk2(b[2], b[3]); *(u32x4*)((bf16_t*)(ws + WS_SKB) + i * 8) = o; }
    }
}
__device__ __forceinline__ void p0b(const Params& P, LAS unsigned char* lds, int vcu, int G) {
    const int tid = threadIdx.x, lane = tid & 63, wave = __builtin_amdgcn_readfirstlane(tid >> 6);
    const int gw = vcu * NWAVES + wave, NGW = G * NWAVES;
    unsigned char* ws = P.ws;
    const unsigned* CMAX = (const unsigned*)(ws + WS_CTL + CTL_CMAX); float* WSC = (float*)(ws + WS_WSC); unsigned char* WT8 = ws + WS_WIN;
    LAS float* scr = (LAS float*)(lds + wave * 16384);
    for (int it = gw; it < 32 * 320; it += NGW) {
        const int nb = it >> 5, kb = it & 31, dn = nb * 32, sn = dn < 6144 ? dn : dn + 8, k0 = kb * 64;
        const int c4 = (lane & 7) * 4;
        float inv[4];
#pragma unroll
        for (int e = 0; e < 4; ++e) { const float cm = fmaxf(__uint_as_float(__hip_atomic_load(CMAX + dn + c4 + e, __ATOMIC_RELAXED, __HIP_MEMORY_SCOPE_AGENT)), 1e-30f); inv[e] = 127.f / cm;
            if (kb == 0 && lane < 8) WSC[dn + c4 + e] = cm * (1.f / 127.f); }
        f32x4 v[8];
#pragma unroll
        for (int i = 0; i < 8; ++i) v[i] = *(const f32x4*)(P.w_in + (size_t)(k0 + 8 * i + (lane >> 3)) * 10248 + sn + c4);
#pragma unroll
        for (int i = 0; i < 8; ++i) { LAS float* sp = scr + (8 * i + (lane >> 3)) * 33 + c4; sp[0] = v[i][0] * inv[0]; sp[1] = v[i][1] * inv[1]; sp[2] = v[i][2] * inv[2]; sp[3] = v[i][3] * inv[3]; }
        LDS_WAIT();
        const int c = lane & 3;
#pragma unroll
        for (int j = 0; j < 2; ++j) { const int n = (lane >> 2) + 16 * j; const LAS float* sp = scr + (16 * c) * 33 + n;
            u32x4 o;
#pragma unroll
            for (int w4 = 0; w4 < 4; ++w4) { unsigned w = 0;
#pragma unroll
                for (int e = 0; e < 4; ++e) w |= ((unsigned)(int)fminf(fmaxf(__builtin_rintf(sp[(4 * w4 + e) * 33]), -127.f), 127.f) & 255u) << (8 * e);
                o[w4] = w; }
            *(u32x4*)(WT8 + (size_t)(dn + n) * 2048 + k0 + 16 * c) = o; }
        LDS_WAIT();
    }
}
__device__ __forceinline__ void late_transposes(const Params& P, LAS unsigned char* lds, int vcu, int G) {
    const int tid = threadIdx.x, lane = tid & 63, wave = __builtin_amdgcn_readfirstlane(tid >> 6);
    const int gw = vcu * NWAVES + wave, NGW = G * NWAVES;
    unsigned char* ws = P.ws;
    LAS float* scr = (LAS float*)(lds + wave * 16384);
    constexpr int I_A = 16 * 64, I_O = 32 * 64, NITEMS = 2 * I_A + 2 * I_O;
    for (int it = gw; it < NITEMS; it += NGW) {
        int r = it;
        if (r < I_A) { const int kb = r / 64, nb = r % 64; transpose_item(P.w_a, 2048, nb * 32, (bf16_t*)(ws + WS_WAT), 1024, nb * 32, kb * 64, scr, lane, nullptr); continue; } r -= I_A;
        if (r < I_A) { const int kb = r / 64, nb = r % 64; transpose_item(P.w_b, 2048, nb * 32, (bf16_t*)(ws + WS_WBT), 1024, nb * 32, kb * 64, scr, lane, nullptr); continue; } r -= I_A;
        if (r < I_O) { const int kb = r / 64, nb = r % 64; transpose_item(P.w_out, 2048, nb * 32, (bf16_t*)(ws + WS_WOUT), 2048, nb * 32, kb * 64, scr, lane, nullptr); continue; } r -= I_O;
        { const int kb = r / 64, nb = r % 64; transpose_item(P.w_query, 2048, nb * 32, (bf16_t*)(ws + WS_WQ), 2048, nb * 32, kb * 64, scr, lane, P.g_ffn); }
    }
}
__device__ __forceinline__ void quantise_expert_rows(const Params& P, int r0, int nrows) {
    const int lane = threadIdx.x & 63;
    unsigned char* ws = P.ws;
    float* SU = (float*)(ws + WS_SU); float* SV = (float*)(ws + WS_SV);
    for (int r = r0; r < r0 + nrows; r += 2) {
        f32x4 v[2][8];
#pragma unroll
        for (int t = 0; t < 2; ++t) { const int rr = r + t; const f32x4* src = (const f32x4*)((rr >= 16384 ? P.e_v : P.e_u) + (size_t)(rr & 16383) * DM) + lane;
#pragma unroll
            for (int j = 0; j < 8; ++j) v[t][j] = __builtin_nontemporal_load(src + 64 * j); }
#pragma unroll
        for (int t = 0; t < 2; ++t) { const int rr = r + t; const bool second = rr >= 16384; const int row = rr & 16383;
            float mx = 0.f;
#pragma unroll
            for (int j = 0; j < 8; ++j) mx = fmaxf(mx, fmaxf(fmaxf(fabsf(v[t][j][0]), fabsf(v[t][j][1])), fmaxf(fabsf(v[t][j][2]), fabsf(v[t][j][3]))));
#pragma unroll
            for (int o = 1; o < 64; o <<= 1) mx = fmaxf(mx, __shfl_xor(mx, o));
            mx = fmaxf(mx, 1e-30f);
            const float inv = 127.f / mx;
            unsigned* dst = (unsigned*)(ws + (second ? WS_EV : WS_EU) + (size_t)row * DM) + lane;
#pragma unroll
            for (int j = 0; j < 8; ++j) { unsigned w = 0;
#pragma unroll
                for (int e = 0; e < 4; ++e) { const int q = (int)__builtin_rintf(v[t][j][e] * inv); w |= ((unsigned)q & 255u) << (8 * e); }
                dst[64 * j] = w; }
            if (lane == 0) (second ? SV : SU)[row] = mx * (1.f / 127.f);
        }
    }
}

namespace att {
constexpr int KST = 272, VST = 320;
constexpr int KBUF = 64 * KST, VBUF = 64 * VST;
constexpr int OFF_K = 0, OFF_V = 2 * KBUF, OFF_F = OFF_V + 2 * VBUF, OFF_SC = OFF_F + 4096 * 4;
constexpr int OFF_FLG = OFF_SC + 64, OFF_UNIT = OFF_FLG + 64;
static_assert(OFF_UNIT + 16 <= 131072, "attention LDS");
constexpr float THR_SB = 30.f, THR_FOX = 20.f;

__device__ __forceinline__ void build_cumf(LAS unsigned char* lds, const float* LOGF, int b, int h, int n, int tid, int lane, int wid) {
    LAS float* F2 = (LAS float*)(lds + OFF_F); LAS float* sc = (LAS float*)(lds + OFF_SC);
    const int s0 = tid * 8; float v[8];
    { const f32x4* lp = (const f32x4*)(LOGF + ((size_t)b * 8 + h) * SEQ + s0); f32x4 a0 = {0.f, 0.f, 0.f, 0.f}, a1 = a0; if (s0 < n) { a0 = lp[0]; a1 = lp[1]; }
      v[0] = a0[0] * LOG2E; v[1] = a0[1] * LOG2E; v[2] = a0[2] * LOG2E; v[3] = a0[3] * LOG2E; v[4] = a1[0] * LOG2E; v[5] = a1[1] * LOG2E; v[6] = a1[2] * LOG2E; v[7] = a1[3] * LOG2E; }
#pragma unroll
    for (int i = 1; i < 8; ++i) v[i] += v[i - 1];
    float tot = v[7], inc = tot;
#pragma unroll
    for (int o = 1; o < 64; o <<= 1) { const float t = __shfl_up(inc, o); if (lane >= o) inc += t; }
    if (lane == 63) sc[wid] = inc;
    __syncthreads();
    float base = inc - tot;
#pragma unroll
    for (int w = 0; w < 8; ++w) if (w < wid) base += sc[w];
    if (s0 < n) {
#pragma unroll
        for (int i = 0; i < 8; ++i) F2[s0 + i] = v[i] + base;
    }
    __syncthreads();
}

template <int MIXER>
__device__ __forceinline__ void attn_unit(LAS unsigned char* lds, const bf16_t* Q, const bf16_t* Kg, const bf16_t* Vg, bf16_t* O, int b, int h, int qb, float kmax, int tid, int lane, int wid) {
    const int c = lane & 31, hh = lane >> 5;
    const int t0 = qb * 256 + wid * 32, tq = t0 + c;
    const size_t rowbase = (size_t)b * SEQ;
    size_t qoff = (rowbase + tq) * 1024 + h * HD + 8 * hh;
    f32x16 oacc[4];
#pragma unroll
    for (int d = 0; d < 4; ++d)
#pragma unroll
        for (int r = 0; r < 16; ++r) oacc[d][r] = 0.f;
    float carry = 0.f, mrun = -1e30f, lsum = 0.f; const float nhf = hh ? 0.f : 1.f;
    const LAS float* F2 = (const LAS float*)(lds + OFF_F);
    const float Ft = (MIXER == 1) ? F2[tq] : 0.f;
    float qk_bound = 0.f;
    if (MIXER == 1) { float qs = 0.f;
#pragma unroll
        for (int s2 = 0; s2 < 8; ++s2) { const u32x4 qv = *(const u32x4*)(Q + qoff + 16 * s2);
#pragma unroll
            for (int e = 0; e < 4; ++e) { const float a = bf_lo(qv[e]), b2 = bf_hi(qv[e]); qs += a * a + b2 * b2; } }
        qs += __shfl_xor(qs, 32);
        qk_bound = sqrtf(qs) * kmax; }
    bool wave_done = false;
    volatile LAS unsigned* flg = (volatile LAS unsigned*)(lds + OFF_FLG);
    const int ktmax = 4 * qb + 3;
    const int srow = tid >> 4, scc = tid & 15;
    u32x4 kr[2], vr[2];
#define ATT_LOAD(kt) do { _Pragma("unroll") for (int j = 0; j < 2; ++j) { const size_t g_ = (rowbase + 64 * (kt) + srow + 32 * j) * 1024 + h * HD + scc * 8; \
        kr[j] = *(const u32x4*)(Kg + g_); vr[j] = *(const u32x4*)(Vg + g_); } } while (0)
#define ATT_WRITE(buf) do { _Pragma("unroll") for (int j = 0; j < 2; ++j) { \
        *(LAS u32x4*)(lds + OFF_K + (buf) * KBUF + (srow + 32 * j) * KST + scc * 16) = kr[j]; \
        *(LAS u32x4*)(lds + OFF_V + (buf) * VBUF + (srow + 32 * j) * VST + scc * 16) = vr[j]; } } while (0)
    ATT_LOAD(ktmax); ATT_WRITE(0); __syncthreads();
    int buf = 0;
    for (int kt = ktmax; kt >= 0; --kt) {
        if (kt > 0) ATT_LOAD(kt - 1);
        const bool started = (64 * kt <= t0 + 31);
        if (started && !wave_done) {
            const LAS unsigned char* Kl = lds + OFF_K + buf * KBUF; const LAS unsigned char* Vl = lds + OFF_V + buf * VBUF;
            f32x16 sacc[2];
            asm volatile("" : "+v"(qoff));
            bf16x8 qf[8];
#pragma unroll
            for (int s = 0; s < 8; ++s) qf[s] = *(const bf16x8*)(Q + qoff + 16 * s);
#pragma unroll
            for (int sub = 0; sub < 2; ++sub) {
#pragma unroll
                for (int r = 0; r < 16; ++r) sacc[sub][r] = 0.f;
#pragma unroll
                for (int s = 0; s < 8; ++s) { const bf16x8 kf = *(const LAS bf16x8*)(Kl + (32 * sub + c) * KST + (16 * s + 8 * hh) * 2);
                    sacc[sub] = __builtin_amdgcn_mfma_f32_32x32x16_bf16(kf, qf[s], sacc[sub], 0, 0, 0); }
            }
            const bool need_mask = (64 * kt + 63 >= t0);
            bool tile_dead = false;
            if (MIXER == 0) {
#pragma unroll
                for (int sub = 1; sub >= 0; --sub) {
                    float lb[16];
#pragma unroll
                    for (int r = 0; r < 16; ++r) { const float z = sacc[sub][r]; float l = -flog2(1.f + fexp2(z));
                        if (need_mask) { const int sidx = 64 * kt + 32 * sub + (r & 3) + 8 * (r >> 2) + 4 * hh; l = (sidx < tq) ? l : 0.f; }
                        lb[r] = l; }
                    float Glo[4], Ghi[4];
#pragma unroll
                    for (int g = 0; g < 4; ++g) { lb[4 * g + 2] += lb[4 * g + 3]; lb[4 * g + 1] += lb[4 * g + 2]; lb[4 * g] += lb[4 * g + 1];
                        const unsigned gu = __builtin_bit_cast(unsigned, lb[4 * g]); const auto rr = __builtin_amdgcn_permlane32_swap(gu, gu, false, false);
                        Glo[g] = __builtin_bit_cast(float, (unsigned)rr[0]); Ghi[g] = __builtin_bit_cast(float, (unsigned)rr[1]); }
                    float E[8];
                    E[7] = carry; E[6] = E[7] + Ghi[3]; E[5] = E[6] + Glo[3]; E[4] = E[5] + Ghi[2]; E[3] = E[4] + Glo[2]; E[2] = E[3] + Ghi[1]; E[1] = E[2] + Glo[1]; E[0] = E[1] + Ghi[0];
                    carry = E[0] + Glo[0];
#pragma unroll
                    for (int g = 0; g < 4; ++g) { const float Eo = __builtin_fmaf(nhf, Ghi[g], E[2 * g + 1]);
#pragma unroll
                        for (int i = 0; i < 4; ++i) { const int r = 4 * g + i; float w = fexp2(sacc[sub][r] + lb[r] + Eo);
                            if (need_mask) { const int sidx = 64 * kt + 32 * sub + (r & 3) + 8 * (r >> 2) + 4 * hh; w = (sidx < tq) ? w : 0.f; }
                            sacc[sub][r] = w; } }
                }
            } else {
                float mx = -1e30f;
#pragma unroll
                for (int sub = 0; sub < 2; ++sub)
#pragma unroll
                    for (int g = 0; g < 4; ++g) { const f32x4 fs = *(const LAS f32x4*)(F2 + 64 * kt + 32 * sub + 8 * g + 4 * hh);
#pragma unroll
                        for (int i = 0; i < 4; ++i) { const int r = 4 * g + i; float xv = sacc[sub][r] + (Ft - fs[i]);
                            if (need_mask) { const int sidx = 64 * kt + 32 * sub + 8 * g + 4 * hh + i; xv = (sidx <= tq) ? xv : -1e30f; }
                            sacc[sub][r] = xv; mx = fmaxf(mx, xv); } }
                { const unsigned mu = __builtin_bit_cast(unsigned, mx); const auto rr = __builtin_amdgcn_permlane32_swap(mu, mu, false, false);
                  mx = fmaxf(__builtin_bit_cast(float, (unsigned)rr[0]), __builtin_bit_cast(float, (unsigned)rr[1])); }
                tile_dead = __all(mx - mrun < -THR_FOX);
                if (!tile_dead) {
                const float mnew = fmaxf(mrun, mx);
                const float alpha = fexp2(mrun - mnew);
                float ps = 0.f;
#pragma unroll
                for (int sub = 0; sub < 2; ++sub)
#pragma unroll
                    for (int r = 0; r < 16; ++r) { const float p = fexp2(sacc[sub][r] - mnew); sacc[sub][r] = p; ps += p; }
                lsum = lsum * alpha + ps;
                if (__any(mnew > mrun)) {
#pragma unroll
                    for (int d = 0; d < 4; ++d)
#pragma unroll
                        for (int r = 0; r < 16; ++r) oacc[d][r] *= alpha;
                }
                mrun = mnew;
                }
            }
            if (!tile_dead)
#pragma unroll
            for (int ks = 0; ks < 4; ++ks) { const int sub = ks >> 1, rb = 8 * (ks & 1);
                u32x4 pw; pw.x = pk2(sacc[sub][rb + 0], sacc[sub][rb + 1]); pw.y = pk2(sacc[sub][rb + 2], sacc[sub][rb + 3]); pw.z = pk2(sacc[sub][rb + 4], sacc[sub][rb + 5]); pw.w = pk2(sacc[sub][rb + 6], sacc[sub][rb + 7]);
                const bf16x8 pf = __builtin_bit_cast(bf16x8, pw);
                const LAS unsigned char* vb = Vl + (16 * ks + 4 * hh + ((lane & 15) >> 2)) * VST + (16 * ((lane >> 4) & 1) + 4 * (lane & 3)) * 2;
#pragma unroll
                for (int d = 0; d < 4; ++d) {
                    const s16x4 a0 = __builtin_amdgcn_ds_read_tr16_b64_v4i16((LAS s16x4*)(vb + d * 64));
                    const s16x4 a1 = __builtin_amdgcn_ds_read_tr16_b64_v4i16((LAS s16x4*)(vb + d * 64 + 8 * VST));
                    const bf16x8 af = {a0[0], a0[1], a0[2], a0[3], a1[0], a1[1], a1[2], a1[3]};
                    oacc[d] = __builtin_amdgcn_mfma_f32_32x32x16_bf16(af, pf, oacc[d], 0, 0, 0); }
            }
        }
        if (kt > 0) ATT_WRITE(buf ^ 1);
        if (kt > 0 && started && !wave_done) {
            if (MIXER == 0) wave_done = __all(carry < -THR_SB);
            else wave_done = __all(qk_bound + (Ft - F2[64 * kt - 1]) - mrun < -THR_FOX);
        }
        if (lane == 0) flg[(kt & 1) * 8 + wid] = wave_done ? 1u : 0u;
        __syncthreads();
        buf ^= 1;
        { unsigned alld = 1u;
#pragma unroll
          for (int w = 0; w < 8; ++w) alld &= flg[(kt & 1) * 8 + w];
          if (alld) break; }
    }
#undef ATT_LOAD
#undef ATT_WRITE
    float inv = 1.f;
    if (MIXER == 1) { const unsigned lu = __builtin_bit_cast(unsigned, lsum); const auto rr = __builtin_amdgcn_permlane32_swap(lu, lu, false, false);
        inv = 1.f / (__builtin_bit_cast(float, (unsigned)rr[0]) + __builtin_bit_cast(float, (unsigned)rr[1])); }
    bf16_t* op = O + (rowbase + tq) * 2048 + 4 * hh;
#pragma unroll
    for (int d = 0; d < 4; ++d)
#pragma unroll
        for (int g = 0; g < 4; ++g) { u32x2 w; w.x = pk2(oacc[d][4 * g] * inv, oacc[d][4 * g + 1] * inv); w.y = pk2(oacc[d][4 * g + 2] * inv, oacc[d][4 * g + 3] * inv);
            *(u32x2*)(op + 32 * d + 8 * g) = w; }
}

__device__ __forceinline__ void attn_phase(const Params& P, LAS unsigned char* lds, int vcu, int G) {
    const int tid = threadIdx.x, lane = tid & 63, wid = __builtin_amdgcn_readfirstlane(tid >> 6);
    unsigned char* ws = P.ws;
    const bf16_t* QKV = (const bf16_t*)(ws + WS_QKV); const size_t TS = (size_t)T_TOK * 1024;
    bf16_t* OAB = (bf16_t*)(ws + WS_H); const float* LOGF = (const float*)(ws + WS_LOGF);
    unsigned* qctr = (unsigned*)(ws + WS_CTL + 196608);
    const unsigned* KMAXW = (const unsigned*)(ws + WS_CTL + 200704);
    volatile LAS unsigned* uw = (volatile LAS unsigned*)(lds + OFF_UNIT);
    for (;;) {
        if (tid == 0) uw[0] = atomicAdd(qctr, 1u);
        __syncthreads();
        const unsigned u = uw[0];
        __syncthreads();
        if (u >= 1024u) break;
        if (u >= 512u) { quantise_expert_rows(P, (int)(u - 512u) * 64 + wid * 8, 8); continue; }
        const int mixer = (u < 256u) ? 1 : 0, v = (int)(u & 255u), qb = 15 - (v >> 4), bh = v & 15, b = bh >> 3, h = bh & 7;
        if (mixer == 0) {
            attn_unit<0>(lds, QKV, QKV + TS, QKV + 2 * TS, OAB + h * HD, b, h, qb, 0.f, tid, lane, wid);
        } else {
            float k2 = 0.f;
#pragma unroll
            for (int w = 0; w < 4; ++w) k2 += __builtin_bit_cast(float, __hip_atomic_load(KMAXW + bh * 4 + w, __ATOMIC_RELAXED, __HIP_MEMORY_SCOPE_AGENT));
            const float kmax = sqrtf(k2) * 1.01f;
            build_cumf(lds, LOGF, b, h, 256 * (qb + 1), tid, lane, wid);
            attn_unit<1>(lds, QKV + 3 * TS, QKV + 4 * TS, QKV + 5 * TS, OAB + 1024 + h * HD, b, h, qb, kmax, tid, lane, wid);
        }
        __syncthreads();
    }
}
}

namespace peer {
__device__ __forceinline__ unsigned sortable(float f) { const unsigned u = __builtin_bit_cast(unsigned, f); return (u & 0x80000000u) ? ~u : (u | 0x80000000u); }
__device__ __forceinline__ float unsortable(unsigned k) { const unsigned u = (k & 0x80000000u) ? (k & 0x7fffffffu) : ~k; return __builtin_bit_cast(float, u); }
#define CE_DESC(x, y) do { const unsigned hi_ = (x) > (y) ? (x) : (y); const unsigned lo_ = (x) > (y) ? (y) : (x); (x) = hi_; (y) = lo_; } while (0)
template <int B, int N> __device__ __forceinline__ void sort16_desc(unsigned (&a)[N]) {
#pragma unroll
    for (int k = 2; k <= 16; k <<= 1)
#pragma unroll
        for (int j = k >> 1; j > 0; j >>= 1)
#pragma unroll
            for (int i = 0; i < 16; ++i) { const int l = i ^ j; if (l > i) { if ((i & k) == 0) CE_DESC(a[B + i], a[B + l]); else CE_DESC(a[B + l], a[B + i]); } }
}
template <int A, int Bq, int N> __device__ __forceinline__ void merge_top16(unsigned (&a)[N]) {
#pragma unroll
    for (int i = 0; i < 16; ++i) { const unsigned x = a[A + i], y = a[Bq + 15 - i]; a[A + i] = x > y ? x : y; }
#pragma unroll
    for (int j = 8; j > 0; j >>= 1)
#pragma unroll
        for (int i = 0; i < 16; ++i) { const int l = i ^ j; if (l > i) CE_DESC(a[A + i], a[A + l]); }
}

__device__ __forceinline__ void topk_phase(const Params& P, LAS unsigned char* lds, int vcu, int G) {
    const int tid = threadIdx.x, lane = tid & 63, wave = __builtin_amdgcn_readfirstlane(tid >> 6);
    const int c = lane & 31, hh = lane >> 5;
    const int gw = vcu * NWAVES + wave, NGW = G * NWAVES;
    unsigned char* ws = P.ws;
    const bf16_t* Q2 = (const bf16_t*)(ws + WS_Q2); const bf16_t* SKB = (const bf16_t*)(ws + WS_SKB);
    const float* ROWSS = (const float*)(ws + WS_CTL); int* IDS = (int*)(ws + WS_IDS); float* GATES = (float*)(ws + WS_GATES);
    LAS unsigned char* scr = lds + wave * 4096;
    const bool shared_head = (G == 256);
    LAS unsigned char* skl = lds + 32768;
    if (shared_head) { const bf16_t* src = SKB + (size_t)(vcu & 7) * 2 * 128 * 128;
#pragma unroll
        for (int q = 0; q < 8; ++q) { const int ch = tid + 512 * q, row = ch >> 4, cc = ch & 15; *(LAS u32x4*)(skl + row * 272 + cc * 16) = *(const u32x4*)(src + row * 128 + cc * 8); }
        __syncthreads(); }
    for (int task = (shared_head ? (((vcu >> 3) * 8 + wave) * 8 + (vcu & 7)) : gw); task < 2048; task += (shared_head ? 1 << 30 : NGW)) {
        const int tg = task >> 3, hd = task & 7, tok = tg * 32 + c;
#pragma unroll 1
        for (int p = 0; p < 2; ++p) {
            bf16x8 qf[8];
            { const bf16_t* qp = Q2 + (size_t)tok * DM + hd * 256 + p * 128 + 8 * hh;
#pragma unroll
              for (int s = 0; s < 8; ++s) qf[s] = *(const bf16x8*)(qp + 16 * s); }
            unsigned keys[64];
#pragma unroll
            for (int sub = 0; sub < 4; ++sub) {
                f32x16 acc;
#pragma unroll
                for (int r = 0; r < 16; ++r) acc[r] = 0.f;
                const bf16_t* kp = SKB + ((size_t)(hd * 2 + p) * 128 + 32 * sub + c) * 128 + 8 * hh;
#pragma unroll
                for (int s = 0; s < 8; ++s) { const bf16x8 kf = shared_head ? *(const LAS bf16x8*)(skl + (p * 128 + 32 * sub + c) * 272 + (16 * s + 8 * hh) * 2) : *(const bf16x8*)(kp + 16 * s); acc = __builtin_amdgcn_mfma_f32_32x32x16_bf16(kf, qf[s], acc, 0, 0, 0); }
#pragma unroll
                for (int r = 0; r < 16; ++r) { const int nlo = 127 - (32 * sub + (r & 3) + 8 * (r >> 2)); keys[sub * 16 + r] = (sortable(acc[r]) & ~127u) | (unsigned)(nlo - 4 * hh); }
            }
            sort16_desc<0>(keys); sort16_desc<16>(keys); sort16_desc<32>(keys); sort16_desc<48>(keys);
            merge_top16<0, 16>(keys); merge_top16<32, 48>(keys); merge_top16<0, 32>(keys);
#pragma unroll
            for (int i = 0; i < 16; ++i) { const unsigned own = keys[i]; const auto rr = __builtin_amdgcn_permlane32_swap(own, own, false, false); keys[16 + i] = hh ? (unsigned)rr[0] : (unsigned)rr[1]; }
            merge_top16<0, 16>(keys);
            if (hh == 0) {
#pragma unroll
                for (int w = 0; w < 4; ++w) *(LAS u32x4*)(scr + (c * 2 + p) * 64 + w * 16) = (u32x4){keys[4 * w], keys[4 * w + 1], keys[4 * w + 2], keys[4 * w + 3]};
            }
        }
        LDS_WAIT();
        float s1[16], s2[16];
#pragma unroll
        for (int w = 0; w < 4; ++w) { const u32x4 a = *(const LAS u32x4*)(scr + (c * 2) * 64 + w * 16), b2 = *(const LAS u32x4*)(scr + (c * 2 + 1) * 64 + w * 16);
#pragma unroll
            for (int e = 0; e < 4; ++e) { s1[4 * w + e] = unsortable((a[e] & ~127u) | 64u); s2[4 * w + e] = unsortable((b2[e] & ~127u) | 64u); } }
        unsigned ck[64];
        { int n = 0;
#pragma unroll
          for (int i = 0; i < 16; ++i)
#pragma unroll
              for (int j = 0; j < 16; ++j) if ((i + 1) * (j + 1) <= 16) { ck[n] = (sortable(s1[i] + s2[j]) & ~255u) | (unsigned)(255 - (i * 16 + j)); ++n; }
#pragma unroll
          for (int q = 50; q < 64; ++q) ck[q] = 0u; }
        sort16_desc<0>(ck); sort16_desc<16>(ck); sort16_desc<32>(ck); sort16_desc<48>(ck);
        merge_top16<0, 16>(ck); merge_top16<32, 48>(ck); merge_top16<0, 32>(ck);
        unsigned t2[16];
#pragma unroll
        for (int k = 0; k < 16; ++k) t2[k] = ck[k];
        int ids[16]; float sc[16];
#pragma unroll
        for (int k = 0; k < 16; ++k) { const unsigned pos = 255u - (t2[k] & 255u);
            const unsigned k1 = *(const LAS unsigned*)(scr + (c * 2) * 64 + (pos >> 4) * 4), k2 = *(const LAS unsigned*)(scr + (c * 2 + 1) * 64 + (pos & 15u) * 4);
            ids[k] = (int)((127u - (k1 & 127u)) * 128u + (127u - (k2 & 127u))); sc[k] = unsortable((t2[k] & ~255u) | 128u); }
        LDS_WAIT();
        const float rs = 1.0f / sqrtf(ROWSS[tok] * (1.f / DM) + EPS);
        float ev[16], Z = 0.f;
#pragma unroll
        for (int k = 0; k < 16; ++k) { ev[k] = fexp2((sc[k] - sc[0]) * rs * LOG2E); Z += ev[k]; }
        const float iz = 1.f / Z;
        int* ip = IDS + (size_t)tok * 128 + hd * 16; float* gp = GATES + (size_t)tok * 128 + hd * 16;
        if (hh == 0) {
#pragma unroll
            for (int k = 0; k < 8; ++k) { ip[k] = ids[k]; gp[k] = ev[k] * iz; }
        } else {
#pragma unroll
            for (int k = 8; k < 16; ++k) { ip[k] = ids[k]; gp[k] = ev[k] * iz; }
        }
    }
}


__device__ __forceinline__ float dot8(u32x4 a, u32x4 b, float acc) {
    const unsigned a0 = a[0], a1 = a[1], a2 = a[2], a3 = a[3], b0 = b[0], b1 = b[1], b2 = b[2], b3 = b[3];
    acc = __builtin_amdgcn_fdot2_f32_bf16(__builtin_bit_cast(bf16v2, a0), __builtin_bit_cast(bf16v2, b0), acc, false);
    acc = __builtin_amdgcn_fdot2_f32_bf16(__builtin_bit_cast(bf16v2, a1), __builtin_bit_cast(bf16v2, b1), acc, false);
    acc = __builtin_amdgcn_fdot2_f32_bf16(__builtin_bit_cast(bf16v2, a2), __builtin_bit_cast(bf16v2, b2), acc, false);
    acc = __builtin_amdgcn_fdot2_f32_bf16(__builtin_bit_cast(bf16v2, a3), __builtin_bit_cast(bf16v2, b3), acc, false);
    return acc;
}
__device__ __forceinline__ float gelu_tanh(float a) { const float t = 1.5957691216f * (a + 0.044715f * a * a * a); return a * frcp(1.f + fexp2(-LOG2E * t)); }

__device__ __forceinline__ int dot16(u32x4 a, u32x4 b, int acc) {
    acc = __builtin_amdgcn_sdot4((int)a[0], (int)b[0], acc, false); acc = __builtin_amdgcn_sdot4((int)a[1], (int)b[1], acc, false);
    acc = __builtin_amdgcn_sdot4((int)a[2], (int)b[2], acc, false); acc = __builtin_amdgcn_sdot4((int)a[3], (int)b[3], acc, false);
    return acc;
}
__device__ __forceinline__ void gather_sweep(const Params& P, LAS unsigned char* lds, int vcu, int G) {
    const int tid = threadIdx.x, lane = tid & 63, wave = __builtin_amdgcn_readfirstlane(tid >> 6);
    const int gw = vcu * NWAVES + wave, NGW = G * NWAVES;
    const int g = lane >> 3, i = lane & 7;
    unsigned char* ws = P.ws;
    const bf16_t* X1B = (const bf16_t*)(ws + WS_X1B); const float* ROWSS = (const float*)(ws + WS_CTL);
    const int* IDS = (const int*)(ws + WS_IDS); const float* GATES = (const float*)(ws + WS_GATES);
    const unsigned char* EU = ws + WS_EU; const unsigned char* EV = ws + WS_EV;
    const float* SU = (const float*)(ws + WS_SU); const float* SV = (const float*)(ws + WS_SV);
    LAS unsigned char* wl = lds + wave * 16384;
    const bool b2 = (lane >> 2) & 1, b1 = (lane >> 1) & 1, b0 = lane & 1, B2 = (lane >> 5) & 1, B1 = (lane >> 4) & 1, B0 = (lane >> 3) & 1;
    for (int tg = gw; tg < T_TOK / 4; tg += NGW) {
        const int tok0 = tg * 4;
        float hs[4];
#pragma unroll
        for (int j = 0; j < 4; ++j) { const int tok = tok0 + j;
            const float rs = 1.0f / sqrtf(ROWSS[tok] * (1.f / DM) + EPS);
            f32x4 hv[8]; float hmx = 0.f;
#pragma unroll
            for (int q = 0; q < 8; ++q) { const u32x2 xb = *((const u32x2*)(X1B + (size_t)tok * DM) + lane + 64 * q); const f32x4 xv = {bf_lo(xb[0]), bf_hi(xb[0]), bf_lo(xb[1]), bf_hi(xb[1])}; const f32x4 gn = *((const f32x4*)P.g_ffn + lane + 64 * q);
                hv[q] = xv * rs * gn; hmx = fmaxf(hmx, fmaxf(fmaxf(fabsf(hv[q][0]), fabsf(hv[q][1])), fmaxf(fabsf(hv[q][2]), fabsf(hv[q][3])))); }
#pragma unroll
            for (int o = 1; o < 64; o <<= 1) hmx = fmaxf(hmx, __shfl_xor(hmx, o));
            hmx = fmaxf(hmx, 1e-30f); const float hinv = 127.f / hmx; hs[j] = hmx * (1.f / 127.f);
#pragma unroll
            for (int q = 0; q < 8; ++q) { unsigned w = 0;
#pragma unroll
                for (int e = 0; e < 4; ++e) w |= ((unsigned)(int)__builtin_rintf(hv[q][e] * hinv) & 255u) << (8 * e);
                *(LAS unsigned*)(wl + j * 2048 + 4 * (lane + 64 * q)) = w; }
#pragma unroll
            for (int hf = 0; hf < 2; ++hf) { const int k = lane + 64 * hf; const int id = IDS[(size_t)tok * 128 + k];
                *(LAS unsigned*)(wl + 8192 + (j * 128 + k) * 4) = (unsigned)id * 2048u;
                *(LAS float*)(wl + 10240 + (j * 128 + k) * 4) = GATES[(size_t)tok * 128 + k] * SV[id];
                *(LAS float*)(wl + 12288 + (j * 128 + k) * 4) = SU[id]; }
        }
        LDS_WAIT();
        int accu[4][16];
#pragma unroll
        for (int j = 0; j < 4; ++j)
#pragma unroll
            for (int m = 0; m < 16; ++m) accu[j][m] = 0;
#pragma unroll 1
        for (int sl = 0; sl < 16; ++sl) {
            __syncthreads();
            const unsigned char* ub = EU + 128 * sl + 16 * i;
#pragma unroll
            for (int j = 0; j < 4; ++j) {
                const u32x4 hqc = *(const LAS u32x4*)(wl + j * 2048 + 128 * sl + 16 * i);
                u32x4 d[16];
#pragma unroll
                for (int m = 0; m < 16; ++m) { const unsigned off = *(const LAS unsigned*)(wl + 8192 + (j * 128 + 8 * m + g) * 4); d[m] = *(const u32x4*)(ub + off); }
#pragma unroll
                for (int m = 0; m < 16; ++m) accu[j][m] = dot16(d[m], hqc, accu[j][m]);
                __builtin_amdgcn_sched_barrier(0);
            }
        }
        float sw[4];
#pragma unroll
        for (int j = 0; j < 4; ++j) {
            int r1[8], r2[4], r3[2];
#pragma unroll
            for (int m = 0; m < 8; ++m) { const int send = b2 ? accu[j][m] : accu[j][m + 8], keep = b2 ? accu[j][m + 8] : accu[j][m]; r1[m] = keep + __shfl_xor(send, 4); }
#pragma unroll
            for (int m = 0; m < 4; ++m) { const int send = b1 ? r1[m] : r1[m + 4], keep = b1 ? r1[m + 4] : r1[m]; r2[m] = keep + __shfl_xor(send, 2); }
#pragma unroll
            for (int m = 0; m < 2; ++m) { const int send = b0 ? r2[m] : r2[m + 2], keep = b0 ? r2[m + 2] : r2[m]; r3[m] = keep + __shfl_xor(send, 1); }
            float w2[2], wmx = 0.f;
#pragma unroll
            for (int m = 0; m < 2; ++m) { const int k = 16 * i + 8 * m + g;
                const float act = (float)r3[m] * (hs[j] * *(const LAS float*)(wl + 12288 + (j * 128 + k) * 4));
                w2[m] = *(const LAS float*)(wl + 10240 + (j * 128 + k) * 4) * gelu_tanh(act); wmx = fmaxf(wmx, fabsf(w2[m])); }
#pragma unroll
            for (int o = 1; o < 64; o <<= 1) wmx = fmaxf(wmx, __shfl_xor(wmx, o));
            wmx = fmaxf(wmx, 1e-30f); sw[j] = wmx * (1.f / 127.f);
            const float winv = 127.f / wmx;
            const unsigned q0 = (unsigned)(int)__builtin_rintf(w2[0] * winv) & 255u, q1 = (unsigned)(int)__builtin_rintf(w2[1] * winv) & 255u;
            *(LAS unsigned short*)(wl + 14336 + j * 128 + 16 * g + 2 * i) = (unsigned short)(q0 | (q1 << 8));
        }
        LDS_WAIT();
        float ssq[4] = {0.f, 0.f, 0.f, 0.f};
#pragma unroll 1
        for (int sl = 0; sl < 16; ++sl) {
            const unsigned char* vb = EV + 128 * sl + 16 * i;
#pragma unroll
            for (int j = 0; j < 4; ++j) {
                u32x4 d[16];
#pragma unroll
                for (int m = 0; m < 16; ++m) { const unsigned off = *(const LAS unsigned*)(wl + 8192 + (j * 128 + 8 * m + g) * 4); d[m] = *(const u32x4*)(vb + off); }
                const u32x4 wpk = *(const LAS u32x4*)(wl + 14336 + j * 128 + 16 * g);
                int ca[16];
#pragma unroll
                for (int b = 0; b < 16; ++b) ca[b] = 0;
#pragma unroll
                for (int mg = 0; mg < 4; ++mg)
#pragma unroll
                    for (int c4 = 0; c4 < 4; ++c4) { const unsigned r0 = d[4 * mg][c4], r1 = d[4 * mg + 1][c4], r2 = d[4 * mg + 2][c4], r3 = d[4 * mg + 3][c4];
                        const unsigned t0 = __builtin_amdgcn_perm(r1, r0, 0x05010400u), t1 = __builtin_amdgcn_perm(r1, r0, 0x07030602u);
                        const unsigned t2 = __builtin_amdgcn_perm(r3, r2, 0x05010400u), t3 = __builtin_amdgcn_perm(r3, r2, 0x07030602u);
                        const int wq4 = (int)wpk[mg];
                        ca[4 * c4 + 0] = __builtin_amdgcn_sdot4((int)__builtin_amdgcn_perm(t2, t0, 0x05040100u), wq4, ca[4 * c4 + 0], false);
                        ca[4 * c4 + 1] = __builtin_amdgcn_sdot4((int)__builtin_amdgcn_perm(t2, t0, 0x07060302u), wq4, ca[4 * c4 + 1], false);
                        ca[4 * c4 + 2] = __builtin_amdgcn_sdot4((int)__builtin_amdgcn_perm(t3, t1, 0x05040100u), wq4, ca[4 * c4 + 2], false);
                        ca[4 * c4 + 3] = __builtin_amdgcn_sdot4((int)__builtin_amdgcn_perm(t3, t1, 0x07060302u), wq4, ca[4 * c4 + 3], false); }
                int c1[8], c2[4], c3[2];
#pragma unroll
                for (int b = 0; b < 8; ++b) { const int send = B2 ? ca[b] : ca[b + 8], keep = B2 ? ca[b + 8] : ca[b]; c1[b] = keep + __shfl_xor(send, 32); }
#pragma unroll
                for (int b = 0; b < 4; ++b) { const int send = B1 ? c1[b] : c1[b + 4], keep = B1 ? c1[b + 4] : c1[b]; c2[b] = keep + __shfl_xor(send, 16); }
#pragma unroll
                for (int b = 0; b < 2; ++b) { const int send = B0 ? c2[b] : c2[b + 2], keep = B0 ? c2[b + 2] : c2[b]; c3[b] = keep + __shfl_xor(send, 8); }
                const size_t o = (size_t)(tok0 + j) * DM + 128 * sl + 16 * i + 2 * g;
                const unsigned xb = *(const unsigned*)(X1B + o); const f32x2 xv = {bf_lo(xb), bf_hi(xb)};
                const f32x2 x2 = {xv[0] + sw[j] * (float)c3[0], xv[1] + sw[j] * (float)c3[1]};
                ssq[j] += x2[0] * x2[0] + x2[1] * x2[1];
                *(f32x2*)(P.out + o) = x2;
                __builtin_amdgcn_sched_barrier(0);
            }
        }
#pragma unroll
        for (int j = 0; j < 4; ++j) { const float rs2 = 1.0f / sqrtf(wave_sum(ssq[j]) * (1.f / DM) + EPS);
            f32x4* orow = (f32x4*)(P.out + (size_t)(tok0 + j) * DM) + lane;
#pragma unroll
            for (int q = 0; q < 8; ++q) { const f32x4 gn = *((const f32x4*)P.g_final + lane + 64 * q); orow[64 * q] = orow[64 * q] * rs2 * gn; } }
        LDS_WAIT();
    }
}

}


#define XB_TMO      128
#define XB_XCNT(j)  (256  + 64 * (j))
#define XB_XSUB(j)  (1280 + 64 * (j))
#define XB_XGEN(j)  (2304 + 64 * (j))
#define XB_TOP      3328
#define XB_TOPGEN   3392
#define XCD_BAR_WORDS 3456
#define XB_SPIN_CAP (1u << 18)
__device__ __forceinline__ unsigned xb_ld(unsigned* p)              { return __hip_atomic_load(p, __ATOMIC_RELAXED, __HIP_MEMORY_SCOPE_AGENT); }
__device__ __forceinline__ unsigned xb_add(unsigned* p, unsigned v) { return __hip_atomic_fetch_add(p, v, __ATOMIC_RELAXED, __HIP_MEMORY_SCOPE_AGENT); }
__device__ __forceinline__ unsigned xb_xcc_id() { return (unsigned)__builtin_amdgcn_s_getreg((3 << 11) | 20) & 0xFu; }
#define XB_SPIN(cond, bar) do { unsigned _sp = 0; while (cond) { __builtin_amdgcn_s_sleep(1); \
    if ((++_sp & 255u) == 0u) { if (xb_ld(&(bar)[XB_TMO])) break; if (_sp > XB_SPIN_CAP) { atomicAdd(&(bar)[XB_TMO], 1u); break; } } } } while (0)
struct XcdBarrier { unsigned* bar; unsigned x; volatile LAS unsigned* st; };
__device__ __forceinline__ XcdBarrier xcd_barrier_post(unsigned* bar, volatile LAS unsigned* st) {
    XcdBarrier b; b.bar = bar; b.x = xb_xcc_id(); b.st = st;
    if (threadIdx.x == 0) (void)xb_add(&bar[XB_XCNT(b.x)], 1u);
    return b;
}
__device__ __forceinline__ void xcd_barrier_complete(unsigned* bar, unsigned x, unsigned& nloc, unsigned& nx) {
    const unsigned G = gridDim.x * gridDim.y * gridDim.z;
    unsigned sum, cnt, mine, sp = 0u;
    for (;;) {
        sum = 0u; cnt = 0u; mine = 0u;
#pragma unroll
        for (unsigned j = 0; j < 16; ++j) { const unsigned c = xb_ld(&bar[XB_XCNT(j)]); sum += c; cnt += (c > 0u) ? 1u : 0u; mine = (j == x) ? c : mine; }
        if (sum == G) break;
        __builtin_amdgcn_s_sleep(1);
        if ((++sp & 255u) == 0u) { if (xb_ld(&bar[XB_TMO])) break; if (sp > XB_SPIN_CAP) { atomicAdd(&bar[XB_TMO], 1u); break; } }
    }
    nloc = mine > 0u ? mine : 1u; nx = cnt > 0u ? cnt : 1u;
}
__device__ __forceinline__ void xcd_barrier(const XcdBarrier& b) {
    asm volatile("s_waitcnt vmcnt(0)" ::: "memory");
    __syncthreads();
    if (threadIdx.x == 0) {
        unsigned* bar = b.bar;
        __builtin_amdgcn_s_waitcnt(0);
        unsigned nloc = b.st[0], nx = b.st[1];
        if (nloc == 0u) { xcd_barrier_complete(bar, b.x, nloc, nx); b.st[0] = nloc; b.st[1] = nx; }
        const unsigned old = xb_add(&bar[XB_XSUB(b.x)], 1u);
        const unsigned gen = old / nloc;
        if (old + 1u == (gen + 1u) * nloc) {
            __builtin_amdgcn_fence(__ATOMIC_RELEASE, "agent");
            asm volatile("s_waitcnt vmcnt(0)" ::: "memory");
            const unsigned og = xb_add(&bar[XB_TOP], 1u);
            const unsigned tg = og / nx;
            if (og + 1u == (tg + 1u) * nx) xb_add(&bar[XB_TOPGEN], 1u);
            else XB_SPIN(xb_ld(&bar[XB_TOPGEN]) == tg, bar);
            __builtin_amdgcn_fence(__ATOMIC_ACQUIRE, "agent");
            xb_add(&bar[XB_XGEN(b.x)], 1u);
            asm volatile("s_waitcnt vmcnt(0)" ::: "memory");
        } else {
            XB_SPIN(xb_ld(&bar[XB_XGEN(b.x)]) == gen, bar);
            __builtin_amdgcn_fence(__ATOMIC_ACQUIRE, "agent");
            asm volatile("s_waitcnt vmcnt(0)" ::: "memory");
        }
    }
    __syncthreads();
}

__global__ void __launch_bounds__(NTHR, 2) mega_fwd(Params P) {
    extern __shared__ __attribute__((aligned(16))) unsigned char lds_raw[];
    LAS unsigned char* lds = (LAS unsigned char*)lds_raw;
    cg::grid_group grid = cg::this_grid();
    const int G = gridDim.x, bx = blockIdx.x;
    const int vcu = (G % 8 == 0) ? (bx % 8) * (G / 8) + bx / 8 : bx;
    unsigned char* ws = P.ws;
#ifndef ONLY_PHASE
#define ONLY_PHASE -1
#endif
#define IN(k) ((ONLY_PHASE < 0 || ONLY_PHASE == (k)) && P.ph_lo <= (k) && (k) < P.ph_hi)
    volatile LAS unsigned* bst = (volatile LAS unsigned*)(lds + 131072);
    if (threadIdx.x < 16) bst[threadIdx.x] = 0u;
    __syncthreads();
    const XcdBarrier xbar = xcd_barrier_post((unsigned*)(ws + WS_CTL + 131072), bst);
    if (P.ph_lo < 0) grid.sync();
#define SEAM(k) do { if (IN(k) && IN((k) + 1)) xcd_barrier(xbar); } while (0)
    if (IN(0)) { p0a(P, lds, vcu, G); xcd_barrier(xbar); p0b(P, lds, vcu, G); }
    SEAM(0);
    if (IN(1)) {
        pg8::Gemm g{ws + WS_H, ws + WS_WIN, T_TOK, 10240, 2048, 2048, 2048};
        pg8::StaticOrder S; S.init(T_TOK, 10240, G, bx, WGM1);
        pg8::EpiProj E{(bf16_t*)(ws + WS_QKV), (bf16_t*)(ws + WS_SG), LOG2E * 0.08838834764831845f, (unsigned*)(ws + WS_CTL + 200704), (const float*)(ws + WS_HSC), (const float*)(ws + WS_WSC)};
        pg8::gemm_phase<pg8::EpiProj, true>(lds, g, S, E);
    }
    SEAM(1);
    if (IN(2)) { att::attn_phase(P, lds, vcu, G); __syncthreads(); late_transposes(P, lds, vcu, G); }
    SEAM(2);
    if (IN(3)) {
        pg8::StaticOrder S; S.init(T_TOK, DM, G, bx, WGM2);
        { pg8::Gemm g{ws + WS_H, ws + WS_WAT, T_TOK, DM, 1024, 4096, 2048};
          pg8::EpiGate<0> E{(const bf16_t*)(ws + WS_SG), (bf16_t*)(ws + WS_TMP), (bf16_t*)(ws + WS_MERGED)};
          pg8::gemm_phase(lds, g, S, E); }
        { pg8::Gemm g{ws + WS_H + 2048, ws + WS_WBT, T_TOK, DM, 1024, 4096, 2048};
          pg8::EpiGate<1> E{(const bf16_t*)(ws + WS_SG) + 2048, (bf16_t*)(ws + WS_TMP), (bf16_t*)(ws + WS_MERGED)};
          pg8::gemm_phase(lds, g, S, E); }
    }
    SEAM(3);
    if (IN(4)) {
        pg8::Gemm g{ws + WS_MERGED, ws + WS_WOUT, T_TOK, DM, 2048, 4096, 4096};
        pg8::StaticOrder S; S.init(T_TOK, DM, G, bx, WGM2);
        pg8::EpiResid E{P.x, (float*)(ws + WS_X1), (bf16_t*)(ws + WS_X1B), (float*)(ws + WS_CTL)};
        pg8::gemm_phase(lds, g, S, E);
    }
    SEAM(4);
    if (IN(5)) {
        pg8::Gemm g{ws + WS_X1B, ws + WS_WQ, T_TOK, DM, 2048, 4096, 4096};
        pg8::StaticOrder S; S.init(T_TOK, DM, G, bx, WGM2);
        pg8::EpiPlainBf16 E{(bf16_t*)(ws + WS_Q2)};
        pg8::gemm_phase(lds, g, S, E);
    }
    SEAM(5);
    if (IN(6)) peer::topk_phase(P, lds, vcu, G);
    SEAM(6);
    if (IN(7)) { peer::gather_sweep(P, lds, vcu, G); }
#undef IN
#undef SEAM
}

extern "C" void kernel_launch(void* const* d_in, const int* in_sizes, int n_in, void* d_out, int out_size, void* d_ws, size_t ws_size, hipStream_t stream) {
    static int grid = 0;
    if (grid == 0) {
        if (n_in != 13 || out_size != T_TOK * DM || ws_size < WS_END) { fprintf(stderr, "kernel_launch: unexpected shapes (n_in %d out %d ws %zu)\n", n_in, out_size, ws_size); grid = -1; return; }
        int dev = 0, cus = 0, per_cu = 0;
        if (hipGetDevice(&dev) != hipSuccess || hipDeviceGetAttribute(&cus, hipDeviceAttributeMultiprocessorCount, dev) != hipSuccess) { grid = -1; return; }
        if (hipFuncSetAttribute((const void*)mega_fwd, hipFuncAttributeMaxDynamicSharedMemorySize, LDS_BYTES) != hipSuccess) { fprintf(stderr, "kernel_launch: hipFuncSetAttribute failed\n"); grid = -1; return; }
        if (hipOccupancyMaxActiveBlocksPerMultiprocessor(&per_cu, (const void*)mega_fwd, NTHR, LDS_BYTES) != hipSuccess || per_cu < 1) { fprintf(stderr, "kernel_launch: occupancy query says %d\n", per_cu); grid = -1; return; }
        grid = cus;
    }
    if (grid < 0) return;
    (void)hipMemsetAsync((char*)d_ws + WS_CTL, 0, 1 * MiB, stream);
    Params p{};
    p.x = (const float*)d_in[0]; p.g_mix = (const float*)d_in[1]; p.w_in = (const float*)d_in[2]; p.b_forget = (const float*)d_in[3];
    p.w_a = (const float*)d_in[4]; p.w_b = (const float*)d_in[5]; p.w_out = (const float*)d_in[6]; p.g_ffn = (const float*)d_in[7];
    p.w_query = (const float*)d_in[8]; p.sub_keys = (const float*)d_in[9]; p.e_u = (const float*)d_in[10]; p.e_v = (const float*)d_in[11]; p.g_final = (const float*)d_in[12];
    p.out = (float*)d_out; p.ws = (unsigned char*)d_ws;
#if MK_N_LAUNCHES == 1
    p.ph_lo = 0; p.ph_hi = N_PHASES;
    void* args[] = {&p};
    hipError_t e = hipLaunchCooperativeKernel((const void*)mega_fwd, dim3(grid), dim3(NTHR), args, LDS_BYTES, stream);
    if (e != hipSuccess) fprintf(stderr, "kernel_launch: cooperative launch failed: %s (grid %d)\n", hipGetErrorString(e), grid);
#else
    for (int ph = 0; ph < N_PHASES; ++ph) { p.ph_lo = ph; p.ph_hi = ph + 1; hipLaunchKernelGGL(mega_fwd, dim3(grid), dim3(NTHR), LDS_BYTES, stream, p); }
#endif
}
```

```cpp
#include <hip/hip_runtime.h>
#include <hip/hip_cooperative_groups.h>
#include <cstdio>
#include <cstdint>
namespace cg = cooperative_groups;

#define LAS __attribute__((address_space(3)))
typedef unsigned short bf16_t;
typedef short bf16x8 __attribute__((ext_vector_type(8)));
typedef short s16x4 __attribute__((ext_vector_type(4)));
typedef float f32x2 __attribute__((ext_vector_type(2)));
typedef float f32x4 __attribute__((ext_vector_type(4)));
typedef float f32x16 __attribute__((ext_vector_type(16)));
typedef unsigned u32x2 __attribute__((ext_vector_type(2)));
typedef unsigned u32x4 __attribute__((ext_vector_type(4)));
typedef __bf16 bf16v2 __attribute__((ext_vector_type(2)));
typedef int i32x4 __attribute__((ext_vector_type(4)));

#ifndef WGM1
#define WGM1 4
#endif
#ifndef WGM2
#define WGM2 4
#endif
#ifndef MK_N_LAUNCHES
#define MK_N_LAUNCHES 1
#endif

constexpr int T_TOK = 8192, DM = 2048, SEQ = 4096, HD = 128;
constexpr int NWAVES = 8, NTHR = 512;
constexpr int LDS_BYTES = 147456;
constexpr float LOG2E = 1.4426950408889634f;
constexpr float EPS = 1e-6f;
constexpr int N_PHASES = 8;

constexpr size_t MiB = 1u << 20;
constexpr size_t WS_CTL = 0;
constexpr size_t WS_LOGF = 1 * MiB;
constexpr size_t WS_SKB = 1 * MiB + 512 * 1024;
constexpr size_t WS_HSC = 1 * MiB + 256 * 1024;
constexpr size_t WS_WSC = 1 * MiB + 320 * 1024;
constexpr size_t CTL_CMAX = 262144;
constexpr size_t WS_IDS = 2 * MiB;
constexpr size_t WS_GATES = 6 * MiB;
constexpr size_t WS_WAT = 10 * MiB, WS_WBT = 14 * MiB, WS_WOUT = 18 * MiB, WS_WQ = 26 * MiB, WS_WIN = 34 * MiB;
constexpr size_t WS_H = 74 * MiB;
constexpr size_t WS_QKV = 106 * MiB;
constexpr size_t WS_TMP = 106 * MiB, WS_MERGED = 170 * MiB, WS_Q2 = 106 * MiB;
constexpr size_t WS_SG = 202 * MiB;
constexpr size_t WS_X1B = 202 * MiB;
constexpr size_t WS_X1 = 266 * MiB;
constexpr size_t WS_EU = 330 * MiB, WS_EV = 362 * MiB;
constexpr size_t WS_SU = 394 * MiB, WS_SV = 394 * MiB + 65536;
constexpr size_t WS_END = 395 * MiB;

struct Params {
    const float* x; const float* g_mix; const float* w_in; const float* b_forget; const float* w_a; const float* w_b; const float* w_out;
    const float* g_ffn; const float* w_query; const float* sub_keys; const float* e_u; const float* e_v; const float* g_final;
    float* out; unsigned char* ws; int ph_lo, ph_hi;
};

__device__ __forceinline__ unsigned pk2(float a, float b) { f32x2 v = {a, b}; return __builtin_bit_cast(unsigned, __builtin_convertvector(v, bf16v2)); }
__device__ __forceinline__ float bf_lo(unsigned u) { return __builtin_bit_cast(float, u << 16); }
__device__ __forceinline__ float bf_hi(unsigned u) { return __builtin_bit_cast(float, u & 0xffff0000u); }
__device__ __forceinline__ float fexp2(float x) { return __builtin_amdgcn_exp2f(x); }
__device__ __forceinline__ float flog2(float x) { return __builtin_amdgcn_logf(x); }
__device__ __forceinline__ float frcp(float x) { return __builtin_amdgcn_rcpf(x); }
__device__ __forceinline__ float wave_sum(float v) {
#pragma unroll
    for (int o = 1; o < 64; o <<= 1) v += __shfl_xor(v, o);
    return v;
}
#define LDS_WAIT() asm volatile("s_waitcnt lgkmcnt(0)" ::: "memory")

namespace pg8 {
constexpr int BM = 256, BK = 64, HALF = 128, HTB = HALF * BK * 2, STAGE_BYTES = 8 * HTB, NXCD = 8, WGM = 8;
__host__ __device__ __forceinline__ int lds_byte(int r, int c) { const int st = (r >> 4) * 2 + (c >> 5), rr = r & 15, cc = c & 31, ob = rr * 64 + cc * 2; return st * 1024 + (ob ^ (((ob >> 9) & 1) << 5)); }
__host__ __device__ __forceinline__ void stage_rc(int b, int& R, int& C) { const int st = b / 1024, sb = b % 1024, swz = sb ^ (((sb >> 9) & 1) << 5); R = (st >> 1) * 16 + swz / 64; C = (st & 1) * 32 + (swz % 64) / 2; }
__host__ __device__ __forceinline__ int perm32(int rho) { const int n = rho >> 4, i = rho & 15; return 8 * (i >> 2) + 4 * n + (i & 3); }
struct Unit { int pm, pn; };
struct Gemm { const void* A; const void* Bt; int M, N, K, pa, pb; };
struct StaticOrder {
    int nM, nN, nwg, G, c, wgm;
    __device__ void init(int M, int N, int G_, int c_, int wgm_ = WGM) { nM = M / BM; nN = N / BM; nwg = nM * nN; G = G_; c = c_; wgm = wgm_; }
    __device__ bool next(int i, Unit& u) const {
        const long L = (long)i * G + c; if (L >= nwg) return false;
        int wgid = (int)L; { const int q = nwg / NXCD, r = nwg % NXCD, xcd = wgid % NXCD, off = wgid / NXCD; wgid = (xcd < r ? xcd * (q + 1) : r * (q + 1) + (xcd - r) * q) + off; }
        const int nig = wgm * nN, gid = wgid / nig, fm = gid * wgm, gsz = (nM - fm) < wgm ? (nM - fm) : wgm;
        u.pm = fm + ((wgid % nig) % gsz); u.pn = (wgid % nig) / gsz; return true;
    }
};
template <class Epi, bool I8 = false>
__device__ __forceinline__ void gemm_phase(LAS unsigned char* lds, const Gemm g, const StaticOrder& S, const Epi& E) {
    const int tid = threadIdx.x, wid = __builtin_amdgcn_readfirstlane(tid >> 6), lane = tid & 63, wr = wid >> 2, wc = wid & 3, fr = lane & 15, fq = lane >> 4;
    const int K = g.K, nt = I8 ? K / (2 * BK) : K / BK;
    unsigned voffA[2], voffB[2];
#pragma unroll
    for (int i = 0; i < 2; ++i) { int R, C; stage_rc(tid * 16 + i * 8192, R, C); const int Rb = (R & ~31) + perm32(R & 31);
        voffA[i] = (unsigned)(R * g.pa + C * 2); voffB[i] = (unsigned)(Rb * g.pb + C * 2); }
    const size_t kstep = (size_t)(BK * 2);
    const size_t hstepA = (size_t)HALF * g.pa, hstepB = (size_t)HALF * g.pb;
    const size_t tstepA = 2 * hstepA, tstepB = 2 * hstepB;
    const unsigned ldsw = (unsigned)wid * 1024u;
    const int aoff = lds_byte(wr * 64 + fr, fq * 8), boff = lds_byte(wc * 32 + fr, fq * 8);
#define PG8_SA(b, h) (((b) * 2 + (h)) * HTB)
#define PG8_SB(b, h) ((4 + (b) * 2 + (h)) * HTB)
#define PG8_STAGE(bufoff, gbase, voff) do { _Pragma("unroll") for (int _i = 0; _i < 2; ++_i) \
        __builtin_amdgcn_global_load_lds((const unsigned*)((const char*)(gbase) + (voff)[_i]), (LAS unsigned*)(lds + (bufoff) + ldsw + _i * 8192), 16, 0, 0); } while (0)
#define PG8_LDA(dst, b, h) do { _Pragma("unroll") for (int m = 0; m < 4; ++m) _Pragma("unroll") for (int k = 0; k < 2; ++k) dst[m][k] = *(const LAS bf16x8*)(lds + PG8_SA(b, h) + aoff + m * 2048 + k * 1024); } while (0)
#define PG8_LDB(dst, b, h) do { _Pragma("unroll") for (int n = 0; n < 2; ++n) _Pragma("unroll") for (int k = 0; k < 2; ++k) dst[n][k] = *(const LAS bf16x8*)(lds + PG8_SB(b, h) + boff + n * 2048 + k * 1024); } while (0)
#define PG8_MMA(ai, bj, At, Bt) do { __builtin_amdgcn_s_setprio(1); _Pragma("unroll") for (int m = 0; m < 4; ++m) _Pragma("unroll") for (int n = 0; n < 2; ++n) _Pragma("unroll") for (int k = 0; k < 2; ++k) \
        { if (I8) acc[ai][bj][m][n] = __builtin_bit_cast(f32x4, __builtin_amdgcn_mfma_i32_16x16x64_i8(__builtin_bit_cast(i32x4, Bt[n][k]), __builtin_bit_cast(i32x4, At[m][k]), __builtin_bit_cast(i32x4, acc[ai][bj][m][n]), 0, 0, 0)); \
          else acc[ai][bj][m][n] = __builtin_amdgcn_mfma_f32_16x16x32_bf16(Bt[n][k], At[m][k], acc[ai][bj][m][n], 0, 0, 0); } __builtin_amdgcn_s_setprio(0); } while (0)
#define PG8_WAIT_V(n) asm volatile("s_waitcnt vmcnt(" #n ")" ::: "memory")
#define PG8_WAIT_L(n) asm volatile("s_waitcnt lgkmcnt(" #n ")" ::: "memory")
#define PG8_BAR __builtin_amdgcn_s_barrier()
#define PG8_SCHED __builtin_amdgcn_sched_barrier(0)
    Unit cur, nxt; int ui = 0;
    if (!S.next(0, cur)) return;
    f32x4 acc[2][2][4][2];
#pragma unroll
    for (int a = 0; a < 2; ++a)
#pragma unroll
        for (int b = 0; b < 2; ++b)
#pragma unroll
            for (int m = 0; m < 4; ++m)
#pragma unroll
                for (int n = 0; n < 2; ++n) acc[a][b][m][n] = (f32x4){0.f, 0.f, 0.f, 0.f};
    bf16x8 At[4][2], B0[2][2], B1[2][2];
    const char* cA = (const char*)g.A + (size_t)cur.pm * tstepA; const char* cB = (const char*)g.Bt + (size_t)cur.pn * tstepB;
    PG8_STAGE(PG8_SB(0, 0), cB, voffB); PG8_STAGE(PG8_SA(0, 0), cA, voffA); PG8_STAGE(PG8_SB(0, 1), cB + hstepB, voffB); PG8_STAGE(PG8_SA(0, 1), cA + hstepA, voffA);
    if (wr == 1) PG8_BAR;
    PG8_WAIT_V(4); PG8_BAR;
    PG8_STAGE(PG8_SB(1, 0), cB + kstep, voffB); PG8_STAGE(PG8_SA(1, 0), cA + kstep, voffA); PG8_STAGE(PG8_SB(1, 1), cB + hstepB + kstep, voffB);
    PG8_WAIT_V(6); PG8_BAR;
    for (;;) {
        const bool has_next = S.next(ui + 1, nxt);
        const char* nA = has_next ? (const char*)g.A + (size_t)nxt.pm * tstepA : cA; const char* nB = has_next ? (const char*)g.Bt + (size_t)nxt.pn * tstepB : cB;
        for (int t = 0; t < nt; t += 2) {
            const bool last = (t == nt - 2);
            const char* a1 = cA + (size_t)(t + 1) * kstep;
            const char* a2 = last ? nA : cA + (size_t)(t + 2) * kstep; const char* b2 = last ? nB : cB + (size_t)(t + 2) * kstep;
            const char* a3 = a2 + kstep; const char* b3 = b2 + kstep;
            PG8_LDB(B0, 0, 0); PG8_SCHED; PG8_LDA(At, 0, 0); PG8_STAGE(PG8_SA(1, 1), a1 + hstepA, voffA);
            PG8_WAIT_L(8); PG8_BAR; PG8_WAIT_L(0); PG8_MMA(0, 0, At, B0); PG8_BAR; PG8_SCHED;
            PG8_LDB(B1, 0, 1); PG8_STAGE(PG8_SB(0, 0), b2, voffB);
            PG8_BAR; PG8_WAIT_L(0); PG8_MMA(0, 1, At, B1); PG8_BAR;
            PG8_LDA(At, 0, 1); PG8_STAGE(PG8_SA(0, 0), a2, voffA);
            PG8_BAR; PG8_WAIT_L(0); PG8_MMA(1, 0, At, B0); PG8_BAR; PG8_SCHED;
            PG8_STAGE(PG8_SB(0, 1), b2 + hstepB, voffB);
            PG8_WAIT_V(6); PG8_BAR; PG8_MMA(1, 1, At, B1); PG8_BAR;
            PG8_LDB(B0, 1, 0); PG8_SCHED; PG8_LDA(At, 1, 0); PG8_STAGE(PG8_SA(0, 1), a2 + hstepA, voffA);
            PG8_WAIT_L(8); PG8_BAR; PG8_WAIT_L(0); PG8_MMA(0, 0, At, B0); PG8_BAR; PG8_SCHED;
            PG8_LDB(B1, 1, 1); PG8_STAGE(PG8_SB(1, 0), b3, voffB);
            PG8_BAR; PG8_WAIT_L(0); PG8_MMA(0, 1, At, B1); PG8_BAR;
            PG8_LDA(At, 1, 1); PG8_STAGE(PG8_SA(1, 0), a3, voffA);
            PG8_BAR; PG8_WAIT_L(0); PG8_MMA(1, 0, At, B0); PG8_BAR; PG8_SCHED;
            PG8_STAGE(PG8_SB(1, 1), b3 + hstepB, voffB);
            PG8_WAIT_V(6); PG8_BAR; PG8_MMA(1, 1, At, B1); PG8_BAR;
        }
        E(acc, cur, wr, wc, fr, fq);
        if (!has_next) break;
#pragma unroll
        for (int a = 0; a < 2; ++a)
#pragma unroll
            for (int b = 0; b < 2; ++b)
#pragma unroll
                for (int m = 0; m < 4; ++m)
#pragma unroll
                    for (int n = 0; n < 2; ++n) acc[a][b][m][n] = (f32x4){0.f, 0.f, 0.f, 0.f};
        cur = nxt; cA = nA; cB = nB; ++ui;
    }
    PG8_WAIT_V(0);
    if (wr == 0) PG8_BAR;
    PG8_BAR;
#undef PG8_SA
#undef PG8_SB
#undef PG8_STAGE
#undef PG8_LDA
#undef PG8_LDB
#undef PG8_MMA
#undef PG8_WAIT_V
#undef PG8_WAIT_L
#undef PG8_BAR
#undef PG8_SCHED
}

struct EpiProj {
    bf16_t* qkv; bf16_t* sg; float qscale; unsigned* kmaxw; const float* hsc; const float* wsc;
    __device__ __forceinline__ void operator()(const f32x4 (&acci)[2][2][4][2], const Unit& u, int wr, int wc, int fr, int fq) const {
        const int row0 = u.pm * BM + wr * 64 + fr;
        f32x4 acc[2][2][4][2];
        { f32x4 cs[2][2];
#pragma unroll
          for (int bj = 0; bj < 2; ++bj)
#pragma unroll
              for (int n = 0; n < 2; ++n) cs[bj][n] = *(const f32x4*)(wsc + u.pn * BM + bj * HALF + wc * 32 + 8 * fq + 4 * n);
#pragma unroll
          for (int ai = 0; ai < 2; ++ai)
#pragma unroll
              for (int m = 0; m < 4; ++m) { const float rsc = hsc[row0 + ai * HALF + m * 16];
#pragma unroll
                  for (int bj = 0; bj < 2; ++bj)
#pragma unroll
                      for (int n = 0; n < 2; ++n) { const i32x4 iv = __builtin_bit_cast(i32x4, acci[ai][bj][m][n]);
                          acc[ai][bj][m][n] = (f32x4){(float)iv[0], (float)iv[1], (float)iv[2], (float)iv[3]} * rsc * cs[bj][n]; } } }
        if (u.pn < 24) {
            const int t = u.pn >> 2; bf16_t* base = qkv + (size_t)t * ((size_t)T_TOK * 1024) + (u.pn & 3) * 256 + wc * 32 + 8 * fq;
            const float sc = (t == 0 || t == 3) ? qscale : 1.f;
            if (t == 4) {
#pragma unroll
                for (int bj = 0; bj < 2; ++bj) { float mxv = 0.f;
#pragma unroll
                    for (int ai = 0; ai < 2; ++ai)
#pragma unroll
                        for (int m = 0; m < 4; ++m) { const f32x4 v0 = acc[ai][bj][m][0], v1 = acc[ai][bj][m][1];
                            float ssq = (v0[0] * v0[0] + v0[1] * v0[1]) + (v0[2] * v0[2] + v0[3] * v0[3]) + (v1[0] * v1[0] + v1[1] * v1[1]) + (v1[2] * v1[2] + v1[3] * v1[3]);
                            ssq += __shfl_xor(ssq, 16); ssq += __shfl_xor(ssq, 32); mxv = fmaxf(mxv, ssq); }
#pragma unroll
                    for (int o = 1; o < 16; o <<= 1) mxv = fmaxf(mxv, __shfl_xor(mxv, o));
                    if ((fr | fq) == 0) atomicMax(kmaxw + ((u.pm >> 4) * 8 + (u.pn & 3) * 2 + bj) * 4 + wc, __builtin_bit_cast(unsigned, mxv)); }
            }
#pragma unroll
            for (int ai = 0; ai < 2; ++ai)
#pragma unroll
                for (int m = 0; m < 4; ++m) { bf16_t* rowp = base + (size_t)(row0 + ai * HALF + m * 16) * 1024;
#pragma unroll
                    for (int bj = 0; bj < 2; ++bj) { const f32x4 v0 = acc[ai][bj][m][0] * sc, v1 = acc[ai][bj][m][1] * sc;
                        u32x4 w; w.x = pk2(v0[0], v0[1]); w.y = pk2(v0[2], v0[3]); w.z = pk2(v1[0], v1[1]); w.w = pk2(v1[2], v1[3]);
                        *(u32x4*)(rowp + bj * HALF) = w; } }
        } else {
            bf16_t* base = sg + (u.pn - 24) * 256 + wc * 32 + 8 * fq;
#pragma unroll
            for (int ai = 0; ai < 2; ++ai)
#pragma unroll
                for (int m = 0; m < 4; ++m) { bf16_t* rowp = base + (size_t)(row0 + ai * HALF + m * 16) * 4096;
#pragma unroll
                    for (int bj = 0; bj < 2; ++bj) { float s[8];
#pragma unroll
                        for (int e = 0; e < 4; ++e) { s[e] = frcp(1.f + fexp2(-LOG2E * acc[ai][bj][m][0][e])); s[4 + e] = frcp(1.f + fexp2(-LOG2E * acc[ai][bj][m][1][e])); }
                        u32x4 w; w.x = pk2(s[0], s[1]); w.y = pk2(s[2], s[3]); w.z = pk2(s[4], s[5]); w.w = pk2(s[6], s[7]);
                        *(u32x4*)(rowp + bj * HALF) = w; } }
        }
    }
};
template <int SECOND> struct EpiGate {
    const bf16_t* sg;
    bf16_t* tmp; bf16_t* merged;
    __device__ __forceinline__ void operator()(const f32x4 (&acc)[2][2][4][2], const Unit& u, int wr, int wc, int fr, int fq) const {
        const int row0 = u.pm * BM + wr * 64 + fr, col0 = u.pn * BM + wc * 32 + 8 * fq;
#pragma unroll
        for (int ai = 0; ai < 2; ++ai)
#pragma unroll
            for (int m = 0; m < 4; ++m) { const size_t row = (size_t)(row0 + ai * HALF + m * 16);
#pragma unroll
                for (int bj = 0; bj < 2; ++bj) { const int col = col0 + bj * HALF;
                    const u32x4 gv = *(const u32x4*)(sg + row * 4096 + col);
                    const f32x4 g0 = {bf_lo(gv.x), bf_hi(gv.x), bf_lo(gv.y), bf_hi(gv.y)}, g1 = {bf_lo(gv.z), bf_hi(gv.z), bf_lo(gv.w), bf_hi(gv.w)};
                    f32x4 v0 = acc[ai][bj][m][0] * g0, v1 = acc[ai][bj][m][1] * g1;
                    bf16_t* tp = tmp + row * DM + col;
                    if (SECOND == 0) { u32x4 w; w.x = pk2(v0[0], v0[1]); w.y = pk2(v0[2], v0[3]); w.z = pk2(v1[0], v1[1]); w.w = pk2(v1[2], v1[3]); *(u32x4*)tp = w; }
                    else { const u32x4 tv = *(const u32x4*)tp; v0 += (f32x4){bf_lo(tv.x), bf_hi(tv.x), bf_lo(tv.y), bf_hi(tv.y)}; v1 += (f32x4){bf_lo(tv.z), bf_hi(tv.z), bf_lo(tv.w), bf_hi(tv.w)};
                        u32x4 w; w.x = pk2(v0[0], v0[1]); w.y = pk2(v0[2], v0[3]); w.z = pk2(v1[0], v1[1]); w.w = pk2(v1[2], v1[3]);
                        *(u32x4*)(merged + row * DM + col) = w; } } }
    }
};
struct EpiResid {
    const float* x; float* x1; bf16_t* x1b; float* rowss;
    __device__ __forceinline__ void operator()(const f32x4 (&acc)[2][2][4][2], const Unit& u, int wr, int wc, int fr, int fq) const {
        const int row0 = u.pm * BM + wr * 64 + fr, col0 = u.pn * BM + wc * 32 + 8 * fq;
#pragma unroll
        for (int ai = 0; ai < 2; ++ai)
#pragma unroll
            for (int m = 0; m < 4; ++m) { const size_t row = (size_t)(row0 + ai * HALF + m * 16); float ss = 0.f;
#pragma unroll
                for (int bj = 0; bj < 2; ++bj) { const size_t o = row * DM + col0 + bj * HALF;
                    const f32x4 v0 = acc[ai][bj][m][0] + *(const f32x4*)(x + o), v1 = acc[ai][bj][m][1] + *(const f32x4*)(x + o + 4);
                    u32x4 w; w.x = pk2(v0[0], v0[1]); w.y = pk2(v0[2], v0[3]); w.z = pk2(v1[0], v1[1]); w.w = pk2(v1[2], v1[3]);
                    *(u32x4*)(x1b + o) = w;
                    ss += (v0[0] * v0[0] + v0[1] * v0[1]) + (v0[2] * v0[2] + v0[3] * v0[3]) + (v1[0] * v1[0] + v1[1] * v1[1]) + (v1[2] * v1[2] + v1[3] * v1[3]); }
                ss += __shfl_xor(ss, 16); ss += __shfl_xor(ss, 32);
                if (fq == 0) atomicAdd(rowss + row, ss); }
    }
};
struct EpiPlainBf16 {
    bf16_t* o;
    __device__ __forceinline__ void operator()(const f32x4 (&acc)[2][2][4][2], const Unit& u, int wr, int wc, int fr, int fq) const {
        const int row0 = u.pm * BM + wr * 64 + fr, col0 = u.pn * BM + wc * 32 + 8 * fq;
#pragma unroll
        for (int ai = 0; ai < 2; ++ai)
#pragma unroll
            for (int m = 0; m < 4; ++m) { const size_t row = (size_t)(row0 + ai * HALF + m * 16);
#pragma unroll
                for (int bj = 0; bj < 2; ++bj) { const f32x4 v0 = acc[ai][bj][m][0], v1 = acc[ai][bj][m][1];
                    u32x4 w; w.x = pk2(v0[0], v0[1]); w.y = pk2(v0[2], v0[3]); w.z = pk2(v1[0], v1[1]); w.w = pk2(v1[2], v1[3]);
                    *(u32x4*)(o + row * DM + col0 + bj * HALF) = w; } }
    }
};
}

__device__ __forceinline__ void transpose_item(const float* W, int ldw, int src_n0, bf16_t* WT, int K, int dst_n0, int k0, LAS float* scr, int lane, const float* kscale) {
    { const int c4 = (lane & 7) * 4;
      f32x4 v[8];
#pragma unroll
      for (int i = 0; i < 8; ++i) v[i] = *(const f32x4*)(W + (size_t)(k0 + 8 * i + (lane >> 3)) * ldw + src_n0 + c4);
#pragma unroll
      for (int i = 0; i < 8; ++i) { const int kk = 8 * i + (lane >> 3); const float ks = kscale ? kscale[k0 + kk] : 1.f; LAS float* sp = scr + kk * 33 + c4;
          sp[0] = v[i][0] * ks; sp[1] = v[i][1] * ks; sp[2] = v[i][2] * ks; sp[3] = v[i][3] * ks; } }
    LDS_WAIT();
    const int c = lane & 7;
#pragma unroll
    for (int j = 0; j < 4; ++j) { const int n = (lane >> 3) + 8 * j; const LAS float* s = scr + (8 * c) * 33 + n;
        u32x4 o; o.x = pk2(s[0 * 33], s[1 * 33]); o.y = pk2(s[2 * 33], s[3 * 33]); o.z = pk2(s[4 * 33], s[5 * 33]); o.w = pk2(s[6 * 33], s[7 * 33]);
        *(u32x4*)(WT + (size_t)(dst_n0 + n) * K + k0 + 8 * c) = o; }
    LDS_WAIT();
}

__device__ __forceinline__ void p0a(const Params& P, LAS unsigned char* lds, int vcu, int G) {
    const int tid = threadIdx.x, lane = tid & 63, wave = __builtin_amdgcn_readfirstlane(tid >> 6);
    const int gw = vcu * NWAVES + wave, NGW = G * NWAVES;
    unsigned char* ws = P.ws;
    {
        unsigned* CMAX = (unsigned*)(ws + WS_CTL + CTL_CMAX);
        constexpr int NCB = (10248 + 255) / 256;
        for (int it = gw; it < 128 * NCB; it += NGW) { const int kb = it / NCB, cb = it % NCB, sc = cb * 256 + 4 * lane;
            if (sc < 10248) { f32x4 v[16];
#pragma unroll
                for (int r = 0; r < 16; ++r) v[r] = *(const f32x4*)(P.w_in + (size_t)(kb * 16 + r) * 10248 + sc);
                float m0 = 0.f, m1 = 0.f, m2 = 0.f, m3 = 0.f;
#pragma unroll
                for (int r = 0; r < 16; ++r) { m0 = fmaxf(m0, fabsf(v[r][0])); m1 = fmaxf(m1, fabsf(v[r][1])); m2 = fmaxf(m2, fabsf(v[r][2])); m3 = fmaxf(m3, fabsf(v[r][3])); }
                const float mm[4] = {m0, m1, m2, m3};
#pragma unroll
                for (int e = 0; e < 4; ++e) { const int c = sc + e; const unsigned mb = __float_as_uint(mm[e]);
                    if (c < 6144) atomicMax(CMAX + c, mb); else if (c >= 6152) atomicMax(CMAX + c - 8, mb); } } }
    }
    {
        LAS float* wf = (LAS float*)lds;
        for (int k = tid; k < 2048; k += NTHR) { const f32x4 a0 = *(const f32x4*)(P.w_in + (size_t)k * 10248 + 6144), a1 = *(const f32x4*)(P.w_in + (size_t)k * 10248 + 6148);
            wf[k] = a0[0]; wf[2048 + k] = a0[1]; wf[4096 + k] = a0[2]; wf[6144 + k] = a0[3]; wf[8192 + k] = a1[0]; wf[10240 + k] = a1[1]; wf[12288 + k] = a1[2]; wf[14336 + k] = a1[3]; }
        __syncthreads();
        unsigned char* HQ8 = ws + WS_H; float* HSC = (float*)(ws + WS_HSC); float* LOGF = (float*)(ws + WS_LOGF);
        f32x4 xn[8];
        if (gw < T_TOK) { const f32x4* xr = (const f32x4*)(P.x + (size_t)gw * DM) + lane;
#pragma unroll
            for (int j = 0; j < 8; ++j) xn[j] = xr[64 * j]; }
        for (int r = gw; r < T_TOK; r += NGW) {
            float ss = 0.f, amx = 0.f; f32x4 hv[8];
#pragma unroll
            for (int j = 0; j < 8; ++j) { const f32x4 v = xn[j]; const f32x4 gn = *((const f32x4*)P.g_mix + lane + 64 * j); ss += (v[0] * v[0] + v[1] * v[1]) + (v[2] * v[2] + v[3] * v[3]);
                hv[j] = v * gn; amx = fmaxf(amx, fmaxf(fmaxf(fabsf(hv[j][0]), fabsf(hv[j][1])), fmaxf(fabsf(hv[j][2]), fabsf(hv[j][3])))); }
            if (r + NGW < T_TOK) { const f32x4* xr = (const f32x4*)(P.x + (size_t)(r + NGW) * DM) + lane;
#pragma unroll
                for (int j = 0; j < 8; ++j) xn[j] = xr[64 * j]; }
            const float rstd = 1.0f / sqrtf(wave_sum(ss) * (1.f / DM) + EPS);
#pragma unroll
            for (int o = 1; o < 64; o <<= 1) amx = fmaxf(amx, __shfl_xor(amx, o));
            const float hmax = fmaxf(amx * rstd, 1e-30f), hinv = 127.f / hmax;
            float fl[8];
#pragma unroll
            for (int c = 0; c < 8; ++c) fl[c] = 0.f;
            unsigned* hp = (unsigned*)(HQ8 + (size_t)r * DM) + lane;
#pragma unroll
            for (int j = 0; j < 8; ++j) { const f32x4 h = hv[j] * rstd;
                unsigned w = 0;
#pragma unroll
                for (int e = 0; e < 4; ++e) w |= ((unsigned)(int)__builtin_rintf(h[e] * hinv) & 255u) << (8 * e);
                hp[64 * j] = w;
#pragma unroll
                for (int c = 0; c < 8; ++c) { const f32x4 wv = *((const LAS f32x4*)(wf + c * 2048) + lane + 64 * j); fl[c] += (h[0] * wv[0] + h[1] * wv[1]) + (h[2] * wv[2] + h[3] * wv[3]); }
                __builtin_amdgcn_sched_barrier(0); }
            { const bool b5 = (lane >> 5) & 1, b4 = (lane >> 4) & 1, b3 = (lane >> 3) & 1; float p1[4], p2[2], p3;
#pragma unroll
              for (int q = 0; q < 4; ++q) { const float send = b5 ? fl[q] : fl[q + 4], keep = b5 ? fl[q + 4] : fl[q]; p1[q] = keep + __shfl_xor(send, 32); }
#pragma unroll
              for (int q = 0; q < 2; ++q) { const float send = b4 ? p1[q] : p1[q + 2], keep = b4 ? p1[q + 2] : p1[q]; p2[q] = keep + __shfl_xor(send, 16); }
              { const float send = b3 ? p2[0] : p2[1], keep = b3 ? p2[1] : p2[0]; p3 = keep + __shfl_xor(send, 8); }
              p3 += __shfl_xor(p3, 4); p3 += __shfl_xor(p3, 2); p3 += __shfl_xor(p3, 1);
              if (lane == 0) HSC[r] = hmax * (1.f / 127.f);
              if ((lane & 7) == 0) { const int c = lane >> 3; const float y = p3 + P.b_forget[c]; LOGF[((size_t)(r >> 12) * 8 + c) * SEQ + (r & (SEQ - 1))] = fminf(y, 0.f) - log1pf(expf(-fabsf(y))); } }
        }
    }
    {
        const size_t gid = (size_t)vcu * NTHR + tid, gstride = (size_t)G * NTHR;
        for (size_t i = gid; i < 262144 / 8; i += gstride) { const float* src = P.sub_keys + i * 8; const f32x4 a = *(const f32x4*)src, b = *((const f32x4*)src + 1);
            u32x4 o; o.x = pk2(a[0], a[1]); o.y = pk2(a[2], a[3]); o.z = pk2(b[0], b[1]); o.w = pk2(b[2], b[3]); *(u32x4*)((bf16_t*)(ws + WS_SKB) + i * 8) = o; }
    }
}
__device__ __forceinline__ void p0b(const Params& P, LAS unsigned char* lds, int vcu, int G) {
    const int tid = threadIdx.x, lane = tid & 63, wave = __builtin_amdgcn_readfirstlane(tid >> 6);
    const int gw = vcu * NWAVES + wave, NGW = G * NWAVES;
    unsigned char* ws = P.ws;
    const unsigned* CMAX = (const unsigned*)(ws + WS_CTL + CTL_CMAX); float* WSC = (float*)(ws + WS_WSC); unsigned char* WT8 = ws + WS_WIN;
    LAS float* scr = (LAS float*)(lds + wave * 16384);
    for (int it = gw; it < 32 * 320; it += NGW) {
        const int nb = it >> 5, kb = it & 31, dn = nb * 32, sn = dn < 6144 ? dn : dn + 8, k0 = kb * 64;
        const int c4 = (lane & 7) * 4;
        float inv[4];
#pragma unroll
        for (int e = 0; e < 4; ++e) { const float cm = fmaxf(__uint_as_float(__hip_atomic_load(CMAX + dn + c4 + e, __ATOMIC_RELAXED, __HIP_MEMORY_SCOPE_AGENT)), 1e-30f); inv[e] = 127.f / cm;
            if (kb == 0 && lane < 8) WSC[dn + c4 + e] = cm * (1.f / 127.f); }
        f32x4 v[8];
#pragma unroll
        for (int i = 0; i < 8; ++i) v[i] = *(const f32x4*)(P.w_in + (size_t)(k0 + 8 * i + (lane >> 3)) * 10248 + sn + c4);
#pragma unroll
        for (int i = 0; i < 8; ++i) { LAS float* sp = scr + (8 * i + (lane >> 3)) * 33 + c4; sp[0] = v[i][0] * inv[0]; sp[1] = v[i][1] * inv[1]; sp[2] = v[i][2] * inv[2]; sp[3] = v[i][3] * inv[3]; }
        LDS_WAIT();
        const int c = lane & 3;
#pragma unroll
        for (int j = 0; j < 2; ++j) { const int n = (lane >> 2) + 16 * j; const LAS float* sp = scr + (16 * c) * 33 + n;
            u32x4 o;
#pragma unroll
            for (int w4 = 0; w4 < 4; ++w4) { unsigned w = 0;
#pragma unroll
                for (int e = 0; e < 4; ++e) w |= ((unsigned)(int)fminf(fmaxf(__builtin_rintf(sp[(4 * w4 + e) * 33]), -127.f), 127.f) & 255u) << (8 * e);
                o[w4] = w; }
            *(u32x4*)(WT8 + (size_t)(dn + n) * 2048 + k0 + 16 * c) = o; }
        LDS_WAIT();
    }
}
__device__ __forceinline__ void late_transposes(const Params& P, LAS unsigned char* lds, int vcu, int G) {
    const int tid = threadIdx.x, lane = tid & 63, wave = __builtin_amdgcn_readfirstlane(tid >> 6);
    const int gw = vcu * NWAVES + wave, NGW = G * NWAVES;
    unsigned char* ws = P.ws;
    LAS float* scr = (LAS float*)(lds + wave * 16384);
    constexpr int I_A = 16 * 64, I_O = 32 * 64, NITEMS = 2 * I_A + 2 * I_O;
    for (int it = gw; it < NITEMS; it += NGW) {
        int r = it;
        if (r < I_A) { const int kb = r / 64, nb = r % 64; transpose_item(P.w_a, 2048, nb * 32, (bf16_t*)(ws + WS_WAT), 1024, nb * 32, kb * 64, scr, lane, nullptr); continue; } r -= I_A;
        if (r < I_A) { const int kb = r / 64, nb = r % 64; transpose_item(P.w_b, 2048, nb * 32, (bf16_t*)(ws + WS_WBT), 1024, nb * 32, kb * 64, scr, lane, nullptr); continue; } r -= I_A;
        if (r < I_O) { const int kb = r / 64, nb = r % 64; transpose_item(P.w_out, 2048, nb * 32, (bf16_t*)(ws + WS_WOUT), 2048, nb * 32, kb * 64, scr, lane, nullptr); continue; } r -= I_O;
        { const int kb = r / 64, nb = r % 64; transpose_item(P.w_query, 2048, nb * 32, (bf16_t*)(ws + WS_WQ), 2048, nb * 32, kb * 64, scr, lane, P.g_ffn); }
    }
}
__device__ __forceinline__ void quantise_expert_rows(const Params& P, int r0, int nrows) {
    const int lane = threadIdx.x & 63;
    unsigned char* ws = P.ws;
    float* SU = (float*)(ws + WS_SU); float* SV = (float*)(ws + WS_SV);
    for (int r = r0; r < r0 + nrows; r += 2) {
        f32x4 v[2][8];
#pragma unroll
        for (int t = 0; t < 2; ++t) { const int rr = r + t; const f32x4* src = (const f32x4*)((rr >= 16384 ? P.e_v : P.e_u) + (size_t)(rr & 16383) * DM) + lane;
#pragma unroll
            for (int j = 0; j < 8; ++j) v[t][j] = __builtin_nontemporal_load(src + 64 * j); }
#pragma unroll
        for (int t = 0; t < 2; ++t) { const int rr = r + t; const bool second = rr >= 16384; const int row = rr & 16383;
            float mx = 0.f;
#pragma unroll
            for (int j = 0; j < 8; ++j) mx = fmaxf(mx, fmaxf(fmaxf(fabsf(v[t][j][0]), fabsf(v[t][j][1])), fmaxf(fabsf(v[t][j][2]), fabsf(v[t][j][3]))));
#pragma unroll
            for (int o = 1; o < 64; o <<= 1) mx = fmaxf(mx, __shfl_xor(mx, o));
            mx = fmaxf(mx, 1e-30f);
            const float inv = 127.f / mx;
            unsigned* dst = (unsigned*)(ws + (second ? WS_EV : WS_EU) + (size_t)row * DM) + lane;
#pragma unroll
            for (int j = 0; j < 8; ++j) { unsigned w = 0;
#pragma unroll
                for (int e = 0; e < 4; ++e) { const int q = (int)__builtin_rintf(v[t][j][e] * inv); w |= ((unsigned)q & 255u) << (8 * e); }
                dst[64 * j] = w; }
            if (lane == 0) (second ? SV : SU)[row] = mx * (1.f / 127.f);
        }
    }
}

namespace att {
constexpr int KST = 272, VST = 320;
constexpr int KBUF = 64 * KST, VBUF = 64 * VST;
constexpr int OFF_K = 0, OFF_V = 2 * KBUF, OFF_F = OFF_V + 2 * VBUF, OFF_SC = OFF_F + 4096 * 4;
constexpr int OFF_FLG = OFF_SC + 64, OFF_UNIT = OFF_FLG + 64;
static_assert(OFF_UNIT + 16 <= 131072, "attention LDS");
constexpr float THR_SB = 30.f, THR_FOX = 20.f;

__device__ __forceinline__ void build_cumf(LAS unsigned char* lds, const float* LOGF, int b, int h, int n, int tid, int lane, int wid) {
    LAS float* F2 = (LAS float*)(lds + OFF_F); LAS float* sc = (LAS float*)(lds + OFF_SC);
    const int s0 = tid * 8; float v[8];
    { const f32x4* lp = (const f32x4*)(LOGF + ((size_t)b * 8 + h) * SEQ + s0); f32x4 a0 = {0.f, 0.f, 0.f, 0.f}, a1 = a0; if (s0 < n) { a0 = lp[0]; a1 = lp[1]; }
      v[0] = a0[0] * LOG2E; v[1] = a0[1] * LOG2E; v[2] = a0[2] * LOG2E; v[3] = a0[3] * LOG2E; v[4] = a1[0] * LOG2E; v[5] = a1[1] * LOG2E; v[6] = a1[2] * LOG2E; v[7] = a1[3] * LOG2E; }
#pragma unroll
    for (int i = 1; i < 8; ++i) v[i] += v[i - 1];
    float tot = v[7], inc = tot;
#pragma unroll
    for (int o = 1; o < 64; o <<= 1) { const float t = __shfl_up(inc, o); if (lane >= o) inc += t; }
    if (lane == 63) sc[wid] = inc;
    __syncthreads();
    float base = inc - tot;
#pragma unroll
    for (int w = 0; w < 8; ++w) if (w < wid) base += sc[w];
    if (s0 < n) {
#pragma unroll
        for (int i = 0; i < 8; ++i) F2[s0 + i] = v[i] + base;
    }
    __syncthreads();
}

template <int MIXER>
__device__ __forceinline__ void attn_unit(LAS unsigned char* lds, const bf16_t* Q, const bf16_t* Kg, const bf16_t* Vg, bf16_t* O, int b, int h, int qb, float kmax, int tid, int lane, int wid) {
    const int c = lane & 31, hh = lane >> 5;
    const int t0 = qb * 256 + wid * 32, tq = t0 + c;
    const size_t rowbase = (size_t)b * SEQ;
    size_t qoff = (rowbase + tq) * 1024 + h * HD + 8 * hh;
    f32x16 oacc[4];
#pragma unroll
    for (int d = 0; d < 4; ++d)
#pragma unroll
        for (int r = 0; r < 16; ++r) oacc[d][r] = 0.f;
    float carry = 0.f, mrun = -1e30f, lsum = 0.f; const float nhf = hh ? 0.f : 1.f;
    const LAS float* F2 = (const LAS float*)(lds + OFF_F);
    const float Ft = (MIXER == 1) ? F2[tq] : 0.f;
    float qk_bound = 0.f;
    if (MIXER == 1) { float qs = 0.f;
#pragma unroll
        for (int s2 = 0; s2 < 8; ++s2) { const u32x4 qv = *(const u32x4*)(Q + qoff + 16 * s2);
#pragma unroll
            for (int e = 0; e < 4; ++e) { const float a = bf_lo(qv[e]), b2 = bf_hi(qv[e]); qs += a * a + b2 * b2; } }
        qs += __shfl_xor(qs, 32);
        qk_bound = sqrtf(qs) * kmax; }
    bool wave_done = false;
    volatile LAS unsigned* flg = (volatile LAS unsigned*)(lds + OFF_FLG);
    const int ktmax = 4 * qb + 3;
    const int srow = tid >> 4, scc = tid & 15;
    u32x4 kr[2], vr[2];
#define ATT_LOAD(kt) do { _Pragma("unroll") for (int j = 0; j < 2; ++j) { const size_t g_ = (rowbase + 64 * (kt) + srow + 32 * j) * 1024 + h * HD + scc * 8; \
        kr[j] = *(const u32x4*)(Kg + g_); vr[j] = *(const u32x4*)(Vg + g_); } } while (0)
#define ATT_WRITE(buf) do { _Pragma("unroll") for (int j = 0; j < 2; ++j) { \
        *(LAS u32x4*)(lds + OFF_K + (buf) * KBUF + (srow + 32 * j) * KST + scc * 16) = kr[j]; \
        *(LAS u32x4*)(lds + OFF_V + (buf) * VBUF + (srow + 32 * j) * VST + scc * 16) = vr[j]; } } while (0)
    ATT_LOAD(ktmax); ATT_WRITE(0); __syncthreads();
    int buf = 0;
    for (int kt = ktmax; kt >= 0; --kt) {
        if (kt > 0) ATT_LOAD(kt - 1);
        const bool started = (64 * kt <= t0 + 31);
        if (started && !wave_done) {
            const LAS unsigned char* Kl = lds + OFF_K + buf * KBUF; const LAS unsigned char* Vl = lds + OFF_V + buf * VBUF;
            f32x16 sacc[2];
            asm volatile("" : "+v"(qoff));
            bf16x8 qf[8];
#pragma unroll
            for (int s = 0; s < 8; ++s) qf[s] = *(const bf16x8*)(Q + qoff + 16 * s);
#pragma unroll
            for (int sub = 0; sub < 2; ++sub) {
#pragma unroll
                for (int r = 0; r < 16; ++r) sacc[sub][r] = 0.f;
#pragma unroll
                for (int s = 0; s < 8; ++s) { const bf16x8 kf = *(const LAS bf16x8*)(Kl + (32 * sub + c) * KST + (16 * s + 8 * hh) * 2);
                    sacc[sub] = __builtin_amdgcn_mfma_f32_32x32x16_bf16(kf, qf[s], sacc[sub], 0, 0, 0); }
            }
            const bool need_mask = (64 * kt + 63 >= t0);
            bool tile_dead = false;
            if (MIXER == 0) {
#pragma unroll
                for (int sub = 1; sub >= 0; --sub) {
                    float lb[16];
#pragma unroll
                    for (int r = 0; r < 16; ++r) { const float z = sacc[sub][r]; float l = -flog2(1.f + fexp2(z));
                        if (need_mask) { const int sidx = 64 * kt + 32 * sub + (r & 3) + 8 * (r >> 2) + 4 * hh; l = (sidx < tq) ? l : 0.f; }
                        lb[r] = l; }
                    float Glo[4], Ghi[4];
#pragma unroll
                    for (int g = 0; g < 4; ++g) { lb[4 * g + 2] += lb[4 * g + 3]; lb[4 * g + 1] += lb[4 * g + 2]; lb[4 * g] += lb[4 * g + 1];
                        const unsigned gu = __builtin_bit_cast(unsigned, lb[4 * g]); const auto rr = __builtin_amdgcn_permlane32_swap(gu, gu, false, false);
                        Glo[g] = __builtin_bit_cast(float, (unsigned)rr[0]); Ghi[g] = __builtin_bit_cast(float, (unsigned)rr[1]); }
                    float E[8];
                    E[7] = carry; E[6] = E[7] + Ghi[3]; E[5] = E[6] + Glo[3]; E[4] = E[5] + Ghi[2]; E[3] = E[4] + Glo[2]; E[2] = E[3] + Ghi[1]; E[1] = E[2] + Glo[1]; E[0] = E[1] + Ghi[0];
                    carry = E[0] + Glo[0];
#pragma unroll
                    for (int g = 0; g < 4; ++g) { const float Eo = __builtin_fmaf(nhf, Ghi[g], E[2 * g + 1]);
#pragma unroll
                        for (int i = 0; i < 4; ++i) { const int r = 4 * g + i; float w = fexp2(sacc[sub][r] + lb[r] + Eo);
                            if (need_mask) { const int sidx = 64 * kt + 32 * sub + (r & 3) + 8 * (r >> 2) + 4 * hh; w = (sidx < tq) ? w : 0.f; }
                            sacc[sub][r] = w; } }
                }
            } else {
                float mx = -1e30f;
#pragma unroll
                for (int sub = 0; sub < 2; ++sub)
#pragma unroll
                    for (int g = 0; g < 4; ++g) { const f32x4 fs = *(const LAS f32x4*)(F2 + 64 * kt + 32 * sub + 8 * g + 4 * hh);
#pragma unroll
                        for (int i = 0; i < 4; ++i) { const int r = 4 * g + i; float xv = sacc[sub][r] + (Ft - fs[i]);
                            if (need_mask) { const int sidx = 64 * kt + 32 * sub + 8 * g + 4 * hh + i; xv = (sidx <= tq) ? xv : -1e30f; }
                            sacc[sub][r] = xv; mx = fmaxf(mx, xv); } }
                { const unsigned mu = __builtin_bit_cast(unsigned, mx); const auto rr = __builtin_amdgcn_permlane32_swap(mu, mu, false, false);
                  mx = fmaxf(__builtin_bit_cast(float, (unsigned)rr[0]), __builtin_bit_cast(float, (unsigned)rr[1])); }
                tile_dead = __all(mx - mrun < -THR_FOX);
                if (!tile_dead) {
                const float mnew = fmaxf(mrun, mx);
                const float alpha = fexp2(mrun - mnew);
                float ps = 0.f;
#pragma unroll
                for (int sub = 0; sub < 2; ++sub)
#pragma unroll
                    for (int r = 0; r < 16; ++r) { const float p = fexp2(sacc[sub][r] - mnew); sacc[sub][r] = p; ps += p; }
                lsum = lsum * alpha + ps;
                if (__any(mnew > mrun)) {
#pragma unroll
                    for (int d = 0; d < 4; ++d)
#pragma unroll
                        for (int r = 0; r < 16; ++r) oacc[d][r] *= alpha;
                }
                mrun = mnew;
                }
            }
            if (!tile_dead)
#pragma unroll
            for (int ks = 0; ks < 4; ++ks) { const int sub = ks >> 1, rb = 8 * (ks & 1);
                u32x4 pw; pw.x = pk2(sacc[sub][rb + 0], sacc[sub][rb + 1]); pw.y = pk2(sacc[sub][rb + 2], sacc[sub][rb + 3]); pw.z = pk2(sacc[sub][rb + 4], sacc[sub][rb + 5]); pw.w = pk2(sacc[sub][rb + 6], sacc[sub][rb + 7]);
                const bf16x8 pf = __builtin_bit_cast(bf16x8, pw);
                const LAS unsigned char* vb = Vl + (16 * ks + 4 * hh + ((lane & 15) >> 2)) * VST + (16 * ((lane >> 4) & 1) + 4 * (lane & 3)) * 2;
#pragma unroll
                for (int d = 0; d < 4; ++d) {
                    const s16x4 a0 = __builtin_amdgcn_ds_read_tr16_b64_v4i16((LAS s16x4*)(vb + d * 64));
                    const s16x4 a1 = __builtin_amdgcn_ds_read_tr16_b64_v4i16((LAS s16x4*)(vb + d * 64 + 8 * VST));
                    const bf16x8 af = {a0[0], a0[1], a0[2], a0[3], a1[0], a1[1], a1[2], a1[3]};
                    oacc[d] = __builtin_amdgcn_mfma_f32_32x32x16_bf16(af, pf, oacc[d], 0, 0, 0); }
            }
        }
        if (kt > 0) ATT_WRITE(buf ^ 1);
        if (kt > 0 && started && !wave_done) {
            if (MIXER == 0) wave_done = __all(carry < -THR_SB);
            else wave_done = __all(qk_bound + (Ft - F2[64 * kt - 1]) - mrun < -THR_FOX);
        }
        if (lane == 0) flg[(kt & 1) * 8 + wid] = wave_done ? 1u : 0u;
        __syncthreads();
        buf ^= 1;
        { unsigned alld = 1u;
#pragma unroll
          for (int w = 0; w < 8; ++w) alld &= flg[(kt & 1) * 8 + w];
          if (alld) break; }
    }
#undef ATT_LOAD
#undef ATT_WRITE
    float inv = 1.f;
    if (MIXER == 1) { const unsigned lu = __builtin_bit_cast(unsigned, lsum); const auto rr = __builtin_amdgcn_permlane32_swap(lu, lu, false, false);
        inv = 1.f / (__builtin_bit_cast(float, (unsigned)rr[0]) + __builtin_bit_cast(float, (unsigned)rr[1])); }
    bf16_t* op = O + (rowbase + tq) * 2048 + 4 * hh;
#pragma unroll
    for (int d = 0; d < 4; ++d)
#pragma unroll
        for (int g = 0; g < 4; ++g) { u32x2 w; w.x = pk2(oacc[d][4 * g] * inv, oacc[d][4 * g + 1] * inv); w.y = pk2(oacc[d][4 * g + 2] * inv, oacc[d][4 * g + 3] * inv);
            *(u32x2*)(op + 32 * d + 8 * g) = w; }
}

__device__ __forceinline__ void attn_phase(const Params& P, LAS unsigned char* lds, int vcu, int G) {
    const int tid = threadIdx.x, lane = tid & 63, wid = __builtin_amdgcn_readfirstlane(tid >> 6);
    unsigned char* ws = P.ws;
    const bf16_t* QKV = (const bf16_t*)(ws + WS_QKV); const size_t TS = (size_t)T_TOK * 1024;
    bf16_t* OAB = (bf16_t*)(ws + WS_H); const float* LOGF = (const float*)(ws + WS_LOGF);
    unsigned* qctr = (unsigned*)(ws + WS_CTL + 196608);
    const unsigned* KMAXW = (const unsigned*)(ws + WS_CTL + 200704);
    volatile LAS unsigned* uw = (volatile LAS unsigned*)(lds + OFF_UNIT);
    for (;;) {
        if (tid == 0) uw[0] = atomicAdd(qctr, 1u);
        __syncthreads();
        const unsigned u = uw[0];
        __syncthreads();
        if (u >= 2560u) break;
        if (u >= 512u) { quantise_expert_rows(P, (int)(u - 512u) * 16 + wid * 2, 2); continue; }
        const int mixer = (u < 256u) ? 1 : 0, v = (int)(u & 255u), qb = 15 - (v >> 4), bh = v & 15, b = bh >> 3, h = bh & 7;
        if (mixer == 0) {
            attn_unit<0>(lds, QKV, QKV + TS, QKV + 2 * TS, OAB + h * HD, b, h, qb, 0.f, tid, lane, wid);
        } else {
            float k2 = 0.f;
#pragma unroll
            for (int w = 0; w < 4; ++w) k2 += __builtin_bit_cast(float, __hip_atomic_load(KMAXW + bh * 4 + w, __ATOMIC_RELAXED, __HIP_MEMORY_SCOPE_AGENT));
            const float kmax = sqrtf(k2) * 1.01f;
            build_cumf(lds, LOGF, b, h, 256 * (qb + 1), tid, lane, wid);
            attn_unit<1>(lds, QKV + 3 * TS, QKV + 4 * TS, QKV + 5 * TS, OAB + 1024 + h * HD, b, h, qb, kmax, tid, lane, wid);
        }
        __syncthreads();
    }
}
}

namespace peer {
__device__ __forceinline__ unsigned sortable(float f) { const unsigned u = __builtin_bit_cast(unsigned, f); return (u & 0x80000000u) ? ~u : (u | 0x80000000u); }
__device__ __forceinline__ float unsortable(unsigned k) { const unsigned u = (k & 0x80000000u) ? (k & 0x7fffffffu) : ~k; return __builtin_bit_cast(float, u); }
#define CE_DESC(x, y) do { const unsigned hi_ = (x) > (y) ? (x) : (y); const unsigned lo_ = (x) > (y) ? (y) : (x); (x) = hi_; (y) = lo_; } while (0)
template <int B, int N> __device__ __forceinline__ void sort16_desc(unsigned (&a)[N]) {
#pragma unroll
    for (int k = 2; k <= 16; k <<= 1)
#pragma unroll
        for (int j = k >> 1; j > 0; j >>= 1)
#pragma unroll
            for (int i = 0; i < 16; ++i) { const int l = i ^ j; if (l > i) { if ((i & k) == 0) CE_DESC(a[B + i], a[B + l]); else CE_DESC(a[B + l], a[B + i]); } }
}
template <int A, int Bq, int N> __device__ __forceinline__ void merge_top16(unsigned (&a)[N]) {
#pragma unroll
    for (int i = 0; i < 16; ++i) { const unsigned x = a[A + i], y = a[Bq + 15 - i]; a[A + i] = x > y ? x : y; }
#pragma unroll
    for (int j = 8; j > 0; j >>= 1)
#pragma unroll
        for (int i = 0; i < 16; ++i) { const int l = i ^ j; if (l > i) CE_DESC(a[A + i], a[A + l]); }
}

__device__ __forceinline__ void topk_phase(const Params& P, LAS unsigned char* lds, int vcu, int G) {
    const int tid = threadIdx.x, lane = tid & 63, wave = __builtin_amdgcn_readfirstlane(tid >> 6);
    const int c = lane & 31, hh = lane >> 5;
    const int gw = vcu * NWAVES + wave, NGW = G * NWAVES;
    unsigned char* ws = P.ws;
    const bf16_t* Q2 = (const bf16_t*)(ws + WS_Q2); const bf16_t* SKB = (const bf16_t*)(ws + WS_SKB);
    const float* ROWSS = (const float*)(ws + WS_CTL); int* IDS = (int*)(ws + WS_IDS); float* GATES = (float*)(ws + WS_GATES);
    LAS unsigned char* scr = lds + wave * 4096;
    const bool shared_head = (G == 256);
    LAS unsigned char* skl = lds + 32768;
    if (shared_head) { const bf16_t* src = SKB + (size_t)(vcu & 7) * 2 * 128 * 128;
#pragma unroll
        for (int q = 0; q < 8; ++q) { const int ch = tid + 512 * q, row = ch >> 4, cc = ch & 15; *(LAS u32x4*)(skl + row * 272 + cc * 16) = *(const u32x4*)(src + row * 128 + cc * 8); }
        __syncthreads(); }
    for (int task = (shared_head ? (((vcu >> 3) * 8 + wave) * 8 + (vcu & 7)) : gw); task < 2048; task += (shared_head ? 1 << 30 : NGW)) {
        const int tg = task >> 3, hd = task & 7, tok = tg * 32 + c;
#pragma unroll 1
        for (int p = 0; p < 2; ++p) {
            bf16x8 qf[8];
            { const bf16_t* qp = Q2 + (size_t)tok * DM + hd * 256 + p * 128 + 8 * hh;
#pragma unroll
              for (int s = 0; s < 8; ++s) qf[s] = *(const bf16x8*)(qp + 16 * s); }
            unsigned keys[64];
#pragma unroll
            for (int sub = 0; sub < 4; ++sub) {
                f32x16 acc;
#pragma unroll
                for (int r = 0; r < 16; ++r) acc[r] = 0.f;
                const bf16_t* kp = SKB + ((size_t)(hd * 2 + p) * 128 + 32 * sub + c) * 128 + 8 * hh;
#pragma unroll
                for (int s = 0; s < 8; ++s) { const bf16x8 kf = shared_head ? *(const LAS bf16x8*)(skl + (p * 128 + 32 * sub + c) * 272 + (16 * s + 8 * hh) * 2) : *(const bf16x8*)(kp + 16 * s); acc = __builtin_amdgcn_mfma_f32_32x32x16_bf16(kf, qf[s], acc, 0, 0, 0); }
#pragma unroll
                for (int r = 0; r < 16; ++r) { const int nlo = 127 - (32 * sub + (r & 3) + 8 * (r >> 2)); keys[sub * 16 + r] = (sortable(acc[r]) & ~127u) | (unsigned)(nlo - 4 * hh); }
            }
            sort16_desc<0>(keys); sort16_desc<16>(keys); sort16_desc<32>(keys); sort16_desc<48>(keys);
            merge_top16<0, 16>(keys); merge_top16<32, 48>(keys); merge_top16<0, 32>(keys);
#pragma unroll
            for (int i = 0; i < 16; ++i) { const unsigned own = keys[i]; const auto rr = __builtin_amdgcn_permlane32_swap(own, own, false, false); keys[16 + i] = hh ? (unsigned)rr[0] : (unsigned)rr[1]; }
            merge_top16<0, 16>(keys);
            if (hh == 0) {
#pragma unroll
                for (int w = 0; w < 4; ++w) *(LAS u32x4*)(scr + (c * 2 + p) * 64 + w * 16) = (u32x4){keys[4 * w], keys[4 * w + 1], keys[4 * w + 2], keys[4 * w + 3]};
            }
        }
        LDS_WAIT();
        float s1[16], s2[16];
#pragma unroll
        for (int w = 0; w < 4; ++w) { const u32x4 a = *(const LAS u32x4*)(scr + (c * 2) * 64 + w * 16), b2 = *(const LAS u32x4*)(scr + (c * 2 + 1) * 64 + w * 16);
#pragma unroll
            for (int e = 0; e < 4; ++e) { s1[4 * w + e] = unsortable((a[e] & ~127u) | 64u); s2[4 * w + e] = unsortable((b2[e] & ~127u) | 64u); } }
        unsigned ck[64];
        { int n = 0;
#pragma unroll
          for (int i = 0; i < 16; ++i)
#pragma unroll
              for (int j = 0; j < 16; ++j) if ((i + 1) * (j + 1) <= 16) { ck[n] = (sortable(s1[i] + s2[j]) & ~255u) | (unsigned)(255 - (i * 16 + j)); ++n; }
#pragma unroll
          for (int q = 50; q < 64; ++q) ck[q] = 0u; }
        sort16_desc<0>(ck); sort16_desc<16>(ck); sort16_desc<32>(ck); sort16_desc<48>(ck);
        merge_top16<0, 16>(ck); merge_top16<32, 48>(ck); merge_top16<0, 32>(ck);
        unsigned t2[16];
#pragma unroll
        for (int k = 0; k < 16; ++k) t2[k] = ck[k];
        int ids[16]; float sc[16];
#pragma unroll
        for (int k = 0; k < 16; ++k) { const unsigned pos = 255u - (t2[k] & 255u);
            const unsigned k1 = *(const LAS unsigned*)(scr + (c * 2) * 64 + (pos >> 4) * 4), k2 = *(const LAS unsigned*)(scr + (c * 2 + 1) * 64 + (pos & 15u) * 4);
            ids[k] = (int)((127u - (k1 & 127u)) * 128u + (127u - (k2 & 127u))); sc[k] = unsortable((t2[k] & ~255u) | 128u); }
        LDS_WAIT();
        const float rs = 1.0f / sqrtf(ROWSS[tok] * (1.f / DM) + EPS);
        float ev[16], Z = 0.f;
#pragma unroll
        for (int k = 0; k < 16; ++k) { ev[k] = fexp2((sc[k] - sc[0]) * rs * LOG2E); Z += ev[k]; }
        const float iz = 1.f / Z;
        int* ip = IDS + (size_t)tok * 128 + hd * 16; float* gp = GATES + (size_t)tok * 128 + hd * 16;
        if (hh == 0) {
#pragma unroll
            for (int k = 0; k < 8; ++k) { ip[k] = ids[k]; gp[k] = ev[k] * iz; }
        } else {
#pragma unroll
            for (int k = 8; k < 16; ++k) { ip[k] = ids[k]; gp[k] = ev[k] * iz; }
        }
    }
}


__device__ __forceinline__ float dot8(u32x4 a, u32x4 b, float acc) {
    const unsigned a0 = a[0], a1 = a[1], a2 = a[2], a3 = a[3], b0 = b[0], b1 = b[1], b2 = b[2], b3 = b[3];
    acc = __builtin_amdgcn_fdot2_f32_bf16(__builtin_bit_cast(bf16v2, a0), __builtin_bit_cast(bf16v2, b0), acc, false);
    acc = __builtin_amdgcn_fdot2_f32_bf16(__builtin_bit_cast(bf16v2, a1), __builtin_bit_cast(bf16v2, b1), acc, false);
    acc = __builtin_amdgcn_fdot2_f32_bf16(__builtin_bit_cast(bf16v2, a2), __builtin_bit_cast(bf16v2, b2), acc, false);
    acc = __builtin_amdgcn_fdot2_f32_bf16(__builtin_bit_cast(bf16v2, a3), __builtin_bit_cast(bf16v2, b3), acc, false);
    return acc;
}
__device__ __forceinline__ float gelu_tanh(float a) { const float t = 1.5957691216f * (a + 0.044715f * a * a * a); return a * frcp(1.f + fexp2(-LOG2E * t)); }

__device__ __forceinline__ int dot16(u32x4 a, u32x4 b, int acc) {
    acc = __builtin_amdgcn_sdot4((int)a[0], (int)b[0], acc, false); acc = __builtin_amdgcn_sdot4((int)a[1], (int)b[1], acc, false);
    acc = __builtin_amdgcn_sdot4((int)a[2], (int)b[2], acc, false); acc = __builtin_amdgcn_sdot4((int)a[3], (int)b[3], acc, false);
    return acc;
}
__device__ __forceinline__ void gather_sweep(const Params& P, LAS unsigned char* lds, int vcu, int G) {
    const int tid = threadIdx.x, lane = tid & 63, wave = __builtin_amdgcn_readfirstlane(tid >> 6);
    const int gw = vcu * NWAVES + wave, NGW = G * NWAVES;
    const int g = lane >> 3, i = lane & 7;
    unsigned char* ws = P.ws;
    const bf16_t* X1B = (const bf16_t*)(ws + WS_X1B); const float* ROWSS = (const float*)(ws + WS_CTL);
    const int* IDS = (const int*)(ws + WS_IDS); const float* GATES = (const float*)(ws + WS_GATES);
    const unsigned char* EU = ws + WS_EU; const unsigned char* EV = ws + WS_EV;
    const float* SU = (const float*)(ws + WS_SU); const float* SV = (const float*)(ws + WS_SV);
    LAS unsigned char* wl = lds + wave * 16384;
    const bool b2 = (lane >> 2) & 1, b1 = (lane >> 1) & 1, b0 = lane & 1, B2 = (lane >> 5) & 1, B1 = (lane >> 4) & 1, B0 = (lane >> 3) & 1;
    for (int tg = gw; tg < T_TOK / 4; tg += NGW) {
        const int tok0 = tg * 4;
        float hs[4];
#pragma unroll
        for (int j = 0; j < 4; ++j) { const int tok = tok0 + j;
            const float rs = 1.0f / sqrtf(ROWSS[tok] * (1.f / DM) + EPS);
            f32x4 hv[8]; float hmx = 0.f;
#pragma unroll
            for (int q = 0; q < 8; ++q) { const u32x2 xb = *((const u32x2*)(X1B + (size_t)tok * DM) + lane + 64 * q); const f32x4 xv = {bf_lo(xb[0]), bf_hi(xb[0]), bf_lo(xb[1]), bf_hi(xb[1])}; const f32x4 gn = *((const f32x4*)P.g_ffn + lane + 64 * q);
                hv[q] = xv * rs * gn; hmx = fmaxf(hmx, fmaxf(fmaxf(fabsf(hv[q][0]), fabsf(hv[q][1])), fmaxf(fabsf(hv[q][2]), fabsf(hv[q][3])))); }
#pragma unroll
            for (int o = 1; o < 64; o <<= 1) hmx = fmaxf(hmx, __shfl_xor(hmx, o));
            hmx = fmaxf(hmx, 1e-30f); const float hinv = 127.f / hmx; hs[j] = hmx * (1.f / 127.f);
#pragma unroll
            for (int q = 0; q < 8; ++q) { unsigned w = 0;
#pragma unroll
                for (int e = 0; e < 4; ++e) w |= ((unsigned)(int)__builtin_rintf(hv[q][e] * hinv) & 255u) << (8 * e);
                *(LAS unsigned*)(wl + j * 2048 + 4 * (lane + 64 * q)) = w; }
#pragma unroll
            for (int hf = 0; hf < 2; ++hf) { const int k = lane + 64 * hf; const int id = IDS[(size_t)tok * 128 + k];
                *(LAS unsigned*)(wl + 8192 + (j * 128 + k) * 4) = (unsigned)id * 2048u;
                *(LAS float*)(wl + 10240 + (j * 128 + k) * 4) = GATES[(size_t)tok * 128 + k] * SV[id];
                *(LAS float*)(wl + 12288 + (j * 128 + k) * 4) = SU[id]; }
        }
        LDS_WAIT();
        int accu[4][16];
#pragma unroll
        for (int j = 0; j < 4; ++j)
#pragma unroll
            for (int m = 0; m < 16; ++m) accu[j][m] = 0;
#pragma unroll 1
        for (int sl = 0; sl < 16; ++sl) {
            __syncthreads();
            const unsigned char* ub = EU + 128 * sl + 16 * i;
#pragma unroll
            for (int j = 0; j < 4; ++j) {
                const u32x4 hqc = *(const LAS u32x4*)(wl + j * 2048 + 128 * sl + 16 * i);
                u32x4 d[16];
#pragma unroll
                for (int m = 0; m < 16; ++m) { const unsigned off = *(const LAS unsigned*)(wl + 8192 + (j * 128 + 8 * m + g) * 4); d[m] = *(const u32x4*)(ub + off); }
#pragma unroll
                for (int m = 0; m < 16; ++m) accu[j][m] = dot16(d[m], hqc, accu[j][m]);
                __builtin_amdgcn_sched_barrier(0);
            }
        }
        float sw[4];
#pragma unroll
        for (int j = 0; j < 4; ++j) {
            int r1[8], r2[4], r3[2];
#pragma unroll
            for (int m = 0; m < 8; ++m) { const int send = b2 ? accu[j][m] : accu[j][m + 8], keep = b2 ? accu[j][m + 8] : accu[j][m]; r1[m] = keep + __shfl_xor(send, 4); }
#pragma unroll
            for (int m = 0; m < 4; ++m) { const int send = b1 ? r1[m] : r1[m + 4], keep = b1 ? r1[m + 4] : r1[m]; r2[m] = keep + __shfl_xor(send, 2); }
#pragma unroll
            for (int m = 0; m < 2; ++m) { const int send = b0 ? r2[m] : r2[m + 2], keep = b0 ? r2[m + 2] : r2[m]; r3[m] = keep + __shfl_xor(send, 1); }
            float w2[2], wmx = 0.f;
#pragma unroll
            for (int m = 0; m < 2; ++m) { const int k = 16 * i + 8 * m + g;
                const float act = (float)r3[m] * (hs[j] * *(const LAS float*)(wl + 12288 + (j * 128 + k) * 4));
                w2[m] = *(const LAS float*)(wl + 10240 + (j * 128 + k) * 4) * gelu_tanh(act); wmx = fmaxf(wmx, fabsf(w2[m])); }
#pragma unroll
            for (int o = 1; o < 64; o <<= 1) wmx = fmaxf(wmx, __shfl_xor(wmx, o));
            wmx = fmaxf(wmx, 1e-30f); sw[j] = wmx * (1.f / 127.f);
            const float winv = 127.f / wmx;
            const unsigned q0 = (unsigned)(int)__builtin_rintf(w2[0] * winv) & 255u, q1 = (unsigned)(int)__builtin_rintf(w2[1] * winv) & 255u;
            *(LAS unsigned short*)(wl + 14336 + j * 128 + 16 * g + 2 * i) = (unsigned short)(q0 | (q1 << 8));
        }
        LDS_WAIT();
        float ssq[4] = {0.f, 0.f, 0.f, 0.f};
#pragma unroll 1
        for (int sl = 0; sl < 16; ++sl) {
            const unsigned char* vb = EV + 128 * sl + 16 * i;
#pragma unroll
            for (int j = 0; j < 4; ++j) {
                u32x4 d[16];
#pragma unroll
                for (int m = 0; m < 16; ++m) { const unsigned off = *(const LAS unsigned*)(wl + 8192 + (j * 128 + 8 * m + g) * 4); d[m] = *(const u32x4*)(vb + off); }
                const u32x4 wpk = *(const LAS u32x4*)(wl + 14336 + j * 128 + 16 * g);
                int ca[16];
#pragma unroll
                for (int b = 0; b < 16; ++b) ca[b] = 0;
#pragma unroll
                for (int mg = 0; mg < 4; ++mg)
#pragma unroll
                    for (int c4 = 0; c4 < 4; ++c4) { const unsigned r0 = d[4 * mg][c4], r1 = d[4 * mg + 1][c4], r2 = d[4 * mg + 2][c4], r3 = d[4 * mg + 3][c4];
                        const unsigned t0 = __builtin_amdgcn_perm(r1, r0, 0x05010400u), t1 = __builtin_amdgcn_perm(r1, r0, 0x07030602u);
                        const unsigned t2 = __builtin_amdgcn_perm(r3, r2, 0x05010400u), t3 = __builtin_amdgcn_perm(r3, r2, 0x07030602u);
                        const int wq4 = (int)wpk[mg];
                        ca[4 * c4 + 0] = __builtin_amdgcn_sdot4((int)__builtin_amdgcn_perm(t2, t0, 0x05040100u), wq4, ca[4 * c4 + 0], false);
                        ca[4 * c4 + 1] = __builtin_amdgcn_sdot4((int)__builtin_amdgcn_perm(t2, t0, 0x07060302u), wq4, ca[4 * c4 + 1], false);
                        ca[4 * c4 + 2] = __builtin_amdgcn_sdot4((int)__builtin_amdgcn_perm(t3, t1, 0x05040100u), wq4, ca[4 * c4 + 2], false);
                        ca[4 * c4 + 3] = __builtin_amdgcn_sdot4((int)__builtin_amdgcn_perm(t3, t1, 0x07060302u), wq4, ca[4 * c4 + 3], false); }
                int c1[8], c2[4], c3[2];
#pragma unroll
                for (int b = 0; b < 8; ++b) { const int send = B2 ? ca[b] : ca[b + 8], keep = B2 ? ca[b + 8] : ca[b]; c1[b] = keep + __shfl_xor(send, 32); }
#pragma unroll
                for (int b = 0; b < 4; ++b) { const int send = B1 ? c1[b] : c1[b + 4], keep = B1 ? c1[b + 4] : c1[b]; c2[b] = keep + __shfl_xor(send, 16); }
#pragma unroll
                for (int b = 0; b < 2; ++b) { const int send = B0 ? c2[b] : c2[b + 2], keep = B0 ? c2[b + 2] : c2[b]; c3[b] = keep + __shfl_xor(send, 8); }
                const size_t o = (size_t)(tok0 + j) * DM + 128 * sl + 16 * i + 2 * g;
                const unsigned xb = *(const unsigned*)(X1B + o); const f32x2 xv = {bf_lo(xb), bf_hi(xb)};
                const f32x2 x2 = {xv[0] + sw[j] * (float)c3[0], xv[1] + sw[j] * (float)c3[1]};
                ssq[j] += x2[0] * x2[0] + x2[1] * x2[1];
                *(f32x2*)(P.out + o) = x2;
                __builtin_amdgcn_sched_barrier(0);
            }
        }
#pragma unroll
        for (int j = 0; j < 4; ++j) { const float rs2 = 1.0f / sqrtf(wave_sum(ssq[j]) * (1.f / DM) + EPS);
            f32x4* orow = (f32x4*)(P.out + (size_t)(tok0 + j) * DM) + lane;
#pragma unroll
            for (int q = 0; q < 8; ++q) { const f32x4 gn = *((const f32x4*)P.g_final + lane + 64 * q); orow[64 * q] = orow[64 * q] * rs2 * gn; } }
        LDS_WAIT();
    }
}

}


#define XB_TMO      128
#define XB_XCNT(j)  (256  + 64 * (j))
#define XB_XSUB(j)  (1280 + 64 * (j))
#define XB_XGEN(j)  (2304 + 64 * (j))
#define XB_TOP      3328
#define XB_TOPGEN   3392
#define XCD_BAR_WORDS 3456
#define XB_SPIN_CAP (1u << 18)
__device__ __forceinline__ unsigned xb_ld(unsigned* p)              { return __hip_atomic_load(p, __ATOMIC_RELAXED, __HIP_MEMORY_SCOPE_AGENT); }
__device__ __forceinline__ unsigned xb_add(unsigned* p, unsigned v) { return __hip_atomic_fetch_add(p, v, __ATOMIC_RELAXED, __HIP_MEMORY_SCOPE_AGENT); }
__device__ __forceinline__ unsigned xb_xcc_id() { return (unsigned)__builtin_amdgcn_s_getreg((3 << 11) | 20) & 0xFu; }
#define XB_SPIN(cond, bar) do { unsigned _sp = 0; while (cond) { __builtin_amdgcn_s_sleep(1); \
    if ((++_sp & 255u) == 0u) { if (xb_ld(&(bar)[XB_TMO])) break; if (_sp > XB_SPIN_CAP) { atomicAdd(&(bar)[XB_TMO], 1u); break; } } } } while (0)
struct XcdBarrier { unsigned* bar; unsigned x; volatile LAS unsigned* st; };
__device__ __forceinline__ XcdBarrier xcd_barrier_post(unsigned* bar, volatile LAS unsigned* st) {
    XcdBarrier b; b.bar = bar; b.x = xb_xcc_id(); b.st = st;
    if (threadIdx.x == 0) (void)xb_add(&bar[XB_XCNT(b.x)], 1u);
    return b;
}
__device__ __forceinline__ void xcd_barrier_complete(unsigned* bar, unsigned x, unsigned& nloc, unsigned& nx) {
    const unsigned G = gridDim.x * gridDim.y * gridDim.z;
    unsigned sum, cnt, mine, sp = 0u;
    for (;;) {
        sum = 0u; cnt = 0u; mine = 0u;
#pragma unroll
        for (unsigned j = 0; j < 16; ++j) { const unsigned c = xb_ld(&bar[XB_XCNT(j)]); sum += c; cnt += (c > 0u) ? 1u : 0u; mine = (j == x) ? c : mine; }
        if (sum == G) break;
        __builtin_amdgcn_s_sleep(1);
        if ((++sp & 255u) == 0u) { if (xb_ld(&bar[XB_TMO])) break; if (sp > XB_SPIN_CAP) { atomicAdd(&bar[XB_TMO], 1u); break; } }
    }
    nloc = mine > 0u ? mine : 1u; nx = cnt > 0u ? cnt : 1u;
}
__device__ __forceinline__ void xcd_barrier(const XcdBarrier& b) {
    asm volatile("s_waitcnt vmcnt(0)" ::: "memory");
    __syncthreads();
    if (threadIdx.x == 0) {
        unsigned* bar = b.bar;
        __builtin_amdgcn_s_waitcnt(0);
        unsigned nloc = b.st[0], nx = b.st[1];
        if (nloc == 0u) { xcd_barrier_complete(bar, b.x, nloc, nx); b.st[0] = nloc; b.st[1] = nx; }
        const unsigned old = xb_add(&bar[XB_XSUB(b.x)], 1u);
        const unsigned gen = old / nloc;
        if (old + 1u == (gen + 1u) * nloc) {
            __builtin_amdgcn_fence(__ATOMIC_RELEASE, "agent");
            asm volatile("s_waitcnt vmcnt(0)" ::: "memory");
            const unsigned og = xb_add(&bar[XB_TOP], 1u);
            const unsigned tg = og / nx;
            if (og + 1u == (tg + 1u) * nx) xb_add(&bar[XB_TOPGEN], 1u);
            else XB_SPIN(xb_ld(&bar[XB_TOPGEN]) == tg, bar);
            __builtin_amdgcn_fence(__ATOMIC_ACQUIRE, "agent");
            xb_add(&bar[XB_XGEN(b.x)], 1u);
            asm volatile("s_waitcnt vmcnt(0)" ::: "memory");
        } else {
            XB_SPIN(xb_ld(&bar[XB_XGEN(b.x)]) == gen, bar);
            __builtin_amdgcn_fence(__ATOMIC_ACQUIRE, "agent");
            asm volatile("s_waitcnt vmcnt(0)" ::: "memory");
        }
    }
    __syncthreads();
}

__global__ void __launch_bounds__(NTHR, 2) mega_fwd(Params P) {
    extern __shared__ __attribute__((aligned(16))) unsigned char lds_raw[];
    LAS unsigned char* lds = (LAS unsigned char*)lds_raw;
    cg::grid_group grid = cg::this_grid();
    const int G = gridDim.x, bx = blockIdx.x;
    const int vcu = (G % 8 == 0) ? (bx % 8) * (G / 8) + bx / 8 : bx;
    unsigned char* ws = P.ws;
#ifndef ONLY_PHASE
#define ONLY_PHASE -1
#endif
#define IN(k) ((ONLY_PHASE < 0 || ONLY_PHASE == (k)) && P.ph_lo <= (k) && (k) < P.ph_hi)
    volatile LAS unsigned* bst = (volatile LAS unsigned*)(lds + 131072);
    if (threadIdx.x < 16) bst[threadIdx.x] = 0u;
    __syncthreads();
    const XcdBarrier xbar = xcd_barrier_post((unsigned*)(ws + WS_CTL + 131072), bst);
    if (P.ph_lo < 0) grid.sync();
#define SEAM(k) do { if (IN(k) && IN((k) + 1)) xcd_barrier(xbar); } while (0)
    if (IN(0)) { p0a(P, lds, vcu, G); xcd_barrier(xbar); p0b(P, lds, vcu, G); }
    SEAM(0);
    if (IN(1)) {
        pg8::Gemm g{ws + WS_H, ws + WS_WIN, T_TOK, 10240, 2048, 2048, 2048};
        pg8::StaticOrder S; S.init(T_TOK, 10240, G, bx, WGM1);
        pg8::EpiProj E{(bf16_t*)(ws + WS_QKV), (bf16_t*)(ws + WS_SG), LOG2E * 0.08838834764831845f, (unsigned*)(ws + WS_CTL + 200704), (const float*)(ws + WS_HSC), (const float*)(ws + WS_WSC)};
        pg8::gemm_phase<pg8::EpiProj, true>(lds, g, S, E);
    }
    SEAM(1);
    if (IN(2)) { att::attn_phase(P, lds, vcu, G); __syncthreads(); late_transposes(P, lds, vcu, G); }
    SEAM(2);
    if (IN(3)) {
        pg8::StaticOrder S; S.init(T_TOK, DM, G, bx, WGM2);
        { pg8::Gemm g{ws + WS_H, ws + WS_WAT, T_TOK, DM, 1024, 4096, 2048};
          pg8::EpiGate<0> E{(const bf16_t*)(ws + WS_SG), (bf16_t*)(ws + WS_TMP), (bf16_t*)(ws + WS_MERGED)};
          pg8::gemm_phase(lds, g, S, E); }
        { pg8::Gemm g{ws + WS_H + 2048, ws + WS_WBT, T_TOK, DM, 1024, 4096, 2048};
          pg8::EpiGate<1> E{(const bf16_t*)(ws + WS_SG) + 2048, (bf16_t*)(ws + WS_TMP), (bf16_t*)(ws + WS_MERGED)};
          pg8::gemm_phase(lds, g, S, E); }
    }
    SEAM(3);
    if (IN(4)) {
        pg8::Gemm g{ws + WS_MERGED, ws + WS_WOUT, T_TOK, DM, 2048, 4096, 4096};
        pg8::StaticOrder S; S.init(T_TOK, DM, G, bx, WGM2);
        pg8::EpiResid E{P.x, (float*)(ws + WS_X1), (bf16_t*)(ws + WS_X1B), (float*)(ws + WS_CTL)};
        pg8::gemm_phase(lds, g, S, E);
    }
    SEAM(4);
    if (IN(5)) {
        pg8::Gemm g{ws + WS_X1B, ws + WS_WQ, T_TOK, DM, 2048, 4096, 4096};
        pg8::StaticOrder S; S.init(T_TOK, DM, G, bx, WGM2);
        pg8::EpiPlainBf16 E{(bf16_t*)(ws + WS_Q2)};
        pg8::gemm_phase(lds, g, S, E);
    }
    SEAM(5);
    if (IN(6)) peer::topk_phase(P, lds, vcu, G);
    SEAM(6);
    if (IN(7)) { peer::gather_sweep(P, lds, vcu, G); }
#undef IN
#undef SEAM
}

extern "C" void kernel_launch(void* const* d_in, const int* in_sizes, int n_in, void* d_out, int out_size, void* d_ws, size_t ws_size, hipStream_t stream) {
    static int grid = 0;
    if (grid == 0) {
        if (n_in != 13 || out_size != T_TOK * DM || ws_size < WS_END) { fprintf(stderr, "kernel_launch: unexpected shapes (n_in %d out %d ws %zu)\n", n_in, out_size, ws_size); grid = -1; return; }
        int dev = 0, cus = 0, per_cu = 0;
        if (hipGetDevice(&dev) != hipSuccess || hipDeviceGetAttribute(&cus, hipDeviceAttributeMultiprocessorCount, dev) != hipSuccess) { grid = -1; return; }
        if (hipFuncSetAttribute((const void*)mega_fwd, hipFuncAttributeMaxDynamicSharedMemorySize, LDS_BYTES) != hipSuccess) { fprintf(stderr, "kernel_launch: hipFuncSetAttribute failed\n"); grid = -1; return; }
        if (hipOccupancyMaxActiveBlocksPerMultiprocessor(&per_cu, (const void*)mega_fwd, NTHR, LDS_BYTES) != hipSuccess || per_cu < 1) { fprintf(stderr, "kernel_launch: occupancy query says %d\n", per_cu); grid = -1; return; }
        grid = cus;
    }
    if (grid < 0) return;
    (void)hipMemsetAsync((char*)d_ws + WS_CTL, 0, 1 * MiB, stream);
    Params p{};
    p.x = (const float*)d_in[0]; p.g_mix = (const float*)d_in[1]; p.w_in = (const float*)d_in[2]; p.b_forget = (const float*)d_in[3];
    p.w_a = (const float*)d_in[4]; p.w_b = (const float*)d_in[5]; p.w_out = (const float*)d_in[6]; p.g_ffn = (const float*)d_in[7];
    p.w_query = (const float*)d_in[8]; p.sub_keys = (const float*)d_in[9]; p.e_u = (const float*)d_in[10]; p.e_v = (const float*)d_in[11]; p.g_final = (const float*)d_in[12];
    p.out = (float*)d_out; p.ws = (unsigned char*)d_ws;
#if MK_N_LAUNCHES == 1
    p.ph_lo = 0; p.ph_hi = N_PHASES;
    void* args[] = {&p};
    hipError_t e = hipLaunchCooperativeKernel((const void*)mega_fwd, dim3(grid), dim3(NTHR), args, LDS_BYTES, stream);
    if (e != hipSuccess) fprintf(stderr, "kernel_launch: cooperative launch failed: %s (grid %d)\n", hipGetErrorString(e), grid);
#else
    for (int ph = 0; ph < N_PHASES; ++ph) { p.ph_lo = ph; p.ph_hi = ph + 1; hipLaunchKernelGGL(mega_fwd, dim3(grid), dim3(NTHR), LDS_BYTES, stream, p); }
#endif
}
```

```cpp
#include <hip/hip_runtime.h>
#include <hip/hip_cooperative_groups.h>
#include <cstdio>
#include <cstdint>
namespace cg = cooperative_groups;

#define LAS __attribute__((address_space(3)))
#define GAS __attribute__((address_space(1)))
typedef unsigned short bf16_t;
typedef short bf16x8 __attribute__((ext_vector_type(8)));
typedef short s16x4 __attribute__((ext_vector_type(4)));
typedef float f32x2 __attribute__((ext_vector_type(2)));
typedef float f32x4 __attribute__((ext_vector_type(4)));
typedef float f32x16 __attribute__((ext_vector_type(16)));
typedef unsigned u32x2 __attribute__((ext_vector_type(2)));
typedef unsigned u32x4 __attribute__((ext_vector_type(4)));
typedef __bf16 bf16v2 __attribute__((ext_vector_type(2)));
typedef int i32x4 __attribute__((ext_vector_type(4)));

#ifndef WGM1
#define WGM1 4
#endif
#ifndef WGM2
#define WGM2 4
#endif
#ifndef MK_N_LAUNCHES
#define MK_N_LAUNCHES 1
#endif

constexpr int T_TOK = 8192, DM = 2048, SEQ = 4096, HD = 128;
constexpr int NWAVES = 8, NTHR = 512;
constexpr int LDS_BYTES = 163840;
constexpr float LOG2E = 1.4426950408889634f;
constexpr float EPS = 1e-6f;
constexpr int N_PHASES = 8;

constexpr size_t MiB = 1u << 20;
constexpr size_t WS_CTL = 0;
constexpr size_t WS_LOGF = 1 * MiB;
constexpr size_t WS_SKB = 1 * MiB + 512 * 1024;
constexpr size_t WS_HSC = 1 * MiB + 256 * 1024;
constexpr size_t WS_WSC = 1 * MiB + 320 * 1024;
constexpr size_t CTL_CMAX = 262144;
constexpr size_t WS_IDS = 2 * MiB;
constexpr size_t WS_GATES = 6 * MiB;
constexpr size_t WS_WAT = 10 * MiB, WS_WBT = 14 * MiB, WS_WOUT = 18 * MiB, WS_WQ = 26 * MiB, WS_WIN = 34 * MiB;
constexpr size_t WS_H = 74 * MiB;
constexpr size_t WS_QKV = 106 * MiB;
constexpr size_t WS_TMP = 106 * MiB, WS_MERGED = 170 * MiB, WS_Q2 = 106 * MiB;
constexpr size_t WS_SG = 202 * MiB;
constexpr size_t WS_X1B = 202 * MiB;
constexpr size_t WS_X1 = 266 * MiB;
constexpr size_t WS_EU = 330 * MiB, WS_EV = 362 * MiB;
constexpr size_t WS_SU = 394 * MiB, WS_SV = 394 * MiB + 65536;
constexpr size_t WS_END = 395 * MiB;

struct Params {
    const float* x; const float* g_mix; const float* w_in; const float* b_forget; const float* w_a; const float* w_b; const float* w_out;
    const float* g_ffn; const float* w_query; const float* sub_keys; const float* e_u; const float* e_v; const float* g_final;
    float* out; unsigned char* ws; int ph_lo, ph_hi;
};

__device__ __forceinline__ unsigned pk2(float a, float b) { f32x2 v = {a, b}; return __builtin_bit_cast(unsigned, __builtin_convertvector(v, bf16v2)); }
__device__ __forceinline__ float bf_lo(unsigned u) { return __builtin_bit_cast(float, u << 16); }
__device__ __forceinline__ float bf_hi(unsigned u) { return __builtin_bit_cast(float, u & 0xffff0000u); }
__device__ __forceinline__ float fexp2(float x) { return __builtin_amdgcn_exp2f(x); }
__device__ __forceinline__ float flog2(float x) { return __builtin_amdgcn_logf(x); }
__device__ __forceinline__ float frcp(float x) { return __builtin_amdgcn_rcpf(x); }
__device__ __forceinline__ float wave_sum(float v) {
#pragma unroll
    for (int o = 1; o < 64; o <<= 1) v += __shfl_xor(v, o);
    return v;
}
#define LDS_WAIT() asm volatile("s_waitcnt lgkmcnt(0)" ::: "memory")

namespace pg8 {
constexpr int BM = 256, BK = 64, HALF = 128, HTB = HALF * BK * 2, STAGE_BYTES = 8 * HTB, NXCD = 8, WGM = 8;
__host__ __device__ __forceinline__ int lds_byte(int r, int c) { const int st = (r >> 4) * 2 + (c >> 5), rr = r & 15, cc = c & 31, ob = rr * 64 + cc * 2; return st * 1024 + (ob ^ (((ob >> 9) & 1) << 5)); }
__host__ __device__ __forceinline__ void stage_rc(int b, int& R, int& C) { const int st = b / 1024, sb = b % 1024, swz = sb ^ (((sb >> 9) & 1) << 5); R = (st >> 1) * 16 + swz / 64; C = (st & 1) * 32 + (swz % 64) / 2; }
__host__ __device__ __forceinline__ int perm32(int rho) { const int n = rho >> 4, i = rho & 15; return 8 * (i >> 2) + 4 * n + (i & 3); }
struct Unit { int pm, pn; };
struct Gemm { const void* A; const void* Bt; int M, N, K, pa, pb; };
struct StaticOrder {
    int nM, nN, nwg, G, c, wgm;
    __device__ void init(int M, int N, int G_, int c_, int wgm_ = WGM) { nM = M / BM; nN = N / BM; nwg = nM * nN; G = G_; c = c_; wgm = wgm_; }
    __device__ bool next(int i, Unit& u) const {
        const long L = (long)i * G + c; if (L >= nwg) return false;
        int wgid = (int)L; { const int q = nwg / NXCD, r = nwg % NXCD, xcd = wgid % NXCD, off = wgid / NXCD; wgid = (xcd < r ? xcd * (q + 1) : r * (q + 1) + (xcd - r) * q) + off; }
        const int nig = wgm * nN, gid = wgid / nig, fm = gid * wgm, gsz = (nM - fm) < wgm ? (nM - fm) : wgm;
        u.pm = fm + ((wgid % nig) % gsz); u.pn = (wgid % nig) / gsz; return true;
    }
};
template <class Epi, bool I8 = false>
__device__ __forceinline__ void gemm_phase(LAS unsigned char* lds, const Gemm g, const StaticOrder& S, const Epi& E) {
    const int tid = threadIdx.x, wid = __builtin_amdgcn_readfirstlane(tid >> 6), lane = tid & 63, wr = wid >> 2, wc = wid & 3, fr = lane & 15, fq = lane >> 4;
    const int K = g.K, nt = I8 ? K / (2 * BK) : K / BK;
    unsigned voffA[2], voffB[2];
#pragma unroll
    for (int i = 0; i < 2; ++i) { int R, C; stage_rc(tid * 16 + i * 8192, R, C); const int Rb = (R & ~31) + perm32(R & 31);
        voffA[i] = (unsigned)(R * g.pa + C * 2); voffB[i] = (unsigned)(Rb * g.pb + C * 2); }
    const size_t kstep = (size_t)(BK * 2);
    const size_t hstepA = (size_t)HALF * g.pa, hstepB = (size_t)HALF * g.pb;
    const size_t tstepA = 2 * hstepA, tstepB = 2 * hstepB;
    const unsigned ldsw = (unsigned)wid * 1024u;
    const int aoff = lds_byte(wr * 64 + fr, fq * 8), boff = lds_byte(wc * 32 + fr, fq * 8);
#define PG8_SA(b, h) (((b) * 2 + (h)) * HTB)
#define PG8_SB(b, h) ((4 + (b) * 2 + (h)) * HTB)
#define PG8_STAGE(bufoff, gbase, voff) do { _Pragma("unroll") for (int _i = 0; _i < 2; ++_i) \
        __builtin_amdgcn_global_load_lds((const unsigned*)((const char*)(gbase) + (voff)[_i]), (LAS unsigned*)(lds + (bufoff) + ldsw + _i * 8192), 16, 0, 0); } while (0)
#define PG8_LDA(dst, b, h) do { _Pragma("unroll") for (int m = 0; m < 4; ++m) _Pragma("unroll") for (int k = 0; k < 2; ++k) dst[m][k] = *(const LAS bf16x8*)(lds + PG8_SA(b, h) + aoff + m * 2048 + k * 1024); } while (0)
#define PG8_LDB(dst, b, h) do { _Pragma("unroll") for (int n = 0; n < 2; ++n) _Pragma("unroll") for (int k = 0; k < 2; ++k) dst[n][k] = *(const LAS bf16x8*)(lds + PG8_SB(b, h) + boff + n * 2048 + k * 1024); } while (0)
#define PG8_MMA(ai, bj, At, Bt) do { __builtin_amdgcn_s_setprio(1); _Pragma("unroll") for (int m = 0; m < 4; ++m) _Pragma("unroll") for (int n = 0; n < 2; ++n) _Pragma("unroll") for (int k = 0; k < 2; ++k) \
        { if (I8) acc[ai][bj][m][n] = __builtin_bit_cast(f32x4, __builtin_amdgcn_mfma_i32_16x16x64_i8(__builtin_bit_cast(i32x4, Bt[n][k]), __builtin_bit_cast(i32x4, At[m][k]), __builtin_bit_cast(i32x4, acc[ai][bj][m][n]), 0, 0, 0)); \
          else acc[ai][bj][m][n] = __builtin_amdgcn_mfma_f32_16x16x32_bf16(Bt[n][k], At[m][k], acc[ai][bj][m][n], 0, 0, 0); } __builtin_amdgcn_s_setprio(0); } while (0)
#define PG8_WAIT_V(n) asm volatile("s_waitcnt vmcnt(" #n ")" ::: "memory")
#define PG8_WAIT_L(n) asm volatile("s_waitcnt lgkmcnt(" #n ")" ::: "memory")
#define PG8_BAR __builtin_amdgcn_s_barrier()
#define PG8_SCHED __builtin_amdgcn_sched_barrier(0)
    Unit cur, nxt; int ui = 0;
    if (!S.next(0, cur)) return;
    f32x4 acc[2][2][4][2];
#pragma unroll
    for (int a = 0; a < 2; ++a)
#pragma unroll
        for (int b = 0; b < 2; ++b)
#pragma unroll
            for (int m = 0; m < 4; ++m)
#pragma unroll
                for (int n = 0; n < 2; ++n) acc[a][b][m][n] = (f32x4){0.f, 0.f, 0.f, 0.f};
    bf16x8 At[4][2], B0[2][2], B1[2][2];
    const char* cA = (const char*)g.A + (size_t)cur.pm * tstepA; const char* cB = (const char*)g.Bt + (size_t)cur.pn * tstepB;
    PG8_STAGE(PG8_SB(0, 0), cB, voffB); PG8_STAGE(PG8_SA(0, 0), cA, voffA); PG8_STAGE(PG8_SB(0, 1), cB + hstepB, voffB); PG8_STAGE(PG8_SA(0, 1), cA + hstepA, voffA);
    if (wr == 1) PG8_BAR;
    PG8_WAIT_V(4); PG8_BAR;
    PG8_STAGE(PG8_SB(1, 0), cB + kstep, voffB); PG8_STAGE(PG8_SA(1, 0), cA + kstep, voffA); PG8_STAGE(PG8_SB(1, 1), cB + hstepB + kstep, voffB);
    PG8_WAIT_V(6); PG8_BAR;
    for (;;) {
        const bool has_next = S.next(ui + 1, nxt);
        const char* nA = has_next ? (const char*)g.A + (size_t)nxt.pm * tstepA : cA; const char* nB = has_next ? (const char*)g.Bt + (size_t)nxt.pn * tstepB : cB;
        for (int t = 0; t < nt; t += 2) {
            const bool last = (t == nt - 2);
            const char* a1 = cA + (size_t)(t + 1) * kstep;
            const char* a2 = last ? nA : cA + (size_t)(t + 2) * kstep; const char* b2 = last ? nB : cB + (size_t)(t + 2) * kstep;
            const char* a3 = a2 + kstep; const char* b3 = b2 + kstep;
            PG8_LDB(B0, 0, 0); PG8_SCHED; PG8_LDA(At, 0, 0); PG8_STAGE(PG8_SA(1, 1), a1 + hstepA, voffA);
            PG8_WAIT_L(8); PG8_BAR; PG8_WAIT_L(0); PG8_MMA(0, 0, At, B0); PG8_BAR; PG8_SCHED;
            PG8_LDB(B1, 0, 1); PG8_STAGE(PG8_SB(0, 0), b2, voffB);
            PG8_BAR; PG8_WAIT_L(0); PG8_MMA(0, 1, At, B1); PG8_BAR;
            PG8_LDA(At, 0, 1); PG8_STAGE(PG8_SA(0, 0), a2, voffA);
            PG8_BAR; PG8_WAIT_L(0); PG8_MMA(1, 0, At, B0); PG8_BAR; PG8_SCHED;
            PG8_STAGE(PG8_SB(0, 1), b2 + hstepB, voffB);
            PG8_WAIT_V(6); PG8_BAR; PG8_MMA(1, 1, At, B1); PG8_BAR;
            PG8_LDB(B0, 1, 0); PG8_SCHED; PG8_LDA(At, 1, 0); PG8_STAGE(PG8_SA(0, 1), a2 + hstepA, voffA);
            PG8_WAIT_L(8); PG8_BAR; PG8_WAIT_L(0); PG8_MMA(0, 0, At, B0); PG8_BAR; PG8_SCHED;
            PG8_LDB(B1, 1, 1); PG8_STAGE(PG8_SB(1, 0), b3, voffB);
            PG8_BAR; PG8_WAIT_L(0); PG8_MMA(0, 1, At, B1); PG8_BAR;
            PG8_LDA(At, 1, 1); PG8_STAGE(PG8_SA(1, 0), a3, voffA);
            PG8_BAR; PG8_WAIT_L(0); PG8_MMA(1, 0, At, B0); PG8_BAR; PG8_SCHED;
            PG8_STAGE(PG8_SB(1, 1), b3 + hstepB, voffB);
            PG8_WAIT_V(6); PG8_BAR; PG8_MMA(1, 1, At, B1); PG8_BAR;
        }
        E(acc, cur, wr, wc, fr, fq);
        if (!has_next) break;
#pragma unroll
        for (int a = 0; a < 2; ++a)
#pragma unroll
            for (int b = 0; b < 2; ++b)
#pragma unroll
                for (int m = 0; m < 4; ++m)
#pragma unroll
                    for (int n = 0; n < 2; ++n) acc[a][b][m][n] = (f32x4){0.f, 0.f, 0.f, 0.f};
        cur = nxt; cA = nA; cB = nB; ++ui;
    }
    PG8_WAIT_V(0);
    if (wr == 0) PG8_BAR;
    PG8_BAR;
#undef PG8_SA
#undef PG8_SB
#undef PG8_STAGE
#undef PG8_LDA
#undef PG8_LDB
#undef PG8_MMA
#undef PG8_WAIT_V
#undef PG8_WAIT_L
#undef PG8_BAR
#undef PG8_SCHED
}

struct EpiProj {
    bf16_t* qkv; bf16_t* sg; float qscale; unsigned* kmaxw; const float* hsc; const float* wsc;
    __device__ __forceinline__ void operator()(const f32x4 (&acci)[2][2][4][2], const Unit& u, int wr, int wc, int fr, int fq) const {
        const int row0 = u.pm * BM + wr * 64 + fr;
        f32x4 acc[2][2][4][2];
        { f32x4 cs[2][2];
#pragma unroll
          for (int bj = 0; bj < 2; ++bj)
#pragma unroll
              for (int n = 0; n < 2; ++n) cs[bj][n] = *(const f32x4*)(wsc + u.pn * BM + bj * HALF + wc * 32 + 8 * fq + 4 * n);
#pragma unroll
          for (int ai = 0; ai < 2; ++ai)
#pragma unroll
              for (int m = 0; m < 4; ++m) { const float rsc = hsc[row0 + ai * HALF + m * 16];
#pragma unroll
                  for (int bj = 0; bj < 2; ++bj)
#pragma unroll
                      for (int n = 0; n < 2; ++n) { const i32x4 iv = __builtin_bit_cast(i32x4, acci[ai][bj][m][n]);
                          acc[ai][bj][m][n] = (f32x4){(float)iv[0], (float)iv[1], (float)iv[2], (float)iv[3]} * rsc * cs[bj][n]; } } }
        if (u.pn < 24) {
            const int t = u.pn >> 2; bf16_t* base = qkv + (size_t)t * ((size_t)T_TOK * 1024) + (u.pn & 3) * 256 + wc * 32 + 8 * fq;
            const float sc = (t == 0 || t == 3) ? qscale : 1.f;
            if (t == 4) {
#pragma unroll
                for (int bj = 0; bj < 2; ++bj) { float mxv = 0.f;
#pragma unroll
                    for (int ai = 0; ai < 2; ++ai)
#pragma unroll
                        for (int m = 0; m < 4; ++m) { const f32x4 v0 = acc[ai][bj][m][0], v1 = acc[ai][bj][m][1];
                            float ssq = (v0[0] * v0[0] + v0[1] * v0[1]) + (v0[2] * v0[2] + v0[3] * v0[3]) + (v1[0] * v1[0] + v1[1] * v1[1]) + (v1[2] * v1[2] + v1[3] * v1[3]);
                            ssq += __shfl_xor(ssq, 16); ssq += __shfl_xor(ssq, 32); mxv = fmaxf(mxv, ssq); }
#pragma unroll
                    for (int o = 1; o < 16; o <<= 1) mxv = fmaxf(mxv, __shfl_xor(mxv, o));
                    if ((fr | fq) == 0) atomicMax(kmaxw + ((u.pm >> 4) * 8 + (u.pn & 3) * 2 + bj) * 4 + wc, __builtin_bit_cast(unsigned, mxv)); }
            }
#pragma unroll
            for (int ai = 0; ai < 2; ++ai)
#pragma unroll
                for (int m = 0; m < 4; ++m) { bf16_t* rowp = base + (size_t)(row0 + ai * HALF + m * 16) * 1024;
#pragma unroll
                    for (int bj = 0; bj < 2; ++bj) { const f32x4 v0 = acc[ai][bj][m][0] * sc, v1 = acc[ai][bj][m][1] * sc;
                        u32x4 w; w.x = pk2(v0[0], v0[1]); w.y = pk2(v0[2], v0[3]); w.z = pk2(v1[0], v1[1]); w.w = pk2(v1[2], v1[3]);
                        *(u32x4*)(rowp + bj * HALF) = w; } }
        } else {
            bf16_t* base = sg + (u.pn - 24) * 256 + wc * 32 + 8 * fq;
#pragma unroll
            for (int ai = 0; ai < 2; ++ai)
#pragma unroll
                for (int m = 0; m < 4; ++m) { bf16_t* rowp = base + (size_t)(row0 + ai * HALF + m * 16) * 4096;
#pragma unroll
                    for (int bj = 0; bj < 2; ++bj) { float s[8];
#pragma unroll
                        for (int e = 0; e < 4; ++e) { s[e] = frcp(1.f + fexp2(-LOG2E * acc[ai][bj][m][0][e])); s[4 + e] = frcp(1.f + fexp2(-LOG2E * acc[ai][bj][m][1][e])); }
                        u32x4 w; w.x = pk2(s[0], s[1]); w.y = pk2(s[2], s[3]); w.z = pk2(s[4], s[5]); w.w = pk2(s[6], s[7]);
                        *(u32x4*)(rowp + bj * HALF) = w; } }
        }
    }
};
template <int SECOND> struct EpiGate {
    const bf16_t* sg;
    bf16_t* tmp; bf16_t* merged;
    __device__ __forceinline__ void operator()(const f32x4 (&acc)[2][2][4][2], const Unit& u, int wr, int wc, int fr, int fq) const {
        const int row0 = u.pm * BM + wr * 64 + fr, col0 = u.pn * BM + wc * 32 + 8 * fq;
#pragma unroll
        for (int ai = 0; ai < 2; ++ai)
#pragma unroll
            for (int m = 0; m < 4; ++m) { const size_t row = (size_t)(row0 + ai * HALF + m * 16);
#pragma unroll
                for (int bj = 0; bj < 2; ++bj) { const int col = col0 + bj * HALF;
                    const u32x4 gv = *(const u32x4*)(sg + row * 4096 + col);
                    const f32x4 g0 = {bf_lo(gv.x), bf_hi(gv.x), bf_lo(gv.y), bf_hi(gv.y)}, g1 = {bf_lo(gv.z), bf_hi(gv.z), bf_lo(gv.w), bf_hi(gv.w)};
                    f32x4 v0 = acc[ai][bj][m][0] * g0, v1 = acc[ai][bj][m][1] * g1;
                    bf16_t* tp = tmp + row * DM + col;
                    if (SECOND == 0) { u32x4 w; w.x = pk2(v0[0], v0[1]); w.y = pk2(v0[2], v0[3]); w.z = pk2(v1[0], v1[1]); w.w = pk2(v1[2], v1[3]); *(u32x4*)tp = w; }
                    else { const u32x4 tv = *(const u32x4*)tp; v0 += (f32x4){bf_lo(tv.x), bf_hi(tv.x), bf_lo(tv.y), bf_hi(tv.y)}; v1 += (f32x4){bf_lo(tv.z), bf_hi(tv.z), bf_lo(tv.w), bf_hi(tv.w)};
                        u32x4 w; w.x = pk2(v0[0], v0[1]); w.y = pk2(v0[2], v0[3]); w.z = pk2(v1[0], v1[1]); w.w = pk2(v1[2], v1[3]);
                        *(u32x4*)(merged + row * DM + col) = w; } } }
    }
};
struct EpiResid {
    const float* x; float* x1; bf16_t* x1b; float* rowss;
    __device__ __forceinline__ void operator()(const f32x4 (&acc)[2][2][4][2], const Unit& u, int wr, int wc, int fr, int fq) const {
        const int row0 = u.pm * BM + wr * 64 + fr, col0 = u.pn * BM + wc * 32 + 8 * fq;
#pragma unroll
        for (int ai = 0; ai < 2; ++ai)
#pragma unroll
            for (int m = 0; m < 4; ++m) { const size_t row = (size_t)(row0 + ai * HALF + m * 16); float ss = 0.f;
#pragma unroll
                for (int bj = 0; bj < 2; ++bj) { const size_t o = row * DM + col0 + bj * HALF;
                    const f32x4 v0 = acc[ai][bj][m][0] + *(const f32x4*)(x + o), v1 = acc[ai][bj][m][1] + *(const f32x4*)(x + o + 4);
                    u32x4 w; w.x = pk2(v0[0], v0[1]); w.y = pk2(v0[2], v0[3]); w.z = pk2(v1[0], v1[1]); w.w = pk2(v1[2], v1[3]);
                    *(u32x4*)(x1b + o) = w;
                    ss += (v0[0] * v0[0] + v0[1] * v0[1]) + (v0[2] * v0[2] + v0[3] * v0[3]) + (v1[0] * v1[0] + v1[1] * v1[1]) + (v1[2] * v1[2] + v1[3] * v1[3]); }
                ss += __shfl_xor(ss, 16); ss += __shfl_xor(ss, 32);
                if (fq == 0) atomicAdd(rowss + row, ss); }
    }
};
struct EpiPlainBf16 {
    bf16_t* o;
    __device__ __forceinline__ void operator()(const f32x4 (&acc)[2][2][4][2], const Unit& u, int wr, int wc, int fr, int fq) const {
        const int row0 = u.pm * BM + wr * 64 + fr, col0 = u.pn * BM + wc * 32 + 8 * fq;
#pragma unroll
        for (int ai = 0; ai < 2; ++ai)
#pragma unroll
            for (int m = 0; m < 4; ++m) { const size_t row = (size_t)(row0 + ai * HALF + m * 16);
#pragma unroll
                for (int bj = 0; bj < 2; ++bj) { const f32x4 v0 = acc[ai][bj][m][0], v1 = acc[ai][bj][m][1];
                    u32x4 w; w.x = pk2(v0[0], v0[1]); w.y = pk2(v0[2], v0[3]); w.z = pk2(v1[0], v1[1]); w.w = pk2(v1[2], v1[3]);
                    *(u32x4*)(o + row * DM + col0 + bj * HALF) = w; } }
    }
};
}

__device__ __forceinline__ void transpose_item(const float* W, int ldw, int src_n0, bf16_t* WT, int K, int dst_n0, int k0, LAS float* scr, int lane, const float* kscale) {
    { const int c4 = (lane & 7) * 4;
      f32x4 v[8];
#pragma unroll
      for (int i = 0; i < 8; ++i) v[i] = *(const f32x4*)(W + (size_t)(k0 + 8 * i + (lane >> 3)) * ldw + src_n0 + c4);
#pragma unroll
      for (int i = 0; i < 8; ++i) { const int kk = 8 * i + (lane >> 3); const float ks = kscale ? kscale[k0 + kk] : 1.f; LAS float* sp = scr + kk * 33 + c4;
          sp[0] = v[i][0] * ks; sp[1] = v[i][1] * ks; sp[2] = v[i][2] * ks; sp[3] = v[i][3] * ks; } }
    LDS_WAIT();
    const int c = lane & 7;
#pragma unroll
    for (int j = 0; j < 4; ++j) { const int n = (lane >> 3) + 8 * j; const LAS float* s = scr + (8 * c) * 33 + n;
        u32x4 o; o.x = pk2(s[0 * 33], s[1 * 33]); o.y = pk2(s[2 * 33], s[3 * 33]); o.z = pk2(s[4 * 33], s[5 * 33]); o.w = pk2(s[6 * 33], s[7 * 33]);
        *(u32x4*)(WT + (size_t)(dst_n0 + n) * K + k0 + 8 * c) = o; }
    LDS_WAIT();
}

__device__ __forceinline__ void p0a(const Params& P, LAS unsigned char* lds, int vcu, int G) {
    const int tid = threadIdx.x, lane = tid & 63, wave = __builtin_amdgcn_readfirstlane(tid >> 6);
    const int gw = vcu * NWAVES + wave, NGW = G * NWAVES;
    unsigned char* ws = P.ws;
    {
        unsigned* CMAX = (unsigned*)(ws + WS_CTL + CTL_CMAX);
        constexpr int NCB = (10248 + 255) / 256;
        for (int it = gw; it < 128 * NCB; it += NGW) { const int kb = it / NCB, cb = it % NCB, sc = cb * 256 + 4 * lane;
            if (sc < 10248) { f32x4 v[16];
#pragma unroll
                for (int r = 0; r < 16; ++r) v[r] = *(const f32x4*)(P.w_in + (size_t)(kb * 16 + r) * 10248 + sc);
                float m0 = 0.f, m1 = 0.f, m2 = 0.f, m3 = 0.f;
#pragma unroll
                for (int r = 0; r < 16; ++r) { m0 = fmaxf(m0, fabsf(v[r][0])); m1 = fmaxf(m1, fabsf(v[r][1])); m2 = fmaxf(m2, fabsf(v[r][2])); m3 = fmaxf(m3, fabsf(v[r][3])); }
                const float mm[4] = {m0, m1, m2, m3};
#pragma unroll
                for (int e = 0; e < 4; ++e) { const int c = sc + e; const unsigned mb = __float_as_uint(mm[e]);
                    if (c < 6144) atomicMax(CMAX + c, mb); else if (c >= 6152) atomicMax(CMAX + c - 8, mb); } } }
    }
    {
        LAS float* wf = (LAS float*)lds;
        for (int k = tid; k < 2048; k += NTHR) { const f32x4 a0 = *(const f32x4*)(P.w_in + (size_t)k * 10248 + 6144), a1 = *(const f32x4*)(P.w_in + (size_t)k * 10248 + 6148);
            wf[k] = a0[0]; wf[2048 + k] = a0[1]; wf[4096 + k] = a0[2]; wf[6144 + k] = a0[3]; wf[8192 + k] = a1[0]; wf[10240 + k] = a1[1]; wf[12288 + k] = a1[2]; wf[14336 + k] = a1[3]; }
        __syncthreads();
        unsigned char* HQ8 = ws + WS_H; float* HSC = (float*)(ws + WS_HSC); float* LOGF = (float*)(ws + WS_LOGF);
        f32x4 xn[8];
        if (gw < T_TOK) { const f32x4* xr = (const f32x4*)(P.x + (size_t)gw * DM) + lane;
#pragma unroll
            for (int j = 0; j < 8; ++j) xn[j] = xr[64 * j]; }
        for (int r = gw; r < T_TOK; r += NGW) {
            float ss = 0.f, amx = 0.f; f32x4 hv[8];
#pragma unroll
            for (int j = 0; j < 8; ++j) { const f32x4 v = xn[j]; const f32x4 gn = *((const f32x4*)P.g_mix + lane + 64 * j); ss += (v[0] * v[0] + v[1] * v[1]) + (v[2] * v[2] + v[3] * v[3]);
                hv[j] = v * gn; amx = fmaxf(amx, fmaxf(fmaxf(fabsf(hv[j][0]), fabsf(hv[j][1])), fmaxf(fabsf(hv[j][2]), fabsf(hv[j][3])))); }
            if (r + NGW < T_TOK) { const f32x4* xr = (const f32x4*)(P.x + (size_t)(r + NGW) * DM) + lane;
#pragma unroll
                for (int j = 0; j < 8; ++j) xn[j] = xr[64 * j]; }
            const float rstd = 1.0f / sqrtf(wave_sum(ss) * (1.f / DM) + EPS);
#pragma unroll
            for (int o = 1; o < 64; o <<= 1) amx = fmaxf(amx, __shfl_xor(amx, o));
            const float hmax = fmaxf(amx * rstd, 1e-30f), hinv = 127.f / hmax;
            float fl[8];
#pragma unroll
            for (int c = 0; c < 8; ++c) fl[c] = 0.f;
            unsigned* hp = (unsigned*)(HQ8 + (size_t)r * DM) + lane;
#pragma unroll
            for (int j = 0; j < 8; ++j) { const f32x4 h = hv[j] * rstd;
                unsigned w = 0;
#pragma unroll
                for (int e = 0; e < 4; ++e) w |= ((unsigned)(int)__builtin_rintf(h[e] * hinv) & 255u) << (8 * e);
                hp[64 * j] = w;
#pragma unroll
                for (int c = 0; c < 8; ++c) { const f32x4 wv = *((const LAS f32x4*)(wf + c * 2048) + lane + 64 * j); fl[c] += (h[0] * wv[0] + h[1] * wv[1]) + (h[2] * wv[2] + h[3] * wv[3]); }
                __builtin_amdgcn_sched_barrier(0); }
            { const bool b5 = (lane >> 5) & 1, b4 = (lane >> 4) & 1, b3 = (lane >> 3) & 1; float p1[4], p2[2], p3;
#pragma unroll
              for (int q = 0; q < 4; ++q) { const float send = b5 ? fl[q] : fl[q + 4], keep = b5 ? fl[q + 4] : fl[q]; p1[q] = keep + __shfl_xor(send, 32); }
#pragma unroll
              for (int q = 0; q < 2; ++q) { const float send = b4 ? p1[q] : p1[q + 2], keep = b4 ? p1[q + 2] : p1[q]; p2[q] = keep + __shfl_xor(send, 16); }
              { const float send = b3 ? p2[0] : p2[1], keep = b3 ? p2[1] : p2[0]; p3 = keep + __shfl_xor(send, 8); }
              p3 += __shfl_xor(p3, 4); p3 += __shfl_xor(p3, 2); p3 += __shfl_xor(p3, 1);
              if (lane == 0) HSC[r] = hmax * (1.f / 127.f);
              if ((lane & 7) == 0) { const int c = lane >> 3; const float y = p3 + P.b_forget[c]; LOGF[((size_t)(r >> 12) * 8 + c) * SEQ + (r & (SEQ - 1))] = fminf(y, 0.f) - log1pf(expf(-fabsf(y))); } }
        }
    }
    {
        const size_t gid = (size_t)vcu * NTHR + tid, gstride = (size_t)G * NTHR;
        for (size_t i = gid; i < 262144 / 8; i += gstride) { const float* src = P.sub_keys + i * 8; const f32x4 a = *(const f32x4*)src, b = *((const f32x4*)src + 1);
            u32x4 o; o.x = pk2(a[0], a[1]); o.y = pk2(a[2], a[3]); o.z = pk2(b[0], b[1]); o.w = pk2(b[2], b[3]); *(u32x4*)((bf16_t*)(ws + WS_SKB) + i * 8) = o; }
    }
}
__device__ __forceinline__ void p0b(const Params& P, LAS unsigned char* lds, int vcu, int G) {
    const int tid = threadIdx.x, lane = tid & 63, wave = __builtin_amdgcn_readfirstlane(tid >> 6);
    const int gw = vcu * NWAVES + wave, NGW = G * NWAVES;
    unsigned char* ws = P.ws;
    const unsigned* CMAX = (const unsigned*)(ws + WS_CTL + CTL_CMAX); float* WSC = (float*)(ws + WS_WSC); unsigned char* WT8 = ws + WS_WIN;
    LAS float* scr = (LAS float*)(lds + wave * 16384);
    for (int it = gw; it < 32 * 320; it += NGW) {
        const int nb = it >> 5, kb = it & 31, dn = nb * 32, sn = dn < 6144 ? dn : dn + 8, k0 = kb * 64;
        const int c4 = (lane & 7) * 4;
        float inv[4];
#pragma unroll
        for (int e = 0; e < 4; ++e) { const float cm = fmaxf(__uint_as_float(__hip_atomic_load(CMAX + dn + c4 + e, __ATOMIC_RELAXED, __HIP_MEMORY_SCOPE_AGENT)), 1e-30f); inv[e] = 127.f / cm;
            if (kb == 0 && lane < 8) WSC[dn + c4 + e] = cm * (1.f / 127.f); }
        f32x4 v[8];
#pragma unroll
        for (int i = 0; i < 8; ++i) v[i] = *(const f32x4*)(P.w_in + (size_t)(k0 + 8 * i + (lane >> 3)) * 10248 + sn + c4);
#pragma unroll
        for (int i = 0; i < 8; ++i) { LAS float* sp = scr + (8 * i + (lane >> 3)) * 33 + c4; sp[0] = v[i][0] * inv[0]; sp[1] = v[i][1] * inv[1]; sp[2] = v[i][2] * inv[2]; sp[3] = v[i][3] * inv[3]; }
        LDS_WAIT();
        const int c = lane & 3;
#pragma unroll
        for (int j = 0; j < 2; ++j) { const int n = (lane >> 2) + 16 * j; const LAS float* sp = scr + (16 * c) * 33 + n;
            u32x4 o;
#pragma unroll
            for (int w4 = 0; w4 < 4; ++w4) { unsigned w = 0;
#pragma unroll
                for (int e = 0; e < 4; ++e) w |= ((unsigned)(int)fminf(fmaxf(__builtin_rintf(sp[(4 * w4 + e) * 33]), -127.f), 127.f) & 255u) << (8 * e);
                o[w4] = w; }
            *(u32x4*)(WT8 + (size_t)(dn + n) * 2048 + k0 + 16 * c) = o; }
        LDS_WAIT();
    }
}
__device__ __forceinline__ void late_transposes(const Params& P, LAS unsigned char* lds, int vcu, int G) {
    const int tid = threadIdx.x, lane = tid & 63, wave = __builtin_amdgcn_readfirstlane(tid >> 6);
    const int gw = vcu * NWAVES + wave, NGW = G * NWAVES;
    unsigned char* ws = P.ws;
    LAS float* scr = (LAS float*)(lds + wave * 16384);
    constexpr int I_A = 16 * 64, I_O = 32 * 64, NITEMS = 2 * I_A + 2 * I_O;
    for (int it = gw; it < NITEMS; it += NGW) {
        int r = it;
        if (r < I_A) { const int kb = r / 64, nb = r % 64; transpose_item(P.w_a, 2048, nb * 32, (bf16_t*)(ws + WS_WAT), 1024, nb * 32, kb * 64, scr, lane, nullptr); continue; } r -= I_A;
        if (r < I_A) { const int kb = r / 64, nb = r % 64; transpose_item(P.w_b, 2048, nb * 32, (bf16_t*)(ws + WS_WBT), 1024, nb * 32, kb * 64, scr, lane, nullptr); continue; } r -= I_A;
        if (r < I_O) { const int kb = r / 64, nb = r % 64; transpose_item(P.w_out, 2048, nb * 32, (bf16_t*)(ws + WS_WOUT), 2048, nb * 32, kb * 64, scr, lane, nullptr); continue; } r -= I_O;
        { const int kb = r / 64, nb = r % 64; transpose_item(P.w_query, 2048, nb * 32, (bf16_t*)(ws + WS_WQ), 2048, nb * 32, kb * 64, scr, lane, P.g_ffn); }
    }
}
__device__ __forceinline__ void quantise_expert_rows(const Params& P, int r0, int nrows) {
    const int lane = threadIdx.x & 63;
    unsigned char* ws = P.ws;
    float* SU = (float*)(ws + WS_SU); float* SV = (float*)(ws + WS_SV);
    for (int r = r0; r < r0 + nrows; r += 2) {
        f32x4 v[2][8];
#pragma unroll
        for (int t = 0; t < 2; ++t) { const int rr = r + t; const f32x4* src = (const f32x4*)((rr >= 16384 ? P.e_v : P.e_u) + (size_t)(rr & 16383) * DM) + lane;
#pragma unroll
            for (int j = 0; j < 8; ++j) v[t][j] = __builtin_nontemporal_load(src + 64 * j); }
#pragma unroll
        for (int t = 0; t < 2; ++t) { const int rr = r + t; const bool second = rr >= 16384; const int row = rr & 16383;
            float mx = 0.f;
#pragma unroll
            for (int j = 0; j < 8; ++j) mx = fmaxf(mx, fmaxf(fmaxf(fabsf(v[t][j][0]), fabsf(v[t][j][1])), fmaxf(fabsf(v[t][j][2]), fabsf(v[t][j][3]))));
#pragma unroll
            for (int o = 1; o < 64; o <<= 1) mx = fmaxf(mx, __shfl_xor(mx, o));
            mx = fmaxf(mx, 1e-30f);
            const float inv = 127.f / mx;
            unsigned* dst = (unsigned*)(ws + (second ? WS_EV : WS_EU) + (size_t)row * DM) + lane;
#pragma unroll
            for (int j = 0; j < 8; ++j) { unsigned w = 0;
#pragma unroll
                for (int e = 0; e < 4; ++e) { const int q = (int)__builtin_rintf(v[t][j][e] * inv); w |= ((unsigned)q & 255u) << (8 * e); }
                dst[64 * j] = w; }
            if (lane == 0) (second ? SV : SU)[row] = mx * (1.f / 127.f);
        }
    }
}

namespace att {
constexpr int KST = 272, VST = 320;
constexpr int KBUF = 64 * KST, VBUF = 64 * VST;
constexpr int OFF_K = 0, OFF_V = 2 * KBUF, OFF_F = OFF_V + 2 * VBUF, OFF_SC = OFF_F + 4096 * 4;
constexpr int OFF_FLG = OFF_SC + 64, OFF_UNIT = OFF_FLG + 64;
static_assert(OFF_UNIT + 16 <= 131072, "attention LDS");
constexpr float THR_SB = 30.f, THR_FOX = 20.f;

__device__ __forceinline__ void build_cumf(LAS unsigned char* lds, const float* LOGF, int b, int h, int n, int tid, int lane, int wid) {
    LAS float* F2 = (LAS float*)(lds + OFF_F); LAS float* sc = (LAS float*)(lds + OFF_SC);
    const int s0 = tid * 8; float v[8];
    { const f32x4* lp = (const f32x4*)(LOGF + ((size_t)b * 8 + h) * SEQ + s0); f32x4 a0 = {0.f, 0.f, 0.f, 0.f}, a1 = a0; if (s0 < n) { a0 = lp[0]; a1 = lp[1]; }
      v[0] = a0[0] * LOG2E; v[1] = a0[1] * LOG2E; v[2] = a0[2] * LOG2E; v[3] = a0[3] * LOG2E; v[4] = a1[0] * LOG2E; v[5] = a1[1] * LOG2E; v[6] = a1[2] * LOG2E; v[7] = a1[3] * LOG2E; }
#pragma unroll
    for (int i = 1; i < 8; ++i) v[i] += v[i - 1];
    float tot = v[7], inc = tot;
#pragma unroll
    for (int o = 1; o < 64; o <<= 1) { const float t = __shfl_up(inc, o); if (lane >= o) inc += t; }
    if (lane == 63) sc[wid] = inc;
    __syncthreads();
    float base = inc - tot;
#pragma unroll
    for (int w = 0; w < 8; ++w) if (w < wid) base += sc[w];
    if (s0 < n) {
#pragma unroll
        for (int i = 0; i < 8; ++i) F2[s0 + i] = v[i] + base;
    }
    __syncthreads();
}

template <int MIXER>
__device__ __forceinline__ void attn_unit(LAS unsigned char* lds, const bf16_t* Q, const bf16_t* Kg, const bf16_t* Vg, bf16_t* O, int b, int h, int qb, float kmax, int tid, int lane, int wid) {
    const int c = lane & 31, hh = lane >> 5;
    const int t0 = qb * 256 + wid * 32, tq = t0 + c;
    const size_t rowbase = (size_t)b * SEQ;
    size_t qoff = (rowbase + tq) * 1024 + h * HD + 8 * hh;
    f32x16 oacc[4];
#pragma unroll
    for (int d = 0; d < 4; ++d)
#pragma unroll
        for (int r = 0; r < 16; ++r) oacc[d][r] = 0.f;
    float carry = 0.f, mrun = -1e30f, lsum = 0.f; const float nhf = hh ? 0.f : 1.f;
    const LAS float* F2 = (const LAS float*)(lds + OFF_F);
    const float Ft = (MIXER == 1) ? F2[tq] : 0.f;
    float qk_bound = 0.f;
    if (MIXER == 1) { float qs = 0.f;
#pragma unroll
        for (int s2 = 0; s2 < 8; ++s2) { const u32x4 qv = *(const u32x4*)(Q + qoff + 16 * s2);
#pragma unroll
            for (int e = 0; e < 4; ++e) { const float a = bf_lo(qv[e]), b2 = bf_hi(qv[e]); qs += a * a + b2 * b2; } }
        qs += __shfl_xor(qs, 32);
        qk_bound = sqrtf(qs) * kmax; }
    bool wave_done = false;
    volatile LAS unsigned* flg = (volatile LAS unsigned*)(lds + OFF_FLG);
    const int ktmax = 4 * qb + 3;
    const int srow = tid >> 4, scc = tid & 15;
    u32x4 kr[2], vr[2];
#define ATT_LOAD(kt) do { _Pragma("unroll") for (int j = 0; j < 2; ++j) { const size_t g_ = (rowbase + 64 * (kt) + srow + 32 * j) * 1024 + h * HD + scc * 8; \
        kr[j] = *(const u32x4*)(Kg + g_); vr[j] = *(const u32x4*)(Vg + g_); } } while (0)
#define ATT_WRITE(buf) do { _Pragma("unroll") for (int j = 0; j < 2; ++j) { \
        *(LAS u32x4*)(lds + OFF_K + (buf) * KBUF + (srow + 32 * j) * KST + scc * 16) = kr[j]; \
        *(LAS u32x4*)(lds + OFF_V + (buf) * VBUF + (srow + 32 * j) * VST + scc * 16) = vr[j]; } } while (0)
    ATT_LOAD(ktmax); ATT_WRITE(0); __syncthreads();
    int buf = 0;
    for (int kt = ktmax; kt >= 0; --kt) {
        if (kt > 0) ATT_LOAD(kt - 1);
        const bool started = (64 * kt <= t0 + 31);
        if (started && !wave_done) {
            const LAS unsigned char* Kl = lds + OFF_K + buf * KBUF; const LAS unsigned char* Vl = lds + OFF_V + buf * VBUF;
            f32x16 sacc[2];
            asm volatile("" : "+v"(qoff));
            bf16x8 qf[8];
#pragma unroll
            for (int s = 0; s < 8; ++s) qf[s] = *(const bf16x8*)(Q + qoff + 16 * s);
#pragma unroll
            for (int sub = 0; sub < 2; ++sub) {
#pragma unroll
                for (int r = 0; r < 16; ++r) sacc[sub][r] = 0.f;
#pragma unroll
                for (int s = 0; s < 8; ++s) { const bf16x8 kf = *(const LAS bf16x8*)(Kl + (32 * sub + c) * KST + (16 * s + 8 * hh) * 2);
                    sacc[sub] = __builtin_amdgcn_mfma_f32_32x32x16_bf16(kf, qf[s], sacc[sub], 0, 0, 0); }
            }
            const bool need_mask = (64 * kt + 63 >= t0);
            bool tile_dead = false;
            if (MIXER == 0) {
#pragma unroll
                for (int sub = 1; sub >= 0; --sub) {
                    float lb[16];
#pragma unroll
                    for (int r = 0; r < 16; ++r) { const float z = sacc[sub][r]; float l = -flog2(1.f + fexp2(z));
                        if (need_mask) { const int sidx = 64 * kt + 32 * sub + (r & 3) + 8 * (r >> 2) + 4 * hh; l = (sidx < tq) ? l : 0.f; }
                        lb[r] = l; }
                    float Glo[4], Ghi[4];
#pragma unroll
                    for (int g = 0; g < 4; ++g) { lb[4 * g + 2] += lb[4 * g + 3]; lb[4 * g + 1] += lb[4 * g + 2]; lb[4 * g] += lb[4 * g + 1];
                        const unsigned gu = __builtin_bit_cast(unsigned, lb[4 * g]); const auto rr = __builtin_amdgcn_permlane32_swap(gu, gu, false, false);
                        Glo[g] = __builtin_bit_cast(float, (unsigned)rr[0]); Ghi[g] = __builtin_bit_cast(float, (unsigned)rr[1]); }
                    float E[8];
                    E[7] = carry; E[6] = E[7] + Ghi[3]; E[5] = E[6] + Glo[3]; E[4] = E[5] + Ghi[2]; E[3] = E[4] + Glo[2]; E[2] = E[3] + Ghi[1]; E[1] = E[2] + Glo[1]; E[0] = E[1] + Ghi[0];
                    carry = E[0] + Glo[0];
#pragma unroll
                    for (int g = 0; g < 4; ++g) { const float Eo = __builtin_fmaf(nhf, Ghi[g], E[2 * g + 1]);
#pragma unroll
                        for (int i = 0; i < 4; ++i) { const int r = 4 * g + i; float w = fexp2(sacc[sub][r] + lb[r] + Eo);
                            if (need_mask) { const int sidx = 64 * kt + 32 * sub + (r & 3) + 8 * (r >> 2) + 4 * hh; w = (sidx < tq) ? w : 0.f; }
                            sacc[sub][r] = w; } }
                }
            } else {
                float mx = -1e30f;
#pragma unroll
                for (int sub = 0; sub < 2; ++sub)
#pragma unroll
                    for (int g = 0; g < 4; ++g) { const f32x4 fs = *(const LAS f32x4*)(F2 + 64 * kt + 32 * sub + 8 * g + 4 * hh);
#pragma unroll
                        for (int i = 0; i < 4; ++i) { const int r = 4 * g + i; float xv = sacc[sub][r] + (Ft - fs[i]);
                            if (need_mask) { const int sidx = 64 * kt + 32 * sub + 8 * g + 4 * hh + i; xv = (sidx <= tq) ? xv : -1e30f; }
                            sacc[sub][r] = xv; mx = fmaxf(mx, xv); } }
                { const unsigned mu = __builtin_bit_cast(unsigned, mx); const auto rr = __builtin_amdgcn_permlane32_swap(mu, mu, false, false);
                  mx = fmaxf(__builtin_bit_cast(float, (unsigned)rr[0]), __builtin_bit_cast(float, (unsigned)rr[1])); }
                tile_dead = __all(mx - mrun < -THR_FOX);
                if (!tile_dead) {
                const float mnew = fmaxf(mrun, mx);
                const float alpha = fexp2(mrun - mnew);
                float ps = 0.f;
#pragma unroll
                for (int sub = 0; sub < 2; ++sub)
#pragma unroll
                    for (int r = 0; r < 16; ++r) { const float p = fexp2(sacc[sub][r] - mnew); sacc[sub][r] = p; ps += p; }
                lsum = lsum * alpha + ps;
                if (__any(mnew > mrun)) {
#pragma unroll
                    for (int d = 0; d < 4; ++d)
#pragma unroll
                        for (int r = 0; r < 16; ++r) oacc[d][r] *= alpha;
                }
                mrun = mnew;
                }
            }
            if (!tile_dead)
#pragma unroll
            for (int ks = 0; ks < 4; ++ks) { const int sub = ks >> 1, rb = 8 * (ks & 1);
                u32x4 pw; pw.x = pk2(sacc[sub][rb + 0], sacc[sub][rb + 1]); pw.y = pk2(sacc[sub][rb + 2], sacc[sub][rb + 3]); pw.z = pk2(sacc[sub][rb + 4], sacc[sub][rb + 5]); pw.w = pk2(sacc[sub][rb + 6], sacc[sub][rb + 7]);
                const bf16x8 pf = __builtin_bit_cast(bf16x8, pw);
                const LAS unsigned char* vb = Vl + (16 * ks + 4 * hh + ((lane & 15) >> 2)) * VST + (16 * ((lane >> 4) & 1) + 4 * (lane & 3)) * 2;
#pragma unroll
                for (int d = 0; d < 4; ++d) {
                    const s16x4 a0 = __builtin_amdgcn_ds_read_tr16_b64_v4i16((LAS s16x4*)(vb + d * 64));
                    const s16x4 a1 = __builtin_amdgcn_ds_read_tr16_b64_v4i16((LAS s16x4*)(vb + d * 64 + 8 * VST));
                    const bf16x8 af = {a0[0], a0[1], a0[2], a0[3], a1[0], a1[1], a1[2], a1[3]};
                    oacc[d] = __builtin_amdgcn_mfma_f32_32x32x16_bf16(af, pf, oacc[d], 0, 0, 0); }
            }
        }
        if (kt > 0) ATT_WRITE(buf ^ 1);
        if (kt > 0 && started && !wave_done) {
            if (MIXER == 0) wave_done = __all(carry < -THR_SB);
            else wave_done = __all(qk_bound + (Ft - F2[64 * kt - 1]) - mrun < -THR_FOX);
        }
        if (lane == 0) flg[(kt & 1) * 8 + wid] = wave_done ? 1u : 0u;
        __syncthreads();
        buf ^= 1;
        { unsigned alld = 1u;
#pragma unroll
          for (int w = 0; w < 8; ++w) alld &= flg[(kt & 1) * 8 + w];
          if (alld) break; }
    }
#undef ATT_LOAD
#undef ATT_WRITE
    float inv = 1.f;
    if (MIXER == 1) { const unsigned lu = __builtin_bit_cast(unsigned, lsum); const auto rr = __builtin_amdgcn_permlane32_swap(lu, lu, false, false);
        inv = 1.f / (__builtin_bit_cast(float, (unsigned)rr[0]) + __builtin_bit_cast(float, (unsigned)rr[1])); }
    bf16_t* op = O + (rowbase + tq) * 2048 + 4 * hh;
#pragma unroll
    for (int d = 0; d < 4; ++d)
#pragma unroll
        for (int g = 0; g < 4; ++g) { u32x2 w; w.x = pk2(oacc[d][4 * g] * inv, oacc[d][4 * g + 1] * inv); w.y = pk2(oacc[d][4 * g + 2] * inv, oacc[d][4 * g + 3] * inv);
            *(u32x2*)(op + 32 * d + 8 * g) = w; }
}

__device__ __forceinline__ void attn_phase(const Params& P, LAS unsigned char* lds, int vcu, int G) {
    const int tid = threadIdx.x, lane = tid & 63, wid = __builtin_amdgcn_readfirstlane(tid >> 6);
    unsigned char* ws = P.ws;
    const bf16_t* QKV = (const bf16_t*)(ws + WS_QKV); const size_t TS = (size_t)T_TOK * 1024;
    bf16_t* OAB = (bf16_t*)(ws + WS_H); const float* LOGF = (const float*)(ws + WS_LOGF);
    unsigned* qctr = (unsigned*)(ws + WS_CTL + 196608);
    const unsigned* KMAXW = (const unsigned*)(ws + WS_CTL + 200704);
    volatile LAS unsigned* uw = (volatile LAS unsigned*)(lds + OFF_UNIT);
    for (;;) {
        if (tid == 0) uw[0] = atomicAdd(qctr, 1u);
        __syncthreads();
        const unsigned u = uw[0];
        __syncthreads();
        if (u >= 2560u) break;
        if (u >= 512u) { quantise_expert_rows(P, (int)(u - 512u) * 16 + wid * 2, 2); continue; }
        const int mixer = (u < 256u) ? 1 : 0, v = (int)(u & 255u), qb = 15 - (v >> 4), bh = v & 15, b = bh >> 3, h = bh & 7;
        if (mixer == 0) {
            attn_unit<0>(lds, QKV, QKV + TS, QKV + 2 * TS, OAB + h * HD, b, h, qb, 0.f, tid, lane, wid);
        } else {
            float k2 = 0.f;
#pragma unroll
            for (int w = 0; w < 4; ++w) k2 += __builtin_bit_cast(float, __hip_atomic_load(KMAXW + bh * 4 + w, __ATOMIC_RELAXED, __HIP_MEMORY_SCOPE_AGENT));
            const float kmax = sqrtf(k2) * 1.01f;
            build_cumf(lds, LOGF, b, h, 256 * (qb + 1), tid, lane, wid);
            attn_unit<1>(lds, QKV + 3 * TS, QKV + 4 * TS, QKV + 5 * TS, OAB + 1024 + h * HD, b, h, qb, kmax, tid, lane, wid);
        }
        __syncthreads();
    }
}
}

namespace peer {
__device__ __forceinline__ unsigned sortable(float f) { const unsigned u = __builtin_bit_cast(unsigned, f); return (u & 0x80000000u) ? ~u : (u | 0x80000000u); }
__device__ __forceinline__ float unsortable(unsigned k) { const unsigned u = (k & 0x80000000u) ? (k & 0x7fffffffu) : ~k; return __builtin_bit_cast(float, u); }
#define CE_DESC(x, y) do { const unsigned hi_ = (x) > (y) ? (x) : (y); const unsigned lo_ = (x) > (y) ? (y) : (x); (x) = hi_; (y) = lo_; } while (0)
template <int B, int N> __device__ __forceinline__ void sort16_desc(unsigned (&a)[N]) {
#pragma unroll
    for (int k = 2; k <= 16; k <<= 1)
#pragma unroll
        for (int j = k >> 1; j > 0; j >>= 1)
#pragma unroll
            for (int i = 0; i < 16; ++i) { const int l = i ^ j; if (l > i) { if ((i & k) == 0) CE_DESC(a[B + i], a[B + l]); else CE_DESC(a[B + l], a[B + i]); } }
}
template <int A, int Bq, int N> __device__ __forceinline__ void merge_top16(unsigned (&a)[N]) {
#pragma unroll
    for (int i = 0; i < 16; ++i) { const unsigned x = a[A + i], y = a[Bq + 15 - i]; a[A + i] = x > y ? x : y; }
#pragma unroll
    for (int j = 8; j > 0; j >>= 1)
#pragma unroll
        for (int i = 0; i < 16; ++i) { const int l = i ^ j; if (l > i) CE_DESC(a[A + i], a[A + l]); }
}

__device__ __forceinline__ void topk_phase(const Params& P, LAS unsigned char* lds, int vcu, int G) {
    const int tid = threadIdx.x, lane = tid & 63, wave = __builtin_amdgcn_readfirstlane(tid >> 6);
    const int c = lane & 31, hh = lane >> 5;
    const int gw = vcu * NWAVES + wave, NGW = G * NWAVES;
    unsigned char* ws = P.ws;
    const bf16_t* Q2 = (const bf16_t*)(ws + WS_Q2); const bf16_t* SKB = (const bf16_t*)(ws + WS_SKB);
    const float* ROWSS = (const float*)(ws + WS_CTL); int* IDS = (int*)(ws + WS_IDS); float* GATES = (float*)(ws + WS_GATES);
    LAS unsigned char* scr = lds + wave * 4096;
    const bool shared_head = (G == 256);
    LAS unsigned char* skl = lds + 32768;
    if (shared_head) { const bf16_t* src = SKB + (size_t)(vcu & 7) * 2 * 128 * 128;
#pragma unroll
        for (int q = 0; q < 8; ++q) { const int ch = tid + 512 * q, row = ch >> 4, cc = ch & 15; *(LAS u32x4*)(skl + row * 272 + cc * 16) = *(const u32x4*)(src + row * 128 + cc * 8); }
        __syncthreads(); }
    for (int task = (shared_head ? (((vcu >> 3) * 8 + wave) * 8 + (vcu & 7)) : gw); task < 2048; task += (shared_head ? 1 << 30 : NGW)) {
        const int tg = task >> 3, hd = task & 7, tok = tg * 32 + c;
#pragma unroll 1
        for (int p = 0; p < 2; ++p) {
            bf16x8 qf[8];
            { const bf16_t* qp = Q2 + (size_t)tok * DM + hd * 256 + p * 128 + 8 * hh;
#pragma unroll
              for (int s = 0; s < 8; ++s) qf[s] = *(const bf16x8*)(qp + 16 * s); }
            unsigned keys[64];
#pragma unroll
            for (int sub = 0; sub < 4; ++sub) {
                f32x16 acc;
#pragma unroll
                for (int r = 0; r < 16; ++r) acc[r] = 0.f;
                const bf16_t* kp = SKB + ((size_t)(hd * 2 + p) * 128 + 32 * sub + c) * 128 + 8 * hh;
#pragma unroll
                for (int s = 0; s < 8; ++s) { const bf16x8 kf = shared_head ? *(const LAS bf16x8*)(skl + (p * 128 + 32 * sub + c) * 272 + (16 * s + 8 * hh) * 2) : *(const bf16x8*)(kp + 16 * s); acc = __builtin_amdgcn_mfma_f32_32x32x16_bf16(kf, qf[s], acc, 0, 0, 0); }
#pragma unroll
                for (int r = 0; r < 16; ++r) { const int nlo = 127 - (32 * sub + (r & 3) + 8 * (r >> 2)); keys[sub * 16 + r] = (sortable(acc[r]) & ~127u) | (unsigned)(nlo - 4 * hh); }
            }
            sort16_desc<0>(keys); sort16_desc<16>(keys); sort16_desc<32>(keys); sort16_desc<48>(keys);
            merge_top16<0, 16>(keys); merge_top16<32, 48>(keys); merge_top16<0, 32>(keys);
#pragma unroll
            for (int i = 0; i < 16; ++i) { const unsigned own = keys[i]; const auto rr = __builtin_amdgcn_permlane32_swap(own, own, false, false); keys[16 + i] = hh ? (unsigned)rr[0] : (unsigned)rr[1]; }
            merge_top16<0, 16>(keys);
            if (hh == 0) {
#pragma unroll
                for (int w = 0; w < 4; ++w) *(LAS u32x4*)(scr + (c * 2 + p) * 64 + w * 16) = (u32x4){keys[4 * w], keys[4 * w + 1], keys[4 * w + 2], keys[4 * w + 3]};
            }
        }
        LDS_WAIT();
        float s1[16], s2[16];
#pragma unroll
        for (int w = 0; w < 4; ++w) { const u32x4 a = *(const LAS u32x4*)(scr + (c * 2) * 64 + w * 16), b2 = *(const LAS u32x4*)(scr + (c * 2 + 1) * 64 + w * 16);
#pragma unroll
            for (int e = 0; e < 4; ++e) { s1[4 * w + e] = unsortable((a[e] & ~127u) | 64u); s2[4 * w + e] = unsortable((b2[e] & ~127u) | 64u); } }
        unsigned ck[64];
        { int n = 0;
#pragma unroll
          for (int i = 0; i < 16; ++i)
#pragma unroll
              for (int j = 0; j < 16; ++j) if ((i + 1) * (j + 1) <= 16) { ck[n] = (sortable(s1[i] + s2[j]) & ~255u) | (unsigned)(255 - (i * 16 + j)); ++n; }
#pragma unroll
          for (int q = 50; q < 64; ++q) ck[q] = 0u; }
        sort16_desc<0>(ck); sort16_desc<16>(ck); sort16_desc<32>(ck); sort16_desc<48>(ck);
        merge_top16<0, 16>(ck); merge_top16<32, 48>(ck); merge_top16<0, 32>(ck);
        unsigned t2[16];
#pragma unroll
        for (int k = 0; k < 16; ++k) t2[k] = ck[k];
        int ids[16]; float sc[16];
#pragma unroll
        for (int k = 0; k < 16; ++k) { const unsigned pos = 255u - (t2[k] & 255u);
            const unsigned k1 = *(const LAS unsigned*)(scr + (c * 2) * 64 + (pos >> 4) * 4), k2 = *(const LAS unsigned*)(scr + (c * 2 + 1) * 64 + (pos & 15u) * 4);
            ids[k] = (int)((127u - (k1 & 127u)) * 128u + (127u - (k2 & 127u))); sc[k] = unsortable((t2[k] & ~255u) | 128u); }
        LDS_WAIT();
        const float rs = 1.0f / sqrtf(ROWSS[tok] * (1.f / DM) + EPS);
        float ev[16], Z = 0.f;
#pragma unroll
        for (int k = 0; k < 16; ++k) { ev[k] = fexp2((sc[k] - sc[0]) * rs * LOG2E); Z += ev[k]; }
        const float iz = 1.f / Z;
        int* ip = IDS + (size_t)tok * 128 + hd * 16; float* gp = GATES + (size_t)tok * 128 + hd * 16;
        if (hh == 0) {
#pragma unroll
            for (int k = 0; k < 8; ++k) { ip[k] = ids[k]; gp[k] = ev[k] * iz; }
        } else {
#pragma unroll
            for (int k = 8; k < 16; ++k) { ip[k] = ids[k]; gp[k] = ev[k] * iz; }
        }
    }
}


__device__ __forceinline__ float dot8(u32x4 a, u32x4 b, float acc) {
    const unsigned a0 = a[0], a1 = a[1], a2 = a[2], a3 = a[3], b0 = b[0], b1 = b[1], b2 = b[2], b3 = b[3];
    acc = __builtin_amdgcn_fdot2_f32_bf16(__builtin_bit_cast(bf16v2, a0), __builtin_bit_cast(bf16v2, b0), acc, false);
    acc = __builtin_amdgcn_fdot2_f32_bf16(__builtin_bit_cast(bf16v2, a1), __builtin_bit_cast(bf16v2, b1), acc, false);
    acc = __builtin_amdgcn_fdot2_f32_bf16(__builtin_bit_cast(bf16v2, a2), __builtin_bit_cast(bf16v2, b2), acc, false);
    acc = __builtin_amdgcn_fdot2_f32_bf16(__builtin_bit_cast(bf16v2, a3), __builtin_bit_cast(bf16v2, b3), acc, false);
    return acc;
}
__device__ __forceinline__ float gelu_tanh(float a) { const float t = 1.5957691216f * (a + 0.044715f * a * a * a); return a * frcp(1.f + fexp2(-LOG2E * t)); }

__device__ __forceinline__ int dot16(u32x4 a, u32x4 b, int acc) {
    acc = __builtin_amdgcn_sdot4((int)a[0], (int)b[0], acc, false); acc = __builtin_amdgcn_sdot4((int)a[1], (int)b[1], acc, false);
    acc = __builtin_amdgcn_sdot4((int)a[2], (int)b[2], acc, false); acc = __builtin_amdgcn_sdot4((int)a[3], (int)b[3], acc, false);
    return acc;
}
__device__ __forceinline__ void gather_sweep(const Params& P, LAS unsigned char* lds, int vcu, int G) {
    const int tid = threadIdx.x, lane = tid & 63, wave = __builtin_amdgcn_readfirstlane(tid >> 6);
    const int gw = vcu * NWAVES + wave, NGW = G * NWAVES;
    const int g = lane >> 3, i = lane & 7;
    unsigned char* ws = P.ws;
    const bf16_t* X1B = (const bf16_t*)(ws + WS_X1B); const float* ROWSS = (const float*)(ws + WS_CTL);
    const int* IDS = (const int*)(ws + WS_IDS); const float* GATES = (const float*)(ws + WS_GATES);
    const unsigned char* EU = ws + WS_EU; const unsigned char* EV = ws + WS_EV;
    const float* SU = (const float*)(ws + WS_SU); const float* SV = (const float*)(ws + WS_SV);
    LAS unsigned char* wl = lds + wave * 19456;
    const bool b2 = (lane >> 2) & 1, b1 = (lane >> 1) & 1, b0 = lane & 1, B2 = (lane >> 5) & 1, B1 = (lane >> 4) & 1, B0 = (lane >> 3) & 1;
    for (int tg = gw; tg < T_TOK / 4; tg += NGW) {
        const int tok0 = tg * 4;
        float hs[4];
#pragma unroll
        for (int j = 0; j < 4; ++j) { const int tok = tok0 + j;
            const float rs = 1.0f / sqrtf(ROWSS[tok] * (1.f / DM) + EPS);
            f32x4 hv[8]; float hmx = 0.f;
#pragma unroll
            for (int q = 0; q < 8; ++q) { const u32x2 xb = *((const u32x2*)(X1B + (size_t)tok * DM) + lane + 64 * q); const f32x4 xv = {bf_lo(xb[0]), bf_hi(xb[0]), bf_lo(xb[1]), bf_hi(xb[1])}; const f32x4 gn = *((const f32x4*)P.g_ffn + lane + 64 * q);
                hv[q] = xv * rs * gn; hmx = fmaxf(hmx, fmaxf(fmaxf(fabsf(hv[q][0]), fabsf(hv[q][1])), fmaxf(fabsf(hv[q][2]), fabsf(hv[q][3])))); }
#pragma unroll
            for (int o = 1; o < 64; o <<= 1) hmx = fmaxf(hmx, __shfl_xor(hmx, o));
            hmx = fmaxf(hmx, 1e-30f); const float hinv = 127.f / hmx; hs[j] = hmx * (1.f / 127.f);
#pragma unroll
            for (int q = 0; q < 8; ++q) { unsigned w = 0;
#pragma unroll
                for (int e = 0; e < 4; ++e) w |= ((unsigned)(int)__builtin_rintf(hv[q][e] * hinv) & 255u) << (8 * e);
                *(LAS unsigned*)(wl + 2560 + j * 2048 + 4 * (lane + 64 * q)) = w; }
#pragma unroll
            for (int hf = 0; hf < 2; ++hf) { const int k = lane + 64 * hf; const int id = IDS[(size_t)tok * 128 + k];
                *(LAS unsigned*)(wl + (j * 128 + k) * 4) = (unsigned)id * 2048u;
                *(LAS float*)(wl + 10752 + (j * 128 + k) * 4) = GATES[(size_t)tok * 128 + k] * SV[id];
                *(LAS float*)(wl + 12800 + (j * 128 + k) * 4) = SU[id]; }
        }
        LDS_WAIT();
        int accu[4][16];
#pragma unroll
        for (int j = 0; j < 4; ++j)
#pragma unroll
            for (int m = 0; m < 16; ++m) accu[j][m] = 0;
#pragma unroll 1
        for (int sl = 0; sl < 16; ++sl) {
            __syncthreads();
            const unsigned char* ub = EU + 128 * sl + 16 * i;
#pragma unroll
            for (int j = 0; j < 4; ++j) {
                const u32x4 hqc = *(const LAS u32x4*)(wl + 2560 + j * 2048 + 128 * sl + 16 * i);
                u32x4 d[16];
#pragma unroll
                for (int m = 0; m < 16; ++m) { const unsigned off = *(const LAS unsigned*)(wl + (j * 128 + 8 * m + g) * 4); d[m] = *(const u32x4*)(ub + off); }
#pragma unroll
                for (int m = 0; m < 16; ++m) accu[j][m] = dot16(d[m], hqc, accu[j][m]);
                __builtin_amdgcn_sched_barrier(0);
            }
        }
        float sw[4];
#pragma unroll
        for (int j = 0; j < 4; ++j) {
            int r1[8], r2[4], r3[2];
#pragma unroll
            for (int m = 0; m < 8; ++m) { const int send = b2 ? accu[j][m] : accu[j][m + 8], keep = b2 ? accu[j][m + 8] : accu[j][m]; r1[m] = keep + __shfl_xor(send, 4); }
#pragma unroll
            for (int m = 0; m < 4; ++m) { const int send = b1 ? r1[m] : r1[m + 4], keep = b1 ? r1[m + 4] : r1[m]; r2[m] = keep + __shfl_xor(send, 2); }
#pragma unroll
            for (int m = 0; m < 2; ++m) { const int send = b0 ? r2[m] : r2[m + 2], keep = b0 ? r2[m + 2] : r2[m]; r3[m] = keep + __shfl_xor(send, 1); }
            float w2[2], wmx = 0.f;
#pragma unroll
            for (int m = 0; m < 2; ++m) { const int k = 16 * i + 8 * m + g;
                const float act = (float)r3[m] * (hs[j] * *(const LAS float*)(wl + 12800 + (j * 128 + k) * 4));
                w2[m] = *(const LAS float*)(wl + 10752 + (j * 128 + k) * 4) * gelu_tanh(act); wmx = fmaxf(wmx, fabsf(w2[m])); }
#pragma unroll
            for (int o = 1; o < 64; o <<= 1) wmx = fmaxf(wmx, __shfl_xor(wmx, o));
            wmx = fmaxf(wmx, 1e-30f); sw[j] = wmx * (1.f / 127.f);
            const float winv = 127.f / wmx;
            const unsigned q0 = (unsigned)(int)__builtin_rintf(w2[0] * winv) & 255u, q1 = (unsigned)(int)__builtin_rintf(w2[1] * winv) & 255u;
            *(LAS unsigned short*)(wl + 2048 + j * 128 + 16 * g + 2 * i) = (unsigned short)(q0 | (q1 << 8));
        }
        LDS_WAIT();
        float ssq[4] = {0.f, 0.f, 0.f, 0.f};
#define VS_LOAD(D, XB, sl_, j_) do { unsigned long long vb64_ = (unsigned long long)(EV + 128 * (sl_)), xb64_ = (unsigned long long)(X1B + (size_t)(tok0 + (j_)) * DM + 128 * (sl_)); \
            asm volatile("" : "+s"(vb64_), "+s"(xb64_));     \
            const GAS unsigned char* vb_ = (const GAS unsigned char*)vb64_; const GAS unsigned char* xb_ = (const GAS unsigned char*)xb64_; \
            XB = *(const GAS unsigned*)(xb_ + xlo); \
            _Pragma("unroll") for (int m = 0; m < 16; ++m) { const unsigned off = *(const LAS unsigned*)(wl + ((j_) * 128 + 8 * m + g) * 4) + i16; D[m] = *(const GAS u32x4*)(vb_ + off); } \
            __builtin_amdgcn_sched_barrier(0); } while (0)
#define VS_COMP(D, XB, sl_, j_) do { \
            asm volatile("" : "+v"(D[0]), "+v"(D[1]), "+v"(D[2]), "+v"(D[3]), "+v"(D[4]), "+v"(D[5]), "+v"(D[6]), "+v"(D[7]), "+v"(D[8]), "+v"(D[9]), "+v"(D[10]), "+v"(D[11]), "+v"(D[12]), "+v"(D[13]), "+v"(D[14]), "+v"(D[15]), "+v"(XB) :: "memory"); \
            const u32x4 wpk = *(const LAS u32x4*)(wl + 2048 + (j_) * 128 + 16 * g); \
            int ca[16]; \
            _Pragma("unroll") for (int b = 0; b < 16; ++b) ca[b] = 0; \
            _Pragma("unroll") for (int mg = 0; mg < 4; ++mg) \
            _Pragma("unroll") for (int c4 = 0; c4 < 4; ++c4) { const unsigned r0 = D[4 * mg][c4], r1 = D[4 * mg + 1][c4], r2 = D[4 * mg + 2][c4], r3 = D[4 * mg + 3][c4]; \
                const unsigned t0 = __builtin_amdgcn_perm(r1, r0, 0x05010400u), t1 = __builtin_amdgcn_perm(r1, r0, 0x07030602u); \
                const unsigned t2 = __builtin_amdgcn_perm(r3, r2, 0x05010400u), t3 = __builtin_amdgcn_perm(r3, r2, 0x07030602u); \
                const int wq4 = (int)wpk[mg]; \
                ca[4 * c4 + 0] = __builtin_amdgcn_sdot4((int)__builtin_amdgcn_perm(t2, t0, 0x05040100u), wq4, ca[4 * c4 + 0], false); \
                ca[4 * c4 + 1] = __builtin_amdgcn_sdot4((int)__builtin_amdgcn_perm(t2, t0, 0x07060302u), wq4, ca[4 * c4 + 1], false); \
                ca[4 * c4 + 2] = __builtin_amdgcn_sdot4((int)__builtin_amdgcn_perm(t3, t1, 0x05040100u), wq4, ca[4 * c4 + 2], false); \
                ca[4 * c4 + 3] = __builtin_amdgcn_sdot4((int)__builtin_amdgcn_perm(t3, t1, 0x07060302u), wq4, ca[4 * c4 + 3], false); } \
            int c1[8], c2[4], c3[2]; \
            _Pragma("unroll") for (int b = 0; b < 8; ++b) { const int send = B2 ? ca[b] : ca[b + 8], keep = B2 ? ca[b + 8] : ca[b]; c1[b] = keep + __shfl_xor(send, 32); } \
            _Pragma("unroll") for (int b = 0; b < 4; ++b) { const int send = B1 ? c1[b] : c1[b + 4], keep = B1 ? c1[b + 4] : c1[b]; c2[b] = keep + __shfl_xor(send, 16); } \
            _Pragma("unroll") for (int b = 0; b < 2; ++b) { const int send = B0 ? c2[b] : c2[b + 2], keep = B0 ? c2[b + 2] : c2[b]; c3[b] = keep + __shfl_xor(send, 8); } \
            const f32x2 xv = {bf_lo(XB), bf_hi(XB)}; \
            const f32x2 x2 = {xv[0] + sw[j_] * (float)c3[0], xv[1] + sw[j_] * (float)c3[1]}; \
            ssq[j_] += x2[0] * x2[0] + x2[1] * x2[1]; \
            *(LAS unsigned*)(wl + 2560 + (((sl_) * 4 + (j_)) * 64 + lane) * 4) = pk2(x2[0], x2[1]); \
            __builtin_amdgcn_sched_barrier(0); } while (0)
        u32x4 dA[16], dB[16]; unsigned xA, xB; const unsigned i16 = 16u * (unsigned)i, xlo = (unsigned)(16 * i + 2 * g) * 2u;
        VS_LOAD(dA, xA, 0, 0);
#pragma unroll 1
        for (int sl = 0; sl < 16; ++sl) {
            const int sln = sl < 15 ? sl + 1 : 15;
            VS_LOAD(dB, xB, sl, 1); VS_COMP(dA, xA, sl, 0);
            VS_LOAD(dA, xA, sl, 2); VS_COMP(dB, xB, sl, 1);
            VS_LOAD(dB, xB, sl, 3); VS_COMP(dA, xA, sl, 2);
            VS_LOAD(dA, xA, sln, 0); VS_COMP(dB, xB, sl, 3);
        }
#undef VS_LOAD
#undef VS_COMP
        float rs2[4];
#pragma unroll
        for (int j = 0; j < 4; ++j) rs2[j] = 1.0f / sqrtf(wave_sum(ssq[j]) * (1.f / DM) + EPS);
        LDS_WAIT();
#pragma unroll 4
        for (int sl = 0; sl < 16; ++sl) { const f32x2 gn = *(const f32x2*)(P.g_final + 128 * sl + 16 * i + 2 * g);
#pragma unroll
            for (int j = 0; j < 4; ++j) { const unsigned xw = *(const LAS unsigned*)(wl + 2560 + ((sl * 4 + j) * 64 + lane) * 4);
                const f32x2 ov = {bf_lo(xw) * rs2[j] * gn[0], bf_hi(xw) * rs2[j] * gn[1]};
                *(f32x2*)(P.out + (size_t)(tok0 + j) * DM + 128 * sl + 16 * i + 2 * g) = ov; } }
        LDS_WAIT();
    }
}

}


#define XB_TMO      128
#define XB_XCNT(j)  (256  + 64 * (j))
#define XB_XSUB(j)  (1280 + 64 * (j))
#define XB_XGEN(j)  (2304 + 64 * (j))
#define XB_TOP      3328
#define XB_TOPGEN   3392
#define XCD_BAR_WORDS 3456
#define XB_SPIN_CAP (1u << 18)
__device__ __forceinline__ unsigned xb_ld(unsigned* p)              { return __hip_atomic_load(p, __ATOMIC_RELAXED, __HIP_MEMORY_SCOPE_AGENT); }
__device__ __forceinline__ unsigned xb_add(unsigned* p, unsigned v) { return __hip_atomic_fetch_add(p, v, __ATOMIC_RELAXED, __HIP_MEMORY_SCOPE_AGENT); }
__device__ __forceinline__ unsigned xb_xcc_id() { return (unsigned)__builtin_amdgcn_s_getreg((3 << 11) | 20) & 0xFu; }
#define XB_SPIN(cond, bar) do { unsigned _sp = 0; while (cond) { __builtin_amdgcn_s_sleep(1); \
    if ((++_sp & 255u) == 0u) { if (xb_ld(&(bar)[XB_TMO])) break; if (_sp > XB_SPIN_CAP) { atomicAdd(&(bar)[XB_TMO], 1u); break; } } } } while (0)
struct XcdBarrier { unsigned* bar; unsigned x; volatile LAS unsigned* st; };
__device__ __forceinline__ XcdBarrier xcd_barrier_post(unsigned* bar, volatile LAS unsigned* st) {
    XcdBarrier b; b.bar = bar; b.x = xb_xcc_id(); b.st = st;
    if (threadIdx.x == 0) (void)xb_add(&bar[XB_XCNT(b.x)], 1u);
    return b;
}
__device__ __forceinline__ void xcd_barrier_complete(unsigned* bar, unsigned x, unsigned& nloc, unsigned& nx) {
    const unsigned G = gridDim.x * gridDim.y * gridDim.z;
    unsigned sum, cnt, mine, sp = 0u;
    for (;;) {
        sum = 0u; cnt = 0u; mine = 0u;
#pragma unroll
        for (unsigned j = 0; j < 16; ++j) { const unsigned c = xb_ld(&bar[XB_XCNT(j)]); sum += c; cnt += (c > 0u) ? 1u : 0u; mine = (j == x) ? c : mine; }
        if (sum == G) break;
        __builtin_amdgcn_s_sleep(1);
        if ((++sp & 255u) == 0u) { if (xb_ld(&bar[XB_TMO])) break; if (sp > XB_SPIN_CAP) { atomicAdd(&bar[XB_TMO], 1u); break; } }
    }
    nloc = mine > 0u ? mine : 1u; nx = cnt > 0u ? cnt : 1u;
}
__device__ __forceinline__ void xcd_barrier(const XcdBarrier& b) {
    asm volatile("s_waitcnt vmcnt(0)" ::: "memory");
    __syncthreads();
    if (threadIdx.x == 0) {
        unsigned* bar = b.bar;
        __builtin_amdgcn_s_waitcnt(0);
        unsigned nloc = b.st[0], nx = b.st[1];
        if (nloc == 0u) { xcd_barrier_complete(bar, b.x, nloc, nx); b.st[0] = nloc; b.st[1] = nx; }
        const unsigned old = xb_add(&bar[XB_XSUB(b.x)], 1u);
        const unsigned gen = old / nloc;
        if (old + 1u == (gen + 1u) * nloc) {
            __builtin_amdgcn_fence(__ATOMIC_RELEASE, "agent");
            asm volatile("s_waitcnt vmcnt(0)" ::: "memory");
            const unsigned og = xb_add(&bar[XB_TOP], 1u);
            const unsigned tg = og / nx;
            if (og + 1u == (tg + 1u) * nx) xb_add(&bar[XB_TOPGEN], 1u);
            else XB_SPIN(xb_ld(&bar[XB_TOPGEN]) == tg, bar);
            __builtin_amdgcn_fence(__ATOMIC_ACQUIRE, "agent");
            xb_add(&bar[XB_XGEN(b.x)], 1u);
            asm volatile("s_waitcnt vmcnt(0)" ::: "memory");
        } else {
            XB_SPIN(xb_ld(&bar[XB_XGEN(b.x)]) == gen, bar);
            __builtin_amdgcn_fence(__ATOMIC_ACQUIRE, "agent");
            asm volatile("s_waitcnt vmcnt(0)" ::: "memory");
        }
    }
    __syncthreads();
}

__global__ void __launch_bounds__(NTHR, 2) mega_fwd(Params P) {
    extern __shared__ __attribute__((aligned(16))) unsigned char lds_raw[];
    LAS unsigned char* lds = (LAS unsigned char*)lds_raw;
    cg::grid_group grid = cg::this_grid();
    const int G = gridDim.x, bx = blockIdx.x;
    const int vcu = (G % 8 == 0) ? (bx % 8) * (G / 8) + bx / 8 : bx;
    unsigned char* ws = P.ws;
#ifndef ONLY_PHASE
#define ONLY_PHASE -1
#endif
#define IN(k) ((ONLY_PHASE < 0 || ONLY_PHASE == (k)) && P.ph_lo <= (k) && (k) < P.ph_hi)
    volatile LAS unsigned* bst = (volatile LAS unsigned*)(lds + LDS_BYTES - 64);
    if (threadIdx.x < 16) bst[threadIdx.x] = 0u;
    __syncthreads();
    const XcdBarrier xbar = xcd_barrier_post((unsigned*)(ws + WS_CTL + 131072), bst);
    if (P.ph_lo < 0) grid.sync();
#define SEAM(k) do { if (IN(k) && IN((k) + 1)) xcd_barrier(xbar); } while (0)
    if (IN(0)) { p0a(P, lds, vcu, G); xcd_barrier(xbar); p0b(P, lds, vcu, G); }
    SEAM(0);
    if (IN(1)) {
        pg8::Gemm g{ws + WS_H, ws + WS_WIN, T_TOK, 10240, 2048, 2048, 2048};
        pg8::StaticOrder S; S.init(T_TOK, 10240, G, bx, WGM1);
        pg8::EpiProj E{(bf16_t*)(ws + WS_QKV), (bf16_t*)(ws + WS_SG), LOG2E * 0.08838834764831845f, (unsigned*)(ws + WS_CTL + 200704), (const float*)(ws + WS_HSC), (const float*)(ws + WS_WSC)};
        pg8::gemm_phase<pg8::EpiProj, true>(lds, g, S, E);
    }
    SEAM(1);
    if (IN(2)) { att::attn_phase(P, lds, vcu, G); __syncthreads(); late_transposes(P, lds, vcu, G); }
    SEAM(2);
    if (IN(3)) {
        pg8::StaticOrder S; S.init(T_TOK, DM, G, bx, WGM2);
        { pg8::Gemm g{ws + WS_H, ws + WS_WAT, T_TOK, DM, 1024, 4096, 2048};
          pg8::EpiGate<0> E{(const bf16_t*)(ws + WS_SG), (bf16_t*)(ws + WS_TMP), (bf16_t*)(ws + WS_MERGED)};
          pg8::gemm_phase(lds, g, S, E); }
        { pg8::Gemm g{ws + WS_H + 2048, ws + WS_WBT, T_TOK, DM, 1024, 4096, 2048};
          pg8::EpiGate<1> E{(const bf16_t*)(ws + WS_SG) + 2048, (bf16_t*)(ws + WS_TMP), (bf16_t*)(ws + WS_MERGED)};
          pg8::gemm_phase(lds, g, S, E); }
    }
    SEAM(3);
    if (IN(4)) {
        pg8::Gemm g{ws + WS_MERGED, ws + WS_WOUT, T_TOK, DM, 2048, 4096, 4096};
        pg8::StaticOrder S; S.init(T_TOK, DM, G, bx, WGM2);
        pg8::EpiResid E{P.x, (float*)(ws + WS_X1), (bf16_t*)(ws + WS_X1B), (float*)(ws + WS_CTL)};
        pg8::gemm_phase(lds, g, S, E);
    }
    SEAM(4);
    if (IN(5)) {
        pg8::Gemm g{ws + WS_X1B, ws + WS_WQ, T_TOK, DM, 2048, 4096, 4096};
        pg8::StaticOrder S; S.init(T_TOK, DM, G, bx, WGM2);
        pg8::EpiPlainBf16 E{(bf16_t*)(ws + WS_Q2)};
        pg8::gemm_phase(lds, g, S, E);
    }
    SEAM(5);
    if (IN(6)) peer::topk_phase(P, lds, vcu, G);
    SEAM(6);
    if (IN(7)) { peer::gather_sweep(P, lds, vcu, G); }
#undef IN
#undef SEAM
}

extern "C" void kernel_launch(void* const* d_in, const int* in_sizes, int n_in, void* d_out, int out_size, void* d_ws, size_t ws_size, hipStream_t stream) {
    static int grid = 0;
    if (grid == 0) {
        if (n_in != 13 || out_size != T_TOK * DM || ws_size < WS_END) { fprintf(stderr, "kernel_launch: unexpected shapes (n_in %d out %d ws %zu)\n", n_in, out_size, ws_size); grid = -1; return; }
        int dev = 0, cus = 0, per_cu = 0;
        if (hipGetDevice(&dev) != hipSuccess || hipDeviceGetAttribute(&cus, hipDeviceAttributeMultiprocessorCount, dev) != hipSuccess) { grid = -1; return; }
        if (hipFuncSetAttribute((const void*)mega_fwd, hipFuncAttributeMaxDynamicSharedMemorySize, LDS_BYTES) != hipSuccess) { fprintf(stderr, "kernel_launch: hipFuncSetAttribute failed\n"); grid = -1; return; }
        if (hipOccupancyMaxActiveBlocksPerMultiprocessor(&per_cu, (const void*)mega_fwd, NTHR, LDS_BYTES) != hipSuccess || per_cu < 1) { fprintf(stderr, "kernel_launch: occupancy query says %d\n", per_cu); grid = -1; return; }
        grid = cus;
    }
    if (grid < 0) return;
    (void)hipMemsetAsync((char*)d_ws + WS_CTL, 0, 1 * MiB, stream);
    Params p{};
    p.x = (const float*)d_in[0]; p.g_mix = (const float*)d_in[1]; p.w_in = (const float*)d_in[2]; p.b_forget = (const float*)d_in[3];
    p.w_a = (const float*)d_in[4]; p.w_b = (const float*)d_in[5]; p.w_out = (const float*)d_in[6]; p.g_ffn = (const float*)d_in[7];
    p.w_query = (const float*)d_in[8]; p.sub_keys = (const float*)d_in[9]; p.e_u = (const float*)d_in[10]; p.e_v = (const float*)d_in[11]; p.g_final = (const float*)d_in[12];
    p.out = (float*)d_out; p.ws = (unsigned char*)d_ws;
#if MK_N_LAUNCHES == 1
    p.ph_lo = 0; p.ph_hi = N_PHASES;
    void* args[] = {&p};
    hipError_t e = hipLaunchCooperativeKernel((const void*)mega_fwd, dim3(grid), dim3(NTHR), args, LDS_BYTES, stream);
    if (e != hipSuccess) fprintf(stderr, "kernel_launch: cooperative launch failed: %s (grid %d)\n", hipGetErrorString(e), grid);
#else
    for (int ph = 0; ph < N_PHASES; ++ph) { p.ph_lo = ph; p.ph_hi = ph + 1; hipLaunchKernelGGL(mega_fwd, dim3(grid), dim3(NTHR), LDS_BYTES, stream, p); }
#endif
}
```

```cpp
#include <hip/hip_runtime.h>
#include <hip/hip_cooperative_groups.h>
#include <cstdio>
#include <cstdint>
namespace cg = cooperative_groups;

#define LAS __attribute__((address_space(3)))
#define GAS __attribute__((address_space(1)))
typedef unsigned short bf16_t;
typedef short bf16x8 __attribute__((ext_vector_type(8)));
typedef short s16x4 __attribute__((ext_vector_type(4)));
typedef float f32x2 __attribute__((ext_vector_type(2)));
typedef float f32x4 __attribute__((ext_vector_type(4)));
typedef float f32x16 __attribute__((ext_vector_type(16)));
typedef unsigned u32x2 __attribute__((ext_vector_type(2)));
typedef unsigned u32x4 __attribute__((ext_vector_type(4)));
typedef __bf16 bf16v2 __attribute__((ext_vector_type(2)));
typedef int i32x4 __attribute__((ext_vector_type(4)));

#ifndef WGM1
#define WGM1 4
#endif
#ifndef WGM2
#define WGM2 4
#endif
#ifndef MK_N_LAUNCHES
#define MK_N_LAUNCHES 1
#endif

constexpr int T_TOK = 8192, DM = 2048, SEQ = 4096, HD = 128;
constexpr int NWAVES = 8, NTHR = 512;
constexpr int LDS_BYTES = 163840;
constexpr float LOG2E = 1.4426950408889634f;
constexpr float EPS = 1e-6f;
constexpr int N_PHASES = 8;

constexpr size_t MiB = 1u << 20;
constexpr size_t WS_CTL = 0;
constexpr size_t WS_LOGF = 1 * MiB;
constexpr size_t WS_SKB = 1 * MiB + 512 * 1024;
constexpr size_t WS_HSC = 1 * MiB + 256 * 1024;
constexpr size_t WS_WSC = 1 * MiB + 320 * 1024;
constexpr size_t CTL_CMAX = 262144;
constexpr size_t WS_IDS = 2 * MiB;
constexpr size_t WS_GATES = 6 * MiB;
constexpr size_t WS_WAT = 10 * MiB, WS_WBT = 14 * MiB, WS_WOUT = 18 * MiB, WS_WQ = 26 * MiB, WS_WIN = 34 * MiB;
constexpr size_t WS_H = 74 * MiB;
constexpr size_t WS_QKV = 106 * MiB;
constexpr size_t WS_TMP = 106 * MiB, WS_MERGED = 170 * MiB, WS_Q2 = 106 * MiB;
constexpr size_t WS_SG = 202 * MiB;
constexpr size_t WS_X1B = 266 * MiB;
constexpr size_t WS_X1 = 266 * MiB;
constexpr size_t WS_EU = 330 * MiB, WS_EV = 362 * MiB;
constexpr size_t WS_SU = 394 * MiB, WS_SV = 394 * MiB + 65536;
constexpr size_t WS_END = 395 * MiB;

struct Params {
    const float* x; const float* g_mix; const float* w_in; const float* b_forget; const float* w_a; const float* w_b; const float* w_out;
    const float* g_ffn; const float* w_query; const float* sub_keys; const float* e_u; const float* e_v; const float* g_final;
    float* out; unsigned char* ws; int ph_lo, ph_hi;
};

__device__ __forceinline__ unsigned pk2(float a, float b) { f32x2 v = {a, b}; return __builtin_bit_cast(unsigned, __builtin_convertvector(v, bf16v2)); }
__device__ __forceinline__ float bf_lo(unsigned u) { return __builtin_bit_cast(float, u << 16); }
__device__ __forceinline__ float bf_hi(unsigned u) { return __builtin_bit_cast(float, u & 0xffff0000u); }
__device__ __forceinline__ float fexp2(float x) { return __builtin_amdgcn_exp2f(x); }
__device__ __forceinline__ float flog2(float x) { return __builtin_amdgcn_logf(x); }
__device__ __forceinline__ float frcp(float x) { return __builtin_amdgcn_rcpf(x); }
__device__ __forceinline__ float wave_sum(float v) {
#pragma unroll
    for (int o = 1; o < 64; o <<= 1) v += __shfl_xor(v, o);
    return v;
}
#define LDS_WAIT() asm volatile("s_waitcnt lgkmcnt(0)" ::: "memory")

namespace pg8 {
constexpr int BM = 256, BK = 64, HALF = 128, HTB = HALF * BK * 2, STAGE_BYTES = 8 * HTB, NXCD = 8, WGM = 8;
__host__ __device__ __forceinline__ int lds_byte(int r, int c) { const int st = (r >> 4) * 2 + (c >> 5), rr = r & 15, cc = c & 31, ob = rr * 64 + cc * 2; return st * 1024 + (ob ^ (((ob >> 9) & 1) << 5)); }
__host__ __device__ __forceinline__ void stage_rc(int b, int& R, int& C) { const int st = b / 1024, sb = b % 1024, swz = sb ^ (((sb >> 9) & 1) << 5); R = (st >> 1) * 16 + swz / 64; C = (st & 1) * 32 + (swz % 64) / 2; }
__host__ __device__ __forceinline__ int perm32(int rho) { const int n = rho >> 4, i = rho & 15; return 8 * (i >> 2) + 4 * n + (i & 3); }
struct Unit { int pm, pn; };
struct Gemm { const void* A; const void* Bt; int M, N, K, pa, pb; };
struct StaticOrder {
    int nM, nN, nwg, G, c, wgm;
    __device__ void init(int M, int N, int G_, int c_, int wgm_ = WGM) { nM = M / BM; nN = N / BM; nwg = nM * nN; G = G_; c = c_; wgm = wgm_; }
    __device__ bool next(int i, Unit& u) const {
        const long L = (long)i * G + c; if (L >= nwg) return false;
        int wgid = (int)L; { const int q = nwg / NXCD, r = nwg % NXCD, xcd = wgid % NXCD, off = wgid / NXCD; wgid = (xcd < r ? xcd * (q + 1) : r * (q + 1) + (xcd - r) * q) + off; }
        const int nig = wgm * nN, gid = wgid / nig, fm = gid * wgm, gsz = (nM - fm) < wgm ? (nM - fm) : wgm;
        u.pm = fm + ((wgid % nig) % gsz); u.pn = (wgid % nig) / gsz; return true;
    }
};
template <class Epi, bool I8 = false>
__device__ __forceinline__ void gemm_phase(LAS unsigned char* lds, const Gemm g, const StaticOrder& S, const Epi& E) {
    const int tid = threadIdx.x, wid = __builtin_amdgcn_readfirstlane(tid >> 6), lane = tid & 63, wr = wid >> 2, wc = wid & 3, fr = lane & 15, fq = lane >> 4;
    const int K = g.K, nt = I8 ? K / (2 * BK) : K / BK;
    unsigned voffA[2], voffB[2];
#pragma unroll
    for (int i = 0; i < 2; ++i) { int R, C; stage_rc(tid * 16 + i * 8192, R, C); const int Rb = (R & ~31) + perm32(R & 31);
        voffA[i] = (unsigned)(R * g.pa + C * 2); voffB[i] = (unsigned)(Rb * g.pb + C * 2); }
    const size_t kstep = (size_t)(BK * 2);
    const size_t hstepA = (size_t)HALF * g.pa, hstepB = (size_t)HALF * g.pb;
    const size_t tstepA = 2 * hstepA, tstepB = 2 * hstepB;
    const unsigned ldsw = (unsigned)wid * 1024u;
    const int aoff = lds_byte(wr * 64 + fr, fq * 8), boff = lds_byte(wc * 32 + fr, fq * 8);
#define PG8_SA(b, h) (((b) * 2 + (h)) * HTB)
#define PG8_SB(b, h) ((4 + (b) * 2 + (h)) * HTB)
#define PG8_STAGE(bufoff, gbase, voff) do { _Pragma("unroll") for (int _i = 0; _i < 2; ++_i) \
        __builtin_amdgcn_global_load_lds((const unsigned*)((const char*)(gbase) + (voff)[_i]), (LAS unsigned*)(lds + (bufoff) + ldsw + _i * 8192), 16, 0, 0); } while (0)
#define PG8_LDA(dst, b, h) do { _Pragma("unroll") for (int m = 0; m < 4; ++m) _Pragma("unroll") for (int k = 0; k < 2; ++k) dst[m][k] = *(const LAS bf16x8*)(lds + PG8_SA(b, h) + aoff + m * 2048 + k * 1024); } while (0)
#define PG8_LDB(dst, b, h) do { _Pragma("unroll") for (int n = 0; n < 2; ++n) _Pragma("unroll") for (int k = 0; k < 2; ++k) dst[n][k] = *(const LAS bf16x8*)(lds + PG8_SB(b, h) + boff + n * 2048 + k * 1024); } while (0)
#define PG8_MMA(ai, bj, At, Bt) do { __builtin_amdgcn_s_setprio(1); _Pragma("unroll") for (int m = 0; m < 4; ++m) _Pragma("unroll") for (int n = 0; n < 2; ++n) _Pragma("unroll") for (int k = 0; k < 2; ++k) \
        { if (I8) acc[ai][bj][m][n] = __builtin_bit_cast(f32x4, __builtin_amdgcn_mfma_i32_16x16x64_i8(__builtin_bit_cast(i32x4, Bt[n][k]), __builtin_bit_cast(i32x4, At[m][k]), __builtin_bit_cast(i32x4, acc[ai][bj][m][n]), 0, 0, 0)); \
          else acc[ai][bj][m][n] = __builtin_amdgcn_mfma_f32_16x16x32_bf16(Bt[n][k], At[m][k], acc[ai][bj][m][n], 0, 0, 0); } __builtin_amdgcn_s_setprio(0); } while (0)
#define PG8_WAIT_V(n) asm volatile("s_waitcnt vmcnt(" #n ")" ::: "memory")
#define PG8_WAIT_L(n) asm volatile("s_waitcnt lgkmcnt(" #n ")" ::: "memory")
#define PG8_BAR __builtin_amdgcn_s_barrier()
#define PG8_SCHED __builtin_amdgcn_sched_barrier(0)
    Unit cur, nxt; int ui = 0;
    if (!S.next(0, cur)) return;
    f32x4 acc[2][2][4][2];
#pragma unroll
    for (int a = 0; a < 2; ++a)
#pragma unroll
        for (int b = 0; b < 2; ++b)
#pragma unroll
            for (int m = 0; m < 4; ++m)
#pragma unroll
                for (int n = 0; n < 2; ++n) acc[a][b][m][n] = (f32x4){0.f, 0.f, 0.f, 0.f};
    bf16x8 At[4][2], B0[2][2], B1[2][2];
    const char* cA = (const char*)g.A + (size_t)cur.pm * tstepA; const char* cB = (const char*)g.Bt + (size_t)cur.pn * tstepB;
    PG8_STAGE(PG8_SB(0, 0), cB, voffB); PG8_STAGE(PG8_SA(0, 0), cA, voffA); PG8_STAGE(PG8_SB(0, 1), cB + hstepB, voffB); PG8_STAGE(PG8_SA(0, 1), cA + hstepA, voffA);
    if (wr == 1) PG8_BAR;
    PG8_WAIT_V(4); PG8_BAR;
    PG8_STAGE(PG8_SB(1, 0), cB + kstep, voffB); PG8_STAGE(PG8_SA(1, 0), cA + kstep, voffA); PG8_STAGE(PG8_SB(1, 1), cB + hstepB + kstep, voffB);
    PG8_WAIT_V(6); PG8_BAR;
    for (;;) {
        const bool has_next = S.next(ui + 1, nxt);
        const char* nA = has_next ? (const char*)g.A + (size_t)nxt.pm * tstepA : cA; const char* nB = has_next ? (const char*)g.Bt + (size_t)nxt.pn * tstepB : cB;
        for (int t = 0; t < nt; t += 2) {
            const bool last = (t == nt - 2);
            const char* a1 = cA + (size_t)(t + 1) * kstep;
            const char* a2 = last ? nA : cA + (size_t)(t + 2) * kstep; const char* b2 = last ? nB : cB + (size_t)(t + 2) * kstep;
            const char* a3 = a2 + kstep; const char* b3 = b2 + kstep;
            PG8_LDB(B0, 0, 0); PG8_SCHED; PG8_LDA(At, 0, 0); PG8_STAGE(PG8_SA(1, 1), a1 + hstepA, voffA);
            PG8_WAIT_L(8); PG8_BAR; PG8_WAIT_L(0); PG8_MMA(0, 0, At, B0); PG8_BAR; PG8_SCHED;
            PG8_LDB(B1, 0, 1); PG8_STAGE(PG8_SB(0, 0), b2, voffB);
            PG8_BAR; PG8_WAIT_L(0); PG8_MMA(0, 1, At, B1); PG8_BAR;
            PG8_LDA(At, 0, 1); PG8_STAGE(PG8_SA(0, 0), a2, voffA);
            PG8_BAR; PG8_WAIT_L(0); PG8_MMA(1, 0, At, B0); PG8_BAR; PG8_SCHED;
            PG8_STAGE(PG8_SB(0, 1), b2 + hstepB, voffB);
            PG8_WAIT_V(6); PG8_BAR; PG8_MMA(1, 1, At, B1); PG8_BAR;
            PG8_LDB(B0, 1, 0); PG8_SCHED; PG8_LDA(At, 1, 0); PG8_STAGE(PG8_SA(0, 1), a2 + hstepA, voffA);
            PG8_WAIT_L(8); PG8_BAR; PG8_WAIT_L(0); PG8_MMA(0, 0, At, B0); PG8_BAR; PG8_SCHED;
            PG8_LDB(B1, 1, 1); PG8_STAGE(PG8_SB(1, 0), b3, voffB);
            PG8_BAR; PG8_WAIT_L(0); PG8_MMA(0, 1, At, B1); PG8_BAR;
            PG8_LDA(At, 1, 1); PG8_STAGE(PG8_SA(1, 0), a3, voffA);
            PG8_BAR; PG8_WAIT_L(0); PG8_MMA(1, 0, At, B0); PG8_BAR; PG8_SCHED;
            PG8_STAGE(PG8_SB(1, 1), b3 + hstepB, voffB);
            PG8_WAIT_V(6); PG8_BAR; PG8_MMA(1, 1, At, B1); PG8_BAR;
        }
        E(acc, cur, wr, wc, fr, fq);
        if (!has_next) break;
#pragma unroll
        for (int a = 0; a < 2; ++a)
#pragma unroll
            for (int b = 0; b < 2; ++b)
#pragma unroll
                for (int m = 0; m < 4; ++m)
#pragma unroll
                    for (int n = 0; n < 2; ++n) acc[a][b][m][n] = (f32x4){0.f, 0.f, 0.f, 0.f};
        cur = nxt; cA = nA; cB = nB; ++ui;
    }
    PG8_WAIT_V(0);
    if (wr == 0) PG8_BAR;
    PG8_BAR;
#undef PG8_SA
#undef PG8_SB
#undef PG8_STAGE
#undef PG8_LDA
#undef PG8_LDB
#undef PG8_MMA
#undef PG8_WAIT_V
#undef PG8_WAIT_L
#undef PG8_BAR
#undef PG8_SCHED
}

struct EpiProj {
    bf16_t* qkv; bf16_t* sg; float qscale; unsigned* kmaxw; const float* hsc; const float* wsc;
    __device__ __forceinline__ void operator()(const f32x4 (&acci)[2][2][4][2], const Unit& u, int wr, int wc, int fr, int fq) const {
        const int row0 = u.pm * BM + wr * 64 + fr;
        f32x4 acc[2][2][4][2];
        { f32x4 cs[2][2];
#pragma unroll
          for (int bj = 0; bj < 2; ++bj)
#pragma unroll
              for (int n = 0; n < 2; ++n) cs[bj][n] = *(const f32x4*)(wsc + u.pn * BM + bj * HALF + wc * 32 + 8 * fq + 4 * n);
#pragma unroll
          for (int ai = 0; ai < 2; ++ai)
#pragma unroll
              for (int m = 0; m < 4; ++m) { const float rsc = hsc[row0 + ai * HALF + m * 16];
#pragma unroll
                  for (int bj = 0; bj < 2; ++bj)
#pragma unroll
                      for (int n = 0; n < 2; ++n) { const i32x4 iv = __builtin_bit_cast(i32x4, acci[ai][bj][m][n]);
                          acc[ai][bj][m][n] = (f32x4){(float)iv[0], (float)iv[1], (float)iv[2], (float)iv[3]} * rsc * cs[bj][n]; } } }
        if (u.pn < 24) {
            const int t = u.pn >> 2; bf16_t* base = qkv + (size_t)t * ((size_t)T_TOK * 1024) + (u.pn & 3) * 256 + wc * 32 + 8 * fq;
            const float sc = (t == 0 || t == 3) ? qscale : 1.f;
            if (t == 4) {
#pragma unroll
                for (int bj = 0; bj < 2; ++bj) { float mxv = 0.f;
#pragma unroll
                    for (int ai = 0; ai < 2; ++ai)
#pragma unroll
                        for (int m = 0; m < 4; ++m) { const f32x4 v0 = acc[ai][bj][m][0], v1 = acc[ai][bj][m][1];
                            float ssq = (v0[0] * v0[0] + v0[1] * v0[1]) + (v0[2] * v0[2] + v0[3] * v0[3]) + (v1[0] * v1[0] + v1[1] * v1[1]) + (v1[2] * v1[2] + v1[3] * v1[3]);
                            ssq += __shfl_xor(ssq, 16); ssq += __shfl_xor(ssq, 32); mxv = fmaxf(mxv, ssq); }
#pragma unroll
                    for (int o = 1; o < 16; o <<= 1) mxv = fmaxf(mxv, __shfl_xor(mxv, o));
                    if ((fr | fq) == 0) atomicMax(kmaxw + ((u.pm >> 4) * 8 + (u.pn & 3) * 2 + bj) * 4 + wc, __builtin_bit_cast(unsigned, mxv)); }
            }
#pragma unroll
            for (int ai = 0; ai < 2; ++ai)
#pragma unroll
                for (int m = 0; m < 4; ++m) { bf16_t* rowp = base + (size_t)(row0 + ai * HALF + m * 16) * 1024;
#pragma unroll
                    for (int bj = 0; bj < 2; ++bj) { const f32x4 v0 = acc[ai][bj][m][0] * sc, v1 = acc[ai][bj][m][1] * sc;
                        u32x4 w; w.x = pk2(v0[0], v0[1]); w.y = pk2(v0[2], v0[3]); w.z = pk2(v1[0], v1[1]); w.w = pk2(v1[2], v1[3]);
                        *(u32x4*)(rowp + bj * HALF) = w; } }
        } else {
            bf16_t* base = sg + (u.pn - 24) * 256 + wc * 32 + 8 * fq;
#pragma unroll
            for (int ai = 0; ai < 2; ++ai)
#pragma unroll
                for (int m = 0; m < 4; ++m) { bf16_t* rowp = base + (size_t)(row0 + ai * HALF + m * 16) * 4096;
#pragma unroll
                    for (int bj = 0; bj < 2; ++bj) { float s[8];
#pragma unroll
                        for (int e = 0; e < 4; ++e) { s[e] = frcp(1.f + fexp2(-LOG2E * acc[ai][bj][m][0][e])); s[4 + e] = frcp(1.f + fexp2(-LOG2E * acc[ai][bj][m][1][e])); }
                        u32x4 w; w.x = pk2(s[0], s[1]); w.y = pk2(s[2], s[3]); w.z = pk2(s[4], s[5]); w.w = pk2(s[6], s[7]);
                        *(u32x4*)(rowp + bj * HALF) = w; } }
        }
    }
};
template <int SECOND> struct EpiGate {
    const bf16_t* sg;
    bf16_t* tmp; bf16_t* merged;
    __device__ __forceinline__ void operator()(const f32x4 (&acc)[2][2][4][2], const Unit& u, int wr, int wc, int fr, int fq) const {
        const int row0 = u.pm * BM + wr * 64 + fr, col0 = u.pn * BM + wc * 32 + 8 * fq;
#pragma unroll
        for (int ai = 0; ai < 2; ++ai)
#pragma unroll
            for (int m = 0; m < 4; ++m) { const size_t row = (size_t)(row0 + ai * HALF + m * 16);
#pragma unroll
                for (int bj = 0; bj < 2; ++bj) { const int col = col0 + bj * HALF;
                    const u32x4 gv = *(const u32x4*)(sg + row * 4096 + col);
                    const f32x4 g0 = {bf_lo(gv.x), bf_hi(gv.x), bf_lo(gv.y), bf_hi(gv.y)}, g1 = {bf_lo(gv.z), bf_hi(gv.z), bf_lo(gv.w), bf_hi(gv.w)};
                    f32x4 v0 = acc[ai][bj][m][0] * g0, v1 = acc[ai][bj][m][1] * g1;
                    bf16_t* tp = tmp + row * DM + col;
                    if (SECOND == 0) { u32x4 w; w.x = pk2(v0[0], v0[1]); w.y = pk2(v0[2], v0[3]); w.z = pk2(v1[0], v1[1]); w.w = pk2(v1[2], v1[3]); *(u32x4*)tp = w; }
                    else { const u32x4 tv = *(const u32x4*)tp; v0 += (f32x4){bf_lo(tv.x), bf_hi(tv.x), bf_lo(tv.y), bf_hi(tv.y)}; v1 += (f32x4){bf_lo(tv.z), bf_hi(tv.z), bf_lo(tv.w), bf_hi(tv.w)};
                        u32x4 w; w.x = pk2(v0[0], v0[1]); w.y = pk2(v0[2], v0[3]); w.z = pk2(v1[0], v1[1]); w.w = pk2(v1[2], v1[3]);
                        *(u32x4*)(merged + row * DM + col) = w; } } }
    }
};
struct EpiResid {
    const float* x; float* x1; bf16_t* x1b; float* rowss;
    __device__ __forceinline__ void operator()(const f32x4 (&acc)[2][2][4][2], const Unit& u, int wr, int wc, int fr, int fq) const {
        const int row0 = u.pm * BM + wr * 64 + fr, col0 = u.pn * BM + wc * 32 + 8 * fq;
#pragma unroll
        for (int ai = 0; ai < 2; ++ai)
#pragma unroll
            for (int m = 0; m < 4; ++m) { const size_t row = (size_t)(row0 + ai * HALF + m * 16); float ss = 0.f;
#pragma unroll
                for (int bj = 0; bj < 2; ++bj) { const size_t o = row * DM + col0 + bj * HALF;
                    const f32x4 v0 = acc[ai][bj][m][0] + *(const f32x4*)(x + o), v1 = acc[ai][bj][m][1] + *(const f32x4*)(x + o + 4);
                    u32x4 w; w.x = pk2(v0[0], v0[1]); w.y = pk2(v0[2], v0[3]); w.z = pk2(v1[0], v1[1]); w.w = pk2(v1[2], v1[3]);
                    *(u32x4*)(x1b + o) = w;
                    ss += (v0[0] * v0[0] + v0[1] * v0[1]) + (v0[2] * v0[2] + v0[3] * v0[3]) + (v1[0] * v1[0] + v1[1] * v1[1]) + (v1[2] * v1[2] + v1[3] * v1[3]); }
                ss += __shfl_xor(ss, 16); ss += __shfl_xor(ss, 32);
                if (fq == 0) atomicAdd(rowss + row, ss); }
    }
};
struct EpiPlainBf16 {
    bf16_t* o;
    __device__ __forceinline__ void operator()(const f32x4 (&acc)[2][2][4][2], const Unit& u, int wr, int wc, int fr, int fq) const {
        const int row0 = u.pm * BM + wr * 64 + fr, col0 = u.pn * BM + wc * 32 + 8 * fq;
#pragma unroll
        for (int ai = 0; ai < 2; ++ai)
#pragma unroll
            for (int m = 0; m < 4; ++m) { const size_t row = (size_t)(row0 + ai * HALF + m * 16);
#pragma unroll
                for (int bj = 0; bj < 2; ++bj) { const f32x4 v0 = acc[ai][bj][m][0], v1 = acc[ai][bj][m][1];
                    u32x4 w; w.x = pk2(v0[0], v0[1]); w.y = pk2(v0[2], v0[3]); w.z = pk2(v1[0], v1[1]); w.w = pk2(v1[2], v1[3]);
                    *(u32x4*)(o + row * DM + col0 + bj * HALF) = w; } }
    }
};
}

__device__ __forceinline__ void transpose_item(const float* W, int ldw, int src_n0, bf16_t* WT, int K, int dst_n0, int k0, LAS float* scr, int lane, const float* kscale) {
    { const int c4 = (lane & 7) * 4;
      f32x4 v[8];
#pragma unroll
      for (int i = 0; i < 8; ++i) v[i] = *(const f32x4*)(W + (size_t)(k0 + 8 * i + (lane >> 3)) * ldw + src_n0 + c4);
#pragma unroll
      for (int i = 0; i < 8; ++i) { const int kk = 8 * i + (lane >> 3); const float ks = kscale ? kscale[k0 + kk] : 1.f; LAS float* sp = scr + kk * 33 + c4;
          sp[0] = v[i][0] * ks; sp[1] = v[i][1] * ks; sp[2] = v[i][2] * ks; sp[3] = v[i][3] * ks; } }
    LDS_WAIT();
    const int c = lane & 7;
#pragma unroll
    for (int j = 0; j < 4; ++j) { const int n = (lane >> 3) + 8 * j; const LAS float* s = scr + (8 * c) * 33 + n;
        u32x4 o; o.x = pk2(s[0 * 33], s[1 * 33]); o.y = pk2(s[2 * 33], s[3 * 33]); o.z = pk2(s[4 * 33], s[5 * 33]); o.w = pk2(s[6 * 33], s[7 * 33]);
        *(u32x4*)(WT + (size_t)(dst_n0 + n) * K + k0 + 8 * c) = o; }
    LDS_WAIT();
}

__device__ __forceinline__ void p0a(const Params& P, LAS unsigned char* lds, int vcu, int G) {
    const int tid = threadIdx.x, lane = tid & 63, wave = __builtin_amdgcn_readfirstlane(tid >> 6);
    const int gw = vcu * NWAVES + wave, NGW = G * NWAVES;
    unsigned char* ws = P.ws;
    {
        unsigned* CMAX = (unsigned*)(ws + WS_CTL + CTL_CMAX);
        constexpr int NCB = (10248 + 255) / 256;
        for (int it = gw; it < 128 * NCB; it += NGW) { const int kb = it / NCB, cb = it % NCB, sc = cb * 256 + 4 * lane;
            if (sc < 10248) { f32x4 v[16];
#pragma unroll
                for (int r = 0; r < 16; ++r) v[r] = *(const f32x4*)(P.w_in + (size_t)(kb * 16 + r) * 10248 + sc);
                float m0 = 0.f, m1 = 0.f, m2 = 0.f, m3 = 0.f;
#pragma unroll
                for (int r = 0; r < 16; ++r) { m0 = fmaxf(m0, fabsf(v[r][0])); m1 = fmaxf(m1, fabsf(v[r][1])); m2 = fmaxf(m2, fabsf(v[r][2])); m3 = fmaxf(m3, fabsf(v[r][3])); }
                const float mm[4] = {m0, m1, m2, m3};
#pragma unroll
                for (int e = 0; e < 4; ++e) { const int c = sc + e; const unsigned mb = __float_as_uint(mm[e]);
                    if (c < 6144) atomicMax(CMAX + c, mb); else if (c >= 6152) atomicMax(CMAX + c - 8, mb); } } }
    }
    {
        LAS float* wf = (LAS float*)lds;
        for (int k = tid; k < 2048; k += NTHR) { const f32x4 a0 = *(const f32x4*)(P.w_in + (size_t)k * 10248 + 6144), a1 = *(const f32x4*)(P.w_in + (size_t)k * 10248 + 6148);
            wf[k] = a0[0]; wf[2048 + k] = a0[1]; wf[4096 + k] = a0[2]; wf[6144 + k] = a0[3]; wf[8192 + k] = a1[0]; wf[10240 + k] = a1[1]; wf[12288 + k] = a1[2]; wf[14336 + k] = a1[3]; }
        __syncthreads();
        unsigned char* HQ8 = ws + WS_H; float* HSC = (float*)(ws + WS_HSC); float* LOGF = (float*)(ws + WS_LOGF);
        f32x4 xn[8];
        if (gw < T_TOK) { const f32x4* xr = (const f32x4*)(P.x + (size_t)gw * DM) + lane;
#pragma unroll
            for (int j = 0; j < 8; ++j) xn[j] = xr[64 * j]; }
        for (int r = gw; r < T_TOK; r += NGW) {
            float ss = 0.f, amx = 0.f; f32x4 hv[8];
#pragma unroll
            for (int j = 0; j < 8; ++j) { const f32x4 v = xn[j]; const f32x4 gn = *((const f32x4*)P.g_mix + lane + 64 * j); ss += (v[0] * v[0] + v[1] * v[1]) + (v[2] * v[2] + v[3] * v[3]);
                hv[j] = v * gn; amx = fmaxf(amx, fmaxf(fmaxf(fabsf(hv[j][0]), fabsf(hv[j][1])), fmaxf(fabsf(hv[j][2]), fabsf(hv[j][3])))); }
            if (r + NGW < T_TOK) { const f32x4* xr = (const f32x4*)(P.x + (size_t)(r + NGW) * DM) + lane;
#pragma unroll
                for (int j = 0; j < 8; ++j) xn[j] = xr[64 * j]; }
            const float rstd = 1.0f / sqrtf(wave_sum(ss) * (1.f / DM) + EPS);
#pragma unroll
            for (int o = 1; o < 64; o <<= 1) amx = fmaxf(amx, __shfl_xor(amx, o));
            const float hmax = fmaxf(amx * rstd, 1e-30f), hinv = 127.f / hmax;
            float fl[8];
#pragma unroll
            for (int c = 0; c < 8; ++c) fl[c] = 0.f;
            unsigned* hp = (unsigned*)(HQ8 + (size_t)r * DM) + lane;
#pragma unroll
            for (int j = 0; j < 8; ++j) { const f32x4 h = hv[j] * rstd;
                unsigned w = 0;
#pragma unroll
                for (int e = 0; e < 4; ++e) w |= ((unsigned)(int)__builtin_rintf(h[e] * hinv) & 255u) << (8 * e);
                hp[64 * j] = w;
#pragma unroll
                for (int c = 0; c < 8; ++c) { const f32x4 wv = *((const LAS f32x4*)(wf + c * 2048) + lane + 64 * j); fl[c] += (h[0] * wv[0] + h[1] * wv[1]) + (h[2] * wv[2] + h[3] * wv[3]); }
                __builtin_amdgcn_sched_barrier(0); }
            { const bool b5 = (lane >> 5) & 1, b4 = (lane >> 4) & 1, b3 = (lane >> 3) & 1; float p1[4], p2[2], p3;
#pragma unroll
              for (int q = 0; q < 4; ++q) { const float send = b5 ? fl[q] : fl[q + 4], keep = b5 ? fl[q + 4] : fl[q]; p1[q] = keep + __shfl_xor(send, 32); }
#pragma unroll
              for (int q = 0; q < 2; ++q) { const float send = b4 ? p1[q] : p1[q + 2], keep = b4 ? p1[q + 2] : p1[q]; p2[q] = keep + __shfl_xor(send, 16); }
              { const float send = b3 ? p2[0] : p2[1], keep = b3 ? p2[1] : p2[0]; p3 = keep + __shfl_xor(send, 8); }
              p3 += __shfl_xor(p3, 4); p3 += __shfl_xor(p3, 2); p3 += __shfl_xor(p3, 1);
              if (lane == 0) HSC[r] = hmax * (1.f / 127.f);
              if ((lane & 7) == 0) { const int c = lane >> 3; const float y = p3 + P.b_forget[c]; LOGF[((size_t)(r >> 12) * 8 + c) * SEQ + (r & (SEQ - 1))] = fminf(y, 0.f) - log1pf(expf(-fabsf(y))); } }
        }
    }
    {
        const size_t gid = (size_t)vcu * NTHR + tid, gstride = (size_t)G * NTHR;
        for (size_t i = gid; i < 262144 / 8; i += gstride) { const float* src = P.sub_keys + i * 8; const f32x4 a = *(const f32x4*)src, b = *((const f32x4*)src + 1);
            u32x4 o; o.x = pk2(a[0], a[1]); o.y = pk2(a[2], a[3]); o.z = pk2(b[0], b[1]); o.w = pk2(b[2], b[3]); *(u32x4*)((bf16_t*)(ws + WS_SKB) + i * 8) = o; }
    }
}
__device__ __forceinline__ void p0b(const Params& P, LAS unsigned char* lds, int vcu, int G) {
    const int tid = threadIdx.x, lane = tid & 63, wave = __builtin_amdgcn_readfirstlane(tid >> 6);
    const int gw = vcu * NWAVES + wave, NGW = G * NWAVES;
    unsigned char* ws = P.ws;
    const unsigned* CMAX = (const unsigned*)(ws + WS_CTL + CTL_CMAX); float* WSC = (float*)(ws + WS_WSC); unsigned char* WT8 = ws + WS_WIN;
    LAS float* scr = (LAS float*)(lds + wave * 16384);
    for (int it = gw; it < 32 * 320; it += NGW) {
        const int nb = it >> 5, kb = it & 31, dn = nb * 32, sn = dn < 6144 ? dn : dn + 8, k0 = kb * 64;
        const int c4 = (lane & 7) * 4;
        float inv[4];
#pragma unroll
        for (int e = 0; e < 4; ++e) { const float cm = fmaxf(__uint_as_float(__hip_atomic_load(CMAX + dn + c4 + e, __ATOMIC_RELAXED, __HIP_MEMORY_SCOPE_AGENT)), 1e-30f); inv[e] = 127.f / cm;
            if (kb == 0 && lane < 8) WSC[dn + c4 + e] = cm * (1.f / 127.f); }
        f32x4 v[8];
#pragma unroll
        for (int i = 0; i < 8; ++i) v[i] = *(const f32x4*)(P.w_in + (size_t)(k0 + 8 * i + (lane >> 3)) * 10248 + sn + c4);
#pragma unroll
        for (int i = 0; i < 8; ++i) { LAS float* sp = scr + (8 * i + (lane >> 3)) * 33 + c4; sp[0] = v[i][0] * inv[0]; sp[1] = v[i][1] * inv[1]; sp[2] = v[i][2] * inv[2]; sp[3] = v[i][3] * inv[3]; }
        LDS_WAIT();
        const int c = lane & 3;
#pragma unroll
        for (int j = 0; j < 2; ++j) { const int n = (lane >> 2) + 16 * j; const LAS float* sp = scr + (16 * c) * 33 + n;
            u32x4 o;
#pragma unroll
            for (int w4 = 0; w4 < 4; ++w4) { unsigned w = 0;
#pragma unroll
                for (int e = 0; e < 4; ++e) w |= ((unsigned)(int)fminf(fmaxf(__builtin_rintf(sp[(4 * w4 + e) * 33]), -127.f), 127.f) & 255u) << (8 * e);
                o[w4] = w; }
            *(u32x4*)(WT8 + (size_t)(dn + n) * 2048 + k0 + 16 * c) = o; }
        LDS_WAIT();
    }
}
__device__ __forceinline__ void late_transposes(const Params& P, LAS unsigned char* lds, int vcu, int G) {
    const int tid = threadIdx.x, lane = tid & 63, wave = __builtin_amdgcn_readfirstlane(tid >> 6);
    const int gw = vcu * NWAVES + wave, NGW = G * NWAVES;
    unsigned char* ws = P.ws;
    LAS float* scr = (LAS float*)(lds + wave * 16384);
    constexpr int I_A = 16 * 64, I_O = 32 * 64, NITEMS = 2 * I_A + 2 * I_O;
    for (int it = gw; it < NITEMS; it += NGW) {
        int r = it;
        if (r < I_A) { const int kb = r / 64, nb = r % 64; transpose_item(P.w_a, 2048, nb * 32, (bf16_t*)(ws + WS_WAT), 1024, nb * 32, kb * 64, scr, lane, nullptr); continue; } r -= I_A;
        if (r < I_A) { const int kb = r / 64, nb = r % 64; transpose_item(P.w_b, 2048, nb * 32, (bf16_t*)(ws + WS_WBT), 1024, nb * 32, kb * 64, scr, lane, nullptr); continue; } r -= I_A;
        if (r < I_O) { const int kb = r / 64, nb = r % 64; transpose_item(P.w_out, 2048, nb * 32, (bf16_t*)(ws + WS_WOUT), 2048, nb * 32, kb * 64, scr, lane, nullptr); continue; } r -= I_O;
        { const int kb = r / 64, nb = r % 64; transpose_item(P.w_query, 2048, nb * 32, (bf16_t*)(ws + WS_WQ), 2048, nb * 32, kb * 64, scr, lane, P.g_ffn); }
    }
}
__device__ __forceinline__ void quantise_expert_rows(const Params& P, int r0, int nrows) {
    const int lane = threadIdx.x & 63;
    unsigned char* ws = P.ws;
    float* SU = (float*)(ws + WS_SU); float* SV = (float*)(ws + WS_SV);
    for (int r = r0; r < r0 + nrows; r += 2) {
        f32x4 v[2][8];
#pragma unroll
        for (int t = 0; t < 2; ++t) { const int rr = r + t; const f32x4* src = (const f32x4*)((rr >= 16384 ? P.e_v : P.e_u) + (size_t)(rr & 16383) * DM) + lane;
#pragma unroll
            for (int j = 0; j < 8; ++j) v[t][j] = __builtin_nontemporal_load(src + 64 * j); }
#pragma unroll
        for (int t = 0; t < 2; ++t) { const int rr = r + t; const bool second = rr >= 16384; const int row = rr & 16383;
            float mx = 0.f;
#pragma unroll
            for (int j = 0; j < 8; ++j) mx = fmaxf(mx, fmaxf(fmaxf(fabsf(v[t][j][0]), fabsf(v[t][j][1])), fmaxf(fabsf(v[t][j][2]), fabsf(v[t][j][3]))));
#pragma unroll
            for (int o = 1; o < 64; o <<= 1) mx = fmaxf(mx, __shfl_xor(mx, o));
            mx = fmaxf(mx, 1e-30f);
            const float inv = 127.f / mx;
            unsigned char* dst = ws + (second ? WS_EV : WS_EU) + ((size_t)(lane >> 5) << 21) + (size_t)row * 128 + 4 * (lane & 31);
#pragma unroll
            for (int j = 0; j < 8; ++j) { unsigned w = 0;
#pragma unroll
                for (int e = 0; e < 4; ++e) { const int q = (int)__builtin_rintf(v[t][j][e] * inv); w |= ((unsigned)q & 255u) << (8 * e); }
                *(unsigned*)(dst + ((size_t)(2 * j) << 21)) = w; }
            if (lane == 0) (second ? SV : SU)[row] = mx * (1.f / 127.f);
        }
    }
}

namespace att {
constexpr int KST = 272, VST = 320;
constexpr int KBUF = 64 * KST, VBUF = 64 * VST;
constexpr int OFF_K = 0, OFF_V = 2 * KBUF, OFF_F = OFF_V + 2 * VBUF, OFF_SC = OFF_F + 4096 * 4;
constexpr int OFF_FLG = OFF_SC + 64, OFF_UNIT = OFF_FLG + 64;
static_assert(OFF_UNIT + 16 <= 131072, "attention LDS");
constexpr float THR_SB = 30.f, THR_FOX = 20.f;

__device__ __forceinline__ void build_cumf(LAS unsigned char* lds, const float* LOGF, int b, int h, int n, int tid, int lane, int wid) {
    LAS float* F2 = (LAS float*)(lds + OFF_F); LAS float* sc = (LAS float*)(lds + OFF_SC);
    const int s0 = tid * 8; float v[8];
    { const f32x4* lp = (const f32x4*)(LOGF + ((size_t)b * 8 + h) * SEQ + s0); f32x4 a0 = {0.f, 0.f, 0.f, 0.f}, a1 = a0; if (s0 < n) { a0 = lp[0]; a1 = lp[1]; }
      v[0] = a0[0] * LOG2E; v[1] = a0[1] * LOG2E; v[2] = a0[2] * LOG2E; v[3] = a0[3] * LOG2E; v[4] = a1[0] * LOG2E; v[5] = a1[1] * LOG2E; v[6] = a1[2] * LOG2E; v[7] = a1[3] * LOG2E; }
#pragma unroll
    for (int i = 1; i < 8; ++i) v[i] += v[i - 1];
    float tot = v[7], inc = tot;
#pragma unroll
    for (int o = 1; o < 64; o <<= 1) { const float t = __shfl_up(inc, o); if (lane >= o) inc += t; }
    if (lane == 63) sc[wid] = inc;
    __syncthreads();
    float base = inc - tot;
#pragma unroll
    for (int w = 0; w < 8; ++w) if (w < wid) base += sc[w];
    if (s0 < n) {
#pragma unroll
        for (int i = 0; i < 8; ++i) F2[s0 + i] = v[i] + base;
    }
    __syncthreads();
}

template <int MIXER>
__device__ __forceinline__ void attn_unit(LAS unsigned char* lds, const bf16_t* Q, const bf16_t* Kg, const bf16_t* Vg, bf16_t* O, int b, int h, int qb, float kmax, int tid, int lane, int wid) {
    const int c = lane & 31, hh = lane >> 5;
    const int t0 = qb * 256 + wid * 32, tq = t0 + c;
    const size_t rowbase = (size_t)b * SEQ;
    size_t qoff = (rowbase + tq) * 1024 + h * HD + 8 * hh;
    f32x16 oacc[4];
#pragma unroll
    for (int d = 0; d < 4; ++d)
#pragma unroll
        for (int r = 0; r < 16; ++r) oacc[d][r] = 0.f;
    float carry = 0.f, mrun = -1e30f, lsum = 0.f; const float nhf = hh ? 0.f : 1.f;
    const LAS float* F2 = (const LAS float*)(lds + OFF_F);
    const float Ft = (MIXER == 1) ? F2[tq] : 0.f;
    float qk_bound = 0.f;
    if (MIXER == 1) { float qs = 0.f;
#pragma unroll
        for (int s2 = 0; s2 < 8; ++s2) { const u32x4 qv = *(const u32x4*)(Q + qoff + 16 * s2);
#pragma unroll
            for (int e = 0; e < 4; ++e) { const float a = bf_lo(qv[e]), b2 = bf_hi(qv[e]); qs += a * a + b2 * b2; } }
        qs += __shfl_xor(qs, 32);
        qk_bound = sqrtf(qs) * kmax; }
    bool wave_done = false;
    volatile LAS unsigned* flg = (volatile LAS unsigned*)(lds + OFF_FLG);
    const int ktmax = 4 * qb + 3;
    const int srow = tid >> 4, scc = tid & 15;
    u32x4 kr[2], vr[2];
#define ATT_LOAD(kt) do { _Pragma("unroll") for (int j = 0; j < 2; ++j) { const size_t g_ = (rowbase + 64 * (kt) + srow + 32 * j) * 1024 + h * HD + scc * 8; \
        kr[j] = *(const u32x4*)(Kg + g_); vr[j] = *(const u32x4*)(Vg + g_); } } while (0)
#define ATT_WRITE(buf) do { _Pragma("unroll") for (int j = 0; j < 2; ++j) { \
        *(LAS u32x4*)(lds + OFF_K + (buf) * KBUF + (srow + 32 * j) * KST + scc * 16) = kr[j]; \
        *(LAS u32x4*)(lds + OFF_V + (buf) * VBUF + (srow + 32 * j) * VST + scc * 16) = vr[j]; } } while (0)
    ATT_LOAD(ktmax); ATT_WRITE(0); __syncthreads();
    int buf = 0;
    for (int kt = ktmax; kt >= 0; --kt) {
        if (kt > 0) ATT_LOAD(kt - 1);
        const bool started = (64 * kt <= t0 + 31);
        if (started && !wave_done) {
            const LAS unsigned char* Kl = lds + OFF_K + buf * KBUF; const LAS unsigned char* Vl = lds + OFF_V + buf * VBUF;
            f32x16 sacc[2];
            asm volatile("" : "+v"(qoff));
            bf16x8 qf[8];
#pragma unroll
            for (int s = 0; s < 8; ++s) qf[s] = *(const bf16x8*)(Q + qoff + 16 * s);
#pragma unroll
            for (int sub = 0; sub < 2; ++sub) {
#pragma unroll
                for (int r = 0; r < 16; ++r) sacc[sub][r] = 0.f;
#pragma unroll
                for (int s = 0; s < 8; ++s) { const bf16x8 kf = *(const LAS bf16x8*)(Kl + (32 * sub + c) * KST + (16 * s + 8 * hh) * 2);
                    sacc[sub] = __builtin_amdgcn_mfma_f32_32x32x16_bf16(kf, qf[s], sacc[sub], 0, 0, 0); }
            }
            const bool need_mask = (64 * kt + 63 >= t0);
            bool tile_dead = false;
            if (MIXER == 0) {
#pragma unroll
                for (int sub = 1; sub >= 0; --sub) {
                    float lb[16];
#pragma unroll
                    for (int r = 0; r < 16; ++r) { const float z = sacc[sub][r]; float l = -flog2(1.f + fexp2(z));
                        if (need_mask) { const int sidx = 64 * kt + 32 * sub + (r & 3) + 8 * (r >> 2) + 4 * hh; l = (sidx < tq) ? l : 0.f; }
                        lb[r] = l; }
                    float Glo[4], Ghi[4];
#pragma unroll
                    for (int g = 0; g < 4; ++g) { lb[4 * g + 2] += lb[4 * g + 3]; lb[4 * g + 1] += lb[4 * g + 2]; lb[4 * g] += lb[4 * g + 1];
                        const unsigned gu = __builtin_bit_cast(unsigned, lb[4 * g]); const auto rr = __builtin_amdgcn_permlane32_swap(gu, gu, false, false);
                        Glo[g] = __builtin_bit_cast(float, (unsigned)rr[0]); Ghi[g] = __builtin_bit_cast(float, (unsigned)rr[1]); }
                    float E[8];
                    E[7] = carry; E[6] = E[7] + Ghi[3]; E[5] = E[6] + Glo[3]; E[4] = E[5] + Ghi[2]; E[3] = E[4] + Glo[2]; E[2] = E[3] + Ghi[1]; E[1] = E[2] + Glo[1]; E[0] = E[1] + Ghi[0];
                    carry = E[0] + Glo[0];
#pragma unroll
                    for (int g = 0; g < 4; ++g) { const float Eo = __builtin_fmaf(nhf, Ghi[g], E[2 * g + 1]);
#pragma unroll
                        for (int i = 0; i < 4; ++i) { const int r = 4 * g + i; float w = fexp2(sacc[sub][r] + lb[r] + Eo);
                            if (need_mask) { const int sidx = 64 * kt + 32 * sub + (r & 3) + 8 * (r >> 2) + 4 * hh; w = (sidx < tq) ? w : 0.f; }
                            sacc[sub][r] = w; } }
                }
            } else {
                float mx = -1e30f;
#pragma unroll
                for (int sub = 0; sub < 2; ++sub)
#pragma unroll
                    for (int g = 0; g < 4; ++g) { const f32x4 fs = *(const LAS f32x4*)(F2 + 64 * kt + 32 * sub + 8 * g + 4 * hh);
#pragma unroll
                        for (int i = 0; i < 4; ++i) { const int r = 4 * g + i; float xv = sacc[sub][r] + (Ft - fs[i]);
                            if (need_mask) { const int sidx = 64 * kt + 32 * sub + 8 * g + 4 * hh + i; xv = (sidx <= tq) ? xv : -1e30f; }
                            sacc[sub][r] = xv; mx = fmaxf(mx, xv); } }
                { const unsigned mu = __builtin_bit_cast(unsigned, mx); const auto rr = __builtin_amdgcn_permlane32_swap(mu, mu, false, false);
                  mx = fmaxf(__builtin_bit_cast(float, (unsigned)rr[0]), __builtin_bit_cast(float, (unsigned)rr[1])); }
                tile_dead = __all(mx - mrun < -THR_FOX);
                if (!tile_dead) {
                const float mnew = fmaxf(mrun, mx);
                const float alpha = fexp2(mrun - mnew);
                float ps = 0.f;
#pragma unroll
                for (int sub = 0; sub < 2; ++sub)
#pragma unroll
                    for (int r = 0; r < 16; ++r) { const float p = fexp2(sacc[sub][r] - mnew); sacc[sub][r] = p; ps += p; }
                lsum = lsum * alpha + ps;
                if (__any(mnew > mrun)) {
#pragma unroll
                    for (int d = 0; d < 4; ++d)
#pragma unroll
                        for (int r = 0; r < 16; ++r) oacc[d][r] *= alpha;
                }
                mrun = mnew;
                }
            }
            if (!tile_dead)
#pragma unroll
            for (int ks = 0; ks < 4; ++ks) { const int sub = ks >> 1, rb = 8 * (ks & 1);
                u32x4 pw; pw.x = pk2(sacc[sub][rb + 0], sacc[sub][rb + 1]); pw.y = pk2(sacc[sub][rb + 2], sacc[sub][rb + 3]); pw.z = pk2(sacc[sub][rb + 4], sacc[sub][rb + 5]); pw.w = pk2(sacc[sub][rb + 6], sacc[sub][rb + 7]);
                const bf16x8 pf = __builtin_bit_cast(bf16x8, pw);
                const LAS unsigned char* vb = Vl + (16 * ks + 4 * hh + ((lane & 15) >> 2)) * VST + (16 * ((lane >> 4) & 1) + 4 * (lane & 3)) * 2;
#pragma unroll
                for (int d = 0; d < 4; ++d) {
                    const s16x4 a0 = __builtin_amdgcn_ds_read_tr16_b64_v4i16((LAS s16x4*)(vb + d * 64));
                    const s16x4 a1 = __builtin_amdgcn_ds_read_tr16_b64_v4i16((LAS s16x4*)(vb + d * 64 + 8 * VST));
                    const bf16x8 af = {a0[0], a0[1], a0[2], a0[3], a1[0], a1[1], a1[2], a1[3]};
                    oacc[d] = __builtin_amdgcn_mfma_f32_32x32x16_bf16(af, pf, oacc[d], 0, 0, 0); }
            }
        }
        if (kt > 0) ATT_WRITE(buf ^ 1);
        if (kt > 0 && started && !wave_done) {
            if (MIXER == 0) wave_done = __all(carry < -THR_SB);
            else wave_done = __all(qk_bound + (Ft - F2[64 * kt - 1]) - mrun < -THR_FOX);
        }
        if (lane == 0) flg[(kt & 1) * 8 + wid] = wave_done ? 1u : 0u;
        __syncthreads();
        buf ^= 1;
        { unsigned alld = 1u;
#pragma unroll
          for (int w = 0; w < 8; ++w) alld &= flg[(kt & 1) * 8 + w];
          if (alld) break; }
    }
#undef ATT_LOAD
#undef ATT_WRITE
    float inv = 1.f;
    if (MIXER == 1) { const unsigned lu = __builtin_bit_cast(unsigned, lsum); const auto rr = __builtin_amdgcn_permlane32_swap(lu, lu, false, false);
        inv = 1.f / (__builtin_bit_cast(float, (unsigned)rr[0]) + __builtin_bit_cast(float, (unsigned)rr[1])); }
    bf16_t* op = O + (rowbase + tq) * 2048 + 4 * hh;
#pragma unroll
    for (int d = 0; d < 4; ++d)
#pragma unroll
        for (int g = 0; g < 4; ++g) { u32x2 w; w.x = pk2(oacc[d][4 * g] * inv, oacc[d][4 * g + 1] * inv); w.y = pk2(oacc[d][4 * g + 2] * inv, oacc[d][4 * g + 3] * inv);
            *(u32x2*)(op + 32 * d + 8 * g) = w; }
}

__device__ __forceinline__ void attn_phase(const Params& P, LAS unsigned char* lds, int vcu, int G) {
    const int tid = threadIdx.x, lane = tid & 63, wid = __builtin_amdgcn_readfirstlane(tid >> 6);
    unsigned char* ws = P.ws;
    const bf16_t* QKV = (const bf16_t*)(ws + WS_QKV); const size_t TS = (size_t)T_TOK * 1024;
    bf16_t* OAB = (bf16_t*)(ws + WS_H); const float* LOGF = (const float*)(ws + WS_LOGF);
    unsigned* qctr = (unsigned*)(ws + WS_CTL + 196608);
    const unsigned* KMAXW = (const unsigned*)(ws + WS_CTL + 200704);
    volatile LAS unsigned* uw = (volatile LAS unsigned*)(lds + OFF_UNIT);
    for (;;) {
        if (tid == 0) uw[0] = atomicAdd(qctr, 1u);
        __syncthreads();
        const unsigned u = uw[0];
        __syncthreads();
        if (u >= 2560u) break;
        if (u >= 512u) { quantise_expert_rows(P, (int)(u - 512u) * 16 + wid * 2, 2); continue; }
        const int mixer = (u < 256u) ? 1 : 0, v = (int)(u & 255u), qb = 15 - (v >> 4), bh = v & 15, b = bh >> 3, h = bh & 7;
        if (mixer == 0) {
            attn_unit<0>(lds, QKV, QKV + TS, QKV + 2 * TS, OAB + h * HD, b, h, qb, 0.f, tid, lane, wid);
        } else {
            float k2 = 0.f;
#pragma unroll
            for (int w = 0; w < 4; ++w) k2 += __builtin_bit_cast(float, __hip_atomic_load(KMAXW + bh * 4 + w, __ATOMIC_RELAXED, __HIP_MEMORY_SCOPE_AGENT));
            const float kmax = sqrtf(k2) * 1.01f;
            build_cumf(lds, LOGF, b, h, 256 * (qb + 1), tid, lane, wid);
            attn_unit<1>(lds, QKV + 3 * TS, QKV + 4 * TS, QKV + 5 * TS, OAB + 1024 + h * HD, b, h, qb, kmax, tid, lane, wid);
        }
        __syncthreads();
    }
}
}

namespace peer {
__device__ __forceinline__ unsigned sortable(float f) { const unsigned u = __builtin_bit_cast(unsigned, f); return (u & 0x80000000u) ? ~u : (u | 0x80000000u); }
__device__ __forceinline__ float unsortable(unsigned k) { const unsigned u = (k & 0x80000000u) ? (k & 0x7fffffffu) : ~k; return __builtin_bit_cast(float, u); }
#define CE_DESC(x, y) do { const unsigned hi_ = (x) > (y) ? (x) : (y); const unsigned lo_ = (x) > (y) ? (y) : (x); (x) = hi_; (y) = lo_; } while (0)
template <int B, int N> __device__ __forceinline__ void sort16_desc(unsigned (&a)[N]) {
#pragma unroll
    for (int k = 2; k <= 16; k <<= 1)
#pragma unroll
        for (int j = k >> 1; j > 0; j >>= 1)
#pragma unroll
            for (int i = 0; i < 16; ++i) { const int l = i ^ j; if (l > i) { if ((i & k) == 0) CE_DESC(a[B + i], a[B + l]); else CE_DESC(a[B + l], a[B + i]); } }
}
template <int A, int Bq, int N> __device__ __forceinline__ void merge_top16(unsigned (&a)[N]) {
#pragma unroll
    for (int i = 0; i < 16; ++i) { const unsigned x = a[A + i], y = a[Bq + 15 - i]; a[A + i] = x > y ? x : y; }
#pragma unroll
    for (int j = 8; j > 0; j >>= 1)
#pragma unroll
        for (int i = 0; i < 16; ++i) { const int l = i ^ j; if (l > i) CE_DESC(a[A + i], a[A + l]); }
}

__device__ __forceinline__ void topk_phase(const Params& P, LAS unsigned char* lds, int vcu, int G) {
    const int tid = threadIdx.x, lane = tid & 63, wave = __builtin_amdgcn_readfirstlane(tid >> 6);
    const int c = lane & 31, hh = lane >> 5;
    const int gw = vcu * NWAVES + wave, NGW = G * NWAVES;
    unsigned char* ws = P.ws;
    const bf16_t* Q2 = (const bf16_t*)(ws + WS_Q2); const bf16_t* SKB = (const bf16_t*)(ws + WS_SKB);
    const float* ROWSS = (const float*)(ws + WS_CTL); int* IDS = (int*)(ws + WS_IDS); float* GATES = (float*)(ws + WS_GATES);
    LAS unsigned char* scr = lds + wave * 4096;
    const bool shared_head = (G == 256);
    LAS unsigned char* skl = lds + 32768;
    if (shared_head) { const bf16_t* src = SKB + (size_t)(vcu & 7) * 2 * 128 * 128;
#pragma unroll
        for (int q = 0; q < 8; ++q) { const int ch = tid + 512 * q, row = ch >> 4, cc = ch & 15; *(LAS u32x4*)(skl + row * 272 + cc * 16) = *(const u32x4*)(src + row * 128 + cc * 8); }
        __syncthreads(); }
    for (int task = (shared_head ? (((vcu >> 3) * 8 + wave) * 8 + (vcu & 7)) : gw); task < 2048; task += (shared_head ? 1 << 30 : NGW)) {
        const int tg = task >> 3, hd = task & 7, tok = tg * 32 + c;
#pragma unroll 1
        for (int p = 0; p < 2; ++p) {
            bf16x8 qf[8];
            { const bf16_t* qp = Q2 + (size_t)tok * DM + hd * 256 + p * 128 + 8 * hh;
#pragma unroll
              for (int s = 0; s < 8; ++s) qf[s] = *(const bf16x8*)(qp + 16 * s); }
            unsigned keys[64];
#pragma unroll
            for (int sub = 0; sub < 4; ++sub) {
                f32x16 acc;
#pragma unroll
                for (int r = 0; r < 16; ++r) acc[r] = 0.f;
                const bf16_t* kp = SKB + ((size_t)(hd * 2 + p) * 128 + 32 * sub + c) * 128 + 8 * hh;
#pragma unroll
                for (int s = 0; s < 8; ++s) { const bf16x8 kf = shared_head ? *(const LAS bf16x8*)(skl + (p * 128 + 32 * sub + c) * 272 + (16 * s + 8 * hh) * 2) : *(const bf16x8*)(kp + 16 * s); acc = __builtin_amdgcn_mfma_f32_32x32x16_bf16(kf, qf[s], acc, 0, 0, 0); }
#pragma unroll
                for (int r = 0; r < 16; ++r) { const int nlo = 127 - (32 * sub + (r & 3) + 8 * (r >> 2)); keys[sub * 16 + r] = (sortable(acc[r]) & ~127u) | (unsigned)(nlo - 4 * hh); }
            }
            sort16_desc<0>(keys); sort16_desc<16>(keys); sort16_desc<32>(keys); sort16_desc<48>(keys);
            merge_top16<0, 16>(keys); merge_top16<32, 48>(keys); merge_top16<0, 32>(keys);
#pragma unroll
            for (int i = 0; i < 16; ++i) { const unsigned own = keys[i]; const auto rr = __builtin_amdgcn_permlane32_swap(own, own, false, false); keys[16 + i] = hh ? (unsigned)rr[0] : (unsigned)rr[1]; }
            merge_top16<0, 16>(keys);
            if (hh == 0) {
#pragma unroll
                for (int w = 0; w < 4; ++w) *(LAS u32x4*)(scr + (c * 2 + p) * 64 + w * 16) = (u32x4){keys[4 * w], keys[4 * w + 1], keys[4 * w + 2], keys[4 * w + 3]};
            }
        }
        LDS_WAIT();
        float s1[16], s2[16];
#pragma unroll
        for (int w = 0; w < 4; ++w) { const u32x4 a = *(const LAS u32x4*)(scr + (c * 2) * 64 + w * 16), b2 = *(const LAS u32x4*)(scr + (c * 2 + 1) * 64 + w * 16);
#pragma unroll
            for (int e = 0; e < 4; ++e) { s1[4 * w + e] = unsortable((a[e] & ~127u) | 64u); s2[4 * w + e] = unsortable((b2[e] & ~127u) | 64u); } }
        unsigned ck[64];
        { int n = 0;
#pragma unroll
          for (int i = 0; i < 16; ++i)
#pragma unroll
              for (int j = 0; j < 16; ++j) if ((i + 1) * (j + 1) <= 16) { ck[n] = (sortable(s1[i] + s2[j]) & ~255u) | (unsigned)(255 - (i * 16 + j)); ++n; }
#pragma unroll
          for (int q = 50; q < 64; ++q) ck[q] = 0u; }
        sort16_desc<0>(ck); sort16_desc<16>(ck); sort16_desc<32>(ck); sort16_desc<48>(ck);
        merge_top16<0, 16>(ck); merge_top16<32, 48>(ck); merge_top16<0, 32>(ck);
        unsigned t2[16];
#pragma unroll
        for (int k = 0; k < 16; ++k) t2[k] = ck[k];
        int ids[16]; float sc[16];
#pragma unroll
        for (int k = 0; k < 16; ++k) { const unsigned pos = 255u - (t2[k] & 255u);
            const unsigned k1 = *(const LAS unsigned*)(scr + (c * 2) * 64 + (pos >> 4) * 4), k2 = *(const LAS unsigned*)(scr + (c * 2 + 1) * 64 + (pos & 15u) * 4);
            ids[k] = (int)((127u - (k1 & 127u)) * 128u + (127u - (k2 & 127u))); sc[k] = unsortable((t2[k] & ~255u) | 128u); }
        LDS_WAIT();
        const float rs = 1.0f / sqrtf(ROWSS[tok] * (1.f / DM) + EPS);
        float ev[16], Z = 0.f;
#pragma unroll
        for (int k = 0; k < 16; ++k) { ev[k] = fexp2((sc[k] - sc[0]) * rs * LOG2E); Z += ev[k]; }
        const float iz = 1.f / Z;
        int* ip = IDS + (size_t)tok * 128 + hd * 16; float* gp = GATES + (size_t)tok * 128 + hd * 16;
        if (hh == 0) {
#pragma unroll
            for (int k = 0; k < 8; ++k) { ip[k] = ids[k]; gp[k] = ev[k] * iz; }
        } else {
#pragma unroll
            for (int k = 8; k < 16; ++k) { ip[k] = ids[k]; gp[k] = ev[k] * iz; }
        }
    }
}


__device__ __forceinline__ float dot8(u32x4 a, u32x4 b, float acc) {
    const unsigned a0 = a[0], a1 = a[1], a2 = a[2], a3 = a[3], b0 = b[0], b1 = b[1], b2 = b[2], b3 = b[3];
    acc = __builtin_amdgcn_fdot2_f32_bf16(__builtin_bit_cast(bf16v2, a0), __builtin_bit_cast(bf16v2, b0), acc, false);
    acc = __builtin_amdgcn_fdot2_f32_bf16(__builtin_bit_cast(bf16v2, a1), __builtin_bit_cast(bf16v2, b1), acc, false);
    acc = __builtin_amdgcn_fdot2_f32_bf16(__builtin_bit_cast(bf16v2, a2), __builtin_bit_cast(bf16v2, b2), acc, false);
    acc = __builtin_amdgcn_fdot2_f32_bf16(__builtin_bit_cast(bf16v2, a3), __builtin_bit_cast(bf16v2, b3), acc, false);
    return acc;
}
__device__ __forceinline__ float gelu_tanh(float a) { const float t = 1.5957691216f * (a + 0.044715f * a * a * a); return a * frcp(1.f + fexp2(-LOG2E * t)); }

__device__ __forceinline__ int dot16(u32x4 a, u32x4 b, int acc) {
    acc = __builtin_amdgcn_sdot4((int)a[0], (int)b[0], acc, false); acc = __builtin_amdgcn_sdot4((int)a[1], (int)b[1], acc, false);
    acc = __builtin_amdgcn_sdot4((int)a[2], (int)b[2], acc, false); acc = __builtin_amdgcn_sdot4((int)a[3], (int)b[3], acc, false);
    return acc;
}
__device__ __forceinline__ void gather_sweep(const Params& P, LAS unsigned char* lds, int vcu, int G) {
    const int tid = threadIdx.x, lane = tid & 63, wave = __builtin_amdgcn_readfirstlane(tid >> 6);
    const int gw = vcu * NWAVES + wave, NGW = G * NWAVES;
    const int g = lane >> 3, i = lane & 7;
    unsigned char* ws = P.ws;
    const bf16_t* X1B = (const bf16_t*)(ws + WS_X1B); const float* ROWSS = (const float*)(ws + WS_CTL);
    const int* IDS = (const int*)(ws + WS_IDS); const float* GATES = (const float*)(ws + WS_GATES);
    const unsigned char* EU = ws + WS_EU; const unsigned char* EV = ws + WS_EV;
    const float* SU = (const float*)(ws + WS_SU); const float* SV = (const float*)(ws + WS_SV);
    LAS unsigned char* wl = lds + wave * 19456;
    const bool b2 = (lane >> 2) & 1, b1 = (lane >> 1) & 1, b0 = lane & 1, B2 = (lane >> 5) & 1, B1 = (lane >> 4) & 1, B0 = (lane >> 3) & 1;
    for (int tg = gw; tg < T_TOK / 4; tg += NGW) {
        const int tok0 = tg * 4;
        float hs[4];
#pragma unroll
        for (int j = 0; j < 4; ++j) { const int tok = tok0 + j;
            const float rs = 1.0f / sqrtf(ROWSS[tok] * (1.f / DM) + EPS);
            f32x4 hv[8]; float hmx = 0.f;
#pragma unroll
            for (int q = 0; q < 8; ++q) { const u32x2 xb = *((const u32x2*)(X1B + (size_t)tok * DM) + lane + 64 * q); const f32x4 xv = {bf_lo(xb[0]), bf_hi(xb[0]), bf_lo(xb[1]), bf_hi(xb[1])}; const f32x4 gn = *((const f32x4*)P.g_ffn + lane + 64 * q);
                hv[q] = xv * rs * gn; hmx = fmaxf(hmx, fmaxf(fmaxf(fabsf(hv[q][0]), fabsf(hv[q][1])), fmaxf(fabsf(hv[q][2]), fabsf(hv[q][3])))); }
#pragma unroll
            for (int o = 1; o < 64; o <<= 1) hmx = fmaxf(hmx, __shfl_xor(hmx, o));
            hmx = fmaxf(hmx, 1e-30f); const float hinv = 127.f / hmx; hs[j] = hmx * (1.f / 127.f);
#pragma unroll
            for (int q = 0; q < 8; ++q) { unsigned w = 0;
#pragma unroll
                for (int e = 0; e < 4; ++e) w |= ((unsigned)(int)__builtin_rintf(hv[q][e] * hinv) & 255u) << (8 * e);
                *(LAS unsigned*)(wl + 2560 + j * 2048 + 4 * (lane + 64 * q)) = w; }
#pragma unroll
            for (int hf = 0; hf < 2; ++hf) { const int k = lane + 64 * hf; const int id = IDS[(size_t)tok * 128 + k];
                *(LAS unsigned*)(wl + (j * 128 + k) * 4) = (unsigned)id * 128u;
                *(LAS float*)(wl + 10752 + (j * 128 + k) * 4) = GATES[(size_t)tok * 128 + k] * SV[id];
                *(LAS float*)(wl + 12800 + (j * 128 + k) * 4) = SU[id]; }
        }
        LDS_WAIT();
        int accu[4][16];
#pragma unroll
        for (int j = 0; j < 4; ++j)
#pragma unroll
            for (int m = 0; m < 16; ++m) accu[j][m] = 0;
        const unsigned i16 = 16u * (unsigned)i;
#define US_LOAD(D, sl_, j_) do { unsigned long long ub64_ = (unsigned long long)(EU + ((size_t)(sl_) << 21)); asm volatile("" : "+s"(ub64_)); const GAS unsigned char* ub_ = (const GAS unsigned char*)ub64_; \
            _Pragma("unroll") for (int m = 0; m < 16; ++m) { const unsigned off = *(const LAS unsigned*)(wl + ((j_) * 128 + 8 * m + g) * 4) + i16; D[m] = *(const GAS u32x4*)(ub_ + off); } \
            __builtin_amdgcn_sched_barrier(0); } while (0)
#define US_COMP(D, sl_, j_) do { \
            asm volatile("" : "+v"(D[0]), "+v"(D[1]), "+v"(D[2]), "+v"(D[3]), "+v"(D[4]), "+v"(D[5]), "+v"(D[6]), "+v"(D[7]), "+v"(D[8]), "+v"(D[9]), "+v"(D[10]), "+v"(D[11]), "+v"(D[12]), "+v"(D[13]), "+v"(D[14]), "+v"(D[15]) :: "memory"); \
            const u32x4 hqc = *(const LAS u32x4*)(wl + 2560 + (j_) * 2048 + 128 * (sl_) + 16 * i); \
            _Pragma("unroll") for (int m = 0; m < 16; ++m) accu[j_][m] = dot16(D[m], hqc, accu[j_][m]); \
            __builtin_amdgcn_sched_barrier(0); } while (0)
        {
            u32x4 dA[16], dB[16];
            US_LOAD(dA, 0, 0);
#pragma unroll 1
            for (int sl = 0; sl < 16; ++sl) {
                const int sln = sl < 15 ? sl + 1 : 15;
                US_LOAD(dB, sl, 1); US_COMP(dA, sl, 0);
                US_LOAD(dA, sl, 2); US_COMP(dB, sl, 1);
                US_LOAD(dB, sl, 3); US_COMP(dA, sl, 2);
                __syncthreads();
                US_LOAD(dA, sln, 0); US_COMP(dB, sl, 3);
            }
        }
#undef US_LOAD
#undef US_COMP
        float sw[4];
#pragma unroll
        for (int j = 0; j < 4; ++j) {
            int r1[8], r2[4], r3[2];
#pragma unroll
            for (int m = 0; m < 8; ++m) { const int send = b2 ? accu[j][m] : accu[j][m + 8], keep = b2 ? accu[j][m + 8] : accu[j][m]; r1[m] = keep + __shfl_xor(send, 4); }
#pragma unroll
            for (int m = 0; m < 4; ++m) { const int send = b1 ? r1[m] : r1[m + 4], keep = b1 ? r1[m + 4] : r1[m]; r2[m] = keep + __shfl_xor(send, 2); }
#pragma unroll
            for (int m = 0; m < 2; ++m) { const int send = b0 ? r2[m] : r2[m + 2], keep = b0 ? r2[m + 2] : r2[m]; r3[m] = keep + __shfl_xor(send, 1); }
            float w2[2], wmx = 0.f;
#pragma unroll
            for (int m = 0; m < 2; ++m) { const int k = 16 * i + 8 * m + g;
                const float act = (float)r3[m] * (hs[j] * *(const LAS float*)(wl + 12800 + (j * 128 + k) * 4));
                w2[m] = *(const LAS float*)(wl + 10752 + (j * 128 + k) * 4) * gelu_tanh(act); wmx = fmaxf(wmx, fabsf(w2[m])); }
#pragma unroll
            for (int o = 1; o < 64; o <<= 1) wmx = fmaxf(wmx, __shfl_xor(wmx, o));
            wmx = fmaxf(wmx, 1e-30f); sw[j] = wmx * (1.f / 127.f);
            const float winv = 127.f / wmx;
            const unsigned q0 = (unsigned)(int)__builtin_rintf(w2[0] * winv) & 255u, q1 = (unsigned)(int)__builtin_rintf(w2[1] * winv) & 255u;
            *(LAS unsigned short*)(wl + 2048 + j * 128 + 16 * g + 2 * i) = (unsigned short)(q0 | (q1 << 8));
        }
        LDS_WAIT();
        float ssq[4] = {0.f, 0.f, 0.f, 0.f};
#define VS_LOAD(D, XB, sl_, j_) do { unsigned long long vb64_ = (unsigned long long)(EV + ((size_t)(sl_) << 21)), xb64_ = (unsigned long long)(X1B + (size_t)(tok0 + (j_)) * DM + 128 * (sl_)); \
            asm volatile("" : "+s"(vb64_), "+s"(xb64_));     \
            const GAS unsigned char* vb_ = (const GAS unsigned char*)vb64_; const GAS unsigned char* xb_ = (const GAS unsigned char*)xb64_; \
            XB = *(const GAS unsigned*)(xb_ + xlo); \
            _Pragma("unroll") for (int m = 0; m < 16; ++m) { const unsigned off = *(const LAS unsigned*)(wl + ((j_) * 128 + 8 * m + g) * 4) + i16; D[m] = *(const GAS u32x4*)(vb_ + off); } \
            __builtin_amdgcn_sched_barrier(0); } while (0)
#define VS_COMP(D, XB, sl_, j_) do { \
            asm volatile("" : "+v"(D[0]), "+v"(D[1]), "+v"(D[2]), "+v"(D[3]), "+v"(D[4]), "+v"(D[5]), "+v"(D[6]), "+v"(D[7]), "+v"(D[8]), "+v"(D[9]), "+v"(D[10]), "+v"(D[11]), "+v"(D[12]), "+v"(D[13]), "+v"(D[14]), "+v"(D[15]), "+v"(XB) :: "memory"); \
            const u32x4 wpk = *(const LAS u32x4*)(wl + 2048 + (j_) * 128 + 16 * g); \
            int ca[16]; \
            _Pragma("unroll") for (int b = 0; b < 16; ++b) ca[b] = 0; \
            _Pragma("unroll") for (int mg = 0; mg < 4; ++mg) \
            _Pragma("unroll") for (int c4 = 0; c4 < 4; ++c4) { const unsigned r0 = D[4 * mg][c4], r1 = D[4 * mg + 1][c4], r2 = D[4 * mg + 2][c4], r3 = D[4 * mg + 3][c4]; \
                const unsigned t0 = __builtin_amdgcn_perm(r1, r0, 0x05010400u), t1 = __builtin_amdgcn_perm(r1, r0, 0x07030602u); \
                const unsigned t2 = __builtin_amdgcn_perm(r3, r2, 0x05010400u), t3 = __builtin_amdgcn_perm(r3, r2, 0x07030602u); \
                const int wq4 = (int)wpk[mg]; \
                ca[4 * c4 + 0] = __builtin_amdgcn_sdot4((int)__builtin_amdgcn_perm(t2, t0, 0x05040100u), wq4, ca[4 * c4 + 0], false); \
                ca[4 * c4 + 1] = __builtin_amdgcn_sdot4((int)__builtin_amdgcn_perm(t2, t0, 0x07060302u), wq4, ca[4 * c4 + 1], false); \
                ca[4 * c4 + 2] = __builtin_amdgcn_sdot4((int)__builtin_amdgcn_perm(t3, t1, 0x05040100u), wq4, ca[4 * c4 + 2], false); \
                ca[4 * c4 + 3] = __builtin_amdgcn_sdot4((int)__builtin_amdgcn_perm(t3, t1, 0x07060302u), wq4, ca[4 * c4 + 3], false); } \
            int c1[8], c2[4], c3[2]; \
            _Pragma("unroll") for (int b = 0; b < 8; ++b) { const auto rr = __builtin_amdgcn_permlane32_swap((unsigned)ca[b], (unsigned)ca[b + 8], false, false); c1[b] = (int)(rr[0] + rr[1]); } \
            _Pragma("unroll") for (int b = 0; b < 4; ++b) { const auto rr = __builtin_amdgcn_permlane16_swap((unsigned)c1[b], (unsigned)c1[b + 4], false, false); c2[b] = (int)(rr[0] + rr[1]); } \
            _Pragma("unroll") for (int b = 0; b < 2; ++b) { const int send = B0 ? c2[b] : c2[b + 2], keep = B0 ? c2[b + 2] : c2[b]; c3[b] = keep + __builtin_amdgcn_update_dpp(0, send, 0x128, 0xf, 0xf, true); } \
            const f32x2 xv = {bf_lo(XB), bf_hi(XB)}; \
            const f32x2 x2 = {xv[0] + sw[j_] * (float)c3[0], xv[1] + sw[j_] * (float)c3[1]}; \
            ssq[j_] += x2[0] * x2[0] + x2[1] * x2[1]; \
            *(LAS unsigned*)(wl + 2560 + (((sl_) * 4 + (j_)) * 64 + lane) * 4) = pk2(x2[0], x2[1]); \
            __builtin_amdgcn_sched_barrier(0); } while (0)
        u32x4 dA[16], dB[16]; unsigned xA, xB; const unsigned xlo = (unsigned)(16 * i + 2 * g) * 2u;
        VS_LOAD(dA, xA, 0, 0);
#pragma unroll 1
        for (int sl = 0; sl < 16; ++sl) {
            const int sln = sl < 15 ? sl + 1 : 15;
            VS_LOAD(dB, xB, sl, 1); VS_COMP(dA, xA, sl, 0);
            VS_LOAD(dA, xA, sl, 2); VS_COMP(dB, xB, sl, 1);
            VS_LOAD(dB, xB, sl, 3); VS_COMP(dA, xA, sl, 2);
            VS_LOAD(dA, xA, sln, 0); VS_COMP(dB, xB, sl, 3);
        }
#undef VS_LOAD
#undef VS_COMP
        float rs2[4];
#pragma unroll
        for (int j = 0; j < 4; ++j) rs2[j] = 1.0f / sqrtf(wave_sum(ssq[j]) * (1.f / DM) + EPS);
        LDS_WAIT();
#pragma unroll 4
        for (int sl = 0; sl < 16; ++sl) { const f32x2 gn = *(const f32x2*)(P.g_final + 128 * sl + 16 * i + 2 * g);
#pragma unroll
            for (int j = 0; j < 4; ++j) { const unsigned xw = *(const LAS unsigned*)(wl + 2560 + ((sl * 4 + j) * 64 + lane) * 4);
                const f32x2 ov = {bf_lo(xw) * rs2[j] * gn[0], bf_hi(xw) * rs2[j] * gn[1]};
                *(f32x2*)(P.out + (size_t)(tok0 + j) * DM + 128 * sl + 16 * i + 2 * g) = ov; } }
        LDS_WAIT();
    }
}

}


#define XB_TMO      128
#define XB_XCNT(j)  (256  + 64 * (j))
#define XB_XSUB(j)  (1280 + 64 * (j))
#define XB_XGEN(j)  (2304 + 64 * (j))
#define XB_TOP      3328
#define XB_TOPGEN   3392
#define XCD_BAR_WORDS 3456
#define XB_SPIN_CAP (1u << 18)
__device__ __forceinline__ unsigned xb_ld(unsigned* p)              { return __hip_atomic_load(p, __ATOMIC_RELAXED, __HIP_MEMORY_SCOPE_AGENT); }
__device__ __forceinline__ unsigned xb_add(unsigned* p, unsigned v) { return __hip_atomic_fetch_add(p, v, __ATOMIC_RELAXED, __HIP_MEMORY_SCOPE_AGENT); }
__device__ __forceinline__ unsigned xb_xcc_id() { return (unsigned)__builtin_amdgcn_s_getreg((3 << 11) | 20) & 0xFu; }
#define XB_SPIN(cond, bar) do { unsigned _sp = 0; while (cond) { __builtin_amdgcn_s_sleep(1); \
    if ((++_sp & 255u) == 0u) { if (xb_ld(&(bar)[XB_TMO])) break; if (_sp > XB_SPIN_CAP) { atomicAdd(&(bar)[XB_TMO], 1u); break; } } } } while (0)
struct XcdBarrier { unsigned* bar; unsigned x; volatile LAS unsigned* st; };
__device__ __forceinline__ XcdBarrier xcd_barrier_post(unsigned* bar, volatile LAS unsigned* st) {
    XcdBarrier b; b.bar = bar; b.x = xb_xcc_id(); b.st = st;
    if (threadIdx.x == 0) (void)xb_add(&bar[XB_XCNT(b.x)], 1u);
    return b;
}
__device__ __forceinline__ void xcd_barrier_complete(unsigned* bar, unsigned x, unsigned& nloc, unsigned& nx) {
    const unsigned G = gridDim.x * gridDim.y * gridDim.z;
    unsigned sum, cnt, mine, sp = 0u;
    for (;;) {
        sum = 0u; cnt = 0u; mine = 0u;
#pragma unroll
        for (unsigned j = 0; j < 16; ++j) { const unsigned c = xb_ld(&bar[XB_XCNT(j)]); sum += c; cnt += (c > 0u) ? 1u : 0u; mine = (j == x) ? c : mine; }
        if (sum == G) break;
        __builtin_amdgcn_s_sleep(1);
        if ((++sp & 255u) == 0u) { if (xb_ld(&bar[XB_TMO])) break; if (sp > XB_SPIN_CAP) { atomicAdd(&bar[XB_TMO], 1u); break; } }
    }
    nloc = mine > 0u ? mine : 1u; nx = cnt > 0u ? cnt : 1u;
}
__device__ __forceinline__ void xcd_barrier(const XcdBarrier& b) {
    asm volatile("s_waitcnt vmcnt(0)" ::: "memory");
    __syncthreads();
    if (threadIdx.x == 0) {
        unsigned* bar = b.bar;
        __builtin_amdgcn_s_waitcnt(0);
        unsigned nloc = b.st[0], nx = b.st[1];
        if (nloc == 0u) { xcd_barrier_complete(bar, b.x, nloc, nx); b.st[0] = nloc; b.st[1] = nx; }
        const unsigned old = xb_add(&bar[XB_XSUB(b.x)], 1u);
        const unsigned gen = old / nloc;
        if (old + 1u == (gen + 1u) * nloc) {
            __builtin_amdgcn_fence(__ATOMIC_RELEASE, "agent");
            asm volatile("s_waitcnt vmcnt(0)" ::: "memory");
            const unsigned og = xb_add(&bar[XB_TOP], 1u);
            const unsigned tg = og / nx;
            if (og + 1u == (tg + 1u) * nx) xb_add(&bar[XB_TOPGEN], 1u);
            else XB_SPIN(xb_ld(&bar[XB_TOPGEN]) == tg, bar);
            __builtin_amdgcn_fence(__ATOMIC_ACQUIRE, "agent");
            xb_add(&bar[XB_XGEN(b.x)], 1u);
            asm volatile("s_waitcnt vmcnt(0)" ::: "memory");
        } else {
            XB_SPIN(xb_ld(&bar[XB_XGEN(b.x)]) == gen, bar);
            __builtin_amdgcn_fence(__ATOMIC_ACQUIRE, "agent");
            asm volatile("s_waitcnt vmcnt(0)" ::: "memory");
        }
    }
    __syncthreads();
}

__device__ __forceinline__ void group_barrier(unsigned* ctr, unsigned target) {
    asm volatile("s_waitcnt vmcnt(0)" ::: "memory");
    __syncthreads();
    if (threadIdx.x == 0) {
        const unsigned gen = target >> 5;
        const unsigned old = xb_add(ctr, 1u);
        if (old + 1u == target) (void)xb_add(ctr + 32, 1u);
        else { unsigned sp = 0u; while (xb_ld(ctr + 32) < gen) { __builtin_amdgcn_s_sleep(1); if (++sp > (1u << 24)) break; } }
        __builtin_amdgcn_fence(__ATOMIC_ACQUIRE, "agent");
        asm volatile("s_waitcnt vmcnt(0)" ::: "memory");
    }
    __syncthreads();
}
__device__ __forceinline__ bool group_purity(unsigned* pur) {
    bool ok = true;
#pragma unroll
    for (int j = 0; j < 8; ++j) { const unsigned w = xb_ld(pur + j); ok = ok && (w != 0u) && ((w & (w - 1u)) == 0u); }
    return ok;
}

__global__ void __launch_bounds__(NTHR, 2) mega_fwd(Params P) {
    extern __shared__ __attribute__((aligned(16))) unsigned char lds_raw[];
    LAS unsigned char* lds = (LAS unsigned char*)lds_raw;
    cg::grid_group grid = cg::this_grid();
    const int G = gridDim.x, bx = blockIdx.x;
    const int vcu = (G % 8 == 0) ? (bx % 8) * (G / 8) + bx / 8 : bx;
    unsigned char* ws = P.ws;
#ifndef ONLY_PHASE
#define ONLY_PHASE -1
#endif
#define IN(k) ((ONLY_PHASE < 0 || ONLY_PHASE == (k)) && P.ph_lo <= (k) && (k) < P.ph_hi)
    volatile LAS unsigned* bst = (volatile LAS unsigned*)(lds + LDS_BYTES - 64);
    if (threadIdx.x < 16) bst[threadIdx.x] = 0u;
    __syncthreads();
    const XcdBarrier xbar = xcd_barrier_post((unsigned*)(ws + WS_CTL + 131072), bst);
    if (threadIdx.x == 0) (void)__hip_atomic_fetch_or((unsigned*)(ws + WS_CTL + 147456 + 4096) + (bx & 7), 1u << xbar.x, __ATOMIC_RELAXED, __HIP_MEMORY_SCOPE_AGENT);
    if (P.ph_lo < 0) grid.sync();
#define SEAM(k) do { if (IN(k) && IN((k) + 1)) xcd_barrier(xbar); } while (0)
    unsigned* gctr = (unsigned*)(ws + WS_CTL + 147456) + 64 * (bx & 7); unsigned* gpur = (unsigned*)(ws + WS_CTL + 147456 + 4096); unsigned lgen = 0u; int lmode = -1;
#define SEAM_L(k) do { if (IN(k) && IN((k) + 1)) { if (lmode < 0) lmode = (G == 256 && IN(0) && group_purity(gpur)) ? 1 : 0; \
        if (lmode) { ++lgen; group_barrier(gctr, 32u * lgen); } else xcd_barrier(xbar); } } while (0)
    if (IN(0)) { p0a(P, lds, vcu, G); xcd_barrier(xbar); p0b(P, lds, vcu, G); }
    SEAM(0);
    if (IN(1)) {
        pg8::Gemm g{ws + WS_H, ws + WS_WIN, T_TOK, 10240, 2048, 2048, 2048};
        pg8::StaticOrder S; S.init(T_TOK, 10240, G, bx, WGM1);
        pg8::EpiProj E{(bf16_t*)(ws + WS_QKV), (bf16_t*)(ws + WS_SG), LOG2E * 0.08838834764831845f, (unsigned*)(ws + WS_CTL + 200704), (const float*)(ws + WS_HSC), (const float*)(ws + WS_WSC)};
        pg8::gemm_phase<pg8::EpiProj, true>(lds, g, S, E);
    }
    SEAM(1);
    if (IN(2)) { att::attn_phase(P, lds, vcu, G); __syncthreads(); late_transposes(P, lds, vcu, G); }
    SEAM(2);
    if (IN(3)) {
        pg8::StaticOrder S; S.init(T_TOK, DM, G, bx, WGM2);
        { pg8::Gemm g{ws + WS_H, ws + WS_WAT, T_TOK, DM, 1024, 4096, 2048};
          pg8::EpiGate<0> E{(const bf16_t*)(ws + WS_SG), (bf16_t*)(ws + WS_TMP), (bf16_t*)(ws + WS_MERGED)};
          pg8::gemm_phase(lds, g, S, E); }
        { pg8::Gemm g{ws + WS_H + 2048, ws + WS_WBT, T_TOK, DM, 1024, 4096, 2048};
          pg8::EpiGate<1> E{(const bf16_t*)(ws + WS_SG) + 2048, (bf16_t*)(ws + WS_TMP), (bf16_t*)(ws + WS_MERGED)};
          pg8::gemm_phase(lds, g, S, E); }
    }
    SEAM_L(3);
    if (IN(4)) {
        pg8::Gemm g{ws + WS_MERGED, ws + WS_WOUT, T_TOK, DM, 2048, 4096, 4096};
        pg8::StaticOrder S; S.init(T_TOK, DM, G, bx, WGM2);
        pg8::EpiResid E{P.x, (float*)(ws + WS_X1), (bf16_t*)(ws + WS_X1B), (float*)(ws + WS_CTL)};
        pg8::gemm_phase(lds, g, S, E);
    }
    SEAM_L(4);
    if (IN(5)) {
        pg8::Gemm g{ws + WS_X1B, ws + WS_WQ, T_TOK, DM, 2048, 4096, 4096};
        pg8::StaticOrder S; S.init(T_TOK, DM, G, bx, WGM2);
        pg8::EpiPlainBf16 E{(bf16_t*)(ws + WS_Q2)};
        pg8::gemm_phase(lds, g, S, E);
    }
    SEAM_L(5);
    if (IN(6)) peer::topk_phase(P, lds, vcu, G);
    SEAM_L(6);
    if (IN(7)) { peer::gather_sweep(P, lds, vcu, G); }
#undef IN
#undef SEAM
#undef SEAM_L
}

extern "C" void kernel_launch(void* const* d_in, const int* in_sizes, int n_in, void* d_out, int out_size, void* d_ws, size_t ws_size, hipStream_t stream) {
    static int grid = 0;
    if (grid == 0) {
        if (n_in != 13 || out_size != T_TOK * DM || ws_size < WS_END) { fprintf(stderr, "kernel_launch: unexpected shapes (n_in %d out %d ws %zu)\n", n_in, out_size, ws_size); grid = -1; return; }
        int dev = 0, cus = 0, per_cu = 0;
        if (hipGetDevice(&dev) != hipSuccess || hipDeviceGetAttribute(&cus, hipDeviceAttributeMultiprocessorCount, dev) != hipSuccess) { grid = -1; return; }
        if (hipFuncSetAttribute((const void*)mega_fwd, hipFuncAttributeMaxDynamicSharedMemorySize, LDS_BYTES) != hipSuccess) { fprintf(stderr, "kernel_launch: hipFuncSetAttribute failed\n"); grid = -1; return; }
        if (hipOccupancyMaxActiveBlocksPerMultiprocessor(&per_cu, (const void*)mega_fwd, NTHR, LDS_BYTES) != hipSuccess || per_cu < 1) { fprintf(stderr, "kernel_launch: occupancy query says %d\n", per_cu); grid = -1; return; }
        grid = cus;
    }
    if (grid < 0) return;
    (void)hipMemsetAsync((char*)d_ws + WS_CTL, 0, 1 * MiB, stream);
    Params p{};
    p.x = (const float*)d_in[0]; p.g_mix = (const float*)d_in[1]; p.w_in = (const float*)d_in[2]; p.b_forget = (const float*)d_in[3];
    p.w_a = (const float*)d_in[4]; p.w_b = (const float*)d_in[5]; p.w_out = (const float*)d_in[6]; p.g_ffn = (const float*)d_in[7];
    p.w_query = (const float*)d_in[8]; p.sub_keys = (const float*)d_in[9]; p.e_u = (const float*)d_in[10]; p.e_v = (const float*)d_in[11]; p.g_final = (const float*)d_in[12];
    p.out = (float*)d_out; p.ws = (unsigned char*)d_ws;
#if MK_N_LAUNCHES == 1
    p.ph_lo = 0; p.ph_hi = N_PHASES;
    void* args[] = {&p};
    hipError_t e = hipLaunchCooperativeKernel((const void*)mega_fwd, dim3(grid), dim3(NTHR), args, LDS_BYTES, stream);
    if (e != hipSuccess) fprintf(stderr, "kernel_launch: cooperative launch failed: %s (grid %d)\n", hipGetErrorString(e), grid);
#else
    for (int ph = 0; ph < N_PHASES; ++ph) { p.ph_lo = ph; p.ph_hi = ph + 1; hipLaunchKernelGGL(mega_fwd, dim3(grid), dim3(NTHR), LDS_BYTES, stream, p); }
#endif
}
```

```cpp
#include <hip/hip_runtime.h>
#include <hip/hip_cooperative_groups.h>
#include <cstdio>
#include <cstdint>
namespace cg = cooperative_groups;

#define LAS __attribute__((address_space(3)))
#define GAS __attribute__((address_space(1)))
typedef unsigned short bf16_t;
typedef short bf16x8 __attribute__((ext_vector_type(8)));
typedef short s16x4 __attribute__((ext_vector_type(4)));
typedef float f32x2 __attribute__((ext_vector_type(2)));
typedef float f32x4 __attribute__((ext_vector_type(4)));
typedef float f32x16 __attribute__((ext_vector_type(16)));
typedef unsigned u32x2 __attribute__((ext_vector_type(2)));
typedef unsigned u32x4 __attribute__((ext_vector_type(4)));
typedef __bf16 bf16v2 __attribute__((ext_vector_type(2)));
typedef int i32x4 __attribute__((ext_vector_type(4)));

#ifndef WGM1
#define WGM1 4
#endif
#ifndef WGM2
#define WGM2 4
#endif
#ifndef MK_N_LAUNCHES
#define MK_N_LAUNCHES 1
#endif

constexpr int T_TOK = 8192, DM = 2048, SEQ = 4096, HD = 128;
constexpr int NWAVES = 8, NTHR = 512;
constexpr int LDS_BYTES = 163840;
constexpr float LOG2E = 1.4426950408889634f;
constexpr float EPS = 1e-6f;
constexpr int N_PHASES = 8;

constexpr size_t MiB = 1u << 20;
constexpr size_t WS_CTL = 0;
constexpr size_t WS_LOGF = 1 * MiB;
constexpr size_t WS_SKB = 1 * MiB + 512 * 1024;
constexpr size_t WS_HSC = 1 * MiB + 256 * 1024;
constexpr size_t WS_WSC = 1 * MiB + 320 * 1024;
constexpr size_t CTL_CMAX = 262144;
constexpr size_t WS_IDS = 2 * MiB;
constexpr size_t WS_GATES = 6 * MiB;
constexpr size_t WS_WAT = 10 * MiB, WS_WBT = 14 * MiB, WS_WOUT = 18 * MiB, WS_WQ = 26 * MiB, WS_WIN = 34 * MiB;
constexpr size_t WS_H = 74 * MiB;
constexpr size_t WS_QKV = 106 * MiB;
constexpr size_t WS_TMP = 106 * MiB, WS_MERGED = 170 * MiB, WS_Q2 = 106 * MiB;
constexpr size_t WS_SG = 202 * MiB;
constexpr size_t WS_X1B = 266 * MiB;
constexpr size_t WS_X1 = 266 * MiB;
constexpr size_t WS_EU = 330 * MiB, WS_EV = 362 * MiB;
constexpr size_t WS_SU = 394 * MiB, WS_SV = 394 * MiB + 65536;
constexpr size_t WS_END = 395 * MiB;

struct Params {
    const float* x; const float* g_mix; const float* w_in; const float* b_forget; const float* w_a; const float* w_b; const float* w_out;
    const float* g_ffn; const float* w_query; const float* sub_keys; const float* e_u; const float* e_v; const float* g_final;
    float* out; unsigned char* ws; int ph_lo, ph_hi;
};

__device__ __forceinline__ unsigned pk2(float a, float b) { f32x2 v = {a, b}; return __builtin_bit_cast(unsigned, __builtin_convertvector(v, bf16v2)); }
__device__ __forceinline__ float bf_lo(unsigned u) { return __builtin_bit_cast(float, u << 16); }
__device__ __forceinline__ float bf_hi(unsigned u) { return __builtin_bit_cast(float, u & 0xffff0000u); }
__device__ __forceinline__ float fexp2(float x) { return __builtin_amdgcn_exp2f(x); }
__device__ __forceinline__ float flog2(float x) { return __builtin_amdgcn_logf(x); }
__device__ __forceinline__ float frcp(float x) { return __builtin_amdgcn_rcpf(x); }
__device__ __forceinline__ float wave_sum(float v) {
#pragma unroll
    for (int o = 1; o < 64; o <<= 1) v += __shfl_xor(v, o);
    return v;
}
#define LDS_WAIT() asm volatile("s_waitcnt lgkmcnt(0)" ::: "memory")

namespace pg8 {
constexpr int BM = 256, BK = 64, HALF = 128, HTB = HALF * BK * 2, STAGE_BYTES = 8 * HTB, NXCD = 8, WGM = 8;
__host__ __device__ __forceinline__ int lds_byte(int r, int c) { const int st = (r >> 4) * 2 + (c >> 5), rr = r & 15, cc = c & 31, ob = rr * 64 + cc * 2; return st * 1024 + (ob ^ (((ob >> 9) & 1) << 5)); }
__host__ __device__ __forceinline__ void stage_rc(int b, int& R, int& C) { const int st = b / 1024, sb = b % 1024, swz = sb ^ (((sb >> 9) & 1) << 5); R = (st >> 1) * 16 + swz / 64; C = (st & 1) * 32 + (swz % 64) / 2; }
__host__ __device__ __forceinline__ int perm32(int rho) { const int n = rho >> 4, i = rho & 15; return 8 * (i >> 2) + 4 * n + (i & 3); }
struct Unit { int pm, pn; };
struct Gemm { const void* A; const void* Bt; int M, N, K, pa, pb; };
struct StaticOrder {
    int nM, nN, nwg, G, c, wgm;
    __device__ void init(int M, int N, int G_, int c_, int wgm_ = WGM) { nM = M / BM; nN = N / BM; nwg = nM * nN; G = G_; c = c_; wgm = wgm_; }
    __device__ bool next(int i, Unit& u) const {
        const long L = (long)i * G + c; if (L >= nwg) return false;
        int wgid = (int)L; { const int q = nwg / NXCD, r = nwg % NXCD, xcd = wgid % NXCD, off = wgid / NXCD; wgid = (xcd < r ? xcd * (q + 1) : r * (q + 1) + (xcd - r) * q) + off; }
        const int nig = wgm * nN, gid = wgid / nig, fm = gid * wgm, gsz = (nM - fm) < wgm ? (nM - fm) : wgm;
        u.pm = fm + ((wgid % nig) % gsz); u.pn = (wgid % nig) / gsz; return true;
    }
};
template <class Epi, bool I8 = false>
__device__ __forceinline__ void gemm_phase(LAS unsigned char* lds, const Gemm g, const StaticOrder& S, const Epi& E) {
    const int tid = threadIdx.x, wid = __builtin_amdgcn_readfirstlane(tid >> 6), lane = tid & 63, wr = wid >> 2, wc = wid & 3, fr = lane & 15, fq = lane >> 4;
    const int K = g.K, nt = I8 ? K / (2 * BK) : K / BK;
    unsigned voffA[2], voffB[2];
#pragma unroll
    for (int i = 0; i < 2; ++i) { int R, C; stage_rc(tid * 16 + i * 8192, R, C); const int Rb = (R & ~31) + perm32(R & 31);
        voffA[i] = (unsigned)(R * g.pa + C * 2); voffB[i] = (unsigned)(Rb * g.pb + C * 2); }
    const size_t kstep = (size_t)(BK * 2);
    const size_t hstepA = (size_t)HALF * g.pa, hstepB = (size_t)HALF * g.pb;
    const size_t tstepA = 2 * hstepA, tstepB = 2 * hstepB;
    const unsigned ldsw = (unsigned)wid * 1024u;
    const int aoff = lds_byte(wr * 64 + fr, fq * 8), boff = lds_byte(wc * 32 + fr, fq * 8);
#define PG8_SA(b, h) (((b) * 2 + (h)) * HTB)
#define PG8_SB(b, h) ((4 + (b) * 2 + (h)) * HTB)
#define PG8_STAGE(bufoff, gbase, voff) do { _Pragma("unroll") for (int _i = 0; _i < 2; ++_i) \
        __builtin_amdgcn_global_load_lds((const unsigned*)((const char*)(gbase) + (voff)[_i]), (LAS unsigned*)(lds + (bufoff) + ldsw + _i * 8192), 16, 0, 0); } while (0)
#define PG8_LDA(dst, b, h) do { _Pragma("unroll") for (int m = 0; m < 4; ++m) _Pragma("unroll") for (int k = 0; k < 2; ++k) dst[m][k] = *(const LAS bf16x8*)(lds + PG8_SA(b, h) + aoff + m * 2048 + k * 1024); } while (0)
#define PG8_LDB(dst, b, h) do { _Pragma("unroll") for (int n = 0; n < 2; ++n) _Pragma("unroll") for (int k = 0; k < 2; ++k) dst[n][k] = *(const LAS bf16x8*)(lds + PG8_SB(b, h) + boff + n * 2048 + k * 1024); } while (0)
#define PG8_MMA(ai, bj, At, Bt) do { __builtin_amdgcn_s_setprio(1); _Pragma("unroll") for (int m = 0; m < 4; ++m) _Pragma("unroll") for (int n = 0; n < 2; ++n) _Pragma("unroll") for (int k = 0; k < 2; ++k) \
        { if (I8) acc[ai][bj][m][n] = __builtin_bit_cast(f32x4, __builtin_amdgcn_mfma_i32_16x16x64_i8(__builtin_bit_cast(i32x4, Bt[n][k]), __builtin_bit_cast(i32x4, At[m][k]), __builtin_bit_cast(i32x4, acc[ai][bj][m][n]), 0, 0, 0)); \
          else acc[ai][bj][m][n] = __builtin_amdgcn_mfma_f32_16x16x32_bf16(Bt[n][k], At[m][k], acc[ai][bj][m][n], 0, 0, 0); } __builtin_amdgcn_s_setprio(0); } while (0)
#define PG8_WAIT_V(n) asm volatile("s_waitcnt vmcnt(" #n ")" ::: "memory")
#define PG8_WAIT_L(n) asm volatile("s_waitcnt lgkmcnt(" #n ")" ::: "memory")
#define PG8_BAR __builtin_amdgcn_s_barrier()
#define PG8_SCHED __builtin_amdgcn_sched_barrier(0)
    Unit cur, nxt; int ui = 0;
    if (!S.next(0, cur)) return;
    f32x4 acc[2][2][4][2];
#pragma unroll
    for (int a = 0; a < 2; ++a)
#pragma unroll
        for (int b = 0; b < 2; ++b)
#pragma unroll
            for (int m = 0; m < 4; ++m)
#pragma unroll
                for (int n = 0; n < 2; ++n) acc[a][b][m][n] = (f32x4){0.f, 0.f, 0.f, 0.f};
    bf16x8 At[4][2], B0[2][2], B1[2][2];
    const char* cA = (const char*)g.A + (size_t)cur.pm * tstepA; const char* cB = (const char*)g.Bt + (size_t)cur.pn * tstepB;
    PG8_STAGE(PG8_SB(0, 0), cB, voffB); PG8_STAGE(PG8_SA(0, 0), cA, voffA); PG8_STAGE(PG8_SB(0, 1), cB + hstepB, voffB); PG8_STAGE(PG8_SA(0, 1), cA + hstepA, voffA);
    if (wr == 1) PG8_BAR;
    PG8_WAIT_V(4); PG8_BAR;
    PG8_STAGE(PG8_SB(1, 0), cB + kstep, voffB); PG8_STAGE(PG8_SA(1, 0), cA + kstep, voffA); PG8_STAGE(PG8_SB(1, 1), cB + hstepB + kstep, voffB);
    PG8_WAIT_V(6); PG8_BAR;
    for (;;) {
        const bool has_next = S.next(ui + 1, nxt);
        const char* nA = has_next ? (const char*)g.A + (size_t)nxt.pm * tstepA : cA; const char* nB = has_next ? (const char*)g.Bt + (size_t)nxt.pn * tstepB : cB;
        for (int t = 0; t < nt; t += 2) {
            const bool last = (t == nt - 2);
            const char* a1 = cA + (size_t)(t + 1) * kstep;
            const char* a2 = last ? nA : cA + (size_t)(t + 2) * kstep; const char* b2 = last ? nB : cB + (size_t)(t + 2) * kstep;
            const char* a3 = a2 + kstep; const char* b3 = b2 + kstep;
            PG8_LDB(B0, 0, 0); PG8_SCHED; PG8_LDA(At, 0, 0); PG8_STAGE(PG8_SA(1, 1), a1 + hstepA, voffA);
            PG8_WAIT_L(8); PG8_BAR; PG8_WAIT_L(0); PG8_MMA(0, 0, At, B0); PG8_BAR; PG8_SCHED;
            PG8_LDB(B1, 0, 1); PG8_STAGE(PG8_SB(0, 0), b2, voffB);
            PG8_BAR; PG8_WAIT_L(0); PG8_MMA(0, 1, At, B1); PG8_BAR;
            PG8_LDA(At, 0, 1); PG8_STAGE(PG8_SA(0, 0), a2, voffA);
            PG8_BAR; PG8_WAIT_L(0); PG8_MMA(1, 0, At, B0); PG8_BAR; PG8_SCHED;
            PG8_STAGE(PG8_SB(0, 1), b2 + hstepB, voffB);
            PG8_WAIT_V(6); PG8_BAR; PG8_MMA(1, 1, At, B1); PG8_BAR;
            PG8_LDB(B0, 1, 0); PG8_SCHED; PG8_LDA(At, 1, 0); PG8_STAGE(PG8_SA(0, 1), a2 + hstepA, voffA);
            PG8_WAIT_L(8); PG8_BAR; PG8_WAIT_L(0); PG8_MMA(0, 0, At, B0); PG8_BAR; PG8_SCHED;
            PG8_LDB(B1, 1, 1); PG8_STAGE(PG8_SB(1, 0), b3, voffB);
            PG8_BAR; PG8_WAIT_L(0); PG8_MMA(0, 1, At, B1); PG8_BAR;
            PG8_LDA(At, 1, 1); PG8_STAGE(PG8_SA(1, 0), a3, voffA);
            PG8_BAR; PG8_WAIT_L(0); PG8_MMA(1, 0, At, B0); PG8_BAR; PG8_SCHED;
            PG8_STAGE(PG8_SB(1, 1), b3 + hstepB, voffB);
            PG8_WAIT_V(6); PG8_BAR; PG8_MMA(1, 1, At, B1); PG8_BAR;
        }
        E(acc, cur, wr, wc, fr, fq);
        if (!has_next) break;
#pragma unroll
        for (int a = 0; a < 2; ++a)
#pragma unroll
            for (int b = 0; b < 2; ++b)
#pragma unroll
                for (int m = 0; m < 4; ++m)
#pragma unroll
                    for (int n = 0; n < 2; ++n) acc[a][b][m][n] = (f32x4){0.f, 0.f, 0.f, 0.f};
        cur = nxt; cA = nA; cB = nB; ++ui;
    }
    PG8_WAIT_V(0);
    if (wr == 0) PG8_BAR;
    PG8_BAR;
#undef PG8_SA
#undef PG8_SB
#undef PG8_STAGE
#undef PG8_LDA
#undef PG8_LDB
#undef PG8_MMA
#undef PG8_WAIT_V
#undef PG8_WAIT_L
#undef PG8_BAR
#undef PG8_SCHED
}

struct EpiProj {
    bf16_t* qkv; bf16_t* sg; float qscale; unsigned* kmaxw; const float* hsc; const float* wsc;
    __device__ __forceinline__ void operator()(const f32x4 (&acci)[2][2][4][2], const Unit& u, int wr, int wc, int fr, int fq) const {
        const int row0 = u.pm * BM + wr * 64 + fr;
        f32x4 acc[2][2][4][2];
        { f32x4 cs[2][2];
#pragma unroll
          for (int bj = 0; bj < 2; ++bj)
#pragma unroll
              for (int n = 0; n < 2; ++n) cs[bj][n] = *(const f32x4*)(wsc + u.pn * BM + bj * HALF + wc * 32 + 8 * fq + 4 * n);
#pragma unroll
          for (int ai = 0; ai < 2; ++ai)
#pragma unroll
              for (int m = 0; m < 4; ++m) { const float rsc = hsc[row0 + ai * HALF + m * 16];
#pragma unroll
                  for (int bj = 0; bj < 2; ++bj)
#pragma unroll
                      for (int n = 0; n < 2; ++n) { const i32x4 iv = __builtin_bit_cast(i32x4, acci[ai][bj][m][n]);
                          acc[ai][bj][m][n] = (f32x4){(float)iv[0], (float)iv[1], (float)iv[2], (float)iv[3]} * rsc * cs[bj][n]; } } }
        if (u.pn < 24) {
            const int t = u.pn >> 2; bf16_t* base = qkv + (size_t)t * ((size_t)T_TOK * 1024) + (u.pn & 3) * 256 + wc * 32 + 8 * fq;
            const float sc = (t == 0 || t == 3) ? qscale : 1.f;
            if (t == 4) {
#pragma unroll
                for (int bj = 0; bj < 2; ++bj) { float mxv = 0.f;
#pragma unroll
                    for (int ai = 0; ai < 2; ++ai)
#pragma unroll
                        for (int m = 0; m < 4; ++m) { const f32x4 v0 = acc[ai][bj][m][0], v1 = acc[ai][bj][m][1];
                            float ssq = (v0[0] * v0[0] + v0[1] * v0[1]) + (v0[2] * v0[2] + v0[3] * v0[3]) + (v1[0] * v1[0] + v1[1] * v1[1]) + (v1[2] * v1[2] + v1[3] * v1[3]);
                            ssq += __shfl_xor(ssq, 16); ssq += __shfl_xor(ssq, 32); mxv = fmaxf(mxv, ssq); }
#pragma unroll
                    for (int o = 1; o < 16; o <<= 1) mxv = fmaxf(mxv, __shfl_xor(mxv, o));
                    if ((fr | fq) == 0) atomicMax(kmaxw + ((u.pm >> 4) * 8 + (u.pn & 3) * 2 + bj) * 4 + wc, __builtin_bit_cast(unsigned, mxv)); }
            }
#pragma unroll
            for (int ai = 0; ai < 2; ++ai)
#pragma unroll
                for (int m = 0; m < 4; ++m) { bf16_t* rowp = base + (size_t)(row0 + ai * HALF + m * 16) * 1024;
#pragma unroll
                    for (int bj = 0; bj < 2; ++bj) { const f32x4 v0 = acc[ai][bj][m][0] * sc, v1 = acc[ai][bj][m][1] * sc;
                        u32x4 w; w.x = pk2(v0[0], v0[1]); w.y = pk2(v0[2], v0[3]); w.z = pk2(v1[0], v1[1]); w.w = pk2(v1[2], v1[3]);
                        *(u32x4*)(rowp + bj * HALF) = w; } }
        } else {
            bf16_t* base = sg + (u.pn - 24) * 256 + wc * 32 + 8 * fq;
#pragma unroll
            for (int ai = 0; ai < 2; ++ai)
#pragma unroll
                for (int m = 0; m < 4; ++m) { bf16_t* rowp = base + (size_t)(row0 + ai * HALF + m * 16) * 4096;
#pragma unroll
                    for (int bj = 0; bj < 2; ++bj) { float s[8];
#pragma unroll
                        for (int e = 0; e < 4; ++e) { s[e] = frcp(1.f + fexp2(-LOG2E * acc[ai][bj][m][0][e])); s[4 + e] = frcp(1.f + fexp2(-LOG2E * acc[ai][bj][m][1][e])); }
                        u32x4 w; w.x = pk2(s[0], s[1]); w.y = pk2(s[2], s[3]); w.z = pk2(s[4], s[5]); w.w = pk2(s[6], s[7]);
                        *(u32x4*)(rowp + bj * HALF) = w; } }
        }
    }
};
template <int SECOND> struct EpiGate {
    const bf16_t* sg;
    bf16_t* tmp; bf16_t* merged;
    __device__ __forceinline__ void operator()(const f32x4 (&acc)[2][2][4][2], const Unit& u, int wr, int wc, int fr, int fq) const {
        const int row0 = u.pm * BM + wr * 64 + fr, col0 = u.pn * BM + wc * 32 + 8 * fq;
#pragma unroll
        for (int ai = 0; ai < 2; ++ai)
#pragma unroll
            for (int m = 0; m < 4; ++m) { const size_t row = (size_t)(row0 + ai * HALF + m * 16);
#pragma unroll
                for (int bj = 0; bj < 2; ++bj) { const int col = col0 + bj * HALF;
                    const u32x4 gv = *(const u32x4*)(sg + row * 4096 + col);
                    const f32x4 g0 = {bf_lo(gv.x), bf_hi(gv.x), bf_lo(gv.y), bf_hi(gv.y)}, g1 = {bf_lo(gv.z), bf_hi(gv.z), bf_lo(gv.w), bf_hi(gv.w)};
                    f32x4 v0 = acc[ai][bj][m][0] * g0, v1 = acc[ai][bj][m][1] * g1;
                    bf16_t* tp = tmp + row * DM + col;
                    if (SECOND == 0) { u32x4 w; w.x = pk2(v0[0], v0[1]); w.y = pk2(v0[2], v0[3]); w.z = pk2(v1[0], v1[1]); w.w = pk2(v1[2], v1[3]); *(u32x4*)tp = w; }
                    else { const u32x4 tv = *(const u32x4*)tp; v0 += (f32x4){bf_lo(tv.x), bf_hi(tv.x), bf_lo(tv.y), bf_hi(tv.y)}; v1 += (f32x4){bf_lo(tv.z), bf_hi(tv.z), bf_lo(tv.w), bf_hi(tv.w)};
                        u32x4 w; w.x = pk2(v0[0], v0[1]); w.y = pk2(v0[2], v0[3]); w.z = pk2(v1[0], v1[1]); w.w = pk2(v1[2], v1[3]);
                        *(u32x4*)(merged + row * DM + col) = w; } } }
    }
};
struct EpiResid {
    const float* x; float* x1; bf16_t* x1b; float* rowss;
    __device__ __forceinline__ void operator()(const f32x4 (&acc)[2][2][4][2], const Unit& u, int wr, int wc, int fr, int fq) const {
        const int row0 = u.pm * BM + wr * 64 + fr, col0 = u.pn * BM + wc * 32 + 8 * fq;
#pragma unroll
        for (int ai = 0; ai < 2; ++ai)
#pragma unroll
            for (int m = 0; m < 4; ++m) { const size_t row = (size_t)(row0 + ai * HALF + m * 16); float ss = 0.f;
#pragma unroll
                for (int bj = 0; bj < 2; ++bj) { const size_t o = row * DM + col0 + bj * HALF;
                    const f32x4 v0 = acc[ai][bj][m][0] + *(const f32x4*)(x + o), v1 = acc[ai][bj][m][1] + *(const f32x4*)(x + o + 4);
                    u32x4 w; w.x = pk2(v0[0], v0[1]); w.y = pk2(v0[2], v0[3]); w.z = pk2(v1[0], v1[1]); w.w = pk2(v1[2], v1[3]);
                    *(u32x4*)(x1b + o) = w;
                    ss += (v0[0] * v0[0] + v0[1] * v0[1]) + (v0[2] * v0[2] + v0[3] * v0[3]) + (v1[0] * v1[0] + v1[1] * v1[1]) + (v1[2] * v1[2] + v1[3] * v1[3]); }
                ss += __shfl_xor(ss, 16); ss += __shfl_xor(ss, 32);
                if (fq == 0) atomicAdd(rowss + row, ss); }
    }
};
struct EpiPlainBf16 {
    bf16_t* o;
    __device__ __forceinline__ void operator()(const f32x4 (&acc)[2][2][4][2], const Unit& u, int wr, int wc, int fr, int fq) const {
        const int row0 = u.pm * BM + wr * 64 + fr, col0 = u.pn * BM + wc * 32 + 8 * fq;
#pragma unroll
        for (int ai = 0; ai < 2; ++ai)
#pragma unroll
            for (int m = 0; m < 4; ++m) { const size_t row = (size_t)(row0 + ai * HALF + m * 16);
#pragma unroll
                for (int bj = 0; bj < 2; ++bj) { const f32x4 v0 = acc[ai][bj][m][0], v1 = acc[ai][bj][m][1];
                    u32x4 w; w.x = pk2(v0[0], v0[1]); w.y = pk2(v0[2], v0[3]); w.z = pk2(v1[0], v1[1]); w.w = pk2(v1[2], v1[3]);
                    *(u32x4*)(o + row * DM + col0 + bj * HALF) = w; } }
    }
};
}

__device__ __forceinline__ void transpose_item(const float* W, int ldw, int src_n0, bf16_t* WT, int K, int dst_n0, int k0, LAS float* scr, int lane, const float* kscale) {
    { const int c4 = (lane & 7) * 4;
      f32x4 v[8];
#pragma unroll
      for (int i = 0; i < 8; ++i) v[i] = *(const f32x4*)(W + (size_t)(k0 + 8 * i + (lane >> 3)) * ldw + src_n0 + c4);
#pragma unroll
      for (int i = 0; i < 8; ++i) { const int kk = 8 * i + (lane >> 3); const float ks = kscale ? kscale[k0 + kk] : 1.f; LAS float* sp = scr + kk * 33 + c4;
          sp[0] = v[i][0] * ks; sp[1] = v[i][1] * ks; sp[2] = v[i][2] * ks; sp[3] = v[i][3] * ks; } }
    LDS_WAIT();
    const int c = lane & 7;
#pragma unroll
    for (int j = 0; j < 4; ++j) { const int n = (lane >> 3) + 8 * j; const LAS float* s = scr + (8 * c) * 33 + n;
        u32x4 o; o.x = pk2(s[0 * 33], s[1 * 33]); o.y = pk2(s[2 * 33], s[3 * 33]); o.z = pk2(s[4 * 33], s[5 * 33]); o.w = pk2(s[6 * 33], s[7 * 33]);
        *(u32x4*)(WT + (size_t)(dst_n0 + n) * K + k0 + 8 * c) = o; }
    LDS_WAIT();
}

__device__ __forceinline__ void p0a(const Params& P, LAS unsigned char* lds, int vcu, int G) {
    const int tid = threadIdx.x, lane = tid & 63, wave = __builtin_amdgcn_readfirstlane(tid >> 6);
    const int gw = vcu * NWAVES + wave, NGW = G * NWAVES;
    unsigned char* ws = P.ws;
    {
        unsigned* CMAX = (unsigned*)(ws + WS_CTL + CTL_CMAX);
        constexpr int NCB = (10248 + 255) / 256;
        for (int it = gw; it < 128 * NCB; it += NGW) { const int kb = it / NCB, cb = it % NCB, sc = cb * 256 + 4 * lane;
            if (sc < 10248) { f32x4 v[16];
#pragma unroll
                for (int r = 0; r < 16; ++r) v[r] = *(const f32x4*)(P.w_in + (size_t)(kb * 16 + r) * 10248 + sc);
                float m0 = 0.f, m1 = 0.f, m2 = 0.f, m3 = 0.f;
#pragma unroll
                for (int r = 0; r < 16; ++r) { m0 = fmaxf(m0, fabsf(v[r][0])); m1 = fmaxf(m1, fabsf(v[r][1])); m2 = fmaxf(m2, fabsf(v[r][2])); m3 = fmaxf(m3, fabsf(v[r][3])); }
                const float mm[4] = {m0, m1, m2, m3};
#pragma unroll
                for (int e = 0; e < 4; ++e) { const int c = sc + e; const unsigned mb = __float_as_uint(mm[e]);
                    if (c < 6144) atomicMax(CMAX + c, mb); else if (c >= 6152) atomicMax(CMAX + c - 8, mb); } } }
    }
    {
        LAS float* wf = (LAS float*)lds;
        for (int k = tid; k < 2048; k += NTHR) { const f32x4 a0 = *(const f32x4*)(P.w_in + (size_t)k * 10248 + 6144), a1 = *(const f32x4*)(P.w_in + (size_t)k * 10248 + 6148);
            wf[k] = a0[0]; wf[2048 + k] = a0[1]; wf[4096 + k] = a0[2]; wf[6144 + k] = a0[3]; wf[8192 + k] = a1[0]; wf[10240 + k] = a1[1]; wf[12288 + k] = a1[2]; wf[14336 + k] = a1[3]; }
        __syncthreads();
        unsigned char* HQ8 = ws + WS_H; float* HSC = (float*)(ws + WS_HSC); float* LOGF = (float*)(ws + WS_LOGF);
        f32x4 xn[8];
        if (gw < T_TOK) { const f32x4* xr = (const f32x4*)(P.x + (size_t)gw * DM) + lane;
#pragma unroll
            for (int j = 0; j < 8; ++j) xn[j] = xr[64 * j]; }
        for (int r = gw; r < T_TOK; r += NGW) {
            float ss = 0.f, amx = 0.f; f32x4 hv[8];
#pragma unroll
            for (int j = 0; j < 8; ++j) { const f32x4 v = xn[j]; const f32x4 gn = *((const f32x4*)P.g_mix + lane + 64 * j); ss += (v[0] * v[0] + v[1] * v[1]) + (v[2] * v[2] + v[3] * v[3]);
                hv[j] = v * gn; amx = fmaxf(amx, fmaxf(fmaxf(fabsf(hv[j][0]), fabsf(hv[j][1])), fmaxf(fabsf(hv[j][2]), fabsf(hv[j][3])))); }
            if (r + NGW < T_TOK) { const f32x4* xr = (const f32x4*)(P.x + (size_t)(r + NGW) * DM) + lane;
#pragma unroll
                for (int j = 0; j < 8; ++j) xn[j] = xr[64 * j]; }
            const float rstd = 1.0f / sqrtf(wave_sum(ss) * (1.f / DM) + EPS);
#pragma unroll
            for (int o = 1; o < 64; o <<= 1) amx = fmaxf(amx, __shfl_xor(amx, o));
            const float hmax = fmaxf(amx * rstd, 1e-30f), hinv = 127.f / hmax;
            float fl[8];
#pragma unroll
            for (int c = 0; c < 8; ++c) fl[c] = 0.f;
            unsigned* hp = (unsigned*)(HQ8 + (size_t)r * DM) + lane;
#pragma unroll
            for (int j = 0; j < 8; ++j) { const f32x4 h = hv[j] * rstd;
                unsigned w = 0;
#pragma unroll
                for (int e = 0; e < 4; ++e) w |= ((unsigned)(int)__builtin_rintf(h[e] * hinv) & 255u) << (8 * e);
                hp[64 * j] = w;
#pragma unroll
                for (int c = 0; c < 8; ++c) { const f32x4 wv = *((const LAS f32x4*)(wf + c * 2048) + lane + 64 * j); fl[c] += (h[0] * wv[0] + h[1] * wv[1]) + (h[2] * wv[2] + h[3] * wv[3]); }
                __builtin_amdgcn_sched_barrier(0); }
            { const bool b5 = (lane >> 5) & 1, b4 = (lane >> 4) & 1, b3 = (lane >> 3) & 1; float p1[4], p2[2], p3;
#pragma unroll
              for (int q = 0; q < 4; ++q) { const float send = b5 ? fl[q] : fl[q + 4], keep = b5 ? fl[q + 4] : fl[q]; p1[q] = keep + __shfl_xor(send, 32); }
#pragma unroll
              for (int q = 0; q < 2; ++q) { const float send = b4 ? p1[q] : p1[q + 2], keep = b4 ? p1[q + 2] : p1[q]; p2[q] = keep + __shfl_xor(send, 16); }
              { const float send = b3 ? p2[0] : p2[1], keep = b3 ? p2[1] : p2[0]; p3 = keep + __shfl_xor(send, 8); }
              p3 += __shfl_xor(p3, 4); p3 += __shfl_xor(p3, 2); p3 += __shfl_xor(p3, 1);
              if (lane == 0) HSC[r] = hmax * (1.f / 127.f);
              if ((lane & 7) == 0) { const int c = lane >> 3; const float y = p3 + P.b_forget[c]; LOGF[((size_t)(r >> 12) * 8 + c) * SEQ + (r & (SEQ - 1))] = fminf(y, 0.f) - log1pf(expf(-fabsf(y))); } }
        }
    }
    {
        const size_t gid = (size_t)vcu * NTHR + tid, gstride = (size_t)G * NTHR;
        for (size_t i = gid; i < 262144 / 8; i += gstride) { const float* src = P.sub_keys + i * 8; const f32x4 a = *(const f32x4*)src, b = *((const f32x4*)src + 1);
            u32x4 o; o.x = pk2(a[0], a[1]); o.y = pk2(a[2], a[3]); o.z = pk2(b[0], b[1]); o.w = pk2(b[2], b[3]); *(u32x4*)((bf16_t*)(ws + WS_SKB) + i * 8) = o; }
    }
}
__device__ __forceinline__ void p0b(const Params& P, LAS unsigned char* lds, int vcu, int G) {
    const int tid = threadIdx.x, lane = tid & 63, wave = __builtin_amdgcn_readfirstlane(tid >> 6);
    const int gw = vcu * NWAVES + wave, NGW = G * NWAVES;
    unsigned char* ws = P.ws;
    const unsigned* CMAX = (const unsigned*)(ws + WS_CTL + CTL_CMAX); float* WSC = (float*)(ws + WS_WSC); unsigned char* WT8 = ws + WS_WIN;
    LAS float* scr = (LAS float*)(lds + wave * 16384);
    for (int it = gw; it < 32 * 320; it += NGW) {
        const int nb = it >> 5, kb = it & 31, dn = nb * 32, sn = dn < 6144 ? dn : dn + 8, k0 = kb * 64;
        const int c4 = (lane & 7) * 4;
        float inv[4];
#pragma unroll
        for (int e = 0; e < 4; ++e) { const float cm = fmaxf(__uint_as_float(__hip_atomic_load(CMAX + dn + c4 + e, __ATOMIC_RELAXED, __HIP_MEMORY_SCOPE_AGENT)), 1e-30f); inv[e] = 127.f / cm;
            if (kb == 0 && lane < 8) WSC[dn + c4 + e] = cm * (1.f / 127.f); }
        f32x4 v[8];
#pragma unroll
        for (int i = 0; i < 8; ++i) v[i] = *(const f32x4*)(P.w_in + (size_t)(k0 + 8 * i + (lane >> 3)) * 10248 + sn + c4);
#pragma unroll
        for (int i = 0; i < 8; ++i) { LAS float* sp = scr + (8 * i + (lane >> 3)) * 33 + c4; sp[0] = v[i][0] * inv[0]; sp[1] = v[i][1] * inv[1]; sp[2] = v[i][2] * inv[2]; sp[3] = v[i][3] * inv[3]; }
        LDS_WAIT();
        const int c = lane & 3;
#pragma unroll
        for (int j = 0; j < 2; ++j) { const int n = (lane >> 2) + 16 * j; const LAS float* sp = scr + (16 * c) * 33 + n;
            u32x4 o;
#pragma unroll
            for (int w4 = 0; w4 < 4; ++w4) { unsigned w = 0;
#pragma unroll
                for (int e = 0; e < 4; ++e) w |= ((unsigned)(int)fminf(fmaxf(__builtin_rintf(sp[(4 * w4 + e) * 33]), -127.f), 127.f) & 255u) << (8 * e);
                o[w4] = w; }
            *(u32x4*)(WT8 + (size_t)(dn + n) * 2048 + k0 + 16 * c) = o; }
        LDS_WAIT();
    }
}
__device__ __forceinline__ void late_transposes(const Params& P, LAS unsigned char* lds, int vcu, int G) {
    const int tid = threadIdx.x, lane = tid & 63, wave = __builtin_amdgcn_readfirstlane(tid >> 6);
    const int gw = vcu * NWAVES + wave, NGW = G * NWAVES;
    unsigned char* ws = P.ws;
    LAS float* scr = (LAS float*)(lds + wave * 16384);
    constexpr int I_A = 16 * 64, I_O = 32 * 64, NITEMS = 2 * I_A + 2 * I_O;
    for (int it = gw; it < NITEMS; it += NGW) {
        int r = it;
        if (r < I_A) { const int kb = r / 64, nb = r % 64; transpose_item(P.w_a, 2048, nb * 32, (bf16_t*)(ws + WS_WAT), 1024, nb * 32, kb * 64, scr, lane, nullptr); continue; } r -= I_A;
        if (r < I_A) { const int kb = r / 64, nb = r % 64; transpose_item(P.w_b, 2048, nb * 32, (bf16_t*)(ws + WS_WBT), 1024, nb * 32, kb * 64, scr, lane, nullptr); continue; } r -= I_A;
        if (r < I_O) { const int kb = r / 64, nb = r % 64; transpose_item(P.w_out, 2048, nb * 32, (bf16_t*)(ws + WS_WOUT), 2048, nb * 32, kb * 64, scr, lane, nullptr); continue; } r -= I_O;
        { const int kb = r / 64, nb = r % 64; transpose_item(P.w_query, 2048, nb * 32, (bf16_t*)(ws + WS_WQ), 2048, nb * 32, kb * 64, scr, lane, P.g_ffn); }
    }
}
__device__ __forceinline__ void quantise_expert_rows(const Params& P, int r0, int nrows) {
    const int lane = threadIdx.x & 63;
    unsigned char* ws = P.ws;
    float* SU = (float*)(ws + WS_SU); float* SV = (float*)(ws + WS_SV);
    for (int r = r0; r < r0 + nrows; r += 2) {
        f32x4 v[2][8];
#pragma unroll
        for (int t = 0; t < 2; ++t) { const int rr = r + t; const f32x4* src = (const f32x4*)((rr >= 16384 ? P.e_v : P.e_u) + (size_t)(rr & 16383) * DM) + lane;
#pragma unroll
            for (int j = 0; j < 8; ++j) v[t][j] = __builtin_nontemporal_load(src + 64 * j); }
#pragma unroll
        for (int t = 0; t < 2; ++t) { const int rr = r + t; const bool second = rr >= 16384; const int row = rr & 16383;
            float mx = 0.f;
#pragma unroll
            for (int j = 0; j < 8; ++j) mx = fmaxf(mx, fmaxf(fmaxf(fabsf(v[t][j][0]), fabsf(v[t][j][1])), fmaxf(fabsf(v[t][j][2]), fabsf(v[t][j][3]))));
#pragma unroll
            for (int o = 1; o < 64; o <<= 1) mx = fmaxf(mx, __shfl_xor(mx, o));
            mx = fmaxf(mx, 1e-30f);
            const float inv = 127.f / mx;
            unsigned char* dst = ws + (second ? WS_EV : WS_EU) + ((size_t)(lane >> 5) << 21) + (size_t)row * 128 + 4 * (lane & 31);
#pragma unroll
            for (int j = 0; j < 8; ++j) { unsigned w = 0;
#pragma unroll
                for (int e = 0; e < 4; ++e) { const int q = (int)__builtin_rintf(v[t][j][e] * inv); w |= ((unsigned)q & 255u) << (8 * e); }
                *(unsigned*)(dst + ((size_t)(2 * j) << 21)) = w; }
            if (lane == 0) (second ? SV : SU)[row] = mx * (1.f / 127.f);
        }
    }
}

namespace att {
constexpr int KST = 272, VST = 320;
constexpr int KBUF = 64 * KST, VBUF = 64 * VST;
constexpr int OFF_K = 0, OFF_V = 2 * KBUF, OFF_F = OFF_V + 2 * VBUF, OFF_SC = OFF_F + 4096 * 4;
constexpr int OFF_FLG = OFF_SC + 64, OFF_UNIT = OFF_FLG + 64;
static_assert(OFF_UNIT + 16 <= 131072, "attention LDS");
constexpr float THR_SB = 30.f, THR_FOX = 20.f;

__device__ __forceinline__ void build_cumf(LAS unsigned char* lds, const float* LOGF, int b, int h, int n, int tid, int lane, int wid) {
    LAS float* F2 = (LAS float*)(lds + OFF_F); LAS float* sc = (LAS float*)(lds + OFF_SC);
    const int s0 = tid * 8; float v[8];
    { const f32x4* lp = (const f32x4*)(LOGF + ((size_t)b * 8 + h) * SEQ + s0); f32x4 a0 = {0.f, 0.f, 0.f, 0.f}, a1 = a0; if (s0 < n) { a0 = lp[0]; a1 = lp[1]; }
      v[0] = a0[0] * LOG2E; v[1] = a0[1] * LOG2E; v[2] = a0[2] * LOG2E; v[3] = a0[3] * LOG2E; v[4] = a1[0] * LOG2E; v[5] = a1[1] * LOG2E; v[6] = a1[2] * LOG2E; v[7] = a1[3] * LOG2E; }
#pragma unroll
    for (int i = 1; i < 8; ++i) v[i] += v[i - 1];
    float tot = v[7], inc = tot;
#pragma unroll
    for (int o = 1; o < 64; o <<= 1) { const float t = __shfl_up(inc, o); if (lane >= o) inc += t; }
    if (lane == 63) sc[wid] = inc;
    __syncthreads();
    float base = inc - tot;
#pragma unroll
    for (int w = 0; w < 8; ++w) if (w < wid) base += sc[w];
    if (s0 < n) {
#pragma unroll
        for (int i = 0; i < 8; ++i) F2[s0 + i] = v[i] + base;
    }
    __syncthreads();
}

template <int MIXER>
__device__ __forceinline__ void attn_unit(LAS unsigned char* lds, const bf16_t* Q, const bf16_t* Kg, const bf16_t* Vg, bf16_t* O, int b, int h, int qb, float kmax, int tid, int lane, int wid) {
    const int c = lane & 31, hh = lane >> 5;
    const int t0 = qb * 256 + wid * 32, tq = t0 + c;
    const size_t rowbase = (size_t)b * SEQ;
    size_t qoff = (rowbase + tq) * 1024 + h * HD + 8 * hh;
    f32x16 oacc[4];
#pragma unroll
    for (int d = 0; d < 4; ++d)
#pragma unroll
        for (int r = 0; r < 16; ++r) oacc[d][r] = 0.f;
    float carry = 0.f, mrun = -1e30f, lsum = 0.f; const float nhf = hh ? 0.f : 1.f;
    const LAS float* F2 = (const LAS float*)(lds + OFF_F);
    const float Ft = (MIXER == 1) ? F2[tq] : 0.f;
    float qk_bound = 0.f;
    if (MIXER == 1) { float qs = 0.f;
#pragma unroll
        for (int s2 = 0; s2 < 8; ++s2) { const u32x4 qv = *(const u32x4*)(Q + qoff + 16 * s2);
#pragma unroll
            for (int e = 0; e < 4; ++e) { const float a = bf_lo(qv[e]), b2 = bf_hi(qv[e]); qs += a * a + b2 * b2; } }
        qs += __shfl_xor(qs, 32);
        qk_bound = sqrtf(qs) * kmax; }
    bool wave_done = false;
    volatile LAS unsigned* flg = (volatile LAS unsigned*)(lds + OFF_FLG);
    const int ktmax = 4 * qb + 3;
    const int srow = tid >> 4, scc = tid & 15;
    u32x4 kr[2], vr[2];
#define ATT_LOAD(kt) do { _Pragma("unroll") for (int j = 0; j < 2; ++j) { const size_t g_ = (rowbase + 64 * (kt) + srow + 32 * j) * 1024 + h * HD + scc * 8; \
        kr[j] = *(const u32x4*)(Kg + g_); vr[j] = *(const u32x4*)(Vg + g_); } } while (0)
#define ATT_WRITE(buf) do { _Pragma("unroll") for (int j = 0; j < 2; ++j) { \
        *(LAS u32x4*)(lds + OFF_K + (buf) * KBUF + (srow + 32 * j) * KST + scc * 16) = kr[j]; \
        *(LAS u32x4*)(lds + OFF_V + (buf) * VBUF + (srow + 32 * j) * VST + scc * 16) = vr[j]; } } while (0)
    ATT_LOAD(ktmax); ATT_WRITE(0); __syncthreads();
    int buf = 0;
    for (int kt = ktmax; kt >= 0; --kt) {
        if (kt > 0) ATT_LOAD(kt - 1);
        const bool started = (64 * kt <= t0 + 31);
        if (started && !wave_done) {
            const LAS unsigned char* Kl = lds + OFF_K + buf * KBUF; const LAS unsigned char* Vl = lds + OFF_V + buf * VBUF;
            f32x16 sacc[2];
            asm volatile("" : "+v"(qoff));
            bf16x8 qf[8];
#pragma unroll
            for (int s = 0; s < 8; ++s) qf[s] = *(const bf16x8*)(Q + qoff + 16 * s);
#pragma unroll
            for (int sub = 0; sub < 2; ++sub) {
#pragma unroll
                for (int r = 0; r < 16; ++r) sacc[sub][r] = 0.f;
#pragma unroll
                for (int s = 0; s < 8; ++s) { const bf16x8 kf = *(const LAS bf16x8*)(Kl + (32 * sub + c) * KST + (16 * s + 8 * hh) * 2);
                    sacc[sub] = __builtin_amdgcn_mfma_f32_32x32x16_bf16(kf, qf[s], sacc[sub], 0, 0, 0); }
            }
            const bool need_mask = (64 * kt + 63 >= t0);
            bool tile_dead = false;
            if (MIXER == 0) {
#pragma unroll
                for (int sub = 1; sub >= 0; --sub) {
                    float lb[16];
#pragma unroll
                    for (int r = 0; r < 16; ++r) { const float z = sacc[sub][r]; float l = -flog2(1.f + fexp2(z));
                        if (need_mask) { const int sidx = 64 * kt + 32 * sub + (r & 3) + 8 * (r >> 2) + 4 * hh; l = (sidx < tq) ? l : 0.f; }
                        lb[r] = l; }
                    float Glo[4], Ghi[4];
#pragma unroll
                    for (int g = 0; g < 4; ++g) { lb[4 * g + 2] += lb[4 * g + 3]; lb[4 * g + 1] += lb[4 * g + 2]; lb[4 * g] += lb[4 * g + 1];
                        const unsigned gu = __builtin_bit_cast(unsigned, lb[4 * g]); const auto rr = __builtin_amdgcn_permlane32_swap(gu, gu, false, false);
                        Glo[g] = __builtin_bit_cast(float, (unsigned)rr[0]); Ghi[g] = __builtin_bit_cast(float, (unsigned)rr[1]); }
                    float E[8];
                    E[7] = carry; E[6] = E[7] + Ghi[3]; E[5] = E[6] + Glo[3]; E[4] = E[5] + Ghi[2]; E[3] = E[4] + Glo[2]; E[2] = E[3] + Ghi[1]; E[1] = E[2] + Glo[1]; E[0] = E[1] + Ghi[0];
                    carry = E[0] + Glo[0];
#pragma unroll
                    for (int g = 0; g < 4; ++g) { const float Eo = __builtin_fmaf(nhf, Ghi[g], E[2 * g + 1]);
#pragma unroll
                        for (int i = 0; i < 4; ++i) { const int r = 4 * g + i; float w = fexp2(sacc[sub][r] + lb[r] + Eo);
                            if (need_mask) { const int sidx = 64 * kt + 32 * sub + (r & 3) + 8 * (r >> 2) + 4 * hh; w = (sidx < tq) ? w : 0.f; }
                            sacc[sub][r] = w; } }
                }
            } else {
                float mx = -1e30f;
#pragma unroll
                for (int sub = 0; sub < 2; ++sub)
#pragma unroll
                    for (int g = 0; g < 4; ++g) { const f32x4 fs = *(const LAS f32x4*)(F2 + 64 * kt + 32 * sub + 8 * g + 4 * hh);
#pragma unroll
                        for (int i = 0; i < 4; ++i) { const int r = 4 * g + i; float xv = sacc[sub][r] + (Ft - fs[i]);
                            if (need_mask) { const int sidx = 64 * kt + 32 * sub + 8 * g + 4 * hh + i; xv = (sidx <= tq) ? xv : -1e30f; }
                            sacc[sub][r] = xv; mx = fmaxf(mx, xv); } }
                { const unsigned mu = __builtin_bit_cast(unsigned, mx); const auto rr = __builtin_amdgcn_permlane32_swap(mu, mu, false, false);
                  mx = fmaxf(__builtin_bit_cast(float, (unsigned)rr[0]), __builtin_bit_cast(float, (unsigned)rr[1])); }
                tile_dead = __all(mx - mrun < -THR_FOX);
                if (!tile_dead) {
                const float mnew = fmaxf(mrun, mx);
                const float alpha = fexp2(mrun - mnew);
                float ps = 0.f;
#pragma unroll
                for (int sub = 0; sub < 2; ++sub)
#pragma unroll
                    for (int r = 0; r < 16; ++r) { const float p = fexp2(sacc[sub][r] - mnew); sacc[sub][r] = p; ps += p; }
                lsum = lsum * alpha + ps;
                if (__any(mnew > mrun)) {
#pragma unroll
                    for (int d = 0; d < 4; ++d)
#pragma unroll
                        for (int r = 0; r < 16; ++r) oacc[d][r] *= alpha;
                }
                mrun = mnew;
                }
            }
            if (!tile_dead)
#pragma unroll
            for (int ks = 0; ks < 4; ++ks) { const int sub = ks >> 1, rb = 8 * (ks & 1);
                u32x4 pw; pw.x = pk2(sacc[sub][rb + 0], sacc[sub][rb + 1]); pw.y = pk2(sacc[sub][rb + 2], sacc[sub][rb + 3]); pw.z = pk2(sacc[sub][rb + 4], sacc[sub][rb + 5]); pw.w = pk2(sacc[sub][rb + 6], sacc[sub][rb + 7]);
                const bf16x8 pf = __builtin_bit_cast(bf16x8, pw);
                const LAS unsigned char* vb = Vl + (16 * ks + 4 * hh + ((lane & 15) >> 2)) * VST + (16 * ((lane >> 4) & 1) + 4 * (lane & 3)) * 2;
#pragma unroll
                for (int d = 0; d < 4; ++d) {
                    const s16x4 a0 = __builtin_amdgcn_ds_read_tr16_b64_v4i16((LAS s16x4*)(vb + d * 64));
                    const s16x4 a1 = __builtin_amdgcn_ds_read_tr16_b64_v4i16((LAS s16x4*)(vb + d * 64 + 8 * VST));
                    const bf16x8 af = {a0[0], a0[1], a0[2], a0[3], a1[0], a1[1], a1[2], a1[3]};
                    oacc[d] = __builtin_amdgcn_mfma_f32_32x32x16_bf16(af, pf, oacc[d], 0, 0, 0); }
            }
        }
        if (kt > 0) ATT_WRITE(buf ^ 1);
        if (kt > 0 && started && !wave_done) {
            if (MIXER == 0) wave_done = __all(carry < -THR_SB);
            else wave_done = __all(qk_bound + (Ft - F2[64 * kt - 1]) - mrun < -THR_FOX);
        }
        if (lane == 0) flg[(kt & 1) * 8 + wid] = wave_done ? 1u : 0u;
        __syncthreads();
        buf ^= 1;
        { unsigned alld = 1u;
#pragma unroll
          for (int w = 0; w < 8; ++w) alld &= flg[(kt & 1) * 8 + w];
          if (alld) break; }
    }
#undef ATT_LOAD
#undef ATT_WRITE
    float inv = 1.f;
    if (MIXER == 1) { const unsigned lu = __builtin_bit_cast(unsigned, lsum); const auto rr = __builtin_amdgcn_permlane32_swap(lu, lu, false, false);
        inv = 1.f / (__builtin_bit_cast(float, (unsigned)rr[0]) + __builtin_bit_cast(float, (unsigned)rr[1])); }
    bf16_t* op = O + (rowbase + tq) * 2048 + 4 * hh;
#pragma unroll
    for (int d = 0; d < 4; ++d)
#pragma unroll
        for (int g = 0; g < 4; ++g) { u32x2 w; w.x = pk2(oacc[d][4 * g] * inv, oacc[d][4 * g + 1] * inv); w.y = pk2(oacc[d][4 * g + 2] * inv, oacc[d][4 * g + 3] * inv);
            *(u32x2*)(op + 32 * d + 8 * g) = w; }
}

__device__ __forceinline__ void attn_phase(const Params& P, LAS unsigned char* lds, int vcu, int G) {
    const int tid = threadIdx.x, lane = tid & 63, wid = __builtin_amdgcn_readfirstlane(tid >> 6);
    unsigned char* ws = P.ws;
    const bf16_t* QKV = (const bf16_t*)(ws + WS_QKV); const size_t TS = (size_t)T_TOK * 1024;
    bf16_t* OAB = (bf16_t*)(ws + WS_H); const float* LOGF = (const float*)(ws + WS_LOGF);
    unsigned* qctr = (unsigned*)(ws + WS_CTL + 196608);
    const unsigned* KMAXW = (const unsigned*)(ws + WS_CTL + 200704);
    volatile LAS unsigned* uw = (volatile LAS unsigned*)(lds + OFF_UNIT);
#ifndef NQ_MASK
#define NQ_MASK 3
#endif
    unsigned* qctrq = qctr + 32;
    const bool qfirst = (vcu & NQ_MASK) == 0;
    bool a_left = true, q_left = true;
    for (;;) {
        const bool takeq = q_left && (qfirst || !a_left);
        if (!takeq && !a_left) break;
        if (tid == 0) uw[0] = atomicAdd(takeq ? qctrq : qctr, 1u);
        __syncthreads();
        const unsigned u = uw[0];
        __syncthreads();
        if (takeq) { if (u >= 2048u) { q_left = false; continue; } quantise_expert_rows(P, (int)u * 16 + wid * 2, 2); continue; }
        if (u >= 512u) { a_left = false; continue; }
        const int mixer = (u < 256u) ? 1 : 0, v = (int)(u & 255u), qb = 15 - (v >> 4), bh = v & 15, b = bh >> 3, h = bh & 7;
        if (mixer == 0) {
            attn_unit<0>(lds, QKV, QKV + TS, QKV + 2 * TS, OAB + h * HD, b, h, qb, 0.f, tid, lane, wid);
        } else {
            float k2 = 0.f;
#pragma unroll
            for (int w = 0; w < 4; ++w) k2 += __builtin_bit_cast(float, __hip_atomic_load(KMAXW + bh * 4 + w, __ATOMIC_RELAXED, __HIP_MEMORY_SCOPE_AGENT));
            const float kmax = sqrtf(k2) * 1.01f;
            build_cumf(lds, LOGF, b, h, 256 * (qb + 1), tid, lane, wid);
            attn_unit<1>(lds, QKV + 3 * TS, QKV + 4 * TS, QKV + 5 * TS, OAB + 1024 + h * HD, b, h, qb, kmax, tid, lane, wid);
        }
        __syncthreads();
    }
}
}

namespace peer {
__device__ __forceinline__ unsigned sortable(float f) { const unsigned u = __builtin_bit_cast(unsigned, f); return (u & 0x80000000u) ? ~u : (u | 0x80000000u); }
__device__ __forceinline__ float unsortable(unsigned k) { const unsigned u = (k & 0x80000000u) ? (k & 0x7fffffffu) : ~k; return __builtin_bit_cast(float, u); }
#define CE_DESC(x, y) do { const unsigned hi_ = (x) > (y) ? (x) : (y); const unsigned lo_ = (x) > (y) ? (y) : (x); (x) = hi_; (y) = lo_; } while (0)
template <int B, int N> __device__ __forceinline__ void sort16_desc(unsigned (&a)[N]) {
#pragma unroll
    for (int k = 2; k <= 16; k <<= 1)
#pragma unroll
        for (int j = k >> 1; j > 0; j >>= 1)
#pragma unroll
            for (int i = 0; i < 16; ++i) { const int l = i ^ j; if (l > i) { if ((i & k) == 0) CE_DESC(a[B + i], a[B + l]); else CE_DESC(a[B + l], a[B + i]); } }
}
template <int A, int Bq, int N> __device__ __forceinline__ void merge_top16(unsigned (&a)[N]) {
#pragma unroll
    for (int i = 0; i < 16; ++i) { const unsigned x = a[A + i], y = a[Bq + 15 - i]; a[A + i] = x > y ? x : y; }
#pragma unroll
    for (int j = 8; j > 0; j >>= 1)
#pragma unroll
        for (int i = 0; i < 16; ++i) { const int l = i ^ j; if (l > i) CE_DESC(a[A + i], a[A + l]); }
}

__device__ __forceinline__ void topk_phase(const Params& P, LAS unsigned char* lds, int vcu, int G) {
    const int tid = threadIdx.x, lane = tid & 63, wave = __builtin_amdgcn_readfirstlane(tid >> 6);
    const int c = lane & 31, hh = lane >> 5;
    const int gw = vcu * NWAVES + wave, NGW = G * NWAVES;
    unsigned char* ws = P.ws;
    const bf16_t* Q2 = (const bf16_t*)(ws + WS_Q2); const bf16_t* SKB = (const bf16_t*)(ws + WS_SKB);
    const float* ROWSS = (const float*)(ws + WS_CTL); int* IDS = (int*)(ws + WS_IDS); float* GATES = (float*)(ws + WS_GATES);
    LAS unsigned char* scr = lds + wave * 4096;
    const bool shared_head = (G == 256);
    LAS unsigned char* skl = lds + 32768;
    if (shared_head) { const bf16_t* src = SKB + (size_t)(vcu & 7) * 2 * 128 * 128;
#pragma unroll
        for (int q = 0; q < 8; ++q) { const int ch = tid + 512 * q, row = ch >> 4, cc = ch & 15; *(LAS u32x4*)(skl + row * 272 + cc * 16) = *(const u32x4*)(src + row * 128 + cc * 8); }
        __syncthreads(); }
    for (int task = (shared_head ? (((vcu >> 3) * 8 + wave) * 8 + (vcu & 7)) : gw); task < 2048; task += (shared_head ? 1 << 30 : NGW)) {
        const int tg = task >> 3, hd = task & 7, tok = tg * 32 + c;
#pragma unroll 1
        for (int p = 0; p < 2; ++p) {
            bf16x8 qf[8];
            { const bf16_t* qp = Q2 + (size_t)tok * DM + hd * 256 + p * 128 + 8 * hh;
#pragma unroll
              for (int s = 0; s < 8; ++s) qf[s] = *(const bf16x8*)(qp + 16 * s); }
            unsigned keys[64];
#pragma unroll
            for (int sub = 0; sub < 4; ++sub) {
                f32x16 acc;
#pragma unroll
                for (int r = 0; r < 16; ++r) acc[r] = 0.f;
                const bf16_t* kp = SKB + ((size_t)(hd * 2 + p) * 128 + 32 * sub + c) * 128 + 8 * hh;
#pragma unroll
                for (int s = 0; s < 8; ++s) { const bf16x8 kf = shared_head ? *(const LAS bf16x8*)(skl + (p * 128 + 32 * sub + c) * 272 + (16 * s + 8 * hh) * 2) : *(const bf16x8*)(kp + 16 * s); acc = __builtin_amdgcn_mfma_f32_32x32x16_bf16(kf, qf[s], acc, 0, 0, 0); }
#pragma unroll
                for (int r = 0; r < 16; ++r) { const int nlo = 127 - (32 * sub + (r & 3) + 8 * (r >> 2)); keys[sub * 16 + r] = (sortable(acc[r]) & ~127u) | (unsigned)(nlo - 4 * hh); }
            }
            sort16_desc<0>(keys); sort16_desc<16>(keys); sort16_desc<32>(keys); sort16_desc<48>(keys);
            merge_top16<0, 16>(keys); merge_top16<32, 48>(keys); merge_top16<0, 32>(keys);
#pragma unroll
            for (int i = 0; i < 16; ++i) { const unsigned own = keys[i]; const auto rr = __builtin_amdgcn_permlane32_swap(own, own, false, false); keys[16 + i] = hh ? (unsigned)rr[0] : (unsigned)rr[1]; }
            merge_top16<0, 16>(keys);
            if (hh == 0) {
#pragma unroll
                for (int w = 0; w < 4; ++w) *(LAS u32x4*)(scr + (c * 2 + p) * 64 + w * 16) = (u32x4){keys[4 * w], keys[4 * w + 1], keys[4 * w + 2], keys[4 * w + 3]};
            }
        }
        LDS_WAIT();
        float s1[16], s2[16];
#pragma unroll
        for (int w = 0; w < 4; ++w) { const u32x4 a = *(const LAS u32x4*)(scr + (c * 2) * 64 + w * 16), b2 = *(const LAS u32x4*)(scr + (c * 2 + 1) * 64 + w * 16);
#pragma unroll
            for (int e = 0; e < 4; ++e) { s1[4 * w + e] = unsortable((a[e] & ~127u) | 64u); s2[4 * w + e] = unsortable((b2[e] & ~127u) | 64u); } }
        unsigned ck[64];
        { int n = 0;
#pragma unroll
          for (int i = 0; i < 16; ++i)
#pragma unroll
              for (int j = 0; j < 16; ++j) if ((i + 1) * (j + 1) <= 16) { ck[n] = (sortable(s1[i] + s2[j]) & ~255u) | (unsigned)(255 - (i * 16 + j)); ++n; }
#pragma unroll
          for (int q = 50; q < 64; ++q) ck[q] = 0u; }
        sort16_desc<0>(ck); sort16_desc<16>(ck); sort16_desc<32>(ck); sort16_desc<48>(ck);
        merge_top16<0, 16>(ck); merge_top16<32, 48>(ck); merge_top16<0, 32>(ck);
        unsigned t2[16];
#pragma unroll
        for (int k = 0; k < 16; ++k) t2[k] = ck[k];
        int ids[16]; float sc[16];
#pragma unroll
        for (int k = 0; k < 16; ++k) { const unsigned pos = 255u - (t2[k] & 255u);
            const unsigned k1 = *(const LAS unsigned*)(scr + (c * 2) * 64 + (pos >> 4) * 4), k2 = *(const LAS unsigned*)(scr + (c * 2 + 1) * 64 + (pos & 15u) * 4);
            ids[k] = (int)((127u - (k1 & 127u)) * 128u + (127u - (k2 & 127u))); sc[k] = unsortable((t2[k] & ~255u) | 128u); }
        LDS_WAIT();
        const float rs = 1.0f / sqrtf(ROWSS[tok] * (1.f / DM) + EPS);
        float ev[16], Z = 0.f;
#pragma unroll
        for (int k = 0; k < 16; ++k) { ev[k] = fexp2((sc[k] - sc[0]) * rs * LOG2E); Z += ev[k]; }
        const float iz = 1.f / Z;
        int* ip = IDS + (size_t)tok * 128 + hd * 16; float* gp = GATES + (size_t)tok * 128 + hd * 16;
        if (hh == 0) {
#pragma unroll
            for (int k = 0; k < 8; ++k) { ip[k] = ids[k]; gp[k] = ev[k] * iz; }
        } else {
#pragma unroll
            for (int k = 8; k < 16; ++k) { ip[k] = ids[k]; gp[k] = ev[k] * iz; }
        }
    }
}


__device__ __forceinline__ float dot8(u32x4 a, u32x4 b, float acc) {
    const unsigned a0 = a[0], a1 = a[1], a2 = a[2], a3 = a[3], b0 = b[0], b1 = b[1], b2 = b[2], b3 = b[3];
    acc = __builtin_amdgcn_fdot2_f32_bf16(__builtin_bit_cast(bf16v2, a0), __builtin_bit_cast(bf16v2, b0), acc, false);
    acc = __builtin_amdgcn_fdot2_f32_bf16(__builtin_bit_cast(bf16v2, a1), __builtin_bit_cast(bf16v2, b1), acc, false);
    acc = __builtin_amdgcn_fdot2_f32_bf16(__builtin_bit_cast(bf16v2, a2), __builtin_bit_cast(bf16v2, b2), acc, false);
    acc = __builtin_amdgcn_fdot2_f32_bf16(__builtin_bit_cast(bf16v2, a3), __builtin_bit_cast(bf16v2, b3), acc, false);
    return acc;
}
__device__ __forceinline__ float gelu_tanh(float a) { const float t = 1.5957691216f * (a + 0.044715f * a * a * a); return a * frcp(1.f + fexp2(-LOG2E * t)); }

__device__ __forceinline__ int dot16(u32x4 a, u32x4 b, int acc) {
    acc = __builtin_amdgcn_sdot4((int)a[0], (int)b[0], acc, false); acc = __builtin_amdgcn_sdot4((int)a[1], (int)b[1], acc, false);
    acc = __builtin_amdgcn_sdot4((int)a[2], (int)b[2], acc, false); acc = __builtin_amdgcn_sdot4((int)a[3], (int)b[3], acc, false);
    return acc;
}
__device__ __forceinline__ void gather_sweep(const Params& P, LAS unsigned char* lds, int vcu, int G) {
    const int tid = threadIdx.x, lane = tid & 63, wave = __builtin_amdgcn_readfirstlane(tid >> 6);
    const int gw = vcu * NWAVES + wave, NGW = G * NWAVES;
    const int g = lane >> 3, i = lane & 7;
    unsigned char* ws = P.ws;
    const bf16_t* X1B = (const bf16_t*)(ws + WS_X1B); const float* ROWSS = (const float*)(ws + WS_CTL);
    const int* IDS = (const int*)(ws + WS_IDS); const float* GATES = (const float*)(ws + WS_GATES);
    const unsigned char* EU = ws + WS_EU; const unsigned char* EV = ws + WS_EV;
    const float* SU = (const float*)(ws + WS_SU); const float* SV = (const float*)(ws + WS_SV);
    LAS unsigned char* wl = lds + wave * 19456;
    const bool b2 = (lane >> 2) & 1, b1 = (lane >> 1) & 1, b0 = lane & 1, B2 = (lane >> 5) & 1, B1 = (lane >> 4) & 1, B0 = (lane >> 3) & 1;
    for (int tg = gw; tg < T_TOK / 4; tg += NGW) {
        const int tok0 = tg * 4;
        float hs[4];
#pragma unroll
        for (int j = 0; j < 4; ++j) { const int tok = tok0 + j;
            const float rs = 1.0f / sqrtf(ROWSS[tok] * (1.f / DM) + EPS);
            f32x4 hv[8]; float hmx = 0.f;
#pragma unroll
            for (int q = 0; q < 8; ++q) { const u32x2 xb = *((const u32x2*)(X1B + (size_t)tok * DM) + lane + 64 * q); const f32x4 xv = {bf_lo(xb[0]), bf_hi(xb[0]), bf_lo(xb[1]), bf_hi(xb[1])}; const f32x4 gn = *((const f32x4*)P.g_ffn + lane + 64 * q);
                hv[q] = xv * rs * gn; hmx = fmaxf(hmx, fmaxf(fmaxf(fabsf(hv[q][0]), fabsf(hv[q][1])), fmaxf(fabsf(hv[q][2]), fabsf(hv[q][3])))); }
#pragma unroll
            for (int o = 1; o < 64; o <<= 1) hmx = fmaxf(hmx, __shfl_xor(hmx, o));
            hmx = fmaxf(hmx, 1e-30f); const float hinv = 127.f / hmx; hs[j] = hmx * (1.f / 127.f);
#pragma unroll
            for (int q = 0; q < 8; ++q) { unsigned w = 0;
#pragma unroll
                for (int e = 0; e < 4; ++e) w |= ((unsigned)(int)__builtin_rintf(hv[q][e] * hinv) & 255u) << (8 * e);
                *(LAS unsigned*)(wl + 2560 + j * 2048 + 4 * (lane + 64 * q)) = w; }
#pragma unroll
            for (int hf = 0; hf < 2; ++hf) { const int k = lane + 64 * hf; const int id = IDS[(size_t)tok * 128 + k];
                *(LAS unsigned*)(wl + (j * 128 + k) * 4) = (unsigned)id * 128u;
                *(LAS float*)(wl + 10752 + (j * 128 + k) * 4) = GATES[(size_t)tok * 128 + k] * SV[id];
                *(LAS float*)(wl + 12800 + (j * 128 + k) * 4) = SU[id]; }
        }
        LDS_WAIT();
        int accu[4][16];
#pragma unroll
        for (int j = 0; j < 4; ++j)
#pragma unroll
            for (int m = 0; m < 16; ++m) accu[j][m] = 0;
        const unsigned i16 = 16u * (unsigned)i;
#define US_LOAD(D, sl_, j_) do { unsigned long long ub64_ = (unsigned long long)(EU + ((size_t)(sl_) << 21)); asm volatile("" : "+s"(ub64_)); const GAS unsigned char* ub_ = (const GAS unsigned char*)ub64_; \
            _Pragma("unroll") for (int m = 0; m < 16; ++m) { const unsigned off = *(const LAS unsigned*)(wl + ((j_) * 128 + 8 * m + g) * 4) + i16; D[m] = *(const GAS u32x4*)(ub_ + off); } \
            __builtin_amdgcn_sched_barrier(0); } while (0)
#define US_COMP(D, sl_, j_) do { \
            asm volatile("" : "+v"(D[0]), "+v"(D[1]), "+v"(D[2]), "+v"(D[3]), "+v"(D[4]), "+v"(D[5]), "+v"(D[6]), "+v"(D[7]), "+v"(D[8]), "+v"(D[9]), "+v"(D[10]), "+v"(D[11]), "+v"(D[12]), "+v"(D[13]), "+v"(D[14]), "+v"(D[15]) :: "memory"); \
            const u32x4 hqc = *(const LAS u32x4*)(wl + 2560 + (j_) * 2048 + 128 * (sl_) + 16 * i); \
            _Pragma("unroll") for (int m = 0; m < 16; ++m) accu[j_][m] = dot16(D[m], hqc, accu[j_][m]); \
            __builtin_amdgcn_sched_barrier(0); } while (0)
        {
            u32x4 dA[16], dB[16];
            US_LOAD(dA, 0, 0);
#pragma unroll 1
            for (int sl = 0; sl < 16; ++sl) {
                const int sln = sl < 15 ? sl + 1 : 15;
                US_LOAD(dB, sl, 1); US_COMP(dA, sl, 0);
                US_LOAD(dA, sl, 2); US_COMP(dB, sl, 1);
                US_LOAD(dB, sl, 3); US_COMP(dA, sl, 2);
                __syncthreads();
                US_LOAD(dA, sln, 0); US_COMP(dB, sl, 3);
            }
        }
#undef US_LOAD
#undef US_COMP
        float sw[4];
#pragma unroll
        for (int j = 0; j < 4; ++j) {
            int r1[8], r2[4], r3[2];
#pragma unroll
            for (int m = 0; m < 8; ++m) { const int send = b2 ? accu[j][m] : accu[j][m + 8], keep = b2 ? accu[j][m + 8] : accu[j][m]; r1[m] = keep + __shfl_xor(send, 4); }
#pragma unroll
            for (int m = 0; m < 4; ++m) { const int send = b1 ? r1[m] : r1[m + 4], keep = b1 ? r1[m + 4] : r1[m]; r2[m] = keep + __shfl_xor(send, 2); }
#pragma unroll
            for (int m = 0; m < 2; ++m) { const int send = b0 ? r2[m] : r2[m + 2], keep = b0 ? r2[m + 2] : r2[m]; r3[m] = keep + __shfl_xor(send, 1); }
            float w2[2], wmx = 0.f;
#pragma unroll
            for (int m = 0; m < 2; ++m) { const int k = 16 * i + 8 * m + g;
                const float act = (float)r3[m] * (hs[j] * *(const LAS float*)(wl + 12800 + (j * 128 + k) * 4));
                w2[m] = *(const LAS float*)(wl + 10752 + (j * 128 + k) * 4) * gelu_tanh(act); wmx = fmaxf(wmx, fabsf(w2[m])); }
#pragma unroll
            for (int o = 1; o < 64; o <<= 1) wmx = fmaxf(wmx, __shfl_xor(wmx, o));
            wmx = fmaxf(wmx, 1e-30f); sw[j] = wmx * (1.f / 127.f);
            const float winv = 127.f / wmx;
            const unsigned q0 = (unsigned)(int)__builtin_rintf(w2[0] * winv) & 255u, q1 = (unsigned)(int)__builtin_rintf(w2[1] * winv) & 255u;
            *(LAS unsigned short*)(wl + 2048 + j * 128 + 16 * g + 2 * i) = (unsigned short)(q0 | (q1 << 8));
        }
        LDS_WAIT();
        float ssq[4] = {0.f, 0.f, 0.f, 0.f};
#define VS_LOAD(D, XB, sl_, j_) do { unsigned long long vb64_ = (unsigned long long)(EV + ((size_t)(sl_) << 21)), xb64_ = (unsigned long long)(X1B + (size_t)(tok0 + (j_)) * DM + 128 * (sl_)); \
            asm volatile("" : "+s"(vb64_), "+s"(xb64_));     \
            const GAS unsigned char* vb_ = (const GAS unsigned char*)vb64_; const GAS unsigned char* xb_ = (const GAS unsigned char*)xb64_; \
            XB = *(const GAS unsigned*)(xb_ + xlo); \
            _Pragma("unroll") for (int m = 0; m < 16; ++m) { const unsigned off = *(const LAS unsigned*)(wl + ((j_) * 128 + 8 * m + g) * 4) + i16; D[m] = *(const GAS u32x4*)(vb_ + off); } \
            __builtin_amdgcn_sched_barrier(0); } while (0)
#define VS_COMP(D, XB, sl_, j_) do { \
            asm volatile("" : "+v"(D[0]), "+v"(D[1]), "+v"(D[2]), "+v"(D[3]), "+v"(D[4]), "+v"(D[5]), "+v"(D[6]), "+v"(D[7]), "+v"(D[8]), "+v"(D[9]), "+v"(D[10]), "+v"(D[11]), "+v"(D[12]), "+v"(D[13]), "+v"(D[14]), "+v"(D[15]), "+v"(XB) :: "memory"); \
            const u32x4 wpk = *(const LAS u32x4*)(wl + 2048 + (j_) * 128 + 16 * g); \
            int ca[16]; \
            _Pragma("unroll") for (int b = 0; b < 16; ++b) ca[b] = 0; \
            _Pragma("unroll") for (int mg = 0; mg < 4; ++mg) \
            _Pragma("unroll") for (int c4 = 0; c4 < 4; ++c4) { const unsigned r0 = D[4 * mg][c4], r1 = D[4 * mg + 1][c4], r2 = D[4 * mg + 2][c4], r3 = D[4 * mg + 3][c4]; \
                const unsigned t0 = __builtin_amdgcn_perm(r1, r0, 0x05010400u), t1 = __builtin_amdgcn_perm(r1, r0, 0x07030602u); \
                const unsigned t2 = __builtin_amdgcn_perm(r3, r2, 0x05010400u), t3 = __builtin_amdgcn_perm(r3, r2, 0x07030602u); \
                const int wq4 = (int)wpk[mg]; \
                ca[4 * c4 + 0] = __builtin_amdgcn_sdot4((int)__builtin_amdgcn_perm(t2, t0, 0x05040100u), wq4, ca[4 * c4 + 0], false); \
                ca[4 * c4 + 1] = __builtin_amdgcn_sdot4((int)__builtin_amdgcn_perm(t2, t0, 0x07060302u), wq4, ca[4 * c4 + 1], false); \
                ca[4 * c4 + 2] = __builtin_amdgcn_sdot4((int)__builtin_amdgcn_perm(t3, t1, 0x05040100u), wq4, ca[4 * c4 + 2], false); \
                ca[4 * c4 + 3] = __builtin_amdgcn_sdot4((int)__builtin_amdgcn_perm(t3, t1, 0x07060302u), wq4, ca[4 * c4 + 3], false); } \
            int c1[8], c2[4], c3[2]; \
            _Pragma("unroll") for (int b = 0; b < 8; ++b) { const auto rr = __builtin_amdgcn_permlane32_swap((unsigned)ca[b], (unsigned)ca[b + 8], false, false); c1[b] = (int)(rr[0] + rr[1]); } \
            _Pragma("unroll") for (int b = 0; b < 4; ++b) { const auto rr = __builtin_amdgcn_permlane16_swap((unsigned)c1[b], (unsigned)c1[b + 4], false, false); c2[b] = (int)(rr[0] + rr[1]); } \
            _Pragma("unroll") for (int b = 0; b < 2; ++b) { const int send = B0 ? c2[b] : c2[b + 2], keep = B0 ? c2[b + 2] : c2[b]; c3[b] = keep + __builtin_amdgcn_update_dpp(0, send, 0x128, 0xf, 0xf, true); } \
            const f32x2 xv = {bf_lo(XB), bf_hi(XB)}; \
            const f32x2 x2 = {xv[0] + sw[j_] * (float)c3[0], xv[1] + sw[j_] * (float)c3[1]}; \
            ssq[j_] += x2[0] * x2[0] + x2[1] * x2[1]; \
            *(LAS unsigned*)(wl + 2560 + (((sl_) * 4 + (j_)) * 64 + lane) * 4) = pk2(x2[0], x2[1]); \
            __builtin_amdgcn_sched_barrier(0); } while (0)
        u32x4 dA[16], dB[16]; unsigned xA, xB; const unsigned xlo = (unsigned)(16 * i + 2 * g) * 2u;
        VS_LOAD(dA, xA, 0, 0);
#pragma unroll 1
        for (int sl = 0; sl < 16; ++sl) {
            const int sln = sl < 15 ? sl + 1 : 15;
            VS_LOAD(dB, xB, sl, 1); VS_COMP(dA, xA, sl, 0);
            VS_LOAD(dA, xA, sl, 2); VS_COMP(dB, xB, sl, 1);
            VS_LOAD(dB, xB, sl, 3); VS_COMP(dA, xA, sl, 2);
            VS_LOAD(dA, xA, sln, 0); VS_COMP(dB, xB, sl, 3);
        }
#undef VS_LOAD
#undef VS_COMP
        float rs2[4];
#pragma unroll
        for (int j = 0; j < 4; ++j) rs2[j] = 1.0f / sqrtf(wave_sum(ssq[j]) * (1.f / DM) + EPS);
        LDS_WAIT();
#pragma unroll 4
        for (int sl = 0; sl < 16; ++sl) { const f32x2 gn = *(const f32x2*)(P.g_final + 128 * sl + 16 * i + 2 * g);
#pragma unroll
            for (int j = 0; j < 4; ++j) { const unsigned xw = *(const LAS unsigned*)(wl + 2560 + ((sl * 4 + j) * 64 + lane) * 4);
                const f32x2 ov = {bf_lo(xw) * rs2[j] * gn[0], bf_hi(xw) * rs2[j] * gn[1]};
                *(f32x2*)(P.out + (size_t)(tok0 + j) * DM + 128 * sl + 16 * i + 2 * g) = ov; } }
        LDS_WAIT();
    }
}

}


#define XB_TMO      128
#define XB_XCNT(j)  (256  + 64 * (j))
#define XB_XSUB(j)  (1280 + 64 * (j))
#define XB_XGEN(j)  (2304 + 64 * (j))
#define XB_TOP      3328
#define XB_TOPGEN   3392
#define XCD_BAR_WORDS 3456
#define XB_SPIN_CAP (1u << 18)
__device__ __forceinline__ unsigned xb_ld(unsigned* p)              { return __hip_atomic_load(p, __ATOMIC_RELAXED, __HIP_MEMORY_SCOPE_AGENT); }
__device__ __forceinline__ unsigned xb_add(unsigned* p, unsigned v) { return __hip_atomic_fetch_add(p, v, __ATOMIC_RELAXED, __HIP_MEMORY_SCOPE_AGENT); }
__device__ __forceinline__ unsigned xb_xcc_id() { return (unsigned)__builtin_amdgcn_s_getreg((3 << 11) | 20) & 0xFu; }
#define XB_SPIN(cond, bar) do { unsigned _sp = 0; while (cond) { __builtin_amdgcn_s_sleep(1); \
    if ((++_sp & 255u) == 0u) { if (xb_ld(&(bar)[XB_TMO])) break; if (_sp > XB_SPIN_CAP) { atomicAdd(&(bar)[XB_TMO], 1u); break; } } } } while (0)
struct XcdBarrier { unsigned* bar; unsigned x; volatile LAS unsigned* st; };
__device__ __forceinline__ XcdBarrier xcd_barrier_post(unsigned* bar, volatile LAS unsigned* st) {
    XcdBarrier b; b.bar = bar; b.x = xb_xcc_id(); b.st = st;
    if (threadIdx.x == 0) (void)xb_add(&bar[XB_XCNT(b.x)], 1u);
    return b;
}
__device__ __forceinline__ void xcd_barrier_complete(unsigned* bar, unsigned x, unsigned& nloc, unsigned& nx) {
    const unsigned G = gridDim.x * gridDim.y * gridDim.z;
    unsigned sum, cnt, mine, sp = 0u;
    for (;;) {
        sum = 0u; cnt = 0u; mine = 0u;
#pragma unroll
        for (unsigned j = 0; j < 16; ++j) { const unsigned c = xb_ld(&bar[XB_XCNT(j)]); sum += c; cnt += (c > 0u) ? 1u : 0u; mine = (j == x) ? c : mine; }
        if (sum == G) break;
        __builtin_amdgcn_s_sleep(1);
        if ((++sp & 255u) == 0u) { if (xb_ld(&bar[XB_TMO])) break; if (sp > XB_SPIN_CAP) { atomicAdd(&bar[XB_TMO], 1u); break; } }
    }
    nloc = mine > 0u ? mine : 1u; nx = cnt > 0u ? cnt : 1u;
}
__device__ __forceinline__ void xcd_barrier(const XcdBarrier& b) {
    asm volatile("s_waitcnt vmcnt(0)" ::: "memory");
    __syncthreads();
    if (threadIdx.x == 0) {
        unsigned* bar = b.bar;
        __builtin_amdgcn_s_waitcnt(0);
        unsigned nloc = b.st[0], nx = b.st[1];
        if (nloc == 0u) { xcd_barrier_complete(bar, b.x, nloc, nx); b.st[0] = nloc; b.st[1] = nx; }
        const unsigned old = xb_add(&bar[XB_XSUB(b.x)], 1u);
        const unsigned gen = old / nloc;
        if (old + 1u == (gen + 1u) * nloc) {
            __builtin_amdgcn_fence(__ATOMIC_RELEASE, "agent");
            asm volatile("s_waitcnt vmcnt(0)" ::: "memory");
            const unsigned og = xb_add(&bar[XB_TOP], 1u);
            const unsigned tg = og / nx;
            if (og + 1u == (tg + 1u) * nx) xb_add(&bar[XB_TOPGEN], 1u);
            else XB_SPIN(xb_ld(&bar[XB_TOPGEN]) == tg, bar);
            __builtin_amdgcn_fence(__ATOMIC_ACQUIRE, "agent");
            xb_add(&bar[XB_XGEN(b.x)], 1u);
            asm volatile("s_waitcnt vmcnt(0)" ::: "memory");
        } else {
            XB_SPIN(xb_ld(&bar[XB_XGEN(b.x)]) == gen, bar);
            __builtin_amdgcn_fence(__ATOMIC_ACQUIRE, "agent");
            asm volatile("s_waitcnt vmcnt(0)" ::: "memory");
        }
    }
    __syncthreads();
}

__device__ __forceinline__ void group_barrier(unsigned* ctr, unsigned gen) {
    asm volatile("s_waitcnt vmcnt(0)" ::: "memory");
    __syncthreads();
    if (threadIdx.x == 0) {
        const unsigned old = xb_add(ctr, 1u);
        if (old + 1u == 8u * gen) (void)xb_add(ctr + 32, 1u);
        else { unsigned sp = 0u; while (xb_ld(ctr + 32) < gen) { __builtin_amdgcn_s_sleep(1); if (++sp > (1u << 24)) break; } }
        __builtin_amdgcn_fence(__ATOMIC_ACQUIRE, "agent");
        asm volatile("s_waitcnt vmcnt(0)" ::: "memory");
    }
    __syncthreads();
}
__device__ __forceinline__ bool group_purity(unsigned* pur) {
    bool ok = true;
#pragma unroll
    for (int j = 0; j < 8; ++j) { const unsigned w = xb_ld(pur + j); ok = ok && (w != 0u) && ((w & (w - 1u)) == 0u); }
    return ok;
}

__global__ void __launch_bounds__(NTHR, 2) mega_fwd(Params P) {
    extern __shared__ __attribute__((aligned(16))) unsigned char lds_raw[];
    LAS unsigned char* lds = (LAS unsigned char*)lds_raw;
    cg::grid_group grid = cg::this_grid();
    const int G = gridDim.x, bx = blockIdx.x;
    const int vcu = (G % 8 == 0) ? (bx % 8) * (G / 8) + bx / 8 : bx;
    unsigned char* ws = P.ws;
#ifndef ONLY_PHASE
#define ONLY_PHASE -1
#endif
#define IN(k) ((ONLY_PHASE < 0 || ONLY_PHASE == (k)) && P.ph_lo <= (k) && (k) < P.ph_hi)
    volatile LAS unsigned* bst = (volatile LAS unsigned*)(lds + LDS_BYTES - 64);
    if (threadIdx.x < 16) bst[threadIdx.x] = 0u;
    __syncthreads();
    const XcdBarrier xbar = xcd_barrier_post((unsigned*)(ws + WS_CTL + 131072), bst);
    if (threadIdx.x == 0) (void)__hip_atomic_fetch_or((unsigned*)(ws + WS_CTL + 147456 + 4096) + (bx & 7), 1u << xbar.x, __ATOMIC_RELAXED, __HIP_MEMORY_SCOPE_AGENT);
    if (P.ph_lo < 0) grid.sync();
#define SEAM(k) do { if (IN(k) && IN((k) + 1)) xcd_barrier(xbar); } while (0)
    int pm_ = 0, pn_ = 0;
    if (G == 256) { pg8::StaticOrder S; S.init(T_TOK, DM, G, bx, WGM2); pg8::Unit u; S.next(0, u); pm_ = u.pm; pn_ = u.pn; }
    const int vcu67 = (G == 256) ? pm_ * 8 + pn_ : vcu;
    unsigned* gctr = (unsigned*)(ws + WS_CTL + 147456 + 8192) + 64 * pm_; unsigned* gpur = (unsigned*)(ws + WS_CTL + 147456 + 4096); unsigned lgen = 0u; int lmode = -1;
#define SEAM_L(k, own) do { if (IN(k) && IN((k) + 1)) { if (lmode < 0) lmode = (G == 256 && IN(0) && group_purity(gpur)) ? 1 : 0; \
        if (!lmode) xcd_barrier(xbar); else if (own) { asm volatile("s_waitcnt vmcnt(0)" ::: "memory"); __syncthreads(); } else { ++lgen; group_barrier(gctr, lgen); } } } while (0)
    if (IN(0)) { p0a(P, lds, vcu, G); xcd_barrier(xbar); p0b(P, lds, vcu, G); }
    SEAM(0);
    if (IN(1)) {
        pg8::Gemm g{ws + WS_H, ws + WS_WIN, T_TOK, 10240, 2048, 2048, 2048};
        pg8::StaticOrder S; S.init(T_TOK, 10240, G, bx, WGM1);
        pg8::EpiProj E{(bf16_t*)(ws + WS_QKV), (bf16_t*)(ws + WS_SG), LOG2E * 0.08838834764831845f, (unsigned*)(ws + WS_CTL + 200704), (const float*)(ws + WS_HSC), (const float*)(ws + WS_WSC)};
        pg8::gemm_phase<pg8::EpiProj, true>(lds, g, S, E);
    }
    SEAM(1);
    if (IN(2)) { att::attn_phase(P, lds, vcu, G); __syncthreads(); late_transposes(P, lds, vcu, G); }
    SEAM(2);
    if (IN(3)) {
        pg8::StaticOrder S; S.init(T_TOK, DM, G, bx, WGM2);
        { pg8::Gemm g{ws + WS_H, ws + WS_WAT, T_TOK, DM, 1024, 4096, 2048};
          pg8::EpiGate<0> E{(const bf16_t*)(ws + WS_SG), (bf16_t*)(ws + WS_TMP), (bf16_t*)(ws + WS_MERGED)};
          pg8::gemm_phase(lds, g, S, E); }
        { pg8::Gemm g{ws + WS_H + 2048, ws + WS_WBT, T_TOK, DM, 1024, 4096, 2048};
          pg8::EpiGate<1> E{(const bf16_t*)(ws + WS_SG) + 2048, (bf16_t*)(ws + WS_TMP), (bf16_t*)(ws + WS_MERGED)};
          pg8::gemm_phase(lds, g, S, E); }
    }
    SEAM_L(3, false);
    if (IN(4)) {
        pg8::Gemm g{ws + WS_MERGED, ws + WS_WOUT, T_TOK, DM, 2048, 4096, 4096};
        pg8::StaticOrder S; S.init(T_TOK, DM, G, bx, WGM2);
        pg8::EpiResid E{P.x, (float*)(ws + WS_X1), (bf16_t*)(ws + WS_X1B), (float*)(ws + WS_CTL)};
        pg8::gemm_phase(lds, g, S, E);
    }
    SEAM_L(4, false);
    if (IN(5)) {
        pg8::Gemm g{ws + WS_X1B, ws + WS_WQ, T_TOK, DM, 2048, 4096, 4096};
        pg8::StaticOrder S; S.init(T_TOK, DM, G, bx, WGM2);
        pg8::EpiPlainBf16 E{(bf16_t*)(ws + WS_Q2)};
        pg8::gemm_phase(lds, g, S, E);
    }
    SEAM_L(5, true);
    if (IN(6)) peer::topk_phase(P, lds, vcu67, G);
    SEAM_L(6, false);
    if (IN(7)) { peer::gather_sweep(P, lds, vcu67, G); }
#undef IN
#undef SEAM
#undef SEAM_L
}

extern "C" void kernel_launch(void* const* d_in, const int* in_sizes, int n_in, void* d_out, int out_size, void* d_ws, size_t ws_size, hipStream_t stream) {
    static int grid = 0;
    if (grid == 0) {
        if (n_in != 13 || out_size != T_TOK * DM || ws_size < WS_END) { fprintf(stderr, "kernel_launch: unexpected shapes (n_in %d out %d ws %zu)\n", n_in, out_size, ws_size); grid = -1; return; }
        int dev = 0, cus = 0, per_cu = 0;
        if (hipGetDevice(&dev) != hipSuccess || hipDeviceGetAttribute(&cus, hipDeviceAttributeMultiprocessorCount, dev) != hipSuccess) { grid = -1; return; }
        if (hipFuncSetAttribute((const void*)mega_fwd, hipFuncAttributeMaxDynamicSharedMemorySize, LDS_BYTES) != hipSuccess) { fprintf(stderr, "kernel_launch: hipFuncSetAttribute failed\n"); grid = -1; return; }
        if (hipOccupancyMaxActiveBlocksPerMultiprocessor(&per_cu, (const void*)mega_fwd, NTHR, LDS_BYTES) != hipSuccess || per_cu < 1) { fprintf(stderr, "kernel_launch: occupancy query says %d\n", per_cu); grid = -1; return; }
        grid = cus;
    }
    if (grid < 0) return;
    (void)hipMemsetAsync((char*)d_ws + WS_CTL, 0, 1 * MiB, stream);
    Params p{};
    p.x = (const float*)d_in[0]; p.g_mix = (const float*)d_in[1]; p.w_in = (const float*)d_in[2]; p.b_forget = (const float*)d_in[3];
    p.w_a = (const float*)d_in[4]; p.w_b = (const float*)d_in[5]; p.w_out = (const float*)d_in[6]; p.g_ffn = (const float*)d_in[7];
    p.w_query = (const float*)d_in[8]; p.sub_keys = (const float*)d_in[9]; p.e_u = (const float*)d_in[10]; p.e_v = (const float*)d_in[11]; p.g_final = (const float*)d_in[12];
    p.out = (float*)d_out; p.ws = (unsigned char*)d_ws;
#if MK_N_LAUNCHES == 1
    p.ph_lo = 0; p.ph_hi = N_PHASES;
    void* args[] = {&p};
    hipError_t e = hipLaunchCooperativeKernel((const void*)mega_fwd, dim3(grid), dim3(NTHR), args, LDS_BYTES, stream);
    if (e != hipSuccess) fprintf(stderr, "kernel_launch: cooperative launch failed: %s (grid %d)\n", hipGetErrorString(e), grid);
#else
    for (int ph = 0; ph < N_PHASES; ++ph) { p.ph_lo = ph; p.ph_hi = ph + 1; hipLaunchKernelGGL(mega_fwd, dim3(grid), dim3(NTHR), LDS_BYTES, stream, p); }
#endif
}
```

```cpp
#include <hip/hip_runtime.h>
#include <hip/hip_cooperative_groups.h>
#include <cstdio>
#include <cstdint>
namespace cg = cooperative_groups;

#define LAS __attribute__((address_space(3)))
#define GAS __attribute__((address_space(1)))
typedef unsigned short bf16_t;
typedef short bf16x8 __attribute__((ext_vector_type(8)));
typedef short s16x4 __attribute__((ext_vector_type(4)));
typedef float f32x2 __attribute__((ext_vector_type(2)));
typedef float f32x4 __attribute__((ext_vector_type(4)));
typedef float f32x16 __attribute__((ext_vector_type(16)));
typedef unsigned u32x2 __attribute__((ext_vector_type(2)));
typedef unsigned u32x4 __attribute__((ext_vector_type(4)));
typedef __bf16 bf16v2 __attribute__((ext_vector_type(2)));
typedef int i32x4 __attribute__((ext_vector_type(4)));
typedef int i32x2 __attribute__((ext_vector_type(2)));

#ifndef UCLIP
#define UCLIP 2.5f
#endif
#ifndef WGM1
#define WGM1 4
#endif
#ifndef WGM2
#define WGM2 4
#endif
#ifndef MK_N_LAUNCHES
#define MK_N_LAUNCHES 1
#endif

constexpr int T_TOK = 8192, DM = 2048, SEQ = 4096, HD = 128;
constexpr int NWAVES = 8, NTHR = 512;
constexpr int LDS_BYTES = 163840;
constexpr float LOG2E = 1.4426950408889634f;
constexpr float EPS = 1e-6f;
constexpr int N_PHASES = 8;

constexpr size_t MiB = 1u << 20;
constexpr size_t WS_CTL = 0;
constexpr size_t WS_LOGF = 1 * MiB;
constexpr size_t WS_SKB = 1 * MiB + 512 * 1024;
constexpr size_t WS_HSC = 1 * MiB + 256 * 1024;
constexpr size_t WS_WSC = 1 * MiB + 320 * 1024;
constexpr size_t WS_WSC2 = 1 * MiB + 384 * 1024;
constexpr size_t WS_ASC = 1 * MiB + 416 * 1024;
constexpr size_t WS_AQ = 298 * MiB;
constexpr size_t CTL_CMAX = 262144;
constexpr size_t WS_IDS = 2 * MiB;
constexpr size_t WS_GATES = 6 * MiB;
constexpr size_t WS_WAT = 10 * MiB, WS_WBT = 14 * MiB, WS_WOUT = 18 * MiB, WS_WQ = 26 * MiB, WS_WIN = 34 * MiB;
constexpr size_t WS_H = 74 * MiB;
constexpr size_t WS_QKV = 106 * MiB;
constexpr size_t WS_TMP = 106 * MiB, WS_MERGED = 170 * MiB, WS_Q2 = 106 * MiB;
constexpr size_t WS_SG = 202 * MiB;
constexpr size_t WS_X1B = 266 * MiB;
constexpr size_t WS_X1 = 266 * MiB;
constexpr size_t WS_EU = 330 * MiB, WS_EV = 362 * MiB;
constexpr size_t WS_REC = 394 * MiB;
constexpr size_t WS_END = 395 * MiB;

struct Params {
    const float* x; const float* g_mix; const float* w_in; const float* b_forget; const float* w_a; const float* w_b; const float* w_out;
    const float* g_ffn; const float* w_query; const float* sub_keys; const float* e_u; const float* e_v; const float* g_final;
    float* out; unsigned char* ws; int ph_lo, ph_hi;
};

__device__ __forceinline__ unsigned pk2(float a, float b) { f32x2 v = {a, b}; return __builtin_bit_cast(unsigned, __builtin_convertvector(v, bf16v2)); }
__device__ __forceinline__ float bf_lo(unsigned u) { return __builtin_bit_cast(float, u << 16); }
__device__ __forceinline__ float bf_hi(unsigned u) { return __builtin_bit_cast(float, u & 0xffff0000u); }
__device__ __forceinline__ float fexp2(float x) { return __builtin_amdgcn_exp2f(x); }
__device__ __forceinline__ float flog2(float x) { return __builtin_amdgcn_logf(x); }
__device__ __forceinline__ float frcp(float x) { return __builtin_amdgcn_rcpf(x); }
__device__ __forceinline__ float wave_sum(float v) {
#pragma unroll
    for (int o = 1; o < 64; o <<= 1) v += __shfl_xor(v, o);
    return v;
}
#define LDS_WAIT() asm volatile("s_waitcnt lgkmcnt(0)" ::: "memory")
#define LDSA_B32(dst, base, IMM) asm volatile("ds_read_b32 %0, %1 offset:%2" : "=v"(dst) : "v"(base), "i"(IMM))
#define LDSA_B64(dst, base, IMM) asm volatile("ds_read_b64 %0, %1 offset:%2" : "=v"(dst) : "v"(base), "i"(IMM))
#define LDSA_TR8(dst, base, IMM) asm volatile("ds_read_b64_tr_b8 %0, %1 offset:%2" : "=v"(dst) : "v"(base), "i"(IMM))
__device__ __forceinline__ unsigned long long uniform64(unsigned long long v) { const unsigned lo = __builtin_amdgcn_readfirstlane((unsigned)v), hi = __builtin_amdgcn_readfirstlane((unsigned)(v >> 32)); return ((unsigned long long)hi << 32) | lo; }

namespace pg8 {
constexpr int BM = 256, BK = 64, HALF = 128, HTB = HALF * BK * 2, STAGE_BYTES = 8 * HTB, NXCD = 8, WGM = 8;
__host__ __device__ __forceinline__ int lds_byte(int r, int c) { const int st = (r >> 4) * 2 + (c >> 5), rr = r & 15, cc = c & 31, ob = rr * 64 + cc * 2; return st * 1024 + (ob ^ (((ob >> 9) & 1) << 5)); }
__host__ __device__ __forceinline__ void stage_rc(int b, int& R, int& C) { const int st = b / 1024, sb = b % 1024, swz = sb ^ (((sb >> 9) & 1) << 5); R = (st >> 1) * 16 + swz / 64; C = (st & 1) * 32 + (swz % 64) / 2; }
__host__ __device__ __forceinline__ int perm32(int rho) { const int n = rho >> 4, i = rho & 15; return 8 * (i >> 2) + 4 * n + (i & 3); }
struct Unit { int pm, pn, br; };
struct Gemm { const void* A; const void* Bt; int M, N, K, pa, pb; size_t brA = 0, brB = 0; };
struct StaticOrder {
    int nM, nN, nwg, G, c, wgm;
    __device__ void init(int M, int N, int G_, int c_, int wgm_ = WGM) { nM = M / BM; nN = N / BM; nwg = nM * nN; G = G_; c = c_; wgm = wgm_; }
    __device__ bool next(int i, Unit& u) const {
        const long L = (long)i * G + c; if (L >= nwg) return false;
        int wgid = (int)L; { const int q = nwg / NXCD, r = nwg % NXCD, xcd = wgid % NXCD, off = wgid / NXCD; wgid = (xcd < r ? xcd * (q + 1) : r * (q + 1) + (xcd - r) * q) + off; }
        const int nig = wgm * nN, gid = wgid / nig, fm = gid * wgm, gsz = (nM - fm) < wgm ? (nM - fm) : wgm;
        u.pm = fm + ((wgid % nig) % gsz); u.pn = (wgid % nig) / gsz; u.br = 0; return true;
    }
};
struct BranchOrder {
    StaticOrder S;
    __device__ bool next(int i, Unit& u) const { if (!S.next(i >> 1, u)) return false; u.br = i & 1; return true; }
};
template <class Epi, bool I8 = false, class Ord = StaticOrder>
__device__ __forceinline__ void gemm_phase(LAS unsigned char* lds, const Gemm g, const Ord& S, const Epi& E) {
    const int tid = threadIdx.x, wid = __builtin_amdgcn_readfirstlane(tid >> 6), lane = tid & 63, wr = wid >> 2, wc = wid & 3, fr = lane & 15, fq = lane >> 4;
    const int K = g.K, nt = I8 ? K / (2 * BK) : K / BK;
    unsigned voffA[2], voffB[2];
#pragma unroll
    for (int i = 0; i < 2; ++i) { int R, C; stage_rc(tid * 16 + i * 8192, R, C); const int Rb = (R & ~31) + perm32(R & 31);
        voffA[i] = (unsigned)(R * g.pa + C * 2); voffB[i] = (unsigned)(Rb * g.pb + C * 2); }
    const size_t kstep = (size_t)(BK * 2);
    const size_t hstepA = (size_t)HALF * g.pa, hstepB = (size_t)HALF * g.pb;
    const size_t tstepA = 2 * hstepA, tstepB = 2 * hstepB;
    const unsigned ldsw = (unsigned)wid * 1024u;
    const int aoff = lds_byte(wr * 64 + fr, fq * 8), boff = lds_byte(wc * 32 + fr, fq * 8);
#define PG8_SA(b, h) (((b) * 2 + (h)) * HTB)
#define PG8_SB(b, h) ((4 + (b) * 2 + (h)) * HTB)
#define PG8_STAGE(bufoff, gbase, voff) do { _Pragma("unroll") for (int _i = 0; _i < 2; ++_i) \
        __builtin_amdgcn_global_load_lds((const unsigned*)((const char*)(gbase) + (voff)[_i]), (LAS unsigned*)(lds + (bufoff) + ldsw + _i * 8192), 16, 0, 0); } while (0)
#define PG8_LDA(dst, b, h) do { _Pragma("unroll") for (int m = 0; m < 4; ++m) _Pragma("unroll") for (int k = 0; k < 2; ++k) dst[m][k] = *(const LAS bf16x8*)(lds + PG8_SA(b, h) + aoff + m * 2048 + k * 1024); } while (0)
#define PG8_LDB(dst, b, h) do { _Pragma("unroll") for (int n = 0; n < 2; ++n) _Pragma("unroll") for (int k = 0; k < 2; ++k) dst[n][k] = *(const LAS bf16x8*)(lds + PG8_SB(b, h) + boff + n * 2048 + k * 1024); } while (0)
#define PG8_MMA(ai, bj, At, Bt) do { __builtin_amdgcn_s_setprio(1); _Pragma("unroll") for (int m = 0; m < 4; ++m) _Pragma("unroll") for (int n = 0; n < 2; ++n) _Pragma("unroll") for (int k = 0; k < 2; ++k) \
        { if (I8) acc[ai][bj][m][n] = __builtin_bit_cast(f32x4, __builtin_amdgcn_mfma_i32_16x16x64_i8(__builtin_bit_cast(i32x4, Bt[n][k]), __builtin_bit_cast(i32x4, At[m][k]), __builtin_bit_cast(i32x4, acc[ai][bj][m][n]), 0, 0, 0)); \
          else acc[ai][bj][m][n] = __builtin_amdgcn_mfma_f32_16x16x32_bf16(Bt[n][k], At[m][k], acc[ai][bj][m][n], 0, 0, 0); } __builtin_amdgcn_s_setprio(0); } while (0)
#define PG8_WAIT_V(n) asm volatile("s_waitcnt vmcnt(" #n ")" ::: "memory")
#define PG8_WAIT_L(n) asm volatile("s_waitcnt lgkmcnt(" #n ")" ::: "memory")
#define PG8_BAR __builtin_amdgcn_s_barrier()
#define PG8_SCHED __builtin_amdgcn_sched_barrier(0)
    Unit cur, nxt; int ui = 0;
    if (!S.next(0, cur)) return;
    f32x4 acc[2][2][4][2];
#pragma unroll
    for (int a = 0; a < 2; ++a)
#pragma unroll
        for (int b = 0; b < 2; ++b)
#pragma unroll
            for (int m = 0; m < 4; ++m)
#pragma unroll
                for (int n = 0; n < 2; ++n) acc[a][b][m][n] = (f32x4){0.f, 0.f, 0.f, 0.f};
    bf16x8 At[4][2], B0[2][2], B1[2][2];
    const char* cA = (const char*)g.A + (size_t)cur.pm * tstepA + (size_t)cur.br * g.brA; const char* cB = (const char*)g.Bt + (size_t)cur.pn * tstepB + (size_t)cur.br * g.brB;
    PG8_STAGE(PG8_SB(0, 0), cB, voffB); PG8_STAGE(PG8_SA(0, 0), cA, voffA); PG8_STAGE(PG8_SB(0, 1), cB + hstepB, voffB); PG8_STAGE(PG8_SA(0, 1), cA + hstepA, voffA);
    if (wr == 1) PG8_BAR;
    PG8_WAIT_V(4); PG8_BAR;
    PG8_STAGE(PG8_SB(1, 0), cB + kstep, voffB); PG8_STAGE(PG8_SA(1, 0), cA + kstep, voffA); PG8_STAGE(PG8_SB(1, 1), cB + hstepB + kstep, voffB);
    PG8_WAIT_V(6); PG8_BAR;
    for (;;) {
        const bool has_next = S.next(ui + 1, nxt);
        const char* nA = has_next ? (const char*)g.A + (size_t)nxt.pm * tstepA + (size_t)nxt.br * g.brA : cA; const char* nB = has_next ? (const char*)g.Bt + (size_t)nxt.pn * tstepB + (size_t)nxt.br * g.brB : cB;
        for (int t = 0; t < nt; t += 2) {
            const bool last = (t == nt - 2);
            const char* a1 = cA + (size_t)(t + 1) * kstep;
            const char* a2 = last ? nA : cA + (size_t)(t + 2) * kstep; const char* b2 = last ? nB : cB + (size_t)(t + 2) * kstep;
            const char* a3 = a2 + kstep; const char* b3 = b2 + kstep;
            PG8_LDB(B0, 0, 0); PG8_SCHED; PG8_LDA(At, 0, 0); PG8_STAGE(PG8_SA(1, 1), a1 + hstepA, voffA);
            PG8_WAIT_L(8); PG8_BAR; PG8_WAIT_L(0); PG8_MMA(0, 0, At, B0); PG8_BAR; PG8_SCHED;
            PG8_LDB(B1, 0, 1); PG8_STAGE(PG8_SB(0, 0), b2, voffB);
            PG8_BAR; PG8_WAIT_L(0); PG8_MMA(0, 1, At, B1); PG8_BAR;
            PG8_LDA(At, 0, 1); PG8_STAGE(PG8_SA(0, 0), a2, voffA);
            PG8_WAIT_V(10); PG8_BAR; PG8_WAIT_L(0); PG8_MMA(1, 0, At, B0); PG8_BAR; PG8_SCHED;
            PG8_LDB(B0, 1, 0); PG8_STAGE(PG8_SB(0, 1), b2 + hstepB, voffB);
            PG8_WAIT_V(6); PG8_BAR; PG8_MMA(1, 1, At, B1); PG8_BAR; PG8_SCHED;
            PG8_LDA(At, 1, 0); PG8_STAGE(PG8_SA(0, 1), a2 + hstepA, voffA);
            PG8_WAIT_L(8); PG8_BAR; PG8_WAIT_L(0); PG8_MMA(0, 0, At, B0); PG8_BAR; PG8_SCHED;
            PG8_LDB(B1, 1, 1); PG8_STAGE(PG8_SB(1, 0), b3, voffB);
            PG8_BAR; PG8_WAIT_L(0); PG8_MMA(0, 1, At, B1); PG8_BAR;
            PG8_LDA(At, 1, 1); PG8_STAGE(PG8_SA(1, 0), a3, voffA);
            PG8_BAR; PG8_WAIT_L(0); PG8_MMA(1, 0, At, B0); PG8_BAR; PG8_SCHED;
            PG8_STAGE(PG8_SB(1, 1), b3 + hstepB, voffB);
            PG8_WAIT_V(6); PG8_BAR; PG8_MMA(1, 1, At, B1); PG8_BAR;
        }
        E(acc, cur, wr, wc, fr, fq);
        if (!has_next) break;
#pragma unroll
        for (int a = 0; a < 2; ++a)
#pragma unroll
            for (int b = 0; b < 2; ++b)
#pragma unroll
                for (int m = 0; m < 4; ++m)
#pragma unroll
                    for (int n = 0; n < 2; ++n) acc[a][b][m][n] = (f32x4){0.f, 0.f, 0.f, 0.f};
        cur = nxt; cA = nA; cB = nB; ++ui;
    }
    PG8_WAIT_V(0);
    if (wr == 0) PG8_BAR;
    PG8_BAR;
#undef PG8_SA
#undef PG8_SB
#undef PG8_STAGE
#undef PG8_LDA
#undef PG8_LDB
#undef PG8_MMA
#undef PG8_WAIT_V
#undef PG8_WAIT_L
#undef PG8_BAR
#undef PG8_SCHED
}

struct EpiProj {
    bf16_t* qkv; bf16_t* sg; float qscale; unsigned* kmaxw; const float* hsc; const float* wsc;
    __device__ __forceinline__ void operator()(const f32x4 (&acci)[2][2][4][2], const Unit& u, int wr, int wc, int fr, int fq) const {
        const int row0 = u.pm * BM + wr * 64 + fr;
        f32x4 acc[2][2][4][2];
        { f32x4 cs[2][2];
#pragma unroll
          for (int bj = 0; bj < 2; ++bj)
#pragma unroll
              for (int n = 0; n < 2; ++n) cs[bj][n] = *(const f32x4*)(wsc + u.pn * BM + bj * HALF + wc * 32 + 8 * fq + 4 * n);
#pragma unroll
          for (int ai = 0; ai < 2; ++ai)
#pragma unroll
              for (int m = 0; m < 4; ++m) { const float rsc = hsc[row0 + ai * HALF + m * 16];
#pragma unroll
                  for (int bj = 0; bj < 2; ++bj)
#pragma unroll
                      for (int n = 0; n < 2; ++n) { const i32x4 iv = __builtin_bit_cast(i32x4, acci[ai][bj][m][n]);
                          acc[ai][bj][m][n] = (f32x4){(float)iv[0], (float)iv[1], (float)iv[2], (float)iv[3]} * rsc * cs[bj][n]; } } }
        if (u.pn < 24) {
            const int t = u.pn >> 2; bf16_t* base = qkv + (size_t)t * ((size_t)T_TOK * 1024) + (u.pn & 3) * 256 + wc * 32 + 8 * fq;
            const float sc = (t == 0 || t == 3) ? qscale : 1.f;
            if (t == 4) {
#pragma unroll
                for (int bj = 0; bj < 2; ++bj) { float mxv = 0.f;
#pragma unroll
                    for (int ai = 0; ai < 2; ++ai)
#pragma unroll
                        for (int m = 0; m < 4; ++m) { const f32x4 v0 = acc[ai][bj][m][0], v1 = acc[ai][bj][m][1];
                            float ssq = (v0[0] * v0[0] + v0[1] * v0[1]) + (v0[2] * v0[2] + v0[3] * v0[3]) + (v1[0] * v1[0] + v1[1] * v1[1]) + (v1[2] * v1[2] + v1[3] * v1[3]);
                            ssq += __shfl_xor(ssq, 16); ssq += __shfl_xor(ssq, 32); mxv = fmaxf(mxv, ssq); }
#pragma unroll
                    for (int o = 1; o < 16; o <<= 1) mxv = fmaxf(mxv, __shfl_xor(mxv, o));
                    if ((fr | fq) == 0) atomicMax(kmaxw + ((u.pm >> 4) * 8 + (u.pn & 3) * 2 + bj) * 4 + wc, __builtin_bit_cast(unsigned, mxv)); }
            }
#pragma unroll
            for (int ai = 0; ai < 2; ++ai)
#pragma unroll
                for (int m = 0; m < 4; ++m) { bf16_t* rowp = base + (size_t)(row0 + ai * HALF + m * 16) * 1024;
#pragma unroll
                    for (int bj = 0; bj < 2; ++bj) { const f32x4 v0 = acc[ai][bj][m][0] * sc, v1 = acc[ai][bj][m][1] * sc;
                        u32x4 w; w.x = pk2(v0[0], v0[1]); w.y = pk2(v0[2], v0[3]); w.z = pk2(v1[0], v1[1]); w.w = pk2(v1[2], v1[3]);
                        *(u32x4*)(rowp + bj * HALF) = w; } }
        } else {
            bf16_t* base = sg + (u.pn - 24) * 256 + wc * 32 + 8 * fq;
#pragma unroll
            for (int ai = 0; ai < 2; ++ai)
#pragma unroll
                for (int m = 0; m < 4; ++m) { bf16_t* rowp = base + (size_t)(row0 + ai * HALF + m * 16) * 4096;
#pragma unroll
                    for (int bj = 0; bj < 2; ++bj) { float s[8];
#pragma unroll
                        for (int e = 0; e < 4; ++e) { s[e] = frcp(1.f + fexp2(-LOG2E * acc[ai][bj][m][0][e])); s[4 + e] = frcp(1.f + fexp2(-LOG2E * acc[ai][bj][m][1][e])); }
                        u32x4 w; w.x = pk2(s[0], s[1]); w.y = pk2(s[2], s[3]); w.z = pk2(s[4], s[5]); w.w = pk2(s[6], s[7]);
                        *(u32x4*)(rowp + bj * HALF) = w; } }
        }
    }
};
template <int SECOND> struct EpiGate {
    const bf16_t* sg;
    bf16_t* tmp; bf16_t* merged;
    __device__ __forceinline__ void operator()(const f32x4 (&acc)[2][2][4][2], const Unit& u, int wr, int wc, int fr, int fq) const {
        const int row0 = u.pm * BM + wr * 64 + fr, col0 = u.pn * BM + wc * 32 + 8 * fq;
#pragma unroll
        for (int ai = 0; ai < 2; ++ai)
#pragma unroll
            for (int m = 0; m < 4; ++m) { const size_t row = (size_t)(row0 + ai * HALF + m * 16);
#pragma unroll
                for (int bj = 0; bj < 2; ++bj) { const int col = col0 + bj * HALF;
                    const u32x4 gv = *(const u32x4*)(sg + row * 4096 + col);
                    const f32x4 g0 = {bf_lo(gv.x), bf_hi(gv.x), bf_lo(gv.y), bf_hi(gv.y)}, g1 = {bf_lo(gv.z), bf_hi(gv.z), bf_lo(gv.w), bf_hi(gv.w)};
                    f32x4 v0 = acc[ai][bj][m][0] * g0, v1 = acc[ai][bj][m][1] * g1;
                    bf16_t* tp = tmp + row * DM + col;
                    if (SECOND == 0) { u32x4 w; w.x = pk2(v0[0], v0[1]); w.y = pk2(v0[2], v0[3]); w.z = pk2(v1[0], v1[1]); w.w = pk2(v1[2], v1[3]); *(u32x4*)tp = w; }
                    else { const u32x4 tv = *(const u32x4*)tp; v0 += (f32x4){bf_lo(tv.x), bf_hi(tv.x), bf_lo(tv.y), bf_hi(tv.y)}; v1 += (f32x4){bf_lo(tv.z), bf_hi(tv.z), bf_lo(tv.w), bf_hi(tv.w)};
                        u32x4 w; w.x = pk2(v0[0], v0[1]); w.y = pk2(v0[2], v0[3]); w.z = pk2(v1[0], v1[1]); w.w = pk2(v1[2], v1[3]);
                        *(u32x4*)(merged + row * DM + col) = w; } } }
    }
};
struct EpiGate2 {
    const bf16_t* sg; bf16_t* tmp; bf16_t* merged;
    __device__ __forceinline__ void operator()(const f32x4 (&acc)[2][2][4][2], const Unit& u, int wr, int wc, int fr, int fq) const {
        if (u.br == 0) EpiGate<0>{sg, tmp, merged}(acc, u, wr, wc, fr, fq); else EpiGate<1>{sg + 2048, tmp, merged}(acc, u, wr, wc, fr, fq);
    }
};
struct EpiResid {
    const float* x; float* x1; bf16_t* x1b; float* rowss;
    __device__ __forceinline__ void operator()(const f32x4 (&acc)[2][2][4][2], const Unit& u, int wr, int wc, int fr, int fq) const {
        const int row0 = u.pm * BM + wr * 64 + fr, col0 = u.pn * BM + wc * 32 + 8 * fq;
#pragma unroll
        for (int ai = 0; ai < 2; ++ai)
#pragma unroll
            for (int m = 0; m < 4; ++m) { const size_t row = (size_t)(row0 + ai * HALF + m * 16); float ss = 0.f;
#pragma unroll
                for (int bj = 0; bj < 2; ++bj) { const size_t o = row * DM + col0 + bj * HALF;
                    const f32x4 v0 = acc[ai][bj][m][0] + *(const f32x4*)(x + o), v1 = acc[ai][bj][m][1] + *(const f32x4*)(x + o + 4);
                    u32x4 w; w.x = pk2(v0[0], v0[1]); w.y = pk2(v0[2], v0[3]); w.z = pk2(v1[0], v1[1]); w.w = pk2(v1[2], v1[3]);
                    *(u32x4*)(x1b + o) = w;
                    ss += (v0[0] * v0[0] + v0[1] * v0[1]) + (v0[2] * v0[2] + v0[3] * v0[3]) + (v1[0] * v1[0] + v1[1] * v1[1]) + (v1[2] * v1[2] + v1[3] * v1[3]); }
                ss += __shfl_xor(ss, 16); ss += __shfl_xor(ss, 32);
                if (fq == 0) atomicAdd(rowss + row, ss); }
    }
};
struct EpiResidI8 {
    const float* x; bf16_t* x1b; float* rowss; const float* asc; const float* wsc;
    __device__ __forceinline__ void operator()(const f32x4 (&acci)[2][2][4][2], const Unit& u, int wr, int wc, int fr, int fq) const {
        const int row0 = u.pm * BM + wr * 64 + fr, col0 = u.pn * BM + wc * 32 + 8 * fq;
        f32x4 cs[2][2];
#pragma unroll
        for (int bj = 0; bj < 2; ++bj)
#pragma unroll
            for (int n = 0; n < 2; ++n) cs[bj][n] = *(const f32x4*)(wsc + col0 + bj * HALF + 4 * n);
#pragma unroll
        for (int ai = 0; ai < 2; ++ai) {
            f32x4 xv[4][2][2]; float rsc[4];
#pragma unroll
            for (int m = 0; m < 4; ++m) { const size_t row = (size_t)(row0 + ai * HALF + m * 16); rsc[m] = asc[row];
#pragma unroll
                for (int bj = 0; bj < 2; ++bj) { const size_t o = row * DM + col0 + bj * HALF; xv[m][bj][0] = *(const f32x4*)(x + o); xv[m][bj][1] = *(const f32x4*)(x + o + 4); } }
            asm volatile("" : "+v"(xv[0][0][0]), "+v"(xv[0][0][1]), "+v"(xv[0][1][0]), "+v"(xv[0][1][1]), "+v"(xv[1][0][0]), "+v"(xv[1][0][1]), "+v"(xv[1][1][0]), "+v"(xv[1][1][1]),
                             "+v"(xv[2][0][0]), "+v"(xv[2][0][1]), "+v"(xv[2][1][0]), "+v"(xv[2][1][1]), "+v"(xv[3][0][0]), "+v"(xv[3][0][1]), "+v"(xv[3][1][0]), "+v"(xv[3][1][1]) :: "memory");
#pragma unroll
            for (int m = 0; m < 4; ++m) { const size_t row = (size_t)(row0 + ai * HALF + m * 16); float ss = 0.f;
#pragma unroll
                for (int bj = 0; bj < 2; ++bj) { const size_t o = row * DM + col0 + bj * HALF;
                    const i32x4 i0 = __builtin_bit_cast(i32x4, acci[ai][bj][m][0]), i1 = __builtin_bit_cast(i32x4, acci[ai][bj][m][1]);
                    const f32x4 v0 = (f32x4){(float)i0[0], (float)i0[1], (float)i0[2], (float)i0[3]} * rsc[m] * cs[bj][0] + xv[m][bj][0];
                    const f32x4 v1 = (f32x4){(float)i1[0], (float)i1[1], (float)i1[2], (float)i1[3]} * rsc[m] * cs[bj][1] + xv[m][bj][1];
                    u32x4 w; w.x = pk2(v0[0], v0[1]); w.y = pk2(v0[2], v0[3]); w.z = pk2(v1[0], v1[1]); w.w = pk2(v1[2], v1[3]);
                    *(u32x4*)(x1b + o) = w;
                    ss += (v0[0] * v0[0] + v0[1] * v0[1]) + (v0[2] * v0[2] + v0[3] * v0[3]) + (v1[0] * v1[0] + v1[1] * v1[1]) + (v1[2] * v1[2] + v1[3] * v1[3]); }
                ss += __shfl_xor(ss, 16); ss += __shfl_xor(ss, 32);
                if (fq == 0) atomicAdd(rowss + row, ss); }
        }
    }
};
struct EpiPlainBf16 {
    bf16_t* o;
    __device__ __forceinline__ void operator()(const f32x4 (&acc)[2][2][4][2], const Unit& u, int wr, int wc, int fr, int fq) const {
        const int row0 = u.pm * BM + wr * 64 + fr, col0 = u.pn * BM + wc * 32 + 8 * fq;
#pragma unroll
        for (int ai = 0; ai < 2; ++ai)
#pragma unroll
            for (int m = 0; m < 4; ++m) { const size_t row = (size_t)(row0 + ai * HALF + m * 16);
#pragma unroll
                for (int bj = 0; bj < 2; ++bj) { const f32x4 v0 = acc[ai][bj][m][0], v1 = acc[ai][bj][m][1];
                    u32x4 w; w.x = pk2(v0[0], v0[1]); w.y = pk2(v0[2], v0[3]); w.z = pk2(v1[0], v1[1]); w.w = pk2(v1[2], v1[3]);
                    *(u32x4*)(o + row * DM + col0 + bj * HALF) = w; } }
    }
};
struct EpiPlainI8 {
    bf16_t* o; const float* asc; const float* wsc;
    __device__ __forceinline__ void operator()(const f32x4 (&acci)[2][2][4][2], const Unit& u, int wr, int wc, int fr, int fq) const {
        const int row0 = u.pm * BM + wr * 64 + fr, col0 = u.pn * BM + wc * 32 + 8 * fq;
        f32x4 cs[2][2];
#pragma unroll
        for (int bj = 0; bj < 2; ++bj)
#pragma unroll
            for (int n = 0; n < 2; ++n) cs[bj][n] = *(const f32x4*)(wsc + col0 + bj * HALF + 4 * n);
#pragma unroll
        for (int ai = 0; ai < 2; ++ai)
#pragma unroll
            for (int m = 0; m < 4; ++m) { const size_t row = (size_t)(row0 + ai * HALF + m * 16); const float rsc = asc[row];
#pragma unroll
                for (int bj = 0; bj < 2; ++bj) { const i32x4 i0 = __builtin_bit_cast(i32x4, acci[ai][bj][m][0]), i1 = __builtin_bit_cast(i32x4, acci[ai][bj][m][1]);
                    const f32x4 v0 = (f32x4){(float)i0[0], (float)i0[1], (float)i0[2], (float)i0[3]} * rsc * cs[bj][0], v1 = (f32x4){(float)i1[0], (float)i1[1], (float)i1[2], (float)i1[3]} * rsc * cs[bj][1];
                    u32x4 w; w.x = pk2(v0[0], v0[1]); w.y = pk2(v0[2], v0[3]); w.z = pk2(v1[0], v1[1]); w.w = pk2(v1[2], v1[3]);
                    *(u32x4*)(o + row * DM + col0 + bj * HALF) = w; } }
    }
};
}

__device__ __forceinline__ void transpose_item(const float* W, int ldw, int src_n0, bf16_t* WT, int K, int dst_n0, int k0, LAS float* scr, int lane, const float* kscale) {
    { const int c4 = (lane & 7) * 4;
      f32x4 v[8];
#pragma unroll
      for (int i = 0; i < 8; ++i) v[i] = *(const f32x4*)(W + (size_t)(k0 + 8 * i + (lane >> 3)) * ldw + src_n0 + c4);
#pragma unroll
      for (int i = 0; i < 8; ++i) { const int kk = 8 * i + (lane >> 3); const float ks = kscale ? kscale[k0 + kk] : 1.f; LAS float* sp = scr + kk * 33 + c4;
          sp[0] = v[i][0] * ks; sp[1] = v[i][1] * ks; sp[2] = v[i][2] * ks; sp[3] = v[i][3] * ks; } }
    LDS_WAIT();
    const int c = lane & 7;
#pragma unroll
    for (int j = 0; j < 4; ++j) { const int n = (lane >> 3) + 8 * j; const LAS float* s = scr + (8 * c) * 33 + n;
        u32x4 o; o.x = pk2(s[0 * 33], s[1 * 33]); o.y = pk2(s[2 * 33], s[3 * 33]); o.z = pk2(s[4 * 33], s[5 * 33]); o.w = pk2(s[6 * 33], s[7 * 33]);
        *(u32x4*)(WT + (size_t)(dst_n0 + n) * K + k0 + 8 * c) = o; }
    LDS_WAIT();
}

template <int NCG, int KK>
__device__ __forceinline__ void wq_item(LAS unsigned char* lds, const float* src0, int ldw, const float* kscale, unsigned char* dst, float* sc) {
    const int tid = threadIdx.x, lane = tid & 63, wave = __builtin_amdgcn_readfirstlane(tid >> 6);
    constexpr int S = 2 * KK + 8;
    LAS float* wm = (LAS float*)(lds + 32 * 4104);
    constexpr int RPP = NTHR / NCG, NPASS = KK / RPP, NB = NPASS / 16 > 0 ? NPASS / 16 : 1, NQ = NPASS / NB;
    const int cg = tid % NCG, r0 = tid / NCG;
    const float* src = src0 + (size_t)r0 * ldw + 4 * cg;
    float m0 = 0.f, m1 = 0.f, m2 = 0.f, m3 = 0.f;
#pragma unroll 1
    for (int pb = 0; pb < NB; ++pb) {
        f32x4 v[NQ];
#pragma unroll
        for (int q = 0; q < NQ; ++q) v[q] = *(const f32x4*)(src + (size_t)(RPP * (NQ * pb + q)) * ldw);
#pragma unroll
        for (int q = 0; q < NQ; ++q) { const int k = RPP * (NQ * pb + q) + r0;
            if (kscale) v[q] = v[q] * kscale[k];
            m0 = fmaxf(m0, fabsf(v[q][0])); m1 = fmaxf(m1, fabsf(v[q][1])); m2 = fmaxf(m2, fabsf(v[q][2])); m3 = fmaxf(m3, fabsf(v[q][3]));
            const unsigned p01 = pk2(v[q][0], v[q][1]), p23 = pk2(v[q][2], v[q][3]);
            LAS unsigned char* d = lds + (4 * cg) * S + 2 * k;
            *(LAS unsigned short*)(d) = (unsigned short)p01; *(LAS unsigned short*)(d + S) = (unsigned short)(p01 >> 16);
            *(LAS unsigned short*)(d + 2 * S) = (unsigned short)p23; *(LAS unsigned short*)(d + 3 * S) = (unsigned short)(p23 >> 16); }
    }
#pragma unroll
    for (int o = NCG; o < 64; o <<= 1) { m0 = fmaxf(m0, __shfl_xor(m0, o)); m1 = fmaxf(m1, __shfl_xor(m1, o)); m2 = fmaxf(m2, __shfl_xor(m2, o)); m3 = fmaxf(m3, __shfl_xor(m3, o)); }
    if (lane < NCG) { LAS float* w4 = wm + wave * 32 + 4 * lane; w4[0] = m0; w4[1] = m1; w4[2] = m2; w4[3] = m3; }
    __syncthreads();
#pragma unroll 1
    for (int e = 0; e < NCG / 2; ++e) { const int n = (NCG / 2) * wave + e; if (n >= 4 * NCG) break;
        float cmx = 0.f;
#pragma unroll
        for (int w = 0; w < 8; ++w) cmx = fmaxf(cmx, wm[w * 32 + n]);
        cmx = fmaxf(cmx, 1e-30f); const float inv = 127.f / cmx;
        if (lane == 0) sc[n] = cmx * (1.f / 127.f);
#pragma unroll
        for (int j = 0; j < KK / 256; ++j) { const u32x2 raw = *(const LAS u32x2*)(lds + n * S + 8 * lane + 512 * j);
            const float f0 = bf_lo(raw[0]), f1 = bf_hi(raw[0]), f2 = bf_lo(raw[1]), f3 = bf_hi(raw[1]);
            const unsigned q0 = (unsigned)(int)fminf(fmaxf(__builtin_rintf(f0 * inv), -127.f), 127.f) & 255u, q1 = (unsigned)(int)fminf(fmaxf(__builtin_rintf(f1 * inv), -127.f), 127.f) & 255u;
            const unsigned q2 = (unsigned)(int)fminf(fmaxf(__builtin_rintf(f2 * inv), -127.f), 127.f) & 255u, q3 = (unsigned)(int)fminf(fmaxf(__builtin_rintf(f3 * inv), -127.f), 127.f) & 255u;
            *(unsigned*)(dst + (size_t)n * KK + 4 * lane + 256 * j) = q0 | (q1 << 8) | (q2 << 16) | (q3 << 24); } }
    __syncthreads();
}
template <int NCG>
__device__ __forceinline__ void p0_witem(const Params& P, LAS unsigned char* lds, int dn) {
    const int sn = dn < 6144 ? dn : dn + 8;
    wq_item<NCG, 2048>(lds, P.w_in + sn, 10248, nullptr, P.ws + WS_WIN + (size_t)dn * 2048, (float*)(P.ws + WS_WSC) + dn);
}
__device__ __forceinline__ void rows4_to_i8(const bf16_t* src, unsigned char* dst, float* sc, int r0, int rstep) {
    const int lane = threadIdx.x & 63;
    u32x4 v[4][4];
#pragma unroll
    for (int k = 0; k < 4; ++k)
#pragma unroll
        for (int q = 0; q < 4; ++q) v[k][q] = *((const u32x4*)(src + (size_t)(r0 + k * rstep) * DM) + lane + 64 * q);
#pragma unroll
    for (int k = 0; k < 4; ++k) { const int r = r0 + k * rstep;
        float mx = 0.f;
#pragma unroll
        for (int q = 0; q < 4; ++q)
#pragma unroll
            for (int e = 0; e < 4; ++e) { const unsigned w = v[k][q][e]; mx = fmaxf(mx, fmaxf(fabsf(bf_lo(w)), fabsf(bf_hi(w)))); }
#pragma unroll
        for (int o = 1; o < 64; o <<= 1) mx = fmaxf(mx, __shfl_xor(mx, o));
        mx = fmaxf(mx, 1e-30f); const float inv = 127.f / mx;
        if (lane == 0) sc[r] = mx * (1.f / 127.f);
#pragma unroll
        for (int q = 0; q < 4; ++q) { u32x2 o;
#pragma unroll
            for (int h = 0; h < 2; ++h) { const unsigned w0 = v[k][q][2 * h], w1 = v[k][q][2 * h + 1];
                o[h] = ((unsigned)(int)__builtin_rintf(bf_lo(w0) * inv) & 255u) | (((unsigned)(int)__builtin_rintf(bf_hi(w0) * inv) & 255u) << 8) |
                       (((unsigned)(int)__builtin_rintf(bf_lo(w1) * inv) & 255u) << 16) | (((unsigned)(int)__builtin_rintf(bf_hi(w1) * inv) & 255u) << 24); }
            *((u32x2*)(dst + (size_t)r * DM) + lane + 64 * q) = o; }
    }
}
__device__ __forceinline__ void rows_to_i8(const bf16_t* src, unsigned char* dst, float* sc, int r0, int r1, int rstep) {
    const int lane = threadIdx.x & 63;
    for (int r = r0; r < r1; r += rstep) {
        u32x4 v[4];
#pragma unroll
        for (int q = 0; q < 4; ++q) v[q] = *((const u32x4*)(src + (size_t)r * DM) + lane + 64 * q);
        float f[32], mx = 0.f;
#pragma unroll
        for (int q = 0; q < 4; ++q)
#pragma unroll
            for (int e = 0; e < 4; ++e) { const unsigned w = v[q][e]; f[8 * q + 2 * e] = bf_lo(w); f[8 * q + 2 * e + 1] = bf_hi(w); mx = fmaxf(mx, fmaxf(fabsf(f[8 * q + 2 * e]), fabsf(f[8 * q + 2 * e + 1]))); }
#pragma unroll
        for (int o = 1; o < 64; o <<= 1) mx = fmaxf(mx, __shfl_xor(mx, o));
        mx = fmaxf(mx, 1e-30f); const float inv = 127.f / mx;
        if (lane == 0) sc[r] = mx * (1.f / 127.f);
#pragma unroll
        for (int q = 0; q < 4; ++q) { u32x2 o;
#pragma unroll
            for (int h = 0; h < 2; ++h) { unsigned w = 0;
#pragma unroll
                for (int e = 0; e < 4; ++e) w |= ((unsigned)(int)__builtin_rintf(f[8 * q + 4 * h + e] * inv) & 255u) << (8 * e);
                o[h] = w; }
            *((u32x2*)(dst + (size_t)r * DM) + lane + 64 * q) = o; }
    }
}
__device__ __forceinline__ void p0(const Params& P, LAS unsigned char* lds, int vcu, int G) {
    const int tid = threadIdx.x, lane = tid & 63, wave = __builtin_amdgcn_readfirstlane(tid >> 6);
    const int gw = vcu * NWAVES + wave, NGW = G * NWAVES;
    unsigned char* ws = P.ws;
    const int rstart = gw, rend = T_TOK, rstep = NGW;
    if (G == 256) {
        p0_witem<8>(P, lds, vcu * 32);
        p0_witem<2>(P, lds, 8192 + vcu * 8);
    } else {
        for (int it = vcu; it < 320; it += G) p0_witem<8>(P, lds, it * 32);
    }
    {
        LAS float* wf = (LAS float*)lds;
        for (int k = tid; k < 2048; k += NTHR) { const f32x4 a0 = *(const f32x4*)(P.w_in + (size_t)k * 10248 + 6144), a1 = *(const f32x4*)(P.w_in + (size_t)k * 10248 + 6148);
            wf[k] = a0[0]; wf[2048 + k] = a0[1]; wf[4096 + k] = a0[2]; wf[6144 + k] = a0[3]; wf[8192 + k] = a1[0]; wf[10240 + k] = a1[1]; wf[12288 + k] = a1[2]; wf[14336 + k] = a1[3]; }
        __syncthreads();
        unsigned char* HQ8 = ws + WS_H; float* HSC = (float*)(ws + WS_HSC); float* LOGF = (float*)(ws + WS_LOGF);
        f32x4 xn[8];
        if (rstart < rend) { const f32x4* xr = (const f32x4*)(P.x + (size_t)rstart * DM) + lane;
#pragma unroll
            for (int j = 0; j < 8; ++j) xn[j] = xr[64 * j]; }
        for (int r = rstart; r < rend; r += rstep) {
            float ss = 0.f, amx = 0.f; f32x4 hv[8];
#pragma unroll
            for (int j = 0; j < 8; ++j) { const f32x4 v = xn[j]; const f32x4 gn = *((const f32x4*)P.g_mix + lane + 64 * j); ss += (v[0] * v[0] + v[1] * v[1]) + (v[2] * v[2] + v[3] * v[3]);
                hv[j] = v * gn; amx = fmaxf(amx, fmaxf(fmaxf(fabsf(hv[j][0]), fabsf(hv[j][1])), fmaxf(fabsf(hv[j][2]), fabsf(hv[j][3])))); }
            if (r + rstep < rend) { const f32x4* xr = (const f32x4*)(P.x + (size_t)(r + rstep) * DM) + lane;
#pragma unroll
                for (int j = 0; j < 8; ++j) xn[j] = xr[64 * j]; }
            const float rstd = 1.0f / sqrtf(wave_sum(ss) * (1.f / DM) + EPS);
#pragma unroll
            for (int o = 1; o < 64; o <<= 1) amx = fmaxf(amx, __shfl_xor(amx, o));
            const float hmax = fmaxf(amx * rstd, 1e-30f), hinv = 127.f / hmax;
            float fl[8];
#pragma unroll
            for (int c = 0; c < 8; ++c) fl[c] = 0.f;
            unsigned* hp = (unsigned*)(HQ8 + (size_t)r * DM) + lane;
#pragma unroll
            for (int j = 0; j < 8; ++j) { const f32x4 h = hv[j] * rstd;
                unsigned w = 0;
#pragma unroll
                for (int e = 0; e < 4; ++e) w |= ((unsigned)(int)__builtin_rintf(h[e] * hinv) & 255u) << (8 * e);
                hp[64 * j] = w;
#pragma unroll
                for (int c = 0; c < 8; ++c) { const f32x4 wv = *((const LAS f32x4*)(wf + c * 2048) + lane + 64 * j); fl[c] += (h[0] * wv[0] + h[1] * wv[1]) + (h[2] * wv[2] + h[3] * wv[3]); }
                __builtin_amdgcn_sched_barrier(0); }
            { const bool b5 = (lane >> 5) & 1, b4 = (lane >> 4) & 1, b3 = (lane >> 3) & 1; float p1[4], p2[2], p3;
#pragma unroll
              for (int q = 0; q < 4; ++q) { const float send = b5 ? fl[q] : fl[q + 4], keep = b5 ? fl[q + 4] : fl[q]; p1[q] = keep + __shfl_xor(send, 32); }
#pragma unroll
              for (int q = 0; q < 2; ++q) { const float send = b4 ? p1[q] : p1[q + 2], keep = b4 ? p1[q + 2] : p1[q]; p2[q] = keep + __shfl_xor(send, 16); }
              { const float send = b3 ? p2[0] : p2[1], keep = b3 ? p2[1] : p2[0]; p3 = keep + __shfl_xor(send, 8); }
              p3 += __shfl_xor(p3, 4); p3 += __shfl_xor(p3, 2); p3 += __shfl_xor(p3, 1);
              if (lane == 0) HSC[r] = hmax * (1.f / 127.f);
              if ((lane & 7) == 0) { const int c = lane >> 3; const float y = p3 + P.b_forget[c]; LOGF[((size_t)(r >> 12) * 8 + c) * SEQ + (r & (SEQ - 1))] = fminf(y, 0.f) - log1pf(expf(-fabsf(y))); } }
        }
    }
    {
        const size_t gid = (size_t)vcu * NTHR + tid, gstride = (size_t)G * NTHR;
        for (size_t i = gid; i < 262144 / 8; i += gstride) { const float* src = P.sub_keys + i * 8; const f32x4 a = *(const f32x4*)src, b = *((const f32x4*)src + 1);
            u32x4 o; o.x = pk2(a[0], a[1]); o.y = pk2(a[2], a[3]); o.z = pk2(b[0], b[1]); o.w = pk2(b[2], b[3]); *(u32x4*)((bf16_t*)(ws + WS_SKB) + i * 8) = o; }
    }
}
__device__ __forceinline__ void late_transposes(const Params& P, LAS unsigned char* lds, int vcu, int G) {
    const int tid = threadIdx.x, lane = tid & 63, wave = __builtin_amdgcn_readfirstlane(tid >> 6);
    const int gw = vcu * NWAVES + wave, NGW = G * NWAVES;
    unsigned char* ws = P.ws;
    LAS float* scr = (LAS float*)(lds + wave * 16384);
    constexpr int I_A = 16 * 64, NITEMS = 2 * I_A;
    for (int it = gw; it < NITEMS; it += NGW) {
        int r = it;
        if (r < I_A) { const int kb = r / 64, nb = r % 64; transpose_item(P.w_a, 2048, nb * 32, (bf16_t*)(ws + WS_WAT), 1024, nb * 32, kb * 64, scr, lane, nullptr); continue; } r -= I_A;
        { const int kb = r / 64, nb = r % 64; transpose_item(P.w_b, 2048, nb * 32, (bf16_t*)(ws + WS_WBT), 1024, nb * 32, kb * 64, scr, lane, nullptr); }
    }
}
__device__ __forceinline__ void quantise_expert_rows(const Params& P, int r0, int nrows) {
    const int lane = threadIdx.x & 63;
    unsigned char* ws = P.ws;
    u32x4* REC = (u32x4*)(ws + WS_REC);
    for (int r = r0; r < r0 + nrows; r += 2) {
        f32x4 v[2][8];
#pragma unroll
        for (int t = 0; t < 2; ++t) { const int rr = r + t; const f32x4* src = (const f32x4*)((rr >= 16384 ? P.e_v : P.e_u) + (size_t)(rr & 16383) * DM) + lane;
#pragma unroll
            for (int j = 0; j < 8; ++j) v[t][j] = __builtin_nontemporal_load(src + 64 * j); }
#pragma unroll
        for (int t = 0; t < 2; ++t) { const int rr = r + t; const bool second = rr >= 16384; const int row = rr & 16383;
            float mx = 0.f, sq = 0.f;
#pragma unroll
            for (int j = 0; j < 8; ++j) { mx = fmaxf(mx, fmaxf(fmaxf(fabsf(v[t][j][0]), fabsf(v[t][j][1])), fmaxf(fabsf(v[t][j][2]), fabsf(v[t][j][3])))); sq += (v[t][j][0] * v[t][j][0] + v[t][j][1] * v[t][j][1]) + (v[t][j][2] * v[t][j][2] + v[t][j][3] * v[t][j][3]); }
#pragma unroll
            for (int o = 1; o < 64; o <<= 1) { mx = fmaxf(mx, __shfl_xor(mx, o)); sq += __shfl_xor(sq, o); }
            mx = fmaxf(mx, 1e-30f);
            if (second) {
                const float rng = fmaxf(fminf(mx, UCLIP * sqrtf(sq * (1.f / DM))), 1e-30f), inv = 7.f / rng;
                unsigned char* dst = ws + WS_EV + (size_t)row * 128 + 4 * (lane & 31);
#pragma unroll
                for (int j = 0; j < 8; ++j) { unsigned nb = 0;
#pragma unroll
                    for (int e = 0; e < 4; ++e) { const unsigned n = (unsigned)((int)fminf(fmaxf(__builtin_rintf(v[t][j][e] * inv), -7.f), 7.f) + 8); nb |= n << (8 * e); }
                    const unsigned other = (unsigned)__shfl_xor((int)nb, 32);
                    if (lane < 32) *(unsigned*)(dst + ((size_t)j << 21)) = nb | (other << 4); }
                if (lane == 0) ((float*)(REC + row))[2] = rng * (1.f / 7.f);
            } else {
                const float rng = fmaxf(fminf(mx, UCLIP * sqrtf(sq * (1.f / DM))), 1e-30f), inv = 7.f / rng;
                unsigned char* dst = ws + WS_EU + (size_t)row * 128 + 4 * (lane >> 1);
                unsigned nsum = 0;
#pragma unroll
                for (int j = 0; j < 8; ++j) { unsigned nb = 0;
#pragma unroll
                    for (int e = 0; e < 4; ++e) { const unsigned n = (unsigned)((int)fminf(fmaxf(__builtin_rintf(v[t][j][e] * inv), -7.f), 7.f) + 8); nb |= n << (4 * e); nsum += n; }
                    const unsigned other = (unsigned)__shfl_xor((int)nb, 1);
                    if ((lane & 1) == 0) *(unsigned*)(dst + ((size_t)j << 21)) = nb | (other << 16); }
#pragma unroll
                for (int o = 1; o < 64; o <<= 1) nsum += (unsigned)__shfl_xor((int)nsum, o);
                if (lane == 0) { ((float*)(REC + row))[0] = rng * (1.f / 7.f); ((unsigned*)(REC + row))[1] = nsum; }
            }
        }
    }
}

namespace att {
constexpr int KST = 272, VST = 320;
constexpr int KBUF = 64 * KST, VBUF = 64 * VST;
constexpr int OFF_K = 0, OFF_V = 2 * KBUF, OFF_F = OFF_V + 2 * VBUF, OFF_SC = OFF_F + 4096 * 4;
constexpr int OFF_FLG = OFF_SC + 64, OFF_UNIT = OFF_FLG + 64;
static_assert(OFF_UNIT + 16 <= 131072, "attention LDS");
constexpr float THR_FOX = 20.f, SB_STICK_MIN = 9.5367431640625e-07f  ;

__device__ __forceinline__ void build_cumf(LAS unsigned char* lds, const float* LOGF, int b, int h, int n, int tid, int lane, int wid) {
    LAS float* F2 = (LAS float*)(lds + OFF_F); LAS float* sc = (LAS float*)(lds + OFF_SC);
    const int s0 = tid * 8; float v[8];
    { const f32x4* lp = (const f32x4*)(LOGF + ((size_t)b * 8 + h) * SEQ + s0); f32x4 a0 = {0.f, 0.f, 0.f, 0.f}, a1 = a0; if (s0 < n) { a0 = lp[0]; a1 = lp[1]; }
      v[0] = a0[0] * LOG2E; v[1] = a0[1] * LOG2E; v[2] = a0[2] * LOG2E; v[3] = a0[3] * LOG2E; v[4] = a1[0] * LOG2E; v[5] = a1[1] * LOG2E; v[6] = a1[2] * LOG2E; v[7] = a1[3] * LOG2E; }
#pragma unroll
    for (int i = 1; i < 8; ++i) v[i] += v[i - 1];
    float tot = v[7], inc = tot;
#pragma unroll
    for (int o = 1; o < 64; o <<= 1) { const float t = __shfl_up(inc, o); if (lane >= o) inc += t; }
    if (lane == 63) sc[wid] = inc;
    __syncthreads();
    float base = inc - tot;
#pragma unroll
    for (int w = 0; w < 8; ++w) if (w < wid) base += sc[w];
    if (s0 < n) {
#pragma unroll
        for (int i = 0; i < 8; ++i) F2[s0 + i] = v[i] + base;
    }
    __syncthreads();
}

template <int MIXER>
__device__ __forceinline__ void attn_unit(LAS unsigned char* lds, const bf16_t* Q, const bf16_t* Kg, const bf16_t* Vg, bf16_t* O, int b, int h, int qb, float kmax, int tid, int lane, int wid) {
    const int c = lane & 31, hh = lane >> 5;
    const int t0 = qb * 256 + wid * 32, tq = t0 + c;
    const size_t rowbase = (size_t)b * SEQ;
    size_t qoff = (rowbase + tq) * 1024 + h * HD + 8 * hh;
    f32x16 oacc[4];
#pragma unroll
    for (int d = 0; d < 4; ++d)
#pragma unroll
        for (int r = 0; r < 16; ++r) oacc[d][r] = 0.f;
    float carry = 1.f, mrun = -1e30f, lsum = 0.f; const float nhf = hh ? 0.f : 1.f;
    const LAS float* F2 = (const LAS float*)(lds + OFF_F);
    const float Ft = (MIXER == 1) ? F2[tq] : 0.f;
    float qk_bound = 0.f;
    if (MIXER == 1) { float qs = 0.f;
#pragma unroll
        for (int s2 = 0; s2 < 8; ++s2) { const u32x4 qv = *(const u32x4*)(Q + qoff + 16 * s2);
#pragma unroll
            for (int e = 0; e < 4; ++e) { const float a = bf_lo(qv[e]), b2 = bf_hi(qv[e]); qs += a * a + b2 * b2; } }
        qs += __shfl_xor(qs, 32);
        qk_bound = sqrtf(qs) * kmax; }
    bool wave_done = false;
    volatile LAS unsigned* flg = (volatile LAS unsigned*)(lds + OFF_FLG);
    const int ktmax = 4 * qb + 3;
    const int srow = tid >> 4, scc = tid & 15;
    u32x4 kr[2], vr[2];
#define ATT_LOAD(kt) do { _Pragma("unroll") for (int j = 0; j < 2; ++j) { const size_t g_ = (rowbase + 64 * (kt) + srow + 32 * j) * 1024 + h * HD + scc * 8; \
        kr[j] = *(const u32x4*)(Kg + g_); vr[j] = *(const u32x4*)(Vg + g_); } } while (0)
#define ATT_WRITE(buf) do { _Pragma("unroll") for (int j = 0; j < 2; ++j) { \
        *(LAS u32x4*)(lds + OFF_K + (buf) * KBUF + (srow + 32 * j) * KST + scc * 16) = kr[j]; \
        *(LAS u32x4*)(lds + OFF_V + (buf) * VBUF + (srow + 32 * j) * VST + scc * 16) = vr[j]; } } while (0)
    ATT_LOAD(ktmax); ATT_WRITE(0); __syncthreads();
    int buf = 0;
    for (int kt = ktmax; kt >= 0; --kt) {
        const bool started = (64 * kt <= t0 + 31);
        if (!(started && !wave_done)) { if (kt > 0) ATT_LOAD(kt - 1); }
        if (started && !wave_done) {
            const LAS unsigned char* Kl = lds + OFF_K + buf * KBUF; const LAS unsigned char* Vl = lds + OFF_V + buf * VBUF;
            f32x16 sacc[2];
            asm volatile("" : "+v"(qoff));
            bf16x8 qf[8];
#pragma unroll
            for (int s = 0; s < 8; ++s) qf[s] = *(const bf16x8*)(Q + qoff + 16 * s);
            ATT_LOAD(kt > 0 ? kt - 1 : 0);
#pragma unroll
            for (int sub = 0; sub < 2; ++sub) {
#pragma unroll
                for (int r = 0; r < 16; ++r) sacc[sub][r] = 0.f;
#pragma unroll
                for (int s = 0; s < 8; ++s) { const bf16x8 kf = *(const LAS bf16x8*)(Kl + (32 * sub + c) * KST + (16 * s + 8 * hh) * 2);
                    sacc[sub] = __builtin_amdgcn_mfma_f32_32x32x16_bf16(kf, qf[s], sacc[sub], 0, 0, 0); }
            }
            const bool need_mask = (64 * kt + 63 >= t0);
            bool tile_dead = false;
            if (MIXER == 0) {
#pragma unroll
                for (int sub = 1; sub >= 0; --sub) {
                    float pr[16];
#pragma unroll
                    for (int r = 0; r < 16; ++r) { float a = fexp2(sacc[sub][r]);
                        if (need_mask) { const int sidx = 64 * kt + 32 * sub + (r & 3) + 8 * (r >> 2) + 4 * hh; a = (sidx < tq) ? a : 0.f; }
                        sacc[sub][r] = a; pr[r] = frcp(1.f + a); }
                    float Glo[4], Ghi[4];
#pragma unroll
                    for (int g = 0; g < 4; ++g) { pr[4 * g + 2] *= pr[4 * g + 3]; pr[4 * g + 1] *= pr[4 * g + 2]; pr[4 * g] *= pr[4 * g + 1];
                        const unsigned gu = __builtin_bit_cast(unsigned, pr[4 * g]); const auto rr = __builtin_amdgcn_permlane32_swap(gu, gu, false, false);
                        Glo[g] = __builtin_bit_cast(float, (unsigned)rr[0]); Ghi[g] = __builtin_bit_cast(float, (unsigned)rr[1]); }
                    float E[8];
                    E[7] = carry; E[6] = E[7] * Ghi[3]; E[5] = E[6] * Glo[3]; E[4] = E[5] * Ghi[2]; E[3] = E[4] * Glo[2]; E[2] = E[3] * Ghi[1]; E[1] = E[2] * Glo[1]; E[0] = E[1] * Ghi[0];
                    carry = E[0] * Glo[0];
#pragma unroll
                    for (int g = 0; g < 4; ++g) { const float Eo = E[2 * g + 1] * __builtin_fmaf(nhf, Ghi[g] - 1.f, 1.f);
#pragma unroll
                        for (int i = 0; i < 4; ++i) { const int r = 4 * g + i; sacc[sub][r] = sacc[sub][r] * pr[r] * Eo; } }
                }
            } else {
                float mx = -1e30f;
#pragma unroll
                for (int sub = 0; sub < 2; ++sub)
#pragma unroll
                    for (int g = 0; g < 4; ++g) { const f32x4 fs = *(const LAS f32x4*)(F2 + 64 * kt + 32 * sub + 8 * g + 4 * hh);
#pragma unroll
                        for (int i = 0; i < 4; ++i) { const int r = 4 * g + i; float xv = sacc[sub][r] + (Ft - fs[i]);
                            if (need_mask) { const int sidx = 64 * kt + 32 * sub + 8 * g + 4 * hh + i; xv = (sidx <= tq) ? xv : -1e30f; }
                            sacc[sub][r] = xv; mx = fmaxf(mx, xv); } }
                { const unsigned mu = __builtin_bit_cast(unsigned, mx); const auto rr = __builtin_amdgcn_permlane32_swap(mu, mu, false, false);
                  mx = fmaxf(__builtin_bit_cast(float, (unsigned)rr[0]), __builtin_bit_cast(float, (unsigned)rr[1])); }
                tile_dead = __all(mx - mrun < -THR_FOX);
                if (!tile_dead) {
                const float mnew = fmaxf(mrun, mx);
                const float alpha = fexp2(mrun - mnew);
                float ps = 0.f;
#pragma unroll
                for (int sub = 0; sub < 2; ++sub)
#pragma unroll
                    for (int r = 0; r < 16; ++r) { const float p = fexp2(sacc[sub][r] - mnew); sacc[sub][r] = p; ps += p; }
                lsum = lsum * alpha + ps;
                if (__any(mnew > mrun)) {
#pragma unroll
                    for (int d = 0; d < 4; ++d)
#pragma unroll
                        for (int r = 0; r < 16; ++r) oacc[d][r] *= alpha;
                }
                mrun = mnew;
                }
            }
            if (!tile_dead)
#pragma unroll
            for (int ks = 0; ks < 4; ++ks) { const int sub = ks >> 1, rb = 8 * (ks & 1);
                u32x4 pw; pw.x = pk2(sacc[sub][rb + 0], sacc[sub][rb + 1]); pw.y = pk2(sacc[sub][rb + 2], sacc[sub][rb + 3]); pw.z = pk2(sacc[sub][rb + 4], sacc[sub][rb + 5]); pw.w = pk2(sacc[sub][rb + 6], sacc[sub][rb + 7]);
                const bf16x8 pf = __builtin_bit_cast(bf16x8, pw);
                const LAS unsigned char* vb = Vl + (16 * ks + 4 * hh + ((lane & 15) >> 2)) * VST + (16 * ((lane >> 4) & 1) + 4 * (lane & 3)) * 2;
#pragma unroll
                for (int d = 0; d < 4; ++d) {
                    const s16x4 a0 = __builtin_amdgcn_ds_read_tr16_b64_v4i16((LAS s16x4*)(vb + d * 64));
                    const s16x4 a1 = __builtin_amdgcn_ds_read_tr16_b64_v4i16((LAS s16x4*)(vb + d * 64 + 8 * VST));
                    const bf16x8 af = {a0[0], a0[1], a0[2], a0[3], a1[0], a1[1], a1[2], a1[3]};
                    oacc[d] = __builtin_amdgcn_mfma_f32_32x32x16_bf16(af, pf, oacc[d], 0, 0, 0); }
            }
        }
        if (kt > 0) ATT_WRITE(buf ^ 1);
        if (kt > 0 && started && !wave_done) {
            if (MIXER == 0) wave_done = __all(carry < SB_STICK_MIN);
            else wave_done = __all(qk_bound + (Ft - F2[64 * kt - 1]) - mrun < -THR_FOX);
        }
        if (lane == 0) flg[(kt & 1) * 8 + wid] = wave_done ? 1u : 0u;
        __syncthreads();
        buf ^= 1;
        { unsigned alld = 1u;
#pragma unroll
          for (int w = 0; w < 8; ++w) alld &= flg[(kt & 1) * 8 + w];
          if (alld) break; }
    }
#undef ATT_LOAD
#undef ATT_WRITE
    float inv = 1.f;
    if (MIXER == 1) { const unsigned lu = __builtin_bit_cast(unsigned, lsum); const auto rr = __builtin_amdgcn_permlane32_swap(lu, lu, false, false);
        inv = 1.f / (__builtin_bit_cast(float, (unsigned)rr[0]) + __builtin_bit_cast(float, (unsigned)rr[1])); }
    bf16_t* op = O + (rowbase + tq) * 2048 + 4 * hh;
#pragma unroll
    for (int d = 0; d < 4; ++d)
#pragma unroll
        for (int g = 0; g < 4; ++g) { u32x2 w; w.x = pk2(oacc[d][4 * g] * inv, oacc[d][4 * g + 1] * inv); w.y = pk2(oacc[d][4 * g + 2] * inv, oacc[d][4 * g + 3] * inv);
            *(u32x2*)(op + 32 * d + 8 * g) = w; }
}

__device__ __forceinline__ void attn_phase(const Params& P, LAS unsigned char* lds, int vcu, int G) {
    const int tid = threadIdx.x, lane = tid & 63, wid = __builtin_amdgcn_readfirstlane(tid >> 6);
    unsigned char* ws = P.ws;
    const bf16_t* QKV = (const bf16_t*)(ws + WS_QKV); const size_t TS = (size_t)T_TOK * 1024;
    bf16_t* OAB = (bf16_t*)(ws + WS_H); const float* LOGF = (const float*)(ws + WS_LOGF);
    unsigned* qctr = (unsigned*)(ws + WS_CTL + 196608);
    const unsigned* KMAXW = (const unsigned*)(ws + WS_CTL + 200704);
    volatile LAS unsigned* uw = (volatile LAS unsigned*)(lds + OFF_UNIT);
#ifndef NQ_MASK
#define NQ_MASK 3
#endif
#ifndef QSTATIC
#define QSTATIC 1024
#endif
    unsigned* qctrq = qctr + 32;
    const bool qfirst = (vcu & NQ_MASK) == 0;
    bool a_left = true, q_left = true;
    if (qfirst) { const int nqf = (G + NQ_MASK) / (NQ_MASK + 1);
        for (int c = vcu / (NQ_MASK + 1); c < QSTATIC; c += nqf) quantise_expert_rows(P, c * 16 + wid * 2, 2);
        for (int it = vcu / (NQ_MASK + 1); it < 64; it += nqf) wq_item<8, 2048>(lds, P.w_query + it * 32, 2048, P.g_ffn, ws + WS_WQ + (size_t)it * 32 * 2048, (float*)(ws + WS_WSC2) + it * 32);
        for (int it = vcu / (NQ_MASK + 1); it < 64; it += nqf) wq_item<8, 2048>(lds, P.w_out + it * 32, 2048, nullptr, ws + WS_WOUT + (size_t)it * 32 * 2048, (float*)(ws + WS_WSC2) + 2048 + it * 32); }
    for (;;) {
        const bool takeq = q_left && (qfirst || !a_left);
        if (!takeq && !a_left) break;
        if (tid == 0) uw[0] = atomicAdd(takeq ? qctrq : qctr, 1u);
        __syncthreads();
        const unsigned u = uw[0];
        __syncthreads();
        if (takeq) { if (u >= 2048u - QSTATIC) { q_left = false; continue; } quantise_expert_rows(P, (int)(u + QSTATIC) * 16 + wid * 2, 2); continue; }
        if (u >= 512u) { a_left = false; continue; }
        const int mixer = (u < 256u) ? 1 : 0, v = (int)(u & 255u), qb = 15 - (v >> 4), bh = v & 15, b = bh >> 3, h = bh & 7;
        if (mixer == 0) {
            attn_unit<0>(lds, QKV, QKV + TS, QKV + 2 * TS, OAB + h * HD, b, h, qb, 0.f, tid, lane, wid);
        } else {
            float k2 = 0.f;
#pragma unroll
            for (int w = 0; w < 4; ++w) k2 += __builtin_bit_cast(float, __hip_atomic_load(KMAXW + bh * 4 + w, __ATOMIC_RELAXED, __HIP_MEMORY_SCOPE_AGENT));
            const float kmax = sqrtf(k2) * 1.01f;
            build_cumf(lds, LOGF, b, h, 256 * (qb + 1), tid, lane, wid);
            attn_unit<1>(lds, QKV + 3 * TS, QKV + 4 * TS, QKV + 5 * TS, OAB + 1024 + h * HD, b, h, qb, kmax, tid, lane, wid);
        }
        __syncthreads();
    }
}
}

namespace peer {
__device__ __forceinline__ unsigned sortable(float f) { const unsigned u = __builtin_bit_cast(unsigned, f); return (u & 0x80000000u) ? ~u : (u | 0x80000000u); }
__device__ __forceinline__ float unsortable(unsigned k) { const unsigned u = (k & 0x80000000u) ? (k & 0x7fffffffu) : ~k; return __builtin_bit_cast(float, u); }
#define CE_DESC(x, y) do { const unsigned hi_ = (x) > (y) ? (x) : (y); const unsigned lo_ = (x) > (y) ? (y) : (x); (x) = hi_; (y) = lo_; } while (0)
template <int B, int N> __device__ __forceinline__ void sort16_desc(unsigned (&a)[N]) {
#pragma unroll
    for (int k = 2; k <= 16; k <<= 1)
#pragma unroll
        for (int j = k >> 1; j > 0; j >>= 1)
#pragma unroll
            for (int i = 0; i < 16; ++i) { const int l = i ^ j; if (l > i) { if ((i & k) == 0) CE_DESC(a[B + i], a[B + l]); else CE_DESC(a[B + l], a[B + i]); } }
}
template <int A, int Bq, int N> __device__ __forceinline__ void merge_top16(unsigned (&a)[N]) {
#pragma unroll
    for (int i = 0; i < 16; ++i) { const unsigned x = a[A + i], y = a[Bq + 15 - i]; a[A + i] = x > y ? x : y; }
#pragma unroll
    for (int j = 8; j > 0; j >>= 1)
#pragma unroll
        for (int i = 0; i < 16; ++i) { const int l = i ^ j; if (l > i) CE_DESC(a[A + i], a[A + l]); }
}

__device__ __forceinline__ void topk_phase(const Params& P, LAS unsigned char* lds, int vcu, int G) {
    const int tid = threadIdx.x, lane = tid & 63, wave = __builtin_amdgcn_readfirstlane(tid >> 6);
    const int c = lane & 31, hh = lane >> 5;
    const int gw = vcu * NWAVES + wave, NGW = G * NWAVES;
    unsigned char* ws = P.ws;
    const bf16_t* Q2 = (const bf16_t*)(ws + WS_Q2); const bf16_t* SKB = (const bf16_t*)(ws + WS_SKB);
    const float* ROWSS = (const float*)(ws + WS_CTL); int* IDS = (int*)(ws + WS_IDS); float* GATES = (float*)(ws + WS_GATES);
    LAS unsigned char* scr = lds + wave * 4096;
    const bool shared_head = (G == 256);
    LAS unsigned char* skl = lds + 32768;
    if (shared_head) { const bf16_t* src = SKB + (size_t)(vcu & 7) * 2 * 128 * 128;
#pragma unroll
        for (int q = 0; q < 8; ++q) { const int ch = tid + 512 * q, row = ch >> 4, cc = ch & 15; *(LAS u32x4*)(skl + row * 272 + cc * 16) = *(const u32x4*)(src + row * 128 + cc * 8); }
        __syncthreads(); }
    for (int task = (shared_head ? (((vcu >> 3) * 8 + wave) * 8 + (vcu & 7)) : gw); task < 2048; task += (shared_head ? 1 << 30 : NGW)) {
        const int tg = task >> 3, hd = task & 7, tok = tg * 32 + c;
#pragma unroll 1
        for (int p = 0; p < 2; ++p) {
            bf16x8 qf[8];
            { const bf16_t* qp = Q2 + (size_t)tok * DM + hd * 256 + p * 128 + 8 * hh;
#pragma unroll
              for (int s = 0; s < 8; ++s) qf[s] = *(const bf16x8*)(qp + 16 * s); }
            unsigned keys[64];
#pragma unroll
            for (int sub = 0; sub < 4; ++sub) {
                f32x16 acc;
#pragma unroll
                for (int r = 0; r < 16; ++r) acc[r] = 0.f;
                const bf16_t* kp = SKB + ((size_t)(hd * 2 + p) * 128 + 32 * sub + c) * 128 + 8 * hh;
                if (shared_head) {
#pragma unroll
                    for (int s = 0; s < 8; ++s) { const bf16x8 kf = *(const LAS bf16x8*)(skl + (p * 128 + 32 * sub + c) * 272 + (16 * s + 8 * hh) * 2); acc = __builtin_amdgcn_mfma_f32_32x32x16_bf16(kf, qf[s], acc, 0, 0, 0); } }
                else {
#pragma unroll
                    for (int s = 0; s < 8; ++s) { const bf16x8 kf = *(const bf16x8*)(kp + 16 * s); acc = __builtin_amdgcn_mfma_f32_32x32x16_bf16(kf, qf[s], acc, 0, 0, 0); } }
#pragma unroll
                for (int r = 0; r < 16; ++r) { const int nlo = 127 - (32 * sub + (r & 3) + 8 * (r >> 2)); keys[sub * 16 + r] = (sortable(acc[r]) & ~127u) | (unsigned)(nlo - 4 * hh); }
            }
            sort16_desc<0>(keys); sort16_desc<16>(keys); sort16_desc<32>(keys); sort16_desc<48>(keys);
            merge_top16<0, 16>(keys); merge_top16<32, 48>(keys); merge_top16<0, 32>(keys);
#pragma unroll
            for (int i = 0; i < 16; ++i) { const unsigned own = keys[i]; const auto rr = __builtin_amdgcn_permlane32_swap(own, own, false, false); keys[16 + i] = hh ? (unsigned)rr[0] : (unsigned)rr[1]; }
            merge_top16<0, 16>(keys);
            if (hh == 0) {
#pragma unroll
                for (int w = 0; w < 4; ++w) *(LAS u32x4*)(scr + (c * 2 + p) * 64 + w * 16) = (u32x4){keys[4 * w], keys[4 * w + 1], keys[4 * w + 2], keys[4 * w + 3]};
            }
        }
        LDS_WAIT();
        float s1[16], s2[16];
#pragma unroll
        for (int w = 0; w < 4; ++w) { const u32x4 a = *(const LAS u32x4*)(scr + (c * 2) * 64 + w * 16), b2 = *(const LAS u32x4*)(scr + (c * 2 + 1) * 64 + w * 16);
#pragma unroll
            for (int e = 0; e < 4; ++e) { s1[4 * w + e] = unsortable((a[e] & ~127u) | 64u); s2[4 * w + e] = unsortable((b2[e] & ~127u) | 64u); } }
        unsigned ck[64];
        { int n = 0;
#pragma unroll
          for (int i = 0; i < 16; ++i)
#pragma unroll
              for (int j = 0; j < 16; ++j) if ((i + 1) * (j + 1) <= 16) { ck[n] = (sortable(s1[i] + s2[j]) & ~255u) | (unsigned)(255 - (i * 16 + j)); ++n; }
#pragma unroll
          for (int q = 50; q < 64; ++q) ck[q] = 0u; }
        sort16_desc<0>(ck); sort16_desc<16>(ck); sort16_desc<32>(ck); sort16_desc<48>(ck);
        merge_top16<0, 16>(ck); merge_top16<32, 48>(ck); merge_top16<0, 32>(ck);
        unsigned t2[16];
#pragma unroll
        for (int k = 0; k < 16; ++k) t2[k] = ck[k];
        int ids[16]; float sc[16];
#pragma unroll
        for (int k = 0; k < 16; ++k) { const unsigned pos = 255u - (t2[k] & 255u);
            const unsigned k1 = *(const LAS unsigned*)(scr + (c * 2) * 64 + (pos >> 4) * 4), k2 = *(const LAS unsigned*)(scr + (c * 2 + 1) * 64 + (pos & 15u) * 4);
            ids[k] = (int)((127u - (k1 & 127u)) * 128u + (127u - (k2 & 127u))); sc[k] = unsortable((t2[k] & ~255u) | 128u); }
        LDS_WAIT();
        const float rs = 1.0f / sqrtf(ROWSS[tok] * (1.f / DM) + EPS);
        float ev[16], Z = 0.f;
#pragma unroll
        for (int k = 0; k < 16; ++k) { ev[k] = fexp2((sc[k] - sc[0]) * rs * LOG2E); Z += ev[k]; }
        const float iz = 1.f / Z;
        int* ip = IDS + (size_t)tok * 128 + hd * 16; float* gp = GATES + (size_t)tok * 128 + hd * 16;
        if (hh == 0) {
#pragma unroll
            for (int k = 0; k < 8; ++k) { ip[k] = ids[k]; gp[k] = ev[k] * iz; }
        } else {
#pragma unroll
            for (int k = 8; k < 16; ++k) { ip[k] = ids[k]; gp[k] = ev[k] * iz; }
        }
    }
}


__device__ __forceinline__ float dot8(u32x4 a, u32x4 b, float acc) {
    const unsigned a0 = a[0], a1 = a[1], a2 = a[2], a3 = a[3], b0 = b[0], b1 = b[1], b2 = b[2], b3 = b[3];
    acc = __builtin_amdgcn_fdot2_f32_bf16(__builtin_bit_cast(bf16v2, a0), __builtin_bit_cast(bf16v2, b0), acc, false);
    acc = __builtin_amdgcn_fdot2_f32_bf16(__builtin_bit_cast(bf16v2, a1), __builtin_bit_cast(bf16v2, b1), acc, false);
    acc = __builtin_amdgcn_fdot2_f32_bf16(__builtin_bit_cast(bf16v2, a2), __builtin_bit_cast(bf16v2, b2), acc, false);
    acc = __builtin_amdgcn_fdot2_f32_bf16(__builtin_bit_cast(bf16v2, a3), __builtin_bit_cast(bf16v2, b3), acc, false);
    return acc;
}
__device__ __forceinline__ float gelu_tanh(float a) { const float t = 1.5957691216f * (a + 0.044715f * a * a * a); return a * frcp(1.f + fexp2(-LOG2E * t)); }

__device__ __forceinline__ int dot16(u32x4 a, u32x4 b, int acc) {
    acc = __builtin_amdgcn_sdot4((int)a[0], (int)b[0], acc, false); acc = __builtin_amdgcn_sdot4((int)a[1], (int)b[1], acc, false);
    acc = __builtin_amdgcn_sdot4((int)a[2], (int)b[2], acc, false); acc = __builtin_amdgcn_sdot4((int)a[3], (int)b[3], acc, false);
    return acc;
}
__device__ __forceinline__ void gather_sweep(const Params& P, LAS unsigned char* lds, int vcu, int G) {
    const int tid = threadIdx.x, lane = tid & 63, wave = __builtin_amdgcn_readfirstlane(tid >> 6);
    const int gw = vcu * NWAVES + wave, NGW = G * NWAVES;
    const int g = lane >> 3, i = lane & 7;
    unsigned char* ws = P.ws;
    const bf16_t* X1B = (const bf16_t*)(ws + WS_X1B); const float* ROWSS = (const float*)(ws + WS_CTL);
    const int* IDS = (const int*)(ws + WS_IDS); const float* GATES = (const float*)(ws + WS_GATES);
    const unsigned char* EU = ws + WS_EU; const unsigned char* EV = ws + WS_EV;
    const u32x4* REC = (const u32x4*)(ws + WS_REC);
    LAS unsigned char* wl = lds + wave * 19456;
    const bool b2 = (lane >> 2) & 1, b1 = (lane >> 1) & 1, b0 = lane & 1, B2 = (lane >> 5) & 1, B1 = (lane >> 4) & 1, B0 = (lane >> 3) & 1;
    for (int tg = gw; tg < T_TOK / 4; tg += NGW) {
        const int tok0 = tg * 4;
        float hs[4]; int hsum[4];
#pragma unroll
        for (int j = 0; j < 4; ++j) { const int tok = tok0 + j;
            const float rs = 1.0f / sqrtf(ROWSS[tok] * (1.f / DM) + EPS);
            f32x4 hv[8]; float hmx = 0.f;
#pragma unroll
            for (int q = 0; q < 8; ++q) { const u32x2 xb = *((const u32x2*)(X1B + (size_t)tok * DM) + lane + 64 * q); const f32x4 xv = {bf_lo(xb[0]), bf_hi(xb[0]), bf_lo(xb[1]), bf_hi(xb[1])}; const f32x4 gn = *((const f32x4*)P.g_ffn + lane + 64 * q);
                hv[q] = xv * rs * gn; hmx = fmaxf(hmx, fmaxf(fmaxf(fabsf(hv[q][0]), fabsf(hv[q][1])), fmaxf(fabsf(hv[q][2]), fabsf(hv[q][3])))); }
#pragma unroll
            for (int o = 1; o < 64; o <<= 1) hmx = fmaxf(hmx, __shfl_xor(hmx, o));
            hmx = fmaxf(hmx, 1e-30f); const float hinv = 127.f / hmx; hs[j] = hmx * (1.f / 127.f);
            int hq_sum = 0;
#pragma unroll
            for (int q = 0; q < 8; ++q) { unsigned wlo = 0, whi = 0;
#pragma unroll
                for (int e = 0; e < 4; ++e) { const int hq = (int)__builtin_rintf(hv[q][e] * hinv); hq_sum += hq; const unsigned hb = (unsigned)(hq + 128); wlo |= (hb & 15u) << (4 * e); whi |= (hb >> 4) << (4 * e); }
                const unsigned olo = (unsigned)__shfl_xor((int)wlo, 1), ohi = (unsigned)__shfl_xor((int)whi, 1);
                if ((lane & 1) == 0) { LAS unsigned* hp = (LAS unsigned*)(wl + 2560 + j * 2048) + (lane >> 1) + 32 * q; hp[0] = wlo | (olo << 16); hp[256] = whi | (ohi << 16); } }
#pragma unroll
            for (int o = 1; o < 64; o <<= 1) hq_sum += __shfl_xor(hq_sum, o);
            hsum[j] = hq_sum;
#pragma unroll
            for (int hf = 0; hf < 2; ++hf) { const int k = lane + 64 * hf; const int id = IDS[(size_t)tok * 128 + k];
                *(LAS unsigned*)(wl + (j * 128 + k) * 4) = (unsigned)id * 128u;
                const u32x4 rec = REC[id];
                *(LAS float*)(wl + 10752 + (j * 128 + k) * 4) = GATES[(size_t)tok * 128 + k] * __uint_as_float(rec[2]);
                *(LAS unsigned*)(wl + 12800 + (j * 128 + k) * 4) = rec[0]; *(LAS unsigned*)(wl + 19456 - 2048 + (j * 128 + k) * 4) = rec[1]; }
        }
        LDS_WAIT();
        unsigned accu[4][16];
#pragma unroll
        for (int j = 0; j < 4; ++j)
#pragma unroll
            for (int m = 0; m < 16; ++m) accu[j][m] = 0u;
        const unsigned i16 = 16u * (unsigned)i;
#define US_LOADG(sl_, j_, mg_) do { unsigned long long ub64_ = (unsigned long long)(EU + ((size_t)(sl_) << 21)); ub64_ = uniform64(ub64_); const GAS unsigned char* ub_ = (const GAS unsigned char*)ub64_; \
            _Pragma("unroll") for (int q = 0; q < 4; ++q) { const int m = 4 * (mg_) + q; const unsigned off = *(const LAS unsigned*)(wl + ((j_) * 128 + 8 * m + g) * 4) + i16; du[m] = *(const GAS u32x4*)(ub_ + off); } \
            __builtin_amdgcn_sched_barrier(0); } while (0)
#define US_COMPG(sl_, j_, mg_) do { \
            asm volatile("" : "+v"(du[4 * (mg_)]), "+v"(du[4 * (mg_) + 1]), "+v"(du[4 * (mg_) + 2]), "+v"(du[4 * (mg_) + 3]) :: "memory"); \
            if ((mg_) == 0) { hl = *(const LAS u32x4*)(wl + 2560 + (j_) * 2048 + 128 * (sl_) + 16 * i); hh = *(const LAS u32x4*)(wl + 2560 + (j_) * 2048 + 1024 + 128 * (sl_) + 16 * i); } \
            _Pragma("unroll") for (int q = 0; q < 4; ++q) { const int m = 4 * (mg_) + q; const u32x4 d = du[m]; \
                unsigned tl = __builtin_amdgcn_udot8(d[0], hl[0], accu[j_][m], false); tl = __builtin_amdgcn_udot8(d[1], hl[1], tl, false); tl = __builtin_amdgcn_udot8(d[2], hl[2], tl, false); tl = __builtin_amdgcn_udot8(d[3], hl[3], tl, false); \
                unsigned th = __builtin_amdgcn_udot8(d[0], hh[0], 0u, false); th = __builtin_amdgcn_udot8(d[1], hh[1], th, false); th = __builtin_amdgcn_udot8(d[2], hh[2], th, false); th = __builtin_amdgcn_udot8(d[3], hh[3], th, false); \
                accu[j_][m] = tl + (th << 4); } \
            __builtin_amdgcn_sched_barrier(0); } while (0)
#define US_STEP(sl_, j_, sn_, jn_) do { \
            US_COMPG(sl_, j_, 0); US_LOADG(sn_, jn_, 0); US_COMPG(sl_, j_, 1); US_LOADG(sn_, jn_, 1); US_COMPG(sl_, j_, 2); US_LOADG(sn_, jn_, 2); US_COMPG(sl_, j_, 3); US_LOADG(sn_, jn_, 3); } while (0)
        {
            u32x4 du[16]; u32x4 hl, hh;
            US_LOADG(0, 0, 0); US_LOADG(0, 0, 1); US_LOADG(0, 0, 2); US_LOADG(0, 0, 3);
#pragma unroll 1
            for (int sl = 0; sl < 8; ++sl) {
                const int sln = sl < 7 ? sl + 1 : 7;
                US_STEP(sl, 0, sl, 1);
                US_STEP(sl, 1, sl, 2);
                US_STEP(sl, 2, sl, 3);
                __syncthreads();
                US_STEP(sl, 3, sln, 0);
            }
        }
#undef US_LOADG
#undef US_COMPG
#undef US_STEP
        float sw[4]; int wsum[4];
#pragma unroll
        for (int j = 0; j < 4; ++j) {
            int r1[8], r2[4], r3[2];
#pragma unroll
            for (int m = 0; m < 8; ++m) { const int send = (int)(b2 ? accu[j][m] : accu[j][m + 8]), keep = (int)(b2 ? accu[j][m + 8] : accu[j][m]); r1[m] = keep + __shfl_xor(send, 4); }
#pragma unroll
            for (int m = 0; m < 4; ++m) { const int send = b1 ? r1[m] : r1[m + 4], keep = b1 ? r1[m + 4] : r1[m]; r2[m] = keep + __shfl_xor(send, 2); }
#pragma unroll
            for (int m = 0; m < 2; ++m) { const int send = b0 ? r2[m] : r2[m + 2], keep = b0 ? r2[m + 2] : r2[m]; r3[m] = keep + __shfl_xor(send, 1); }
            float w2[2], wmx = 0.f;
#pragma unroll
            for (int m = 0; m < 2; ++m) { const int k = 16 * i + 8 * m + g;
                const int dq = r3[m] - 128 * (int)*(const LAS unsigned*)(wl + 19456 - 2048 + (j * 128 + k) * 4) - 8 * hsum[j];
                const float act = (float)dq * (hs[j] * *(const LAS float*)(wl + 12800 + (j * 128 + k) * 4));
                w2[m] = *(const LAS float*)(wl + 10752 + (j * 128 + k) * 4) * gelu_tanh(act); wmx = fmaxf(wmx, fabsf(w2[m])); }
#pragma unroll
            for (int o = 1; o < 64; o <<= 1) wmx = fmaxf(wmx, __shfl_xor(wmx, o));
            wmx = fmaxf(wmx, 1e-30f); sw[j] = wmx * (1.f / 127.f);
            const float winv = 127.f / wmx;
            const unsigned q0 = (unsigned)(int)__builtin_rintf(w2[0] * winv) & 255u, q1 = (unsigned)(int)__builtin_rintf(w2[1] * winv) & 255u;
            *(LAS unsigned short*)(wl + 2048 + j * 128 + 16 * g + 2 * i) = (unsigned short)(q0 | (q1 << 8));
            { int ws_ = (int)__builtin_rintf(w2[0] * winv) + (int)__builtin_rintf(w2[1] * winv);
#pragma unroll
              for (int o = 1; o < 64; o <<= 1) ws_ += __shfl_xor(ws_, o);
              wsum[j] = ws_; }
        }
        LDS_WAIT();
        float ssq[4] = {0.f, 0.f, 0.f, 0.f};
        unsigned* X2P = (unsigned*)(ws + WS_TMP);
        const int kg = lane >> 4, j16 = lane & 15;
        LAS unsigned char* tile = wl + 2560;
        const unsigned troff = (unsigned)((j16 >> 1) * 1040 + kg * 128 + 8 * (j16 & 1));
        const unsigned wla = (unsigned)(size_t)wl, tla = wla + 2560u + troff, wlg = wla + 4u * (unsigned)g, wlk = wla + 16u * (unsigned)kg;
#define VM_ISSUE(sl_, j_, kh_, XV) do { unsigned long long vb64_ = (unsigned long long)(EV + ((size_t)(sl_) << 21)); vb64_ = uniform64(vb64_); const GAS unsigned char* vb_ = (const GAS unsigned char*)vb64_; \
            if ((kh_) == 0) { const GAS bf16_t* xp_ = (const GAS bf16_t*)(X1B + (size_t)(tok0 + (j_)) * DM + 256 * (sl_)) + lane; XV[0] = xp_[0]; XV[1] = xp_[64]; XV[2] = xp_[128]; XV[3] = xp_[192]; } \
            unsigned o_[8]; \
            LDSA_B32(o_[0], wlg, (j_) * 512 + (kh_) * 256 + 0);  LDSA_B32(o_[1], wlg, (j_) * 512 + (kh_) * 256 + 32);  LDSA_B32(o_[2], wlg, (j_) * 512 + (kh_) * 256 + 64);  LDSA_B32(o_[3], wlg, (j_) * 512 + (kh_) * 256 + 96); \
            LDSA_B32(o_[4], wlg, (j_) * 512 + (kh_) * 256 + 128); LDSA_B32(o_[5], wlg, (j_) * 512 + (kh_) * 256 + 160); LDSA_B32(o_[6], wlg, (j_) * 512 + (kh_) * 256 + 192); LDSA_B32(o_[7], wlg, (j_) * 512 + (kh_) * 256 + 224); \
            asm volatile("s_waitcnt lgkmcnt(0)" : "+v"(o_[0]), "+v"(o_[1]), "+v"(o_[2]), "+v"(o_[3]), "+v"(o_[4]), "+v"(o_[5]), "+v"(o_[6]), "+v"(o_[7]) :: "memory"); \
            _Pragma("unroll") for (int mp = 0; mp < 8; ++mp) \
                __builtin_amdgcn_global_load_lds((const unsigned*)(vb_ + (o_[mp] + i16)), (LAS unsigned*)(tile + (kh_) * 8320 + mp * 1040), 16, 0, 0); \
            __builtin_amdgcn_sched_barrier(0); } while (0)
#define VM_TR4(hb_, kh_) \
                LDSA_TR8(b_[0], tla, (kh_) * 8320 + 64 * (hb_) + 0);  LDSA_TR8(b_[1], tla, (kh_) * 8320 + 64 * (hb_) + 512); \
                LDSA_TR8(b_[2], tla, (kh_) * 8320 + 64 * (hb_) + 16); LDSA_TR8(b_[3], tla, (kh_) * 8320 + 64 * (hb_) + 528); \
                LDSA_TR8(b_[4], tla, (kh_) * 8320 + 64 * (hb_) + 32); LDSA_TR8(b_[5], tla, (kh_) * 8320 + 64 * (hb_) + 544); \
                LDSA_TR8(b_[6], tla, (kh_) * 8320 + 64 * (hb_) + 48); LDSA_TR8(b_[7], tla, (kh_) * 8320 + 64 * (hb_) + 560)
#define VM_MMA4(hb_) do { \
                asm volatile("s_waitcnt lgkmcnt(0)" : "+v"(aw0), "+v"(aw1), "+v"(b_[0]), "+v"(b_[1]), "+v"(b_[2]), "+v"(b_[3]), "+v"(b_[4]), "+v"(b_[5]), "+v"(b_[6]), "+v"(b_[7]) :: "memory"); \
                _Pragma("unroll") for (int c = 0; c < 4; ++c) { const bool on = (j16 == 4 * c); \
                    const i32x4 Av = {on ? (int)aw0[0] : 0, on ? (int)aw0[1] : 0, on ? (int)aw1[0] : 0, on ? (int)aw1[1] : 0}; \
                    const i32x4 Bp = {b_[2 * c][0], b_[2 * c][1], b_[2 * c + 1][0], b_[2 * c + 1][1]}; \
                    const i32x4 Bl = Bp & 0x0F0F0F0F, Bh = (Bp >> 4) & 0x0F0F0F0F;       \
                    accl[hb_] = __builtin_amdgcn_mfma_i32_16x16x64_i8(Av, Bl, accl[hb_], 0, 0, 0); \
                    acch[hb_] = __builtin_amdgcn_mfma_i32_16x16x64_i8(Av, Bh, acch[hb_], 0, 0, 0); } } while (0)
#define VM_COMP(j_, kh_) do { \
            u32x2 aw0, aw1; i32x2 b_[8]; \
            LDSA_B64(aw0, wlk, 2048 + (j_) * 128 + 8 * (kh_)); LDSA_B64(aw1, wlk, 2048 + (j_) * 128 + 64 + 8 * (kh_)); \
            VM_TR4(0, kh_); VM_MMA4(0); \
            VM_TR4(1, kh_); VM_MMA4(1); \
            __builtin_amdgcn_sched_barrier(0); } while (0)
#define VM_FIN(sl_, j_, X0, X1, X2, X3) do { \
            const int cw = 8 * wsum[j_]; \
            const float y0 = bf_lo((unsigned)X0) + sw[j_] * (float)(accl[0][0] - cw), y1 = bf_lo((unsigned)X1) + sw[j_] * (float)(accl[1][0] - cw); \
            const float y2 = bf_lo((unsigned)X2) + sw[j_] * (float)(acch[0][0] - cw), y3 = bf_lo((unsigned)X3) + sw[j_] * (float)(acch[1][0] - cw); \
            ssq[j_] += (y0 * y0 + y1 * y1) + (y2 * y2 + y3 * y3); \
            unsigned* xp2_ = X2P + (((size_t)(tok0 + (j_)) * 8 + (sl_)) * 2) * 64 + lane; xp2_[0] = pk2(y0, y1); xp2_[64] = pk2(y2, y3); \
            accl[0] = (i32x4){0, 0, 0, 0}; accl[1] = (i32x4){0, 0, 0, 0}; acch[0] = (i32x4){0, 0, 0, 0}; acch[1] = (i32x4){0, 0, 0, 0}; \
            __builtin_amdgcn_sched_barrier(0); } while (0)
#define VM_WAIT(n) asm volatile("s_waitcnt vmcnt(" #n ")" ::: "memory")
        i32x4 accl[2] = {{0, 0, 0, 0}, {0, 0, 0, 0}}, acch[2] = {{0, 0, 0, 0}, {0, 0, 0, 0}};
        bf16_t xe[4] = {0, 0, 0, 0}, xo[4] = {0, 0, 0, 0};
        VM_ISSUE(0, 0, 0, xe);
#pragma unroll 1
        for (int sl = 0; sl < 8; ++sl) {
            const int sln = sl < 7 ? sl + 1 : 7;
            __syncthreads();
            VM_ISSUE(sl, 0, 1, xe); VM_WAIT(8);  VM_COMP(0, 0);
            VM_ISSUE(sl, 1, 0, xo); VM_WAIT(12); VM_COMP(0, 1); VM_FIN(sl, 0, xe[0], xe[1], xe[2], xe[3]);
            VM_ISSUE(sl, 1, 1, xo); VM_WAIT(8);  VM_COMP(1, 0);
            VM_ISSUE(sl, 2, 0, xe); VM_WAIT(12); VM_COMP(1, 1); VM_FIN(sl, 1, xo[0], xo[1], xo[2], xo[3]);
            VM_ISSUE(sl, 2, 1, xe); VM_WAIT(8);  VM_COMP(2, 0);
            VM_ISSUE(sl, 3, 0, xo); VM_WAIT(12); VM_COMP(2, 1); VM_FIN(sl, 2, xe[0], xe[1], xe[2], xe[3]);
            VM_ISSUE(sl, 3, 1, xo); VM_WAIT(8);  VM_COMP(3, 0);
            VM_ISSUE(sln, 0, 0, xe); VM_WAIT(12); VM_COMP(3, 1); VM_FIN(sl, 3, xo[0], xo[1], xo[2], xo[3]);
        }
#undef VM_ISSUE
#undef VM_COMP
#undef VM_TR4
#undef VM_MMA4
#undef VM_FIN
        float rs2[4];
#pragma unroll
        for (int j = 0; j < 4; ++j) rs2[j] = 1.0f / sqrtf(wave_sum(ssq[j]) * (1.f / DM) + EPS);
        VM_WAIT(0);
#undef VM_WAIT
#pragma unroll 2
        for (int sl = 0; sl < 8; ++sl) { const float gn0 = P.g_final[256 * sl + lane], gn1 = P.g_final[256 * sl + 64 + lane], gn2 = P.g_final[256 * sl + 128 + lane], gn3 = P.g_final[256 * sl + 192 + lane];
#pragma unroll
            for (int j = 0; j < 4; ++j) { const unsigned* xp2 = X2P + (((size_t)(tok0 + j) * 8 + sl) * 2) * 64 + lane; const unsigned w0 = xp2[0], w1 = xp2[64];
                float* op = P.out + (size_t)(tok0 + j) * DM + 256 * sl + lane;
                op[0] = bf_lo(w0) * rs2[j] * gn0; op[64] = bf_hi(w0) * rs2[j] * gn1; op[128] = bf_lo(w1) * rs2[j] * gn2; op[192] = bf_hi(w1) * rs2[j] * gn3; } }
        LDS_WAIT();
    }
}

}


#define XB_TMO      128
#define XB_XCNT(j)  (256  + 64 * (j))
#define XB_XSUB(j)  (1280 + 64 * (j))
#define XB_XGEN(j)  (2304 + 64 * (j))
#define XB_TOP      3328
#define XB_TOPGEN   3392
#define XCD_BAR_WORDS 3456
#define XB_SPIN_CAP (1u << 18)
__device__ __forceinline__ unsigned xb_ld(unsigned* p)              { return __hip_atomic_load(p, __ATOMIC_RELAXED, __HIP_MEMORY_SCOPE_AGENT); }
__device__ __forceinline__ unsigned xb_add(unsigned* p, unsigned v) { return __hip_atomic_fetch_add(p, v, __ATOMIC_RELAXED, __HIP_MEMORY_SCOPE_AGENT); }
__device__ __forceinline__ unsigned xb_xcc_id() { return (unsigned)__builtin_amdgcn_s_getreg((3 << 11) | 20) & 0xFu; }
#define XB_SPIN(cond, bar) do { unsigned _sp = 0; while (cond) { __builtin_amdgcn_s_sleep(1); \
    if ((++_sp & 255u) == 0u) { if (xb_ld(&(bar)[XB_TMO])) break; if (_sp > XB_SPIN_CAP) { atomicAdd(&(bar)[XB_TMO], 1u); break; } } } } while (0)
struct XcdBarrier { unsigned* bar; unsigned x; volatile LAS unsigned* st; };
__device__ __forceinline__ XcdBarrier xcd_barrier_post(unsigned* bar, volatile LAS unsigned* st) {
    XcdBarrier b; b.bar = bar; b.x = xb_xcc_id(); b.st = st;
    if (threadIdx.x == 0) (void)xb_add(&bar[XB_XCNT(b.x)], 1u);
    return b;
}
__device__ __forceinline__ void xcd_barrier_complete(unsigned* bar, unsigned x, unsigned& nloc, unsigned& nx) {
    const unsigned G = gridDim.x * gridDim.y * gridDim.z;
    unsigned sum, cnt, mine, sp = 0u;
    for (;;) {
        sum = 0u; cnt = 0u; mine = 0u;
#pragma unroll
        for (unsigned j = 0; j < 16; ++j) { const unsigned c = xb_ld(&bar[XB_XCNT(j)]); sum += c; cnt += (c > 0u) ? 1u : 0u; mine = (j == x) ? c : mine; }
        if (sum == G) break;
        __builtin_amdgcn_s_sleep(1);
        if ((++sp & 255u) == 0u) { if (xb_ld(&bar[XB_TMO])) break; if (sp > XB_SPIN_CAP) { atomicAdd(&bar[XB_TMO], 1u); break; } }
    }
    nloc = mine > 0u ? mine : 1u; nx = cnt > 0u ? cnt : 1u;
}
__device__ __forceinline__ void xcd_barrier(const XcdBarrier& b) {
    asm volatile("s_waitcnt vmcnt(0)" ::: "memory");
    __syncthreads();
    if (threadIdx.x == 0) {
        unsigned* bar = b.bar;
        __builtin_amdgcn_s_waitcnt(0);
        unsigned nloc = b.st[0], nx = b.st[1];
        if (nloc == 0u) { xcd_barrier_complete(bar, b.x, nloc, nx); b.st[0] = nloc; b.st[1] = nx; }
        const unsigned old = xb_add(&bar[XB_XSUB(b.x)], 1u);
        const unsigned gen = old / nloc;
        if (old + 1u == (gen + 1u) * nloc) {
            __builtin_amdgcn_fence(__ATOMIC_RELEASE, "agent");
            asm volatile("s_waitcnt vmcnt(0)" ::: "memory");
            const unsigned og = xb_add(&bar[XB_TOP], 1u);
            const unsigned tg = og / nx;
            if (og + 1u == (tg + 1u) * nx) xb_add(&bar[XB_TOPGEN], 1u);
            else XB_SPIN(xb_ld(&bar[XB_TOPGEN]) == tg, bar);
            __builtin_amdgcn_fence(__ATOMIC_ACQUIRE, "agent");
            xb_add(&bar[XB_XGEN(b.x)], 1u);
            asm volatile("s_waitcnt vmcnt(0)" ::: "memory");
        } else {
            XB_SPIN(xb_ld(&bar[XB_XGEN(b.x)]) == gen, bar);
            __builtin_amdgcn_fence(__ATOMIC_ACQUIRE, "agent");
            asm volatile("s_waitcnt vmcnt(0)" ::: "memory");
        }
    }
    __syncthreads();
}

__device__ __forceinline__ void group_barrier(unsigned* ctr, unsigned gen, unsigned members = 8u) {
    asm volatile("s_waitcnt vmcnt(0)" ::: "memory");
    __syncthreads();
    if (threadIdx.x == 0) {
        const unsigned old = xb_add(ctr, 1u);
        if (old + 1u == members * gen) (void)xb_add(ctr + 32, 1u);
        else { unsigned sp = 0u; while (xb_ld(ctr + 32) < gen) { __builtin_amdgcn_s_sleep(1); if (++sp > (1u << 24)) break; } }
        __builtin_amdgcn_fence(__ATOMIC_ACQUIRE, "agent");
        asm volatile("s_waitcnt vmcnt(0)" ::: "memory");
    }
    __syncthreads();
}
__device__ __forceinline__ bool group_purity(unsigned* pur) {
    bool ok = true;
#pragma unroll
    for (int j = 0; j < 8; ++j) { const unsigned w = xb_ld(pur + j); ok = ok && (w != 0u) && ((w & (w - 1u)) == 0u); }
    return ok;
}

__global__ void __launch_bounds__(NTHR, 2) mega_fwd(Params P) {
    extern __shared__ __attribute__((aligned(16))) unsigned char lds_raw[];
    LAS unsigned char* lds = (LAS unsigned char*)lds_raw;
    cg::grid_group grid = cg::this_grid();
    const int G = gridDim.x, bx = blockIdx.x;
    const int vcu = (G % 8 == 0) ? (bx % 8) * (G / 8) + bx / 8 : bx;
    unsigned char* ws = P.ws;
#ifndef ONLY_PHASE
#define ONLY_PHASE -1
#endif
#define IN(k) ((ONLY_PHASE < 0 || ONLY_PHASE == (k)) && P.ph_lo <= (k) && (k) < P.ph_hi)
    volatile LAS unsigned* bst = (volatile LAS unsigned*)(lds + LDS_BYTES - 64);
    if (threadIdx.x < 16) bst[threadIdx.x] = 0u;
    __syncthreads();
    const XcdBarrier xbar = xcd_barrier_post((unsigned*)(ws + WS_CTL + 131072), bst);
    if (threadIdx.x == 0) (void)__hip_atomic_fetch_or((unsigned*)(ws + WS_CTL + 147456 + 4096) + (bx & 7), 1u << xbar.x, __ATOMIC_RELAXED, __HIP_MEMORY_SCOPE_AGENT);
    if (P.ph_lo < 0) grid.sync();
#define SEAM(k) do { if (IN(k) && IN((k) + 1)) xcd_barrier(xbar); } while (0)
    int pm_ = 0, pn_ = 0;
    if (G == 256) { pg8::StaticOrder S; S.init(T_TOK, DM, G, bx, WGM2); pg8::Unit u; S.next(0, u); pm_ = u.pm; pn_ = u.pn; }
    const int vcu67 = (G == 256) ? pm_ * 8 + pn_ : vcu;
    unsigned* gctr = (unsigned*)(ws + WS_CTL + 147456 + 8192) + 64 * pm_; unsigned* gpur = (unsigned*)(ws + WS_CTL + 147456 + 4096); unsigned lgen = 0u; int lmode = -1;
#define SEAM_L(k, own) do { if (IN(k) && IN((k) + 1)) { if (lmode < 0) lmode = (G == 256 && IN(0) && group_purity(gpur)) ? 1 : 0; \
        if (!lmode) xcd_barrier(xbar); else if (own) { asm volatile("s_waitcnt vmcnt(0)" ::: "memory"); __syncthreads(); } else { ++lgen; group_barrier(gctr, lgen); } } } while (0)
#define SEAM_X() do { if (lmode < 0) lmode = (G == 256 && IN(0) && group_purity(gpur)) ? 1 : 0; if (!lmode) xcd_barrier(xbar); else { ++lgen; group_barrier(gctr, lgen); } } while (0)
    if (IN(0)) p0(P, lds, vcu, G);
    SEAM(0);
    if (IN(1)) {
        pg8::Gemm g{ws + WS_H, ws + WS_WIN, T_TOK, 10240, 2048, 2048, 2048};
        pg8::StaticOrder S; S.init(T_TOK, 10240, G, bx, WGM1);
        pg8::EpiProj E{(bf16_t*)(ws + WS_QKV), (bf16_t*)(ws + WS_SG), LOG2E * 0.08838834764831845f, (unsigned*)(ws + WS_CTL + 200704), (const float*)(ws + WS_HSC), (const float*)(ws + WS_WSC)};
        pg8::gemm_phase<pg8::EpiProj, true>(lds, g, S, E);
    }
    SEAM(1);
    if (IN(2)) { att::attn_phase(P, lds, vcu, G); __syncthreads(); late_transposes(P, lds, vcu, G); }
    SEAM(2);
    if (IN(3)) {
        pg8::BranchOrder S; S.S.init(T_TOK, DM, G, bx, WGM2);
        pg8::Gemm g{ws + WS_H, ws + WS_WAT, T_TOK, DM, 1024, 4096, 2048, 2048, (size_t)(WS_WBT - WS_WAT)};
        pg8::EpiGate2 E{(const bf16_t*)(ws + WS_SG), (bf16_t*)(ws + WS_TMP), (bf16_t*)(ws + WS_MERGED)};
        pg8::gemm_phase<pg8::EpiGate2, false, pg8::BranchOrder>(lds, g, S, E);
    }
    SEAM_L(3, false);
    if (IN(4)) {
        { const int wave = __builtin_amdgcn_readfirstlane(threadIdx.x >> 6);
          if (G == 256) rows4_to_i8((const bf16_t*)(ws + WS_MERGED), ws + WS_AQ, (float*)(ws + WS_ASC) + 8192, pm_ * 256 + pn_ * 32 + wave, NWAVES);
          else rows_to_i8((const bf16_t*)(ws + WS_MERGED), ws + WS_AQ, (float*)(ws + WS_ASC) + 8192, vcu * NWAVES + wave, T_TOK, G * NWAVES); }
        SEAM_X();
        pg8::Gemm g{ws + WS_AQ, ws + WS_WOUT, T_TOK, DM, 2048, 2048, 2048};
        pg8::StaticOrder S; S.init(T_TOK, DM, G, bx, WGM2);
        pg8::EpiResidI8 E{P.x, (bf16_t*)(ws + WS_X1B), (float*)(ws + WS_CTL), (const float*)(ws + WS_ASC) + 8192, (const float*)(ws + WS_WSC2) + 2048};
        pg8::gemm_phase<pg8::EpiResidI8, true>(lds, g, S, E);
    }
    SEAM_L(4, false);
    if (IN(5)) {
        { const int wave = __builtin_amdgcn_readfirstlane(threadIdx.x >> 6);
          if (G == 256) rows4_to_i8((const bf16_t*)(ws + WS_X1B), ws + WS_AQ, (float*)(ws + WS_ASC), pm_ * 256 + pn_ * 32 + wave, NWAVES);
          else rows_to_i8((const bf16_t*)(ws + WS_X1B), ws + WS_AQ, (float*)(ws + WS_ASC), vcu * NWAVES + wave, T_TOK, G * NWAVES); }
        SEAM_X();
        pg8::Gemm g{ws + WS_AQ, ws + WS_WQ, T_TOK, DM, 2048, 2048, 2048};
        pg8::StaticOrder S; S.init(T_TOK, DM, G, bx, WGM2);
        pg8::EpiPlainI8 E{(bf16_t*)(ws + WS_Q2), (const float*)(ws + WS_ASC), (const float*)(ws + WS_WSC2)};
        pg8::gemm_phase<pg8::EpiPlainI8, true>(lds, g, S, E);
    }
    SEAM_L(5, true);
    if (IN(6)) peer::topk_phase(P, lds, vcu67, G);
    if (IN(6) && IN(7)) { if (lmode < 0) lmode = (G == 256 && IN(0) && group_purity(gpur)) ? 1 : 0; if (!lmode) xcd_barrier(xbar); else group_barrier((unsigned*)(ws + WS_CTL + 147456) + 64 * (bx & 7), 1u, 32u); }
    if (IN(7)) { peer::gather_sweep(P, lds, vcu67, G); }
#undef IN
#undef SEAM
#undef SEAM_L
#undef SEAM_X
}

extern "C" void kernel_launch(void* const* d_in, const int* in_sizes, int n_in, void* d_out, int out_size, void* d_ws, size_t ws_size, hipStream_t stream) {
    static int grid = 0;
    if (grid == 0) {
        if (n_in != 13 || out_size != T_TOK * DM || ws_size < WS_END) { fprintf(stderr, "kernel_launch: unexpected shapes (n_in %d out %d ws %zu)\n", n_in, out_size, ws_size); grid = -1; return; }
        int dev = 0, cus = 0, per_cu = 0;
        if (hipGetDevice(&dev) != hipSuccess || hipDeviceGetAttribute(&cus, hipDeviceAttributeMultiprocessorCount, dev) != hipSuccess) { grid = -1; return; }
        if (hipFuncSetAttribute((const void*)mega_fwd, hipFuncAttributeMaxDynamicSharedMemorySize, LDS_BYTES) != hipSuccess) { fprintf(stderr, "kernel_launch: hipFuncSetAttribute failed\n"); grid = -1; return; }
        if (hipOccupancyMaxActiveBlocksPerMultiprocessor(&per_cu, (const void*)mega_fwd, NTHR, LDS_BYTES) != hipSuccess || per_cu < 1) { fprintf(stderr, "kernel_launch: occupancy query says %d\n", per_cu); grid = -1; return; }
        grid = cus;
    }
    if (grid < 0) return;
    (void)hipMemsetAsync((char*)d_ws + WS_CTL, 0, 1 * MiB, stream);
    Params p{};
    p.x = (const float*)d_in[0]; p.g_mix = (const float*)d_in[1]; p.w_in = (const float*)d_in[2]; p.b_forget = (const float*)d_in[3];
    p.w_a = (const float*)d_in[4]; p.w_b = (const float*)d_in[5]; p.w_out = (const float*)d_in[6]; p.g_ffn = (const float*)d_in[7];
    p.w_query = (const float*)d_in[8]; p.sub_keys = (const float*)d_in[9]; p.e_u = (const float*)d_in[10]; p.e_v = (const float*)d_in[11]; p.g_final = (const float*)d_in[12];
    p.out = (float*)d_out; p.ws = (unsigned char*)d_ws;
#if MK_N_LAUNCHES == 1
    p.ph_lo = 0; p.ph_hi = N_PHASES;
    void* args[] = {&p};
    hipError_t e = hipLaunchCooperativeKernel((const void*)mega_fwd, dim3(grid), dim3(NTHR), args, LDS_BYTES, stream);
    if (e != hipSuccess) fprintf(stderr, "kernel_launch: cooperative launch failed: %s (grid %d)\n", hipGetErrorString(e), grid);
#else
    for (int ph = 0; ph < N_PHASES; ++ph) { p.ph_lo = ph; p.ph_hi = ph + 1; hipLaunchKernelGGL(mega_fwd, dim3(grid), dim3(NTHR), LDS_BYTES, stream, p); }
#endif
}
```
